# Optimizing an MI355X kernel written in HIP

```python
import math
import jax
import jax.numpy as jnp
from jax import lax
import numpy as np

D_MODEL = 1024
BATCH = 2
SEQ = 8192
DEPTH = 2

CTX_LEN = 256
GRID_W = 64
N_BRANCH = 4
BRANCH_W = D_MODEL // N_BRANCH
NA_HEADS = 4
NA_DIM = BRANCH_W // NA_HEADS
NA_WIN_H = 8
NA_WIN_W = 16
NA_QB = 16
NA_KB = 32
DA_HEADS = 4
DA_QK_DIM = BRANCH_W // (2 * DA_HEADS)
DA_V_DIM = 2 * DA_QK_DIM
DA_QBLOCK = 128
ROPE_BASE = 10000.0
GDN_HEADS = 4
GDN_DIM = BRANCH_W // GDN_HEADS
GDN_CONV = 5
GDN_CHUNK = 64
FNET_GROUPS = 4
FNET_GROUP_W = BRANCH_W // FNET_GROUPS
N_EXPERTS = 16
N_GROUPS = 4
TOP_K = 2
D_FF = 512
MOE_BLOCK = 128
RMS_EPS = 1e-6
NEG_INF = -1e30
IN_SPLITS = (3 * BRANCH_W, 3 * BRANCH_W, 3 * BRANCH_W, BRANCH_W, 4 * GDN_HEADS, BRANCH_W, N_BRANCH * D_MODEL)
D_IN = sum(IN_SPLITS)

kernel_name = 'hybrid_diffusion_trunk'


def rmsnorm(x, g):
    xf = x.astype(jnp.float32)
    y = xf * lax.rsqrt(jnp.mean(xf * xf, axis=-1, keepdims=True) + RMS_EPS)
    return (y * g.astype(jnp.float32)).astype(x.dtype)


def l2norm(x):
    xf = x.astype(jnp.float32)
    return xf * lax.rsqrt(jnp.sum(xf * xf, axis=-1, keepdims=True) + RMS_EPS)


def modulate(h, shift, scale):
    return h * (1.0 + scale) + shift


def softmax_f32(s):
    return jax.nn.softmax(s.astype(jnp.float32), axis=-1)


def split_cols(p):
    outs, o = [], 0
    for w in IN_SPLITS:
        outs.append(p[..., o:o + w])
        o += w
    return outs


def rope_2d(x, rows, cols):
    nf = x.shape[-1] // 4
    freqs = ROPE_BASE ** (-jnp.arange(nf, dtype=jnp.float32) / nf)
    ang = jnp.stack([rows[:, None] * freqs, cols[:, None] * freqs], axis=1)
    cos = jnp.cos(ang)[None, :, None, None]
    sin = jnp.sin(ang)[None, :, None, None]
    xf = x.astype(jnp.float32).reshape(*x.shape[:-1], 2, 2, nf)
    x1, x2 = xf[..., 0, :], xf[..., 1, :]
    out = jnp.stack([x1 * cos - x2 * sin, x2 * cos + x1 * sin], axis=-2)
    return out.reshape(x.shape).astype(x.dtype)


def dense_ctx_attention(qc, kc, vc):
    p = softmax_f32(jnp.einsum('bqhd,bkhd->bhqk', qc, kc) * qc.shape[-1] ** -0.5)
    return jnp.einsum('bhqk,bkhd->bqhd', p.astype(vc.dtype), vc)


def neighbourhood_attention(q, k, v, qc, kc, vc, rpb, ctx_out):
    B, S, H, Dh = q.shape
    L = qc.shape[1]
    rows = S // GRID_W
    wh = min(NA_WIN_H, rows)
    ncb = GRID_W // NA_QB
    scale = Dh ** -0.5
    r = jnp.arange(rows)
    row_idx = jnp.clip(r - wh // 2, 0, rows - wh)[:, None] + jnp.arange(wh)[None, :]
    qcol = jnp.arange(GRID_W).reshape(ncb, NA_QB)
    col_idx = jnp.clip(qcol[:, 0] - NA_WIN_W // 2, 0, GRID_W - NA_KB)[:, None] + jnp.arange(NA_KB)[None, :]
    win_start = jnp.clip(qcol - NA_WIN_W // 2, 0, GRID_W - NA_WIN_W)
    rel = col_idx[:, None, :] - win_start[..., None]
    col_mask = (rel >= 0) & (rel < NA_WIN_W)
    rel_r = row_idx - r[:, None] + NA_WIN_H - 1
    rel_c = jnp.clip(col_idx[:, None, :] - qcol[..., None] + NA_WIN_W - 1, 0, 2 * NA_WIN_W - 2)
    bias = rpb.astype(jnp.float32)[:, rel_r[:, None, None, :, None], rel_c[None, :, :, None, :]]
    bias = jnp.where(col_mask[None, None, :, :, None, :], bias, NEG_INF)
    nk = wh * NA_KB
    bias = bias.reshape(H, rows, ncb, NA_QB, nk)
    kw = k.reshape(B, rows, GRID_W, H, Dh)[:, row_idx[:, None, :, None], col_idx[None, :, None, :]]
    vw = v.reshape(B, rows, GRID_W, H, Dh)[:, row_idx[:, None, :, None], col_idx[None, :, None, :]]
    kw = kw.reshape(B, rows, ncb, nk, H, Dh)
    vw = vw.reshape(B, rows, ncb, nk, H, Dh)
    qb = q.reshape(B, rows, ncb, NA_QB, H, Dh)
    s_loc = jnp.einsum('brjqhd,brjkhd->bhrjqk', qb, kw).astype(jnp.float32) * scale + bias[None]
    s_ctx = jnp.einsum('brjqhd,bchd->bhrjqc', qb, kc).astype(jnp.float32) * scale
    p = softmax_f32(jnp.concatenate([s_loc, s_ctx], axis=-1)).astype(v.dtype)
    o = (jnp.einsum('bhrjqk,brjkhd->brjqhd', p[..., :nk], vw)
         + jnp.einsum('bhrjqc,bchd->brjqhd', p[..., nk:], vc)).reshape(B, S, H * Dh)
    o_c = dense_ctx_attention(qc, kc, vc).reshape(B, L, H * Dh) if ctx_out else None
    return o, o_c


def diff_attention(q, k, v, qc, kc, vc, lam, ctx_out):
    B, S, H, _, dq = q.shape
    scale = dq ** -0.5
    k_all = jnp.concatenate([k, kc], axis=1)
    v_all = jnp.concatenate([v, vc], axis=1)
    nb = S // DA_QBLOCK
    qb = jnp.moveaxis(q.reshape(B, nb, DA_QBLOCK, H, 2, dq), 1, 0)

    def block(qblk):
        p = softmax_f32(jnp.einsum('bqhmd,bkhmd->bhmqk', qblk, k_all) * scale)
        a = p[:, :, 0] - lam * p[:, :, 1]
        return jnp.einsum('bhqk,bkhd->bqhd', a.astype(v_all.dtype), v_all)

    o = jnp.moveaxis(lax.map(block, qb), 0, 1).reshape(B, S, H, v.shape[-1])
    o_c = None
    if ctx_out:
        p = softmax_f32(jnp.einsum('bqhmd,bkhmd->bhmqk', qc, kc) * scale)
        a = p[:, :, 0] - lam * p[:, :, 1]
        o_c = jnp.einsum('bhqk,bkhd->bqhd', a.astype(vc.dtype), vc)
    return o, o_c


def short_conv(x, w):
    K = w.shape[0]
    pad = K // 2
    T = x.shape[1]
    xp = jnp.pad(x, ((0, 0), (pad, pad), (0, 0)))
    y = xp[:, 0:T] * w[0]
    for i in range(1, K):
        y = y + xp[:, i:i + T] * w[i]
    return jax.nn.silu(y)


def gdn_prepare(qkv, ab, conv_w, a_log, dt_bias):
    B, T, _ = qkv.shape
    q, k, v = jnp.split(short_conv(qkv, conv_w), 3, axis=-1)
    to_heads = lambda u: jnp.moveaxis(u.reshape(B, T, GDN_HEADS, GDN_DIM), 1, 2)
    q = l2norm(to_heads(q)) * GDN_DIM ** -0.5
    k = l2norm(to_heads(k))
    v = to_heads(v).astype(jnp.float32)
    abf = ab.astype(jnp.float32).reshape(B, T, 2, 2, GDN_HEADS)
    g = -jnp.exp(a_log.astype(jnp.float32)) * jax.nn.softplus(abf[:, :, 0] + dt_bias.astype(jnp.float32))
    beta = jax.nn.sigmoid(abf[:, :, 1])
    g = jnp.transpose(g, (2, 0, 3, 1))
    beta = jnp.transpose(beta, (2, 0, 3, 1))
    return q, k, v, g, beta


def gdn_chunked(q, k, v, g, beta, s0):
    B, H, T, dk = q.shape
    dv = v.shape[-1]
    C = GDN_CHUNK
    N = T // C
    q, k, v = (u.reshape(B, H, N, C, -1) for u in (q, k, v))
    g = g.reshape(B, H, N, C)
    beta = beta.reshape(B, H, N, C)
    G = jnp.cumsum(g, axis=-1)
    incl = jnp.tril(jnp.ones((C, C), dtype=bool))
    strict = jnp.tril(jnp.ones((C, C), dtype=bool), -1)
    decay = jnp.where(incl, jnp.exp(jnp.where(incl, G[..., :, None] - G[..., None, :], 0.0)), 0.0)
    kb = k * beta[..., None]
    a = jnp.where(strict, jnp.einsum('bhnid,bhnjd->bhnij', kb, k) * decay, 0.0)
    lhs = a + jnp.eye(C, dtype=a.dtype)
    u = lax.linalg.triangular_solve(lhs, v * beta[..., None], left_side=True, lower=True, unit_diagonal=True)
    w = lax.linalg.triangular_solve(lhs, kb * jnp.exp(G)[..., None], left_side=True, lower=True, unit_diagonal=True)
    qk = jnp.where(incl, jnp.einsum('bhnid,bhnjd->bhnij', q, k) * decay, 0.0)
    q_dec = q * jnp.exp(G)[..., None]
    k_dec = k * jnp.exp(G[..., -1:] - G)[..., None]
    g_last = jnp.exp(G[..., -1])

    def step(S, xs):
        qk_c, qd_c, kd_c, u_c, w_c, gl_c = xs
        v_new = u_c - jnp.einsum('bhcd,bhde->bhce', w_c, S)
        o = jnp.einsum('bhcd,bhde->bhce', qd_c, S) + jnp.einsum('bhij,bhje->bhie', qk_c, v_new)
        S = S * gl_c[..., None, None] + jnp.einsum('bhcd,bhce->bhde', kd_c, v_new)
        return S, o

    xs = tuple(jnp.moveaxis(t, 2, 0) for t in (qk, q_dec, k_dec, u, w, g_last))
    s_final, o = lax.scan(step, s0, xs)
    return jnp.moveaxis(o, 0, 2).reshape(B, H, T, dv), s_final


def gdn_mixer(qkv, ab, z, qkv_c, ab_c, z_c, conv_w, a_log, dt_bias, onorm_g, ctx_out):
    ql, kl, vl, gl, bl = gdn_prepare(qkv, ab, conv_w, a_log, dt_bias)
    qc, kc, vc, gc, bc = gdn_prepare(qkv_c, ab_c, conv_w, a_log, dt_bias)
    B = qkv.shape[0]
    s0 = jnp.zeros((B, GDN_HEADS, GDN_DIM, GDN_DIM), jnp.float32)
    o_lat, o_ctx = 0.0, 0.0
    for d in range(2):
        fl = (lambda u: jnp.flip(u, axis=2)) if d == 1 else (lambda u: u)
        oc, s_ctx = gdn_chunked(fl(qc), fl(kc), fl(vc), fl(gc[d]), fl(bc[d]), s0)
        ol, _ = gdn_chunked(fl(ql), fl(kl), fl(vl), fl(gl[d]), fl(bl[d]), s_ctx)
        o_lat = o_lat + fl(ol)
        if ctx_out:
            o_ctx = o_ctx + fl(oc)

    def gate_out(o, zz):
        Bq, H, T, dv = o.shape
        y = rmsnorm(jnp.moveaxis(o, 1, 2), onorm_g) * jax.nn.silu(zz.reshape(Bq, T, H, dv).astype(jnp.float32))
        return y.reshape(Bq, T, H * dv).astype(zz.dtype)

    return gate_out(o_lat, z), (gate_out(o_ctx, z_c) if ctx_out else None)


def fourier_mix(f):
    B, T, _ = f.shape
    fg = f.astype(jnp.float32).reshape(B, T, FNET_GROUPS, FNET_GROUP_W)
    y = jnp.real(jnp.fft.fft2(fg, axes=(1, 3), norm='ortho'))
    return y.reshape(B, T, BRANCH_W).astype(f.dtype)


def merge_branches(branches, gate_in, w_branch, w_out):
    br = jnp.stack(branches, axis=2)
    proj = jnp.einsum('btiw,iwd->btid', br, w_branch)
    gates = jax.nn.sigmoid(gate_in.reshape(*gate_in.shape[:2], N_BRANCH, D_MODEL))
    return jnp.sum(gates * proj, axis=2) @ w_out


def token_mixers(h, hc, w_in, na_qn_g, na_kn_g, na_rpb, da_qn_g, da_kn_g, da_lam_q1, da_lam_k1,
                 da_lam_q2, da_lam_k2, da_subln_g, gdn_conv_w, gdn_a_log, gdn_dt_bias, gdn_onorm_g,
                 w_branch, w_out, lam_init, ctx_out):
    B, S, _ = h.shape
    L = hc.shape[1]
    na_qkv, da_qkv, gdn_qkv, gdn_z, gdn_ab, fnet_in, gate_in = split_cols(h @ w_in)
    na_qkv_c, da_qkv_c, gdn_qkv_c, gdn_z_c, gdn_ab_c, fnet_in_c, gate_in_c = split_cols(hc @ w_in)

    def na_heads(u, n):
        q, k, v = (t.reshape(B, n, NA_HEADS, NA_DIM) for t in jnp.split(u, 3, axis=-1))
        return rmsnorm(q, na_qn_g), rmsnorm(k, na_kn_g), v
    ya, ya_c = neighbourhood_attention(*na_heads(na_qkv, S), *na_heads(na_qkv_c, L), na_rpb, ctx_out)

    t = jnp.arange(S)
    rows = (t // GRID_W).astype(jnp.float32)
    cols = (t % GRID_W).astype(jnp.float32)

    def da_heads(u, n):
        q, k, v = jnp.split(u, 3, axis=-1)
        q = rmsnorm(q.reshape(B, n, DA_HEADS, 2, DA_QK_DIM), da_qn_g)
        k = rmsnorm(k.reshape(B, n, DA_HEADS, 2, DA_QK_DIM), da_kn_g)
        return q, k, v.reshape(B, n, DA_HEADS, DA_V_DIM)

    qd, kd, vd = da_heads(da_qkv, S)
    qd, kd = rope_2d(qd, rows, cols), rope_2d(kd, rows, cols)
    lam = (jnp.exp(jnp.sum(da_lam_q1.astype(jnp.float32) * da_lam_k1.astype(jnp.float32)))
           - jnp.exp(jnp.sum(da_lam_q2.astype(jnp.float32) * da_lam_k2.astype(jnp.float32))) + lam_init)
    yd, yd_c = diff_attention(qd, kd, vd, *da_heads(da_qkv_c, L), lam, ctx_out)

    def da_out(o):
        return (rmsnorm(o, da_subln_g) * (1.0 - lam_init)).reshape(*o.shape[:2], BRANCH_W)

    yg, yg_c = gdn_mixer(gdn_qkv, gdn_ab, gdn_z, gdn_qkv_c, gdn_ab_c, gdn_z_c, gdn_conv_w, gdn_a_log,
                         gdn_dt_bias, gdn_onorm_g, ctx_out)

    y = merge_branches((ya, da_out(yd), yg, fourier_mix(fnet_in)), gate_in, w_branch, w_out)
    y_c = None
    if ctx_out:
        y_c = merge_branches((ya_c, da_out(yd_c), yg_c, fourier_mix(fnet_in_c)), gate_in_c, w_branch, w_out)
    return y, y_c


def moe_ffn(h, w_router, router_bias, w_g, w_u, w_d):
    N, D = h.shape
    per_group = N_EXPERTS // N_GROUPS
    scores = jax.nn.sigmoid((h @ w_router).astype(jnp.float32))
    sel = scores + router_bias.astype(jnp.float32)
    group_score = lax.top_k(sel.reshape(N, N_GROUPS, per_group), 2)[0].sum(-1)
    best = jnp.argmax(group_score, axis=-1)
    in_group = (jnp.arange(N_EXPERTS) // per_group)[None, :] == best[:, None]
    _, idx = lax.top_k(jnp.where(in_group, sel, NEG_INF), TOP_K)
    wts = jnp.take_along_axis(scores, idx, axis=-1)
    wts = wts / jnp.sum(wts, axis=-1, keepdims=True)
    A = N * TOP_K
    expert = idx.reshape(A)
    token = jnp.repeat(jnp.arange(N, dtype=jnp.int32), TOP_K)
    weight = wts.reshape(A)
    order = jnp.argsort(expert)
    e_sorted = expert[order]
    counts = jnp.bincount(expert, length=N_EXPERTS)
    padded = (counts + MOE_BLOCK - 1) // MOE_BLOCK * MOE_BLOCK
    pad_end = jnp.cumsum(padded)
    pad_start = pad_end - padded
    start = jnp.cumsum(counts) - counts
    dest = pad_start[e_sorted] + jnp.arange(A) - start[e_sorted]
    n_blocks = -(-A // MOE_BLOCK) + N_EXPERTS
    P = n_blocks * MOE_BLOCK
    row_token = jnp.full((P,), N, jnp.int32).at[dest].set(token[order])
    row_weight = jnp.zeros((P,), h.dtype).at[dest].set(weight[order].astype(h.dtype))
    block_expert = jnp.minimum(jnp.searchsorted(pad_end, jnp.arange(n_blocks) * MOE_BLOCK, side='right'), N_EXPERTS - 1)
    h_pad = jnp.concatenate([h, jnp.zeros((1, D), h.dtype)], axis=0)
    xs = h_pad[row_token].reshape(n_blocks, MOE_BLOCK, D)

    def expert_block(args):
        xb, e = args
        return (jax.nn.silu(xb @ w_g[e]) * (xb @ w_u[e])) @ w_d[e]

    y = lax.map(expert_block, (xs, block_expert)).reshape(P, D) * row_weight[:, None]
    return jnp.zeros((N + 1, D), h.dtype).at[row_token].add(y)[:N]


def setup_inputs(seed: int = 0) -> dict:
    key = jax.random.key(seed)
    ks = (jax.random.fold_in(key, i) for i in range(100))
    nrm = lambda shape, s: jax.random.normal(next(ks), shape, jnp.float32) * s
    gain = lambda shape: 1.0 + nrm(shape, 0.01)
    dt = jnp.exp(jax.random.uniform(next(ks), (DEPTH, 2, GDN_HEADS), jnp.float32,
                                    minval=math.log(1e-3), maxval=math.log(1e-1)))
    a_log = jnp.log(jax.random.uniform(next(ks), (DEPTH, 2, GDN_HEADS), jnp.float32, minval=1.0, maxval=16.0))
    return {
        'x': nrm((BATCH, SEQ, D_MODEL), 1.0),
        'c': nrm((BATCH, D_MODEL), 1.0),
        'ctx': nrm((BATCH, CTX_LEN, D_MODEL), 1.0),
        'c_ctx': nrm((D_MODEL,), 1.0),
        'w_mod': nrm((DEPTH, D_MODEL, 6 * D_MODEL), 0.5 * D_MODEL ** -0.5),
        'b_mod': nrm((DEPTH, 6 * D_MODEL), 0.02),
        'norm1_g': gain((DEPTH, D_MODEL)),
        'norm2_g': gain((DEPTH, D_MODEL)),
        'w_in': nrm((DEPTH, D_MODEL, D_IN), D_MODEL ** -0.5),
        'na_qn_g': gain((DEPTH, NA_DIM)),
        'na_kn_g': gain((DEPTH, NA_DIM)),
        'na_rpb': nrm((DEPTH, NA_HEADS, 2 * NA_WIN_H - 1, 2 * NA_WIN_W - 1), 0.1),
        'da_qn_g': gain((DEPTH, DA_QK_DIM)),
        'da_kn_g': gain((DEPTH, DA_QK_DIM)),
        'da_lam_q1': nrm((DEPTH, DA_QK_DIM), 0.1),
        'da_lam_k1': nrm((DEPTH, DA_QK_DIM), 0.1),
        'da_lam_q2': nrm((DEPTH, DA_QK_DIM), 0.1),
        'da_lam_k2': nrm((DEPTH, DA_QK_DIM), 0.1),
        'da_subln_g': gain((DEPTH, DA_V_DIM)),
        'gdn_conv_w': nrm((DEPTH, GDN_CONV, 3 * BRANCH_W), GDN_CONV ** -0.5),
        'gdn_a_log': a_log,
        'gdn_dt_bias': dt + jnp.log(-jnp.expm1(-dt)),
        'gdn_onorm_g': gain((DEPTH, GDN_DIM)),
        'w_branch': nrm((DEPTH, N_BRANCH, BRANCH_W, D_MODEL), BRANCH_W ** -0.5),
        'w_out': nrm((DEPTH, D_MODEL, D_MODEL), D_MODEL ** -0.5),
        'w_router': nrm((D_MODEL, N_EXPERTS), D_MODEL ** -0.5),
        'router_bias': nrm((N_EXPERTS,), 0.01),
        'moe_w_gate': nrm((DEPTH, N_EXPERTS, D_MODEL, D_FF), D_MODEL ** -0.5),
        'moe_w_up': nrm((DEPTH, N_EXPERTS, D_MODEL, D_FF), D_MODEL ** -0.5),
        'moe_w_down': nrm((DEPTH, N_EXPERTS, D_FF, D_MODEL), D_FF ** -0.5),
    }


def reference(x, c, ctx, c_ctx, w_mod, b_mod, norm1_g, norm2_g, w_in, na_qn_g, na_kn_g, na_rpb,
              da_qn_g, da_kn_g, da_lam_q1, da_lam_k1, da_lam_q2, da_lam_k2, da_subln_g, gdn_conv_w,
              gdn_a_log, gdn_dt_bias, gdn_onorm_g, w_branch, w_out, w_router, router_bias,
              moe_w_gate, moe_w_up, moe_w_down):
    B, S, _ = x.shape
    L = ctx.shape[1]
    for l in range(DEPTH):
        last = l == DEPTH - 1
        lam_init = 0.8 - 0.6 * math.exp(-0.3 * l)
        mod = jax.nn.silu(c) @ w_mod[l] + b_mod[l]
        mod_c = jax.nn.silu(c_ctx) @ w_mod[l] + b_mod[l]
        sh1, sc1, g1, sh2, sc2, g2 = jnp.split(mod[:, None, :], 6, axis=-1)
        sh1c, sc1c, g1c, sh2c, sc2c, g2c = jnp.split(mod_c, 6)
        h = modulate(rmsnorm(x, norm1_g[l]), sh1, sc1)
        hc = modulate(rmsnorm(ctx, norm1_g[l]), sh1c, sc1c)
        y, y_c = token_mixers(h, hc, w_in[l], na_qn_g[l], na_kn_g[l], na_rpb[l], da_qn_g[l], da_kn_g[l],
                              da_lam_q1[l], da_lam_k1[l], da_lam_q2[l], da_lam_k2[l], da_subln_g[l],
                              gdn_conv_w[l], gdn_a_log[l], gdn_dt_bias[l], gdn_onorm_g[l],
                              w_branch[l], w_out[l], lam_init, not last)
        x = x + g1 * y
        h2 = modulate(rmsnorm(x, norm2_g[l]), sh2, sc2).reshape(B * S, D_MODEL)
        if last:
            f = moe_ffn(h2, w_router, router_bias, moe_w_gate[l], moe_w_up[l], moe_w_down[l])
            x = x + g2 * f.reshape(B, S, D_MODEL)
        else:
            ctx = ctx + g1c * y_c
            h2c = modulate(rmsnorm(ctx, norm2_g[l]), sh2c, sc2c).reshape(B * L, D_MODEL)
            f = moe_ffn(jnp.concatenate([h2, h2c], axis=0), w_router, router_bias,
                        moe_w_gate[l], moe_w_up[l], moe_w_down[l])
            x = x + g2 * f[:B * S].reshape(B, S, D_MODEL)
            ctx = ctx + g2c * f[B * S:].reshape(B, L, D_MODEL)
    return x
```

```cpp
#ifndef CPU_EMU
#include <hip/hip_runtime.h>
#include <hip/hip_cooperative_groups.h>
#include <cstdio>
namespace cg = cooperative_groups;
#define HD __device__ __forceinline__
#define THREADS(t, n) for (int t = threadIdx.x; t < (n); t += 256)
#define SYNC __syncthreads();
#define COSPI(x) cospif(x)
#define SINPI(x) sinpif(x)
typedef float4 f4;
#else
#include <cmath>
#include <cstdio>
#include <cstring>
#include <cstddef>
#define HD inline
#define THREADS(t, n) for (int t = 0; t < (n); ++t)
#define SYNC
#define COSPI(x) ((float)cos(M_PI * (double)(x)))
#define SINPI(x) ((float)sin(M_PI * (double)(x)))
struct f4 { float x, y, z, w; };
#endif

#ifndef SEQ
#define SEQ 8192
#endif
#ifndef CTXL
#define CTXL 256
#endif

typedef unsigned short bf16;
constexpr int NB = 2, D = 1024, GW = 64, ROWS = SEQ / GW;
constexpr int NLAT = NB * SEQ, NCTX = NB * CTXL, R = NLAT + NCTX;
constexpr int DIN = 6928;
constexpr int PLD = 2880;
constexpr int C_NAQ = 0, C_NAK = 256, C_NAV = 512, C_DAQ = 768, C_DAK = 1024, C_DAV = 1280, C_GQ = 1536, C_Z = 2304,
              C_F = 2560, C_AB = 2816;
constexpr int NCC = CTXL / 64, NCL = SEQ / 64, NCH = NCC + NCL;
constexpr int NUNIT = 2 * NB * 4 * NCH;
constexpr int SMEM_FLOATS = 22 * 1024;

struct Params {
    const float* in[30];
    float* out;
    float* mods;
    float* cosT;
    float* sinT;
    float* cs;
    bf16* h;
    bf16* P;
    bf16* gq;
    float* gg;
    float* gbeta;
    bf16* fcs;
    bf16* cU;
    bf16* cW;
    bf16* cQK;
    float* cG;
    float* odir;
    bf16* br;
    bf16* mg;
    int* sel_e;
    float* sel_w;
    bf16* act;
    int phase;
    int layer;
};

enum { I_X = 0, I_C, I_CTX, I_CCTX, I_WMOD, I_BMOD, I_N1G, I_N2G, I_WIN, I_NAQG, I_NAKG, I_RPB, I_DAQG, I_DAKG, I_LQ1, I_LK1,
       I_LQ2, I_LK2, I_SUBLN, I_CONVW, I_ALOG, I_DTB, I_ONORM, I_WBR, I_WOUT, I_WROUTER, I_RBIAS, I_MG, I_MU, I_MD };

HD float bf2f(bf16 v) { union { unsigned u; float f; } x; x.u = ((unsigned)v) << 16; return x.f; }
HD bf16 f2bf(float f) { union { unsigned u; float f; } x; x.f = f; unsigned u = x.u; u += 0x7fffu + ((u >> 16) & 1u); return (bf16)(u >> 16); }
HD float sigmoidf_(float x) { return 1.0f / (1.0f + expf(-x)); }
HD float siluf_(float x) { return x / (1.0f + expf(-x)); }

struct RowInfo { int seg, b, t, T, base; };
HD RowInfo rowinfo(int r) {
    RowInfo q;
    if (r < NLAT) { q.seg = 0; q.b = r / SEQ; q.t = r % SEQ; q.T = SEQ; q.base = q.b * SEQ; }
    else { int r2 = r - NLAT; q.seg = 1; q.b = r2 / CTXL; q.t = r2 % CTXL; q.T = CTXL; q.base = NLAT + q.b * CTXL; }
    return q;
}
HD const float* xrow_in(const Params& p, int l, int r) {
    if (r < NLAT) return (l == 0 ? p.in[I_X] : p.out) + (size_t)r * D;
    return p.cs + (size_t)(r - NLAT) * D;
}
HD float* xrow_out(const Params& p, int r) {
    if (r < NLAT) return p.out + (size_t)r * D;
    return p.cs + (size_t)(r - NLAT) * D;
}
HD const float* modrow(const Params& p, int l, int r) {
    int s = (r < NLAT) ? (r / SEQ) : 2;
    return p.mods + (size_t)(l * 3 + s) * 6144;
}
HD float lam_init_of(int l) { return l == 0 ? 0.2f : (0.8f - 0.6f * 0.7408182206817179f); }

HD void ph_init(const Params& p, int bid, int nb) {
    const int NMOD = 2 * 3 * 6144;
    for (int u = bid; u < (NMOD + 255) / 256; u += nb) {
        THREADS(t, 256) {
            int idx = u * 256 + t;
            if (idx < NMOD) {
                int l = idx / (3 * 6144), s = (idx / 6144) % 3, col = idx % 6144;
                const float* cv = (s < 2) ? p.in[I_C] + s * D : p.in[I_CCTX];
                const float* w = p.in[I_WMOD] + (size_t)l * D * 6144 + col;
                float acc = 0.f;
                for (int k = 0; k < D; ++k) acc += siluf_(cv[k]) * w[(size_t)k * 6144];
                p.mods[idx] = acc + p.in[I_BMOD][l * 6144 + col];
            }
        }
    }
    for (int u = bid; u < (SEQ + 255) / 256; u += nb) {
        THREADS(t, 256) {
            int j = u * 256 + t;
            if (j < SEQ) { float a = 2.0f * (float)j / (float)SEQ; p.cosT[j] = COSPI(a); p.sinT[j] = SINPI(a); }
        }
    }
    for (int u = bid; u < (NCTX * D) / 256; u += nb) {
        THREADS(t, 256) { int i = u * 256 + t; p.cs[i] = p.in[I_CTX][i]; }
    }
}

HD void ph_norm1(const Params& p, int l, int bid, int nb, float* sm) {
    const float* g = p.in[I_N1G] + l * D;
    for (int r = bid; r < R; r += nb) {
        const float* x = xrow_in(p, l, r);
        const float* m = modrow(p, l, r);
        THREADS(t, 256) { float s = 0.f; for (int k = t; k < D; k += 256) s += x[k] * x[k]; sm[t] = s; }
        SYNC
        THREADS(t, 1) { float s = 0.f; for (int i = 0; i < 256; ++i) s += sm[i]; sm[256] = s; }
        SYNC
        THREADS(t, 256) {
            float rs = 1.0f / sqrtf(sm[256] / D + 1e-6f);
            for (int k = t; k < D; k += 256) {
                float v = x[k] * rs * g[k];
                p.h[(size_t)r * D + k] = f2bf(v * (1.0f + m[1024 + k]) + m[k]);
            }
        }
        SYNC
    }
}

HD void ph_inproj(const Params& p, int l, int bid, int nb) {
    const int NQ = PLD / 4, QB = (NQ + 255) / 256;
    const float* W = p.in[I_WIN] + (size_t)l * D * DIN;
    for (int u = bid; u < R * QB; u += nb) {
        int r = u / QB, qb = u % QB;
        const bf16* hr = p.h + (size_t)r * D;
        THREADS(t, 256) {
            int q = qb * 256 + t;
            if (q < NQ) {
                int j = q * 4;
                float a0 = 0, a1 = 0, a2 = 0, a3 = 0;
                if (j < 2832) {
                    int sc = (j < 2560) ? j : (j < 2816 ? j + 16 : j - 256);
                    const float* wp = W + sc;
                    for (int k = 0; k < D; ++k) {
                        float a = bf2f(hr[k]);
                        f4 w = *(const f4*)(wp + (size_t)k * DIN);
                        a0 += a * w.x; a1 += a * w.y; a2 += a * w.z; a3 += a * w.w;
                    }
                }
                bf16* o = p.P + (size_t)r * PLD + j;
                o[0] = f2bf(a0); o[1] = f2bf(a1); o[2] = f2bf(a2); o[3] = f2bf(a3);
            }
        }
    }
}

HD void ph_prep(const Params& p, int l, int bid, int nb) {
    {
        const float* naq = p.in[I_NAQG] + l * 64; const float* nak = p.in[I_NAKG] + l * 64;
        const float* daq = p.in[I_DAQG] + l * 32; const float* dak = p.in[I_DAKG] + l * 32;
        const int N = R * 24;
        for (int u = bid; u < (N + 255) / 256; u += nb) {
            THREADS(t, 256) {
                int idx = u * 256 + t;
                if (idx < N) {
                    int r = idx / 24, gidx = idx % 24;
                    if (gidx < 8) {
                        int isk = gidx >> 2, hd = gidx & 3;
                        bf16* ptr = p.P + (size_t)r * PLD + (isk ? C_NAK : C_NAQ) + hd * 64;
                        const float* g = isk ? nak : naq;
                        float ss = 0.f;
                        for (int d = 0; d < 64; ++d) { float v = bf2f(ptr[d]); ss += v * v; }
                        float rs = 1.0f / sqrtf(ss / 64.0f + 1e-6f);
                        for (int d = 0; d < 64; ++d) ptr[d] = f2bf(bf2f(ptr[d]) * rs * g[d]);
                    } else {
                        int gi = gidx - 8; int isk = gi >> 3; int hm = gi & 7;
                        bf16* ptr = p.P + (size_t)r * PLD + (isk ? C_DAK : C_DAQ) + hm * 32;
                        const float* g = isk ? dak : daq;
                        float ss = 0.f;
                        for (int d = 0; d < 32; ++d) { float v = bf2f(ptr[d]); ss += v * v; }
                        float rs = 1.0f / sqrtf(ss / 32.0f + 1e-6f);
                        if (r < NLAT) {
                            int tt = r % SEQ; float prow = (float)(tt / GW), pcol = (float)(tt % GW);
                            for (int a = 0; a < 2; ++a) {
                                float pos = a == 0 ? prow : pcol;
                                float fr = 1.0f;
                                for (int f = 0; f < 8; ++f) {
                                    float ang = pos * fr;
                                    float cs = cosf(ang), sn = sinf(ang);
                                    int i1 = a * 16 + f, i2 = a * 16 + 8 + f;
                                    float x1 = bf2f(ptr[i1]) * rs * g[i1], x2 = bf2f(ptr[i2]) * rs * g[i2];
                                    ptr[i1] = f2bf(x1 * cs - x2 * sn);
                                    ptr[i2] = f2bf(x2 * cs + x1 * sn);
                                    fr *= 0.31622776601683794f;
                                }
                            }
                        } else {
                            for (int d = 0; d < 32; ++d) ptr[d] = f2bf(bf2f(ptr[d]) * rs * g[d]);
                        }
                    }
                }
            }
        }
    }
    {
        const float* cw = p.in[I_CONVW] + (size_t)l * 5 * 768;
        const int N = R * 12;
        for (int u = bid; u < (N + 255) / 256; u += nb) {
            THREADS(t, 256) {
                int idx = u * 256 + t;
                if (idx < N) {
                    int r = idx / 12, ph = idx % 12; int part = ph >> 2, hd = ph & 3;
                    RowInfo ri = rowinfo(r);
                    int ch0 = part * 256 + hd * 64;
                    float ss = 0.f;
                    for (int pass = 0; pass < 2; ++pass) {
                        float scl = 1.0f;
                        if (pass == 1) { if (part == 0) scl = 0.125f / sqrtf(ss + 1e-6f); else if (part == 1) scl = 1.0f / sqrtf(ss + 1e-6f); }
                        if (pass == 0 && part == 2) continue;
                        for (int c = 0; c < 64; ++c) {
                            float y = 0.f;
                            for (int i = 0; i < 5; ++i) {
                                int tt = ri.t + i - 2;
                                if (tt >= 0 && tt < ri.T) y += bf2f(p.P[(size_t)(ri.base + tt) * PLD + C_GQ + ch0 + c]) * cw[i * 768 + ch0 + c];
                            }
                            y = siluf_(y);
                            if (pass == 0) ss += y * y; else p.gq[(size_t)r * 768 + ch0 + c] = f2bf(y * scl);
                        }
                    }
                }
            }
        }
    }
    {
        const float* alog = p.in[I_ALOG] + l * 8; const float* dtb = p.in[I_DTB] + l * 8;
        const int N = R * 8;
        for (int u = bid; u < (N + 255) / 256; u += nb) {
            THREADS(t, 256) {
                int idx = u * 256 + t;
                if (idx < N) {
                    int r = idx / 8, dh = idx % 8;
                    float a = bf2f(p.P[(size_t)r * PLD + C_AB + dh]);
                    float b = bf2f(p.P[(size_t)r * PLD + C_AB + 8 + dh]);
                    float xx = a + dtb[dh];
                    float sp = xx > 20.f ? xx : log1pf(expf(xx));
                    p.gg[(size_t)dh * R + r] = -expf(alog[dh]) * sp;
                    p.gbeta[(size_t)dh * R + r] = sigmoidf_(b);
                }
            }
        }
    }
    {
        const int RQ = (l == 0) ? R : NLAT;
        for (int r = bid; r < RQ; r += nb) {
            THREADS(t, 256) {
                int g = t >> 6, m = t & 63;
                const bf16* f = p.P + (size_t)r * PLD + C_F + g * 64;
                float fc = 0.f, fs = 0.f;
                for (int c = 0; c < 64; ++c) {
                    int ti = ((m * c) & 63) * (SEQ / 64);
                    float v = bf2f(f[c]);
                    fc += v * p.cosT[ti]; fs += v * p.sinT[ti];
                }
                p.fcs[(size_t)r * 512 + t] = f2bf(fc);
                p.fcs[(size_t)r * 512 + 256 + t] = f2bf(fs);
            }
        }
    }
}

HD void ph_na(const Params& p, int l, int bid, int nb) {
    const float* rpb = p.in[I_RPB] + (size_t)l * 4 * 15 * 31;
    const int RQ = (l == 0) ? R : NLAT;
    const int N = RQ * 4;
    const int wh = ROWS < 8 ? ROWS : 8;
    for (int u = bid; u < (N + 255) / 256; u += nb) {
        THREADS(t, 256) {
            int idx = u * 256 + t;
            if (idx < N) {
                int hd = idx / RQ, r = idx % RQ;
                RowInfo ri = rowinfo(r);
                float q[64], o[64];
                const bf16* qp = p.P + (size_t)r * PLD + C_NAQ + hd * 64;
#pragma unroll
                for (int d = 0; d < 64; ++d) { q[d] = bf2f(qp[d]) * 0.125f; o[d] = 0.f; }
                float mx = -1e30f, lsum = 0.f;
                int nloc = 0, rs = 0, ws = 0, gr = 0, gc = 0;
                if (ri.seg == 0) {
                    gr = ri.t / GW; gc = ri.t % GW;
                    rs = gr - wh / 2; if (rs < 0) rs = 0; if (rs > ROWS - wh) rs = ROWS - wh;
                    ws = gc - 8; if (ws < 0) ws = 0; if (ws > GW - 16) ws = GW - 16;
                    nloc = wh * 16;
                }
                int ctxbase = NLAT + ri.b * CTXL;
                for (int kk = 0; kk < nloc + CTXL; ++kk) {
                    int kr; float bias = 0.f;
                    if (kk < nloc) {
                        int a = kk >> 4, c = kk & 15;
                        int krow = rs + a, kcol = ws + c;
                        kr = ri.base + krow * GW + kcol;
                        bias = rpb[(hd * 15 + (krow - gr + 7)) * 31 + (kcol - gc + 15)];
                    } else kr = ctxbase + (kk - nloc);
                    const bf16* kp = p.P + (size_t)kr * PLD + C_NAK + hd * 64;
                    float s = 0.f;
#pragma unroll
                    for (int d = 0; d < 64; ++d) s += q[d] * bf2f(kp[d]);
                    s += bias;
                    if (s > mx) { float f = expf(mx - s); lsum *= f;
#pragma unroll
                        for (int d = 0; d < 64; ++d) o[d] *= f;
                        mx = s; }
                    float e = expf(s - mx);
                    lsum += e;
                    const bf16* vp = p.P + (size_t)kr * PLD + C_NAV + hd * 64;
#pragma unroll
                    for (int d = 0; d < 64; ++d) o[d] += e * bf2f(vp[d]);
                }
                float inv = 1.0f / lsum;
                bf16* op = p.br + (size_t)r * D + hd * 64;
#pragma unroll
                for (int d = 0; d < 64; ++d) op[d] = f2bf(o[d] * inv);
            }
        }
    }
}

HD void ph_da(const Params& p, int l, int bid, int nb) {
    const int RQ = (l == 0) ? R : NLAT;
    const int N = RQ * 4;
    const float lam_init = lam_init_of(l);
    float s1 = 0.f, s2 = 0.f;
    for (int d = 0; d < 32; ++d) {
        s1 += p.in[I_LQ1][l * 32 + d] * p.in[I_LK1][l * 32 + d];
        s2 += p.in[I_LQ2][l * 32 + d] * p.in[I_LK2][l * 32 + d];
    }
    const float lam = expf(s1) - expf(s2) + lam_init;
    const float* sg = p.in[I_SUBLN] + l * 64;
    const float scale = 0.17677669529663687f;
    for (int u = bid; u < (N + 255) / 256; u += nb) {
        THREADS(t, 256) {
            int idx = u * 256 + t;
            if (idx < N) {
                int hd = idx / RQ, r = idx % RQ;
                RowInfo ri = rowinfo(r);
                float q0[32], q1[32], o0[64], o1[64];
                const bf16* qp = p.P + (size_t)r * PLD + C_DAQ + hd * 64;
#pragma unroll
                for (int d = 0; d < 32; ++d) { q0[d] = bf2f(qp[d]) * scale; q1[d] = bf2f(qp[32 + d]) * scale; }
#pragma unroll
                for (int d = 0; d < 64; ++d) { o0[d] = 0.f; o1[d] = 0.f; }
                float m0 = -1e30f, m1 = -1e30f, l0 = 0.f, l1 = 0.f;
                int nlat = (ri.seg == 0) ? SEQ : 0;
                int latbase = ri.b * SEQ, ctxbase = NLAT + ri.b * CTXL;
                for (int kk = 0; kk < nlat + CTXL; ++kk) {
                    int kr = (kk < nlat) ? latbase + kk : ctxbase + (kk - nlat);
                    const bf16* kp = p.P + (size_t)kr * PLD + C_DAK + hd * 64;
                    const bf16* vp = p.P + (size_t)kr * PLD + C_DAV + hd * 64;
                    float sa = 0.f, sb = 0.f;
#pragma unroll
                    for (int d = 0; d < 32; ++d) { sa += q0[d] * bf2f(kp[d]); sb += q1[d] * bf2f(kp[32 + d]); }
                    if (sa > m0) { float f = expf(m0 - sa); l0 *= f;
#pragma unroll
                        for (int d = 0; d < 64; ++d) o0[d] *= f;
                        m0 = sa; }
                    if (sb > m1) { float f = expf(m1 - sb); l1 *= f;
#pragma unroll
                        for (int d = 0; d < 64; ++d) o1[d] *= f;
                        m1 = sb; }
                    float ea = expf(sa - m0), eb = expf(sb - m1);
                    l0 += ea; l1 += eb;
#pragma unroll
                    for (int d = 0; d < 64; ++d) { float v = bf2f(vp[d]); o0[d] += ea * v; o1[d] += eb * v; }
                }
                float i0 = 1.0f / l0, i1 = lam / l1;
                float ss = 0.f;
#pragma unroll
                for (int d = 0; d < 64; ++d) { o0[d] = o0[d] * i0 - o1[d] * i1; ss += o0[d] * o0[d]; }
                float rs = (1.0f - lam_init) / sqrtf(ss / 64.0f + 1e-6f);
                bf16* op = p.br + (size_t)r * D + 256 + hd * 64;
#pragma unroll
                for (int d = 0; d < 64; ++d) op[d] = f2bf(o0[d] * rs * sg[d]);
            }
        }
    }
}

struct ChunkInfo { int dir, b, hd, n, seg, T, base, nloc; };
HD ChunkInfo chunkinfo(int unit) {
    ChunkInfo c;
    c.n = unit % NCH; int ch = unit / NCH; c.hd = ch & 3; c.b = (ch >> 2) % NB; c.dir = ch / (4 * NB);
    if (c.n < NCC) { c.seg = 1; c.T = CTXL; c.base = NLAT + c.b * CTXL; c.nloc = c.n; }
    else { c.seg = 0; c.T = SEQ; c.base = c.b * SEQ; c.nloc = c.n - NCC; }
    return c;
}
HD int chunk_row(const ChunkInfo& c, int i) { int pf = c.nloc * 64 + i; return c.base + (c.dir ? (c.T - 1 - pf) : pf); }

HD void ph_gdn_chunk(const Params& p, int l, int bid, int nb, float* sm) {
    float* sk = sm;
    float* sq = sm + 4096;
    float* sA = sm + 8192;
    float* sX = sm + 12288;
    float* sG = sm + 20480;
    float* sB = sm + 20544;
    for (int unit = bid; unit < NUNIT; unit += nb) {
        ChunkInfo c = chunkinfo(unit);
        int dh = c.dir * 4 + c.hd;
        THREADS(t, 4096) {
            int i = t >> 6, d = t & 63; int row = chunk_row(c, i);
            sq[t] = bf2f(p.gq[(size_t)row * 768 + c.hd * 64 + d]);
            sk[t] = bf2f(p.gq[(size_t)row * 768 + 256 + c.hd * 64 + d]);
        }
        THREADS(t, 1) {
            float acc = 0.f;
            for (int i = 0; i < 64; ++i) { int row = chunk_row(c, i); acc += p.gg[(size_t)dh * R + row]; sG[i] = acc; sB[i] = p.gbeta[(size_t)dh * R + row]; }
        }
        SYNC
        THREADS(t, 4096) {
            int i = t >> 6, j = t & 63;
            float kk = 0.f, qk = 0.f;
            for (int d = 0; d < 64; ++d) { kk += sk[i * 64 + d] * sk[j * 64 + d]; qk += sq[i * 64 + d] * sk[j * 64 + d]; }
            float dec = (j <= i) ? expf(sG[i] - sG[j]) : 0.f;
            sA[t] = (j < i) ? kk * sB[i] * dec : 0.f;
            p.cQK[(size_t)unit * 4096 + t] = f2bf(qk * dec);
        }
        THREADS(t, 8192) {
            int i = t >> 7, cc = t & 127; int row = chunk_row(c, i);
            float v;
            if (cc < 64) v = sB[i] * bf2f(p.gq[(size_t)row * 768 + 512 + c.hd * 64 + cc]);
            else v = sB[i] * expf(sG[i]) * sk[i * 64 + (cc - 64)];
            sX[t] = v;
        }
        SYNC
        for (int i = 1; i < 64; ++i) {
            THREADS(cc, 128) {
                float acc = sX[i * 128 + cc];
                for (int j = 0; j < i; ++j) acc -= sA[i * 64 + j] * sX[j * 128 + cc];
                sX[i * 128 + cc] = acc;
            }
            SYNC
        }
        THREADS(t, 8192) {
            int i = t >> 7, cc = t & 127;
            if (cc < 64) p.cU[(size_t)unit * 4096 + i * 64 + cc] = f2bf(sX[t]);
            else p.cW[(size_t)unit * 4096 + i * 64 + (cc - 64)] = f2bf(sX[t]);
        }
        THREADS(t, 64) { p.cG[(size_t)unit * 64 + t] = sG[t]; }
        SYNC
    }
}

HD void ph_fourier2(const Params& p, int l, int bid, int nb) {
    const int RQ = (l == 0) ? R : NLAT;
    for (int r = bid; r < RQ; r += nb) {
        RowInfo ri = rowinfo(r);
        const float nrm = 1.0f / sqrtf((float)ri.T * 64.0f);
        const int mul = SEQ / ri.T;
        THREADS(ch, 256) {
            float acc = 0.f;
            for (int tt = 0; tt < ri.T; ++tt) {
                int ti = ((ri.t * tt) & (ri.T - 1)) * mul;
                const bf16* f = p.fcs + (size_t)(ri.base + tt) * 512;
                acc += p.cosT[ti] * bf2f(f[ch]) - p.sinT[ti] * bf2f(f[256 + ch]);
            }
            p.br[(size_t)r * D + 768 + ch] = f2bf(acc * nrm);
        }
    }
}

HD void ph_gdn_scan(const Params& p, int l, int bid, int nb, float* sm) {
    float* sW = sm;
    float* sQ = sm + 4096;
    float* sK = sm + 8192;
    float* sQK = sm + 12288;
    float* sS = sm + 16384;
    float* sV = sm + 17408;
    float* sU = sm + 18432;
    float* sG = sm + 19456;
    const int RQ = (l == 0) ? R : NLAT;
    for (int cu = bid; cu < 2 * NB * 4 * 4; cu += nb) {
        int chain = cu >> 2, cb = cu & 3;
        THREADS(t, 1024) { sS[t] = 0.f; }
        SYNC
        for (int n = 0; n < NCH; ++n) {
            int unit = chain * NCH + n;
            ChunkInfo c = chunkinfo(unit);
            THREADS(t, 64) { sG[t] = p.cG[(size_t)unit * 64 + t]; }
            SYNC
            THREADS(t, 4096) {
                int i = t >> 6, d = t & 63; int row = chunk_row(c, i);
                sW[t] = bf2f(p.cW[(size_t)unit * 4096 + t]);
                sQK[t] = bf2f(p.cQK[(size_t)unit * 4096 + t]);
                sQ[t] = bf2f(p.gq[(size_t)row * 768 + c.hd * 64 + d]) * expf(sG[i]);
                sK[t] = bf2f(p.gq[(size_t)row * 768 + 256 + c.hd * 64 + d]) * expf(sG[63] - sG[i]);
            }
            THREADS(t, 1024) { int i = t >> 4, e = t & 15; sU[t] = bf2f(p.cU[(size_t)unit * 4096 + i * 64 + cb * 16 + e]); }
            SYNC
            THREADS(t, 1024) {
                int i = t >> 4, e = t & 15;
                float acc = sU[t];
                for (int d = 0; d < 64; ++d) acc -= sW[i * 64 + d] * sS[d * 16 + e];
                sV[t] = acc;
            }
            SYNC
            THREADS(t, 1024) {
                int i = t >> 4, e = t & 15;
                float acc = 0.f;
                for (int d = 0; d < 64; ++d) acc += sQ[i * 64 + d] * sS[d * 16 + e];
                for (int j = 0; j < 64; ++j) acc += sQK[i * 64 + j] * sV[j * 16 + e];
                int row = chunk_row(c, i);
                if (row < RQ) p.odir[((size_t)c.dir * R + row) * 256 + c.hd * 64 + cb * 16 + e] = acc;
            }
            SYNC
            THREADS(t, 1024) {
                int d = t >> 4, e = t & 15;
                float acc = sS[t] * expf(sG[63]);
                for (int i = 0; i < 64; ++i) acc += sK[i * 64 + d] * sV[i * 16 + e];
                sS[t] = acc;
            }
            SYNC
        }
    }
}

HD void ph_gdn_fin(const Params& p, int l, int bid, int nb) {
    const int RQ = (l == 0) ? R : NLAT;
    const float* og = p.in[I_ONORM] + l * 64;
    const int N = RQ * 4;
    for (int u = bid; u < (N + 255) / 256; u += nb) {
        THREADS(t, 256) {
            int idx = u * 256 + t;
            if (idx < N) {
                int r = idx >> 2, hd = idx & 3;
                const float* o0 = p.odir + (size_t)r * 256 + hd * 64;
                const float* o1 = p.odir + ((size_t)R + r) * 256 + hd * 64;
                float ss = 0.f;
                for (int d = 0; d < 64; ++d) { float v = o0[d] + o1[d]; ss += v * v; }
                float rs = 1.0f / sqrtf(ss / 64.0f + 1e-6f);
                for (int d = 0; d < 64; ++d) {
                    float v = (o0[d] + o1[d]) * rs * og[d];
                    float z = bf2f(p.P[(size_t)r * PLD + C_Z + hd * 64 + d]);
                    p.br[(size_t)r * D + 512 + hd * 64 + d] = f2bf(v * siluf_(z));
                }
            }
        }
    }
}

HD void ph_merge(const Params& p, int l, int bid, int nb) {
    const int RQ = (l == 0) ? R : NLAT;
    const float* W = p.in[I_WIN] + (size_t)l * D * DIN + 2832;
    const float* WB = p.in[I_WBR] + (size_t)l * 4 * 256 * D;
    for (int r = bid; r < RQ; r += nb) {
        const bf16* hr = p.h + (size_t)r * D;
        const bf16* brr = p.br + (size_t)r * D;
        THREADS(t, 256) {
            int j = t * 4;
            float m0 = 0, m1 = 0, m2 = 0, m3 = 0;
            for (int i = 0; i < 4; ++i) {
                float g0 = 0, g1 = 0, g2 = 0, g3 = 0, p0 = 0, p1 = 0, p2 = 0, p3 = 0;
                const float* wg = W + i * 1024 + j;
                for (int k = 0; k < D; ++k) {
                    float a = bf2f(hr[k]); f4 w = *(const f4*)(wg + (size_t)k * DIN);
                    g0 += a * w.x; g1 += a * w.y; g2 += a * w.z; g3 += a * w.w;
                }
                const float* wb = WB + (size_t)i * 256 * D + j;
                for (int k = 0; k < 256; ++k) {
                    float a = bf2f(brr[i * 256 + k]); f4 w = *(const f4*)(wb + (size_t)k * D);
                    p0 += a * w.x; p1 += a * w.y; p2 += a * w.z; p3 += a * w.w;
                }
                m0 += sigmoidf_(g0) * p0; m1 += sigmoidf_(g1) * p1; m2 += sigmoidf_(g2) * p2; m3 += sigmoidf_(g3) * p3;
            }
            bf16* o = p.mg + (size_t)r * D + j;
            o[0] = f2bf(m0); o[1] = f2bf(m1); o[2] = f2bf(m2); o[3] = f2bf(m3);
        }
    }
}

HD void ph_outproj(const Params& p, int l, int bid, int nb) {
    const int RQ = (l == 0) ? R : NLAT;
    const float* W = p.in[I_WOUT] + (size_t)l * D * D;
    for (int r = bid; r < RQ; r += nb) {
        const bf16* a_ = p.mg + (size_t)r * D;
        const float* xi = xrow_in(p, l, r);
        float* xo = xrow_out(p, r);
        const float* m = modrow(p, l, r);
        THREADS(t, 256) {
            int j = t * 4;
            float a0 = 0, a1 = 0, a2 = 0, a3 = 0;
            for (int k = 0; k < D; ++k) {
                float a = bf2f(a_[k]); f4 w = *(const f4*)(W + (size_t)k * D + j);
                a0 += a * w.x; a1 += a * w.y; a2 += a * w.z; a3 += a * w.w;
            }
            xo[j] = xi[j] + m[2048 + j] * a0; xo[j + 1] = xi[j + 1] + m[2048 + j + 1] * a1;
            xo[j + 2] = xi[j + 2] + m[2048 + j + 2] * a2; xo[j + 3] = xi[j + 3] + m[2048 + j + 3] * a3;
        }
    }
}

HD void ph_router(const Params& p, int l, int bid, int nb, float* sm) {
    const int RQ = (l == 0) ? R : NLAT;
    const float* g = p.in[I_N2G] + l * D;
    const float* wr = p.in[I_WROUTER];
    float* sh = sm + 512;
    float* sl = sm + 2048;
    for (int r = bid; r < RQ; r += nb) {
        const float* x = xrow_out(p, r);
        const float* m = modrow(p, l, r);
        THREADS(t, 256) { float s = 0.f; for (int k = t; k < D; k += 256) s += x[k] * x[k]; sm[t] = s; }
        SYNC
        THREADS(t, 1) { float s = 0.f; for (int i = 0; i < 256; ++i) s += sm[i]; sm[256] = s; }
        SYNC
        THREADS(t, 256) {
            float rs = 1.0f / sqrtf(sm[256] / D + 1e-6f);
            for (int k = t; k < D; k += 256) {
                float v = x[k] * rs * g[k];
                v = v * (1.0f + m[4096 + k]) + m[3072 + k];
                sh[k] = v;
                p.h[(size_t)r * D + k] = f2bf(v);
            }
        }
        SYNC
        THREADS(t, 256) {
            int e = t & 15, ks = t >> 4;
            float acc = 0.f;
            for (int k = ks * 64; k < ks * 64 + 64; ++k) acc += sh[k] * wr[k * 16 + e];
            sl[ks * 16 + e] = acc;
        }
        SYNC
        THREADS(t, 1) {
            float* sc = sm + 2304; float* sel = sm + 2320;
            for (int e = 0; e < 16; ++e) {
                float acc = 0.f;
                for (int ks = 0; ks < 16; ++ks) acc += sl[ks * 16 + e];
                sc[e] = sigmoidf_(acc); sel[e] = sc[e] + p.in[I_RBIAS][e];
            }
            int best = 0; float bestv = -1e30f;
            for (int gph = 0; gph < 4; ++gph) {
                float t1 = -1e30f, t2 = -1e30f;
                for (int j = 0; j < 4; ++j) { float v = sel[gph * 4 + j]; if (v > t1) { t2 = t1; t1 = v; } else if (v > t2) t2 = v; }
                float gs = t1 + t2;
                if (gs > bestv) { bestv = gs; best = gph; }
            }
            int i1 = -1, i2 = -1; float v1 = -1e30f, v2 = -1e30f;
            for (int j = 0; j < 4; ++j) {
                float v = sel[best * 4 + j];
                if (v > v1) { v2 = v1; i2 = i1; v1 = v; i1 = best * 4 + j; } else if (v > v2) { v2 = v; i2 = best * 4 + j; }
            }
            float w1 = sc[i1], w2 = sc[i2], ws = w1 + w2;
            p.sel_e[r * 2] = i1; p.sel_e[r * 2 + 1] = i2;
            p.sel_w[r * 2] = w1 / ws; p.sel_w[r * 2 + 1] = w2 / ws;
        }
        SYNC
    }
}

HD void ph_ffn1(const Params& p, int l, int bid, int nb) {
    const int RQ = (l == 0) ? R : NLAT;
    for (int u = bid; u < RQ; u += nb) {
        int r = u;
        const bf16* hr = p.h + (size_t)r * D;
        THREADS(t, 256) {
            int slot = t >> 7, j = (t & 127) * 4;
            int e = p.sel_e[r * 2 + slot];
            const float* wg = p.in[I_MG] + ((size_t)(l * 16 + e) * D) * 512 + j;
            const float* wu = p.in[I_MU] + ((size_t)(l * 16 + e) * D) * 512 + j;
            float g0 = 0, g1 = 0, g2 = 0, g3 = 0, u0 = 0, u1 = 0, u2 = 0, u3 = 0;
            for (int k = 0; k < D; ++k) {
                float a = bf2f(hr[k]);
                f4 w = *(const f4*)(wg + (size_t)k * 512); f4 v = *(const f4*)(wu + (size_t)k * 512);
                g0 += a * w.x; g1 += a * w.y; g2 += a * w.z; g3 += a * w.w;
                u0 += a * v.x; u1 += a * v.y; u2 += a * v.z; u3 += a * v.w;
            }
            bf16* o = p.act + ((size_t)r * 2 + slot) * 512 + j;
            o[0] = f2bf(siluf_(g0) * u0); o[1] = f2bf(siluf_(g1) * u1); o[2] = f2bf(siluf_(g2) * u2); o[3] = f2bf(siluf_(g3) * u3);
        }
    }
}

HD void ph_ffn2(const Params& p, int l, int bid, int nb) {
    const int RQ = (l == 0) ? R : NLAT;
    for (int r = bid; r < RQ; r += nb) {
        float* xo = xrow_out(p, r);
        const float* m = modrow(p, l, r);
        THREADS(t, 256) {
            int j = t * 4;
            float f0 = 0, f1 = 0, f2 = 0, f3 = 0;
            for (int slot = 0; slot < 2; ++slot) {
                int e = p.sel_e[r * 2 + slot]; float wt = p.sel_w[r * 2 + slot];
                const float* wd = p.in[I_MD] + ((size_t)(l * 16 + e) * 512) * D + j;
                const bf16* a_ = p.act + ((size_t)r * 2 + slot) * 512;
                float a0 = 0, a1 = 0, a2 = 0, a3 = 0;
                for (int k = 0; k < 512; ++k) {
                    float a = bf2f(a_[k]); f4 w = *(const f4*)(wd + (size_t)k * D);
                    a0 += a * w.x; a1 += a * w.y; a2 += a * w.z; a3 += a * w.w;
                }
                f0 += wt * a0; f1 += wt * a1; f2 += wt * a2; f3 += wt * a3;
            }
            xo[j] += m[5120 + j] * f0; xo[j + 1] += m[5120 + j + 1] * f1; xo[j + 2] += m[5120 + j + 2] * f2; xo[j + 3] += m[5120 + j + 3] * f3;
        }
    }
}

constexpr int NPHASE_LAYER = 13;
HD void run_phase(const Params& p, int ph, int l, int bid, int nb, float* sm) {
    switch (ph) {
        case 0: ph_norm1(p, l, bid, nb, sm); break;
        case 1: ph_inproj(p, l, bid, nb); break;
        case 2: ph_prep(p, l, bid, nb); break;
        case 3: ph_na(p, l, bid, nb); break;
        case 4: ph_da(p, l, bid, nb); break;
        case 5: ph_gdn_chunk(p, l, bid, nb, sm); break;
        case 6: ph_fourier2(p, l, bid, nb); break;
        case 7: ph_gdn_scan(p, l, bid, nb, sm); break;
        case 8: ph_gdn_fin(p, l, bid, nb); break;
        case 9: ph_merge(p, l, bid, nb); break;
        case 10: ph_outproj(p, l, bid, nb); break;
        case 11: ph_router(p, l, bid, nb, sm); break;
        case 12: ph_ffn1(p, l, bid, nb); break;
        case 13: ph_ffn2(p, l, bid, nb); break;
        default: break;
    }
}

struct WsLayout { size_t mods, cosT, sinT, cs, h, P, gq, gg, gbeta, fcs, cU, cW, cQK, cG, odir, br, mg, sel_e, sel_w, act, total; };
inline WsLayout ws_layout() {
    WsLayout w; size_t o = 0;
    auto take = [&](size_t bytes) { size_t r = o; o += (bytes + 255) & ~(size_t)255; return r; };
    w.mods = take(2 * 3 * 6144 * 4); w.cosT = take(SEQ * 4); w.sinT = take(SEQ * 4); w.cs = take((size_t)NCTX * D * 4);
    w.h = take((size_t)R * D * 2); w.P = take((size_t)R * PLD * 2); w.gq = take((size_t)R * 768 * 2);
    w.gg = take((size_t)8 * R * 4); w.gbeta = take((size_t)8 * R * 4); w.fcs = take((size_t)R * 512 * 2);
    w.cU = take((size_t)NUNIT * 4096 * 2); w.cW = take((size_t)NUNIT * 4096 * 2); w.cQK = take((size_t)NUNIT * 4096 * 2);
    w.cG = take((size_t)NUNIT * 64 * 4); w.odir = take((size_t)2 * R * 256 * 4); w.br = take((size_t)R * D * 2);
    w.mg = take((size_t)R * D * 2); w.sel_e = take((size_t)R * 2 * 4); w.sel_w = take((size_t)R * 2 * 4);
    w.act = w.P;
    w.total = o;
    return w;
}
inline void fill_params(Params& p, void* const* d_in, void* d_out, void* d_ws) {
    WsLayout w = ws_layout(); char* b = (char*)d_ws;
    for (int i = 0; i < 30; ++i) p.in[i] = (const float*)d_in[i];
    p.out = (float*)d_out;
    p.mods = (float*)(b + w.mods); p.cosT = (float*)(b + w.cosT); p.sinT = (float*)(b + w.sinT); p.cs = (float*)(b + w.cs);
    p.h = (bf16*)(b + w.h); p.P = (bf16*)(b + w.P); p.gq = (bf16*)(b + w.gq); p.gg = (float*)(b + w.gg); p.gbeta = (float*)(b + w.gbeta);
    p.fcs = (bf16*)(b + w.fcs); p.cU = (bf16*)(b + w.cU); p.cW = (bf16*)(b + w.cW); p.cQK = (bf16*)(b + w.cQK); p.cG = (float*)(b + w.cG);
    p.odir = (float*)(b + w.odir); p.br = (bf16*)(b + w.br); p.mg = (bf16*)(b + w.mg); p.sel_e = (int*)(b + w.sel_e);
    p.sel_w = (float*)(b + w.sel_w); p.act = (bf16*)(b + w.act);
}

#ifndef CPU_EMU
__global__ void __launch_bounds__(256) fwd_megakernel(Params p) {
    __shared__ float sm[SMEM_FLOATS];
    cg::grid_group grid = cg::this_grid();
    ph_init(p, blockIdx.x, gridDim.x);
    grid.sync();
    for (int l = 0; l < 2; ++l)
        for (int ph = 0; ph <= NPHASE_LAYER; ++ph) {
            run_phase(p, ph, l, blockIdx.x, gridDim.x, sm);
            grid.sync();
        }
}

extern "C" void kernel_launch(void* const* d_in, const int* in_sizes, int n_in, void* d_out, int out_size,
                              void* d_ws, size_t ws_size, hipStream_t stream) {
    WsLayout w = ws_layout();
    if (ws_size < w.total) { fprintf(stderr, "ws too small: need %zu have %zu\n", w.total, ws_size); return; }
    static int grid_blocks = 0;
    if (!grid_blocks) {
        int dev = 0, cus = 0, per_cu = 0;
        (void)hipGetDevice(&dev);
        (void)hipDeviceGetAttribute(&cus, hipDeviceAttributeMultiprocessorCount, dev);
        (void)hipOccupancyMaxActiveBlocksPerMultiprocessor(&per_cu, fwd_megakernel, 256, 0);
        if (per_cu < 1) per_cu = 1;
        grid_blocks = cus * per_cu;
    }
    Params p{};
    fill_params(p, d_in, d_out, d_ws);
    void* args[] = {&p};
    hipError_t e = hipLaunchCooperativeKernel((void*)fwd_megakernel, dim3(grid_blocks), dim3(256), args, 0, stream);
    if (e != hipSuccess) fprintf(stderr, "cooperative launch failed: %s (grid %d)\n", hipGetErrorString(e), grid_blocks);
}
#endif
```

```cpp
#ifndef CPU_EMU
#include <hip/hip_runtime.h>
#include <hip/hip_cooperative_groups.h>
#include <cstdio>
namespace cg = cooperative_groups;
#define HD __device__ __forceinline__
#define THREADS(t, n) for (int t = threadIdx.x; t < (n); t += 256)
#define SYNC __syncthreads();
#define COSPI(x) cospif(x)
#define SINPI(x) sinpif(x)
typedef float4 f4;
#else
#include <cmath>
#include <cstdio>
#include <cstring>
#include <cstddef>
#define HD inline
#define THREADS(t, n) for (int t = 0; t < (n); ++t)
#define SYNC
#define COSPI(x) ((float)cos(M_PI * (double)(x)))
#define SINPI(x) ((float)sin(M_PI * (double)(x)))
struct f4 { float x, y, z, w; };
#endif

#ifndef SEQ
#define SEQ 8192
#endif
#ifndef CTXL
#define CTXL 256
#endif

typedef unsigned short bf16;
#ifndef CPU_EMU
typedef __attribute__((ext_vector_type(8))) short bf16x8_t;
typedef __attribute__((ext_vector_type(4))) float f32x4_t;
typedef __attribute__((ext_vector_type(4))) int i32x4_t;
#define ATOMIC_ADD_RET(ptr, v) atomicAdd((ptr), (v))
#else
HD int atomic_add_ret_(int* p, int v) { int old;
#pragma omp atomic capture
    { old = *p; *p += v; }
    return old; }
#define ATOMIC_ADD_RET(ptr, v) atomic_add_ret_((ptr), (v))
#endif
constexpr int NB = 2, D = 1024, GW = 64, ROWS = SEQ / GW;
constexpr int NLAT = NB * SEQ, NCTX = NB * CTXL, R = NLAT + NCTX;
constexpr int DIN = 6928;
constexpr int PLD = 2816;
constexpr int C_NAQ = 0, C_NAK = 256, C_NAV = 512, C_DAQ = 768, C_DAK = 1024, C_DAV = 1280, C_GQ = 1536, C_Z = 2304,
              C_F = 2560;
constexpr int WIN_N = 6912;
constexpr int PADROWS = 2 * R + 16 * 128;
constexpr int NCC = CTXL / 64, NCL = SEQ / 64, NCH = NCC + NCL;
constexpr int NUNIT = 2 * NB * 4 * NCH;
constexpr int SMEM_FLOATS = 66 * 256;

struct Params {
    const float* in[30];
    float* out;
    float* mods;
    float* cosT;
    float* sinT;
    float* cs;
    bf16* h;
    bf16* P;
    bf16* gq;
    float* gg;
    float* gbeta;
    bf16* fcs;
    bf16* cU;
    bf16* cW;
    bf16* cQK;
    float* cG;
    float* odir;
    bf16* br;
    bf16* mg;
    int* sel_e;
    float* sel_w;
    bf16* act;
    bf16* Y;
    bf16* wt_in;
    bf16* wt_br;
    bf16* wt_out;
    bf16* wt_gu;
    bf16* wt_d;
    int* cnt;
    int* elist;
    int* apos;
    int phase;
    int layer;
};

enum { I_X = 0, I_C, I_CTX, I_CCTX, I_WMOD, I_BMOD, I_N1G, I_N2G, I_WIN, I_NAQG, I_NAKG, I_RPB, I_DAQG, I_DAKG, I_LQ1, I_LK1,
       I_LQ2, I_LK2, I_SUBLN, I_CONVW, I_ALOG, I_DTB, I_ONORM, I_WBR, I_WOUT, I_WROUTER, I_RBIAS, I_MG, I_MU, I_MD };

HD float bf2f(bf16 v) { union { unsigned u; float f; } x; x.u = ((unsigned)v) << 16; return x.f; }
HD bf16 f2bf(float f) { union { unsigned u; float f; } x; x.f = f; unsigned u = x.u; u += 0x7fffu + ((u >> 16) & 1u); return (bf16)(u >> 16); }
HD float sigmoidf_(float x) { return 1.0f / (1.0f + expf(-x)); }
HD float siluf_(float x) { return x / (1.0f + expf(-x)); }

struct RowInfo { int seg, b, t, T, base; };
HD RowInfo rowinfo(int r) {
    RowInfo q;
    if (r < NLAT) { q.seg = 0; q.b = r / SEQ; q.t = r % SEQ; q.T = SEQ; q.base = q.b * SEQ; }
    else { int r2 = r - NLAT; q.seg = 1; q.b = r2 / CTXL; q.t = r2 % CTXL; q.T = CTXL; q.base = NLAT + q.b * CTXL; }
    return q;
}
HD const float* xrow_in(const Params& p, int l, int r) {
    if (r < NLAT) return (l == 0 ? p.in[I_X] : p.out) + (size_t)r * D;
    return p.cs + (size_t)(r - NLAT) * D;
}
HD float* xrow_out(const Params& p, int r) {
    if (r < NLAT) return p.out + (size_t)r * D;
    return p.cs + (size_t)(r - NLAT) * D;
}
HD const float* modrow(const Params& p, int l, int r) {
    int s = (r < NLAT) ? (r / SEQ) : 2;
    return p.mods + (size_t)(l * 3 + s) * 6144;
}
HD float lam_init_of(int l) { return l == 0 ? 0.2f : (0.8f - 0.6f * 0.7408182206817179f); }


#ifndef CPU_EMU
template <int NJ> struct AccT { f32x4_t v[4][NJ]; };
#define ACC_DECL(NJ, a) AccT<NJ> a
template <int NJ> HD void acc_zero(AccT<NJ>& a) {
#pragma unroll
    for (int i = 0; i < 4; ++i)
#pragma unroll
        for (int j = 0; j < NJ; ++j) a.v[i][j] = f32x4_t{0.f, 0.f, 0.f, 0.f};
}
#define ACC_FOR(NJ, row, col) { const int _ln = threadIdx.x & 63, _w = threadIdx.x >> 6; \
    _Pragma("unroll") for (int _i = 0; _i < 4; ++_i) _Pragma("unroll") for (int _j = 0; _j < NJ; ++_j) _Pragma("unroll") for (int _r = 0; _r < 4; ++_r) { \
    const int row = (_w >> 1) * 64 + _i * 16 + (_ln >> 4) * 4 + _r; const int col = (_w & 1) * (16 * NJ) + _j * 16 + (_ln & 15);
#define AV(a) a.v[_i][_j][_r]
#define ACC_END }}
#define ACC_FOR_PAIR(row, pcol) { const int _ln = threadIdx.x & 63, _w = threadIdx.x >> 6; \
    _Pragma("unroll") for (int _i = 0; _i < 4; ++_i) _Pragma("unroll") for (int _jj = 0; _jj < 2; ++_jj) _Pragma("unroll") for (int _r = 0; _r < 4; ++_r) { \
    const int row = (_w >> 1) * 64 + _i * 16 + (_ln >> 4) * 4 + _r; const int pcol = (_w & 1) * 32 + _jj * 16 + (_ln & 15);
#define AV_G(a) a.v[_i][2 * _jj][_r]
#define AV_U(a) a.v[_i][2 * _jj + 1][_r]

template <int NJ, class AF, class BF>
HD void gemm_accum(AccT<NJ>& acc, AF arow, BF brow, int K, char* smem) {
    constexpr int NBL = NJ;
    const int t = threadIdx.x, lane = t & 63, w = t >> 6, wr = w >> 1, wc = w & 1;
    const int lr = t >> 3, lc = t & 7;
    const bf16* ap[4]; const bf16* bp[NBL];
#pragma unroll
    for (int i = 0; i < 4; ++i) ap[i] = arow(lr + 32 * i) + lc * 8;
#pragma unroll
    for (int i = 0; i < NBL; ++i) bp[i] = brow(lr + 32 * i) + lc * 8;
    char* sA = smem; char* sB = smem + 32768;
    const unsigned wofs = lr * 128 + ((lc ^ (lr & 7)) << 4);
    const int fr = lane & 15, fg = lane >> 4;
    const unsigned aoff0 = (wr * 64 + fr) * 128 + (((fg) ^ (fr & 7)) << 4);
    const unsigned aoff1 = (wr * 64 + fr) * 128 + (((4 + fg) ^ (fr & 7)) << 4);
    const unsigned boff0 = (wc * (16 * NJ) + fr) * 128 + (((fg) ^ (fr & 7)) << 4);
    const unsigned boff1 = (wc * (16 * NJ) + fr) * 128 + (((4 + fg) ^ (fr & 7)) << 4);
    const int KT = K >> 6;
    i32x4_t ra[4], rb[NBL];
    __syncthreads();
#pragma unroll
    for (int i = 0; i < 4; ++i) ra[i] = *(const i32x4_t*)(ap[i]);
#pragma unroll
    for (int i = 0; i < NBL; ++i) rb[i] = *(const i32x4_t*)(bp[i]);
#pragma unroll
    for (int i = 0; i < 4; ++i) *(i32x4_t*)(sA + wofs + 4096 * i) = ra[i];
#pragma unroll
    for (int i = 0; i < NBL; ++i) *(i32x4_t*)(sB + wofs + 4096 * i) = rb[i];
    __syncthreads();
    for (int kt = 0; kt < KT; ++kt) {
        const int cur = kt & 1;
        if (kt + 1 < KT) {
#pragma unroll
            for (int i = 0; i < 4; ++i) ra[i] = *(const i32x4_t*)(ap[i] + (kt + 1) * 64);
#pragma unroll
            for (int i = 0; i < NBL; ++i) rb[i] = *(const i32x4_t*)(bp[i] + (kt + 1) * 64);
        }
        const char* cA = sA + cur * 16384; const char* cB = sB + cur * 16384;
#pragma unroll
        for (int s = 0; s < 2; ++s) {
            bf16x8_t af[4], bfr[NJ];
#pragma unroll
            for (int i = 0; i < 4; ++i) af[i] = *(const bf16x8_t*)(cA + (s ? aoff1 : aoff0) + i * 2048);
#pragma unroll
            for (int j = 0; j < NJ; ++j) bfr[j] = *(const bf16x8_t*)(cB + (s ? boff1 : boff0) + j * 2048);
#pragma unroll
            for (int i = 0; i < 4; ++i)
#pragma unroll
                for (int j = 0; j < NJ; ++j) acc.v[i][j] = __builtin_amdgcn_mfma_f32_16x16x32_bf16(af[i], bfr[j], acc.v[i][j], 0, 0, 0);
        }
        if (kt + 1 < KT) {
            char* nA = sA + (cur ^ 1) * 16384; char* nB = sB + (cur ^ 1) * 16384;
#pragma unroll
            for (int i = 0; i < 4; ++i) *(i32x4_t*)(nA + wofs + 4096 * i) = ra[i];
#pragma unroll
            for (int i = 0; i < NBL; ++i) *(i32x4_t*)(nB + wofs + 4096 * i) = rb[i];
        }
        __syncthreads();
    }
}
#else
template <int NJ> struct AccT { float v[128][32 * NJ]; };
#define ACC_DECL(NJ, a) static thread_local AccT<NJ> a
template <int NJ> HD void acc_zero(AccT<NJ>& a) { memset(a.v, 0, sizeof(a.v)); }
#define ACC_FOR(NJ, row, col) { for (int row = 0; row < 128; ++row) for (int col = 0; col < 32 * NJ; ++col) {
#define AV(a) a.v[row][col]
#define ACC_END }}
#define ACC_FOR_PAIR(row, pcol) { for (int row = 0; row < 128; ++row) for (int pcol = 0; pcol < 64; ++pcol) {
#define AV_G(a) a.v[row][(pcol / 16) * 32 + (pcol % 16)]
#define AV_U(a) a.v[row][(pcol / 16) * 32 + 16 + (pcol % 16)]
template <int NJ, class AF, class BF>
HD void gemm_accum(AccT<NJ>& acc, AF arow, BF brow, int K, char* smem) {
    for (int i = 0; i < 128; ++i) { const bf16* a = arow(i);
        for (int j = 0; j < 32 * NJ; ++j) { const bf16* b = brow(j); float s = 0.f;
            for (int k = 0; k < K; ++k) s += bf2f(a[k]) * bf2f(b[k]);
            acc.v[i][j] += s; } }
}
#endif

template <class DF>
HD void conv_tile(const float* src, size_t lds_, bf16* dst, size_t ldd, int k0, int nsrc0, DF drow, float* sm) {
    THREADS(t, 4096) { int kk = t >> 6, nn = t & 63; sm[kk * 65 + nn] = src[(size_t)(k0 + kk) * lds_ + nsrc0 + nn]; }
    SYNC
    THREADS(t, 4096) { int nn = t >> 6, kk = t & 63; dst[(size_t)drow(nn) * ldd + k0 + kk] = f2bf(sm[kk * 65 + nn]); }
    SYNC
}
HD void convert_moe(const Params& p, int l, int bid, int nb, float* sm) {
    for (int w = bid; w < 4096 + 2048; w += nb) {
        if (w < 4096) {
            int nt = w & 7, kt = (w >> 3) & 15, gu = (w >> 7) & 1, e = w >> 8;
            const float* src = p.in[gu ? I_MU : I_MG] + (size_t)(l * 16 + e) * D * 512;
            bf16* dst = p.wt_gu + (size_t)e * 1024 * D;
            conv_tile(src, 512, dst, D, kt * 64, nt * 64, [&](int nn) { int j = nt * 64 + nn; return (j >> 4) * 32 + (j & 15) + 16 * gu; }, sm);
        } else {
            int w2 = w - 4096; int nt = w2 & 15, kt = (w2 >> 4) & 7, e = w2 >> 7;
            const float* src = p.in[I_MD] + (size_t)(l * 16 + e) * 512 * D;
            bf16* dst = p.wt_d + (size_t)e * D * 512;
            conv_tile(src, D, dst, 512, kt * 64, nt * 64, [&](int nn) { return nt * 64 + nn; }, sm);
        }
    }
}
HD void convert_static(const Params& p, int bid, int nb, float* sm) {
    for (int w = bid; w < 3456 + 512 + 512; w += nb) {
        if (w < 3456) {
            int nt = w % 108, kt = (w / 108) & 15, l = w / (108 * 16);
            int n0 = nt * 64;
            conv_tile(p.in[I_WIN] + (size_t)l * D * DIN, DIN, p.wt_in + (size_t)l * WIN_N * D, D, kt * 64, n0 < 2560 ? n0 : n0 + 16,
                      [&](int nn) { return n0 + nn; }, sm);
        } else if (w < 3456 + 512) {
            int w2 = w - 3456; int nt = w2 & 15, kt = (w2 >> 4) & 3, li = w2 >> 6;
            conv_tile(p.in[I_WBR] + (size_t)li * 256 * D, D, p.wt_br + (size_t)li * D * 256, 256, kt * 64, nt * 64, [&](int nn) { return nt * 64 + nn; }, sm);
        } else {
            int w2 = w - 3456 - 512; int nt = w2 & 15, kt = (w2 >> 4) & 15, l = w2 >> 8;
            conv_tile(p.in[I_WOUT] + (size_t)l * D * D, D, p.wt_out + (size_t)l * D * D, D, kt * 64, nt * 64, [&](int nn) { return nt * 64 + nn; }, sm);
        }
    }
}

HD void ph_init(const Params& p, int bid, int nb, float* sm) {
    const int NMOD = 2 * 3 * 6144;
    if (bid == 0) { THREADS(t, 32) { p.cnt[t] = 0; } }
    convert_static(p, bid, nb, sm);
    convert_moe(p, 0, bid, nb, sm);
    for (int u = bid; u < (NMOD + 255) / 256; u += nb) {
        THREADS(t, 256) {
            int idx = u * 256 + t;
            if (idx < NMOD) {
                int l = idx / (3 * 6144), s = (idx / 6144) % 3, col = idx % 6144;
                const float* cv = (s < 2) ? p.in[I_C] + s * D : p.in[I_CCTX];
                const float* w = p.in[I_WMOD] + (size_t)l * D * 6144 + col;
                float acc = 0.f;
                for (int k = 0; k < D; ++k) acc += siluf_(cv[k]) * w[(size_t)k * 6144];
                p.mods[idx] = acc + p.in[I_BMOD][l * 6144 + col];
            }
        }
    }
    for (int u = bid; u < (SEQ + 255) / 256; u += nb) {
        THREADS(t, 256) {
            int j = u * 256 + t;
            if (j < SEQ) { float a = 2.0f * (float)j / (float)SEQ; p.cosT[j] = COSPI(a); p.sinT[j] = SINPI(a); }
        }
    }
    for (int u = bid; u < (NCTX * D) / 256; u += nb) {
        THREADS(t, 256) { int i = u * 256 + t; p.cs[i] = p.in[I_CTX][i]; }
    }
}

HD void ph_norm1(const Params& p, int l, int bid, int nb, float* sm) {
    const float* g = p.in[I_N1G] + l * D;
    for (int r = bid; r < R; r += nb) {
        const float* x = xrow_in(p, l, r);
        const float* m = modrow(p, l, r);
        THREADS(t, 256) { float s = 0.f; for (int k = t; k < D; k += 256) s += x[k] * x[k]; sm[t] = s; }
        SYNC
        THREADS(t, 1) { float s = 0.f; for (int i = 0; i < 256; ++i) s += sm[i]; sm[256] = s; }
        SYNC
        THREADS(t, 256) {
            float rs = 1.0f / sqrtf(sm[256] / D + 1e-6f);
            for (int k = t; k < D; k += 256) {
                float v = x[k] * rs * g[k];
                float hv = v * (1.0f + m[1024 + k]) + m[k];
                sm[512 + k] = hv;
                p.h[(size_t)r * D + k] = f2bf(hv);
            }
        }
        SYNC
        THREADS(t, 256) {
            int c = t & 15, ks = t >> 4;
            const float* w = p.in[I_WIN] + (size_t)l * D * DIN + 2560 + c;
            float acc = 0.f;
            for (int k = ks * 64; k < ks * 64 + 64; ++k) acc += sm[512 + k] * w[(size_t)k * DIN];
            sm[2048 + ks * 16 + c] = acc;
        }
        SYNC
        THREADS(t, 8) {
            float a = 0.f, b = 0.f;
            for (int ks = 0; ks < 16; ++ks) { a += sm[2048 + ks * 16 + t]; b += sm[2048 + ks * 16 + 8 + t]; }
            float xx = a + p.in[I_DTB][l * 8 + t];
            float sp = xx > 20.f ? xx : log1pf(expf(xx));
            p.gg[(size_t)t * R + r] = -expf(p.in[I_ALOG][l * 8 + t]) * sp;
            p.gbeta[(size_t)t * R + r] = sigmoidf_(b);
        }
        SYNC
    }
}

HD void ph_inproj(const Params& p, int l, int bid, int nb, char* smc) {
    const bf16* Wt = p.wt_in + (size_t)l * WIN_N * D;
    constexpr int NT = PLD / 128, MT = R / 128;
    for (int tile = bid; tile < MT * NT; tile += nb) {
        const int mt = tile / NT, nt = tile % NT;
        ACC_DECL(4, acc); acc_zero(acc);
        gemm_accum<4>(acc, [&](int i) { return p.h + (size_t)(mt * 128 + i) * D; }, [&](int j) { return Wt + (size_t)(nt * 128 + j) * D; }, D, smc);
        ACC_FOR(4, row, col) { p.P[(size_t)(mt * 128 + row) * PLD + nt * 128 + col] = f2bf(AV(acc)); } ACC_END
    }
}

HD void ph_prep(const Params& p, int l, int bid, int nb) {
    {
        const float* naq = p.in[I_NAQG] + l * 64; const float* nak = p.in[I_NAKG] + l * 64;
        const float* daq = p.in[I_DAQG] + l * 32; const float* dak = p.in[I_DAKG] + l * 32;
        const int N = R * 24;
        for (int u = bid; u < (N + 255) / 256; u += nb) {
            THREADS(t, 256) {
                int idx = u * 256 + t;
                if (idx < N) {
                    int r = idx / 24, gidx = idx % 24;
                    if (gidx < 8) {
                        int isk = gidx >> 2, hd = gidx & 3;
                        bf16* ptr = p.P + (size_t)r * PLD + (isk ? C_NAK : C_NAQ) + hd * 64;
                        const float* g = isk ? nak : naq;
                        float ss = 0.f;
                        for (int d = 0; d < 64; ++d) { float v = bf2f(ptr[d]); ss += v * v; }
                        float rs = 1.0f / sqrtf(ss / 64.0f + 1e-6f);
                        for (int d = 0; d < 64; ++d) ptr[d] = f2bf(bf2f(ptr[d]) * rs * g[d]);
                    } else {
                        int gi = gidx - 8; int isk = gi >> 3; int hm = gi & 7;
                        bf16* ptr = p.P + (size_t)r * PLD + (isk ? C_DAK : C_DAQ) + hm * 32;
                        const float* g = isk ? dak : daq;
                        float ss = 0.f;
                        for (int d = 0; d < 32; ++d) { float v = bf2f(ptr[d]); ss += v * v; }
                        float rs = 1.0f / sqrtf(ss / 32.0f + 1e-6f);
                        if (r < NLAT) {
                            int tt = r % SEQ; float prow = (float)(tt / GW), pcol = (float)(tt % GW);
                            for (int a = 0; a < 2; ++a) {
                                float pos = a == 0 ? prow : pcol;
                                float fr = 1.0f;
                                for (int f = 0; f < 8; ++f) {
                                    float ang = pos * fr;
                                    float cs = cosf(ang), sn = sinf(ang);
                                    int i1 = a * 16 + f, i2 = a * 16 + 8 + f;
                                    float x1 = bf2f(ptr[i1]) * rs * g[i1], x2 = bf2f(ptr[i2]) * rs * g[i2];
                                    ptr[i1] = f2bf(x1 * cs - x2 * sn);
                                    ptr[i2] = f2bf(x2 * cs + x1 * sn);
                                    fr *= 0.31622776601683794f;
                                }
                            }
                        } else {
                            for (int d = 0; d < 32; ++d) ptr[d] = f2bf(bf2f(ptr[d]) * rs * g[d]);
                        }
                    }
                }
            }
        }
    }
    {
        const float* cw = p.in[I_CONVW] + (size_t)l * 5 * 768;
        const int N = R * 12;
        for (int u = bid; u < (N + 255) / 256; u += nb) {
            THREADS(t, 256) {
                int idx = u * 256 + t;
                if (idx < N) {
                    int r = idx / 12, ph = idx % 12; int part = ph >> 2, hd = ph & 3;
                    RowInfo ri = rowinfo(r);
                    int ch0 = part * 256 + hd * 64;
                    float ss = 0.f;
                    for (int pass = 0; pass < 2; ++pass) {
                        float scl = 1.0f;
                        if (pass == 1) { if (part == 0) scl = 0.125f / sqrtf(ss + 1e-6f); else if (part == 1) scl = 1.0f / sqrtf(ss + 1e-6f); }
                        if (pass == 0 && part == 2) continue;
                        for (int c = 0; c < 64; ++c) {
                            float y = 0.f;
                            for (int i = 0; i < 5; ++i) {
                                int tt = ri.t + i - 2;
                                if (tt >= 0 && tt < ri.T) y += bf2f(p.P[(size_t)(ri.base + tt) * PLD + C_GQ + ch0 + c]) * cw[i * 768 + ch0 + c];
                            }
                            y = siluf_(y);
                            if (pass == 0) ss += y * y; else p.gq[(size_t)r * 768 + ch0 + c] = f2bf(y * scl);
                        }
                    }
                }
            }
        }
    }
    {
        const int RQ = (l == 0) ? R : NLAT;
        for (int r = bid; r < RQ; r += nb) {
            THREADS(t, 256) {
                int g = t >> 6, m = t & 63;
                const bf16* f = p.P + (size_t)r * PLD + C_F + g * 64;
                float fc = 0.f, fs = 0.f;
                for (int c = 0; c < 64; ++c) {
                    int ti = ((m * c) & 63) * (SEQ / 64);
                    float v = bf2f(f[c]);
                    fc += v * p.cosT[ti]; fs += v * p.sinT[ti];
                }
                p.fcs[(size_t)r * 512 + t] = f2bf(fc);
                p.fcs[(size_t)r * 512 + 256 + t] = f2bf(fs);
            }
        }
    }
}

HD void ph_na(const Params& p, int l, int bid, int nb) {
    const float* rpb = p.in[I_RPB] + (size_t)l * 4 * 15 * 31;
    const int RQ = (l == 0) ? R : NLAT;
    const int N = RQ * 4;
    const int wh = ROWS < 8 ? ROWS : 8;
    for (int u = bid; u < (N + 255) / 256; u += nb) {
        THREADS(t, 256) {
            int idx = u * 256 + t;
            if (idx < N) {
                int hd = idx / RQ, r = idx % RQ;
                RowInfo ri = rowinfo(r);
                float q[64], o[64];
                const bf16* qp = p.P + (size_t)r * PLD + C_NAQ + hd * 64;
#pragma unroll
                for (int d = 0; d < 64; ++d) { q[d] = bf2f(qp[d]) * 0.125f; o[d] = 0.f; }
                float mx = -1e30f, lsum = 0.f;
                int nloc = 0, rs = 0, ws = 0, gr = 0, gc = 0;
                if (ri.seg == 0) {
                    gr = ri.t / GW; gc = ri.t % GW;
                    rs = gr - wh / 2; if (rs < 0) rs = 0; if (rs > ROWS - wh) rs = ROWS - wh;
                    ws = gc - 8; if (ws < 0) ws = 0; if (ws > GW - 16) ws = GW - 16;
                    nloc = wh * 16;
                }
                int ctxbase = NLAT + ri.b * CTXL;
                for (int kk = 0; kk < nloc + CTXL; ++kk) {
                    int kr; float bias = 0.f;
                    if (kk < nloc) {
                        int a = kk >> 4, c = kk & 15;
                        int krow = rs + a, kcol = ws + c;
                        kr = ri.base + krow * GW + kcol;
                        bias = rpb[(hd * 15 + (krow - gr + 7)) * 31 + (kcol - gc + 15)];
                    } else kr = ctxbase + (kk - nloc);
                    const bf16* kp = p.P + (size_t)kr * PLD + C_NAK + hd * 64;
                    float s = 0.f;
#pragma unroll
                    for (int d = 0; d < 64; ++d) s += q[d] * bf2f(kp[d]);
                    s += bias;
                    if (s > mx) { float f = expf(mx - s); lsum *= f;
#pragma unroll
                        for (int d = 0; d < 64; ++d) o[d] *= f;
                        mx = s; }
                    float e = expf(s - mx);
                    lsum += e;
                    const bf16* vp = p.P + (size_t)kr * PLD + C_NAV + hd * 64;
#pragma unroll
                    for (int d = 0; d < 64; ++d) o[d] += e * bf2f(vp[d]);
                }
                float inv = 1.0f / lsum;
                bf16* op = p.br + (size_t)r * D + hd * 64;
#pragma unroll
                for (int d = 0; d < 64; ++d) op[d] = f2bf(o[d] * inv);
            }
        }
    }
}

HD void ph_da(const Params& p, int l, int bid, int nb) {
    const int RQ = (l == 0) ? R : NLAT;
    const int N = RQ * 4;
    const float lam_init = lam_init_of(l);
    float s1 = 0.f, s2 = 0.f;
    for (int d = 0; d < 32; ++d) {
        s1 += p.in[I_LQ1][l * 32 + d] * p.in[I_LK1][l * 32 + d];
        s2 += p.in[I_LQ2][l * 32 + d] * p.in[I_LK2][l * 32 + d];
    }
    const float lam = expf(s1) - expf(s2) + lam_init;
    const float* sg = p.in[I_SUBLN] + l * 64;
    const float scale = 0.17677669529663687f;
    for (int u = bid; u < (N + 255) / 256; u += nb) {
        THREADS(t, 256) {
            int idx = u * 256 + t;
            if (idx < N) {
                int hd = idx / RQ, r = idx % RQ;
                RowInfo ri = rowinfo(r);
                float q0[32], q1[32], o0[64], o1[64];
                const bf16* qp = p.P + (size_t)r * PLD + C_DAQ + hd * 64;
#pragma unroll
                for (int d = 0; d < 32; ++d) { q0[d] = bf2f(qp[d]) * scale; q1[d] = bf2f(qp[32 + d]) * scale; }
#pragma unroll
                for (int d = 0; d < 64; ++d) { o0[d] = 0.f; o1[d] = 0.f; }
                float m0 = -1e30f, m1 = -1e30f, l0 = 0.f, l1 = 0.f;
                int nlat = (ri.seg == 0) ? SEQ : 0;
                int latbase = ri.b * SEQ, ctxbase = NLAT + ri.b * CTXL;
                for (int kk = 0; kk < nlat + CTXL; ++kk) {
                    int kr = (kk < nlat) ? latbase + kk : ctxbase + (kk - nlat);
                    const bf16* kp = p.P + (size_t)kr * PLD + C_DAK + hd * 64;
                    const bf16* vp = p.P + (size_t)kr * PLD + C_DAV + hd * 64;
                    float sa = 0.f, sb = 0.f;
#pragma unroll
                    for (int d = 0; d < 32; ++d) { sa += q0[d] * bf2f(kp[d]); sb += q1[d] * bf2f(kp[32 + d]); }
                    if (sa > m0) { float f = expf(m0 - sa); l0 *= f;
#pragma unroll
                        for (int d = 0; d < 64; ++d) o0[d] *= f;
                        m0 = sa; }
                    if (sb > m1) { float f = expf(m1 - sb); l1 *= f;
#pragma unroll
                        for (int d = 0; d < 64; ++d) o1[d] *= f;
                        m1 = sb; }
                    float ea = expf(sa - m0), eb = expf(sb - m1);
                    l0 += ea; l1 += eb;
#pragma unroll
                    for (int d = 0; d < 64; ++d) { float v = bf2f(vp[d]); o0[d] += ea * v; o1[d] += eb * v; }
                }
                float i0 = 1.0f / l0, i1 = lam / l1;
                float ss = 0.f;
#pragma unroll
                for (int d = 0; d < 64; ++d) { o0[d] = o0[d] * i0 - o1[d] * i1; ss += o0[d] * o0[d]; }
                float rs = (1.0f - lam_init) / sqrtf(ss / 64.0f + 1e-6f);
                bf16* op = p.br + (size_t)r * D + 256 + hd * 64;
#pragma unroll
                for (int d = 0; d < 64; ++d) op[d] = f2bf(o0[d] * rs * sg[d]);
            }
        }
    }
}

struct ChunkInfo { int dir, b, hd, n, seg, T, base, nloc; };
HD ChunkInfo chunkinfo(int unit) {
    ChunkInfo c;
    c.n = unit % NCH; int ch = unit / NCH; c.hd = ch & 3; c.b = (ch >> 2) % NB; c.dir = ch / (4 * NB);
    if (c.n < NCC) { c.seg = 1; c.T = CTXL; c.base = NLAT + c.b * CTXL; c.nloc = c.n; }
    else { c.seg = 0; c.T = SEQ; c.base = c.b * SEQ; c.nloc = c.n - NCC; }
    return c;
}
HD int chunk_row(const ChunkInfo& c, int i) { int pf = c.nloc * 64 + i; return c.base + (c.dir ? (c.T - 1 - pf) : pf); }

HD void ph_gdn_chunk(const Params& p, int l, int bid, int nb, float* sm) {
    float* sk = sm;
    float* sq = sm + 4096;
    float* sA = sm + 8192;
    float* sXu = sm + 12288;
    float* sXw = sm + 4096;
    float* sG = sm + 16384;
    float* sB = sm + 16448;
    for (int unit = bid; unit < NUNIT; unit += nb) {
        ChunkInfo c = chunkinfo(unit);
        int dh = c.dir * 4 + c.hd;
        THREADS(t, 4096) {
            int i = t >> 6, d = t & 63; int row = chunk_row(c, i);
            sq[t] = bf2f(p.gq[(size_t)row * 768 + c.hd * 64 + d]);
            sk[t] = bf2f(p.gq[(size_t)row * 768 + 256 + c.hd * 64 + d]);
        }
        THREADS(t, 1) {
            float acc = 0.f;
            for (int i = 0; i < 64; ++i) { int row = chunk_row(c, i); acc += p.gg[(size_t)dh * R + row]; sG[i] = acc; sB[i] = p.gbeta[(size_t)dh * R + row]; }
        }
        SYNC
        THREADS(t, 4096) {
            int i = t >> 6, j = t & 63;
            float kk = 0.f, qk = 0.f;
            for (int d = 0; d < 64; ++d) { kk += sk[i * 64 + d] * sk[j * 64 + d]; qk += sq[i * 64 + d] * sk[j * 64 + d]; }
            float dec = (j <= i) ? expf(sG[i] - sG[j]) : 0.f;
            sA[t] = (j < i) ? kk * sB[i] * dec : 0.f;
            p.cQK[(size_t)unit * 4096 + t] = f2bf(qk * dec);
        }
        SYNC
        THREADS(t, 4096) {
            int i = t >> 6, cc = t & 63; int row = chunk_row(c, i);
            sXu[t] = sB[i] * bf2f(p.gq[(size_t)row * 768 + 512 + c.hd * 64 + cc]);
            sXw[t] = sB[i] * expf(sG[i]) * sk[t];
        }
        SYNC
        for (int i = 1; i < 64; ++i) {
            THREADS(cc, 128) {
                float* X = (cc < 64) ? (sXu + cc) : (sXw + cc - 64);
                float acc = X[i * 64];
                for (int j = 0; j < i; ++j) acc -= sA[i * 64 + j] * X[j * 64];
                X[i * 64] = acc;
            }
            SYNC
        }
        THREADS(t, 4096) {
            p.cU[(size_t)unit * 4096 + t] = f2bf(sXu[t]);
            p.cW[(size_t)unit * 4096 + t] = f2bf(sXw[t]);
        }
        THREADS(t, 64) { p.cG[(size_t)unit * 64 + t] = sG[t]; }
        SYNC
    }
}

HD void ph_fourier2(const Params& p, int l, int bid, int nb) {
    const int RQ = (l == 0) ? R : NLAT;
    for (int r = bid; r < RQ; r += nb) {
        RowInfo ri = rowinfo(r);
        const float nrm = 1.0f / sqrtf((float)ri.T * 64.0f);
        const int mul = SEQ / ri.T;
        THREADS(ch, 256) {
            float acc = 0.f;
            for (int tt = 0; tt < ri.T; ++tt) {
                int ti = ((ri.t * tt) & (ri.T - 1)) * mul;
                const bf16* f = p.fcs + (size_t)(ri.base + tt) * 512;
                acc += p.cosT[ti] * bf2f(f[ch]) - p.sinT[ti] * bf2f(f[256 + ch]);
            }
            p.br[(size_t)r * D + 768 + ch] = f2bf(acc * nrm);
        }
    }
}

HD void ph_gdn_scan(const Params& p, int l, int bid, int nb, float* sm) {
    float* sQ = sm;
    float* sK = sm + 4096;
    bf16* sW = (bf16*)(sm + 8192);
    bf16* sQK = (bf16*)(sm + 10240);
    float* sS = sm + 12288;
    float* sV = sm + 13312;
    float* sU = sm + 14336;
    float* sG = sm + 15360;
    const int RQ = (l == 0) ? R : NLAT;
    for (int cu = bid; cu < 2 * NB * 4 * 4; cu += nb) {
        int chain = cu >> 2, cb = cu & 3;
        THREADS(t, 1024) { sS[t] = 0.f; }
        SYNC
        for (int n = 0; n < NCH; ++n) {
            int unit = chain * NCH + n;
            ChunkInfo c = chunkinfo(unit);
            THREADS(t, 64) { sG[t] = p.cG[(size_t)unit * 64 + t]; }
            SYNC
            THREADS(t, 4096) {
                int i = t >> 6, d = t & 63; int row = chunk_row(c, i);
                sW[t] = p.cW[(size_t)unit * 4096 + t];
                sQK[t] = p.cQK[(size_t)unit * 4096 + t];
                sQ[t] = bf2f(p.gq[(size_t)row * 768 + c.hd * 64 + d]) * expf(sG[i]);
                sK[t] = bf2f(p.gq[(size_t)row * 768 + 256 + c.hd * 64 + d]) * expf(sG[63] - sG[i]);
            }
            THREADS(t, 1024) { int i = t >> 4, e = t & 15; sU[t] = bf2f(p.cU[(size_t)unit * 4096 + i * 64 + cb * 16 + e]); }
            SYNC
            THREADS(t, 1024) {
                int i = t >> 4, e = t & 15;
                float acc = sU[t];
                for (int d = 0; d < 64; ++d) acc -= bf2f(sW[i * 64 + d]) * sS[d * 16 + e];
                sV[t] = acc;
            }
            SYNC
            THREADS(t, 1024) {
                int i = t >> 4, e = t & 15;
                float acc = 0.f;
                for (int d = 0; d < 64; ++d) acc += sQ[i * 64 + d] * sS[d * 16 + e];
                for (int j = 0; j < 64; ++j) acc += bf2f(sQK[i * 64 + j]) * sV[j * 16 + e];
                int row = chunk_row(c, i);
                if (row < RQ) p.odir[((size_t)c.dir * R + row) * 256 + c.hd * 64 + cb * 16 + e] = acc;
            }
            SYNC
            THREADS(t, 1024) {
                int d = t >> 4, e = t & 15;
                float acc = sS[t] * expf(sG[63]);
                for (int i = 0; i < 64; ++i) acc += sK[i * 64 + d] * sV[i * 16 + e];
                sS[t] = acc;
            }
            SYNC
        }
    }
}

HD void ph_gdn_fin(const Params& p, int l, int bid, int nb) {
    const int RQ = (l == 0) ? R : NLAT;
    const float* og = p.in[I_ONORM] + l * 64;
    const int N = RQ * 4;
    for (int u = bid; u < (N + 255) / 256; u += nb) {
        THREADS(t, 256) {
            int idx = u * 256 + t;
            if (idx < N) {
                int r = idx >> 2, hd = idx & 3;
                const float* o0 = p.odir + (size_t)r * 256 + hd * 64;
                const float* o1 = p.odir + ((size_t)R + r) * 256 + hd * 64;
                float ss = 0.f;
                for (int d = 0; d < 64; ++d) { float v = o0[d] + o1[d]; ss += v * v; }
                float rs = 1.0f / sqrtf(ss / 64.0f + 1e-6f);
                for (int d = 0; d < 64; ++d) {
                    float v = (o0[d] + o1[d]) * rs * og[d];
                    float z = bf2f(p.P[(size_t)r * PLD + C_Z + hd * 64 + d]);
                    p.br[(size_t)r * D + 512 + hd * 64 + d] = f2bf(v * siluf_(z));
                }
            }
        }
    }
}

HD void ph_merge(const Params& p, int l, int bid, int nb, char* smc) {
    const int MT = ((l == 0) ? R : NLAT) / 128;
    const bf16* Wg = p.wt_in + (size_t)l * WIN_N * D + (size_t)PLD * D;
    const bf16* Wb = p.wt_br + (size_t)l * 4 * D * 256;
    for (int tile = bid; tile < MT * 16; tile += nb) {
        const int mt = tile >> 4, nt = tile & 15;
        ACC_DECL(2, accM); acc_zero(accM);
        for (int i = 0; i < 4; ++i) {
            ACC_DECL(2, accG); acc_zero(accG);
            ACC_DECL(2, accP); acc_zero(accP);
            gemm_accum<2>(accG, [&](int r) { return p.h + (size_t)(mt * 128 + r) * D; },
                          [&](int j) { return Wg + (size_t)(i * 1024 + nt * 64 + j) * D; }, D, smc);
            gemm_accum<2>(accP, [&](int r) { return p.br + (size_t)(mt * 128 + r) * D + i * 256; },
                          [&](int j) { return Wb + ((size_t)i * D + nt * 64 + j) * 256; }, 256, smc);
            ACC_FOR(2, row, col) { AV(accM) += sigmoidf_(AV(accG)) * AV(accP); } ACC_END
        }
        ACC_FOR(2, row, col) { p.mg[(size_t)(mt * 128 + row) * D + nt * 64 + col] = f2bf(AV(accM)); } ACC_END
    }
}

HD void ph_outproj(const Params& p, int l, int bid, int nb, char* smc) {
    const int MT = ((l == 0) ? R : NLAT) / 128;
    const bf16* Wt = p.wt_out + (size_t)l * D * D;
    for (int tile = bid; tile < MT * 8; tile += nb) {
        const int mt = tile >> 3, nt = tile & 7;
        ACC_DECL(4, acc); acc_zero(acc);
        gemm_accum<4>(acc, [&](int r) { return p.mg + (size_t)(mt * 128 + r) * D; }, [&](int j) { return Wt + (size_t)(nt * 128 + j) * D; }, D, smc);
        ACC_FOR(4, row, col) {
            const int r = mt * 128 + row, c = nt * 128 + col;
            xrow_out(p, r)[c] = xrow_in(p, l, r)[c] + modrow(p, l, r)[2048 + c] * AV(acc);
        } ACC_END
    }
}

HD void ph_router(const Params& p, int l, int bid, int nb, float* sm) {
    const int RQ = (l == 0) ? R : NLAT;
    const float* g = p.in[I_N2G] + l * D;
    const float* wr = p.in[I_WROUTER];
    float* sh = sm + 512;
    float* sl = sm + 2048;
    for (int r = bid; r < RQ; r += nb) {
        const float* x = xrow_out(p, r);
        const float* m = modrow(p, l, r);
        THREADS(t, 256) { float s = 0.f; for (int k = t; k < D; k += 256) s += x[k] * x[k]; sm[t] = s; }
        SYNC
        THREADS(t, 1) { float s = 0.f; for (int i = 0; i < 256; ++i) s += sm[i]; sm[256] = s; }
        SYNC
        THREADS(t, 256) {
            float rs = 1.0f / sqrtf(sm[256] / D + 1e-6f);
            for (int k = t; k < D; k += 256) {
                float v = x[k] * rs * g[k];
                v = v * (1.0f + m[4096 + k]) + m[3072 + k];
                sh[k] = v;
                p.h[(size_t)r * D + k] = f2bf(v);
            }
        }
        SYNC
        THREADS(t, 256) {
            int e = t & 15, ks = t >> 4;
            float acc = 0.f;
            for (int k = ks * 64; k < ks * 64 + 64; ++k) acc += sh[k] * wr[k * 16 + e];
            sl[ks * 16 + e] = acc;
        }
        SYNC
        THREADS(t, 1) {
            float* sc = sm + 2304; float* sel = sm + 2320;
            for (int e = 0; e < 16; ++e) {
                float acc = 0.f;
                for (int ks = 0; ks < 16; ++ks) acc += sl[ks * 16 + e];
                sc[e] = sigmoidf_(acc); sel[e] = sc[e] + p.in[I_RBIAS][e];
            }
            int best = 0; float bestv = -1e30f;
            for (int gph = 0; gph < 4; ++gph) {
                float t1 = -1e30f, t2 = -1e30f;
                for (int j = 0; j < 4; ++j) { float v = sel[gph * 4 + j]; if (v > t1) { t2 = t1; t1 = v; } else if (v > t2) t2 = v; }
                float gs = t1 + t2;
                if (gs > bestv) { bestv = gs; best = gph; }
            }
            int i1 = -1, i2 = -1; float v1 = -1e30f, v2 = -1e30f;
            for (int j = 0; j < 4; ++j) {
                float v = sel[best * 4 + j];
                if (v > v1) { v2 = v1; i2 = i1; v1 = v; i1 = best * 4 + j; } else if (v > v2) { v2 = v; i2 = best * 4 + j; }
            }
            float w1 = sc[i1], w2 = sc[i2], ws = w1 + w2;
            p.sel_e[r * 2] = i1; p.sel_e[r * 2 + 1] = i2;
            p.sel_w[r * 2] = w1 / ws; p.sel_w[r * 2 + 1] = w2 / ws;
            int q1 = ATOMIC_ADD_RET(&p.cnt[l * 16 + i1], 1); p.elist[(size_t)i1 * 2 * R + q1] = r * 2; p.apos[r * 2] = q1;
            int q2 = ATOMIC_ADD_RET(&p.cnt[l * 16 + i2], 1); p.elist[(size_t)i2 * 2 * R + q2] = r * 2 + 1; p.apos[r * 2 + 1] = q2;
        }
        SYNC
    }
}

struct MoeTiles { int tstart[17]; };
HD MoeTiles moe_tiles(const Params& p, int l) {
    MoeTiles m; int acc = 0;
    for (int e = 0; e < 16; ++e) { m.tstart[e] = acc; acc += (p.cnt[l * 16 + e] + 127) >> 7; }
    m.tstart[16] = acc; return m;
}

HD void ph_ffn1(const Params& p, int l, int bid, int nb, char* smc) {
    int tstart[17];
    { int acc = 0; for (int e = 0; e < 16; ++e) { tstart[e] = acc; acc += (p.cnt[l * 16 + e] + 127) >> 7; } tstart[16] = acc; }
    const int ntiles = tstart[16];
    for (int tile = bid; tile < ntiles * 8; tile += nb) {
        const int rt = tile >> 3, nt = tile & 7;
        int e = 0, ts = 0;
#pragma unroll
        for (int q = 1; q < 16; ++q) if (rt >= tstart[q]) { e = q; ts = tstart[q]; }
        const int mt = rt - ts;
        const int cnt_e = p.cnt[l * 16 + e];
        const int* el = p.elist + (size_t)e * 2 * R;
        const bf16* Wt = p.wt_gu + (size_t)e * 1024 * D;
        ACC_DECL(4, acc); acc_zero(acc);
        gemm_accum<4>(acc, [&](int i) { int q = mt * 128 + i; int a = (q < cnt_e) ? el[q] : el[0]; return p.h + (size_t)(a >> 1) * D; },
                      [&](int j) { return Wt + (size_t)(nt * 128 + j) * D; }, D, smc);
        ACC_FOR_PAIR(row, pcol) {
            float gv = AV_G(acc), uv = AV_U(acc);
            p.act[(size_t)(rt * 128 + row) * 512 + nt * 64 + pcol] = f2bf(siluf_(gv) * uv);
        } ACC_END
    }
}

HD void ph_ffn2(const Params& p, int l, int bid, int nb, char* smc) {
    int tstart[17];
    { int acc = 0; for (int e = 0; e < 16; ++e) { tstart[e] = acc; acc += (p.cnt[l * 16 + e] + 127) >> 7; } tstart[16] = acc; }
    const int ntiles = tstart[16];
    for (int tile = bid; tile < ntiles * 8; tile += nb) {
        const int rt = tile >> 3, nt = tile & 7;
        int e = 0;
#pragma unroll
        for (int q = 1; q < 16; ++q) if (rt >= tstart[q]) e = q;
        const bf16* Wt = p.wt_d + (size_t)e * D * 512;
        ACC_DECL(4, acc); acc_zero(acc);
        gemm_accum<4>(acc, [&](int i) { return p.act + (size_t)(rt * 128 + i) * 512; }, [&](int j) { return Wt + (size_t)(nt * 128 + j) * 512; }, 512, smc);
        ACC_FOR(4, row, col) { p.Y[(size_t)(rt * 128 + row) * D + nt * 128 + col] = f2bf(AV(acc)); } ACC_END
    }
}

HD void ph_combine(const Params& p, int l, int bid, int nb) {
    const int RQ = (l == 0) ? R : NLAT;
    int tstart[17];
    { int acc = 0; for (int e = 0; e < 16; ++e) { tstart[e] = acc; acc += (p.cnt[l * 16 + e] + 127) >> 7; } tstart[16] = acc; }
    for (int r = bid; r < RQ; r += nb) {
        float* xo = xrow_out(p, r);
        const float* m = modrow(p, l, r);
        int e0 = p.sel_e[r * 2], e1 = p.sel_e[r * 2 + 1];
        int t0 = 0, t1 = 0;
#pragma unroll
        for (int q = 0; q < 16; ++q) { if (q == e0) t0 = tstart[q]; if (q == e1) t1 = tstart[q]; }
        const bf16* y0 = p.Y + (size_t)(t0 * 128 + p.apos[r * 2]) * D;
        const bf16* y1 = p.Y + (size_t)(t1 * 128 + p.apos[r * 2 + 1]) * D;
        const float w0 = p.sel_w[r * 2], w1 = p.sel_w[r * 2 + 1];
        THREADS(t, 256) {
            for (int k = t; k < D; k += 256) xo[k] += m[5120 + k] * (w0 * bf2f(y0[k]) + w1 * bf2f(y1[k]));
        }
    }
}

constexpr int NPHASE_LAYER = 14;
HD void run_phase(const Params& p, int ph, int l, int bid, int nb, float* sm) {
    switch (ph) {
        case 0: ph_norm1(p, l, bid, nb, sm); break;
        case 1: ph_inproj(p, l, bid, nb, (char*)sm); break;
        case 2: ph_prep(p, l, bid, nb); break;
        case 3: ph_na(p, l, bid, nb); break;
        case 4: ph_da(p, l, bid, nb); break;
        case 5: ph_gdn_chunk(p, l, bid, nb, sm); break;
        case 6: ph_fourier2(p, l, bid, nb); break;
        case 7: ph_gdn_scan(p, l, bid, nb, sm); if (l == 1) convert_moe(p, 1, bid, nb, sm); break;
        case 8: ph_gdn_fin(p, l, bid, nb); break;
        case 9: ph_merge(p, l, bid, nb, (char*)sm); break;
        case 10: ph_outproj(p, l, bid, nb, (char*)sm); break;
        case 11: ph_router(p, l, bid, nb, sm); break;
        case 12: ph_ffn1(p, l, bid, nb, (char*)sm); break;
        case 13: ph_ffn2(p, l, bid, nb, (char*)sm); break;
        case 14: ph_combine(p, l, bid, nb); break;
        default: break;
    }
}

struct WsLayout { size_t mods, cosT, sinT, cs, gg, gbeta, sel_e, sel_w, cnt, elist, apos, cG, wt_in, wt_br, wt_out, wt_gu, wt_d,
                  h, P, gq, fcs, cU, cW, cQK, odir, br, mg, act, Y, total; };
inline WsLayout ws_layout() {
    WsLayout w; size_t o = 0;
    auto take = [&](size_t bytes) { size_t r = o; o += (bytes + 255) & ~(size_t)255; return r; };
    w.mods = take(2 * 3 * 6144 * 4); w.cosT = take(SEQ * 4); w.sinT = take(SEQ * 4); w.cs = take((size_t)NCTX * D * 4);
    w.gg = take((size_t)8 * R * 4); w.gbeta = take((size_t)8 * R * 4); w.sel_e = take((size_t)R * 2 * 4); w.sel_w = take((size_t)R * 2 * 4);
    w.cnt = take(32 * 4); w.elist = take((size_t)16 * 2 * R * 4); w.apos = take((size_t)2 * R * 4); w.cG = take((size_t)NUNIT * 64 * 4);
    w.wt_in = take((size_t)2 * WIN_N * D * 2); w.wt_br = take((size_t)2 * 4 * D * 256 * 2); w.wt_out = take((size_t)2 * D * D * 2);
    w.wt_gu = take((size_t)16 * 1024 * D * 2); w.wt_d = take((size_t)16 * D * 512 * 2);
    w.h = take((size_t)R * D * 2);
    {
        const size_t szP = ((size_t)R * PLD * 2 + 255) & ~(size_t)255, szQ = ((size_t)R * 768 * 2 + 255) & ~(size_t)255;
        const size_t szA = ((size_t)PADROWS * 512 * 2 + 255) & ~(size_t)255, szY = ((size_t)PADROWS * 1024 * 2 + 255) & ~(size_t)255;
        const size_t base = take((szP + szQ) > (szA + szY) ? (szP + szQ) : (szA + szY));
        w.P = base; w.gq = base + szP; w.act = base; w.Y = base + szA;
    }
    w.fcs = take((size_t)R * 512 * 2);
    w.cU = take((size_t)NUNIT * 4096 * 2); w.cW = take((size_t)NUNIT * 4096 * 2); w.cQK = take((size_t)NUNIT * 4096 * 2);
    w.odir = take((size_t)2 * R * 256 * 4); w.br = take((size_t)R * D * 2);
    w.mg = w.cU;
    w.total = o;
    return w;
}
inline void fill_params(Params& p, void* const* d_in, void* d_out, void* d_ws) {
    WsLayout w = ws_layout(); char* b = (char*)d_ws;
    for (int i = 0; i < 30; ++i) p.in[i] = (const float*)d_in[i];
    p.out = (float*)d_out;
    p.mods = (float*)(b + w.mods); p.cosT = (float*)(b + w.cosT); p.sinT = (float*)(b + w.sinT); p.cs = (float*)(b + w.cs);
    p.h = (bf16*)(b + w.h); p.P = (bf16*)(b + w.P); p.gq = (bf16*)(b + w.gq); p.gg = (float*)(b + w.gg); p.gbeta = (float*)(b + w.gbeta);
    p.fcs = (bf16*)(b + w.fcs); p.cU = (bf16*)(b + w.cU); p.cW = (bf16*)(b + w.cW); p.cQK = (bf16*)(b + w.cQK); p.cG = (float*)(b + w.cG);
    p.odir = (float*)(b + w.odir); p.br = (bf16*)(b + w.br); p.mg = (bf16*)(b + w.mg); p.sel_e = (int*)(b + w.sel_e);
    p.sel_w = (float*)(b + w.sel_w); p.act = (bf16*)(b + w.act); p.Y = (bf16*)(b + w.Y);
    p.wt_in = (bf16*)(b + w.wt_in); p.wt_br = (bf16*)(b + w.wt_br); p.wt_out = (bf16*)(b + w.wt_out); p.wt_gu = (bf16*)(b + w.wt_gu);
    p.wt_d = (bf16*)(b + w.wt_d); p.cnt = (int*)(b + w.cnt); p.elist = (int*)(b + w.elist); p.apos = (int*)(b + w.apos);
}

#if !defined(CPU_EMU) && defined(PHASE_KERNELS)
#define PK(n) __global__ void __launch_bounds__(256, 2) pk_##n(Params p) { __shared__ __attribute__((aligned(16))) float sm[SMEM_FLOATS]; run_phase(p, n, p.layer, blockIdx.x, gridDim.x, sm); }
PK(0) PK(1) PK(2) PK(3) PK(4) PK(5) PK(6) PK(7) PK(8) PK(9) PK(10) PK(11) PK(12) PK(13) PK(14)
__global__ void __launch_bounds__(256, 2) pk_init(Params p) { __shared__ __attribute__((aligned(16))) float sm[SMEM_FLOATS]; ph_init(p, blockIdx.x, gridDim.x, sm); }
#endif
#ifndef CPU_EMU
__global__ void __launch_bounds__(256, 2) fwd_megakernel(Params p) {
    __shared__ __attribute__((aligned(16))) float sm[SMEM_FLOATS];
    cg::grid_group grid = cg::this_grid();
    const int bid = blockIdx.x, nb = gridDim.x;
    ph_init(p, bid, nb, sm);
    grid.sync();
#define PH(n, l) run_phase(p, n, l, bid, nb, sm); grid.sync();
#define LAYER(l) PH(0, l) PH(1, l) PH(2, l) PH(3, l) PH(4, l) PH(5, l) PH(6, l) PH(7, l) PH(8, l) PH(9, l) PH(10, l) PH(11, l) PH(12, l) PH(13, l) PH(14, l)
    LAYER(0)
    LAYER(1)
}

extern "C" void kernel_launch(void* const* d_in, const int* in_sizes, int n_in, void* d_out, int out_size,
                              void* d_ws, size_t ws_size, hipStream_t stream) {
    WsLayout w = ws_layout();
    if (ws_size < w.total) { fprintf(stderr, "ws too small: need %zu have %zu\n", w.total, ws_size); return; }
    static int grid_blocks = 0;
    if (!grid_blocks) {
        int dev = 0, cus = 0, per_cu = 0;
        (void)hipGetDevice(&dev);
        (void)hipDeviceGetAttribute(&cus, hipDeviceAttributeMultiprocessorCount, dev);
        (void)hipOccupancyMaxActiveBlocksPerMultiprocessor(&per_cu, fwd_megakernel, 256, 0);
        if (per_cu < 1) per_cu = 1;
        grid_blocks = cus * per_cu;
    }
    Params p{};
    fill_params(p, d_in, d_out, d_ws);
    void* args[] = {&p};
    hipError_t e = hipLaunchCooperativeKernel((void*)fwd_megakernel, dim3(grid_blocks), dim3(256), args, 0, stream);
    if (e != hipSuccess) fprintf(stderr, "cooperative launch failed: %s (grid %d)\n", hipGetErrorString(e), grid_blocks);
}
#endif
```

```cpp
#ifndef CPU_EMU
#include <hip/hip_runtime.h>
#include <hip/hip_cooperative_groups.h>
#include <cstdio>
namespace cg = cooperative_groups;
#define HD __device__ __forceinline__
__device__ __forceinline__ int tid_() { int v = threadIdx.x; asm volatile("" : "+v"(v)); return v; }
#define THREADS(t, n) for (int t = tid_(); t < (n); t += 256)
#define SYNC __syncthreads();
#define COSPI(x) cospif(x)
#define SINPI(x) sinpif(x)
typedef float4 f4;
#else
#include <cmath>
#include <cstdio>
#include <cstring>
#include <cstddef>
#define HD inline
#define THREADS(t, n) for (int t = 0; t < (n); ++t)
#define SYNC
#define COSPI(x) ((float)cos(M_PI * (double)(x)))
#define SINPI(x) ((float)sin(M_PI * (double)(x)))
struct f4 { float x, y, z, w; };
#endif

#ifndef SEQ
#define SEQ 8192
#endif
#ifndef CTXL
#define CTXL 256
#endif

typedef unsigned short bf16;
#ifndef CPU_EMU
typedef __attribute__((ext_vector_type(8))) short bf16x8_t;
typedef __attribute__((ext_vector_type(4))) float f32x4_t;
typedef __attribute__((ext_vector_type(4))) int i32x4_t;
#define ATOMIC_ADD_RET(ptr, v) atomicAdd((ptr), (v))
#else
HD int atomic_add_ret_(int* p, int v) { int old;
#pragma omp atomic capture
    { old = *p; *p += v; }
    return old; }
#define ATOMIC_ADD_RET(ptr, v) atomic_add_ret_((ptr), (v))
#endif
constexpr int NB = 2, D = 1024, GW = 64, ROWS = SEQ / GW;
constexpr int NLAT = NB * SEQ, NCTX = NB * CTXL, R = NLAT + NCTX;
constexpr int DIN = 6928;
constexpr int PLD = 2816;
constexpr int C_NAQ = 0, C_NAK = 256, C_NAV = 512, C_DAQ = 768, C_DAK = 1024, C_DAV = 1280, C_GQ = 1536, C_Z = 2304,
              C_F = 2560;
constexpr int WIN_N = 6912;
constexpr int PADROWS = 2 * R + 16 * 128;
constexpr int NCC = CTXL / 64, NCL = SEQ / 64, NCH = NCC + NCL;
constexpr int NUNIT = 2 * NB * 4 * NCH;
constexpr bool FOURIER_GEMM = (SEQ == 8192);
constexpr int SMEM_FLOATS = 73 * 256 + 4;

struct Params {
    const float* in[30];
    float* out;
    float* mods;
    float* cosT;
    float* sinT;
    float* cs;
    bf16* h;
    bf16* P;
    bf16* gq;
    float* gg;
    float* gbeta;
    bf16* fcs;
    bf16* cU;
    bf16* cW;
    bf16* cQK;
    float* cG;
    bf16* odir;
    bf16* br;
    bf16* mg;
    int* sel_e;
    float* sel_w;
    bf16* act;
    bf16* Y;
    bf16* wt_in;
    bf16* wt_br;
    bf16* wt_out;
    bf16* wt_gu;
    bf16* wt_d;
    int* cnt;
    unsigned* bar;
    bf16* fa2;
    bf16* fW1;
    bf16* fWA;
    bf16* fWB;
    int* elist;
    int* apos;
    int phase;
    int layer;
};

enum { I_X = 0, I_C, I_CTX, I_CCTX, I_WMOD, I_BMOD, I_N1G, I_N2G, I_WIN, I_NAQG, I_NAKG, I_RPB, I_DAQG, I_DAKG, I_LQ1, I_LK1,
       I_LQ2, I_LK2, I_SUBLN, I_CONVW, I_ALOG, I_DTB, I_ONORM, I_WBR, I_WOUT, I_WROUTER, I_RBIAS, I_MG, I_MU, I_MD };

HD float bf2f(bf16 v) { union { unsigned u; float f; } x; x.u = ((unsigned)v) << 16; return x.f; }
#ifndef CPU_EMU
typedef float f32x2_t __attribute__((ext_vector_type(2))); typedef __bf16 bf16x2_t __attribute__((ext_vector_type(2)));
typedef short s16x4_t __attribute__((ext_vector_type(4)));
typedef __attribute__((address_space(3))) const char* lds_cptr;
HD unsigned cvtpk(float lo, float hi) { f32x2_t v = {lo, hi}; bf16x2_t b = __builtin_convertvector(v, bf16x2_t); return __builtin_bit_cast(unsigned, b); }
HD bf16 f2bf(float f) { return (bf16)(cvtpk(f, 0.f) & 0xffffu); }
HD s16x4_t lds_tr16(lds_cptr p) { return __builtin_bit_cast(s16x4_t, __builtin_amdgcn_ds_read_tr16_b64_v4i16((__attribute__((address_space(3))) s16x4_t*)p)); }
#else
HD bf16 f2bf(float f) { union { unsigned u; float f; } x; x.f = f; unsigned u = x.u; u += 0x7fffu + ((u >> 16) & 1u); return (bf16)(u >> 16); }
#endif
HD float sigmoidf_(float x) { return 1.0f / (1.0f + expf(-x)); }
HD float siluf_(float x) { return x / (1.0f + expf(-x)); }

struct RowInfo { int seg, b, t, T, base; };
HD RowInfo rowinfo(int r) {
    RowInfo q;
    if (r < NLAT) { q.seg = 0; q.b = r / SEQ; q.t = r % SEQ; q.T = SEQ; q.base = q.b * SEQ; }
    else { int r2 = r - NLAT; q.seg = 1; q.b = r2 / CTXL; q.t = r2 % CTXL; q.T = CTXL; q.base = NLAT + q.b * CTXL; }
    return q;
}
HD const float* xrow_in(const Params& p, int l, int r) {
    if (r < NLAT) return (l == 0 ? p.in[I_X] : p.out) + (size_t)r * D;
    return p.cs + (size_t)(r - NLAT) * D;
}
HD float* xrow_out(const Params& p, int r) {
    if (r < NLAT) return p.out + (size_t)r * D;
    return p.cs + (size_t)(r - NLAT) * D;
}
HD const float* modrow(const Params& p, int l, int r) {
    int s = (r < NLAT) ? (r / SEQ) : 2;
    return p.mods + (size_t)(l * 3 + s) * 6144;
}
HD float lam_init_of(int l) { return l == 0 ? 0.2f : (0.8f - 0.6f * 0.7408182206817179f); }


#ifndef CPU_EMU
template <int NJ> struct AccT { f32x4_t v[4][NJ]; };
#define ACC_DECL(NJ, a) AccT<NJ> a
template <int NJ> HD void acc_zero(AccT<NJ>& a) {
#pragma unroll
    for (int i = 0; i < 4; ++i)
#pragma unroll
        for (int j = 0; j < NJ; ++j) a.v[i][j] = f32x4_t{0.f, 0.f, 0.f, 0.f};
}
#define ACC_FOR(NJ, row, col) { const int _t = tid_(); const int _ln = _t & 63, _w = _t >> 6; \
    _Pragma("unroll") for (int _i = 0; _i < 4; ++_i) _Pragma("unroll") for (int _j = 0; _j < NJ; ++_j) _Pragma("unroll") for (int _r = 0; _r < 4; ++_r) { \
    const int row = (_w >> 1) * 64 + _i * 16 + (_ln >> 4) * 4 + _r; const int col = (_w & 1) * (16 * NJ) + _j * 16 + (_ln & 15);
#define AV(a) a.v[_i][_j][_r]
#define ACC_END }}
#define ACC_FOR_PAIR(row, pcol) { const int _t = tid_(); const int _ln = _t & 63, _w = _t >> 6; \
    _Pragma("unroll") for (int _i = 0; _i < 4; ++_i) _Pragma("unroll") for (int _jj = 0; _jj < 2; ++_jj) _Pragma("unroll") for (int _r = 0; _r < 4; ++_r) { \
    const int row = (_w >> 1) * 64 + _i * 16 + (_ln >> 4) * 4 + _r; const int pcol = (_w & 1) * 32 + _jj * 16 + (_ln & 15);
#define AV_G(a) a.v[_i][2 * _jj][_r]
#define AV_U(a) a.v[_i][2 * _jj + 1][_r]

#define WAIT_VM0() asm volatile("s_waitcnt vmcnt(0)" ::: "memory")
#define GLDS16(gp, lp) __builtin_amdgcn_global_load_lds((const unsigned*)(gp), (unsigned*)(lp), 16, 0, 0)
template <int NJ, class AF, class BF>
HD void gemm_accum(AccT<NJ>& acc, AF arow, BF brow, int K, char* smem) {
    constexpr int NBL = NJ;
    const int t = tid_(), lane = t & 63, w = t >> 6, wr = w >> 1, wc = w & 1;
    const int lr = t >> 3, lc = t & 7;
    const bf16* ap[4]; const bf16* bp[NBL];
#pragma unroll
    for (int i = 0; i < 4; ++i) ap[i] = arow(lr + 32 * i) + ((lc ^ (lr & 7)) << 3);
#pragma unroll
    for (int i = 0; i < NBL; ++i) bp[i] = brow(lr + 32 * i) + ((lc ^ (lr & 7)) << 3);
    char* sA = smem + w * 1024; char* sB = smem + 32768 + w * 1024;
    const int fr = lane & 15, fg = lane >> 4;
    const unsigned aoff0 = (wr * 64 + fr) * 128 + (((fg) ^ (fr & 7)) << 4);
    const unsigned aoff1 = (wr * 64 + fr) * 128 + (((4 + fg) ^ (fr & 7)) << 4);
    const unsigned boff0 = (wc * (16 * NJ) + fr) * 128 + (((fg) ^ (fr & 7)) << 4);
    const unsigned boff1 = (wc * (16 * NJ) + fr) * 128 + (((4 + fg) ^ (fr & 7)) << 4);
    const int KT = K >> 6;
    __syncthreads();
#pragma unroll
    for (int i = 0; i < 4; ++i) GLDS16(ap[i], sA + 4096 * i);
#pragma unroll
    for (int i = 0; i < NBL; ++i) GLDS16(bp[i], sB + 4096 * i);
    WAIT_VM0();
    __syncthreads();
#pragma unroll 1
    for (int kt = 0; kt < KT; ++kt) {
        const int cur = kt & 1;
        if (kt + 1 < KT) {
#pragma unroll
            for (int i = 0; i < 4; ++i) GLDS16(ap[i] + (kt + 1) * 64, sA + (cur ^ 1) * 16384 + 4096 * i);
#pragma unroll
            for (int i = 0; i < NBL; ++i) GLDS16(bp[i] + (kt + 1) * 64, sB + (cur ^ 1) * 16384 + 4096 * i);
        }
        const char* cA = smem + cur * 16384; const char* cB = smem + 32768 + cur * 16384;
#pragma unroll
        for (int s = 0; s < 2; ++s) {
            bf16x8_t af[4], bfr[NJ];
#pragma unroll
            for (int i = 0; i < 4; ++i) af[i] = *(const bf16x8_t*)(cA + (s ? aoff1 : aoff0) + i * 2048);
#pragma unroll
            for (int j = 0; j < NJ; ++j) bfr[j] = *(const bf16x8_t*)(cB + (s ? boff1 : boff0) + j * 2048);
#pragma unroll
            for (int i = 0; i < 4; ++i)
#pragma unroll
                for (int j = 0; j < NJ; ++j) acc.v[i][j] = __builtin_amdgcn_mfma_f32_16x16x32_bf16(af[i], bfr[j], acc.v[i][j], 0, 0, 0);
        }
        WAIT_VM0();
        __syncthreads();
    }
}
#else
template <int NJ> struct AccT { float v[128][32 * NJ]; };
#define ACC_DECL(NJ, a) static thread_local AccT<NJ> a
template <int NJ> HD void acc_zero(AccT<NJ>& a) { memset(a.v, 0, sizeof(a.v)); }
#define ACC_FOR(NJ, row, col) { for (int row = 0; row < 128; ++row) for (int col = 0; col < 32 * NJ; ++col) {
#define AV(a) a.v[row][col]
#define ACC_END }}
#define ACC_FOR_PAIR(row, pcol) { for (int row = 0; row < 128; ++row) for (int pcol = 0; pcol < 64; ++pcol) {
#define AV_G(a) a.v[row][(pcol / 16) * 32 + (pcol % 16)]
#define AV_U(a) a.v[row][(pcol / 16) * 32 + 16 + (pcol % 16)]
template <int NJ, class AF, class BF>
HD void gemm_accum(AccT<NJ>& acc, AF arow, BF brow, int K, char* smem) {
    for (int i = 0; i < 128; ++i) { const bf16* a = arow(i);
        for (int j = 0; j < 32 * NJ; ++j) { const bf16* b = brow(j); float s = 0.f;
            for (int k = 0; k < K; ++k) s += bf2f(a[k]) * bf2f(b[k]);
            acc.v[i][j] += s; } }
}
#endif

template <class DF>
HD void conv_tile(const float* src, size_t lds_, bf16* dst, size_t ldd, int k0, int nsrc0, DF drow, float* sm) {
    THREADS(t, 4096) { int kk = t >> 6, nn = t & 63; sm[kk * 65 + nn] = src[(size_t)(k0 + kk) * lds_ + nsrc0 + nn]; }
    SYNC
    THREADS(t, 4096) { int nn = t >> 6, kk = t & 63; dst[(size_t)drow(nn) * ldd + k0 + kk] = f2bf(sm[kk * 65 + nn]); }
    SYNC
}
HD void convert_moe(const Params& p, int l, int bid, int nb, float* sm) {
    for (int w = bid; w < 4096 + 2048; w += nb) {
        if (w < 4096) {
            int nt = w & 7, kt = (w >> 3) & 15, gu = (w >> 7) & 1, e = w >> 8;
            const float* src = p.in[gu ? I_MU : I_MG] + (size_t)(l * 16 + e) * D * 512;
            bf16* dst = p.wt_gu + (size_t)e * 1024 * D;
            conv_tile(src, 512, dst, D, kt * 64, nt * 64, [&](int nn) { int j = nt * 64 + nn; return (j >> 4) * 32 + (j & 15) + 16 * gu; }, sm);
        } else {
            int w2 = w - 4096; int nt = w2 & 15, kt = (w2 >> 4) & 7, e = w2 >> 7;
            const float* src = p.in[I_MD] + (size_t)(l * 16 + e) * 512 * D;
            bf16* dst = p.wt_d + (size_t)e * D * 512;
            conv_tile(src, D, dst, 512, kt * 64, nt * 64, [&](int nn) { return nt * 64 + nn; }, sm);
        }
    }
}
HD void convert_static(const Params& p, int bid, int nb, float* sm) {
    for (int w = bid; w < 3456 + 512 + 512; w += nb) {
        if (w < 3456) {
            int nt = w % 108, kt = (w / 108) & 15, l = w / (108 * 16);
            int n0 = nt * 64;
            conv_tile(p.in[I_WIN] + (size_t)l * D * DIN, DIN, p.wt_in + (size_t)l * WIN_N * D, D, kt * 64, n0 < 2560 ? n0 : n0 + 16,
                      [&](int nn) { return n0 + nn; }, sm);
        } else if (w < 3456 + 512) {
            int w2 = w - 3456; int nt = w2 & 15, kt = (w2 >> 4) & 3, li = w2 >> 6;
            conv_tile(p.in[I_WBR] + (size_t)li * 256 * D, D, p.wt_br + (size_t)li * D * 256, 256, kt * 64, nt * 64, [&](int nn) { return nt * 64 + nn; }, sm);
        } else {
            int w2 = w - 3456 - 512; int nt = w2 & 15, kt = (w2 >> 4) & 15, l = w2 >> 8;
            conv_tile(p.in[I_WOUT] + (size_t)l * D * D, D, p.wt_out + (size_t)l * D * D, D, kt * 64, nt * 64, [&](int nn) { return nt * 64 + nn; }, sm);
        }
    }
}

HD void init_tables(const Params& p, int bid, int nb) {
    for (int u = bid; u < (SEQ + 255) / 256; u += nb) {
        THREADS(t, 256) {
            int j = u * 256 + t;
            if (j < SEQ) { float a = 2.0f * (float)j / (float)SEQ; p.cosT[j] = COSPI(a); p.sinT[j] = SINPI(a); }
        }
    }
    for (int u = bid; u < (8192 + 65536 + 8192) / 256; u += nb) {
        THREADS(t, 256) {
            int i = u * 256 + t;
            if (i < 8192) {
                int j = i >> 6, c = i & 63; int cs = j >> 6, m = j & 63;
                float a = 2.0f * (float)((m * c) & 63) / 64.0f;
                p.fW1[i] = f2bf(cs ? SINPI(a) : COSPI(a));
            } else if (i < 8192 + 65536) {
                int q = i - 8192; int n = q >> 8, k = q & 255;
                int ri = (n >> 4) & 1, k1 = (n >> 5) * 16 + (n & 15); int cs = k >> 7, t1 = k & 127;
                float a = 2.0f * (float)((k1 * t1) & 127) / 128.0f;
                float cv = COSPI(a), sv = SINPI(a);
                float v = (ri == 0) ? (cs == 0 ? cv : -sv) : (cs == 0 ? -sv : -cv);
                p.fWA[q] = f2bf(v);
            } else {
                int q = i - 8192 - 65536; int k2 = q >> 7, k = q & 127; int ri = k >> 6, t2 = k & 63;
                float a = 2.0f * (float)((k2 * t2) & 63) / 64.0f;
                p.fWB[q] = f2bf(ri ? SINPI(a) : COSPI(a));
            }
        }
    }
}

HD void ph_init(const Params& p, int bid, int nb, float* sm) {
    const int NMOD = 2 * 3 * 6144;
    if (bid == 0) { THREADS(t, 32) { p.cnt[t] = 0; } }
    convert_static(p, bid, nb, sm);
    convert_moe(p, 0, bid, nb, sm);
    for (int u = bid; u < (NMOD + 255) / 256; u += nb) {
        THREADS(t, 256) {
            int idx = u * 256 + t;
            if (idx < NMOD) {
                int l = idx / (3 * 6144), s = (idx / 6144) % 3, col = idx % 6144;
                const float* cv = (s < 2) ? p.in[I_C] + s * D : p.in[I_CCTX];
                const float* w = p.in[I_WMOD] + (size_t)l * D * 6144 + col;
                float acc = 0.f;
                for (int k = 0; k < D; ++k) acc += siluf_(cv[k]) * w[(size_t)k * 6144];
                p.mods[idx] = acc + p.in[I_BMOD][l * 6144 + col];
            }
        }
    }
    init_tables(p, bid, nb);
    for (int u = bid; u < (NCTX * D) / 256; u += nb) {
        THREADS(t, 256) { int i = u * 256 + t; p.cs[i] = p.in[I_CTX][i]; }
    }

}

HD void ph_norm1(const Params& p, int l, int bid, int nb, float* sm) {
    const float* g = p.in[I_N1G] + l * D;
    for (int r = bid; r < R; r += nb) {
        const float* x = xrow_in(p, l, r);
        const float* m = modrow(p, l, r);
        THREADS(t, 256) { float s = 0.f; for (int k = t; k < D; k += 256) s += x[k] * x[k]; sm[t] = s; }
        SYNC
        THREADS(t, 1) { float s = 0.f; for (int i = 0; i < 256; ++i) s += sm[i]; sm[256] = s; }
        SYNC
        THREADS(t, 256) {
            float rs = 1.0f / sqrtf(sm[256] / D + 1e-6f);
            for (int k = t; k < D; k += 256) {
                float v = x[k] * rs * g[k];
                float hv = v * (1.0f + m[1024 + k]) + m[k];
                sm[512 + k] = hv;
                p.h[(size_t)r * D + k] = f2bf(hv);
            }
        }
        SYNC
        THREADS(t, 256) {
            int c = t & 15, ks = t >> 4;
            const float* w = p.in[I_WIN] + (size_t)l * D * DIN + 2560 + c;
            float acc = 0.f;
            for (int k = ks * 64; k < ks * 64 + 64; ++k) acc += sm[512 + k] * w[(size_t)k * DIN];
            sm[2048 + ks * 16 + c] = acc;
        }
        SYNC
        THREADS(t, 8) {
            float a = 0.f, b = 0.f;
            for (int ks = 0; ks < 16; ++ks) { a += sm[2048 + ks * 16 + t]; b += sm[2048 + ks * 16 + 8 + t]; }
            float xx = a + p.in[I_DTB][l * 8 + t];
            float sp = xx > 20.f ? xx : log1pf(expf(xx));
            p.gg[(size_t)t * R + r] = -expf(p.in[I_ALOG][l * 8 + t]) * sp;
            p.gbeta[(size_t)t * R + r] = sigmoidf_(b);
        }
        SYNC
    }
}

HD void ph_inproj(const Params& p, int l, int bid, int nb, char* smc) {
    const bf16* Wt = p.wt_in + (size_t)l * WIN_N * D;
    constexpr int NT = PLD / 128, MT = R / 128;
    for (int tile = bid; tile < MT * NT; tile += nb) {
        const int mt = tile / NT, nt = tile % NT;
        ACC_DECL(4, acc); acc_zero(acc);
        gemm_accum<4>(acc, [&](int i) { return p.h + (size_t)(mt * 128 + i) * D; }, [&](int j) { return Wt + (size_t)(nt * 128 + j) * D; }, D, smc);
        ACC_FOR(4, row, col) { p.P[(size_t)(mt * 128 + row) * PLD + nt * 128 + col] = f2bf(AV(acc)); } ACC_END
    }
}

HD void ph_prep(const Params& p, int l, int bid, int nb) {
    {
        const float* naq = p.in[I_NAQG] + l * 64; const float* nak = p.in[I_NAKG] + l * 64;
        const float* daq = p.in[I_DAQG] + l * 32; const float* dak = p.in[I_DAKG] + l * 32;
        const int N = R * 24;
        for (int u = bid; u < (N + 255) / 256; u += nb) {
            THREADS(t, 256) {
                int idx = u * 256 + t;
                if (idx < N) {
                    int r = idx / 24, gidx = idx % 24;
                    if (gidx < 8) {
                        int isk = gidx >> 2, hd = gidx & 3;
                        bf16* ptr = p.P + (size_t)r * PLD + (isk ? C_NAK : C_NAQ) + hd * 64;
                        const float* g = isk ? nak : naq;
                        float ss = 0.f;
                        for (int d = 0; d < 64; ++d) { float v = bf2f(ptr[d]); ss += v * v; }
                        float rs = 1.0f / sqrtf(ss / 64.0f + 1e-6f);
#ifndef CPU_EMU
                        if (!isk) rs *= 0.125f * 1.4426950408889634f;
#endif
                        for (int d = 0; d < 64; ++d) ptr[d] = f2bf(bf2f(ptr[d]) * rs * g[d]);
                    } else {
                        int gi = gidx - 8; int isk = gi >> 3; int hm = gi & 7;
                        bf16* ptr = p.P + (size_t)r * PLD + (isk ? C_DAK : C_DAQ) + hm * 32;
                        const float* g = isk ? dak : daq;
                        float ss = 0.f;
                        for (int d = 0; d < 32; ++d) { float v = bf2f(ptr[d]); ss += v * v; }
                        float rs = 1.0f / sqrtf(ss / 32.0f + 1e-6f);
#ifndef CPU_EMU
                        if (!isk) rs *= 0.17677669529663687f * 1.4426950408889634f;
#endif
                        if (r < NLAT) {
                            int tt = r % SEQ; float prow = (float)(tt / GW), pcol = (float)(tt % GW);
                            for (int a = 0; a < 2; ++a) {
                                float pos = a == 0 ? prow : pcol;
                                float fr = 1.0f;
                                for (int f = 0; f < 8; ++f) {
                                    float ang = pos * fr;
                                    float cs = cosf(ang), sn = sinf(ang);
                                    int i1 = a * 16 + f, i2 = a * 16 + 8 + f;
                                    float x1 = bf2f(ptr[i1]) * rs * g[i1], x2 = bf2f(ptr[i2]) * rs * g[i2];
                                    ptr[i1] = f2bf(x1 * cs - x2 * sn);
                                    ptr[i2] = f2bf(x2 * cs + x1 * sn);
                                    fr *= 0.31622776601683794f;
                                }
                            }
                        } else {
                            for (int d = 0; d < 32; ++d) ptr[d] = f2bf(bf2f(ptr[d]) * rs * g[d]);
                        }
                    }
                }
            }
        }
    }
    {
        const float* cw = p.in[I_CONVW] + (size_t)l * 5 * 768;
        const int N = R * 12;
        for (int u = bid; u < (N + 255) / 256; u += nb) {
            THREADS(t, 256) {
                int idx = u * 256 + t;
                if (idx < N) {
                    int r = idx / 12, ph = idx % 12; int part = ph >> 2, hd = ph & 3;
                    RowInfo ri = rowinfo(r);
                    int ch0 = part * 256 + hd * 64;
                    float ss = 0.f;
                    for (int pass = 0; pass < 2; ++pass) {
                        float scl = 1.0f;
                        if (pass == 1) { if (part == 0) scl = 0.125f / sqrtf(ss + 1e-6f); else if (part == 1) scl = 1.0f / sqrtf(ss + 1e-6f); }
                        if (pass == 0 && part == 2) continue;
                        for (int c = 0; c < 64; ++c) {
                            float y = 0.f;
                            for (int i = 0; i < 5; ++i) {
                                int tt = ri.t + i - 2;
                                if (tt >= 0 && tt < ri.T) y += bf2f(p.P[(size_t)(ri.base + tt) * PLD + C_GQ + ch0 + c]) * cw[i * 768 + ch0 + c];
                            }
                            y = siluf_(y);
                            if (pass == 0) ss += y * y; else p.gq[(size_t)r * 768 + ch0 + c] = f2bf(y * scl);
                        }
                    }
                }
            }
        }
    }
    {
        const int RQ = (l == 0) ? R : NLAT;
        for (int r = (FOURIER_GEMM ? NLAT : 0) + bid; r < RQ; r += nb) {
            THREADS(t, 256) {
                int g = t >> 6, m = t & 63;
                const bf16* f = p.P + (size_t)r * PLD + C_F + g * 64;
                float fc = 0.f, fs = 0.f;
                for (int c = 0; c < 64; ++c) {
                    int ti = ((m * c) & 63) * (SEQ / 64);
                    float v = bf2f(f[c]);
                    fc += v * p.cosT[ti]; fs += v * p.sinT[ti];
                }
                p.fcs[(size_t)r * 512 + t] = f2bf(fc);
                p.fcs[(size_t)r * 512 + 256 + t] = f2bf(fs);
            }
        }
    }
}

#ifndef CPU_EMU
HD void ph_na(const Params& p, int l, int bid, int nb, char* smc) {
    const int t = tid_(), lane = t & 63, w = t >> 6, fr = lane & 15, fg = lane >> 4;
    const float* rpb = p.in[I_RPB] + (size_t)l * 4 * 15 * 31;
    float* sbias = (float*)(smc + 32768);
    const lds_cptr lds = (lds_cptr)smc;
    constexpr int WH = ROWS < 8 ? ROWS : 8;
    const int nlat = NB * ROWS * 4;
    const int nctx = (l == 0) ? NB * 4 * (CTXL / 64) : 0;
    const int lkey = t >> 3, lc = t & 7;
    const int ksrc = (lc ^ (lkey & 7)) << 3;
    const int vsrc = ((((lc >> 1) ^ ((lkey >> 1) & 3)) << 1) | (lc & 1)) << 3;
    for (int unit = bid; unit < nlat + nctx; unit += nb) {
        int b, hd, qrow, ntl, rs = 0, gr = 0;
        if (unit < nlat) {
            hd = unit & 3; const int br_ = unit >> 2; gr = br_ % ROWS; b = br_ / ROWS;
            qrow = b * SEQ + gr * GW + w * 16 + fr; ntl = WH;
            rs = gr - WH / 2; if (rs < 0) rs = 0; if (rs > ROWS - WH) rs = ROWS - WH;
        } else {
            const int u2 = unit - nlat; const int qt = u2 % (CTXL / 64); const int bh = u2 / (CTXL / 64); hd = bh & 3; b = bh >> 2;
            qrow = NLAT + b * CTXL + qt * 64 + w * 16 + fr; ntl = 0;
        }
        const int ntiles = ntl + NCC;
        const int qcol = w * 16 + fr;
        int cs0 = w * 16 - 8; if (cs0 < 0) cs0 = 0; if (cs0 > GW - 32) cs0 = GW - 32;
        int wsq = qcol - 8; if (wsq < 0) wsq = 0; if (wsq > GW - 16) wsq = GW - 16;
        bf16x8_t qf[2];
#pragma unroll
        for (int s_ = 0; s_ < 2; ++s_) qf[s_] = *(const bf16x8_t*)(p.P + (size_t)qrow * PLD + C_NAQ + hd * 64 + s_ * 32 + fg * 8);
        f32x4_t O[4];
#pragma unroll
        for (int d = 0; d < 4; ++d) O[d] = f32x4_t{0.f, 0.f, 0.f, 0.f};
        float ls = 0.f;
        auto keyrow = [&](int tt, int i) { return (tt < ntl) ? (b * SEQ + (rs + tt) * GW + i) : (NLAT + b * CTXL + (tt - ntl) * 64 + i); };
        char* ldst = smc + w * 1024;
        __syncthreads();
        for (int i = t; i < 15 * 31; i += 256) sbias[i] = rpb[hd * 465 + i] * 1.4426950408889634f;
#pragma unroll
        for (int i = 0; i < 2; ++i) {
            const bf16* src = p.P + (size_t)keyrow(0, lkey + 32 * i) * PLD + hd * 64;
            GLDS16(src + C_NAK + ksrc, ldst + 4096 * i); GLDS16(src + C_NAV + vsrc, ldst + 16384 + 4096 * i);
        }
        WAIT_VM0();
        __syncthreads();
        const int vkl = 4 * fg + (fr >> 2);
        const int vsw = (vkl >> 1) & 3;
        unsigned va[4];
#pragma unroll
        for (int d = 0; d < 4; ++d) va[d] = 16384 + vkl * 128 + ((((d ^ vsw) << 1) | ((fr & 3) >> 1)) << 4) + (fr & 1) * 8;
#pragma unroll 1
        for (int tt = 0; tt < ntiles; ++tt) {
            const int cur = tt & 1;
            if (tt + 1 < ntiles) {
#pragma unroll
                for (int i = 0; i < 2; ++i) {
                    const bf16* src = p.P + (size_t)keyrow(tt + 1, lkey + 32 * i) * PLD + hd * 64;
                    GLDS16(src + C_NAK + ksrc, ldst + (cur ^ 1) * 8192 + 4096 * i); GLDS16(src + C_NAV + vsrc, ldst + 16384 + (cur ^ 1) * 8192 + 4096 * i);
                }
            }
            const char* cK = smc + cur * 8192;
            const lds_cptr cV = lds + cur * 8192;
            const bool local = tt < ntl;
            const int kbase = local ? cs0 : 0;
            const int nkf = local ? 2 : 4;
            unsigned pb[2][4];
#pragma unroll
            for (int f = 0; f < 4; ++f) {
                if (f < nkf) {
                    const int key = kbase + f * 16 + fr;
                    const char* kp = cK + key * 128;
                    const bf16x8_t a0 = *(const bf16x8_t*)(kp + (((fg) ^ (fr & 7)) << 4));
                    const bf16x8_t a1 = *(const bf16x8_t*)(kp + (((4 + fg) ^ (fr & 7)) << 4));
                    f32x4_t S = __builtin_amdgcn_mfma_f32_16x16x32_bf16(a0, qf[0], f32x4_t{0.f, 0.f, 0.f, 0.f}, 0, 0, 0);
                    S = __builtin_amdgcn_mfma_f32_16x16x32_bf16(a1, qf[1], S, 0, 0, 0);
                    float e[4];
#pragma unroll
                    for (int r = 0; r < 4; ++r) {
                        float sv = S[r]; bool ok = true;
                        if (local) {
                            const int kc = kbase + f * 16 + 4 * fg + r;
                            ok = (unsigned)(kc - wsq) < 16u;
                            sv += sbias[((rs + tt) - gr + 7) * 31 + (ok ? (kc - qcol + 15) : 15)];
                        }
                        e[r] = ok ? __builtin_amdgcn_exp2f(sv) : 0.f;
                    }
                    ls += (e[0] + e[1]) + (e[2] + e[3]);
                    pb[f >> 1][(f & 1) * 2] = cvtpk(e[0], e[1]);
                    pb[f >> 1][(f & 1) * 2 + 1] = cvtpk(e[2], e[3]);
                }
            }
#pragma unroll
            for (int ks = 0; ks < 2; ++ks) {
                if (ks * 2 < nkf) {
#pragma unroll
                    for (int d = 0; d < 4; ++d) {
                        const s16x4_t lo = lds_tr16(cV + va[d] + (kbase + ks * 32) * 128);
                        const s16x4_t hi = lds_tr16(cV + va[d] + (kbase + ks * 32 + 16) * 128);
                        const bf16x8_t vf = bf16x8_t{lo[0], lo[1], lo[2], lo[3], hi[0], hi[1], hi[2], hi[3]};
                        const i32x4_t bi = i32x4_t{(int)pb[ks][0], (int)pb[ks][1], (int)pb[ks][2], (int)pb[ks][3]};
                        O[d] = __builtin_amdgcn_mfma_f32_16x16x32_bf16(vf, __builtin_bit_cast(bf16x8_t, bi), O[d], 0, 0, 0);
                    }
                }
            }
            WAIT_VM0();
            __syncthreads();
        }
        ls += __shfl_xor(ls, 16); ls += __shfl_xor(ls, 32);
        const float inv = 1.0f / ls;
        bf16* op = p.br + (size_t)qrow * D + hd * 64;
#pragma unroll
        for (int d = 0; d < 4; ++d) {
            uint2 pk; pk.x = cvtpk(O[d][0] * inv, O[d][1] * inv); pk.y = cvtpk(O[d][2] * inv, O[d][3] * inv);
            *(uint2*)(op + d * 16 + 4 * fg) = pk;
        }
    }
}
#else
HD void ph_na(const Params& p, int l, int bid, int nb, char*) {
    const float* rpb = p.in[I_RPB] + (size_t)l * 4 * 15 * 31;
    const int RQ = (l == 0) ? R : NLAT;
    const int N = RQ * 4;
    const int wh = ROWS < 8 ? ROWS : 8;
    for (int u = bid; u < (N + 255) / 256; u += nb) {
        THREADS(t, 256) {
            int idx = u * 256 + t;
            if (idx < N) {
                int hd = idx / RQ, r = idx % RQ;
                RowInfo ri = rowinfo(r);
                float q[64], o[64];
                const bf16* qp = p.P + (size_t)r * PLD + C_NAQ + hd * 64;
#pragma unroll
                for (int d = 0; d < 64; ++d) { q[d] = bf2f(qp[d]) * 0.125f; o[d] = 0.f; }
                float mx = -1e30f, lsum = 0.f;
                int nloc = 0, rs = 0, ws = 0, gr = 0, gc = 0;
                if (ri.seg == 0) {
                    gr = ri.t / GW; gc = ri.t % GW;
                    rs = gr - wh / 2; if (rs < 0) rs = 0; if (rs > ROWS - wh) rs = ROWS - wh;
                    ws = gc - 8; if (ws < 0) ws = 0; if (ws > GW - 16) ws = GW - 16;
                    nloc = wh * 16;
                }
                int ctxbase = NLAT + ri.b * CTXL;
                for (int kk = 0; kk < nloc + CTXL; ++kk) {
                    int kr; float bias = 0.f;
                    if (kk < nloc) {
                        int a = kk >> 4, c = kk & 15;
                        int krow = rs + a, kcol = ws + c;
                        kr = ri.base + krow * GW + kcol;
                        bias = rpb[(hd * 15 + (krow - gr + 7)) * 31 + (kcol - gc + 15)];
                    } else kr = ctxbase + (kk - nloc);
                    const bf16* kp = p.P + (size_t)kr * PLD + C_NAK + hd * 64;
                    float s = 0.f;
#pragma unroll
                    for (int d = 0; d < 64; ++d) s += q[d] * bf2f(kp[d]);
                    s += bias;
                    if (s > mx) { float f = expf(mx - s); lsum *= f;
#pragma unroll
                        for (int d = 0; d < 64; ++d) o[d] *= f;
                        mx = s; }
                    float e = expf(s - mx);
                    lsum += e;
                    const bf16* vp = p.P + (size_t)kr * PLD + C_NAV + hd * 64;
#pragma unroll
                    for (int d = 0; d < 64; ++d) o[d] += e * bf2f(vp[d]);
                }
                float inv = 1.0f / lsum;
                bf16* op = p.br + (size_t)r * D + hd * 64;
#pragma unroll
                for (int d = 0; d < 64; ++d) op[d] = f2bf(o[d] * inv);
            }
        }
    }
}

#endif

#ifndef CPU_EMU
HD void ph_da(const Params& p, int l, int bid, int nb, char* smc) {
    const int t = tid_(), lane = t & 63, w = t >> 6, fr = lane & 15, fg = lane >> 4;
    const float lam_init = lam_init_of(l);
    float s1 = 0.f, s2 = 0.f;
    for (int d = 0; d < 32; ++d) {
        s1 += p.in[I_LQ1][l * 32 + d] * p.in[I_LK1][l * 32 + d];
        s2 += p.in[I_LQ2][l * 32 + d] * p.in[I_LK2][l * 32 + d];
    }
    const float lam = expf(s1) - expf(s2) + lam_init;
    const float* sg = p.in[I_SUBLN] + l * 64;
    constexpr int NQT = SEQ / 128, NQC = CTXL / 128;
    const int nlat = NB * 4 * NQT;
    const int nctx = (l == 0) ? NB * 4 * NQC : 0;
    const lds_cptr lds = (lds_cptr)smc;
    for (int unit = bid; unit < nlat + nctx; unit += nb) {
        int b, hd, qrow0, kt0;
        if (unit < nlat) { const int qt = unit % NQT, bh = unit / NQT; hd = bh & 3; b = bh >> 2; qrow0 = b * SEQ + qt * 128; kt0 = 0; }
        else { const int u2 = unit - nlat; const int qt = u2 % NQC, bh = u2 / NQC; hd = bh & 3; b = bh >> 2; qrow0 = NLAT + b * CTXL + qt * 128; kt0 = NCL; }
        const int kt1 = NCL + NCC;
        bf16x8_t qf[2][2];
#pragma unroll
        for (int m = 0; m < 2; ++m)
#pragma unroll
            for (int n = 0; n < 2; ++n)
                qf[m][n] = *(const bf16x8_t*)(p.P + (size_t)(qrow0 + w * 32 + n * 16 + fr) * PLD + C_DAQ + hd * 64 + m * 32 + fg * 8);
        f32x4_t O[2][4][2];
#pragma unroll
        for (int m = 0; m < 2; ++m)
#pragma unroll
            for (int d = 0; d < 4; ++d)
#pragma unroll
                for (int n = 0; n < 2; ++n) O[m][d][n] = f32x4_t{0.f, 0.f, 0.f, 0.f};
        float ls[2][2] = {{0.f, 0.f}, {0.f, 0.f}};
        const int lkey = t >> 3, lc = t & 7;
        const int ksrc = (lc ^ (lkey & 7)) << 3;
        const int vsrc = ((((lc >> 1) ^ ((lkey >> 1) & 3)) << 1) | (lc & 1)) << 3;
        auto keyrow = [&](int kt, int i) { return (kt < NCL) ? (b * SEQ + kt * 64 + i) : (NLAT + b * CTXL + (kt - NCL) * 64 + i); };
        char* ldst = smc + w * 1024;
        __syncthreads();
#pragma unroll
        for (int i = 0; i < 2; ++i) {
            const bf16* src = p.P + (size_t)keyrow(kt0, lkey + 32 * i) * PLD + hd * 64;
            GLDS16(src + C_DAK + ksrc, ldst + 4096 * i); GLDS16(src + C_DAV + vsrc, ldst + 16384 + 4096 * i);
        }
        WAIT_VM0();
        __syncthreads();
        const unsigned ka0 = fr * 128 + (((fg) ^ (fr & 7)) << 4);
        const unsigned ka1 = fr * 128 + (((4 + fg) ^ (fr & 7)) << 4);
        const int vkey = 4 * fg + (fr >> 2);
        const int vsw = (vkey >> 1) & 3;
        unsigned va[4];
#pragma unroll
        for (int d = 0; d < 4; ++d) va[d] = 16384 + vkey * 128 + ((((d ^ vsw) << 1) | ((fr & 3) >> 1)) << 4) + (fr & 1) * 8;
#pragma unroll 1
        for (int kt = kt0; kt < kt1; ++kt) {
            const int cur = (kt - kt0) & 1;
            if (kt + 1 < kt1) {
#pragma unroll
                for (int i = 0; i < 2; ++i) {
                    const bf16* src = p.P + (size_t)keyrow(kt + 1, lkey + 32 * i) * PLD + hd * 64;
                    GLDS16(src + C_DAK + ksrc, ldst + (cur ^ 1) * 8192 + 4096 * i); GLDS16(src + C_DAV + vsrc, ldst + 16384 + (cur ^ 1) * 8192 + 4096 * i);
                }
            }
            const char* cK = smc + cur * 8192;
            const lds_cptr cV = lds + cur * 8192;
#pragma unroll
            for (int m = 0; m < 2; ++m) {
                unsigned pb[2][2][4];
                {
                    f32x4_t S[4][2];
#pragma unroll
                    for (int kf = 0; kf < 4; ++kf) {
                        const bf16x8_t a = *(const bf16x8_t*)(cK + (m ? ka1 : ka0) + kf * 2048);
#pragma unroll
                        for (int n = 0; n < 2; ++n) S[kf][n] = __builtin_amdgcn_mfma_f32_16x16x32_bf16(a, qf[m][n], f32x4_t{0.f, 0.f, 0.f, 0.f}, 0, 0, 0);
                    }
#pragma unroll
                    for (int kf = 0; kf < 4; ++kf)
#pragma unroll
                        for (int n = 0; n < 2; ++n) {
                            const float e0 = __builtin_amdgcn_exp2f(S[kf][n][0]), e1 = __builtin_amdgcn_exp2f(S[kf][n][1]);
                            const float e2 = __builtin_amdgcn_exp2f(S[kf][n][2]), e3 = __builtin_amdgcn_exp2f(S[kf][n][3]);
                            ls[m][n] += (e0 + e1) + (e2 + e3);
                            pb[n][kf >> 1][(kf & 1) * 2] = cvtpk(e0, e1);
                            pb[n][kf >> 1][(kf & 1) * 2 + 1] = cvtpk(e2, e3);
                        }
                }
#pragma unroll
                for (int ks = 0; ks < 2; ++ks)
#pragma unroll
                    for (int d = 0; d < 4; ++d) {
                        const s16x4_t lo = lds_tr16(cV + va[d] + ks * 4096);
                        const s16x4_t hi = lds_tr16(cV + va[d] + ks * 4096 + 2048);
                        const bf16x8_t vf = bf16x8_t{lo[0], lo[1], lo[2], lo[3], hi[0], hi[1], hi[2], hi[3]};
#pragma unroll
                        for (int n = 0; n < 2; ++n) {
                            const i32x4_t bi = i32x4_t{(int)pb[n][ks][0], (int)pb[n][ks][1], (int)pb[n][ks][2], (int)pb[n][ks][3]};
                            O[m][d][n] = __builtin_amdgcn_mfma_f32_16x16x32_bf16(vf, __builtin_bit_cast(bf16x8_t, bi), O[m][d][n], 0, 0, 0);
                        }
                    }
                asm volatile("" ::: "memory");
            }
            WAIT_VM0();
            __syncthreads();
        }
#pragma unroll
        for (int n = 0; n < 2; ++n) {
            float l0 = ls[0][n], l1 = ls[1][n];
            l0 += __shfl_xor(l0, 16); l0 += __shfl_xor(l0, 32);
            l1 += __shfl_xor(l1, 16); l1 += __shfl_xor(l1, 32);
            const float i0 = 1.0f / l0, i1 = lam / l1;
            float ss = 0.f;
#pragma unroll
            for (int d = 0; d < 4; ++d)
#pragma unroll
                for (int r = 0; r < 4; ++r) { const float o = O[0][d][n][r] * i0 - O[1][d][n][r] * i1; O[0][d][n][r] = o; ss += o * o; }
            ss += __shfl_xor(ss, 16); ss += __shfl_xor(ss, 32);
            const float rs = (1.0f - lam_init) / sqrtf(ss / 64.0f + 1e-6f);
            bf16* op = p.br + (size_t)(qrow0 + w * 32 + n * 16 + fr) * D + 256 + hd * 64;
#pragma unroll
            for (int d = 0; d < 4; ++d) {
                const int dv = d * 16 + 4 * fg;
                const unsigned lo = cvtpk(O[0][d][n][0] * rs * sg[dv], O[0][d][n][1] * rs * sg[dv + 1]);
                const unsigned hi = cvtpk(O[0][d][n][2] * rs * sg[dv + 2], O[0][d][n][3] * rs * sg[dv + 3]);
                uint2 pk; pk.x = lo; pk.y = hi;
                *(uint2*)(op + dv) = pk;
            }
        }
    }
}
#else
HD void ph_da(const Params& p, int l, int bid, int nb, char*) {
    const int RQ = (l == 0) ? R : NLAT;
    const int N = RQ * 4;
    const float lam_init = lam_init_of(l);
    float s1 = 0.f, s2 = 0.f;
    for (int d = 0; d < 32; ++d) {
        s1 += p.in[I_LQ1][l * 32 + d] * p.in[I_LK1][l * 32 + d];
        s2 += p.in[I_LQ2][l * 32 + d] * p.in[I_LK2][l * 32 + d];
    }
    const float lam = expf(s1) - expf(s2) + lam_init;
    const float* sg = p.in[I_SUBLN] + l * 64;
    const float scale = 0.17677669529663687f;
    for (int u = bid; u < (N + 255) / 256; u += nb) {
        THREADS(t, 256) {
            int idx = u * 256 + t;
            if (idx < N) {
                int hd = idx / RQ, r = idx % RQ;
                RowInfo ri = rowinfo(r);
                float q0[32], q1[32], o0[64], o1[64];
                const bf16* qp = p.P + (size_t)r * PLD + C_DAQ + hd * 64;
#pragma unroll
                for (int d = 0; d < 32; ++d) { q0[d] = bf2f(qp[d]) * scale; q1[d] = bf2f(qp[32 + d]) * scale; }
#pragma unroll
                for (int d = 0; d < 64; ++d) { o0[d] = 0.f; o1[d] = 0.f; }
                float m0 = -1e30f, m1 = -1e30f, l0 = 0.f, l1 = 0.f;
                int nlat = (ri.seg == 0) ? SEQ : 0;
                int latbase = ri.b * SEQ, ctxbase = NLAT + ri.b * CTXL;
                for (int kk = 0; kk < nlat + CTXL; ++kk) {
                    int kr = (kk < nlat) ? latbase + kk : ctxbase + (kk - nlat);
                    const bf16* kp = p.P + (size_t)kr * PLD + C_DAK + hd * 64;
                    const bf16* vp = p.P + (size_t)kr * PLD + C_DAV + hd * 64;
                    float sa = 0.f, sb = 0.f;
#pragma unroll
                    for (int d = 0; d < 32; ++d) { sa += q0[d] * bf2f(kp[d]); sb += q1[d] * bf2f(kp[32 + d]); }
                    if (sa > m0) { float f = expf(m0 - sa); l0 *= f;
#pragma unroll
                        for (int d = 0; d < 64; ++d) o0[d] *= f;
                        m0 = sa; }
                    if (sb > m1) { float f = expf(m1 - sb); l1 *= f;
#pragma unroll
                        for (int d = 0; d < 64; ++d) o1[d] *= f;
                        m1 = sb; }
                    float ea = expf(sa - m0), eb = expf(sb - m1);
                    l0 += ea; l1 += eb;
#pragma unroll
                    for (int d = 0; d < 64; ++d) { float v = bf2f(vp[d]); o0[d] += ea * v; o1[d] += eb * v; }
                }
                float i0 = 1.0f / l0, i1 = lam / l1;
                float ss = 0.f;
#pragma unroll
                for (int d = 0; d < 64; ++d) { o0[d] = o0[d] * i0 - o1[d] * i1; ss += o0[d] * o0[d]; }
                float rs = (1.0f - lam_init) / sqrtf(ss / 64.0f + 1e-6f);
                bf16* op = p.br + (size_t)r * D + 256 + hd * 64;
#pragma unroll
                for (int d = 0; d < 64; ++d) op[d] = f2bf(o0[d] * rs * sg[d]);
            }
        }
    }
}

#endif

struct ChunkInfo { int dir, b, hd, n, seg, T, base, nloc; };
HD ChunkInfo chunkinfo(int unit) {
    ChunkInfo c;
    c.n = unit % NCH; int ch = unit / NCH; c.hd = ch & 3; c.b = (ch >> 2) % NB; c.dir = ch / (4 * NB);
    if (c.n < NCC) { c.seg = 1; c.T = CTXL; c.base = NLAT + c.b * CTXL; c.nloc = c.n; }
    else { c.seg = 0; c.T = SEQ; c.base = c.b * SEQ; c.nloc = c.n - NCC; }
    return c;
}
HD int chunk_row(const ChunkInfo& c, int i) { int pf = c.nloc * 64 + i; return c.base + (c.dir ? (c.T - 1 - pf) : pf); }

#ifndef CPU_EMU
HD void ph_gdn_chunk(const Params& p, int l, int bid, int nb, float* smf) {
    char* smc = (char*)smf;
    const int t = tid_(), lane = t & 63, w = t >> 6, fr = lane & 15, fg = lane >> 4;
    float* sA = (float*)(smc + 24576); float* sG = (float*)(smc + 40960); float* sB = (float*)(smc + 41216);
    const int lkey = t >> 3, lc = t & 7;
    const int ksrc = (lc ^ (lkey & 7)) << 3;
    char* ldst = smc + w * 1024;
    for (int unit = bid; unit < NUNIT; unit += nb) {
        const ChunkInfo c = chunkinfo(unit);
        const int dh = c.dir * 4 + c.hd;
        __syncthreads();
#pragma unroll
        for (int i = 0; i < 2; ++i) {
            const bf16* src = p.gq + (size_t)chunk_row(c, lkey + 32 * i) * 768 + c.hd * 64;
            GLDS16(src + 256 + ksrc, ldst + 4096 * i);
            GLDS16(src + ksrc, ldst + 8192 + 4096 * i);
            GLDS16(src + 512 + lc * 8, ldst + 16384 + 4096 * i);
        }
        if (w == 0) {
            const int row = chunk_row(c, lane);
            float x = p.gg[(size_t)dh * R + row];
#pragma unroll
            for (int off = 1; off < 64; off <<= 1) { const float y = __shfl_up(x, off); if (lane >= off) x += y; }
            sG[lane] = x; sB[lane] = p.gbeta[(size_t)dh * R + row];
            p.cG[(size_t)unit * 64 + lane] = x;
        }
        WAIT_VM0();
        __syncthreads();
        {
            const char* kt_ = smc; const char* qt_ = smc + 8192;
            const unsigned ro = (16 * w + fr) * 128;
            const unsigned c0 = ((fg) ^ (fr & 7)) << 4, c1 = ((4 + fg) ^ (fr & 7)) << 4;
            const bf16x8_t ak0 = *(const bf16x8_t*)(kt_ + ro + c0), ak1 = *(const bf16x8_t*)(kt_ + ro + c1);
            const bf16x8_t aq0 = *(const bf16x8_t*)(qt_ + ro + c0), aq1 = *(const bf16x8_t*)(qt_ + ro + c1);
            float gi[4], bi[4];
#pragma unroll
            for (int r = 0; r < 4; ++r) { gi[r] = sG[16 * w + 4 * fg + r]; bi[r] = sB[16 * w + 4 * fg + r]; }
#pragma unroll
            for (int n = 0; n < 4; ++n) {
                const unsigned rb = (16 * n + fr) * 128;
                const bf16x8_t b0 = *(const bf16x8_t*)(kt_ + rb + c0), b1 = *(const bf16x8_t*)(kt_ + rb + c1);
                f32x4_t kk = __builtin_amdgcn_mfma_f32_16x16x32_bf16(ak0, b0, f32x4_t{0.f, 0.f, 0.f, 0.f}, 0, 0, 0);
                kk = __builtin_amdgcn_mfma_f32_16x16x32_bf16(ak1, b1, kk, 0, 0, 0);
                f32x4_t qk = __builtin_amdgcn_mfma_f32_16x16x32_bf16(aq0, b0, f32x4_t{0.f, 0.f, 0.f, 0.f}, 0, 0, 0);
                qk = __builtin_amdgcn_mfma_f32_16x16x32_bf16(aq1, b1, qk, 0, 0, 0);
                const int j = 16 * n + fr; const float gj = sG[j];
#pragma unroll
                for (int r = 0; r < 4; ++r) {
                    const int i = 16 * w + 4 * fg + r;
                    const float dec = (j <= i) ? __expf(gi[r] - gj) : 0.f;
                    sA[i * 64 + j] = (j < i) ? kk[r] * bi[r] * dec : 0.f;
                    p.cQK[(size_t)unit * 4096 + i * 64 + j] = f2bf(qk[r] * dec);
                }
            }
        }
        __syncthreads();
        if (w < 2) {
            float x[64];
            bf16* dst = (w == 0 ? p.cU : p.cW) + (size_t)unit * 4096 + lane;
#pragma unroll
            for (int i = 0; i < 64; ++i) {
                float rhs;
                if (w == 0) rhs = sB[i] * bf2f(*(const bf16*)(smc + 16384 + i * 128 + lane * 2));
                else rhs = sB[i] * __expf(sG[i]) * bf2f(*(const bf16*)(smc + i * 128 + ((((lane >> 3) ^ (i & 7))) << 4) + (lane & 7) * 2));
                float acc = rhs;
#pragma unroll
                for (int j4 = 0; j4 < i; j4 += 4) {
                    const f32x4_t a4 = *(const f32x4_t*)(sA + i * 64 + j4);
                    acc -= a4[0] * x[j4];
                    if (j4 + 1 < i) acc -= a4[1] * x[j4 + 1];
                    if (j4 + 2 < i) acc -= a4[2] * x[j4 + 2];
                    if (j4 + 3 < i) acc -= a4[3] * x[j4 + 3];
                }
                x[i] = acc;
                dst[i * 64] = f2bf(acc);
            }
        }
    }
}
#else
HD void ph_gdn_chunk(const Params& p, int l, int bid, int nb, float* sm) {
    float* sk = sm;
    float* sq = sm + 4096;
    float* sA = sm + 8192;
    float* sXu = sm + 12288;
    float* sXw = sm + 4096;
    float* sG = sm + 16384;
    float* sB = sm + 16448;
    for (int unit = bid; unit < NUNIT; unit += nb) {
        ChunkInfo c = chunkinfo(unit);
        int dh = c.dir * 4 + c.hd;
        THREADS(t, 4096) {
            int i = t >> 6, d = t & 63; int row = chunk_row(c, i);
            sq[t] = bf2f(p.gq[(size_t)row * 768 + c.hd * 64 + d]);
            sk[t] = bf2f(p.gq[(size_t)row * 768 + 256 + c.hd * 64 + d]);
        }
        THREADS(t, 1) {
            float acc = 0.f;
            for (int i = 0; i < 64; ++i) { int row = chunk_row(c, i); acc += p.gg[(size_t)dh * R + row]; sG[i] = acc; sB[i] = p.gbeta[(size_t)dh * R + row]; }
        }
        SYNC
        THREADS(t, 4096) {
            int i = t >> 6, j = t & 63;
            float kk = 0.f, qk = 0.f;
            for (int d = 0; d < 64; ++d) { kk += sk[i * 64 + d] * sk[j * 64 + d]; qk += sq[i * 64 + d] * sk[j * 64 + d]; }
            float dec = (j <= i) ? expf(sG[i] - sG[j]) : 0.f;
            sA[t] = (j < i) ? kk * sB[i] * dec : 0.f;
            p.cQK[(size_t)unit * 4096 + t] = f2bf(qk * dec);
        }
        SYNC
        THREADS(t, 4096) {
            int i = t >> 6, cc = t & 63; int row = chunk_row(c, i);
            sXu[t] = sB[i] * bf2f(p.gq[(size_t)row * 768 + 512 + c.hd * 64 + cc]);
            sXw[t] = sB[i] * expf(sG[i]) * sk[t];
        }
        SYNC
        for (int i = 1; i < 64; ++i) {
            THREADS(cc, 128) {
                float* X = (cc < 64) ? (sXu + cc) : (sXw + cc - 64);
                float acc = X[i * 64];
                for (int j = 0; j < i; ++j) acc -= sA[i * 64 + j] * X[j * 64];
                X[i * 64] = acc;
            }
            SYNC
        }
        THREADS(t, 4096) {
            p.cU[(size_t)unit * 4096 + t] = f2bf(sXu[t]);
            p.cW[(size_t)unit * 4096 + t] = f2bf(sXw[t]);
        }
        THREADS(t, 64) { p.cG[(size_t)unit * 64 + t] = sG[t]; }
        SYNC
    }
}

#endif

HD void ph_fourier2(const Params& p, int l, int bid, int nb) {
    const int RQ = (l == 0) ? R : NLAT;
    for (int r = (FOURIER_GEMM ? NLAT : 0) + bid; r < RQ; r += nb) {
        RowInfo ri = rowinfo(r);
        const float nrm = 1.0f / sqrtf((float)ri.T * 64.0f);
        const int mul = SEQ / ri.T;
        THREADS(ch, 256) {
            float acc = 0.f;
            for (int tt = 0; tt < ri.T; ++tt) {
                int ti = ((ri.t * tt) & (ri.T - 1)) * mul;
                const bf16* f = p.fcs + (size_t)(ri.base + tt) * 512;
                acc += p.cosT[ti] * bf2f(f[ch]) - p.sinT[ti] * bf2f(f[256 + ch]);
            }
            p.br[(size_t)r * D + 768 + ch] = f2bf(acc * nrm);
        }
    }
}


HD void ph_fourier_s1(const Params& p, int bid, int nb, char* smc) {
    for (int tile = bid; tile < NB * 64 * 4; tile += nb) {
        const int g = tile & 3, t2 = (tile >> 2) & 63, b = tile >> 8;
        ACC_DECL(4, acc); acc_zero(acc);
        gemm_accum<4>(acc, [&](int i) { return p.P + (size_t)(b * SEQ + 64 * i + t2) * PLD + C_F + g * 64; },
                      [&](int j) { return p.fW1 + j * 64; }, 64, smc);
        ACC_FOR(4, row, col) {
            const int cs = col >> 6, m = col & 63;
            p.fcs[((((size_t)b * 256 + g * 64 + m) * 64 + t2) * 2 + cs) * 128 + row] = f2bf(AV(acc));
        } ACC_END
    }
}
HD void ph_fourier_sA(const Params& p, int bid, int nb, char* smc) {
    for (int tile = bid; tile < NB * 128 * 2; tile += nb) {
        const int nt = tile & 1, mt = (tile >> 1) & 127, b = tile >> 8;
        ACC_DECL(4, acc); acc_zero(acc);
        gemm_accum<4>(acc, [&](int i) { return p.fcs + ((size_t)b * 16384 + mt * 128 + i) * 256; },
                      [&](int j) { return p.fWA + (size_t)(nt * 128 + j) * 256; }, 256, smc);
        ACC_FOR_PAIR(row, pcol) {
            const int k1 = nt * 64 + pcol; const int rr = mt * 128 + row; const int ch = rr >> 6, t2 = rr & 63;
            const float re = AV_G(acc), im = AV_U(acc);
            const float c = p.cosT[k1 * t2], sn = p.sinT[k1 * t2];
            bf16* o = p.fa2 + ((((size_t)b * 128 + k1) * 256 + ch) * 2) * 64 + t2;
            o[0] = f2bf(re * c + im * sn); o[64] = f2bf(im * c - re * sn);
        } ACC_END
    }
}
HD void ph_fourier_sB(const Params& p, int bid, int nb, char* smc) {
    const float nrm = 1.0f / sqrtf((float)SEQ * 64.0f);
    for (int tile = bid; tile < NB * 128 * 2; tile += nb) {
        const int cht = tile & 1, k1 = (tile >> 1) & 127, b = tile >> 8;
        ACC_DECL(2, acc); acc_zero(acc);
        gemm_accum<2>(acc, [&](int i) { return p.fa2 + (((size_t)b * 128 + k1) * 256 + cht * 128 + i) * 128; },
                      [&](int j) { return p.fWB + j * 128; }, 128, smc);
        ACC_FOR(2, row, col) {
            p.br[(size_t)(b * SEQ + k1 + 128 * col) * D + 768 + cht * 128 + row] = f2bf(AV(acc) * nrm);
        } ACC_END
    }
}

#ifndef CPU_EMU
HD void ph_gdn_scan(const Params& p, int l, int bid, int nb, float* smf) {
    char* smc = (char*)smf;
    const int t = tid_(), lane = t & 63, w = t >> 6, fr = lane & 15, fg = lane >> 4;
    const int RQ = (l == 0) ? R : NLAT;
    constexpr int STG = 32768;
    char* sST = smc + 65536;
    char* sVT = smc + 65536 + 2048;
    char* sVS = smc + 65536 + 4096;
    float* sG = (float*)(smc + 65536 + 6144);
    const lds_cptr lds = (lds_cptr)smc;
    const int lkey = t >> 3, lc = t & 7;
    const int ksrc = (lc ^ (lkey & 7)) << 3;
    char* ldst = smc + w * 1024;
    for (int cu = bid; cu < 2 * NB * 4 * 4; cu += nb) {
        const int chain = cu >> 2, cb = cu & 3;
        auto stage = [&](int n, int buf) {
            const int unit = chain * NCH + n;
            const ChunkInfo c = chunkinfo(unit);
#pragma unroll
            for (int i = 0; i < 2; ++i) {
                const int ci = lkey + 32 * i;
                const int fsw = ((ci >> 1) & 1) | (((ci >> 3) & 1) << 1);
                const int k16 = ((((lc >> 1) ^ fsw) << 1) | (lc & 1)) << 3;
                const bf16* gsrc = p.gq + (size_t)chunk_row(c, ci) * 768 + c.hd * 64;
                GLDS16(p.cW + (size_t)unit * 4096 + ci * 64 + ksrc, ldst + buf * STG + 4096 * i);
                GLDS16(p.cQK + (size_t)unit * 4096 + ci * 64 + ksrc, ldst + buf * STG + 8192 + 4096 * i);
                GLDS16(gsrc + ksrc, ldst + buf * STG + 16384 + 4096 * i);
                GLDS16(gsrc + 256 + k16, ldst + buf * STG + 24576 + 4096 * i);
            }
        };
        f32x4_t S = f32x4_t{0.f, 0.f, 0.f, 0.f};
        __syncthreads();
        stage(0, 0);
        if (t < 64) sG[t] = p.cG[(size_t)(chain * NCH) * 64 + t];
        if (t < 512) ((unsigned*)sST)[t] = 0u;
        ((unsigned*)sST)[t + 256] = 0u;
        float un[4];
        {
            const ChunkInfo c0 = chunkinfo(chain * NCH);
            (void)c0;
#pragma unroll
            for (int r = 0; r < 4; ++r) un[r] = bf2f(p.cU[(size_t)(chain * NCH) * 4096 + (16 * w + 4 * fg + r) * 64 + cb * 16 + fr]);
        }
        WAIT_VM0();
        __syncthreads();
        const unsigned ro = (16 * w + fr) * 128;
        const unsigned c0 = ((fg) ^ (fr & 7)) << 4, c1 = ((4 + fg) ^ (fr & 7)) << 4;
        const unsigned bo0 = fr * 128 + c0, bo1 = fr * 128 + c1;
        const unsigned wofs = fr * 128 + ((((2 * w + (fg >> 1)) ^ (fr & 7))) << 4) + (fg & 1) * 8;
        unsigned ka[2][2];
#pragma unroll
        for (int s_ = 0; s_ < 2; ++s_)
#pragma unroll
            for (int h2 = 0; h2 < 2; ++h2) {
                const int cr = 32 * s_ + 8 * fg + (fr >> 2) + 4 * h2;
                const int fsw = ((cr >> 1) & 1) | (((cr >> 3) & 1) << 1);
                ka[s_][h2] = 24576 + cr * 128 + (((((w ^ fsw) << 1) | ((fr & 3) >> 1))) << 4) + (fr & 1) * 8;
            }
#pragma unroll 1
        for (int n = 0; n < NCH; ++n) {
            const int cur = n & 1;
            const int unit = chain * NCH + n;
            const ChunkInfo c = chunkinfo(unit);
            float gnext = 0.f; float unx[4] = {0.f, 0.f, 0.f, 0.f};
            if (n + 1 < NCH) {
                stage(n + 1, cur ^ 1);
                if (t < 64) gnext = p.cG[(size_t)(unit + 1) * 64 + t];
#pragma unroll
                for (int r = 0; r < 4; ++r) unx[r] = bf2f(p.cU[(size_t)(unit + 1) * 4096 + (16 * w + 4 * fg + r) * 64 + cb * 16 + fr]);
            }
            const char* st = smc + cur * STG;
            const float* g = sG + cur * 64;
            const f32x4_t gv = *(const f32x4_t*)(g + 16 * w + 4 * fg);
            const float g63 = g[63];
            const bf16x8_t st0 = *(const bf16x8_t*)(sST + bo0), st1 = *(const bf16x8_t*)(sST + bo1);
            f32x4_t v = __builtin_amdgcn_mfma_f32_16x16x32_bf16(*(const bf16x8_t*)(st + ro + c0), st0, f32x4_t{0.f, 0.f, 0.f, 0.f}, 0, 0, 0);
            v = __builtin_amdgcn_mfma_f32_16x16x32_bf16(*(const bf16x8_t*)(st + ro + c1), st1, v, 0, 0, 0);
            f32x4_t o1 = __builtin_amdgcn_mfma_f32_16x16x32_bf16(*(const bf16x8_t*)(st + 16384 + ro + c0), st0, f32x4_t{0.f, 0.f, 0.f, 0.f}, 0, 0, 0);
            o1 = __builtin_amdgcn_mfma_f32_16x16x32_bf16(*(const bf16x8_t*)(st + 16384 + ro + c1), st1, o1, 0, 0, 0);
            float vn[4];
#pragma unroll
            for (int r = 0; r < 4; ++r) vn[r] = un[r] - v[r];
            { uint2 pk; pk.x = cvtpk(vn[0], vn[1]); pk.y = cvtpk(vn[2], vn[3]); *(uint2*)(sVT + wofs) = pk; }
            { uint2 pk; pk.x = cvtpk(vn[0] * __expf(g63 - gv[0]), vn[1] * __expf(g63 - gv[1]));
              pk.y = cvtpk(vn[2] * __expf(g63 - gv[2]), vn[3] * __expf(g63 - gv[3])); *(uint2*)(sVS + wofs) = pk; }
            __syncthreads();
            const bf16x8_t vt0 = *(const bf16x8_t*)(sVT + bo0), vt1 = *(const bf16x8_t*)(sVT + bo1);
            f32x4_t o2 = __builtin_amdgcn_mfma_f32_16x16x32_bf16(*(const bf16x8_t*)(st + 8192 + ro + c0), vt0, f32x4_t{0.f, 0.f, 0.f, 0.f}, 0, 0, 0);
            o2 = __builtin_amdgcn_mfma_f32_16x16x32_bf16(*(const bf16x8_t*)(st + 8192 + ro + c1), vt1, o2, 0, 0, 0);
            const bf16x8_t vs0 = *(const bf16x8_t*)(sVS + bo0), vs1 = *(const bf16x8_t*)(sVS + bo1);
            f32x4_t dS;
            {
                const lds_cptr kb = lds + cur * STG;
                const s16x4_t a00 = lds_tr16(kb + ka[0][0]), a01 = lds_tr16(kb + ka[0][1]);
                const s16x4_t a10 = lds_tr16(kb + ka[1][0]), a11 = lds_tr16(kb + ka[1][1]);
                dS = __builtin_amdgcn_mfma_f32_16x16x32_bf16(bf16x8_t{a00[0], a00[1], a00[2], a00[3], a01[0], a01[1], a01[2], a01[3]}, vs0, f32x4_t{0.f, 0.f, 0.f, 0.f}, 0, 0, 0);
                dS = __builtin_amdgcn_mfma_f32_16x16x32_bf16(bf16x8_t{a10[0], a10[1], a10[2], a10[3], a11[0], a11[1], a11[2], a11[3]}, vs1, dS, 0, 0, 0);
            }
            const float e63 = __expf(g63);
#pragma unroll
            for (int r = 0; r < 4; ++r) S[r] = S[r] * e63 + dS[r];
            { uint2 pk; pk.x = cvtpk(S[0], S[1]); pk.y = cvtpk(S[2], S[3]); *(uint2*)(sST + wofs) = pk; }
#pragma unroll
            for (int r = 0; r < 4; ++r) {
                const int row = chunk_row(c, 16 * w + 4 * fg + r);
                if (row < RQ) p.odir[((size_t)c.dir * R + row) * 256 + c.hd * 64 + cb * 16 + fr] = f2bf(__expf(gv[r]) * o1[r] + o2[r]);
            }
            if (t < 64) sG[(cur ^ 1) * 64 + t] = gnext;
#pragma unroll
            for (int r = 0; r < 4; ++r) un[r] = unx[r];
            WAIT_VM0();
            __syncthreads();
        }
    }
}
#else
HD void ph_gdn_scan(const Params& p, int l, int bid, int nb, float* sm) {
    float* sQ = sm;
    float* sK = sm + 4096;
    bf16* sW = (bf16*)(sm + 8192);
    bf16* sQK = (bf16*)(sm + 10240);
    float* sS = sm + 12288;
    float* sV = sm + 13312;
    float* sU = sm + 14336;
    float* sG = sm + 15360;
    const int RQ = (l == 0) ? R : NLAT;
    for (int cu = bid; cu < 2 * NB * 4 * 4; cu += nb) {
        int chain = cu >> 2, cb = cu & 3;
        THREADS(t, 1024) { sS[t] = 0.f; }
        SYNC
        for (int n = 0; n < NCH; ++n) {
            int unit = chain * NCH + n;
            ChunkInfo c = chunkinfo(unit);
            THREADS(t, 64) { sG[t] = p.cG[(size_t)unit * 64 + t]; }
            SYNC
            THREADS(t, 4096) {
                int i = t >> 6, d = t & 63; int row = chunk_row(c, i);
                sW[t] = p.cW[(size_t)unit * 4096 + t];
                sQK[t] = p.cQK[(size_t)unit * 4096 + t];
                sQ[t] = bf2f(p.gq[(size_t)row * 768 + c.hd * 64 + d]) * expf(sG[i]);
                sK[t] = bf2f(p.gq[(size_t)row * 768 + 256 + c.hd * 64 + d]) * expf(sG[63] - sG[i]);
            }
            THREADS(t, 1024) { int i = t >> 4, e = t & 15; sU[t] = bf2f(p.cU[(size_t)unit * 4096 + i * 64 + cb * 16 + e]); }
            SYNC
            THREADS(t, 1024) {
                int i = t >> 4, e = t & 15;
                float acc = sU[t];
                for (int d = 0; d < 64; ++d) acc -= bf2f(sW[i * 64 + d]) * sS[d * 16 + e];
                sV[t] = acc;
            }
            SYNC
            THREADS(t, 1024) {
                int i = t >> 4, e = t & 15;
                float acc = 0.f;
                for (int d = 0; d < 64; ++d) acc += sQ[i * 64 + d] * sS[d * 16 + e];
                for (int j = 0; j < 64; ++j) acc += bf2f(sQK[i * 64 + j]) * sV[j * 16 + e];
                int row = chunk_row(c, i);
                if (row < RQ) p.odir[((size_t)c.dir * R + row) * 256 + c.hd * 64 + cb * 16 + e] = f2bf(acc);
            }
            SYNC
            THREADS(t, 1024) {
                int d = t >> 4, e = t & 15;
                float acc = sS[t] * expf(sG[63]);
                for (int i = 0; i < 64; ++i) acc += sK[i * 64 + d] * sV[i * 16 + e];
                sS[t] = acc;
            }
            SYNC
        }
    }
}

#endif

HD void ph_gdn_fin(const Params& p, int l, int bid, int nb) {
    const int RQ = (l == 0) ? R : NLAT;
    const float* og = p.in[I_ONORM] + l * 64;
    const int N = RQ * 4;
    for (int u = bid; u < (N + 255) / 256; u += nb) {
        THREADS(t, 256) {
            int idx = u * 256 + t;
            if (idx < N) {
                int r = idx >> 2, hd = idx & 3;
                const bf16* o0 = p.odir + (size_t)r * 256 + hd * 64;
                const bf16* o1 = p.odir + ((size_t)R + r) * 256 + hd * 64;
                float ss = 0.f;
                for (int d = 0; d < 64; ++d) { float v = bf2f(o0[d]) + bf2f(o1[d]); ss += v * v; }
                float rs = 1.0f / sqrtf(ss / 64.0f + 1e-6f);
                for (int d = 0; d < 64; ++d) {
                    float v = (bf2f(o0[d]) + bf2f(o1[d])) * rs * og[d];
                    float z = bf2f(p.P[(size_t)r * PLD + C_Z + hd * 64 + d]);
                    p.br[(size_t)r * D + 512 + hd * 64 + d] = f2bf(v * siluf_(z));
                }
            }
        }
    }
}

HD void ph_merge(const Params& p, int l, int bid, int nb, char* smc) {
    const int MT = ((l == 0) ? R : NLAT) / 128;
    const bf16* Wg = p.wt_in + (size_t)l * WIN_N * D + (size_t)PLD * D;
    const bf16* Wb = p.wt_br + (size_t)l * 4 * D * 256;
    for (int tile = bid; tile < MT * 16; tile += nb) {
        const int mt = tile >> 4, nt = tile & 15;
        ACC_DECL(2, accM); acc_zero(accM);
        for (int i = 0; i < 4; ++i) {
            ACC_DECL(2, accG); acc_zero(accG);
            ACC_DECL(2, accP); acc_zero(accP);
            gemm_accum<2>(accG, [&](int r) { return p.h + (size_t)(mt * 128 + r) * D; },
                          [&](int j) { return Wg + (size_t)(i * 1024 + nt * 64 + j) * D; }, D, smc);
            gemm_accum<2>(accP, [&](int r) { return p.br + (size_t)(mt * 128 + r) * D + i * 256; },
                          [&](int j) { return Wb + ((size_t)i * D + nt * 64 + j) * 256; }, 256, smc);
            ACC_FOR(2, row, col) { AV(accM) += sigmoidf_(AV(accG)) * AV(accP); } ACC_END
        }
        ACC_FOR(2, row, col) { p.mg[(size_t)(mt * 128 + row) * D + nt * 64 + col] = f2bf(AV(accM)); } ACC_END
    }
}

HD void ph_outproj(const Params& p, int l, int bid, int nb, char* smc) {
    const int MT = ((l == 0) ? R : NLAT) / 128;
    const bf16* Wt = p.wt_out + (size_t)l * D * D;
    for (int tile = bid; tile < MT * 8; tile += nb) {
        const int mt = tile >> 3, nt = tile & 7;
        ACC_DECL(4, acc); acc_zero(acc);
        gemm_accum<4>(acc, [&](int r) { return p.mg + (size_t)(mt * 128 + r) * D; }, [&](int j) { return Wt + (size_t)(nt * 128 + j) * D; }, D, smc);
        ACC_FOR(4, row, col) {
            const int r = mt * 128 + row, c = nt * 128 + col;
            xrow_out(p, r)[c] = xrow_in(p, l, r)[c] + modrow(p, l, r)[2048 + c] * AV(acc);
        } ACC_END
    }
}

HD void ph_router(const Params& p, int l, int bid, int nb, float* sm) {
    const int RQ = (l == 0) ? R : NLAT;
    const float* g = p.in[I_N2G] + l * D;
    const float* wr = p.in[I_WROUTER];
    float* sh = sm + 512;
    float* sl = sm + 2048;
    for (int r = bid; r < RQ; r += nb) {
        const float* x = xrow_out(p, r);
        const float* m = modrow(p, l, r);
        THREADS(t, 256) { float s = 0.f; for (int k = t; k < D; k += 256) s += x[k] * x[k]; sm[t] = s; }
        SYNC
        THREADS(t, 1) { float s = 0.f; for (int i = 0; i < 256; ++i) s += sm[i]; sm[256] = s; }
        SYNC
        THREADS(t, 256) {
            float rs = 1.0f / sqrtf(sm[256] / D + 1e-6f);
            for (int k = t; k < D; k += 256) {
                float v = x[k] * rs * g[k];
                v = v * (1.0f + m[4096 + k]) + m[3072 + k];
                sh[k] = v;
                p.h[(size_t)r * D + k] = f2bf(v);
            }
        }
        SYNC
        THREADS(t, 256) {
            int e = t & 15, ks = t >> 4;
            float acc = 0.f;
            for (int k = ks * 64; k < ks * 64 + 64; ++k) acc += sh[k] * wr[k * 16 + e];
            sl[ks * 16 + e] = acc;
        }
        SYNC
        THREADS(t, 1) {
            float* sc = sm + 2304; float* sel = sm + 2320;
            for (int e = 0; e < 16; ++e) {
                float acc = 0.f;
                for (int ks = 0; ks < 16; ++ks) acc += sl[ks * 16 + e];
                sc[e] = sigmoidf_(acc); sel[e] = sc[e] + p.in[I_RBIAS][e];
            }
            int best = 0; float bestv = -1e30f;
            for (int gph = 0; gph < 4; ++gph) {
                float t1 = -1e30f, t2 = -1e30f;
                for (int j = 0; j < 4; ++j) { float v = sel[gph * 4 + j]; if (v > t1) { t2 = t1; t1 = v; } else if (v > t2) t2 = v; }
                float gs = t1 + t2;
                if (gs > bestv) { bestv = gs; best = gph; }
            }
            int i1 = -1, i2 = -1; float v1 = -1e30f, v2 = -1e30f;
            for (int j = 0; j < 4; ++j) {
                float v = sel[best * 4 + j];
                if (v > v1) { v2 = v1; i2 = i1; v1 = v; i1 = best * 4 + j; } else if (v > v2) { v2 = v; i2 = best * 4 + j; }
            }
            float w1 = sc[i1], w2 = sc[i2], ws = w1 + w2;
            p.sel_e[r * 2] = i1; p.sel_e[r * 2 + 1] = i2;
            p.sel_w[r * 2] = w1 / ws; p.sel_w[r * 2 + 1] = w2 / ws;
            int q1 = ATOMIC_ADD_RET(&p.cnt[l * 16 + i1], 1); p.elist[(size_t)i1 * 2 * R + q1] = r * 2; p.apos[r * 2] = q1;
            int q2 = ATOMIC_ADD_RET(&p.cnt[l * 16 + i2], 1); p.elist[(size_t)i2 * 2 * R + q2] = r * 2 + 1; p.apos[r * 2 + 1] = q2;
        }
        SYNC
    }
}

struct MoeTiles { int tstart[17]; };
HD MoeTiles moe_tiles(const Params& p, int l) {
    MoeTiles m; int acc = 0;
    for (int e = 0; e < 16; ++e) { m.tstart[e] = acc; acc += (p.cnt[l * 16 + e] + 127) >> 7; }
    m.tstart[16] = acc; return m;
}

HD void ph_ffn1(const Params& p, int l, int bid, int nb, char* smc) {
    int tstart[17];
    { int acc = 0; for (int e = 0; e < 16; ++e) { tstart[e] = acc; acc += (p.cnt[l * 16 + e] + 127) >> 7; } tstart[16] = acc; }
    const int ntiles = tstart[16];
    for (int tile = bid; tile < ntiles * 8; tile += nb) {
        const int rt = tile >> 3, nt = tile & 7;
        int e = 0, ts = 0;
#pragma unroll
        for (int q = 1; q < 16; ++q) if (rt >= tstart[q]) { e = q; ts = tstart[q]; }
        const int mt = rt - ts;
        const int cnt_e = p.cnt[l * 16 + e];
        const int* el = p.elist + (size_t)e * 2 * R;
        const bf16* Wt = p.wt_gu + (size_t)e * 1024 * D;
        ACC_DECL(4, acc); acc_zero(acc);
        gemm_accum<4>(acc, [&](int i) { int q = mt * 128 + i; int a = (q < cnt_e) ? el[q] : el[0]; return p.h + (size_t)(a >> 1) * D; },
                      [&](int j) { return Wt + (size_t)(nt * 128 + j) * D; }, D, smc);
        ACC_FOR_PAIR(row, pcol) {
            float gv = AV_G(acc), uv = AV_U(acc);
            p.act[(size_t)(rt * 128 + row) * 512 + nt * 64 + pcol] = f2bf(siluf_(gv) * uv);
        } ACC_END
    }
}

HD void ph_ffn2(const Params& p, int l, int bid, int nb, char* smc) {
    int tstart[17];
    { int acc = 0; for (int e = 0; e < 16; ++e) { tstart[e] = acc; acc += (p.cnt[l * 16 + e] + 127) >> 7; } tstart[16] = acc; }
    const int ntiles = tstart[16];
    for (int tile = bid; tile < ntiles * 8; tile += nb) {
        const int rt = tile >> 3, nt = tile & 7;
        int e = 0;
#pragma unroll
        for (int q = 1; q < 16; ++q) if (rt >= tstart[q]) e = q;
        const bf16* Wt = p.wt_d + (size_t)e * D * 512;
        ACC_DECL(4, acc); acc_zero(acc);
        gemm_accum<4>(acc, [&](int i) { return p.act + (size_t)(rt * 128 + i) * 512; }, [&](int j) { return Wt + (size_t)(nt * 128 + j) * 512; }, 512, smc);
        ACC_FOR(4, row, col) { p.Y[(size_t)(rt * 128 + row) * D + nt * 128 + col] = f2bf(AV(acc)); } ACC_END
    }
}

HD void ph_combine(const Params& p, int l, int bid, int nb) {
    const int RQ = (l == 0) ? R : NLAT;
    int tstart[17];
    { int acc = 0; for (int e = 0; e < 16; ++e) { tstart[e] = acc; acc += (p.cnt[l * 16 + e] + 127) >> 7; } tstart[16] = acc; }
    for (int r = bid; r < RQ; r += nb) {
        float* xo = xrow_out(p, r);
        const float* m = modrow(p, l, r);
        int e0 = p.sel_e[r * 2], e1 = p.sel_e[r * 2 + 1];
        int t0 = 0, t1 = 0;
#pragma unroll
        for (int q = 0; q < 16; ++q) { if (q == e0) t0 = tstart[q]; if (q == e1) t1 = tstart[q]; }
        const bf16* y0 = p.Y + (size_t)(t0 * 128 + p.apos[r * 2]) * D;
        const bf16* y1 = p.Y + (size_t)(t1 * 128 + p.apos[r * 2 + 1]) * D;
        const float w0 = p.sel_w[r * 2], w1 = p.sel_w[r * 2 + 1];
        THREADS(t, 256) {
            for (int k = t; k < D; k += 256) xo[k] += m[5120 + k] * (w0 * bf2f(y0[k]) + w1 * bf2f(y1[k]));
        }
    }
}

constexpr int NPHASE_LAYER = 14;
HD void run_phase(const Params& p, int ph, int l, int bid, int nb, float* sm) {
    switch (ph) {
        case 0: ph_norm1(p, l, bid, nb, sm); break;
        case 1: ph_inproj(p, l, bid, nb, (char*)sm); break;
        case 2: ph_prep(p, l, bid, nb); if (FOURIER_GEMM) ph_fourier_s1(p, bid, nb, (char*)sm); break;
        case 3: ph_na(p, l, bid, nb, (char*)sm); break;
        case 4: ph_da(p, l, bid, nb, (char*)sm); break;
        case 5: ph_gdn_chunk(p, l, bid, nb, sm); break;
        case 6: ph_fourier2(p, l, bid, nb); if (FOURIER_GEMM) ph_fourier_sA(p, bid, nb, (char*)sm); break;
        case 7: ph_gdn_scan(p, l, bid, nb, sm); if (FOURIER_GEMM) ph_fourier_sB(p, bid, nb, (char*)sm); if (l == 1) convert_moe(p, 1, bid, nb, sm); break;
        case 8: ph_gdn_fin(p, l, bid, nb); break;
        case 9: ph_merge(p, l, bid, nb, (char*)sm); break;
        case 10: ph_outproj(p, l, bid, nb, (char*)sm); break;
        case 11: ph_router(p, l, bid, nb, sm); break;
        case 12: ph_ffn1(p, l, bid, nb, (char*)sm); break;
        case 13: ph_ffn2(p, l, bid, nb, (char*)sm); break;
        case 14: ph_combine(p, l, bid, nb); break;
        default: break;
    }
}

struct WsLayout { size_t bar, fa2, fW1, fWA, fWB, mods, cosT, sinT, cs, gg, gbeta, sel_e, sel_w, cnt, elist, apos, cG, wt_in, wt_br, wt_out, wt_gu, wt_d,
                  h, P, gq, fcs, cU, cW, cQK, odir, br, mg, act, Y, total; };
inline WsLayout ws_layout() {
    WsLayout w; size_t o = 0;
    auto take = [&](size_t bytes) { size_t r = o; o += (bytes + 255) & ~(size_t)255; return r; };
    w.bar = take(3456 * 4);
    w.mods = take(2 * 3 * 6144 * 4); w.cosT = take(SEQ * 4); w.sinT = take(SEQ * 4); w.cs = take((size_t)NCTX * D * 4);
    w.gg = take((size_t)8 * R * 4); w.gbeta = take((size_t)8 * R * 4); w.sel_e = take((size_t)R * 2 * 4); w.sel_w = take((size_t)R * 2 * 4);
    w.cnt = take(32 * 4); w.elist = take((size_t)16 * 2 * R * 4); w.apos = take((size_t)2 * R * 4); w.cG = take((size_t)NUNIT * 64 * 4);
    w.wt_in = take((size_t)2 * WIN_N * D * 2); w.wt_br = take((size_t)2 * 4 * D * 256 * 2); w.wt_out = take((size_t)2 * D * D * 2);
    w.wt_gu = take((size_t)16 * 1024 * D * 2); w.wt_d = take((size_t)16 * D * 512 * 2);
    w.h = take((size_t)R * D * 2);
    w.fa2 = take((size_t)NB * 128 * 256 * 2 * 64 * 2); w.fW1 = take(8192 * 2); w.fWA = take(65536 * 2); w.fWB = take(8192 * 2);
    {
        const size_t szP = ((size_t)R * PLD * 2 + 255) & ~(size_t)255, szQ = ((size_t)R * 768 * 2 + 255) & ~(size_t)255;
        const size_t szA = ((size_t)PADROWS * 512 * 2 + 255) & ~(size_t)255, szY = ((size_t)PADROWS * 1024 * 2 + 255) & ~(size_t)255;
        const size_t base = take((szP + szQ) > (szA + szY) ? (szP + szQ) : (szA + szY));
        w.P = base; w.gq = base + szP; w.act = base; w.Y = base + szA;
    }
    w.fcs = take((size_t)R * 512 * 2);
    w.cU = take((size_t)NUNIT * 4096 * 2); w.cW = take((size_t)NUNIT * 4096 * 2); w.cQK = take((size_t)NUNIT * 4096 * 2);
    w.odir = take((size_t)2 * R * 256 * 2); w.br = take((size_t)R * D * 2);
    w.mg = w.cU;
    w.total = o;
    return w;
}
inline void fill_params(Params& p, void* const* d_in, void* d_out, void* d_ws) {
    WsLayout w = ws_layout(); char* b = (char*)d_ws;
    for (int i = 0; i < 30; ++i) p.in[i] = (const float*)d_in[i];
    p.out = (float*)d_out;
    p.mods = (float*)(b + w.mods); p.cosT = (float*)(b + w.cosT); p.sinT = (float*)(b + w.sinT); p.cs = (float*)(b + w.cs);
    p.h = (bf16*)(b + w.h); p.P = (bf16*)(b + w.P); p.gq = (bf16*)(b + w.gq); p.gg = (float*)(b + w.gg); p.gbeta = (float*)(b + w.gbeta);
    p.fcs = (bf16*)(b + w.fcs); p.cU = (bf16*)(b + w.cU); p.cW = (bf16*)(b + w.cW); p.cQK = (bf16*)(b + w.cQK); p.cG = (float*)(b + w.cG);
    p.odir = (bf16*)(b + w.odir); p.br = (bf16*)(b + w.br); p.mg = (bf16*)(b + w.mg); p.sel_e = (int*)(b + w.sel_e);
    p.sel_w = (float*)(b + w.sel_w); p.act = (bf16*)(b + w.act); p.Y = (bf16*)(b + w.Y);
    p.wt_in = (bf16*)(b + w.wt_in); p.wt_br = (bf16*)(b + w.wt_br); p.wt_out = (bf16*)(b + w.wt_out); p.wt_gu = (bf16*)(b + w.wt_gu);
    p.fa2 = (bf16*)(b + w.fa2); p.fW1 = (bf16*)(b + w.fW1); p.fWA = (bf16*)(b + w.fWA); p.fWB = (bf16*)(b + w.fWB);
    p.bar = (unsigned*)(b + w.bar);
    p.wt_d = (bf16*)(b + w.wt_d); p.cnt = (int*)(b + w.cnt); p.elist = (int*)(b + w.elist); p.apos = (int*)(b + w.apos);
}

#if !defined(CPU_EMU) && defined(PHASE_KERNELS)
#define PK(n) __global__ void __launch_bounds__(256, 2) pk_##n(Params p) { __shared__ __attribute__((aligned(16))) float sm[SMEM_FLOATS]; run_phase(p, n, p.layer, blockIdx.x, gridDim.x, sm); }
PK(0) PK(1) PK(2) PK(3) PK(4) PK(5) PK(6) PK(7) PK(8) PK(9) PK(10) PK(11) PK(12) PK(13) PK(14)
__global__ void __launch_bounds__(256, 2) pk_init(Params p) { __shared__ __attribute__((aligned(16))) float sm[SMEM_FLOATS]; ph_init(p, blockIdx.x, gridDim.x, sm); }
#endif
#ifndef CPU_EMU

#define XB_TMO      128
#define XB_XCNT(j)  (256  + 64 * (j))
#define XB_XSUB(j)  (1280 + 64 * (j))
#define XB_XGEN(j)  (2304 + 64 * (j))
#define XB_TOP      3328
#define XB_TOPGEN   3392
#define XCD_BAR_WORDS 3456
#define XB_SPIN_CAP (1u << 22)
#define LAS __attribute__((address_space(3)))
__device__ __forceinline__ unsigned xb_ld(unsigned* p)              { return __hip_atomic_load(p, __ATOMIC_RELAXED, __HIP_MEMORY_SCOPE_AGENT); }
__device__ __forceinline__ unsigned xb_add(unsigned* p, unsigned v) { return __hip_atomic_fetch_add(p, v, __ATOMIC_RELAXED, __HIP_MEMORY_SCOPE_AGENT); }
__device__ __forceinline__ unsigned xb_xcc_id() { return (unsigned)__builtin_amdgcn_s_getreg((3 << 11) | 20) & 0xFu; }
#define XB_SPIN(cond, bar) do { unsigned _sp = 0; while (cond) { __builtin_amdgcn_s_sleep(1); \
    if ((++_sp & 255u) == 0u) { if (xb_ld(&(bar)[XB_TMO])) break; if (_sp > XB_SPIN_CAP) { atomicAdd(&(bar)[XB_TMO], 1u); break; } } } } while (0)
struct XcdBarrier { unsigned* bar; unsigned x; volatile LAS unsigned* st; };
__device__ __forceinline__ XcdBarrier xcd_barrier_post(unsigned* bar, volatile LAS unsigned* st) {
    XcdBarrier b; b.bar = bar; b.x = xb_xcc_id(); b.st = st;
    if (threadIdx.x == 0) (void)xb_add(&bar[XB_XCNT(b.x)], 1u);
    return b;
}
__device__ __forceinline__ void xcd_barrier_complete(unsigned* bar, unsigned x, unsigned& nloc, unsigned& nx) {
    const unsigned G = gridDim.x * gridDim.y * gridDim.z;
    unsigned sum, cnt, mine, sp = 0u;
    for (;;) {
        sum = 0u; cnt = 0u; mine = 0u;
#pragma unroll
        for (unsigned j = 0; j < 16; ++j) { const unsigned c = xb_ld(&bar[XB_XCNT(j)]); sum += c; cnt += (c > 0u) ? 1u : 0u; mine = (j == x) ? c : mine; }
        if (sum == G) break;
        __builtin_amdgcn_s_sleep(1);
        if ((++sp & 255u) == 0u) { if (xb_ld(&bar[XB_TMO])) break; if (sp > XB_SPIN_CAP) { atomicAdd(&bar[XB_TMO], 1u); break; } }
    }
    nloc = mine > 0u ? mine : 1u; nx = cnt > 0u ? cnt : 1u;
}
__device__ __forceinline__ void xcd_barrier(const XcdBarrier& b) {
    asm volatile("s_waitcnt vmcnt(0)" ::: "memory");
    __syncthreads();
    if (threadIdx.x == 0) {
        unsigned* bar = b.bar;
        __builtin_amdgcn_s_waitcnt(0);
        unsigned nloc = b.st[0], nx = b.st[1];
        if (nloc == 0u) { xcd_barrier_complete(bar, b.x, nloc, nx); b.st[0] = nloc; b.st[1] = nx; }
        const unsigned old = xb_add(&bar[XB_XSUB(b.x)], 1u);
        const unsigned gen = old / nloc;
        if (old + 1u == (gen + 1u) * nloc) {
            __builtin_amdgcn_fence(__ATOMIC_RELEASE, "agent");
            asm volatile("s_waitcnt vmcnt(0)" ::: "memory");
            const unsigned og = xb_add(&bar[XB_TOP], 1u);
            const unsigned tg = og / nx;
            if (og + 1u == (tg + 1u) * nx) xb_add(&bar[XB_TOPGEN], 1u);
            else XB_SPIN(xb_ld(&bar[XB_TOPGEN]) == tg, bar);
            __builtin_amdgcn_fence(__ATOMIC_ACQUIRE, "agent");
            xb_add(&bar[XB_XGEN(b.x)], 1u);
            asm volatile("s_waitcnt vmcnt(0)" ::: "memory");
        } else {
            XB_SPIN(xb_ld(&bar[XB_XGEN(b.x)]) == gen, bar);
            __builtin_amdgcn_fence(__ATOMIC_ACQUIRE, "agent");
            asm volatile("s_waitcnt vmcnt(0)" ::: "memory");
        }
    }
    __syncthreads();
}

__global__ void __launch_bounds__(256, 2) fwd_megakernel(Params p) {
    __shared__ __attribute__((aligned(16))) float sm[SMEM_FLOATS];
    cg::grid_group grid = cg::this_grid();
    const int bid = blockIdx.x, nb = gridDim.x;
    volatile LAS unsigned* xst = (volatile LAS unsigned*)(sm + SMEM_FLOATS - 4);
    if (threadIdx.x == 0) { xst[0] = 0u; xst[1] = 0u; }
    __syncthreads();
    XcdBarrier xb = xcd_barrier_post(p.bar, xst);
    ph_init(p, bid, nb, sm);
    grid.sync();
#define PH(n, l) run_phase(p, n, l, bid, nb, sm); xcd_barrier(xb);
#ifndef PROBE_X
#define PROBE_X(n, l)
#endif
#define LAYER(l) PH(0, l) PROBE_X(0, l) PH(1, l) PROBE_X(1, l) PH(2, l) PH(3, l) PROBE_X(3, l) PH(4, l) PROBE_X(4, l) PH(5, l) PROBE_X(5, l) \
    PH(6, l) PROBE_X(6, l) PH(7, l) PROBE_X(7, l) PH(8, l) PROBE_X(8, l) PH(9, l) PROBE_X(9, l) PH(10, l) PH(11, l) PH(12, l) PROBE_X(12, l) \
    PH(13, l) PROBE_X(13, l) PH(14, l)
    LAYER(0)
    LAYER(1)
}

extern "C" void kernel_launch(void* const* d_in, const int* in_sizes, int n_in, void* d_out, int out_size,
                              void* d_ws, size_t ws_size, hipStream_t stream) {
    WsLayout w = ws_layout();
    if (ws_size < w.total) { fprintf(stderr, "ws too small: need %zu have %zu\n", w.total, ws_size); return; }
    static int grid_blocks = 0;
    if (!grid_blocks) {
        int dev = 0, cus = 0, per_cu = 0;
        (void)hipGetDevice(&dev);
        (void)hipDeviceGetAttribute(&cus, hipDeviceAttributeMultiprocessorCount, dev);
        (void)hipOccupancyMaxActiveBlocksPerMultiprocessor(&per_cu, fwd_megakernel, 256, 0);
        if (per_cu < 1) per_cu = 1;
        grid_blocks = cus * per_cu;
    }
    Params p{};
    fill_params(p, d_in, d_out, d_ws);
    (void)hipMemsetAsync(p.bar, 0, XCD_BAR_WORDS * 4, stream);
    void* args[] = {&p};
    hipError_t e = hipLaunchCooperativeKernel((void*)fwd_megakernel, dim3(grid_blocks), dim3(256), args, 0, stream);
    if (e != hipSuccess) fprintf(stderr, "cooperative launch failed: %s (grid %d)\n", hipGetErrorString(e), grid_blocks);
}
#endif
```

```cpp
#ifndef CPU_EMU
#include <hip/hip_runtime.h>
#include <hip/hip_cooperative_groups.h>
#include <cstdio>
namespace cg = cooperative_groups;
#define HD __device__ __forceinline__
__device__ __forceinline__ int tid_() { int v = threadIdx.x; asm volatile("" : "+v"(v)); return v; }
#define THREADS(t, n) for (int t = tid_(); t < (n); t += 256)
#define SYNC __syncthreads();
#define COSPI(x) cospif(x)
#define SINPI(x) sinpif(x)
typedef float4 f4;
#else
#include <cmath>
#include <cstdio>
#include <cstring>
#include <cstddef>
#define HD inline
#define THREADS(t, n) for (int t = 0; t < (n); ++t)
#define SYNC
#define COSPI(x) ((float)cos(M_PI * (double)(x)))
#define SINPI(x) ((float)sin(M_PI * (double)(x)))
struct f4 { float x, y, z, w; };
#endif

#ifndef SEQ
#define SEQ 8192
#endif
#ifndef CTXL
#define CTXL 256
#endif

typedef unsigned short bf16;
#ifndef CPU_EMU
typedef __attribute__((ext_vector_type(8))) short bf16x8_t;
typedef __attribute__((ext_vector_type(4))) float f32x4_t;
typedef __attribute__((ext_vector_type(4))) int i32x4_t;
#define ATOMIC_ADD_RET(ptr, v) atomicAdd((ptr), (v))
#else
HD int atomic_add_ret_(int* p, int v) { int old;
#pragma omp atomic capture
    { old = *p; *p += v; }
    return old; }
#define ATOMIC_ADD_RET(ptr, v) atomic_add_ret_((ptr), (v))
#endif
constexpr int NB = 2, D = 1024, GW = 64, ROWS = SEQ / GW;
constexpr int NLAT = NB * SEQ, NCTX = NB * CTXL, R = NLAT + NCTX;
constexpr int DIN = 6928;
constexpr int PLD = 2816;
constexpr int C_NAQ = 0, C_NAK = 256, C_NAV = 512, C_DAQ = 768, C_DAK = 1024, C_DAV = 1280, C_GQ = 1536, C_Z = 2304,
              C_F = 2560;
constexpr int WIN_N = 6912;
constexpr int WIN_NP = WIN_N + 64;
constexpr int PADROWS = 2 * R + 16 * 128;
constexpr int NCC = CTXL / 64, NCL = SEQ / 64, NCH = NCC + NCL;
constexpr int NUNIT = 2 * NB * 4 * NCH;
constexpr bool FOURIER_GEMM = (SEQ == 8192);
constexpr int SMEM_FLOATS = 73 * 256 + 4;

struct Params {
    const float* in[30];
    float* out;
    float* mods;
    float* cosT;
    float* sinT;
    float* cs;
    bf16* h;
    bf16* P;
    bf16* gq;
    float* gg;
    float* gbeta;
    bf16* fcs;
    bf16* cU;
    bf16* cW;
    bf16* cQK;
    float* cG;
    bf16* odir;
    bf16* br;
    bf16* mg;
    int* sel_e;
    float* sel_w;
    bf16* act;
    bf16* Y;
    bf16* wt_in;
    bf16* wt_br;
    bf16* wt_out;
    bf16* wt_gu;
    bf16* wt_d;
    int* cnt;
    unsigned* bar;
    bf16* fa2;
    bf16* fW1;
    float* ropeT;
    bf16* fWA;
    bf16* fWB;
    int* elist;
    int* apos;
    int phase;
    int layer;
};

enum { I_X = 0, I_C, I_CTX, I_CCTX, I_WMOD, I_BMOD, I_N1G, I_N2G, I_WIN, I_NAQG, I_NAKG, I_RPB, I_DAQG, I_DAKG, I_LQ1, I_LK1,
       I_LQ2, I_LK2, I_SUBLN, I_CONVW, I_ALOG, I_DTB, I_ONORM, I_WBR, I_WOUT, I_WROUTER, I_RBIAS, I_MG, I_MU, I_MD };

HD float bf2f(bf16 v) { union { unsigned u; float f; } x; x.u = ((unsigned)v) << 16; return x.f; }
#ifndef CPU_EMU
typedef float f32x2_t __attribute__((ext_vector_type(2))); typedef __bf16 bf16x2_t __attribute__((ext_vector_type(2)));
typedef short s16x4_t __attribute__((ext_vector_type(4)));
typedef __attribute__((address_space(3))) const char* lds_cptr;
HD unsigned cvtpk(float lo, float hi) { f32x2_t v = {lo, hi}; bf16x2_t b = __builtin_convertvector(v, bf16x2_t); return __builtin_bit_cast(unsigned, b); }
HD bf16 f2bf(float f) { return (bf16)(cvtpk(f, 0.f) & 0xffffu); }
HD s16x4_t lds_tr16(lds_cptr p) { return __builtin_bit_cast(s16x4_t, __builtin_amdgcn_ds_read_tr16_b64_v4i16((__attribute__((address_space(3))) s16x4_t*)p)); }
#else
HD bf16 f2bf(float f) { union { unsigned u; float f; } x; x.f = f; unsigned u = x.u; u += 0x7fffu + ((u >> 16) & 1u); return (bf16)(u >> 16); }
#endif
HD float sigmoidf_(float x) { return 1.0f / (1.0f + expf(-x)); }
HD float siluf_(float x) { return x / (1.0f + expf(-x)); }

struct RowInfo { int seg, b, t, T, base; };
HD RowInfo rowinfo(int r) {
    RowInfo q;
    if (r < NLAT) { q.seg = 0; q.b = r / SEQ; q.t = r % SEQ; q.T = SEQ; q.base = q.b * SEQ; }
    else { int r2 = r - NLAT; q.seg = 1; q.b = r2 / CTXL; q.t = r2 % CTXL; q.T = CTXL; q.base = NLAT + q.b * CTXL; }
    return q;
}
HD const float* xrow_in(const Params& p, int l, int r) {
    if (r < NLAT) return (l == 0 ? p.in[I_X] : p.out) + (size_t)r * D;
    return p.cs + (size_t)(r - NLAT) * D;
}
HD float* xrow_out(const Params& p, int r) {
    if (r < NLAT) return p.out + (size_t)r * D;
    return p.cs + (size_t)(r - NLAT) * D;
}
HD const float* modrow(const Params& p, int l, int r) {
    int s = (r < NLAT) ? (r / SEQ) : 2;
    return p.mods + (size_t)(l * 3 + s) * 6144;
}
HD float lam_init_of(int l) { return l == 0 ? 0.2f : (0.8f - 0.6f * 0.7408182206817179f); }


#ifndef CPU_EMU
template <int NJ> struct AccT { f32x4_t v[4][NJ]; };
#define ACC_DECL(NJ, a) AccT<NJ> a
template <int NJ> HD void acc_zero(AccT<NJ>& a) {
#pragma unroll
    for (int i = 0; i < 4; ++i)
#pragma unroll
        for (int j = 0; j < NJ; ++j) a.v[i][j] = f32x4_t{0.f, 0.f, 0.f, 0.f};
}
#define ACC_FOR(NJ, row, col) { const int _t = tid_(); const int _ln = _t & 63, _w = _t >> 6; \
    _Pragma("unroll") for (int _i = 0; _i < 4; ++_i) _Pragma("unroll") for (int _j = 0; _j < NJ; ++_j) _Pragma("unroll") for (int _r = 0; _r < 4; ++_r) { \
    const int row = (_w >> 1) * 64 + _i * 16 + (_ln >> 4) * 4 + _r; const int col = (_w & 1) * (16 * NJ) + _j * 16 + (_ln & 15);
#define AV(a) a.v[_i][_j][_r]
#define ACC_END }}
#define ACC_FOR_PAIR(row, pcol) { const int _t = tid_(); const int _ln = _t & 63, _w = _t >> 6; \
    _Pragma("unroll") for (int _i = 0; _i < 4; ++_i) _Pragma("unroll") for (int _jj = 0; _jj < 2; ++_jj) _Pragma("unroll") for (int _r = 0; _r < 4; ++_r) { \
    const int row = (_w >> 1) * 64 + _i * 16 + (_ln >> 4) * 4 + _r; const int pcol = (_w & 1) * 32 + _jj * 16 + (_ln & 15);
#define AV_G(a) a.v[_i][2 * _jj][_r]
#define AV_U(a) a.v[_i][2 * _jj + 1][_r]

#define WAIT_VM0() asm volatile("s_waitcnt vmcnt(0)" ::: "memory")
#define GLDS16(gp, lp) __builtin_amdgcn_global_load_lds((const unsigned*)(gp), (unsigned*)(lp), 16, 0, 0)
template <int NJ, class AF, class BF>
HD void gemm_accum(AccT<NJ>& acc, AF arow, BF brow, int K, char* smem) {
    constexpr int NBL = NJ;
    const int t = tid_(), lane = t & 63, w = t >> 6, wr = w >> 1, wc = w & 1;
    const int lr = t >> 3, lc = t & 7;
    const bf16* ap[4]; const bf16* bp[NBL];
#pragma unroll
    for (int i = 0; i < 4; ++i) ap[i] = arow(lr + 32 * i) + ((lc ^ (lr & 7)) << 3);
#pragma unroll
    for (int i = 0; i < NBL; ++i) bp[i] = brow(lr + 32 * i) + ((lc ^ (lr & 7)) << 3);
    char* sA = smem + w * 1024; char* sB = smem + 32768 + w * 1024;
    const int fr = lane & 15, fg = lane >> 4;
    const unsigned aoff0 = (wr * 64 + fr) * 128 + (((fg) ^ (fr & 7)) << 4);
    const unsigned aoff1 = (wr * 64 + fr) * 128 + (((4 + fg) ^ (fr & 7)) << 4);
    const unsigned boff0 = (wc * (16 * NJ) + fr) * 128 + (((fg) ^ (fr & 7)) << 4);
    const unsigned boff1 = (wc * (16 * NJ) + fr) * 128 + (((4 + fg) ^ (fr & 7)) << 4);
    const int KT = K >> 6;
    __syncthreads();
#pragma unroll
    for (int i = 0; i < 4; ++i) GLDS16(ap[i], sA + 4096 * i);
#pragma unroll
    for (int i = 0; i < NBL; ++i) GLDS16(bp[i], sB + 4096 * i);
    WAIT_VM0();
    __syncthreads();
#pragma unroll 1
    for (int kt = 0; kt < KT; ++kt) {
        const int cur = kt & 1;
        if (kt + 1 < KT) {
#pragma unroll
            for (int i = 0; i < 4; ++i) GLDS16(ap[i] + (kt + 1) * 64, sA + (cur ^ 1) * 16384 + 4096 * i);
#pragma unroll
            for (int i = 0; i < NBL; ++i) GLDS16(bp[i] + (kt + 1) * 64, sB + (cur ^ 1) * 16384 + 4096 * i);
        }
        const char* cA = smem + cur * 16384; const char* cB = smem + 32768 + cur * 16384;
#pragma unroll
        for (int s = 0; s < 2; ++s) {
            bf16x8_t af[4], bfr[NJ];
#pragma unroll
            for (int i = 0; i < 4; ++i) af[i] = *(const bf16x8_t*)(cA + (s ? aoff1 : aoff0) + i * 2048);
#pragma unroll
            for (int j = 0; j < NJ; ++j) bfr[j] = *(const bf16x8_t*)(cB + (s ? boff1 : boff0) + j * 2048);
#pragma unroll
            for (int i = 0; i < 4; ++i)
#pragma unroll
                for (int j = 0; j < NJ; ++j) acc.v[i][j] = __builtin_amdgcn_mfma_f32_16x16x32_bf16(af[i], bfr[j], acc.v[i][j], 0, 0, 0);
        }
        WAIT_VM0();
        __syncthreads();
    }
}
template <int NJ> HD void acc_to_lds(const AccT<NJ>& acc, float* tl) {
    const int t = tid_(), lane = t & 63, w = t >> 6;
    constexpr int LD = 32 * NJ + 4;
    float* base = tl + ((w >> 1) * 64 + (lane >> 4) * 4) * LD + (w & 1) * (16 * NJ) + (lane & 15);
#pragma unroll
    for (int i = 0; i < 4; ++i)
#pragma unroll
        for (int j = 0; j < NJ; ++j)
#pragma unroll
            for (int r = 0; r < 4; ++r) base[(i * 16 + r) * LD + j * 16] = acc.v[i][j][r];
}
#else
template <int NJ> struct AccT { float v[128][32 * NJ]; };
#define ACC_DECL(NJ, a) static thread_local AccT<NJ> a
template <int NJ> HD void acc_zero(AccT<NJ>& a) { memset(a.v, 0, sizeof(a.v)); }
#define ACC_FOR(NJ, row, col) { for (int row = 0; row < 128; ++row) for (int col = 0; col < 32 * NJ; ++col) {
#define AV(a) a.v[row][col]
#define ACC_END }}
#define ACC_FOR_PAIR(row, pcol) { for (int row = 0; row < 128; ++row) for (int pcol = 0; pcol < 64; ++pcol) {
#define AV_G(a) a.v[row][(pcol / 16) * 32 + (pcol % 16)]
#define AV_U(a) a.v[row][(pcol / 16) * 32 + 16 + (pcol % 16)]
template <int NJ, class AF, class BF>
HD void gemm_accum(AccT<NJ>& acc, AF arow, BF brow, int K, char* smem) {
    for (int i = 0; i < 128; ++i) { const bf16* a = arow(i);
        for (int j = 0; j < 32 * NJ; ++j) { const bf16* b = brow(j); float s = 0.f;
            for (int k = 0; k < K; ++k) s += bf2f(a[k]) * bf2f(b[k]);
            acc.v[i][j] += s; } }
}
#endif

template <class DF>
HD void conv_tile(const float* src, size_t lds_, bf16* dst, size_t ldd, int k0, int nsrc0, DF drow, float* sm) {
    THREADS(t, 4096) { int kk = t >> 6, nn = t & 63; sm[kk * 65 + nn] = src[(size_t)(k0 + kk) * lds_ + nsrc0 + nn]; }
    SYNC
    THREADS(t, 4096) { int nn = t >> 6, kk = t & 63; dst[(size_t)drow(nn) * ldd + k0 + kk] = f2bf(sm[kk * 65 + nn]); }
    SYNC
}
HD void convert_moe(const Params& p, int l, int bid, int nb, float* sm) {
    for (int w = bid; w < 4096 + 2048; w += nb) {
        if (w < 4096) {
            int nt = w & 7, kt = (w >> 3) & 15, gu = (w >> 7) & 1, e = w >> 8;
            const float* src = p.in[gu ? I_MU : I_MG] + (size_t)(l * 16 + e) * D * 512;
            bf16* dst = p.wt_gu + (size_t)e * 1024 * D;
            conv_tile(src, 512, dst, D, kt * 64, nt * 64, [&](int nn) { int j = nt * 64 + nn; return (j >> 4) * 32 + (j & 15) + 16 * gu; }, sm);
        } else {
            int w2 = w - 4096; int nt = w2 & 15, kt = (w2 >> 4) & 7, e = w2 >> 7;
            const float* src = p.in[I_MD] + (size_t)(l * 16 + e) * 512 * D;
            bf16* dst = p.wt_d + (size_t)e * D * 512;
            conv_tile(src, D, dst, 512, kt * 64, nt * 64, [&](int nn) { return nt * 64 + nn; }, sm);
        }
    }
}
HD void convert_static(const Params& p, int bid, int nb, float* sm) {
    for (int w = bid; w < 3456 + 512 + 512 + 32; w += nb) {
        if (w >= 3456 + 512 + 512) {
            int w2 = w - 3456 - 512 - 512; int kt = w2 & 15, l = w2 >> 4;
            conv_tile(p.in[I_WIN] + (size_t)l * D * DIN, DIN, p.wt_in + (size_t)l * WIN_NP * D, D, kt * 64, 2560, [&](int nn) { return WIN_N + nn; }, sm);
        } else if (w < 3456) {
            int nt = w % 108, kt = (w / 108) & 15, l = w / (108 * 16);
            int n0 = nt * 64;
            conv_tile(p.in[I_WIN] + (size_t)l * D * DIN, DIN, p.wt_in + (size_t)l * WIN_NP * D, D, kt * 64, n0 < 2560 ? n0 : n0 + 16,
                      [&](int nn) { return n0 + nn; }, sm);
        } else if (w < 3456 + 512) {
            int w2 = w - 3456; int nt = w2 & 15, kt = (w2 >> 4) & 3, li = w2 >> 6;
            conv_tile(p.in[I_WBR] + (size_t)li * 256 * D, D, p.wt_br + (size_t)li * D * 256, 256, kt * 64, nt * 64, [&](int nn) { return nt * 64 + nn; }, sm);
        } else {
            int w2 = w - 3456 - 512; int nt = w2 & 15, kt = (w2 >> 4) & 15, l = w2 >> 8;
            conv_tile(p.in[I_WOUT] + (size_t)l * D * D, D, p.wt_out + (size_t)l * D * D, D, kt * 64, nt * 64, [&](int nn) { return nt * 64 + nn; }, sm);
        }
    }
}

HD void init_tables(const Params& p, int bid, int nb) {
    for (int u = bid; u < (SEQ + 255) / 256; u += nb) {
        THREADS(t, 256) {
            int j = u * 256 + t;
            if (j < SEQ) { float a = 2.0f * (float)j / (float)SEQ; p.cosT[j] = COSPI(a); p.sinT[j] = SINPI(a); }
        }
    }
    if (bid == 0) {
        THREADS(t, 1024) {
            int pos = t >> 3, f = t & 7; float fr_ = 1.0f;
            for (int q = 0; q < f; ++q) fr_ *= 0.31622776601683794f;
            float ang = (float)pos * fr_;
            p.ropeT[t * 2] = cosf(ang); p.ropeT[t * 2 + 1] = sinf(ang);
        }
    }
    for (int u = bid; u < (8192 + 65536 + 8192) / 256; u += nb) {
        THREADS(t, 256) {
            int i = u * 256 + t;
            if (i < 8192) {
                int j = i >> 6, c = i & 63; int cs = j >> 6, m = j & 63;
                float a = 2.0f * (float)((m * c) & 63) / 64.0f;
                p.fW1[i] = f2bf(cs ? SINPI(a) : COSPI(a));
            } else if (i < 8192 + 65536) {
                int q = i - 8192; int n = q >> 8, k = q & 255;
                int ri = (n >> 4) & 1, k1 = (n >> 5) * 16 + (n & 15); int cs = k >> 7, t1 = k & 127;
                float a = 2.0f * (float)((k1 * t1) & 127) / 128.0f;
                float cv = COSPI(a), sv = SINPI(a);
                float v = (ri == 0) ? (cs == 0 ? cv : -sv) : (cs == 0 ? -sv : -cv);
                p.fWA[q] = f2bf(v);
            } else {
                int q = i - 8192 - 65536; int k2 = q >> 7, k = q & 127; int ri = k >> 6, t2 = k & 63;
                float a = 2.0f * (float)((k2 * t2) & 63) / 64.0f;
                p.fWB[q] = f2bf(ri ? SINPI(a) : COSPI(a));
            }
        }
    }
}

HD void ph_init(const Params& p, int bid, int nb, float* sm) {
    const int NMOD = 2 * 3 * 6144;
    if (bid == 0) { THREADS(t, 32) { p.cnt[t] = 0; } }
    convert_static(p, bid, nb, sm);
    convert_moe(p, 0, bid, nb, sm);
    for (int u = bid; u < (NMOD + 255) / 256; u += nb) {
        THREADS(t, 256) {
            int idx = u * 256 + t;
            if (idx < NMOD) {
                int l = idx / (3 * 6144), s = (idx / 6144) % 3, col = idx % 6144;
                const float* cv = (s < 2) ? p.in[I_C] + s * D : p.in[I_CCTX];
                const float* w = p.in[I_WMOD] + (size_t)l * D * 6144 + col;
                float acc = 0.f;
                for (int k = 0; k < D; ++k) acc += siluf_(cv[k]) * w[(size_t)k * 6144];
                p.mods[idx] = acc + p.in[I_BMOD][l * 6144 + col];
            }
        }
    }
    init_tables(p, bid, nb);
    for (int u = bid; u < (NCTX * D) / 256; u += nb) {
        THREADS(t, 256) { int i = u * 256 + t; p.cs[i] = p.in[I_CTX][i]; }
    }

}

#ifndef CPU_EMU
HD float wave_sum(float v) {
#pragma unroll
    for (int o = 32; o >= 1; o >>= 1) v += __shfl_xor(v, o);
    return v;
}
HD void ph_norm1(const Params& p, int l, int bid, int nb, float* sm) {
    const int t = tid_(), lane = t & 63, w = t >> 6;
    const float* g = p.in[I_N1G] + l * D;
    for (int r = bid * 4 + w; r < R; r += nb * 4) {
        const float* x = xrow_in(p, l, r);
        const float* m = modrow(p, l, r);
        f32x4_t xv[4]; float ss = 0.f;
#pragma unroll
        for (int j = 0; j < 4; ++j) { xv[j] = *(const f32x4_t*)(x + j * 256 + lane * 4); ss += xv[j][0] * xv[j][0] + xv[j][1] * xv[j][1] + xv[j][2] * xv[j][2] + xv[j][3] * xv[j][3]; }
        ss = wave_sum(ss);
        const float rs = 1.0f / sqrtf(ss / D + 1e-6f);
#pragma unroll
        for (int j = 0; j < 4; ++j) {
            const int k = j * 256 + lane * 4;
            const f32x4_t gv = *(const f32x4_t*)(g + k), sc = *(const f32x4_t*)(m + 1024 + k), sh = *(const f32x4_t*)(m + k);
            float o[4];
#pragma unroll
            for (int q = 0; q < 4; ++q) o[q] = xv[j][q] * rs * gv[q] * (1.0f + sc[q]) + sh[q];
            uint2 pk; pk.x = cvtpk(o[0], o[1]); pk.y = cvtpk(o[2], o[3]);
            *(uint2*)(p.h + (size_t)r * D + k) = pk;
        }
    }
}
#else
HD void ph_norm1(const Params& p, int l, int bid, int nb, float* sm) {
    const float* g = p.in[I_N1G] + l * D;
    for (int r = bid; r < R; r += nb) {
        const float* x = xrow_in(p, l, r);
        const float* m = modrow(p, l, r);
        THREADS(t, 256) { float s = 0.f; for (int k = t; k < D; k += 256) s += x[k] * x[k]; sm[t] = s; }
        SYNC
        THREADS(t, 1) { float s = 0.f; for (int i = 0; i < 256; ++i) s += sm[i]; sm[256] = s; }
        SYNC
        THREADS(t, 256) {
            float rs = 1.0f / sqrtf(sm[256] / D + 1e-6f);
            for (int k = t; k < D; k += 256) {
                float v = x[k] * rs * g[k];
                p.h[(size_t)r * D + k] = f2bf(v * (1.0f + m[1024 + k]) + m[k]);
            }
        }
        SYNC
    }
}
#endif

HD void ph_inproj(const Params& p, int l, int bid, int nb, char* smc) {
    const bf16* Wt = p.wt_in + (size_t)l * WIN_NP * D;
    constexpr int NT = PLD / 128, MT = R / 128;
    for (int mt = bid; mt < MT; mt += nb) {
        ACC_DECL(2, acc); acc_zero(acc);
        gemm_accum<2>(acc, [&](int i) { return p.h + (size_t)(mt * 128 + i) * D; }, [&](int j) { return Wt + (size_t)(WIN_N + j) * D; }, D, smc);
        ACC_FOR(2, row, col) {
            const int r = mt * 128 + row;
            if (col < 8) {
                const float xx = AV(acc) + p.in[I_DTB][l * 8 + col];
                const float sp = xx > 20.f ? xx : log1pf(expf(xx));
                p.gg[(size_t)col * R + r] = -expf(p.in[I_ALOG][l * 8 + col]) * sp;
            } else if (col < 16) p.gbeta[(size_t)(col - 8) * R + r] = sigmoidf_(AV(acc));
        } ACC_END
    }
    for (int tile = bid; tile < MT * NT; tile += nb) {
        const int mt = tile / NT, nt = tile % NT;
        ACC_DECL(4, acc); acc_zero(acc);
        gemm_accum<4>(acc, [&](int i) { return p.h + (size_t)(mt * 128 + i) * D; }, [&](int j) { return Wt + (size_t)(nt * 128 + j) * D; }, D, smc);
#ifndef CPU_EMU
        {
            float* tl = (float*)smc;
            acc_to_lds<4>(acc, tl);
            __syncthreads();
            const int t_ = tid_(); const int row = t_ >> 1, half = t_ & 1;
            const int cb = nt * 128 + half * 64;
            float v[64];
#pragma unroll
            for (int q = 0; q < 16; ++q) { const f32x4_t x4 = *(const f32x4_t*)(tl + row * 132 + half * 64 + q * 4); v[q * 4] = x4[0]; v[q * 4 + 1] = x4[1]; v[q * 4 + 2] = x4[2]; v[q * 4 + 3] = x4[3]; }
            if (cb < 512) {
                const float* gn = (cb < 256 ? p.in[I_NAQG] : p.in[I_NAKG]) + l * 64;
                float ss = 0.f;
#pragma unroll
                for (int c = 0; c < 64; ++c) ss += v[c] * v[c];
                const float rs = __builtin_amdgcn_rsqf(ss * (1.0f / 64.0f) + 1e-6f) * ((cb < 256) ? 0.125f * 1.4426950408889634f : 1.0f);
#pragma unroll
                for (int c = 0; c < 64; ++c) v[c] *= rs * gn[c];
            } else if (cb >= 768 && cb < 1280) {
                const float* gn = (cb < 1024 ? p.in[I_DAQG] : p.in[I_DAKG]) + l * 32;
                const float qs = (cb < 1024) ? 0.17677669529663687f * 1.4426950408889634f : 1.0f;
#pragma unroll
                for (int gp = 0; gp < 2; ++gp) {
                    float ss = 0.f;
#pragma unroll
                    for (int c = 0; c < 32; ++c) ss += v[gp * 32 + c] * v[gp * 32 + c];
                    const float rs = __builtin_amdgcn_rsqf(ss * (1.0f / 32.0f) + 1e-6f) * qs;
#pragma unroll
                    for (int c = 0; c < 32; ++c) v[gp * 32 + c] *= rs * gn[c];
                }
                const int gr_ = mt * 128 + row;
                if (gr_ < NLAT) {
                    const int tt = gr_ % SEQ;
#pragma unroll
                    for (int a = 0; a < 2; ++a) {
                        const float pos = (float)(a == 0 ? tt / GW : tt % GW);
                        float frev = 0.15915494309189535f;
#pragma unroll
                        for (int f = 0; f < 8; ++f) {
                            const float cs = __builtin_amdgcn_cosf(pos * frev), sn = __builtin_amdgcn_sinf(pos * frev);
#pragma unroll
                            for (int gp = 0; gp < 2; ++gp) {
                                const int i1 = gp * 32 + a * 16 + f, i2 = i1 + 8;
                                const float x1 = v[i1], x2 = v[i2];
                                v[i1] = x1 * cs - x2 * sn; v[i2] = x2 * cs + x1 * sn;
                            }
                            frev *= 0.31622776601683794f;
                        }
                    }
                }
            }
            bf16* dst = p.P + (size_t)(mt * 128 + row) * PLD + cb;
#pragma unroll
            for (int q = 0; q < 8; ++q) {
                uint4 pk; pk.x = cvtpk(v[q * 8], v[q * 8 + 1]); pk.y = cvtpk(v[q * 8 + 2], v[q * 8 + 3]); pk.z = cvtpk(v[q * 8 + 4], v[q * 8 + 5]); pk.w = cvtpk(v[q * 8 + 6], v[q * 8 + 7]);
                *(uint4*)(dst + q * 8) = pk;
            }
        }
#else
        ACC_FOR(4, row, col) { p.P[(size_t)(mt * 128 + row) * PLD + nt * 128 + col] = f2bf(AV(acc)); } ACC_END
#endif
    }
}

HD void ph_prep(const Params& p, int l, int bid, int nb) {
#ifdef CPU_EMU
    {
        const float* naq = p.in[I_NAQG] + l * 64; const float* nak = p.in[I_NAKG] + l * 64;
        const float* daq = p.in[I_DAQG] + l * 32; const float* dak = p.in[I_DAKG] + l * 32;
        const int N = R * 24;
        for (int u = bid; u < (N + 255) / 256; u += nb) {
            THREADS(t, 256) {
                int idx = u * 256 + t;
                if (idx < N) {
                    int r = idx / 24, gidx = idx % 24;
                    if (gidx < 8) {
                        int isk = gidx >> 2, hd = gidx & 3;
                        bf16* ptr = p.P + (size_t)r * PLD + (isk ? C_NAK : C_NAQ) + hd * 64;
                        const float* g = isk ? nak : naq;
                        float ss = 0.f;
                        for (int d = 0; d < 64; ++d) { float v = bf2f(ptr[d]); ss += v * v; }
                        float rs = 1.0f / sqrtf(ss / 64.0f + 1e-6f);
#ifndef CPU_EMU
                        if (!isk) rs *= 0.125f * 1.4426950408889634f;
#endif
                        for (int d = 0; d < 64; ++d) ptr[d] = f2bf(bf2f(ptr[d]) * rs * g[d]);
                    } else {
                        int gi = gidx - 8; int isk = gi >> 3; int hm = gi & 7;
                        bf16* ptr = p.P + (size_t)r * PLD + (isk ? C_DAK : C_DAQ) + hm * 32;
                        const float* g = isk ? dak : daq;
                        float ss = 0.f;
                        for (int d = 0; d < 32; ++d) { float v = bf2f(ptr[d]); ss += v * v; }
                        float rs = 1.0f / sqrtf(ss / 32.0f + 1e-6f);
#ifndef CPU_EMU
                        if (!isk) rs *= 0.17677669529663687f * 1.4426950408889634f;
#endif
                        if (r < NLAT) {
                            int tt = r % SEQ; float prow = (float)(tt / GW), pcol = (float)(tt % GW);
                            for (int a = 0; a < 2; ++a) {
                                float pos = a == 0 ? prow : pcol;
                                float fr = 1.0f;
                                for (int f = 0; f < 8; ++f) {
                                    float ang = pos * fr;
                                    float cs = cosf(ang), sn = sinf(ang);
                                    int i1 = a * 16 + f, i2 = a * 16 + 8 + f;
                                    float x1 = bf2f(ptr[i1]) * rs * g[i1], x2 = bf2f(ptr[i2]) * rs * g[i2];
                                    ptr[i1] = f2bf(x1 * cs - x2 * sn);
                                    ptr[i2] = f2bf(x2 * cs + x1 * sn);
                                    fr *= 0.31622776601683794f;
                                }
                            }
                        } else {
                            for (int d = 0; d < 32; ++d) ptr[d] = f2bf(bf2f(ptr[d]) * rs * g[d]);
                        }
                    }
                }
            }
        }
    }
#endif
#ifndef CPU_EMU
    {
        const float* cw = p.in[I_CONVW] + (size_t)l * 5 * 768;
        const int N = R * 96;
        for (int idx = bid * 256 + tid_(); idx < N; idx += nb * 256) {
            const int r = idx / 96, q = idx % 96; const int ph = q >> 3, cg = q & 7; const int part = ph >> 2, hd = ph & 3;
            const RowInfo ri = rowinfo(r);
            const int ch0 = part * 256 + hd * 64 + cg * 8;
            float y[8];
#pragma unroll
            for (int c = 0; c < 8; ++c) y[c] = 0.f;
#pragma unroll
            for (int i = 0; i < 5; ++i) {
                const int tt = ri.t + i - 2;
                if (tt >= 0 && tt < ri.T) {
                    const uint4 raw = *(const uint4*)(p.P + (size_t)(ri.base + tt) * PLD + C_GQ + ch0);
                    const f32x4_t w0 = *(const f32x4_t*)(cw + i * 768 + ch0), w1 = *(const f32x4_t*)(cw + i * 768 + ch0 + 4);
                    y[0] += __uint_as_float(raw.x << 16) * w0[0]; y[1] += __uint_as_float(raw.x & 0xffff0000u) * w0[1];
                    y[2] += __uint_as_float(raw.y << 16) * w0[2]; y[3] += __uint_as_float(raw.y & 0xffff0000u) * w0[3];
                    y[4] += __uint_as_float(raw.z << 16) * w1[0]; y[5] += __uint_as_float(raw.z & 0xffff0000u) * w1[1];
                    y[6] += __uint_as_float(raw.w << 16) * w1[2]; y[7] += __uint_as_float(raw.w & 0xffff0000u) * w1[3];
                }
            }
            float ss = 0.f;
#pragma unroll
            for (int c = 0; c < 8; ++c) { y[c] = siluf_(y[c]); ss += y[c] * y[c]; }
            ss += __shfl_xor(ss, 1); ss += __shfl_xor(ss, 2); ss += __shfl_xor(ss, 4);
            float scl = 1.0f;
            if (part == 0) scl = 0.125f / sqrtf(ss + 1e-6f); else if (part == 1) scl = 1.0f / sqrtf(ss + 1e-6f);
            uint4 pk; pk.x = cvtpk(y[0] * scl, y[1] * scl); pk.y = cvtpk(y[2] * scl, y[3] * scl); pk.z = cvtpk(y[4] * scl, y[5] * scl); pk.w = cvtpk(y[6] * scl, y[7] * scl);
            *(uint4*)(p.gq + (size_t)r * 768 + ch0) = pk;
        }
    }
#else
    {
        const float* cw = p.in[I_CONVW] + (size_t)l * 5 * 768;
        const int N = R * 12;
        for (int u = bid; u < (N + 255) / 256; u += nb) {
            THREADS(t, 256) {
                int idx = u * 256 + t;
                if (idx < N) {
                    int r = idx / 12, ph = idx % 12; int part = ph >> 2, hd = ph & 3;
                    RowInfo ri = rowinfo(r);
                    int ch0 = part * 256 + hd * 64;
                    float ss = 0.f;
                    for (int pass = 0; pass < 2; ++pass) {
                        float scl = 1.0f;
                        if (pass == 1) { if (part == 0) scl = 0.125f / sqrtf(ss + 1e-6f); else if (part == 1) scl = 1.0f / sqrtf(ss + 1e-6f); }
                        if (pass == 0 && part == 2) continue;
                        for (int c = 0; c < 64; ++c) {
                            float y = 0.f;
                            for (int i = 0; i < 5; ++i) {
                                int tt = ri.t + i - 2;
                                if (tt >= 0 && tt < ri.T) y += bf2f(p.P[(size_t)(ri.base + tt) * PLD + C_GQ + ch0 + c]) * cw[i * 768 + ch0 + c];
                            }
                            y = siluf_(y);
                            if (pass == 0) ss += y * y; else p.gq[(size_t)r * 768 + ch0 + c] = f2bf(y * scl);
                        }
                    }
                }
            }
        }
    }
#endif
    {
        const int RQ = (l == 0) ? R : NLAT;
        for (int r = (FOURIER_GEMM ? NLAT : 0) + bid; r < RQ; r += nb) {
            THREADS(t, 256) {
                int g = t >> 6, m = t & 63;
                const bf16* f = p.P + (size_t)r * PLD + C_F + g * 64;
                float fc = 0.f, fs = 0.f;
                for (int c = 0; c < 64; ++c) {
                    int ti = ((m * c) & 63) * (SEQ / 64);
                    float v = bf2f(f[c]);
                    fc += v * p.cosT[ti]; fs += v * p.sinT[ti];
                }
                p.fcs[(size_t)r * 512 + t] = f2bf(fc);
                p.fcs[(size_t)r * 512 + 256 + t] = f2bf(fs);
            }
        }
    }
}

#ifndef CPU_EMU
HD void ph_na(const Params& p, int l, int bid, int nb, char* smc) {
    const int t = tid_(), lane = t & 63, w = t >> 6, fr = lane & 15, fg = lane >> 4;
    const float* rpb = p.in[I_RPB] + (size_t)l * 4 * 15 * 31;
    float* sbias = (float*)(smc + 32768);
    const lds_cptr lds = (lds_cptr)smc;
    constexpr int WH = ROWS < 8 ? ROWS : 8;
    const int nlat = NB * ROWS * 4;
    const int nctx = (l == 0) ? NB * 4 * (CTXL / 64) : 0;
    const int lkey = t >> 3, lc = t & 7;
    const int ksrc = (lc ^ (lkey & 7)) << 3;
    const int vsrc = ((((lc >> 1) ^ ((lkey >> 1) & 3)) << 1) | (lc & 1)) << 3;
    for (int unit = bid; unit < nlat + nctx; unit += nb) {
        int b, hd, qrow, ntl, rs = 0, gr = 0;
        if (unit < nlat) {
            hd = unit & 3; const int br_ = unit >> 2; gr = br_ % ROWS; b = br_ / ROWS;
            qrow = b * SEQ + gr * GW + w * 16 + fr; ntl = WH;
            rs = gr - WH / 2; if (rs < 0) rs = 0; if (rs > ROWS - WH) rs = ROWS - WH;
        } else {
            const int u2 = unit - nlat; const int qt = u2 % (CTXL / 64); const int bh = u2 / (CTXL / 64); hd = bh & 3; b = bh >> 2;
            qrow = NLAT + b * CTXL + qt * 64 + w * 16 + fr; ntl = 0;
        }
        const int ntiles = ntl + NCC;
        const int qcol = w * 16 + fr;
        int cs0 = w * 16 - 8; if (cs0 < 0) cs0 = 0; if (cs0 > GW - 32) cs0 = GW - 32;
        int wsq = qcol - 8; if (wsq < 0) wsq = 0; if (wsq > GW - 16) wsq = GW - 16;
        bf16x8_t qf[2];
#pragma unroll
        for (int s_ = 0; s_ < 2; ++s_) qf[s_] = *(const bf16x8_t*)(p.P + (size_t)qrow * PLD + C_NAQ + hd * 64 + s_ * 32 + fg * 8);
        f32x4_t O[4];
#pragma unroll
        for (int d = 0; d < 4; ++d) O[d] = f32x4_t{0.f, 0.f, 0.f, 0.f};
        float ls = 0.f;
        auto keyrow = [&](int tt, int i) { return (tt < ntl) ? (b * SEQ + (rs + tt) * GW + i) : (NLAT + b * CTXL + (tt - ntl) * 64 + i); };
        char* ldst = smc + w * 1024;
        __syncthreads();
        for (int i = t; i < 15 * 31; i += 256) sbias[i] = rpb[hd * 465 + i] * 1.4426950408889634f;
#pragma unroll
        for (int i = 0; i < 2; ++i) {
            const bf16* src = p.P + (size_t)keyrow(0, lkey + 32 * i) * PLD + hd * 64;
            GLDS16(src + C_NAK + ksrc, ldst + 4096 * i); GLDS16(src + C_NAV + vsrc, ldst + 16384 + 4096 * i);
        }
        WAIT_VM0();
        __syncthreads();
        const int vkl = 4 * fg + (fr >> 2);
        const int vsw = (vkl >> 1) & 3;
        unsigned va[4];
#pragma unroll
        for (int d = 0; d < 4; ++d) va[d] = 16384 + vkl * 128 + ((((d ^ vsw) << 1) | ((fr & 3) >> 1)) << 4) + (fr & 1) * 8;
#pragma unroll 1
        for (int tt = 0; tt < ntiles; ++tt) {
            const int cur = tt & 1;
            if (tt + 1 < ntiles) {
#pragma unroll
                for (int i = 0; i < 2; ++i) {
                    const bf16* src = p.P + (size_t)keyrow(tt + 1, lkey + 32 * i) * PLD + hd * 64;
                    GLDS16(src + C_NAK + ksrc, ldst + (cur ^ 1) * 8192 + 4096 * i); GLDS16(src + C_NAV + vsrc, ldst + 16384 + (cur ^ 1) * 8192 + 4096 * i);
                }
            }
            const char* cK = smc + cur * 8192;
            const lds_cptr cV = lds + cur * 8192;
            const bool local = tt < ntl;
            const int kbase = local ? cs0 : 0;
            const int nkf = local ? 2 : 4;
            unsigned pb[2][4];
#pragma unroll
            for (int f = 0; f < 4; ++f) {
                if (f < nkf) {
                    const int key = kbase + f * 16 + fr;
                    const char* kp = cK + key * 128;
                    const bf16x8_t a0 = *(const bf16x8_t*)(kp + (((fg) ^ (fr & 7)) << 4));
                    const bf16x8_t a1 = *(const bf16x8_t*)(kp + (((4 + fg) ^ (fr & 7)) << 4));
                    f32x4_t S = __builtin_amdgcn_mfma_f32_16x16x32_bf16(a0, qf[0], f32x4_t{0.f, 0.f, 0.f, 0.f}, 0, 0, 0);
                    S = __builtin_amdgcn_mfma_f32_16x16x32_bf16(a1, qf[1], S, 0, 0, 0);
                    float e[4];
#pragma unroll
                    for (int r = 0; r < 4; ++r) {
                        float sv = S[r]; bool ok = true;
                        if (local) {
                            const int kc = kbase + f * 16 + 4 * fg + r;
                            ok = (unsigned)(kc - wsq) < 16u;
                            sv += sbias[((rs + tt) - gr + 7) * 31 + (ok ? (kc - qcol + 15) : 15)];
                        }
                        e[r] = ok ? __builtin_amdgcn_exp2f(sv) : 0.f;
                    }
                    ls += (e[0] + e[1]) + (e[2] + e[3]);
                    pb[f >> 1][(f & 1) * 2] = cvtpk(e[0], e[1]);
                    pb[f >> 1][(f & 1) * 2 + 1] = cvtpk(e[2], e[3]);
                }
            }
#pragma unroll
            for (int ks = 0; ks < 2; ++ks) {
                if (ks * 2 < nkf) {
#pragma unroll
                    for (int d = 0; d < 4; ++d) {
                        const s16x4_t lo = lds_tr16(cV + va[d] + (kbase + ks * 32) * 128);
                        const s16x4_t hi = lds_tr16(cV + va[d] + (kbase + ks * 32 + 16) * 128);
                        const bf16x8_t vf = bf16x8_t{lo[0], lo[1], lo[2], lo[3], hi[0], hi[1], hi[2], hi[3]};
                        const i32x4_t bi = i32x4_t{(int)pb[ks][0], (int)pb[ks][1], (int)pb[ks][2], (int)pb[ks][3]};
                        O[d] = __builtin_amdgcn_mfma_f32_16x16x32_bf16(vf, __builtin_bit_cast(bf16x8_t, bi), O[d], 0, 0, 0);
                    }
                }
            }
            WAIT_VM0();
            __syncthreads();
        }
        ls += __shfl_xor(ls, 16); ls += __shfl_xor(ls, 32);
        const float inv = 1.0f / ls;
        bf16* op = p.br + (size_t)qrow * D + hd * 64;
#pragma unroll
        for (int d = 0; d < 4; ++d) {
            uint2 pk; pk.x = cvtpk(O[d][0] * inv, O[d][1] * inv); pk.y = cvtpk(O[d][2] * inv, O[d][3] * inv);
            *(uint2*)(op + d * 16 + 4 * fg) = pk;
        }
    }
}
#else
HD void ph_na(const Params& p, int l, int bid, int nb, char*) {
    const float* rpb = p.in[I_RPB] + (size_t)l * 4 * 15 * 31;
    const int RQ = (l == 0) ? R : NLAT;
    const int N = RQ * 4;
    const int wh = ROWS < 8 ? ROWS : 8;
    for (int u = bid; u < (N + 255) / 256; u += nb) {
        THREADS(t, 256) {
            int idx = u * 256 + t;
            if (idx < N) {
                int hd = idx / RQ, r = idx % RQ;
                RowInfo ri = rowinfo(r);
                float q[64], o[64];
                const bf16* qp = p.P + (size_t)r * PLD + C_NAQ + hd * 64;
#pragma unroll
                for (int d = 0; d < 64; ++d) { q[d] = bf2f(qp[d]) * 0.125f; o[d] = 0.f; }
                float mx = -1e30f, lsum = 0.f;
                int nloc = 0, rs = 0, ws = 0, gr = 0, gc = 0;
                if (ri.seg == 0) {
                    gr = ri.t / GW; gc = ri.t % GW;
                    rs = gr - wh / 2; if (rs < 0) rs = 0; if (rs > ROWS - wh) rs = ROWS - wh;
                    ws = gc - 8; if (ws < 0) ws = 0; if (ws > GW - 16) ws = GW - 16;
                    nloc = wh * 16;
                }
                int ctxbase = NLAT + ri.b * CTXL;
                for (int kk = 0; kk < nloc + CTXL; ++kk) {
                    int kr; float bias = 0.f;
                    if (kk < nloc) {
                        int a = kk >> 4, c = kk & 15;
                        int krow = rs + a, kcol = ws + c;
                        kr = ri.base + krow * GW + kcol;
                        bias = rpb[(hd * 15 + (krow - gr + 7)) * 31 + (kcol - gc + 15)];
                    } else kr = ctxbase + (kk - nloc);
                    const bf16* kp = p.P + (size_t)kr * PLD + C_NAK + hd * 64;
                    float s = 0.f;
#pragma unroll
                    for (int d = 0; d < 64; ++d) s += q[d] * bf2f(kp[d]);
                    s += bias;
                    if (s > mx) { float f = expf(mx - s); lsum *= f;
#pragma unroll
                        for (int d = 0; d < 64; ++d) o[d] *= f;
                        mx = s; }
                    float e = expf(s - mx);
                    lsum += e;
                    const bf16* vp = p.P + (size_t)kr * PLD + C_NAV + hd * 64;
#pragma unroll
                    for (int d = 0; d < 64; ++d) o[d] += e * bf2f(vp[d]);
                }
                float inv = 1.0f / lsum;
                bf16* op = p.br + (size_t)r * D + hd * 64;
#pragma unroll
                for (int d = 0; d < 64; ++d) op[d] = f2bf(o[d] * inv);
            }
        }
    }
}

#endif

#ifndef CPU_EMU
HD void ph_da(const Params& p, int l, int bid, int nb, char* smc) {
    const int t = tid_(), lane = t & 63, w = t >> 6, fr = lane & 15, fg = lane >> 4;
    const float lam_init = lam_init_of(l);
    float s1 = 0.f, s2 = 0.f;
    for (int d = 0; d < 32; ++d) {
        s1 += p.in[I_LQ1][l * 32 + d] * p.in[I_LK1][l * 32 + d];
        s2 += p.in[I_LQ2][l * 32 + d] * p.in[I_LK2][l * 32 + d];
    }
    const float lam = expf(s1) - expf(s2) + lam_init;
    const float* sg = p.in[I_SUBLN] + l * 64;
    constexpr int NQT = SEQ / 128, NQC = CTXL / 128;
    const int nlat = NB * 4 * NQT;
    const int nctx = (l == 0) ? NB * 4 * NQC : 0;
    const lds_cptr lds = (lds_cptr)smc;
    for (int unit = bid; unit < nlat + nctx; unit += nb) {
        int b, hd, qrow0, kt0;
        if (unit < nlat) { const int qt = unit % NQT, bh = unit / NQT; hd = bh & 3; b = bh >> 2; qrow0 = b * SEQ + qt * 128; kt0 = 0; }
        else { const int u2 = unit - nlat; const int qt = u2 % NQC, bh = u2 / NQC; hd = bh & 3; b = bh >> 2; qrow0 = NLAT + b * CTXL + qt * 128; kt0 = NCL; }
        const int kt1 = NCL + NCC;
        bf16x8_t qf[2][2];
#pragma unroll
        for (int m = 0; m < 2; ++m)
#pragma unroll
            for (int n = 0; n < 2; ++n)
                qf[m][n] = *(const bf16x8_t*)(p.P + (size_t)(qrow0 + w * 32 + n * 16 + fr) * PLD + C_DAQ + hd * 64 + m * 32 + fg * 8);
        f32x4_t O[2][4][2];
#pragma unroll
        for (int m = 0; m < 2; ++m)
#pragma unroll
            for (int d = 0; d < 4; ++d)
#pragma unroll
                for (int n = 0; n < 2; ++n) O[m][d][n] = f32x4_t{0.f, 0.f, 0.f, 0.f};
        float ls[2][2] = {{0.f, 0.f}, {0.f, 0.f}};
        const int lkey = t >> 3, lc = t & 7;
        const int ksrc = (lc ^ (lkey & 7)) << 3;
        const int vsrc = ((((lc >> 1) ^ ((lkey >> 1) & 3)) << 1) | (lc & 1)) << 3;
        auto keyrow = [&](int kt, int i) { return (kt < NCL) ? (b * SEQ + kt * 64 + i) : (NLAT + b * CTXL + (kt - NCL) * 64 + i); };
        char* ldst = smc + w * 1024;
        __syncthreads();
#pragma unroll
        for (int i = 0; i < 2; ++i) {
            const bf16* src = p.P + (size_t)keyrow(kt0, lkey + 32 * i) * PLD + hd * 64;
            GLDS16(src + C_DAK + ksrc, ldst + 4096 * i); GLDS16(src + C_DAV + vsrc, ldst + 16384 + 4096 * i);
        }
        WAIT_VM0();
        __syncthreads();
        const unsigned ka0 = fr * 128 + (((fg) ^ (fr & 7)) << 4);
        const unsigned ka1 = fr * 128 + (((4 + fg) ^ (fr & 7)) << 4);
        const int vkey = 4 * fg + (fr >> 2);
        const int vsw = (vkey >> 1) & 3;
        unsigned va[4];
#pragma unroll
        for (int d = 0; d < 4; ++d) va[d] = 16384 + vkey * 128 + ((((d ^ vsw) << 1) | ((fr & 3) >> 1)) << 4) + (fr & 1) * 8;
#pragma unroll 1
        for (int kt = kt0; kt < kt1; ++kt) {
            const int cur = (kt - kt0) & 1;
            if (kt + 1 < kt1) {
#pragma unroll
                for (int i = 0; i < 2; ++i) {
                    const bf16* src = p.P + (size_t)keyrow(kt + 1, lkey + 32 * i) * PLD + hd * 64;
                    GLDS16(src + C_DAK + ksrc, ldst + (cur ^ 1) * 8192 + 4096 * i); GLDS16(src + C_DAV + vsrc, ldst + 16384 + (cur ^ 1) * 8192 + 4096 * i);
                }
            }
            const char* cK = smc + cur * 8192;
            const lds_cptr cV = lds + cur * 8192;
#pragma unroll
            for (int m = 0; m < 2; ++m) {
                unsigned pb[2][2][4];
                {
                    f32x4_t S[4][2];
#pragma unroll
                    for (int kf = 0; kf < 4; ++kf) {
                        const bf16x8_t a = *(const bf16x8_t*)(cK + (m ? ka1 : ka0) + kf * 2048);
#pragma unroll
                        for (int n = 0; n < 2; ++n) S[kf][n] = __builtin_amdgcn_mfma_f32_16x16x32_bf16(a, qf[m][n], f32x4_t{0.f, 0.f, 0.f, 0.f}, 0, 0, 0);
                    }
#pragma unroll
                    for (int kf = 0; kf < 4; ++kf)
#pragma unroll
                        for (int n = 0; n < 2; ++n) {
                            const float e0 = __builtin_amdgcn_exp2f(S[kf][n][0]), e1 = __builtin_amdgcn_exp2f(S[kf][n][1]);
                            const float e2 = __builtin_amdgcn_exp2f(S[kf][n][2]), e3 = __builtin_amdgcn_exp2f(S[kf][n][3]);
                            ls[m][n] += (e0 + e1) + (e2 + e3);
                            pb[n][kf >> 1][(kf & 1) * 2] = cvtpk(e0, e1);
                            pb[n][kf >> 1][(kf & 1) * 2 + 1] = cvtpk(e2, e3);
                        }
                }
#pragma unroll
                for (int ks = 0; ks < 2; ++ks)
#pragma unroll
                    for (int d = 0; d < 4; ++d) {
                        const s16x4_t lo = lds_tr16(cV + va[d] + ks * 4096);
                        const s16x4_t hi = lds_tr16(cV + va[d] + ks * 4096 + 2048);
                        const bf16x8_t vf = bf16x8_t{lo[0], lo[1], lo[2], lo[3], hi[0], hi[1], hi[2], hi[3]};
#pragma unroll
                        for (int n = 0; n < 2; ++n) {
                            const i32x4_t bi = i32x4_t{(int)pb[n][ks][0], (int)pb[n][ks][1], (int)pb[n][ks][2], (int)pb[n][ks][3]};
                            O[m][d][n] = __builtin_amdgcn_mfma_f32_16x16x32_bf16(vf, __builtin_bit_cast(bf16x8_t, bi), O[m][d][n], 0, 0, 0);
                        }
                    }
                asm volatile("" ::: "memory");
            }
            WAIT_VM0();
            __syncthreads();
        }
#pragma unroll
        for (int n = 0; n < 2; ++n) {
            float l0 = ls[0][n], l1 = ls[1][n];
            l0 += __shfl_xor(l0, 16); l0 += __shfl_xor(l0, 32);
            l1 += __shfl_xor(l1, 16); l1 += __shfl_xor(l1, 32);
            const float i0 = 1.0f / l0, i1 = lam / l1;
            float ss = 0.f;
#pragma unroll
            for (int d = 0; d < 4; ++d)
#pragma unroll
                for (int r = 0; r < 4; ++r) { const float o = O[0][d][n][r] * i0 - O[1][d][n][r] * i1; O[0][d][n][r] = o; ss += o * o; }
            ss += __shfl_xor(ss, 16); ss += __shfl_xor(ss, 32);
            const float rs = (1.0f - lam_init) / sqrtf(ss / 64.0f + 1e-6f);
            bf16* op = p.br + (size_t)(qrow0 + w * 32 + n * 16 + fr) * D + 256 + hd * 64;
#pragma unroll
            for (int d = 0; d < 4; ++d) {
                const int dv = d * 16 + 4 * fg;
                const unsigned lo = cvtpk(O[0][d][n][0] * rs * sg[dv], O[0][d][n][1] * rs * sg[dv + 1]);
                const unsigned hi = cvtpk(O[0][d][n][2] * rs * sg[dv + 2], O[0][d][n][3] * rs * sg[dv + 3]);
                uint2 pk; pk.x = lo; pk.y = hi;
                *(uint2*)(op + dv) = pk;
            }
        }
    }
}
#else
HD void ph_da(const Params& p, int l, int bid, int nb, char*) {
    const int RQ = (l == 0) ? R : NLAT;
    const int N = RQ * 4;
    const float lam_init = lam_init_of(l);
    float s1 = 0.f, s2 = 0.f;
    for (int d = 0; d < 32; ++d) {
        s1 += p.in[I_LQ1][l * 32 + d] * p.in[I_LK1][l * 32 + d];
        s2 += p.in[I_LQ2][l * 32 + d] * p.in[I_LK2][l * 32 + d];
    }
    const float lam = expf(s1) - expf(s2) + lam_init;
    const float* sg = p.in[I_SUBLN] + l * 64;
    const float scale = 0.17677669529663687f;
    for (int u = bid; u < (N + 255) / 256; u += nb) {
        THREADS(t, 256) {
            int idx = u * 256 + t;
            if (idx < N) {
                int hd = idx / RQ, r = idx % RQ;
                RowInfo ri = rowinfo(r);
                float q0[32], q1[32], o0[64], o1[64];
                const bf16* qp = p.P + (size_t)r * PLD + C_DAQ + hd * 64;
#pragma unroll
                for (int d = 0; d < 32; ++d) { q0[d] = bf2f(qp[d]) * scale; q1[d] = bf2f(qp[32 + d]) * scale; }
#pragma unroll
                for (int d = 0; d < 64; ++d) { o0[d] = 0.f; o1[d] = 0.f; }
                float m0 = -1e30f, m1 = -1e30f, l0 = 0.f, l1 = 0.f;
                int nlat = (ri.seg == 0) ? SEQ : 0;
                int latbase = ri.b * SEQ, ctxbase = NLAT + ri.b * CTXL;
                for (int kk = 0; kk < nlat + CTXL; ++kk) {
                    int kr = (kk < nlat) ? latbase + kk : ctxbase + (kk - nlat);
                    const bf16* kp = p.P + (size_t)kr * PLD + C_DAK + hd * 64;
                    const bf16* vp = p.P + (size_t)kr * PLD + C_DAV + hd * 64;
                    float sa = 0.f, sb = 0.f;
#pragma unroll
                    for (int d = 0; d < 32; ++d) { sa += q0[d] * bf2f(kp[d]); sb += q1[d] * bf2f(kp[32 + d]); }
                    if (sa > m0) { float f = expf(m0 - sa); l0 *= f;
#pragma unroll
                        for (int d = 0; d < 64; ++d) o0[d] *= f;
                        m0 = sa; }
                    if (sb > m1) { float f = expf(m1 - sb); l1 *= f;
#pragma unroll
                        for (int d = 0; d < 64; ++d) o1[d] *= f;
                        m1 = sb; }
                    float ea = expf(sa - m0), eb = expf(sb - m1);
                    l0 += ea; l1 += eb;
#pragma unroll
                    for (int d = 0; d < 64; ++d) { float v = bf2f(vp[d]); o0[d] += ea * v; o1[d] += eb * v; }
                }
                float i0 = 1.0f / l0, i1 = lam / l1;
                float ss = 0.f;
#pragma unroll
                for (int d = 0; d < 64; ++d) { o0[d] = o0[d] * i0 - o1[d] * i1; ss += o0[d] * o0[d]; }
                float rs = (1.0f - lam_init) / sqrtf(ss / 64.0f + 1e-6f);
                bf16* op = p.br + (size_t)r * D + 256 + hd * 64;
#pragma unroll
                for (int d = 0; d < 64; ++d) op[d] = f2bf(o0[d] * rs * sg[d]);
            }
        }
    }
}

#endif

struct ChunkInfo { int dir, b, hd, n, seg, T, base, nloc; };
HD ChunkInfo chunkinfo(int unit) {
    ChunkInfo c;
    c.n = unit % NCH; int ch = unit / NCH; c.hd = ch & 3; c.b = (ch >> 2) % NB; c.dir = ch / (4 * NB);
    if (c.n < NCC) { c.seg = 1; c.T = CTXL; c.base = NLAT + c.b * CTXL; c.nloc = c.n; }
    else { c.seg = 0; c.T = SEQ; c.base = c.b * SEQ; c.nloc = c.n - NCC; }
    return c;
}
HD int chunk_row(const ChunkInfo& c, int i) { int pf = c.nloc * 64 + i; return c.base + (c.dir ? (c.T - 1 - pf) : pf); }

#ifndef CPU_EMU
HD void ph_gdn_chunk(const Params& p, int l, int bid, int nb, float* smf) {
    char* smc = (char*)smf;
    const int t = tid_(), lane = t & 63, w = t >> 6, fr = lane & 15, fg = lane >> 4;
    float* sA = (float*)(smc + 24576); float* sG = (float*)(smc + 40960); float* sB = (float*)(smc + 41216);
    const int lkey = t >> 3, lc = t & 7;
    const int ksrc = (lc ^ (lkey & 7)) << 3;
    char* ldst = smc + w * 1024;
    for (int unit = bid; unit < NUNIT; unit += nb) {
        const ChunkInfo c = chunkinfo(unit);
        const int dh = c.dir * 4 + c.hd;
        __syncthreads();
#pragma unroll
        for (int i = 0; i < 2; ++i) {
            const bf16* src = p.gq + (size_t)chunk_row(c, lkey + 32 * i) * 768 + c.hd * 64;
            GLDS16(src + 256 + ksrc, ldst + 4096 * i);
            GLDS16(src + ksrc, ldst + 8192 + 4096 * i);
            GLDS16(src + 512 + lc * 8, ldst + 16384 + 4096 * i);
        }
        if (w == 0) {
            const int row = chunk_row(c, lane);
            float x = p.gg[(size_t)dh * R + row];
#pragma unroll
            for (int off = 1; off < 64; off <<= 1) { const float y = __shfl_up(x, off); if (lane >= off) x += y; }
            sG[lane] = x; sB[lane] = p.gbeta[(size_t)dh * R + row];
            p.cG[(size_t)unit * 64 + lane] = x;
        }
        WAIT_VM0();
        __syncthreads();
        {
            const char* kt_ = smc; const char* qt_ = smc + 8192;
            const unsigned ro = (16 * w + fr) * 128;
            const unsigned c0 = ((fg) ^ (fr & 7)) << 4, c1 = ((4 + fg) ^ (fr & 7)) << 4;
            const bf16x8_t ak0 = *(const bf16x8_t*)(kt_ + ro + c0), ak1 = *(const bf16x8_t*)(kt_ + ro + c1);
            const bf16x8_t aq0 = *(const bf16x8_t*)(qt_ + ro + c0), aq1 = *(const bf16x8_t*)(qt_ + ro + c1);
            float gi[4], bi[4];
#pragma unroll
            for (int r = 0; r < 4; ++r) { gi[r] = sG[16 * w + 4 * fg + r]; bi[r] = sB[16 * w + 4 * fg + r]; }
#pragma unroll
            for (int n = 0; n < 4; ++n) {
                const unsigned rb = (16 * n + fr) * 128;
                const bf16x8_t b0 = *(const bf16x8_t*)(kt_ + rb + c0), b1 = *(const bf16x8_t*)(kt_ + rb + c1);
                f32x4_t kk = __builtin_amdgcn_mfma_f32_16x16x32_bf16(ak0, b0, f32x4_t{0.f, 0.f, 0.f, 0.f}, 0, 0, 0);
                kk = __builtin_amdgcn_mfma_f32_16x16x32_bf16(ak1, b1, kk, 0, 0, 0);
                f32x4_t qk = __builtin_amdgcn_mfma_f32_16x16x32_bf16(aq0, b0, f32x4_t{0.f, 0.f, 0.f, 0.f}, 0, 0, 0);
                qk = __builtin_amdgcn_mfma_f32_16x16x32_bf16(aq1, b1, qk, 0, 0, 0);
                const int j = 16 * n + fr; const float gj = sG[j];
#pragma unroll
                for (int r = 0; r < 4; ++r) {
                    const int i = 16 * w + 4 * fg + r;
                    const float dec = (j <= i) ? __expf(gi[r] - gj) : 0.f;
                    sA[i * 64 + j] = (j < i) ? kk[r] * bi[r] * dec : 0.f;
                    p.cQK[(size_t)unit * 4096 + i * 64 + j] = f2bf(qk[r] * dec);
                }
            }
        }
        __syncthreads();
        if (w < 2) {
            float x[64];
            bf16* dst = (w == 0 ? p.cU : p.cW) + (size_t)unit * 4096 + lane;
#pragma unroll
            for (int i = 0; i < 64; ++i) {
                float rhs;
                if (w == 0) rhs = sB[i] * bf2f(*(const bf16*)(smc + 16384 + i * 128 + lane * 2));
                else rhs = sB[i] * __expf(sG[i]) * bf2f(*(const bf16*)(smc + i * 128 + ((((lane >> 3) ^ (i & 7))) << 4) + (lane & 7) * 2));
                float acc = rhs;
#pragma unroll
                for (int j4 = 0; j4 < i; j4 += 4) {
                    const f32x4_t a4 = *(const f32x4_t*)(sA + i * 64 + j4);
                    acc -= a4[0] * x[j4];
                    if (j4 + 1 < i) acc -= a4[1] * x[j4 + 1];
                    if (j4 + 2 < i) acc -= a4[2] * x[j4 + 2];
                    if (j4 + 3 < i) acc -= a4[3] * x[j4 + 3];
                }
                x[i] = acc;
                dst[i * 64] = f2bf(acc);
            }
        }
    }
}
#else
HD void ph_gdn_chunk(const Params& p, int l, int bid, int nb, float* sm) {
    float* sk = sm;
    float* sq = sm + 4096;
    float* sA = sm + 8192;
    float* sXu = sm + 12288;
    float* sXw = sm + 4096;
    float* sG = sm + 16384;
    float* sB = sm + 16448;
    for (int unit = bid; unit < NUNIT; unit += nb) {
        ChunkInfo c = chunkinfo(unit);
        int dh = c.dir * 4 + c.hd;
        THREADS(t, 4096) {
            int i = t >> 6, d = t & 63; int row = chunk_row(c, i);
            sq[t] = bf2f(p.gq[(size_t)row * 768 + c.hd * 64 + d]);
            sk[t] = bf2f(p.gq[(size_t)row * 768 + 256 + c.hd * 64 + d]);
        }
        THREADS(t, 1) {
            float acc = 0.f;
            for (int i = 0; i < 64; ++i) { int row = chunk_row(c, i); acc += p.gg[(size_t)dh * R + row]; sG[i] = acc; sB[i] = p.gbeta[(size_t)dh * R + row]; }
        }
        SYNC
        THREADS(t, 4096) {
            int i = t >> 6, j = t & 63;
            float kk = 0.f, qk = 0.f;
            for (int d = 0; d < 64; ++d) { kk += sk[i * 64 + d] * sk[j * 64 + d]; qk += sq[i * 64 + d] * sk[j * 64 + d]; }
            float dec = (j <= i) ? expf(sG[i] - sG[j]) : 0.f;
            sA[t] = (j < i) ? kk * sB[i] * dec : 0.f;
            p.cQK[(size_t)unit * 4096 + t] = f2bf(qk * dec);
        }
        SYNC
        THREADS(t, 4096) {
            int i = t >> 6, cc = t & 63; int row = chunk_row(c, i);
            sXu[t] = sB[i] * bf2f(p.gq[(size_t)row * 768 + 512 + c.hd * 64 + cc]);
            sXw[t] = sB[i] * expf(sG[i]) * sk[t];
        }
        SYNC
        for (int i = 1; i < 64; ++i) {
            THREADS(cc, 128) {
                float* X = (cc < 64) ? (sXu + cc) : (sXw + cc - 64);
                float acc = X[i * 64];
                for (int j = 0; j < i; ++j) acc -= sA[i * 64 + j] * X[j * 64];
                X[i * 64] = acc;
            }
            SYNC
        }
        THREADS(t, 4096) {
            p.cU[(size_t)unit * 4096 + t] = f2bf(sXu[t]);
            p.cW[(size_t)unit * 4096 + t] = f2bf(sXw[t]);
        }
        THREADS(t, 64) { p.cG[(size_t)unit * 64 + t] = sG[t]; }
        SYNC
    }
}

#endif

HD void ph_fourier2(const Params& p, int l, int bid, int nb) {
    const int RQ = (l == 0) ? R : NLAT;
    for (int r = (FOURIER_GEMM ? NLAT : 0) + bid; r < RQ; r += nb) {
        RowInfo ri = rowinfo(r);
        const float nrm = 1.0f / sqrtf((float)ri.T * 64.0f);
        const int mul = SEQ / ri.T;
        THREADS(ch, 256) {
            float acc = 0.f;
            for (int tt = 0; tt < ri.T; ++tt) {
                int ti = ((ri.t * tt) & (ri.T - 1)) * mul;
                const bf16* f = p.fcs + (size_t)(ri.base + tt) * 512;
                acc += p.cosT[ti] * bf2f(f[ch]) - p.sinT[ti] * bf2f(f[256 + ch]);
            }
            p.br[(size_t)r * D + 768 + ch] = f2bf(acc * nrm);
        }
    }
}


HD void ph_fourier_s1(const Params& p, int bid, int nb, char* smc) {
    for (int tile = bid; tile < NB * 64 * 4; tile += nb) {
        const int g = tile & 3, t2 = (tile >> 2) & 63, b = tile >> 8;
        ACC_DECL(4, acc); acc_zero(acc);
        gemm_accum<4>(acc, [&](int i) { return p.P + (size_t)(b * SEQ + 64 * i + t2) * PLD + C_F + g * 64; },
                      [&](int j) { return p.fW1 + j * 64; }, 64, smc);
        ACC_FOR(4, row, col) {
            const int cs = col >> 6, m = col & 63;
            p.fcs[((((size_t)b * 256 + g * 64 + m) * 64 + t2) * 2 + cs) * 128 + row] = f2bf(AV(acc));
        } ACC_END
    }
}
HD void ph_fourier_sA(const Params& p, int bid, int nb, char* smc) {
    for (int tile = bid; tile < NB * 128 * 2; tile += nb) {
        const int nt = tile & 1, mt = (tile >> 1) & 127, b = tile >> 8;
        ACC_DECL(4, acc); acc_zero(acc);
        gemm_accum<4>(acc, [&](int i) { return p.fcs + ((size_t)b * 16384 + mt * 128 + i) * 256; },
                      [&](int j) { return p.fWA + (size_t)(nt * 128 + j) * 256; }, 256, smc);
        ACC_FOR_PAIR(row, pcol) {
            const int k1 = nt * 64 + pcol; const int rr = mt * 128 + row; const int ch = rr >> 6, t2 = rr & 63;
            const float re = AV_G(acc), im = AV_U(acc);
            const float c = p.cosT[k1 * t2], sn = p.sinT[k1 * t2];
            bf16* o = p.fa2 + ((((size_t)b * 128 + k1) * 256 + ch) * 2) * 64 + t2;
            o[0] = f2bf(re * c + im * sn); o[64] = f2bf(im * c - re * sn);
        } ACC_END
    }
}
HD void ph_fourier_sB(const Params& p, int bid, int nb, char* smc) {
    const float nrm = 1.0f / sqrtf((float)SEQ * 64.0f);
    for (int tile = bid; tile < NB * 128 * 2; tile += nb) {
        const int cht = tile & 1, k1 = (tile >> 1) & 127, b = tile >> 8;
        ACC_DECL(2, acc); acc_zero(acc);
        gemm_accum<2>(acc, [&](int i) { return p.fa2 + (((size_t)b * 128 + k1) * 256 + cht * 128 + i) * 128; },
                      [&](int j) { return p.fWB + j * 128; }, 128, smc);
        ACC_FOR(2, row, col) {
            p.br[(size_t)(b * SEQ + k1 + 128 * col) * D + 768 + cht * 128 + row] = f2bf(AV(acc) * nrm);
        } ACC_END
    }
}

#ifndef CPU_EMU
HD void ph_gdn_scan(const Params& p, int l, int bid, int nb, float* smf) {
    char* smc = (char*)smf;
    const int t = tid_(), lane = t & 63, w = t >> 6, fr = lane & 15, fg = lane >> 4;
    const int RQ = (l == 0) ? R : NLAT;
    constexpr int STG = 32768;
    char* sST = smc + 65536;
    char* sVT = smc + 65536 + 2048;
    char* sVS = smc + 65536 + 4096;
    float* sG = (float*)(smc + 65536 + 6144);
    const lds_cptr lds = (lds_cptr)smc;
    const int lkey = t >> 3, lc = t & 7;
    const int ksrc = (lc ^ (lkey & 7)) << 3;
    char* ldst = smc + w * 1024;
    for (int cu = bid; cu < 2 * NB * 4 * 4; cu += nb) {
        const int chain = cu >> 2, cb = cu & 3;
        auto stage = [&](int n, int buf) {
            const int unit = chain * NCH + n;
            const ChunkInfo c = chunkinfo(unit);
#pragma unroll
            for (int i = 0; i < 2; ++i) {
                const int ci = lkey + 32 * i;
                const int fsw = ((ci >> 1) & 1) | (((ci >> 3) & 1) << 1);
                const int k16 = ((((lc >> 1) ^ fsw) << 1) | (lc & 1)) << 3;
                const bf16* gsrc = p.gq + (size_t)chunk_row(c, ci) * 768 + c.hd * 64;
                GLDS16(p.cW + (size_t)unit * 4096 + ci * 64 + ksrc, ldst + buf * STG + 4096 * i);
                GLDS16(p.cQK + (size_t)unit * 4096 + ci * 64 + ksrc, ldst + buf * STG + 8192 + 4096 * i);
                GLDS16(gsrc + ksrc, ldst + buf * STG + 16384 + 4096 * i);
                GLDS16(gsrc + 256 + k16, ldst + buf * STG + 24576 + 4096 * i);
            }
        };
        f32x4_t S = f32x4_t{0.f, 0.f, 0.f, 0.f};
        __syncthreads();
        stage(0, 0);
        if (t < 64) sG[t] = p.cG[(size_t)(chain * NCH) * 64 + t];
        if (t < 512) ((unsigned*)sST)[t] = 0u;
        ((unsigned*)sST)[t + 256] = 0u;
        float un[4];
        {
            const ChunkInfo c0 = chunkinfo(chain * NCH);
            (void)c0;
#pragma unroll
            for (int r = 0; r < 4; ++r) un[r] = bf2f(p.cU[(size_t)(chain * NCH) * 4096 + (16 * w + 4 * fg + r) * 64 + cb * 16 + fr]);
        }
        WAIT_VM0();
        __syncthreads();
        const unsigned ro = (16 * w + fr) * 128;
        const unsigned c0 = ((fg) ^ (fr & 7)) << 4, c1 = ((4 + fg) ^ (fr & 7)) << 4;
        const unsigned bo0 = fr * 128 + c0, bo1 = fr * 128 + c1;
        const unsigned wofs = fr * 128 + ((((2 * w + (fg >> 1)) ^ (fr & 7))) << 4) + (fg & 1) * 8;
        unsigned ka[2][2];
#pragma unroll
        for (int s_ = 0; s_ < 2; ++s_)
#pragma unroll
            for (int h2 = 0; h2 < 2; ++h2) {
                const int cr = 32 * s_ + 8 * fg + (fr >> 2) + 4 * h2;
                const int fsw = ((cr >> 1) & 1) | (((cr >> 3) & 1) << 1);
                ka[s_][h2] = 24576 + cr * 128 + (((((w ^ fsw) << 1) | ((fr & 3) >> 1))) << 4) + (fr & 1) * 8;
            }
#pragma unroll 1
        for (int n = 0; n < NCH; ++n) {
            const int cur = n & 1;
            const int unit = chain * NCH + n;
            const ChunkInfo c = chunkinfo(unit);
            float gnext = 0.f; float unx[4] = {0.f, 0.f, 0.f, 0.f};
            if (n + 1 < NCH) {
                stage(n + 1, cur ^ 1);
                if (t < 64) gnext = p.cG[(size_t)(unit + 1) * 64 + t];
#pragma unroll
                for (int r = 0; r < 4; ++r) unx[r] = bf2f(p.cU[(size_t)(unit + 1) * 4096 + (16 * w + 4 * fg + r) * 64 + cb * 16 + fr]);
            }
            const char* st = smc + cur * STG;
            const float* g = sG + cur * 64;
            const f32x4_t gv = *(const f32x4_t*)(g + 16 * w + 4 * fg);
            const float g63 = g[63];
            const bf16x8_t st0 = *(const bf16x8_t*)(sST + bo0), st1 = *(const bf16x8_t*)(sST + bo1);
            f32x4_t v = __builtin_amdgcn_mfma_f32_16x16x32_bf16(*(const bf16x8_t*)(st + ro + c0), st0, f32x4_t{0.f, 0.f, 0.f, 0.f}, 0, 0, 0);
            v = __builtin_amdgcn_mfma_f32_16x16x32_bf16(*(const bf16x8_t*)(st + ro + c1), st1, v, 0, 0, 0);
            f32x4_t o1 = __builtin_amdgcn_mfma_f32_16x16x32_bf16(*(const bf16x8_t*)(st + 16384 + ro + c0), st0, f32x4_t{0.f, 0.f, 0.f, 0.f}, 0, 0, 0);
            o1 = __builtin_amdgcn_mfma_f32_16x16x32_bf16(*(const bf16x8_t*)(st + 16384 + ro + c1), st1, o1, 0, 0, 0);
            float vn[4];
#pragma unroll
            for (int r = 0; r < 4; ++r) vn[r] = un[r] - v[r];
            { uint2 pk; pk.x = cvtpk(vn[0], vn[1]); pk.y = cvtpk(vn[2], vn[3]); *(uint2*)(sVT + wofs) = pk; }
            { uint2 pk; pk.x = cvtpk(vn[0] * __expf(g63 - gv[0]), vn[1] * __expf(g63 - gv[1]));
              pk.y = cvtpk(vn[2] * __expf(g63 - gv[2]), vn[3] * __expf(g63 - gv[3])); *(uint2*)(sVS + wofs) = pk; }
            __syncthreads();
            const bf16x8_t vt0 = *(const bf16x8_t*)(sVT + bo0), vt1 = *(const bf16x8_t*)(sVT + bo1);
            f32x4_t o2 = __builtin_amdgcn_mfma_f32_16x16x32_bf16(*(const bf16x8_t*)(st + 8192 + ro + c0), vt0, f32x4_t{0.f, 0.f, 0.f, 0.f}, 0, 0, 0);
            o2 = __builtin_amdgcn_mfma_f32_16x16x32_bf16(*(const bf16x8_t*)(st + 8192 + ro + c1), vt1, o2, 0, 0, 0);
            const bf16x8_t vs0 = *(const bf16x8_t*)(sVS + bo0), vs1 = *(const bf16x8_t*)(sVS + bo1);
            f32x4_t dS;
            {
                const lds_cptr kb = lds + cur * STG;
                const s16x4_t a00 = lds_tr16(kb + ka[0][0]), a01 = lds_tr16(kb + ka[0][1]);
                const s16x4_t a10 = lds_tr16(kb + ka[1][0]), a11 = lds_tr16(kb + ka[1][1]);
                dS = __builtin_amdgcn_mfma_f32_16x16x32_bf16(bf16x8_t{a00[0], a00[1], a00[2], a00[3], a01[0], a01[1], a01[2], a01[3]}, vs0, f32x4_t{0.f, 0.f, 0.f, 0.f}, 0, 0, 0);
                dS = __builtin_amdgcn_mfma_f32_16x16x32_bf16(bf16x8_t{a10[0], a10[1], a10[2], a10[3], a11[0], a11[1], a11[2], a11[3]}, vs1, dS, 0, 0, 0);
            }
            const float e63 = __expf(g63);
#pragma unroll
            for (int r = 0; r < 4; ++r) S[r] = S[r] * e63 + dS[r];
            { uint2 pk; pk.x = cvtpk(S[0], S[1]); pk.y = cvtpk(S[2], S[3]); *(uint2*)(sST + wofs) = pk; }
#pragma unroll
            for (int r = 0; r < 4; ++r) {
                const int row = chunk_row(c, 16 * w + 4 * fg + r);
                if (row < RQ) p.odir[((size_t)c.dir * R + row) * 256 + c.hd * 64 + cb * 16 + fr] = f2bf(__expf(gv[r]) * o1[r] + o2[r]);
            }
            if (t < 64) sG[(cur ^ 1) * 64 + t] = gnext;
#pragma unroll
            for (int r = 0; r < 4; ++r) un[r] = unx[r];
            WAIT_VM0();
            __syncthreads();
        }
    }
}
#else
HD void ph_gdn_scan(const Params& p, int l, int bid, int nb, float* sm) {
    float* sQ = sm;
    float* sK = sm + 4096;
    bf16* sW = (bf16*)(sm + 8192);
    bf16* sQK = (bf16*)(sm + 10240);
    float* sS = sm + 12288;
    float* sV = sm + 13312;
    float* sU = sm + 14336;
    float* sG = sm + 15360;
    const int RQ = (l == 0) ? R : NLAT;
    for (int cu = bid; cu < 2 * NB * 4 * 4; cu += nb) {
        int chain = cu >> 2, cb = cu & 3;
        THREADS(t, 1024) { sS[t] = 0.f; }
        SYNC
        for (int n = 0; n < NCH; ++n) {
            int unit = chain * NCH + n;
            ChunkInfo c = chunkinfo(unit);
            THREADS(t, 64) { sG[t] = p.cG[(size_t)unit * 64 + t]; }
            SYNC
            THREADS(t, 4096) {
                int i = t >> 6, d = t & 63; int row = chunk_row(c, i);
                sW[t] = p.cW[(size_t)unit * 4096 + t];
                sQK[t] = p.cQK[(size_t)unit * 4096 + t];
                sQ[t] = bf2f(p.gq[(size_t)row * 768 + c.hd * 64 + d]) * expf(sG[i]);
                sK[t] = bf2f(p.gq[(size_t)row * 768 + 256 + c.hd * 64 + d]) * expf(sG[63] - sG[i]);
            }
            THREADS(t, 1024) { int i = t >> 4, e = t & 15; sU[t] = bf2f(p.cU[(size_t)unit * 4096 + i * 64 + cb * 16 + e]); }
            SYNC
            THREADS(t, 1024) {
                int i = t >> 4, e = t & 15;
                float acc = sU[t];
                for (int d = 0; d < 64; ++d) acc -= bf2f(sW[i * 64 + d]) * sS[d * 16 + e];
                sV[t] = acc;
            }
            SYNC
            THREADS(t, 1024) {
                int i = t >> 4, e = t & 15;
                float acc = 0.f;
                for (int d = 0; d < 64; ++d) acc += sQ[i * 64 + d] * sS[d * 16 + e];
                for (int j = 0; j < 64; ++j) acc += bf2f(sQK[i * 64 + j]) * sV[j * 16 + e];
                int row = chunk_row(c, i);
                if (row < RQ) p.odir[((size_t)c.dir * R + row) * 256 + c.hd * 64 + cb * 16 + e] = f2bf(acc);
            }
            SYNC
            THREADS(t, 1024) {
                int d = t >> 4, e = t & 15;
                float acc = sS[t] * expf(sG[63]);
                for (int i = 0; i < 64; ++i) acc += sK[i * 64 + d] * sV[i * 16 + e];
                sS[t] = acc;
            }
            SYNC
        }
    }
}

#endif

#ifndef CPU_EMU
HD void ph_gdn_fin(const Params& p, int l, int bid, int nb) {
    const int RQ = (l == 0) ? R : NLAT;
    const float* og = p.in[I_ONORM] + l * 64;
    const int N = RQ * 32;
    for (int idx = bid * 256 + tid_(); idx < N; idx += nb * 256) {
        const int r = idx >> 5, q = idx & 31; const int hd = q >> 3, cg = q & 7;
        const uint4 a0 = *(const uint4*)(p.odir + (size_t)r * 256 + hd * 64 + cg * 8);
        const uint4 a1 = *(const uint4*)(p.odir + ((size_t)R + r) * 256 + hd * 64 + cg * 8);
        const uint4 zz = *(const uint4*)(p.P + (size_t)r * PLD + C_Z + hd * 64 + cg * 8);
        float v[8], z[8];
        v[0] = __uint_as_float(a0.x << 16) + __uint_as_float(a1.x << 16); v[1] = __uint_as_float(a0.x & 0xffff0000u) + __uint_as_float(a1.x & 0xffff0000u);
        v[2] = __uint_as_float(a0.y << 16) + __uint_as_float(a1.y << 16); v[3] = __uint_as_float(a0.y & 0xffff0000u) + __uint_as_float(a1.y & 0xffff0000u);
        v[4] = __uint_as_float(a0.z << 16) + __uint_as_float(a1.z << 16); v[5] = __uint_as_float(a0.z & 0xffff0000u) + __uint_as_float(a1.z & 0xffff0000u);
        v[6] = __uint_as_float(a0.w << 16) + __uint_as_float(a1.w << 16); v[7] = __uint_as_float(a0.w & 0xffff0000u) + __uint_as_float(a1.w & 0xffff0000u);
        z[0] = __uint_as_float(zz.x << 16); z[1] = __uint_as_float(zz.x & 0xffff0000u); z[2] = __uint_as_float(zz.y << 16); z[3] = __uint_as_float(zz.y & 0xffff0000u);
        z[4] = __uint_as_float(zz.z << 16); z[5] = __uint_as_float(zz.z & 0xffff0000u); z[6] = __uint_as_float(zz.w << 16); z[7] = __uint_as_float(zz.w & 0xffff0000u);
        float ss = 0.f;
#pragma unroll
        for (int c = 0; c < 8; ++c) ss += v[c] * v[c];
        ss += __shfl_xor(ss, 1); ss += __shfl_xor(ss, 2); ss += __shfl_xor(ss, 4);
        const float rs = 1.0f / sqrtf(ss / 64.0f + 1e-6f);
        float o[8];
#pragma unroll
        for (int c = 0; c < 8; ++c) o[c] = v[c] * rs * og[cg * 8 + c] * siluf_(z[c]);
        uint4 pk; pk.x = cvtpk(o[0], o[1]); pk.y = cvtpk(o[2], o[3]); pk.z = cvtpk(o[4], o[5]); pk.w = cvtpk(o[6], o[7]);
        *(uint4*)(p.br + (size_t)r * D + 512 + hd * 64 + cg * 8) = pk;
    }
}
#else
HD void ph_gdn_fin(const Params& p, int l, int bid, int nb) {
    const int RQ = (l == 0) ? R : NLAT;
    const float* og = p.in[I_ONORM] + l * 64;
    const int N = RQ * 4;
    for (int u = bid; u < (N + 255) / 256; u += nb) {
        THREADS(t, 256) {
            int idx = u * 256 + t;
            if (idx < N) {
                int r = idx >> 2, hd = idx & 3;
                const bf16* o0 = p.odir + (size_t)r * 256 + hd * 64;
                const bf16* o1 = p.odir + ((size_t)R + r) * 256 + hd * 64;
                float ss = 0.f;
                for (int d = 0; d < 64; ++d) { float v = bf2f(o0[d]) + bf2f(o1[d]); ss += v * v; }
                float rs = 1.0f / sqrtf(ss / 64.0f + 1e-6f);
                for (int d = 0; d < 64; ++d) {
                    float v = (bf2f(o0[d]) + bf2f(o1[d])) * rs * og[d];
                    float z = bf2f(p.P[(size_t)r * PLD + C_Z + hd * 64 + d]);
                    p.br[(size_t)r * D + 512 + hd * 64 + d] = f2bf(v * siluf_(z));
                }
            }
        }
    }
}

#endif

HD void ph_merge(const Params& p, int l, int bid, int nb, char* smc) {
    const int MT = ((l == 0) ? R : NLAT) / 128;
    const bf16* Wg = p.wt_in + (size_t)l * WIN_NP * D + (size_t)PLD * D;
    const bf16* Wb = p.wt_br + (size_t)l * 4 * D * 256;
    for (int tile = bid; tile < MT * 16; tile += nb) {
        const int mt = tile >> 4, nt = tile & 15;
        ACC_DECL(2, accM); acc_zero(accM);
        for (int i = 0; i < 4; ++i) {
            ACC_DECL(2, accG); acc_zero(accG);
            ACC_DECL(2, accP); acc_zero(accP);
            gemm_accum<2>(accG, [&](int r) { return p.h + (size_t)(mt * 128 + r) * D; },
                          [&](int j) { return Wg + (size_t)(i * 1024 + nt * 64 + j) * D; }, D, smc);
            gemm_accum<2>(accP, [&](int r) { return p.br + (size_t)(mt * 128 + r) * D + i * 256; },
                          [&](int j) { return Wb + ((size_t)i * D + nt * 64 + j) * 256; }, 256, smc);
            ACC_FOR(2, row, col) { AV(accM) += sigmoidf_(AV(accG)) * AV(accP); } ACC_END
        }
        ACC_FOR(2, row, col) { p.mg[(size_t)(mt * 128 + row) * D + nt * 64 + col] = f2bf(AV(accM)); } ACC_END
    }
}

HD void ph_outproj(const Params& p, int l, int bid, int nb, char* smc) {
    const int MT = ((l == 0) ? R : NLAT) / 128;
    const bf16* Wt = p.wt_out + (size_t)l * D * D;
    for (int tile = bid; tile < MT * 8; tile += nb) {
        const int mt = tile >> 3, nt = tile & 7;
        ACC_DECL(4, acc); acc_zero(acc);
        gemm_accum<4>(acc, [&](int r) { return p.mg + (size_t)(mt * 128 + r) * D; }, [&](int j) { return Wt + (size_t)(nt * 128 + j) * D; }, D, smc);
        ACC_FOR(4, row, col) {
            const int r = mt * 128 + row, c = nt * 128 + col;
            xrow_out(p, r)[c] = xrow_in(p, l, r)[c] + modrow(p, l, r)[2048 + c] * AV(acc);
        } ACC_END
    }
}

#ifndef CPU_EMU
HD void ph_router(const Params& p, int l, int bid, int nb, float* smf) {
    char* smc = (char*)smf;
    const int t = tid_(), lane = t & 63, w = t >> 6, fr = lane & 15, fg = lane >> 4;
    const int RQ = (l == 0) ? R : NLAT;
    const float* gN = p.in[I_N2G] + l * D;
    constexpr int WST = 2080;
    float* lgw = (float*)(smc + 66560) + w * (16 * 17);
    int* lcnt = (int*)(smc + 70912); int* gbase = (int*)(smc + 70976);
    __syncthreads();
    for (int k = t; k < 1024; k += 256) {
        const float* wrow = p.in[I_WROUTER] + k * 16;
#pragma unroll
        for (int e = 0; e < 16; ++e) {
            const float v = wrow[e]; const bf16 hi = f2bf(v);
            *(bf16*)(smc + e * WST + k * 2) = hi; *(bf16*)(smc + 33280 + e * WST + k * 2) = f2bf(v - bf2f(hi));
        }
    }
    const int ngroups = RQ / 16;
    for (int g0 = bid * 4; g0 < ngroups; g0 += nb * 4) {
        __syncthreads();
        if (t < 16) lcnt[t] = 0;
        __syncthreads();
        const int gidx = g0 + w;
        const bool active = gidx < ngroups;
        int e1 = 0, e2 = 0, q1 = 0, q2 = 0; const int rsel = gidx * 16 + lane;
        if (active) {
            const int r = gidx * 16 + fr;
            const float* x = xrow_out(p, r);
            const float* m = modrow(p, l, r);
            float ss = 0.f;
#pragma unroll 4
            for (int s_ = 0; s_ < 32; ++s_) {
                const f32x4_t a = *(const f32x4_t*)(x + s_ * 32 + fg * 8), b = *(const f32x4_t*)(x + s_ * 32 + fg * 8 + 4);
                ss += a[0] * a[0] + a[1] * a[1] + a[2] * a[2] + a[3] * a[3] + b[0] * b[0] + b[1] * b[1] + b[2] * b[2] + b[3] * b[3];
            }
            ss += __shfl_xor(ss, 16); ss += __shfl_xor(ss, 32);
            const float rs = 1.0f / sqrtf(ss / D + 1e-6f);
            f32x4_t acc = f32x4_t{0.f, 0.f, 0.f, 0.f};
#pragma unroll 2
            for (int s_ = 0; s_ < 32; ++s_) {
                const int k0 = s_ * 32 + fg * 8;
                float hv[8];
#pragma unroll
                for (int hh = 0; hh < 2; ++hh) {
                    const f32x4_t xv = *(const f32x4_t*)(x + k0 + hh * 4), gv = *(const f32x4_t*)(gN + k0 + hh * 4);
                    const f32x4_t sc = *(const f32x4_t*)(m + 4096 + k0 + hh * 4), sh = *(const f32x4_t*)(m + 3072 + k0 + hh * 4);
#pragma unroll
                    for (int q = 0; q < 4; ++q) hv[hh * 4 + q] = xv[q] * rs * gv[q] * (1.0f + sc[q]) + sh[q];
                }
                unsigned hi[4], lo[4];
#pragma unroll
                for (int q = 0; q < 4; ++q) {
                    hi[q] = cvtpk(hv[2 * q], hv[2 * q + 1]);
                    lo[q] = cvtpk(hv[2 * q] - __uint_as_float(hi[q] << 16), hv[2 * q + 1] - __uint_as_float(hi[q] & 0xffff0000u));
                }
                const i32x4_t hiv = i32x4_t{(int)hi[0], (int)hi[1], (int)hi[2], (int)hi[3]}, lov = i32x4_t{(int)lo[0], (int)lo[1], (int)lo[2], (int)lo[3]};
                *(i32x4_t*)(p.h + (size_t)r * D + k0) = hiv;
                const bf16x8_t bh = *(const bf16x8_t*)(smc + fr * WST + s_ * 64 + fg * 16), bl = *(const bf16x8_t*)(smc + 33280 + fr * WST + s_ * 64 + fg * 16);
                acc = __builtin_amdgcn_mfma_f32_16x16x32_bf16(__builtin_bit_cast(bf16x8_t, hiv), bh, acc, 0, 0, 0);
                acc = __builtin_amdgcn_mfma_f32_16x16x32_bf16(__builtin_bit_cast(bf16x8_t, hiv), bl, acc, 0, 0, 0);
                acc = __builtin_amdgcn_mfma_f32_16x16x32_bf16(__builtin_bit_cast(bf16x8_t, lov), bh, acc, 0, 0, 0);
            }
#pragma unroll
            for (int q = 0; q < 4; ++q) lgw[(4 * fg + q) * 17 + fr] = acc[q];
            if (lane < 16) {
                float sc[16], sel[16];
#pragma unroll
                for (int e = 0; e < 16; ++e) { sc[e] = sigmoidf_(lgw[lane * 17 + e]); sel[e] = sc[e] + p.in[I_RBIAS][e]; }
                int best = 0; float bestv = -1e30f;
#pragma unroll
                for (int gph = 0; gph < 4; ++gph) {
                    float t1 = -1e30f, t2 = -1e30f;
#pragma unroll
                    for (int j = 0; j < 4; ++j) { const float v = sel[gph * 4 + j]; if (v > t1) { t2 = t1; t1 = v; } else if (v > t2) t2 = v; }
                    const float gs = t1 + t2;
                    if (gs > bestv) { bestv = gs; best = gph; }
                }
                float v1 = -1e30f, v2 = -1e30f, w1 = 0.f, w2 = 0.f; int i1 = 0, i2 = 0;
#pragma unroll
                for (int e = 0; e < 16; ++e) {
                    if ((e >> 2) == best) {
                        const float v = sel[e];
                        if (v > v1) { v2 = v1; i2 = i1; w2 = w1; v1 = v; i1 = e; w1 = sc[e]; } else if (v > v2) { v2 = v; i2 = e; w2 = sc[e]; }
                    }
                }
                e1 = i1; e2 = i2;
                const float ws_ = w1 + w2;
                p.sel_e[rsel * 2] = i1; p.sel_e[rsel * 2 + 1] = i2;
                p.sel_w[rsel * 2] = w1 / ws_; p.sel_w[rsel * 2 + 1] = w2 / ws_;
                q1 = atomicAdd(&lcnt[i1], 1); q2 = atomicAdd(&lcnt[i2], 1);
            }
        }
        __syncthreads();
        if (t < 16) { const int c = lcnt[t]; gbase[t] = c ? atomicAdd(&p.cnt[l * 16 + t], c) : 0; }
        __syncthreads();
        if (active && lane < 16) {
            const int p1 = gbase[e1] + q1, p2 = gbase[e2] + q2;
            p.elist[(size_t)e1 * 2 * R + p1] = rsel * 2; p.apos[rsel * 2] = p1;
            p.elist[(size_t)e2 * 2 * R + p2] = rsel * 2 + 1; p.apos[rsel * 2 + 1] = p2;
        }
    }
}
#else
HD void ph_router(const Params& p, int l, int bid, int nb, float* sm) {
    const int RQ = (l == 0) ? R : NLAT;
    const float* g = p.in[I_N2G] + l * D;
    const float* wr = p.in[I_WROUTER];
    float* sh = sm + 512;
    float* sl = sm + 2048;
    for (int r = bid; r < RQ; r += nb) {
        const float* x = xrow_out(p, r);
        const float* m = modrow(p, l, r);
        THREADS(t, 256) { float s = 0.f; for (int k = t; k < D; k += 256) s += x[k] * x[k]; sm[t] = s; }
        SYNC
        THREADS(t, 1) { float s = 0.f; for (int i = 0; i < 256; ++i) s += sm[i]; sm[256] = s; }
        SYNC
        THREADS(t, 256) {
            float rs = 1.0f / sqrtf(sm[256] / D + 1e-6f);
            for (int k = t; k < D; k += 256) {
                float v = x[k] * rs * g[k];
                v = v * (1.0f + m[4096 + k]) + m[3072 + k];
                sh[k] = v;
                p.h[(size_t)r * D + k] = f2bf(v);
            }
        }
        SYNC
        THREADS(t, 256) {
            int e = t & 15, ks = t >> 4;
            float acc = 0.f;
            for (int k = ks * 64; k < ks * 64 + 64; ++k) acc += sh[k] * wr[k * 16 + e];
            sl[ks * 16 + e] = acc;
        }
        SYNC
        THREADS(t, 1) {
            float* sc = sm + 2304; float* sel = sm + 2320;
            for (int e = 0; e < 16; ++e) {
                float acc = 0.f;
                for (int ks = 0; ks < 16; ++ks) acc += sl[ks * 16 + e];
                sc[e] = sigmoidf_(acc); sel[e] = sc[e] + p.in[I_RBIAS][e];
            }
            int best = 0; float bestv = -1e30f;
            for (int gph = 0; gph < 4; ++gph) {
                float t1 = -1e30f, t2 = -1e30f;
                for (int j = 0; j < 4; ++j) { float v = sel[gph * 4 + j]; if (v > t1) { t2 = t1; t1 = v; } else if (v > t2) t2 = v; }
                float gs = t1 + t2;
                if (gs > bestv) { bestv = gs; best = gph; }
            }
            int i1 = -1, i2 = -1; float v1 = -1e30f, v2 = -1e30f;
            for (int j = 0; j < 4; ++j) {
                float v = sel[best * 4 + j];
                if (v > v1) { v2 = v1; i2 = i1; v1 = v; i1 = best * 4 + j; } else if (v > v2) { v2 = v; i2 = best * 4 + j; }
            }
            float w1 = sc[i1], w2 = sc[i2], ws = w1 + w2;
            p.sel_e[r * 2] = i1; p.sel_e[r * 2 + 1] = i2;
            p.sel_w[r * 2] = w1 / ws; p.sel_w[r * 2 + 1] = w2 / ws;
            int q1 = ATOMIC_ADD_RET(&p.cnt[l * 16 + i1], 1); p.elist[(size_t)i1 * 2 * R + q1] = r * 2; p.apos[r * 2] = q1;
            int q2 = ATOMIC_ADD_RET(&p.cnt[l * 16 + i2], 1); p.elist[(size_t)i2 * 2 * R + q2] = r * 2 + 1; p.apos[r * 2 + 1] = q2;
        }
        SYNC
    }
}

#endif

struct MoeTiles { int tstart[17]; };
HD MoeTiles moe_tiles(const Params& p, int l) {
    MoeTiles m; int acc = 0;
    for (int e = 0; e < 16; ++e) { m.tstart[e] = acc; acc += (p.cnt[l * 16 + e] + 127) >> 7; }
    m.tstart[16] = acc; return m;
}

HD void ph_ffn1(const Params& p, int l, int bid, int nb, char* smc) {
    int tstart[17];
    { int acc = 0; for (int e = 0; e < 16; ++e) { tstart[e] = acc; acc += (p.cnt[l * 16 + e] + 127) >> 7; } tstart[16] = acc; }
    const int ntiles = tstart[16];
    for (int tile = bid; tile < ntiles * 8; tile += nb) {
        const int rt = tile >> 3, nt = tile & 7;
        int e = 0, ts = 0;
#pragma unroll
        for (int q = 1; q < 16; ++q) if (rt >= tstart[q]) { e = q; ts = tstart[q]; }
        const int mt = rt - ts;
        const int cnt_e = p.cnt[l * 16 + e];
        const int* el = p.elist + (size_t)e * 2 * R;
        const bf16* Wt = p.wt_gu + (size_t)e * 1024 * D;
        ACC_DECL(4, acc); acc_zero(acc);
        gemm_accum<4>(acc, [&](int i) { int q = mt * 128 + i; int a = (q < cnt_e) ? el[q] : el[0]; return p.h + (size_t)(a >> 1) * D; },
                      [&](int j) { return Wt + (size_t)(nt * 128 + j) * D; }, D, smc);
        ACC_FOR_PAIR(row, pcol) {
            float gv = AV_G(acc), uv = AV_U(acc);
            p.act[(size_t)(rt * 128 + row) * 512 + nt * 64 + pcol] = f2bf(siluf_(gv) * uv);
        } ACC_END
    }
}

HD void ph_ffn2(const Params& p, int l, int bid, int nb, char* smc) {
    int tstart[17];
    { int acc = 0; for (int e = 0; e < 16; ++e) { tstart[e] = acc; acc += (p.cnt[l * 16 + e] + 127) >> 7; } tstart[16] = acc; }
    const int ntiles = tstart[16];
    for (int tile = bid; tile < ntiles * 8; tile += nb) {
        const int rt = tile >> 3, nt = tile & 7;
        int e = 0;
#pragma unroll
        for (int q = 1; q < 16; ++q) if (rt >= tstart[q]) e = q;
        const bf16* Wt = p.wt_d + (size_t)e * D * 512;
        ACC_DECL(4, acc); acc_zero(acc);
        gemm_accum<4>(acc, [&](int i) { return p.act + (size_t)(rt * 128 + i) * 512; }, [&](int j) { return Wt + (size_t)(nt * 128 + j) * 512; }, 512, smc);
        ACC_FOR(4, row, col) { p.Y[(size_t)(rt * 128 + row) * D + nt * 128 + col] = f2bf(AV(acc)); } ACC_END
    }
}

#ifndef CPU_EMU
HD void ph_combine(const Params& p, int l, int bid, int nb) {
    const int RQ = (l == 0) ? R : NLAT;
    const int t = tid_(), lane = t & 63, w = t >> 6;
    int tstart[17];
    { int acc = 0;
#pragma unroll
      for (int e = 0; e < 16; ++e) { tstart[e] = acc; acc += (p.cnt[l * 16 + e] + 127) >> 7; } tstart[16] = acc; }
    for (int r = bid * 4 + w; r < RQ; r += nb * 4) {
        float* xo = xrow_out(p, r);
        const float* m = modrow(p, l, r) + 5120;
        const int e0 = p.sel_e[r * 2], e1 = p.sel_e[r * 2 + 1];
        int t0 = 0, t1 = 0;
#pragma unroll
        for (int q = 0; q < 16; ++q) { if (q == e0) t0 = tstart[q]; if (q == e1) t1 = tstart[q]; }
        const bf16* y0 = p.Y + (size_t)(t0 * 128 + p.apos[r * 2]) * D;
        const bf16* y1 = p.Y + (size_t)(t1 * 128 + p.apos[r * 2 + 1]) * D;
        const float w0 = p.sel_w[r * 2], w1 = p.sel_w[r * 2 + 1];
#pragma unroll
        for (int j = 0; j < 4; ++j) {
            const int k = j * 256 + lane * 4;
            f32x4_t xv = *(const f32x4_t*)(xo + k);
            const f32x4_t gv = *(const f32x4_t*)(m + k);
            const uint2 a = *(const uint2*)(y0 + k), b = *(const uint2*)(y1 + k);
            xv[0] += gv[0] * (w0 * __uint_as_float(a.x << 16) + w1 * __uint_as_float(b.x << 16));
            xv[1] += gv[1] * (w0 * __uint_as_float(a.x & 0xffff0000u) + w1 * __uint_as_float(b.x & 0xffff0000u));
            xv[2] += gv[2] * (w0 * __uint_as_float(a.y << 16) + w1 * __uint_as_float(b.y << 16));
            xv[3] += gv[3] * (w0 * __uint_as_float(a.y & 0xffff0000u) + w1 * __uint_as_float(b.y & 0xffff0000u));
            *(f32x4_t*)(xo + k) = xv;
        }
    }
}
#else
HD void ph_combine(const Params& p, int l, int bid, int nb) {
    const int RQ = (l == 0) ? R : NLAT;
    int tstart[17];
    { int acc = 0; for (int e = 0; e < 16; ++e) { tstart[e] = acc; acc += (p.cnt[l * 16 + e] + 127) >> 7; } tstart[16] = acc; }
    for (int r = bid; r < RQ; r += nb) {
        float* xo = xrow_out(p, r);
        const float* m = modrow(p, l, r);
        int e0 = p.sel_e[r * 2], e1 = p.sel_e[r * 2 + 1];
        int t0 = 0, t1 = 0;
#pragma unroll
        for (int q = 0; q < 16; ++q) { if (q == e0) t0 = tstart[q]; if (q == e1) t1 = tstart[q]; }
        const bf16* y0 = p.Y + (size_t)(t0 * 128 + p.apos[r * 2]) * D;
        const bf16* y1 = p.Y + (size_t)(t1 * 128 + p.apos[r * 2 + 1]) * D;
        const float w0 = p.sel_w[r * 2], w1 = p.sel_w[r * 2 + 1];
        THREADS(t, 256) {
            for (int k = t; k < D; k += 256) xo[k] += m[5120 + k] * (w0 * bf2f(y0[k]) + w1 * bf2f(y1[k]));
        }
    }
}

#endif

constexpr int NPHASE_LAYER = 14;
HD void run_phase(const Params& p, int ph, int l, int bid, int nb, float* sm) {
    switch (ph) {
        case 0: ph_norm1(p, l, bid, nb, sm); break;
        case 1: ph_inproj(p, l, bid, nb, (char*)sm); break;
        case 2: ph_prep(p, l, bid, nb); if (FOURIER_GEMM) ph_fourier_s1(p, bid, nb, (char*)sm); break;
        case 3: ph_na(p, l, bid, nb, (char*)sm); break;
        case 4: ph_da(p, l, bid, nb, (char*)sm); break;
        case 5: ph_gdn_chunk(p, l, bid, nb, sm); break;
        case 6: ph_fourier2(p, l, bid, nb); if (FOURIER_GEMM) ph_fourier_sA(p, bid, nb, (char*)sm); break;
        case 7: ph_gdn_scan(p, l, bid, nb, sm); if (FOURIER_GEMM) ph_fourier_sB(p, bid, nb, (char*)sm); if (l == 1) convert_moe(p, 1, bid, nb, sm); break;
        case 8: ph_gdn_fin(p, l, bid, nb); break;
        case 9: ph_merge(p, l, bid, nb, (char*)sm); break;
        case 10: ph_outproj(p, l, bid, nb, (char*)sm); break;
        case 11: ph_router(p, l, bid, nb, sm); break;
        case 12: ph_ffn1(p, l, bid, nb, (char*)sm); break;
        case 13: ph_ffn2(p, l, bid, nb, (char*)sm); break;
        case 14: ph_combine(p, l, bid, nb); break;
        default: break;
    }
}

struct WsLayout { size_t ropeT, bar, fa2, fW1, fWA, fWB, mods, cosT, sinT, cs, gg, gbeta, sel_e, sel_w, cnt, elist, apos, cG, wt_in, wt_br, wt_out, wt_gu, wt_d,
                  h, P, gq, fcs, cU, cW, cQK, odir, br, mg, act, Y, total; };
inline WsLayout ws_layout() {
    WsLayout w; size_t o = 0;
    auto take = [&](size_t bytes) { size_t r = o; o += (bytes + 255) & ~(size_t)255; return r; };
    w.bar = take(3456 * 4); w.ropeT = take(128 * 8 * 2 * 4);
    w.mods = take(2 * 3 * 6144 * 4); w.cosT = take(SEQ * 4); w.sinT = take(SEQ * 4); w.cs = take((size_t)NCTX * D * 4);
    w.gg = take((size_t)8 * R * 4); w.gbeta = take((size_t)8 * R * 4); w.sel_e = take((size_t)R * 2 * 4); w.sel_w = take((size_t)R * 2 * 4);
    w.cnt = take(32 * 4); w.elist = take((size_t)16 * 2 * R * 4); w.apos = take((size_t)2 * R * 4); w.cG = take((size_t)NUNIT * 64 * 4);
    w.wt_in = take((size_t)2 * WIN_NP * D * 2); w.wt_br = take((size_t)2 * 4 * D * 256 * 2); w.wt_out = take((size_t)2 * D * D * 2);
    w.wt_gu = take((size_t)16 * 1024 * D * 2); w.wt_d = take((size_t)16 * D * 512 * 2);
    w.h = take((size_t)R * D * 2);
    w.fa2 = take((size_t)NB * 128 * 256 * 2 * 64 * 2); w.fW1 = take(8192 * 2); w.fWA = take(65536 * 2); w.fWB = take(8192 * 2);
    {
        const size_t szP = ((size_t)R * PLD * 2 + 255) & ~(size_t)255, szQ = ((size_t)R * 768 * 2 + 255) & ~(size_t)255;
        const size_t szA = ((size_t)PADROWS * 512 * 2 + 255) & ~(size_t)255, szY = ((size_t)PADROWS * 1024 * 2 + 255) & ~(size_t)255;
        const size_t base = take((szP + szQ) > (szA + szY) ? (szP + szQ) : (szA + szY));
        w.P = base; w.gq = base + szP; w.act = base; w.Y = base + szA;
    }
    w.fcs = take((size_t)R * 512 * 2);
    w.cU = take((size_t)NUNIT * 4096 * 2); w.cW = take((size_t)NUNIT * 4096 * 2); w.cQK = take((size_t)NUNIT * 4096 * 2);
    w.odir = take((size_t)2 * R * 256 * 2); w.br = take((size_t)R * D * 2);
    w.mg = w.cU;
    w.total = o;
    return w;
}
inline void fill_params(Params& p, void* const* d_in, void* d_out, void* d_ws) {
    WsLayout w = ws_layout(); char* b = (char*)d_ws;
    for (int i = 0; i < 30; ++i) p.in[i] = (const float*)d_in[i];
    p.out = (float*)d_out;
    p.mods = (float*)(b + w.mods); p.cosT = (float*)(b + w.cosT); p.sinT = (float*)(b + w.sinT); p.cs = (float*)(b + w.cs);
    p.h = (bf16*)(b + w.h); p.P = (bf16*)(b + w.P); p.gq = (bf16*)(b + w.gq); p.gg = (float*)(b + w.gg); p.gbeta = (float*)(b + w.gbeta);
    p.fcs = (bf16*)(b + w.fcs); p.cU = (bf16*)(b + w.cU); p.cW = (bf16*)(b + w.cW); p.cQK = (bf16*)(b + w.cQK); p.cG = (float*)(b + w.cG);
    p.odir = (bf16*)(b + w.odir); p.br = (bf16*)(b + w.br); p.mg = (bf16*)(b + w.mg); p.sel_e = (int*)(b + w.sel_e);
    p.sel_w = (float*)(b + w.sel_w); p.act = (bf16*)(b + w.act); p.Y = (bf16*)(b + w.Y);
    p.wt_in = (bf16*)(b + w.wt_in); p.wt_br = (bf16*)(b + w.wt_br); p.wt_out = (bf16*)(b + w.wt_out); p.wt_gu = (bf16*)(b + w.wt_gu);
    p.fa2 = (bf16*)(b + w.fa2); p.fW1 = (bf16*)(b + w.fW1); p.fWA = (bf16*)(b + w.fWA); p.fWB = (bf16*)(b + w.fWB);
    p.bar = (unsigned*)(b + w.bar); p.ropeT = (float*)(b + w.ropeT);
    p.wt_d = (bf16*)(b + w.wt_d); p.cnt = (int*)(b + w.cnt); p.elist = (int*)(b + w.elist); p.apos = (int*)(b + w.apos);
}

#if !defined(CPU_EMU) && defined(PHASE_KERNELS)
#define PK(n) __global__ void __launch_bounds__(256, 2) pk_##n(Params p) { __shared__ __attribute__((aligned(16))) float sm[SMEM_FLOATS]; run_phase(p, n, p.layer, blockIdx.x, gridDim.x, sm); }
PK(0) PK(1) PK(2) PK(3) PK(4) PK(5) PK(6) PK(7) PK(8) PK(9) PK(10) PK(11) PK(12) PK(13) PK(14)
__global__ void __launch_bounds__(256, 2) pk_init(Params p) { __shared__ __attribute__((aligned(16))) float sm[SMEM_FLOATS]; ph_init(p, blockIdx.x, gridDim.x, sm); }
#endif
#ifndef CPU_EMU

#define XB_TMO      128
#define XB_XCNT(j)  (256  + 64 * (j))
#define XB_XSUB(j)  (1280 + 64 * (j))
#define XB_XGEN(j)  (2304 + 64 * (j))
#define XB_TOP      3328
#define XB_TOPGEN   3392
#define XCD_BAR_WORDS 3456
#define XB_SPIN_CAP (1u << 22)
#define LAS __attribute__((address_space(3)))
__device__ __forceinline__ unsigned xb_ld(unsigned* p)              { return __hip_atomic_load(p, __ATOMIC_RELAXED, __HIP_MEMORY_SCOPE_AGENT); }
__device__ __forceinline__ unsigned xb_add(unsigned* p, unsigned v) { return __hip_atomic_fetch_add(p, v, __ATOMIC_RELAXED, __HIP_MEMORY_SCOPE_AGENT); }
__device__ __forceinline__ unsigned xb_xcc_id() { return (unsigned)__builtin_amdgcn_s_getreg((3 << 11) | 20) & 0xFu; }
#define XB_SPIN(cond, bar) do { unsigned _sp = 0; while (cond) { __builtin_amdgcn_s_sleep(1); \
    if ((++_sp & 255u) == 0u) { if (xb_ld(&(bar)[XB_TMO])) break; if (_sp > XB_SPIN_CAP) { atomicAdd(&(bar)[XB_TMO], 1u); break; } } } } while (0)
struct XcdBarrier { unsigned* bar; unsigned x; volatile LAS unsigned* st; };
__device__ __forceinline__ XcdBarrier xcd_barrier_post(unsigned* bar, volatile LAS unsigned* st) {
    XcdBarrier b; b.bar = bar; b.x = xb_xcc_id(); b.st = st;
    if (threadIdx.x == 0) (void)xb_add(&bar[XB_XCNT(b.x)], 1u);
    return b;
}
__device__ __forceinline__ void xcd_barrier_complete(unsigned* bar, unsigned x, unsigned& nloc, unsigned& nx) {
    const unsigned G = gridDim.x * gridDim.y * gridDim.z;
    unsigned sum, cnt, mine, sp = 0u;
    for (;;) {
        sum = 0u; cnt = 0u; mine = 0u;
#pragma unroll
        for (unsigned j = 0; j < 16; ++j) { const unsigned c = xb_ld(&bar[XB_XCNT(j)]); sum += c; cnt += (c > 0u) ? 1u : 0u; mine = (j == x) ? c : mine; }
        if (sum == G) break;
        __builtin_amdgcn_s_sleep(1);
        if ((++sp & 255u) == 0u) { if (xb_ld(&bar[XB_TMO])) break; if (sp > XB_SPIN_CAP) { atomicAdd(&bar[XB_TMO], 1u); break; } }
    }
    nloc = mine > 0u ? mine : 1u; nx = cnt > 0u ? cnt : 1u;
}
__device__ __forceinline__ void xcd_barrier(const XcdBarrier& b) {
    asm volatile("s_waitcnt vmcnt(0)" ::: "memory");
    __syncthreads();
    if (threadIdx.x == 0) {
        unsigned* bar = b.bar;
        __builtin_amdgcn_s_waitcnt(0);
        unsigned nloc = b.st[0], nx = b.st[1];
        if (nloc == 0u) { xcd_barrier_complete(bar, b.x, nloc, nx); b.st[0] = nloc; b.st[1] = nx; }
        const unsigned old = xb_add(&bar[XB_XSUB(b.x)], 1u);
        const unsigned gen = old / nloc;
        if (old + 1u == (gen + 1u) * nloc) {
            __builtin_amdgcn_fence(__ATOMIC_RELEASE, "agent");
            asm volatile("s_waitcnt vmcnt(0)" ::: "memory");
            const unsigned og = xb_add(&bar[XB_TOP], 1u);
            const unsigned tg = og / nx;
            if (og + 1u == (tg + 1u) * nx) xb_add(&bar[XB_TOPGEN], 1u);
            else XB_SPIN(xb_ld(&bar[XB_TOPGEN]) == tg, bar);
            __builtin_amdgcn_fence(__ATOMIC_ACQUIRE, "agent");
            xb_add(&bar[XB_XGEN(b.x)], 1u);
            asm volatile("s_waitcnt vmcnt(0)" ::: "memory");
        } else {
            XB_SPIN(xb_ld(&bar[XB_XGEN(b.x)]) == gen, bar);
            __builtin_amdgcn_fence(__ATOMIC_ACQUIRE, "agent");
            asm volatile("s_waitcnt vmcnt(0)" ::: "memory");
        }
    }
    __syncthreads();
}

__global__ void __launch_bounds__(256, 2) fwd_megakernel(Params p) {
    __shared__ __attribute__((aligned(16))) float sm[SMEM_FLOATS];
    cg::grid_group grid = cg::this_grid();
    const int bid = blockIdx.x, nb = gridDim.x;
    volatile LAS unsigned* xst = (volatile LAS unsigned*)(sm + SMEM_FLOATS - 4);
    if (threadIdx.x == 0) { xst[0] = 0u; xst[1] = 0u; }
    __syncthreads();
    XcdBarrier xb = xcd_barrier_post(p.bar, xst);
    ph_init(p, bid, nb, sm);
    grid.sync();
#define PH(n, l) run_phase(p, n, l, bid, nb, sm); xcd_barrier(xb);
#ifndef PROBE_X
#define PROBE_X(n, l)
#endif
#define LAYER(l) PH(0, l) PROBE_X(0, l) PH(1, l) PROBE_X(1, l) PH(2, l) PH(3, l) PROBE_X(3, l) PH(4, l) PROBE_X(4, l) PH(5, l) PROBE_X(5, l) \
    PH(6, l) PROBE_X(6, l) PH(7, l) PROBE_X(7, l) PH(8, l) PROBE_X(8, l) PH(9, l) PROBE_X(9, l) PH(10, l) PH(11, l) PH(12, l) PROBE_X(12, l) \
    PH(13, l) PROBE_X(13, l) PH(14, l)
    LAYER(0)
    LAYER(1)
}

extern "C" void kernel_launch(void* const* d_in, const int* in_sizes, int n_in, void* d_out, int out_size,
                              void* d_ws, size_t ws_size, hipStream_t stream) {
    WsLayout w = ws_layout();
    if (ws_size < w.total) { fprintf(stderr, "ws too small: need %zu have %zu\n", w.total, ws_size); return; }
    static int grid_blocks = 0;
    if (!grid_blocks) {
        int dev = 0, cus = 0, per_cu = 0;
        (void)hipGetDevice(&dev);
        (void)hipDeviceGetAttribute(&cus, hipDeviceAttributeMultiprocessorCount, dev);
        (void)hipOccupancyMaxActiveBlocksPerMultiprocessor(&per_cu, fwd_megakernel, 256, 0);
        if (per_cu < 1) per_cu = 1;
        grid_blocks = cus * per_cu;
    }
    Params p{};
    fill_params(p, d_in, d_out, d_ws);
    (void)hipMemsetAsync(p.bar, 0, XCD_BAR_WORDS * 4, stream);
    void* args[] = {&p};
    hipError_t e = hipLaunchCooperativeKernel((void*)fwd_megakernel, dim3(grid_blocks), dim3(256), args, 0, stream);
    if (e != hipSuccess) fprintf(stderr, "cooperative launch failed: %s (grid %d)\n", hipGetErrorString(e), grid_blocks);
}
#endif
```

```cpp
#ifndef CPU_EMU
#include <hip/hip_runtime.h>
#include <hip/hip_cooperative_groups.h>
#include <cstdio>
namespace cg = cooperative_groups;
#define HD __device__ __forceinline__
__device__ __forceinline__ int tid_() { int v = threadIdx.x; asm volatile("" : "+v"(v)); return v; }
#define THREADS(t, n) for (int t = tid_(); t < (n); t += 256)
#define SYNC __syncthreads();
#define COSPI(x) cospif(x)
#define SINPI(x) sinpif(x)
typedef float4 f4;
#else
#include <cmath>
#include <cstdio>
#include <cstring>
#include <cstddef>
#define HD inline
#define THREADS(t, n) for (int t = 0; t < (n); ++t)
#define SYNC
#define COSPI(x) ((float)cos(M_PI * (double)(x)))
#define SINPI(x) ((float)sin(M_PI * (double)(x)))
struct f4 { float x, y, z, w; };
#endif

#ifndef SEQ
#define SEQ 8192
#endif
#ifndef CTXL
#define CTXL 256
#endif

typedef unsigned short bf16;
#ifndef CPU_EMU
typedef __attribute__((ext_vector_type(8))) short bf16x8_t;
typedef __attribute__((ext_vector_type(4))) float f32x4_t;
typedef __attribute__((ext_vector_type(4))) int i32x4_t;
#define ATOMIC_ADD_RET(ptr, v) atomicAdd((ptr), (v))
#else
HD int atomic_add_ret_(int* p, int v) { int old;
#pragma omp atomic capture
    { old = *p; *p += v; }
    return old; }
#define ATOMIC_ADD_RET(ptr, v) atomic_add_ret_((ptr), (v))
#endif
constexpr int NB = 2, D = 1024, GW = 64, ROWS = SEQ / GW;
constexpr int NLAT = NB * SEQ, NCTX = NB * CTXL, R = NLAT + NCTX;
constexpr int DIN = 6928;
constexpr int PLD = 2816;
constexpr int C_NAQ = 0, C_NAK = 256, C_NAV = 512, C_DAQ = 768, C_DAK = 1024, C_DAV = 1280, C_GQ = 1536, C_Z = 2304,
              C_F = 2560;
constexpr int WIN_N = 6912;
constexpr int WIN_NP = WIN_N + 64;
constexpr int PADROWS = 2 * R + 16 * 128;
constexpr int NCC = CTXL / 64, NCL = SEQ / 64, NCH = NCC + NCL;
constexpr int NUNIT = 2 * NB * 4 * NCH;
constexpr bool FOURIER_GEMM = (SEQ == 8192);
constexpr int SMEM_FLOATS = 73 * 256 + 4;

struct Params {
    const float* in[30];
    float* out;
    float* mods;
    float* cosT;
    float* sinT;
    float* cs;
    bf16* h;
    bf16* P;
    bf16* gq;
    float* gg;
    float* gbeta;
    bf16* fcs;
    bf16* cU;
    bf16* cW;
    bf16* cQK;
    float* cG;
    bf16* odir;
    bf16* br;
    bf16* mg;
    int* sel_e;
    float* sel_w;
    bf16* act;
    bf16* Y;
    bf16* wt_in;
    bf16* wt_br;
    bf16* wt_out;
    bf16* wt_gu;
    bf16* wt_d;
    int* cnt;
    unsigned* bar;
    bf16* fa2;
    bf16* fW1;
    float* ropeT;
    bf16* fWA;
    bf16* fWB;
    int* elist;
    int* apos;
    int phase;
    int layer;
};

enum { I_X = 0, I_C, I_CTX, I_CCTX, I_WMOD, I_BMOD, I_N1G, I_N2G, I_WIN, I_NAQG, I_NAKG, I_RPB, I_DAQG, I_DAKG, I_LQ1, I_LK1,
       I_LQ2, I_LK2, I_SUBLN, I_CONVW, I_ALOG, I_DTB, I_ONORM, I_WBR, I_WOUT, I_WROUTER, I_RBIAS, I_MG, I_MU, I_MD };

HD float bf2f(bf16 v) { union { unsigned u; float f; } x; x.u = ((unsigned)v) << 16; return x.f; }
#ifndef CPU_EMU
typedef float f32x2_t __attribute__((ext_vector_type(2))); typedef __bf16 bf16x2_t __attribute__((ext_vector_type(2)));
typedef short s16x4_t __attribute__((ext_vector_type(4)));
typedef __attribute__((address_space(3))) const char* lds_cptr;
HD unsigned cvtpk(float lo, float hi) { f32x2_t v = {lo, hi}; bf16x2_t b = __builtin_convertvector(v, bf16x2_t); return __builtin_bit_cast(unsigned, b); }
HD bf16 f2bf(float f) { return (bf16)(cvtpk(f, 0.f) & 0xffffu); }
HD s16x4_t lds_tr16(lds_cptr p) { return __builtin_bit_cast(s16x4_t, __builtin_amdgcn_ds_read_tr16_b64_v4i16((__attribute__((address_space(3))) s16x4_t*)p)); }
#else
HD bf16 f2bf(float f) { union { unsigned u; float f; } x; x.f = f; unsigned u = x.u; u += 0x7fffu + ((u >> 16) & 1u); return (bf16)(u >> 16); }
#endif
HD float sigmoidf_(float x) { return 1.0f / (1.0f + expf(-x)); }
HD float siluf_(float x) { return x / (1.0f + expf(-x)); }

struct RowInfo { int seg, b, t, T, base; };
HD RowInfo rowinfo(int r) {
    RowInfo q;
    if (r < NLAT) { q.seg = 0; q.b = r / SEQ; q.t = r % SEQ; q.T = SEQ; q.base = q.b * SEQ; }
    else { int r2 = r - NLAT; q.seg = 1; q.b = r2 / CTXL; q.t = r2 % CTXL; q.T = CTXL; q.base = NLAT + q.b * CTXL; }
    return q;
}
HD const float* xrow_in(const Params& p, int l, int r) {
    if (r < NLAT) return (l == 0 ? p.in[I_X] : p.out) + (size_t)r * D;
    return p.cs + (size_t)(r - NLAT) * D;
}
HD float* xrow_out(const Params& p, int r) {
    if (r < NLAT) return p.out + (size_t)r * D;
    return p.cs + (size_t)(r - NLAT) * D;
}
HD const float* modrow(const Params& p, int l, int r) {
    int s = (r < NLAT) ? (r / SEQ) : 2;
    return p.mods + (size_t)(l * 3 + s) * 6144;
}
#ifndef CPU_EMU
HD unsigned char* gu8_of(const Params& p) { return (unsigned char*)p.wt_gu; }
HD unsigned char* d8_of(const Params& p) { return (unsigned char*)p.wt_gu + (size_t)16 * 1024 * 1024; }
HD unsigned char* h8_of(const Params& p) { return (unsigned char*)p.wt_gu + (size_t)16 * 1024 * 1024 + (size_t)16 * 1024 * 512; }
#endif
HD float lam_init_of(int l) { return l == 0 ? 0.2f : (0.8f - 0.6f * 0.7408182206817179f); }


#ifndef CPU_EMU
template <int NJ> struct AccT { f32x4_t v[4][NJ]; };
#define ACC_DECL(NJ, a) AccT<NJ> a
template <int NJ> HD void acc_zero(AccT<NJ>& a) {
#pragma unroll
    for (int i = 0; i < 4; ++i)
#pragma unroll
        for (int j = 0; j < NJ; ++j) a.v[i][j] = f32x4_t{0.f, 0.f, 0.f, 0.f};
}
#define ACC_FOR(NJ, row, col) { const int _t = tid_(); const int _ln = _t & 63, _w = _t >> 6; \
    _Pragma("unroll") for (int _i = 0; _i < 4; ++_i) _Pragma("unroll") for (int _j = 0; _j < NJ; ++_j) _Pragma("unroll") for (int _r = 0; _r < 4; ++_r) { \
    const int row = (_w >> 1) * 64 + _i * 16 + (_ln >> 4) * 4 + _r; const int col = (_w & 1) * (16 * NJ) + _j * 16 + (_ln & 15);
#define AV(a) a.v[_i][_j][_r]
#define ACC_END }}
#define ACC_FOR_PAIR(row, pcol) { const int _t = tid_(); const int _ln = _t & 63, _w = _t >> 6; \
    _Pragma("unroll") for (int _i = 0; _i < 4; ++_i) _Pragma("unroll") for (int _jj = 0; _jj < 2; ++_jj) _Pragma("unroll") for (int _r = 0; _r < 4; ++_r) { \
    const int row = (_w >> 1) * 64 + _i * 16 + (_ln >> 4) * 4 + _r; const int pcol = (_w & 1) * 32 + _jj * 16 + (_ln & 15);
#define AV_G(a) a.v[_i][2 * _jj][_r]
#define AV_U(a) a.v[_i][2 * _jj + 1][_r]

#define WAIT_VM0() asm volatile("s_waitcnt vmcnt(0)" ::: "memory")
#define GLDS16(gp, lp) __builtin_amdgcn_global_load_lds((const unsigned*)(gp), (unsigned*)(lp), 16, 0, 0)
template <int NJ, class AF, class BF>
HD void gemm_accum(AccT<NJ>& acc, AF arow, BF brow, int K, char* smem) {
    constexpr int NBL = NJ;
    const int t = tid_(), lane = t & 63, w = t >> 6, wr = w >> 1, wc = w & 1;
    const int lr = t >> 3, lc = t & 7;
    const bf16* ap[4]; const bf16* bp[NBL];
#pragma unroll
    for (int i = 0; i < 4; ++i) ap[i] = arow(lr + 32 * i) + ((lc ^ (lr & 7)) << 3);
#pragma unroll
    for (int i = 0; i < NBL; ++i) bp[i] = brow(lr + 32 * i) + ((lc ^ (lr & 7)) << 3);
    char* sA = smem + w * 1024; char* sB = smem + 32768 + w * 1024;
    const int fr = lane & 15, fg = lane >> 4;
    const unsigned aoff0 = (wr * 64 + fr) * 128 + (((fg) ^ (fr & 7)) << 4);
    const unsigned aoff1 = (wr * 64 + fr) * 128 + (((4 + fg) ^ (fr & 7)) << 4);
    const unsigned boff0 = (wc * (16 * NJ) + fr) * 128 + (((fg) ^ (fr & 7)) << 4);
    const unsigned boff1 = (wc * (16 * NJ) + fr) * 128 + (((4 + fg) ^ (fr & 7)) << 4);
    const int KT = K >> 6;
    __syncthreads();
#pragma unroll
    for (int i = 0; i < 4; ++i) GLDS16(ap[i], sA + 4096 * i);
#pragma unroll
    for (int i = 0; i < NBL; ++i) GLDS16(bp[i], sB + 4096 * i);
    WAIT_VM0();
    __syncthreads();
#pragma unroll 1
    for (int kt = 0; kt < KT; ++kt) {
        const int cur = kt & 1;
        if (kt + 1 < KT) {
#pragma unroll
            for (int i = 0; i < 4; ++i) GLDS16(ap[i] + (kt + 1) * 64, sA + (cur ^ 1) * 16384 + 4096 * i);
#pragma unroll
            for (int i = 0; i < NBL; ++i) GLDS16(bp[i] + (kt + 1) * 64, sB + (cur ^ 1) * 16384 + 4096 * i);
        }
        const char* cA = smem + cur * 16384; const char* cB = smem + 32768 + cur * 16384;
#pragma unroll
        for (int s = 0; s < 2; ++s) {
            bf16x8_t af[4], bfr[NJ];
#pragma unroll
            for (int i = 0; i < 4; ++i) af[i] = *(const bf16x8_t*)(cA + (s ? aoff1 : aoff0) + i * 2048);
#pragma unroll
            for (int j = 0; j < NJ; ++j) bfr[j] = *(const bf16x8_t*)(cB + (s ? boff1 : boff0) + j * 2048);
#pragma unroll
            for (int i = 0; i < 4; ++i)
#pragma unroll
                for (int j = 0; j < NJ; ++j) acc.v[i][j] = __builtin_amdgcn_mfma_f32_16x16x32_bf16(af[i], bfr[j], acc.v[i][j], 0, 0, 0);
        }
        WAIT_VM0();
        __syncthreads();
    }
}
template <int NJ> HD void acc_to_lds(const AccT<NJ>& acc, float* tl) {
    const int t = tid_(), lane = t & 63, w = t >> 6;
    constexpr int LD = 32 * NJ + 4;
    float* base = tl + ((w >> 1) * 64 + (lane >> 4) * 4) * LD + (w & 1) * (16 * NJ) + (lane & 15);
#pragma unroll
    for (int i = 0; i < 4; ++i)
#pragma unroll
        for (int j = 0; j < NJ; ++j)
#pragma unroll
            for (int r = 0; r < 4; ++r) base[(i * 16 + r) * LD + j * 16] = acc.v[i][j][r];
}
typedef int i32x8_t __attribute__((ext_vector_type(8)));
typedef unsigned char u8;
template <int NJ, class AF, class BF>
HD void gemm_accum8(AccT<NJ>& acc, AF arow, BF brow, int K, char* smem, int sa, int sb) {
    constexpr int NBL = NJ;
    const int t = tid_(), lane = t & 63, w = t >> 6, wr = w >> 1, wc = w & 1;
    const int lr = t >> 3, lc = t & 7;
    const u8* ap[4]; const u8* bp[NBL];
#pragma unroll
    for (int i = 0; i < 4; ++i) ap[i] = arow(lr + 32 * i) + ((lc ^ (lr & 7)) << 4);
#pragma unroll
    for (int i = 0; i < NBL; ++i) bp[i] = brow(lr + 32 * i) + ((lc ^ (lr & 7)) << 4);
    char* sA = smem + w * 1024; char* sB = smem + 32768 + w * 1024;
    const int fr = lane & 15, fg = lane >> 4;
    const unsigned aoff0 = (wr * 64 + fr) * 128 + (((2 * fg) ^ (fr & 7)) << 4);
    const unsigned aoff1 = (wr * 64 + fr) * 128 + (((2 * fg + 1) ^ (fr & 7)) << 4);
    const unsigned boff0 = (wc * (16 * NJ) + fr) * 128 + (((2 * fg) ^ (fr & 7)) << 4);
    const unsigned boff1 = (wc * (16 * NJ) + fr) * 128 + (((2 * fg + 1) ^ (fr & 7)) << 4);
    const int KT = K >> 7;
    __syncthreads();
#pragma unroll
    for (int i = 0; i < 4; ++i) GLDS16(ap[i], sA + 4096 * i);
#pragma unroll
    for (int i = 0; i < NBL; ++i) GLDS16(bp[i], sB + 4096 * i);
    WAIT_VM0();
    __syncthreads();
#pragma unroll 1
    for (int kt = 0; kt < KT; ++kt) {
        const int cur = kt & 1;
        if (kt + 1 < KT) {
#pragma unroll
            for (int i = 0; i < 4; ++i) GLDS16(ap[i] + (kt + 1) * 128, sA + (cur ^ 1) * 16384 + 4096 * i);
#pragma unroll
            for (int i = 0; i < NBL; ++i) GLDS16(bp[i] + (kt + 1) * 128, sB + (cur ^ 1) * 16384 + 4096 * i);
        }
        const char* cA = smem + cur * 16384; const char* cB = smem + 32768 + cur * 16384;
        i32x8_t af[4], bfr[NJ];
#pragma unroll
        for (int i = 0; i < 4; ++i) {
            const i32x4_t lo = *(const i32x4_t*)(cA + aoff0 + i * 2048), hi = *(const i32x4_t*)(cA + aoff1 + i * 2048);
            af[i] = i32x8_t{lo[0], lo[1], lo[2], lo[3], hi[0], hi[1], hi[2], hi[3]};
        }
#pragma unroll
        for (int j = 0; j < NJ; ++j) {
            const i32x4_t lo = *(const i32x4_t*)(cB + boff0 + j * 2048), hi = *(const i32x4_t*)(cB + boff1 + j * 2048);
            bfr[j] = i32x8_t{lo[0], lo[1], lo[2], lo[3], hi[0], hi[1], hi[2], hi[3]};
        }
#pragma unroll
        for (int i = 0; i < 4; ++i)
#pragma unroll
            for (int j = 0; j < NJ; ++j) acc.v[i][j] = __builtin_amdgcn_mfma_scale_f32_16x16x128_f8f6f4(af[i], bfr[j], acc.v[i][j], 0, 0, 0, sa, 0, sb);
        WAIT_VM0();
        __syncthreads();
    }
}
HD unsigned pack_fp8x4(float a, float b, float c, float d) {
    a = __builtin_amdgcn_fmed3f(a, -448.f, 448.f); b = __builtin_amdgcn_fmed3f(b, -448.f, 448.f);
    c = __builtin_amdgcn_fmed3f(c, -448.f, 448.f); d = __builtin_amdgcn_fmed3f(d, -448.f, 448.f);
    int w = 0;
    w = __builtin_amdgcn_cvt_pk_fp8_f32(a, b, w, false);
    w = __builtin_amdgcn_cvt_pk_fp8_f32(c, d, w, true);
    return (unsigned)w;
}
constexpr int SC_H = 0x7d7d7d7d;
constexpr int SC_W = 0x7a7a7a7a;
constexpr int SC_ACT = 0x7b7b7b7b;
#else
template <int NJ> struct AccT { float v[128][32 * NJ]; };
#define ACC_DECL(NJ, a) static thread_local AccT<NJ> a
template <int NJ> HD void acc_zero(AccT<NJ>& a) { memset(a.v, 0, sizeof(a.v)); }
#define ACC_FOR(NJ, row, col) { for (int row = 0; row < 128; ++row) for (int col = 0; col < 32 * NJ; ++col) {
#define AV(a) a.v[row][col]
#define ACC_END }}
#define ACC_FOR_PAIR(row, pcol) { for (int row = 0; row < 128; ++row) for (int pcol = 0; pcol < 64; ++pcol) {
#define AV_G(a) a.v[row][(pcol / 16) * 32 + (pcol % 16)]
#define AV_U(a) a.v[row][(pcol / 16) * 32 + 16 + (pcol % 16)]
template <int NJ, class AF, class BF>
HD void gemm_accum(AccT<NJ>& acc, AF arow, BF brow, int K, char* smem) {
    for (int i = 0; i < 128; ++i) { const bf16* a = arow(i);
        for (int j = 0; j < 32 * NJ; ++j) { const bf16* b = brow(j); float s = 0.f;
            for (int k = 0; k < K; ++k) s += bf2f(a[k]) * bf2f(b[k]);
            acc.v[i][j] += s; } }
}
#endif

template <class DF>
HD void conv_tile(const float* src, size_t lds_, bf16* dst, size_t ldd, int k0, int nsrc0, DF drow, float* sm) {
    THREADS(t, 4096) { int kk = t >> 6, nn = t & 63; sm[kk * 65 + nn] = src[(size_t)(k0 + kk) * lds_ + nsrc0 + nn]; }
    SYNC
    THREADS(t, 4096) { int nn = t >> 6, kk = t & 63; dst[(size_t)drow(nn) * ldd + k0 + kk] = f2bf(sm[kk * 65 + nn]); }
    SYNC
}
#ifndef CPU_EMU
template <class DF>
HD void conv_tile8(const float* src, size_t lds_, unsigned char* dst, size_t ldd, int k0, int nsrc0, DF drow, float scale, float* sm) {
    THREADS(t, 4096) { int kk = t >> 6, nn = t & 63; sm[kk * 65 + nn] = src[(size_t)(k0 + kk) * lds_ + nsrc0 + nn] * scale; }
    SYNC
    THREADS(t, 1024) { int nn = t >> 4, k4 = (t & 15) * 4;
        *(unsigned*)(dst + (size_t)drow(nn) * ldd + k0 + k4) = pack_fp8x4(sm[k4 * 65 + nn], sm[(k4 + 1) * 65 + nn], sm[(k4 + 2) * 65 + nn], sm[(k4 + 3) * 65 + nn]); }
    SYNC
}
HD void convert_moe(const Params& p, int l, int bid, int nb, float* sm) {
    for (int w = bid; w < 4096 + 2048; w += nb) {
        if (w < 4096) {
            int nt = w & 7, kt = (w >> 3) & 15, gu = (w >> 7) & 1, e = w >> 8;
            const float* src = p.in[gu ? I_MU : I_MG] + (size_t)(l * 16 + e) * D * 512;
            conv_tile8(src, 512, gu8_of(p) + (size_t)e * 1024 * D, D, kt * 64, nt * 64, [&](int nn) { int j = nt * 64 + nn; return (j >> 4) * 32 + (j & 15) + 16 * gu; }, 32.0f, sm);
        } else {
            int w2 = w - 4096; int nt = w2 & 15, kt = (w2 >> 4) & 7, e = w2 >> 7;
            const float* src = p.in[I_MD] + (size_t)(l * 16 + e) * 512 * D;
            conv_tile8(src, D, d8_of(p) + (size_t)e * D * 512, 512, kt * 64, nt * 64, [&](int nn) { return nt * 64 + nn; }, 32.0f, sm);
        }
    }
}
#else
HD void convert_moe(const Params& p, int l, int bid, int nb, float* sm) {
    for (int w = bid; w < 4096 + 2048; w += nb) {
        if (w < 4096) {
            int nt = w & 7, kt = (w >> 3) & 15, gu = (w >> 7) & 1, e = w >> 8;
            const float* src = p.in[gu ? I_MU : I_MG] + (size_t)(l * 16 + e) * D * 512;
            bf16* dst = p.wt_gu + (size_t)e * 1024 * D;
            conv_tile(src, 512, dst, D, kt * 64, nt * 64, [&](int nn) { int j = nt * 64 + nn; return (j >> 4) * 32 + (j & 15) + 16 * gu; }, sm);
        } else {
            int w2 = w - 4096; int nt = w2 & 15, kt = (w2 >> 4) & 7, e = w2 >> 7;
            const float* src = p.in[I_MD] + (size_t)(l * 16 + e) * 512 * D;
            bf16* dst = p.wt_d + (size_t)e * D * 512;
            conv_tile(src, D, dst, 512, kt * 64, nt * 64, [&](int nn) { return nt * 64 + nn; }, sm);
        }
    }
}
#endif
HD void convert_static(const Params& p, int bid, int nb, float* sm, int part) {
    for (int w = bid; w < 3456 + 512 + 512 + 32; w += nb) {
        if ((part == 0) != (w < 3456 || w >= 3456 + 512 + 512)) continue;
        if (w >= 3456 + 512 + 512) {
            int w2 = w - 3456 - 512 - 512; int kt = w2 & 15, l = w2 >> 4;
            conv_tile(p.in[I_WIN] + (size_t)l * D * DIN, DIN, p.wt_in + (size_t)l * WIN_NP * D, D, kt * 64, 2560, [&](int nn) { return WIN_N + nn; }, sm);
        } else if (w < 3456) {
            int nt = w % 108, kt = (w / 108) & 15, l = w / (108 * 16);
            int n0 = nt * 64;
#ifndef CPU_EMU
            if (n0 >= PLD) {
                conv_tile8(p.in[I_WIN] + (size_t)l * D * DIN, DIN, (unsigned char*)(p.wt_in + (size_t)l * WIN_NP * D + (size_t)PLD * D), D, kt * 64, n0 + 16,
                           [&](int nn) { return n0 - PLD + nn; }, 32.0f, sm);
                continue;
            }
#endif
            conv_tile(p.in[I_WIN] + (size_t)l * D * DIN, DIN, p.wt_in + (size_t)l * WIN_NP * D, D, kt * 64, n0 < 2560 ? n0 : n0 + 16,
                      [&](int nn) { return n0 + nn; }, sm);
        } else if (w < 3456 + 512) {
            int w2 = w - 3456; int nt = w2 & 15, kt = (w2 >> 4) & 3, li = w2 >> 6;
            conv_tile(p.in[I_WBR] + (size_t)li * 256 * D, D, p.wt_br + (size_t)li * D * 256, 256, kt * 64, nt * 64, [&](int nn) { return nt * 64 + nn; }, sm);
        } else {
            int w2 = w - 3456 - 512; int nt = w2 & 15, kt = (w2 >> 4) & 15, l = w2 >> 8;
            conv_tile(p.in[I_WOUT] + (size_t)l * D * D, D, p.wt_out + (size_t)l * D * D, D, kt * 64, nt * 64, [&](int nn) { return nt * 64 + nn; }, sm);
        }
    }
}

HD void init_tables(const Params& p, int bid, int nb) {
    for (int u = bid; u < (SEQ + 255) / 256; u += nb) {
        THREADS(t, 256) {
            int j = u * 256 + t;
            if (j < SEQ) { float a = 2.0f * (float)j / (float)SEQ; p.cosT[j] = COSPI(a); p.sinT[j] = SINPI(a); }
        }
    }
    if (bid == 0) {
        THREADS(t, 1024) {
            int pos = t >> 3, f = t & 7; float fr_ = 1.0f;
            for (int q = 0; q < f; ++q) fr_ *= 0.31622776601683794f;
            float ang = (float)pos * fr_;
            p.ropeT[t * 2] = cosf(ang); p.ropeT[t * 2 + 1] = sinf(ang);
        }
    }
    for (int u = bid; u < (8192 + 65536 + 8192) / 256; u += nb) {
        THREADS(t, 256) {
            int i = u * 256 + t;
            if (i < 8192) {
                int j = i >> 6, c = i & 63; int cs = j >> 6, m = j & 63;
                float a = 2.0f * (float)((m * c) & 63) / 64.0f;
                p.fW1[i] = f2bf(cs ? SINPI(a) : COSPI(a));
            } else if (i < 8192 + 65536) {
                int q = i - 8192; int n = q >> 8, k = q & 255;
                int ri = (n >> 4) & 1, k1 = (n >> 5) * 16 + (n & 15); int cs = k >> 7, t1 = k & 127;
                float a = 2.0f * (float)((k1 * t1) & 127) / 128.0f;
                float cv = COSPI(a), sv = SINPI(a);
                float v = (ri == 0) ? (cs == 0 ? cv : -sv) : (cs == 0 ? -sv : -cv);
                p.fWA[q] = f2bf(v);
            } else {
                int q = i - 8192 - 65536; int k2 = q >> 7, k = q & 127; int ri = k >> 6, t2 = k & 63;
                float a = 2.0f * (float)((k2 * t2) & 63) / 64.0f;
                p.fWB[q] = f2bf(ri ? SINPI(a) : COSPI(a));
            }
        }
    }
}

HD void ph_init(const Params& p, int bid, int nb, float* sm) {
    const int NMOD = 2 * 3 * 6144;
    if (bid == 0) { THREADS(t, 32) { p.cnt[t] = 0; } }
    convert_static(p, bid, nb, sm, 0);
    for (int u = bid; u < (NMOD + 255) / 256; u += nb) {
        THREADS(t, 256) {
            int idx = u * 256 + t;
            if (idx < NMOD) {
                int l = idx / (3 * 6144), s = (idx / 6144) % 3, col = idx % 6144;
                const float* cv = (s < 2) ? p.in[I_C] + s * D : p.in[I_CCTX];
                const float* w = p.in[I_WMOD] + (size_t)l * D * 6144 + col;
                float acc = 0.f;
                for (int k = 0; k < D; ++k) acc += siluf_(cv[k]) * w[(size_t)k * 6144];
                p.mods[idx] = acc + p.in[I_BMOD][l * 6144 + col];
            }
        }
    }
    init_tables(p, bid, nb);
    for (int u = bid; u < (NCTX * D) / 256; u += nb) {
        THREADS(t, 256) { int i = u * 256 + t; p.cs[i] = p.in[I_CTX][i]; }
    }

}

#ifndef CPU_EMU
HD float wave_sum(float v) {
#pragma unroll
    for (int o = 32; o >= 1; o >>= 1) v += __shfl_xor(v, o);
    return v;
}
HD void ph_norm1(const Params& p, int l, int bid, int nb, float* sm) {
    const int t = tid_(), lane = t & 63, w = t >> 6;
    const float* g = p.in[I_N1G] + l * D;
    for (int r = bid * 4 + w; r < R; r += nb * 4) {
        const float* x = xrow_in(p, l, r);
        const float* m = modrow(p, l, r);
        f32x4_t xv[4]; float ss = 0.f;
#pragma unroll
        for (int j = 0; j < 4; ++j) { xv[j] = *(const f32x4_t*)(x + j * 256 + lane * 4); ss += xv[j][0] * xv[j][0] + xv[j][1] * xv[j][1] + xv[j][2] * xv[j][2] + xv[j][3] * xv[j][3]; }
        ss = wave_sum(ss);
        const float rs = 1.0f / sqrtf(ss / D + 1e-6f);
#pragma unroll
        for (int j = 0; j < 4; ++j) {
            const int k = j * 256 + lane * 4;
            const f32x4_t gv = *(const f32x4_t*)(g + k), sc = *(const f32x4_t*)(m + 1024 + k), sh = *(const f32x4_t*)(m + k);
            float o[4];
#pragma unroll
            for (int q = 0; q < 4; ++q) o[q] = xv[j][q] * rs * gv[q] * (1.0f + sc[q]) + sh[q];
            uint2 pk; pk.x = cvtpk(o[0], o[1]); pk.y = cvtpk(o[2], o[3]);
            *(uint2*)(p.h + (size_t)r * D + k) = pk;
            *(unsigned*)(h8_of(p) + (size_t)r * D + k) = pack_fp8x4(o[0] * 4.f, o[1] * 4.f, o[2] * 4.f, o[3] * 4.f);
        }
    }
}
#else
HD void ph_norm1(const Params& p, int l, int bid, int nb, float* sm) {
    const float* g = p.in[I_N1G] + l * D;
    for (int r = bid; r < R; r += nb) {
        const float* x = xrow_in(p, l, r);
        const float* m = modrow(p, l, r);
        THREADS(t, 256) { float s = 0.f; for (int k = t; k < D; k += 256) s += x[k] * x[k]; sm[t] = s; }
        SYNC
        THREADS(t, 1) { float s = 0.f; for (int i = 0; i < 256; ++i) s += sm[i]; sm[256] = s; }
        SYNC
        THREADS(t, 256) {
            float rs = 1.0f / sqrtf(sm[256] / D + 1e-6f);
            for (int k = t; k < D; k += 256) {
                float v = x[k] * rs * g[k];
                p.h[(size_t)r * D + k] = f2bf(v * (1.0f + m[1024 + k]) + m[k]);
            }
        }
        SYNC
    }
}
#endif

HD void ph_inproj(const Params& p, int l, int bid, int nb, char* smc) {
    const bf16* Wt = p.wt_in + (size_t)l * WIN_NP * D;
    constexpr int NT = PLD / 128, MT = R / 128;
    for (int mt = bid; mt < MT; mt += nb) {
        ACC_DECL(2, acc); acc_zero(acc);
        gemm_accum<2>(acc, [&](int i) { return p.h + (size_t)(mt * 128 + i) * D; }, [&](int j) { return Wt + (size_t)(WIN_N + j) * D; }, D, smc);
        ACC_FOR(2, row, col) {
            const int r = mt * 128 + row;
            if (col < 8) {
                const float xx = AV(acc) + p.in[I_DTB][l * 8 + col];
                const float sp = xx > 20.f ? xx : log1pf(expf(xx));
                p.gg[(size_t)col * R + r] = -expf(p.in[I_ALOG][l * 8 + col]) * sp;
            } else if (col < 16) p.gbeta[(size_t)(col - 8) * R + r] = sigmoidf_(AV(acc));
        } ACC_END
    }
    for (int tile = bid; tile < MT * NT; tile += nb) {
        const int mt = tile / NT, nt = tile % NT;
        ACC_DECL(4, acc); acc_zero(acc);
        gemm_accum<4>(acc, [&](int i) { return p.h + (size_t)(mt * 128 + i) * D; }, [&](int j) { return Wt + (size_t)(nt * 128 + j) * D; }, D, smc);
#ifndef CPU_EMU
        {
            float* tl = (float*)smc;
            acc_to_lds<4>(acc, tl);
            __syncthreads();
            const int t_ = tid_(); const int row = t_ >> 1, half = t_ & 1;
            const int cb = nt * 128 + half * 64;
            float v[64];
#pragma unroll
            for (int q = 0; q < 16; ++q) { const f32x4_t x4 = *(const f32x4_t*)(tl + row * 132 + half * 64 + q * 4); v[q * 4] = x4[0]; v[q * 4 + 1] = x4[1]; v[q * 4 + 2] = x4[2]; v[q * 4 + 3] = x4[3]; }
            if (cb < 512) {
                const float* gn = (cb < 256 ? p.in[I_NAQG] : p.in[I_NAKG]) + l * 64;
                float ss = 0.f;
#pragma unroll
                for (int c = 0; c < 64; ++c) ss += v[c] * v[c];
                const float rs = __builtin_amdgcn_rsqf(ss * (1.0f / 64.0f) + 1e-6f) * ((cb < 256) ? 0.125f * 1.4426950408889634f : 1.0f);
#pragma unroll
                for (int c = 0; c < 64; ++c) v[c] *= rs * gn[c];
            } else if (cb >= 768 && cb < 1280) {
                const float* gn = (cb < 1024 ? p.in[I_DAQG] : p.in[I_DAKG]) + l * 32;
                const float qs = (cb < 1024) ? 0.17677669529663687f * 1.4426950408889634f : 1.0f;
#pragma unroll
                for (int gp = 0; gp < 2; ++gp) {
                    float ss = 0.f;
#pragma unroll
                    for (int c = 0; c < 32; ++c) ss += v[gp * 32 + c] * v[gp * 32 + c];
                    const float rs = __builtin_amdgcn_rsqf(ss * (1.0f / 32.0f) + 1e-6f) * qs;
#pragma unroll
                    for (int c = 0; c < 32; ++c) v[gp * 32 + c] *= rs * gn[c];
                }
                const int gr_ = mt * 128 + row;
                if (gr_ < NLAT) {
                    const int tt = gr_ % SEQ;
#pragma unroll
                    for (int a = 0; a < 2; ++a) {
                        const float pos = (float)(a == 0 ? tt / GW : tt % GW);
                        float frev = 0.15915494309189535f;
#pragma unroll
                        for (int f = 0; f < 8; ++f) {
                            const float cs = __builtin_amdgcn_cosf(pos * frev), sn = __builtin_amdgcn_sinf(pos * frev);
#pragma unroll
                            for (int gp = 0; gp < 2; ++gp) {
                                const int i1 = gp * 32 + a * 16 + f, i2 = i1 + 8;
                                const float x1 = v[i1], x2 = v[i2];
                                v[i1] = x1 * cs - x2 * sn; v[i2] = x2 * cs + x1 * sn;
                            }
                            frev *= 0.31622776601683794f;
                        }
                    }
                }
            }
            bf16* dst = p.P + (size_t)(mt * 128 + row) * PLD + cb;
#pragma unroll
            for (int q = 0; q < 8; ++q) {
                uint4 pk; pk.x = cvtpk(v[q * 8], v[q * 8 + 1]); pk.y = cvtpk(v[q * 8 + 2], v[q * 8 + 3]); pk.z = cvtpk(v[q * 8 + 4], v[q * 8 + 5]); pk.w = cvtpk(v[q * 8 + 6], v[q * 8 + 7]);
                *(uint4*)(dst + q * 8) = pk;
            }
        }
#else
        ACC_FOR(4, row, col) { p.P[(size_t)(mt * 128 + row) * PLD + nt * 128 + col] = f2bf(AV(acc)); } ACC_END
#endif
    }
}

HD void ph_prep(const Params& p, int l, int bid, int nb) {
#ifdef CPU_EMU
    {
        const float* naq = p.in[I_NAQG] + l * 64; const float* nak = p.in[I_NAKG] + l * 64;
        const float* daq = p.in[I_DAQG] + l * 32; const float* dak = p.in[I_DAKG] + l * 32;
        const int N = R * 24;
        for (int u = bid; u < (N + 255) / 256; u += nb) {
            THREADS(t, 256) {
                int idx = u * 256 + t;
                if (idx < N) {
                    int r = idx / 24, gidx = idx % 24;
                    if (gidx < 8) {
                        int isk = gidx >> 2, hd = gidx & 3;
                        bf16* ptr = p.P + (size_t)r * PLD + (isk ? C_NAK : C_NAQ) + hd * 64;
                        const float* g = isk ? nak : naq;
                        float ss = 0.f;
                        for (int d = 0; d < 64; ++d) { float v = bf2f(ptr[d]); ss += v * v; }
                        float rs = 1.0f / sqrtf(ss / 64.0f + 1e-6f);
#ifndef CPU_EMU
                        if (!isk) rs *= 0.125f * 1.4426950408889634f;
#endif
                        for (int d = 0; d < 64; ++d) ptr[d] = f2bf(bf2f(ptr[d]) * rs * g[d]);
                    } else {
                        int gi = gidx - 8; int isk = gi >> 3; int hm = gi & 7;
                        bf16* ptr = p.P + (size_t)r * PLD + (isk ? C_DAK : C_DAQ) + hm * 32;
                        const float* g = isk ? dak : daq;
                        float ss = 0.f;
                        for (int d = 0; d < 32; ++d) { float v = bf2f(ptr[d]); ss += v * v; }
                        float rs = 1.0f / sqrtf(ss / 32.0f + 1e-6f);
#ifndef CPU_EMU
                        if (!isk) rs *= 0.17677669529663687f * 1.4426950408889634f;
#endif
                        if (r < NLAT) {
                            int tt = r % SEQ; float prow = (float)(tt / GW), pcol = (float)(tt % GW);
                            for (int a = 0; a < 2; ++a) {
                                float pos = a == 0 ? prow : pcol;
                                float fr = 1.0f;
                                for (int f = 0; f < 8; ++f) {
                                    float ang = pos * fr;
                                    float cs = cosf(ang), sn = sinf(ang);
                                    int i1 = a * 16 + f, i2 = a * 16 + 8 + f;
                                    float x1 = bf2f(ptr[i1]) * rs * g[i1], x2 = bf2f(ptr[i2]) * rs * g[i2];
                                    ptr[i1] = f2bf(x1 * cs - x2 * sn);
                                    ptr[i2] = f2bf(x2 * cs + x1 * sn);
                                    fr *= 0.31622776601683794f;
                                }
                            }
                        } else {
                            for (int d = 0; d < 32; ++d) ptr[d] = f2bf(bf2f(ptr[d]) * rs * g[d]);
                        }
                    }
                }
            }
        }
    }
#endif
#ifndef CPU_EMU
    {
        const float* cw = p.in[I_CONVW] + (size_t)l * 5 * 768;
        const int N = R * 96;
        for (int idx = bid * 256 + tid_(); idx < N; idx += nb * 256) {
            const int r = idx / 96, q = idx % 96; const int ph = q >> 3, cg = q & 7; const int part = ph >> 2, hd = ph & 3;
            const RowInfo ri = rowinfo(r);
            const int ch0 = part * 256 + hd * 64 + cg * 8;
            float y[8];
#pragma unroll
            for (int c = 0; c < 8; ++c) y[c] = 0.f;
#pragma unroll
            for (int i = 0; i < 5; ++i) {
                const int tt = ri.t + i - 2;
                if (tt >= 0 && tt < ri.T) {
                    const uint4 raw = *(const uint4*)(p.P + (size_t)(ri.base + tt) * PLD + C_GQ + ch0);
                    const f32x4_t w0 = *(const f32x4_t*)(cw + i * 768 + ch0), w1 = *(const f32x4_t*)(cw + i * 768 + ch0 + 4);
                    y[0] += __uint_as_float(raw.x << 16) * w0[0]; y[1] += __uint_as_float(raw.x & 0xffff0000u) * w0[1];
                    y[2] += __uint_as_float(raw.y << 16) * w0[2]; y[3] += __uint_as_float(raw.y & 0xffff0000u) * w0[3];
                    y[4] += __uint_as_float(raw.z << 16) * w1[0]; y[5] += __uint_as_float(raw.z & 0xffff0000u) * w1[1];
                    y[6] += __uint_as_float(raw.w << 16) * w1[2]; y[7] += __uint_as_float(raw.w & 0xffff0000u) * w1[3];
                }
            }
            float ss = 0.f;
#pragma unroll
            for (int c = 0; c < 8; ++c) { y[c] = siluf_(y[c]); ss += y[c] * y[c]; }
            ss += __shfl_xor(ss, 1); ss += __shfl_xor(ss, 2); ss += __shfl_xor(ss, 4);
            float scl = 1.0f;
            if (part == 0) scl = 0.125f / sqrtf(ss + 1e-6f); else if (part == 1) scl = 1.0f / sqrtf(ss + 1e-6f);
            uint4 pk; pk.x = cvtpk(y[0] * scl, y[1] * scl); pk.y = cvtpk(y[2] * scl, y[3] * scl); pk.z = cvtpk(y[4] * scl, y[5] * scl); pk.w = cvtpk(y[6] * scl, y[7] * scl);
            *(uint4*)(p.gq + (size_t)r * 768 + ch0) = pk;
        }
    }
#else
    {
        const float* cw = p.in[I_CONVW] + (size_t)l * 5 * 768;
        const int N = R * 12;
        for (int u = bid; u < (N + 255) / 256; u += nb) {
            THREADS(t, 256) {
                int idx = u * 256 + t;
                if (idx < N) {
                    int r = idx / 12, ph = idx % 12; int part = ph >> 2, hd = ph & 3;
                    RowInfo ri = rowinfo(r);
                    int ch0 = part * 256 + hd * 64;
                    float ss = 0.f;
                    for (int pass = 0; pass < 2; ++pass) {
                        float scl = 1.0f;
                        if (pass == 1) { if (part == 0) scl = 0.125f / sqrtf(ss + 1e-6f); else if (part == 1) scl = 1.0f / sqrtf(ss + 1e-6f); }
                        if (pass == 0 && part == 2) continue;
                        for (int c = 0; c < 64; ++c) {
                            float y = 0.f;
                            for (int i = 0; i < 5; ++i) {
                                int tt = ri.t + i - 2;
                                if (tt >= 0 && tt < ri.T) y += bf2f(p.P[(size_t)(ri.base + tt) * PLD + C_GQ + ch0 + c]) * cw[i * 768 + ch0 + c];
                            }
                            y = siluf_(y);
                            if (pass == 0) ss += y * y; else p.gq[(size_t)r * 768 + ch0 + c] = f2bf(y * scl);
                        }
                    }
                }
            }
        }
    }
#endif
    {
        const int RQ = (l == 0) ? R : NLAT;
        for (int r = (FOURIER_GEMM ? NLAT : 0) + bid; r < RQ; r += nb) {
            THREADS(t, 256) {
                int g = t >> 6, m = t & 63;
                const bf16* f = p.P + (size_t)r * PLD + C_F + g * 64;
                float fc = 0.f, fs = 0.f;
                for (int c = 0; c < 64; ++c) {
                    int ti = ((m * c) & 63) * (SEQ / 64);
                    float v = bf2f(f[c]);
                    fc += v * p.cosT[ti]; fs += v * p.sinT[ti];
                }
                p.fcs[(size_t)r * 512 + t] = f2bf(fc);
                p.fcs[(size_t)r * 512 + 256 + t] = f2bf(fs);
            }
        }
    }
}

#ifndef CPU_EMU
HD void ph_na(const Params& p, int l, int bid, int nb, char* smc) {
    const int t = tid_(), lane = t & 63, w = t >> 6, fr = lane & 15, fg = lane >> 4;
    const float* rpb = p.in[I_RPB] + (size_t)l * 4 * 15 * 31;
    float* sbias = (float*)(smc + 32768);
    const lds_cptr lds = (lds_cptr)smc;
    constexpr int WH = ROWS < 8 ? ROWS : 8;
    const int nlat = NB * ROWS * 4;
    const int nctx = (l == 0) ? NB * 4 * (CTXL / 64) : 0;
    const int lkey = t >> 3, lc = t & 7;
    const int ksrc = (lc ^ (lkey & 7)) << 3;
    const int vsrc = ((((lc >> 1) ^ ((lkey >> 1) & 3)) << 1) | (lc & 1)) << 3;
    for (int unit = bid; unit < nlat + nctx; unit += nb) {
        int b, hd, qrow, ntl, rs = 0, gr = 0;
        if (unit < nlat) {
            hd = unit & 3; const int br_ = unit >> 2; gr = br_ % ROWS; b = br_ / ROWS;
            qrow = b * SEQ + gr * GW + w * 16 + fr; ntl = WH;
            rs = gr - WH / 2; if (rs < 0) rs = 0; if (rs > ROWS - WH) rs = ROWS - WH;
        } else {
            const int u2 = unit - nlat; const int qt = u2 % (CTXL / 64); const int bh = u2 / (CTXL / 64); hd = bh & 3; b = bh >> 2;
            qrow = NLAT + b * CTXL + qt * 64 + w * 16 + fr; ntl = 0;
        }
        const int ntiles = ntl + NCC;
        const int qcol = w * 16 + fr;
        int cs0 = w * 16 - 8; if (cs0 < 0) cs0 = 0; if (cs0 > GW - 32) cs0 = GW - 32;
        int wsq = qcol - 8; if (wsq < 0) wsq = 0; if (wsq > GW - 16) wsq = GW - 16;
        bf16x8_t qf[2];
#pragma unroll
        for (int s_ = 0; s_ < 2; ++s_) qf[s_] = *(const bf16x8_t*)(p.P + (size_t)qrow * PLD + C_NAQ + hd * 64 + s_ * 32 + fg * 8);
        f32x4_t O[4];
#pragma unroll
        for (int d = 0; d < 4; ++d) O[d] = f32x4_t{0.f, 0.f, 0.f, 0.f};
        float ls = 0.f;
        auto keyrow = [&](int tt, int i) { return (tt < ntl) ? (b * SEQ + (rs + tt) * GW + i) : (NLAT + b * CTXL + (tt - ntl) * 64 + i); };
        char* ldst = smc + w * 1024;
        __syncthreads();
        for (int i = t; i < 15 * 31; i += 256) sbias[i] = rpb[hd * 465 + i] * 1.4426950408889634f;
#pragma unroll
        for (int i = 0; i < 2; ++i) {
            const bf16* src = p.P + (size_t)keyrow(0, lkey + 32 * i) * PLD + hd * 64;
            GLDS16(src + C_NAK + ksrc, ldst + 4096 * i); GLDS16(src + C_NAV + vsrc, ldst + 16384 + 4096 * i);
        }
        WAIT_VM0();
        __syncthreads();
        const int vkl = 4 * fg + (fr >> 2);
        const int vsw = (vkl >> 1) & 3;
        unsigned va[4];
#pragma unroll
        for (int d = 0; d < 4; ++d) va[d] = 16384 + vkl * 128 + ((((d ^ vsw) << 1) | ((fr & 3) >> 1)) << 4) + (fr & 1) * 8;
#pragma unroll 1
        for (int tt = 0; tt < ntiles; ++tt) {
            const int cur = tt & 1;
            if (tt + 1 < ntiles) {
#pragma unroll
                for (int i = 0; i < 2; ++i) {
                    const bf16* src = p.P + (size_t)keyrow(tt + 1, lkey + 32 * i) * PLD + hd * 64;
                    GLDS16(src + C_NAK + ksrc, ldst + (cur ^ 1) * 8192 + 4096 * i); GLDS16(src + C_NAV + vsrc, ldst + 16384 + (cur ^ 1) * 8192 + 4096 * i);
                }
            }
            const char* cK = smc + cur * 8192;
            const lds_cptr cV = lds + cur * 8192;
            const bool local = tt < ntl;
            const int kbase = local ? cs0 : 0;
            const int nkf = local ? 2 : 4;
            unsigned pb[2][4];
#pragma unroll
            for (int f = 0; f < 4; ++f) {
                if (f < nkf) {
                    const int key = kbase + f * 16 + fr;
                    const char* kp = cK + key * 128;
                    const bf16x8_t a0 = *(const bf16x8_t*)(kp + (((fg) ^ (fr & 7)) << 4));
                    const bf16x8_t a1 = *(const bf16x8_t*)(kp + (((4 + fg) ^ (fr & 7)) << 4));
                    f32x4_t S = __builtin_amdgcn_mfma_f32_16x16x32_bf16(a0, qf[0], f32x4_t{0.f, 0.f, 0.f, 0.f}, 0, 0, 0);
                    S = __builtin_amdgcn_mfma_f32_16x16x32_bf16(a1, qf[1], S, 0, 0, 0);
                    float e[4];
#pragma unroll
                    for (int r = 0; r < 4; ++r) {
                        float sv = S[r]; bool ok = true;
                        if (local) {
                            const int kc = kbase + f * 16 + 4 * fg + r;
                            ok = (unsigned)(kc - wsq) < 16u;
                            sv += sbias[((rs + tt) - gr + 7) * 31 + (ok ? (kc - qcol + 15) : 15)];
                        }
                        e[r] = ok ? __builtin_amdgcn_exp2f(sv) : 0.f;
                    }
                    ls += (e[0] + e[1]) + (e[2] + e[3]);
                    pb[f >> 1][(f & 1) * 2] = cvtpk(e[0], e[1]);
                    pb[f >> 1][(f & 1) * 2 + 1] = cvtpk(e[2], e[3]);
                }
            }
#pragma unroll
            for (int ks = 0; ks < 2; ++ks) {
                if (ks * 2 < nkf) {
#pragma unroll
                    for (int d = 0; d < 4; ++d) {
                        const s16x4_t lo = lds_tr16(cV + va[d] + (kbase + ks * 32) * 128);
                        const s16x4_t hi = lds_tr16(cV + va[d] + (kbase + ks * 32 + 16) * 128);
                        const bf16x8_t vf = bf16x8_t{lo[0], lo[1], lo[2], lo[3], hi[0], hi[1], hi[2], hi[3]};
                        const i32x4_t bi = i32x4_t{(int)pb[ks][0], (int)pb[ks][1], (int)pb[ks][2], (int)pb[ks][3]};
                        O[d] = __builtin_amdgcn_mfma_f32_16x16x32_bf16(vf, __builtin_bit_cast(bf16x8_t, bi), O[d], 0, 0, 0);
                    }
                }
            }
            WAIT_VM0();
            __syncthreads();
        }
        ls += __shfl_xor(ls, 16); ls += __shfl_xor(ls, 32);
        const float inv = 1.0f / ls;
        bf16* op = p.br + (size_t)qrow * D + hd * 64;
#pragma unroll
        for (int d = 0; d < 4; ++d) {
            uint2 pk; pk.x = cvtpk(O[d][0] * inv, O[d][1] * inv); pk.y = cvtpk(O[d][2] * inv, O[d][3] * inv);
            *(uint2*)(op + d * 16 + 4 * fg) = pk;
        }
    }
}
#else
HD void ph_na(const Params& p, int l, int bid, int nb, char*) {
    const float* rpb = p.in[I_RPB] + (size_t)l * 4 * 15 * 31;
    const int RQ = (l == 0) ? R : NLAT;
    const int N = RQ * 4;
    const int wh = ROWS < 8 ? ROWS : 8;
    for (int u = bid; u < (N + 255) / 256; u += nb) {
        THREADS(t, 256) {
            int idx = u * 256 + t;
            if (idx < N) {
                int hd = idx / RQ, r = idx % RQ;
                RowInfo ri = rowinfo(r);
                float q[64], o[64];
                const bf16* qp = p.P + (size_t)r * PLD + C_NAQ + hd * 64;
#pragma unroll
                for (int d = 0; d < 64; ++d) { q[d] = bf2f(qp[d]) * 0.125f; o[d] = 0.f; }
                float mx = -1e30f, lsum = 0.f;
                int nloc = 0, rs = 0, ws = 0, gr = 0, gc = 0;
                if (ri.seg == 0) {
                    gr = ri.t / GW; gc = ri.t % GW;
                    rs = gr - wh / 2; if (rs < 0) rs = 0; if (rs > ROWS - wh) rs = ROWS - wh;
                    ws = gc - 8; if (ws < 0) ws = 0; if (ws > GW - 16) ws = GW - 16;
                    nloc = wh * 16;
                }
                int ctxbase = NLAT + ri.b * CTXL;
                for (int kk = 0; kk < nloc + CTXL; ++kk) {
                    int kr; float bias = 0.f;
                    if (kk < nloc) {
                        int a = kk >> 4, c = kk & 15;
                        int krow = rs + a, kcol = ws + c;
                        kr = ri.base + krow * GW + kcol;
                        bias = rpb[(hd * 15 + (krow - gr + 7)) * 31 + (kcol - gc + 15)];
                    } else kr = ctxbase + (kk - nloc);
                    const bf16* kp = p.P + (size_t)kr * PLD + C_NAK + hd * 64;
                    float s = 0.f;
#pragma unroll
                    for (int d = 0; d < 64; ++d) s += q[d] * bf2f(kp[d]);
                    s += bias;
                    if (s > mx) { float f = expf(mx - s); lsum *= f;
#pragma unroll
                        for (int d = 0; d < 64; ++d) o[d] *= f;
                        mx = s; }
                    float e = expf(s - mx);
                    lsum += e;
                    const bf16* vp = p.P + (size_t)kr * PLD + C_NAV + hd * 64;
#pragma unroll
                    for (int d = 0; d < 64; ++d) o[d] += e * bf2f(vp[d]);
                }
                float inv = 1.0f / lsum;
                bf16* op = p.br + (size_t)r * D + hd * 64;
#pragma unroll
                for (int d = 0; d < 64; ++d) op[d] = f2bf(o[d] * inv);
            }
        }
    }
}

#endif

#ifndef CPU_EMU
HD void ph_da(const Params& p, int l, int bid, int nb, char* smc) {
    const int t = tid_(), lane = t & 63, w = t >> 6, fr = lane & 15, fg = lane >> 4;
    const float lam_init = lam_init_of(l);
    float s1 = 0.f, s2 = 0.f;
    for (int d = 0; d < 32; ++d) {
        s1 += p.in[I_LQ1][l * 32 + d] * p.in[I_LK1][l * 32 + d];
        s2 += p.in[I_LQ2][l * 32 + d] * p.in[I_LK2][l * 32 + d];
    }
    const float lam = expf(s1) - expf(s2) + lam_init;
    const float* sg = p.in[I_SUBLN] + l * 64;
    constexpr int NQT = SEQ / 128, NQC = CTXL / 128;
    const int nlat = NB * 4 * NQT;
    const int nctx = (l == 0) ? NB * 4 * NQC : 0;
    const lds_cptr lds = (lds_cptr)smc;
    for (int unit = bid; unit < nlat + nctx; unit += nb) {
        int b, hd, qrow0, kt0;
        if (unit < nlat) { const int qt = unit % NQT, bh = unit / NQT; hd = bh & 3; b = bh >> 2; qrow0 = b * SEQ + qt * 128; kt0 = 0; }
        else { const int u2 = unit - nlat; const int qt = u2 % NQC, bh = u2 / NQC; hd = bh & 3; b = bh >> 2; qrow0 = NLAT + b * CTXL + qt * 128; kt0 = NCL; }
        const int kt1 = NCL + NCC;
        bf16x8_t qf[2][2];
#pragma unroll
        for (int m = 0; m < 2; ++m)
#pragma unroll
            for (int n = 0; n < 2; ++n)
                qf[m][n] = *(const bf16x8_t*)(p.P + (size_t)(qrow0 + w * 32 + n * 16 + fr) * PLD + C_DAQ + hd * 64 + m * 32 + fg * 8);
        f32x4_t O[2][4][2];
#pragma unroll
        for (int m = 0; m < 2; ++m)
#pragma unroll
            for (int d = 0; d < 4; ++d)
#pragma unroll
                for (int n = 0; n < 2; ++n) O[m][d][n] = f32x4_t{0.f, 0.f, 0.f, 0.f};
        float ls[2][2] = {{0.f, 0.f}, {0.f, 0.f}};
        const int lkey = t >> 3, lc = t & 7;
        const int ksrc = (lc ^ (lkey & 7)) << 3;
        const int vsrc = ((((lc >> 1) ^ ((lkey >> 1) & 3)) << 1) | (lc & 1)) << 3;
        auto keyrow = [&](int kt, int i) { return (kt < NCL) ? (b * SEQ + kt * 64 + i) : (NLAT + b * CTXL + (kt - NCL) * 64 + i); };
        char* ldst = smc + w * 1024;
        __syncthreads();
#pragma unroll
        for (int i = 0; i < 2; ++i) {
            const bf16* src = p.P + (size_t)keyrow(kt0, lkey + 32 * i) * PLD + hd * 64;
            GLDS16(src + C_DAK + ksrc, ldst + 4096 * i); GLDS16(src + C_DAV + vsrc, ldst + 16384 + 4096 * i);
        }
        WAIT_VM0();
        __syncthreads();
        const unsigned ka0 = fr * 128 + (((fg) ^ (fr & 7)) << 4);
        const unsigned ka1 = fr * 128 + (((4 + fg) ^ (fr & 7)) << 4);
        const int vkey = 4 * fg + (fr >> 2);
        const int vsw = (vkey >> 1) & 3;
        unsigned va[4];
#pragma unroll
        for (int d = 0; d < 4; ++d) va[d] = 16384 + vkey * 128 + ((((d ^ vsw) << 1) | ((fr & 3) >> 1)) << 4) + (fr & 1) * 8;
#pragma unroll 1
        for (int kt = kt0; kt < kt1; ++kt) {
            const int cur = (kt - kt0) & 1;
            if (kt + 1 < kt1) {
#pragma unroll
                for (int i = 0; i < 2; ++i) {
                    const bf16* src = p.P + (size_t)keyrow(kt + 1, lkey + 32 * i) * PLD + hd * 64;
                    GLDS16(src + C_DAK + ksrc, ldst + (cur ^ 1) * 8192 + 4096 * i); GLDS16(src + C_DAV + vsrc, ldst + 16384 + (cur ^ 1) * 8192 + 4096 * i);
                }
            }
            const char* cK = smc + cur * 8192;
            const lds_cptr cV = lds + cur * 8192;
#pragma unroll
            for (int m = 0; m < 2; ++m) {
                unsigned pb[2][2][4];
                {
                    f32x4_t S[4][2];
#pragma unroll
                    for (int kf = 0; kf < 4; ++kf) {
                        const bf16x8_t a = *(const bf16x8_t*)(cK + (m ? ka1 : ka0) + kf * 2048);
#pragma unroll
                        for (int n = 0; n < 2; ++n) S[kf][n] = __builtin_amdgcn_mfma_f32_16x16x32_bf16(a, qf[m][n], f32x4_t{0.f, 0.f, 0.f, 0.f}, 0, 0, 0);
                    }
#pragma unroll
                    for (int kf = 0; kf < 4; ++kf)
#pragma unroll
                        for (int n = 0; n < 2; ++n) {
                            const float e0 = __builtin_amdgcn_exp2f(S[kf][n][0]), e1 = __builtin_amdgcn_exp2f(S[kf][n][1]);
                            const float e2 = __builtin_amdgcn_exp2f(S[kf][n][2]), e3 = __builtin_amdgcn_exp2f(S[kf][n][3]);
                            ls[m][n] += (e0 + e1) + (e2 + e3);
                            pb[n][kf >> 1][(kf & 1) * 2] = cvtpk(e0, e1);
                            pb[n][kf >> 1][(kf & 1) * 2 + 1] = cvtpk(e2, e3);
                        }
                }
#pragma unroll
                for (int ks = 0; ks < 2; ++ks)
#pragma unroll
                    for (int d = 0; d < 4; ++d) {
                        const s16x4_t lo = lds_tr16(cV + va[d] + ks * 4096);
                        const s16x4_t hi = lds_tr16(cV + va[d] + ks * 4096 + 2048);
                        const bf16x8_t vf = bf16x8_t{lo[0], lo[1], lo[2], lo[3], hi[0], hi[1], hi[2], hi[3]};
#pragma unroll
                        for (int n = 0; n < 2; ++n) {
                            const i32x4_t bi = i32x4_t{(int)pb[n][ks][0], (int)pb[n][ks][1], (int)pb[n][ks][2], (int)pb[n][ks][3]};
                            O[m][d][n] = __builtin_amdgcn_mfma_f32_16x16x32_bf16(vf, __builtin_bit_cast(bf16x8_t, bi), O[m][d][n], 0, 0, 0);
                        }
                    }
                asm volatile("" ::: "memory");
            }
            WAIT_VM0();
            __syncthreads();
        }
#pragma unroll
        for (int n = 0; n < 2; ++n) {
            float l0 = ls[0][n], l1 = ls[1][n];
            l0 += __shfl_xor(l0, 16); l0 += __shfl_xor(l0, 32);
            l1 += __shfl_xor(l1, 16); l1 += __shfl_xor(l1, 32);
            const float i0 = 1.0f / l0, i1 = lam / l1;
            float ss = 0.f;
#pragma unroll
            for (int d = 0; d < 4; ++d)
#pragma unroll
                for (int r = 0; r < 4; ++r) { const float o = O[0][d][n][r] * i0 - O[1][d][n][r] * i1; O[0][d][n][r] = o; ss += o * o; }
            ss += __shfl_xor(ss, 16); ss += __shfl_xor(ss, 32);
            const float rs = (1.0f - lam_init) / sqrtf(ss / 64.0f + 1e-6f);
            bf16* op = p.br + (size_t)(qrow0 + w * 32 + n * 16 + fr) * D + 256 + hd * 64;
#pragma unroll
            for (int d = 0; d < 4; ++d) {
                const int dv = d * 16 + 4 * fg;
                const unsigned lo = cvtpk(O[0][d][n][0] * rs * sg[dv], O[0][d][n][1] * rs * sg[dv + 1]);
                const unsigned hi = cvtpk(O[0][d][n][2] * rs * sg[dv + 2], O[0][d][n][3] * rs * sg[dv + 3]);
                uint2 pk; pk.x = lo; pk.y = hi;
                *(uint2*)(op + dv) = pk;
            }
        }
    }
}
#else
HD void ph_da(const Params& p, int l, int bid, int nb, char*) {
    const int RQ = (l == 0) ? R : NLAT;
    const int N = RQ * 4;
    const float lam_init = lam_init_of(l);
    float s1 = 0.f, s2 = 0.f;
    for (int d = 0; d < 32; ++d) {
        s1 += p.in[I_LQ1][l * 32 + d] * p.in[I_LK1][l * 32 + d];
        s2 += p.in[I_LQ2][l * 32 + d] * p.in[I_LK2][l * 32 + d];
    }
    const float lam = expf(s1) - expf(s2) + lam_init;
    const float* sg = p.in[I_SUBLN] + l * 64;
    const float scale = 0.17677669529663687f;
    for (int u = bid; u < (N + 255) / 256; u += nb) {
        THREADS(t, 256) {
            int idx = u * 256 + t;
            if (idx < N) {
                int hd = idx / RQ, r = idx % RQ;
                RowInfo ri = rowinfo(r);
                float q0[32], q1[32], o0[64], o1[64];
                const bf16* qp = p.P + (size_t)r * PLD + C_DAQ + hd * 64;
#pragma unroll
                for (int d = 0; d < 32; ++d) { q0[d] = bf2f(qp[d]) * scale; q1[d] = bf2f(qp[32 + d]) * scale; }
#pragma unroll
                for (int d = 0; d < 64; ++d) { o0[d] = 0.f; o1[d] = 0.f; }
                float m0 = -1e30f, m1 = -1e30f, l0 = 0.f, l1 = 0.f;
                int nlat = (ri.seg == 0) ? SEQ : 0;
                int latbase = ri.b * SEQ, ctxbase = NLAT + ri.b * CTXL;
                for (int kk = 0; kk < nlat + CTXL; ++kk) {
                    int kr = (kk < nlat) ? latbase + kk : ctxbase + (kk - nlat);
                    const bf16* kp = p.P + (size_t)kr * PLD + C_DAK + hd * 64;
                    const bf16* vp = p.P + (size_t)kr * PLD + C_DAV + hd * 64;
                    float sa = 0.f, sb = 0.f;
#pragma unroll
                    for (int d = 0; d < 32; ++d) { sa += q0[d] * bf2f(kp[d]); sb += q1[d] * bf2f(kp[32 + d]); }
                    if (sa > m0) { float f = expf(m0 - sa); l0 *= f;
#pragma unroll
                        for (int d = 0; d < 64; ++d) o0[d] *= f;
                        m0 = sa; }
                    if (sb > m1) { float f = expf(m1 - sb); l1 *= f;
#pragma unroll
                        for (int d = 0; d < 64; ++d) o1[d] *= f;
                        m1 = sb; }
                    float ea = expf(sa - m0), eb = expf(sb - m1);
                    l0 += ea; l1 += eb;
#pragma unroll
                    for (int d = 0; d < 64; ++d) { float v = bf2f(vp[d]); o0[d] += ea * v; o1[d] += eb * v; }
                }
                float i0 = 1.0f / l0, i1 = lam / l1;
                float ss = 0.f;
#pragma unroll
                for (int d = 0; d < 64; ++d) { o0[d] = o0[d] * i0 - o1[d] * i1; ss += o0[d] * o0[d]; }
                float rs = (1.0f - lam_init) / sqrtf(ss / 64.0f + 1e-6f);
                bf16* op = p.br + (size_t)r * D + 256 + hd * 64;
#pragma unroll
                for (int d = 0; d < 64; ++d) op[d] = f2bf(o0[d] * rs * sg[d]);
            }
        }
    }
}

#endif

struct ChunkInfo { int dir, b, hd, n, seg, T, base, nloc; };
HD ChunkInfo chunkinfo(int unit) {
    ChunkInfo c;
    c.n = unit % NCH; int ch = unit / NCH; c.hd = ch & 3; c.b = (ch >> 2) % NB; c.dir = ch / (4 * NB);
    if (c.n < NCC) { c.seg = 1; c.T = CTXL; c.base = NLAT + c.b * CTXL; c.nloc = c.n; }
    else { c.seg = 0; c.T = SEQ; c.base = c.b * SEQ; c.nloc = c.n - NCC; }
    return c;
}
HD int chunk_row(const ChunkInfo& c, int i) { int pf = c.nloc * 64 + i; return c.base + (c.dir ? (c.T - 1 - pf) : pf); }

#ifndef CPU_EMU
HD void ph_gdn_chunk(const Params& p, int l, int bid, int nb, float* smf) {
    char* smc = (char*)smf;
    const int t = tid_(), lane = t & 63, w = t >> 6, fr = lane & 15, fg = lane >> 4;
    float* sA = (float*)(smc + 24576); float* sG = (float*)(smc + 40960); float* sB = (float*)(smc + 41216);
    const int lkey = t >> 3, lc = t & 7;
    const int ksrc = (lc ^ (lkey & 7)) << 3;
    char* ldst = smc + w * 1024;
    for (int unit = bid; unit < NUNIT; unit += nb) {
        const ChunkInfo c = chunkinfo(unit);
        const int dh = c.dir * 4 + c.hd;
        __syncthreads();
#pragma unroll
        for (int i = 0; i < 2; ++i) {
            const bf16* src = p.gq + (size_t)chunk_row(c, lkey + 32 * i) * 768 + c.hd * 64;
            GLDS16(src + 256 + ksrc, ldst + 4096 * i);
            GLDS16(src + ksrc, ldst + 8192 + 4096 * i);
            GLDS16(src + 512 + lc * 8, ldst + 16384 + 4096 * i);
        }
        if (w == 0) {
            const int row = chunk_row(c, lane);
            float x = p.gg[(size_t)dh * R + row];
#pragma unroll
            for (int off = 1; off < 64; off <<= 1) { const float y = __shfl_up(x, off); if (lane >= off) x += y; }
            sG[lane] = x; sB[lane] = p.gbeta[(size_t)dh * R + row];
            const float x63 = __shfl(x, 63);
            float* cg = p.cG + (size_t)unit * 192;
            cg[lane] = __expf(x); cg[64 + lane] = __expf(x63 - x); cg[128 + lane] = __expf(x63);
        }
        WAIT_VM0();
        __syncthreads();
        {
            const char* kt_ = smc; const char* qt_ = smc + 8192;
            const unsigned ro = (16 * w + fr) * 128;
            const unsigned c0 = ((fg) ^ (fr & 7)) << 4, c1 = ((4 + fg) ^ (fr & 7)) << 4;
            const bf16x8_t ak0 = *(const bf16x8_t*)(kt_ + ro + c0), ak1 = *(const bf16x8_t*)(kt_ + ro + c1);
            const bf16x8_t aq0 = *(const bf16x8_t*)(qt_ + ro + c0), aq1 = *(const bf16x8_t*)(qt_ + ro + c1);
            float gi[4], bi[4];
#pragma unroll
            for (int r = 0; r < 4; ++r) { gi[r] = sG[16 * w + 4 * fg + r]; bi[r] = sB[16 * w + 4 * fg + r]; }
#pragma unroll
            for (int n = 0; n < 4; ++n) {
                const unsigned rb = (16 * n + fr) * 128;
                const bf16x8_t b0 = *(const bf16x8_t*)(kt_ + rb + c0), b1 = *(const bf16x8_t*)(kt_ + rb + c1);
                f32x4_t kk = __builtin_amdgcn_mfma_f32_16x16x32_bf16(ak0, b0, f32x4_t{0.f, 0.f, 0.f, 0.f}, 0, 0, 0);
                kk = __builtin_amdgcn_mfma_f32_16x16x32_bf16(ak1, b1, kk, 0, 0, 0);
                f32x4_t qk = __builtin_amdgcn_mfma_f32_16x16x32_bf16(aq0, b0, f32x4_t{0.f, 0.f, 0.f, 0.f}, 0, 0, 0);
                qk = __builtin_amdgcn_mfma_f32_16x16x32_bf16(aq1, b1, qk, 0, 0, 0);
                const int j = 16 * n + fr; const float gj = sG[j];
#pragma unroll
                for (int r = 0; r < 4; ++r) {
                    const int i = 16 * w + 4 * fg + r;
                    const float dec = (j <= i) ? __expf(gi[r] - gj) : 0.f;
                    sA[i * 64 + j] = (j < i) ? kk[r] * bi[r] * dec : 0.f;
                    p.cQK[(size_t)unit * 4096 + i * 64 + j] = f2bf(qk[r] * dec);
                }
            }
        }
        __syncthreads();
        if (w < 2) {
            float x[64];
            bf16* dst = (w == 0 ? p.cU : p.cW) + (size_t)unit * 4096 + lane;
#pragma unroll
            for (int i = 0; i < 64; ++i) {
                float rhs;
                if (w == 0) rhs = sB[i] * bf2f(*(const bf16*)(smc + 16384 + i * 128 + lane * 2));
                else rhs = sB[i] * __expf(sG[i]) * bf2f(*(const bf16*)(smc + i * 128 + ((((lane >> 3) ^ (i & 7))) << 4) + (lane & 7) * 2));
                float acc = rhs;
#pragma unroll
                for (int j4 = 0; j4 < i; j4 += 4) {
                    const f32x4_t a4 = *(const f32x4_t*)(sA + i * 64 + j4);
                    acc -= a4[0] * x[j4];
                    if (j4 + 1 < i) acc -= a4[1] * x[j4 + 1];
                    if (j4 + 2 < i) acc -= a4[2] * x[j4 + 2];
                    if (j4 + 3 < i) acc -= a4[3] * x[j4 + 3];
                }
                x[i] = acc;
                dst[i * 64] = f2bf(acc);
            }
        }
    }
}
#else
HD void ph_gdn_chunk(const Params& p, int l, int bid, int nb, float* sm) {
    float* sk = sm;
    float* sq = sm + 4096;
    float* sA = sm + 8192;
    float* sXu = sm + 12288;
    float* sXw = sm + 4096;
    float* sG = sm + 16384;
    float* sB = sm + 16448;
    for (int unit = bid; unit < NUNIT; unit += nb) {
        ChunkInfo c = chunkinfo(unit);
        int dh = c.dir * 4 + c.hd;
        THREADS(t, 4096) {
            int i = t >> 6, d = t & 63; int row = chunk_row(c, i);
            sq[t] = bf2f(p.gq[(size_t)row * 768 + c.hd * 64 + d]);
            sk[t] = bf2f(p.gq[(size_t)row * 768 + 256 + c.hd * 64 + d]);
        }
        THREADS(t, 1) {
            float acc = 0.f;
            for (int i = 0; i < 64; ++i) { int row = chunk_row(c, i); acc += p.gg[(size_t)dh * R + row]; sG[i] = acc; sB[i] = p.gbeta[(size_t)dh * R + row]; }
        }
        SYNC
        THREADS(t, 4096) {
            int i = t >> 6, j = t & 63;
            float kk = 0.f, qk = 0.f;
            for (int d = 0; d < 64; ++d) { kk += sk[i * 64 + d] * sk[j * 64 + d]; qk += sq[i * 64 + d] * sk[j * 64 + d]; }
            float dec = (j <= i) ? expf(sG[i] - sG[j]) : 0.f;
            sA[t] = (j < i) ? kk * sB[i] * dec : 0.f;
            p.cQK[(size_t)unit * 4096 + t] = f2bf(qk * dec);
        }
        SYNC
        THREADS(t, 4096) {
            int i = t >> 6, cc = t & 63; int row = chunk_row(c, i);
            sXu[t] = sB[i] * bf2f(p.gq[(size_t)row * 768 + 512 + c.hd * 64 + cc]);
            sXw[t] = sB[i] * expf(sG[i]) * sk[t];
        }
        SYNC
        for (int i = 1; i < 64; ++i) {
            THREADS(cc, 128) {
                float* X = (cc < 64) ? (sXu + cc) : (sXw + cc - 64);
                float acc = X[i * 64];
                for (int j = 0; j < i; ++j) acc -= sA[i * 64 + j] * X[j * 64];
                X[i * 64] = acc;
            }
            SYNC
        }
        THREADS(t, 4096) {
            p.cU[(size_t)unit * 4096 + t] = f2bf(sXu[t]);
            p.cW[(size_t)unit * 4096 + t] = f2bf(sXw[t]);
        }
        THREADS(t, 64) { p.cG[(size_t)unit * 64 + t] = sG[t]; }
        SYNC
    }
}

#endif

HD void ph_fourier2(const Params& p, int l, int bid, int nb) {
    const int RQ = (l == 0) ? R : NLAT;
    for (int r = (FOURIER_GEMM ? NLAT : 0) + bid; r < RQ; r += nb) {
        RowInfo ri = rowinfo(r);
        const float nrm = 1.0f / sqrtf((float)ri.T * 64.0f);
        const int mul = SEQ / ri.T;
        THREADS(ch, 256) {
            float acc = 0.f;
            for (int tt = 0; tt < ri.T; ++tt) {
                int ti = ((ri.t * tt) & (ri.T - 1)) * mul;
                const bf16* f = p.fcs + (size_t)(ri.base + tt) * 512;
                acc += p.cosT[ti] * bf2f(f[ch]) - p.sinT[ti] * bf2f(f[256 + ch]);
            }
            p.br[(size_t)r * D + 768 + ch] = f2bf(acc * nrm);
        }
    }
}


HD void ph_fourier_s1(const Params& p, int bid, int nb, char* smc) {
    for (int tile = bid; tile < NB * 64 * 4; tile += nb) {
        const int g = tile & 3, t2 = (tile >> 2) & 63, b = tile >> 8;
        ACC_DECL(4, acc); acc_zero(acc);
        gemm_accum<4>(acc, [&](int i) { return p.P + (size_t)(b * SEQ + 64 * i + t2) * PLD + C_F + g * 64; },
                      [&](int j) { return p.fW1 + j * 64; }, 64, smc);
        ACC_FOR(4, row, col) {
            const int cs = col >> 6, m = col & 63;
            p.fcs[((((size_t)b * 256 + g * 64 + m) * 64 + t2) * 2 + cs) * 128 + row] = f2bf(AV(acc));
        } ACC_END
    }
}
HD void ph_fourier_sA(const Params& p, int bid, int nb, char* smc) {
    for (int tile = bid; tile < NB * 128 * 2; tile += nb) {
        const int nt = tile & 1, mt = (tile >> 1) & 127, b = tile >> 8;
        ACC_DECL(4, acc); acc_zero(acc);
        gemm_accum<4>(acc, [&](int i) { return p.fcs + ((size_t)b * 16384 + mt * 128 + i) * 256; },
                      [&](int j) { return p.fWA + (size_t)(nt * 128 + j) * 256; }, 256, smc);
        ACC_FOR_PAIR(row, pcol) {
            const int k1 = nt * 64 + pcol; const int rr = mt * 128 + row; const int ch = rr >> 6, t2 = rr & 63;
            const float re = AV_G(acc), im = AV_U(acc);
            const float c = p.cosT[k1 * t2], sn = p.sinT[k1 * t2];
            bf16* o = p.fa2 + ((((size_t)b * 128 + k1) * 256 + ch) * 2) * 64 + t2;
            o[0] = f2bf(re * c + im * sn); o[64] = f2bf(im * c - re * sn);
        } ACC_END
    }
}
HD void ph_fourier_sB(const Params& p, int bid, int nb, char* smc) {
    const float nrm = 1.0f / sqrtf((float)SEQ * 64.0f);
    for (int tile = bid; tile < NB * 128 * 2; tile += nb) {
        const int cht = tile & 1, k1 = (tile >> 1) & 127, b = tile >> 8;
        ACC_DECL(2, acc); acc_zero(acc);
        gemm_accum<2>(acc, [&](int i) { return p.fa2 + (((size_t)b * 128 + k1) * 256 + cht * 128 + i) * 128; },
                      [&](int j) { return p.fWB + j * 128; }, 128, smc);
        ACC_FOR(2, row, col) {
            p.br[(size_t)(b * SEQ + k1 + 128 * col) * D + 768 + cht * 128 + row] = f2bf(AV(acc) * nrm);
        } ACC_END
    }
}

#ifndef CPU_EMU
struct ScanRegs { i32x4_t W[2], QK[2], q[2], k[2]; unsigned u[4]; float g; };
HD void ph_gdn_scan(const Params& p, int l, int bid, int nb, float* smf) {
    static_assert(NCH % 3 == 0, "scan ring assumes the chunk count is a multiple of 3");
    char* smc = (char*)smf;
    const int t = tid_(), lane = t & 63, w = t >> 6, fr = lane & 15, fg = lane >> 4;
    const int RQ = (l == 0) ? R : NLAT;
    char* sST = smc + 24576; char* sVT = smc + 26624; char* sVS = smc + 28672; float* sG = (float*)(smc + 30720);
    bf16* sO = (bf16*)(smc + 33024);
    const lds_cptr lds = (lds_cptr)smc;
    const int lkey = t >> 3, lc = t & 7;
    for (int cu = bid; cu < 2 * NB * 4 * 4; cu += nb) {
        const int chain = cu >> 2, cb = cu & 3;
        const ChunkInfo c0 = chunkinfo(chain * NCH);
        const int hd = c0.hd, dir = c0.dir;
        auto issue = [&](ScanRegs& Rg, int n) {
            const int unit = chain * NCH + n;
            const ChunkInfo c = chunkinfo(unit);
            const bf16* wsrc = p.cW + (size_t)unit * 4096 + (16 * w + fr) * 64 + 8 * fg;
            const bf16* qksrc = p.cQK + (size_t)unit * 4096 + (16 * w + fr) * 64 + 8 * fg;
            const bf16* qsrc = p.gq + (size_t)chunk_row(c, 16 * w + fr) * 768 + hd * 64 + 8 * fg;
#pragma unroll
            for (int s_ = 0; s_ < 2; ++s_) {
                Rg.W[s_] = *(const i32x4_t*)(wsrc + 32 * s_); Rg.QK[s_] = *(const i32x4_t*)(qksrc + 32 * s_); Rg.q[s_] = *(const i32x4_t*)(qsrc + 32 * s_);
                Rg.k[s_] = *(const i32x4_t*)(p.gq + (size_t)chunk_row(c, lkey + 32 * s_) * 768 + 256 + hd * 64 + lc * 8);
            }
#pragma unroll
            for (int r = 0; r < 4; ++r) Rg.u[r] = p.cU[(size_t)unit * 4096 + (16 * w + 4 * fg + r) * 64 + cb * 16 + fr];
            Rg.g = p.cG[(size_t)unit * 192 + (t < 192 ? t : 191)];
        };
        auto put_k = [&](const ScanRegs& Rg, int buf) {
#pragma unroll
            for (int s_ = 0; s_ < 2; ++s_) {
                const int ci = lkey + 32 * s_;
                const int fsw = ((ci >> 1) & 1) | (((ci >> 3) & 1) << 1);
                *(i32x4_t*)(smc + buf * 8192 + ci * 128 + (((((lc >> 1) ^ fsw) << 1) | (lc & 1)) << 4)) = Rg.k[s_];
            }
            if (t < 192) sG[buf * 192 + t] = Rg.g;
        };
        auto flush_o = [&](int n) {
            const ChunkInfo cc_ = chunkinfo(chain * NCH + n);
            if ((cc_.seg == 0 || l == 0) && t < 128) {
                const int ci = t >> 1, hf = t & 1;
                const uint4 vv = *(const uint4*)(sO + ci * 16 + hf * 8);
                *(uint4*)(p.odir + ((size_t)dir * R + chunk_row(cc_, ci)) * 256 + hd * 64 + cb * 16 + hf * 8) = vv;
            }
        };
        const unsigned c0o = ((fg) ^ (fr & 7)) << 4, c1o = ((4 + fg) ^ (fr & 7)) << 4;
        const unsigned bo0 = fr * 128 + c0o, bo1 = fr * 128 + c1o;
        const unsigned wofs = fr * 128 + ((((2 * w + (fg >> 1)) ^ (fr & 7))) << 4) + (fg & 1) * 8;
        unsigned ka[2][2];
#pragma unroll
        for (int s_ = 0; s_ < 2; ++s_)
#pragma unroll
            for (int h2 = 0; h2 < 2; ++h2) {
                const int cr = 32 * s_ + 8 * fg + (fr >> 2) + 4 * h2;
                const int fsw = ((cr >> 1) & 1) | (((cr >> 3) & 1) << 1);
                ka[s_][h2] = cr * 128 + (((((w ^ fsw) << 1) | ((fr & 3) >> 1))) << 4) + (fr & 1) * 8;
            }
        f32x4_t S = f32x4_t{0.f, 0.f, 0.f, 0.f};
        ScanRegs R0, R1, R2;
        __syncthreads();
        issue(R0, 0); issue(R1, 1);
        ((unsigned*)sST)[t] = 0u; ((unsigned*)sST)[t + 256] = 0u;
        put_k(R0, 0);
        __syncthreads();
#define SCAN_STEP(Rc, Rn, Rnn, nn, b)                                                                                                        \
        {                                                                                                                                    \
            const int n_ = (nn);                                                                                                             \
            if (n_ > 0) flush_o(n_ - 1);                                                                                                     \
            issue(Rnn, (n_ + 2 < NCH) ? n_ + 2 : NCH - 1);                  \
            const float* g = sG + (b) * 192;                                                                                                 \
            const f32x4_t eG = *(const f32x4_t*)(g + 16 * w + 4 * fg), eD = *(const f32x4_t*)(g + 64 + 16 * w + 4 * fg);                     \
            const float e63 = g[128];                                                                                                        \
            const bf16x8_t st0 = *(const bf16x8_t*)(sST + bo0), st1 = *(const bf16x8_t*)(sST + bo1);                                         \
            f32x4_t v = __builtin_amdgcn_mfma_f32_16x16x32_bf16(__builtin_bit_cast(bf16x8_t, Rc.W[0]), st0, f32x4_t{0.f, 0.f, 0.f, 0.f}, 0, 0, 0); \
            v = __builtin_amdgcn_mfma_f32_16x16x32_bf16(__builtin_bit_cast(bf16x8_t, Rc.W[1]), st1, v, 0, 0, 0);                              \
            f32x4_t o1 = __builtin_amdgcn_mfma_f32_16x16x32_bf16(__builtin_bit_cast(bf16x8_t, Rc.q[0]), st0, f32x4_t{0.f, 0.f, 0.f, 0.f}, 0, 0, 0); \
            o1 = __builtin_amdgcn_mfma_f32_16x16x32_bf16(__builtin_bit_cast(bf16x8_t, Rc.q[1]), st1, o1, 0, 0, 0);                            \
            float vn[4];                                                                                                                     \
            _Pragma("unroll") for (int r = 0; r < 4; ++r) vn[r] = __uint_as_float(Rc.u[r] << 16) - v[r];                                                            \
            { uint2 pk; pk.x = cvtpk(vn[0], vn[1]); pk.y = cvtpk(vn[2], vn[3]); *(uint2*)(sVT + wofs) = pk; }                                \
            { uint2 pk; pk.x = cvtpk(vn[0] * eD[0], vn[1] * eD[1]); pk.y = cvtpk(vn[2] * eD[2], vn[3] * eD[3]); *(uint2*)(sVS + wofs) = pk; }  \
            put_k(Rn, ((b) + 1) % 3);                                                                                                        \
            __syncthreads();                                                                                                                 \
            const bf16x8_t vt0 = *(const bf16x8_t*)(sVT + bo0), vt1 = *(const bf16x8_t*)(sVT + bo1);                                         \
            f32x4_t o2 = __builtin_amdgcn_mfma_f32_16x16x32_bf16(__builtin_bit_cast(bf16x8_t, Rc.QK[0]), vt0, f32x4_t{0.f, 0.f, 0.f, 0.f}, 0, 0, 0); \
            o2 = __builtin_amdgcn_mfma_f32_16x16x32_bf16(__builtin_bit_cast(bf16x8_t, Rc.QK[1]), vt1, o2, 0, 0, 0);                           \
            const bf16x8_t vs0 = *(const bf16x8_t*)(sVS + bo0), vs1 = *(const bf16x8_t*)(sVS + bo1);                                         \
            const lds_cptr kb = lds + (b) * 8192;                                                                                            \
            const s16x4_t a00 = lds_tr16(kb + ka[0][0]), a01 = lds_tr16(kb + ka[0][1]);                                                      \
            const s16x4_t a10 = lds_tr16(kb + ka[1][0]), a11 = lds_tr16(kb + ka[1][1]);                                                      \
            f32x4_t dS = __builtin_amdgcn_mfma_f32_16x16x32_bf16(bf16x8_t{a00[0], a00[1], a00[2], a00[3], a01[0], a01[1], a01[2], a01[3]}, vs0, f32x4_t{0.f, 0.f, 0.f, 0.f}, 0, 0, 0); \
            dS = __builtin_amdgcn_mfma_f32_16x16x32_bf16(bf16x8_t{a10[0], a10[1], a10[2], a10[3], a11[0], a11[1], a11[2], a11[3]}, vs1, dS, 0, 0, 0); \
            _Pragma("unroll") for (int r = 0; r < 4; ++r) S[r] = S[r] * e63 + dS[r];                                                         \
            { uint2 pk; pk.x = cvtpk(S[0], S[1]); pk.y = cvtpk(S[2], S[3]); *(uint2*)(sST + wofs) = pk; }                                    \
            _Pragma("unroll") for (int r = 0; r < 4; ++r) sO[(16 * w + 4 * fg + r) * 16 + fr] = f2bf(eG[r] * o1[r] + o2[r]);                 \
            __syncthreads();                                                                                                                 \
        }
#pragma unroll 1
        for (int n = 0; n < NCH; n += 3) {
            SCAN_STEP(R0, R1, R2, n, 0)
            SCAN_STEP(R1, R2, R0, n + 1, 1)
            SCAN_STEP(R2, R0, R1, n + 2, 2)
        }
#undef SCAN_STEP
        flush_o(NCH - 1);
    }
}
#else
HD void ph_gdn_scan(const Params& p, int l, int bid, int nb, float* sm) {
    float* sQ = sm;
    float* sK = sm + 4096;
    bf16* sW = (bf16*)(sm + 8192);
    bf16* sQK = (bf16*)(sm + 10240);
    float* sS = sm + 12288;
    float* sV = sm + 13312;
    float* sU = sm + 14336;
    float* sG = sm + 15360;
    const int RQ = (l == 0) ? R : NLAT;
    for (int cu = bid; cu < 2 * NB * 4 * 4; cu += nb) {
        int chain = cu >> 2, cb = cu & 3;
        THREADS(t, 1024) { sS[t] = 0.f; }
        SYNC
        for (int n = 0; n < NCH; ++n) {
            int unit = chain * NCH + n;
            ChunkInfo c = chunkinfo(unit);
            THREADS(t, 64) { sG[t] = p.cG[(size_t)unit * 64 + t]; }
            SYNC
            THREADS(t, 4096) {
                int i = t >> 6, d = t & 63; int row = chunk_row(c, i);
                sW[t] = p.cW[(size_t)unit * 4096 + t];
                sQK[t] = p.cQK[(size_t)unit * 4096 + t];
                sQ[t] = bf2f(p.gq[(size_t)row * 768 + c.hd * 64 + d]) * expf(sG[i]);
                sK[t] = bf2f(p.gq[(size_t)row * 768 + 256 + c.hd * 64 + d]) * expf(sG[63] - sG[i]);
            }
            THREADS(t, 1024) { int i = t >> 4, e = t & 15; sU[t] = bf2f(p.cU[(size_t)unit * 4096 + i * 64 + cb * 16 + e]); }
            SYNC
            THREADS(t, 1024) {
                int i = t >> 4, e = t & 15;
                float acc = sU[t];
                for (int d = 0; d < 64; ++d) acc -= bf2f(sW[i * 64 + d]) * sS[d * 16 + e];
                sV[t] = acc;
            }
            SYNC
            THREADS(t, 1024) {
                int i = t >> 4, e = t & 15;
                float acc = 0.f;
                for (int d = 0; d < 64; ++d) acc += sQ[i * 64 + d] * sS[d * 16 + e];
                for (int j = 0; j < 64; ++j) acc += bf2f(sQK[i * 64 + j]) * sV[j * 16 + e];
                int row = chunk_row(c, i);
                if (row < RQ) p.odir[((size_t)c.dir * R + row) * 256 + c.hd * 64 + cb * 16 + e] = f2bf(acc);
            }
            SYNC
            THREADS(t, 1024) {
                int d = t >> 4, e = t & 15;
                float acc = sS[t] * expf(sG[63]);
                for (int i = 0; i < 64; ++i) acc += sK[i * 64 + d] * sV[i * 16 + e];
                sS[t] = acc;
            }
            SYNC
        }
    }
}

#endif

#ifndef CPU_EMU
HD void ph_gdn_fin(const Params& p, int l, int bid, int nb) {
    const int RQ = (l == 0) ? R : NLAT;
    const float* og = p.in[I_ONORM] + l * 64;
    const int N = RQ * 32;
    for (int idx = bid * 256 + tid_(); idx < N; idx += nb * 256) {
        const int r = idx >> 5, q = idx & 31; const int hd = q >> 3, cg = q & 7;
        const uint4 a0 = *(const uint4*)(p.odir + (size_t)r * 256 + hd * 64 + cg * 8);
        const uint4 a1 = *(const uint4*)(p.odir + ((size_t)R + r) * 256 + hd * 64 + cg * 8);
        const uint4 zz = *(const uint4*)(p.P + (size_t)r * PLD + C_Z + hd * 64 + cg * 8);
        float v[8], z[8];
        v[0] = __uint_as_float(a0.x << 16) + __uint_as_float(a1.x << 16); v[1] = __uint_as_float(a0.x & 0xffff0000u) + __uint_as_float(a1.x & 0xffff0000u);
        v[2] = __uint_as_float(a0.y << 16) + __uint_as_float(a1.y << 16); v[3] = __uint_as_float(a0.y & 0xffff0000u) + __uint_as_float(a1.y & 0xffff0000u);
        v[4] = __uint_as_float(a0.z << 16) + __uint_as_float(a1.z << 16); v[5] = __uint_as_float(a0.z & 0xffff0000u) + __uint_as_float(a1.z & 0xffff0000u);
        v[6] = __uint_as_float(a0.w << 16) + __uint_as_float(a1.w << 16); v[7] = __uint_as_float(a0.w & 0xffff0000u) + __uint_as_float(a1.w & 0xffff0000u);
        z[0] = __uint_as_float(zz.x << 16); z[1] = __uint_as_float(zz.x & 0xffff0000u); z[2] = __uint_as_float(zz.y << 16); z[3] = __uint_as_float(zz.y & 0xffff0000u);
        z[4] = __uint_as_float(zz.z << 16); z[5] = __uint_as_float(zz.z & 0xffff0000u); z[6] = __uint_as_float(zz.w << 16); z[7] = __uint_as_float(zz.w & 0xffff0000u);
        float ss = 0.f;
#pragma unroll
        for (int c = 0; c < 8; ++c) ss += v[c] * v[c];
        ss += __shfl_xor(ss, 1); ss += __shfl_xor(ss, 2); ss += __shfl_xor(ss, 4);
        const float rs = 1.0f / sqrtf(ss / 64.0f + 1e-6f);
        float o[8];
#pragma unroll
        for (int c = 0; c < 8; ++c) o[c] = v[c] * rs * og[cg * 8 + c] * siluf_(z[c]);
        uint4 pk; pk.x = cvtpk(o[0], o[1]); pk.y = cvtpk(o[2], o[3]); pk.z = cvtpk(o[4], o[5]); pk.w = cvtpk(o[6], o[7]);
        *(uint4*)(p.br + (size_t)r * D + 512 + hd * 64 + cg * 8) = pk;
    }
}
#else
HD void ph_gdn_fin(const Params& p, int l, int bid, int nb) {
    const int RQ = (l == 0) ? R : NLAT;
    const float* og = p.in[I_ONORM] + l * 64;
    const int N = RQ * 4;
    for (int u = bid; u < (N + 255) / 256; u += nb) {
        THREADS(t, 256) {
            int idx = u * 256 + t;
            if (idx < N) {
                int r = idx >> 2, hd = idx & 3;
                const bf16* o0 = p.odir + (size_t)r * 256 + hd * 64;
                const bf16* o1 = p.odir + ((size_t)R + r) * 256 + hd * 64;
                float ss = 0.f;
                for (int d = 0; d < 64; ++d) { float v = bf2f(o0[d]) + bf2f(o1[d]); ss += v * v; }
                float rs = 1.0f / sqrtf(ss / 64.0f + 1e-6f);
                for (int d = 0; d < 64; ++d) {
                    float v = (bf2f(o0[d]) + bf2f(o1[d])) * rs * og[d];
                    float z = bf2f(p.P[(size_t)r * PLD + C_Z + hd * 64 + d]);
                    p.br[(size_t)r * D + 512 + hd * 64 + d] = f2bf(v * siluf_(z));
                }
            }
        }
    }
}

#endif

#ifndef CPU_EMU
HD void ph_merge(const Params& p, int l, int bid, int nb, char* smc) {
    const int MT = ((l == 0) ? R : NLAT) / 128;
    const bf16* Wg = p.wt_in + (size_t)l * WIN_NP * D + (size_t)PLD * D;
    const bf16* Wb = p.wt_br + (size_t)l * 4 * D * 256;
    for (int tile = bid; tile < MT * 8; tile += nb) {
        const int mt = tile >> 3, nt = tile & 7;
        AccT<4> accM; acc_zero(accM);
#pragma unroll 1
        for (int i = 0; i < 4; ++i) {
            AccT<4> acc; acc_zero(acc);
            gemm_accum8<4>(acc, [&](int r) { return (const unsigned char*)h8_of(p) + (size_t)(mt * 128 + r) * D; },
                           [&](int j) { return (const unsigned char*)Wg + (size_t)(i * 1024 + nt * 128 + j) * D; }, D, smc, SC_H, SC_W);
            unsigned sg[4][4][2];
#pragma unroll
            for (int a_ = 0; a_ < 4; ++a_)
#pragma unroll
                for (int b_ = 0; b_ < 4; ++b_) {
                    float e[4];
#pragma unroll
                    for (int r = 0; r < 4; ++r) e[r] = __builtin_amdgcn_rcpf(1.0f + __expf(-acc.v[a_][b_][r]));
                    sg[a_][b_][0] = cvtpk(e[0], e[1]); sg[a_][b_][1] = cvtpk(e[2], e[3]);
                }
            acc_zero(acc);
            gemm_accum<4>(acc, [&](int r) { return p.br + (size_t)(mt * 128 + r) * D + i * 256; },
                          [&](int j) { return Wb + ((size_t)i * D + nt * 128 + j) * 256; }, 256, smc);
#pragma unroll
            for (int a_ = 0; a_ < 4; ++a_)
#pragma unroll
                for (int b_ = 0; b_ < 4; ++b_) {
                    accM.v[a_][b_][0] += __uint_as_float(sg[a_][b_][0] << 16) * acc.v[a_][b_][0];
                    accM.v[a_][b_][1] += __uint_as_float(sg[a_][b_][0] & 0xffff0000u) * acc.v[a_][b_][1];
                    accM.v[a_][b_][2] += __uint_as_float(sg[a_][b_][1] << 16) * acc.v[a_][b_][2];
                    accM.v[a_][b_][3] += __uint_as_float(sg[a_][b_][1] & 0xffff0000u) * acc.v[a_][b_][3];
                }
        }
        float* tl = (float*)smc;
        acc_to_lds<4>(accM, tl);
        __syncthreads();
        const int t_ = tid_(); const int row = t_ >> 1, half = t_ & 1;
        bf16* dst = p.mg + (size_t)(mt * 128 + row) * D + nt * 128 + half * 64;
#pragma unroll
        for (int q = 0; q < 8; ++q) {
            const f32x4_t a = *(const f32x4_t*)(tl + row * 132 + half * 64 + q * 8), b = *(const f32x4_t*)(tl + row * 132 + half * 64 + q * 8 + 4);
            uint4 pk; pk.x = cvtpk(a[0], a[1]); pk.y = cvtpk(a[2], a[3]); pk.z = cvtpk(b[0], b[1]); pk.w = cvtpk(b[2], b[3]);
            *(uint4*)(dst + q * 8) = pk;
        }
    }
}
#else
HD void ph_merge(const Params& p, int l, int bid, int nb, char* smc) {
    const int MT = ((l == 0) ? R : NLAT) / 128;
    const bf16* Wg = p.wt_in + (size_t)l * WIN_NP * D + (size_t)PLD * D;
    const bf16* Wb = p.wt_br + (size_t)l * 4 * D * 256;
    for (int tile = bid; tile < MT * 16; tile += nb) {
        const int mt = tile >> 4, nt = tile & 15;
        ACC_DECL(2, accM); acc_zero(accM);
        for (int i = 0; i < 4; ++i) {
            ACC_DECL(2, accG); acc_zero(accG);
            ACC_DECL(2, accP); acc_zero(accP);
            gemm_accum<2>(accG, [&](int r) { return p.h + (size_t)(mt * 128 + r) * D; },
                          [&](int j) { return Wg + (size_t)(i * 1024 + nt * 64 + j) * D; }, D, smc);
            gemm_accum<2>(accP, [&](int r) { return p.br + (size_t)(mt * 128 + r) * D + i * 256; },
                          [&](int j) { return Wb + ((size_t)i * D + nt * 64 + j) * 256; }, 256, smc);
            ACC_FOR(2, row, col) { AV(accM) += sigmoidf_(AV(accG)) * AV(accP); } ACC_END
        }
#ifndef CPU_EMU
        {
            float* tl = (float*)smc;
            acc_to_lds<2>(accM, tl);
            __syncthreads();
            const int t_ = tid_(); const int row = t_ >> 1, half = t_ & 1;
            bf16* dst = p.mg + (size_t)(mt * 128 + row) * D + nt * 64 + half * 32;
#pragma unroll
            for (int q = 0; q < 4; ++q) {
                const f32x4_t a = *(const f32x4_t*)(tl + row * 68 + half * 32 + q * 8), b = *(const f32x4_t*)(tl + row * 68 + half * 32 + q * 8 + 4);
                uint4 pk; pk.x = cvtpk(a[0], a[1]); pk.y = cvtpk(a[2], a[3]); pk.z = cvtpk(b[0], b[1]); pk.w = cvtpk(b[2], b[3]);
                *(uint4*)(dst + q * 8) = pk;
            }
        }
#else
        ACC_FOR(2, row, col) { p.mg[(size_t)(mt * 128 + row) * D + nt * 64 + col] = f2bf(AV(accM)); } ACC_END
#endif
    }
}

#endif

template <int DRY> HD void ph_outproj_t(const Params& p, int l, int bid, int nb, char* smc) {
    const int MT = ((l == 0) ? R : NLAT) / 128;
    const bf16* Wt = p.wt_out + (size_t)l * D * D;
    for (int tile = bid; tile < MT * 8; tile += nb) {
        const int mt = tile >> 3, nt = tile & 7;
        ACC_DECL(4, acc); acc_zero(acc);
        gemm_accum<4>(acc, [&](int r) { return p.mg + (size_t)(mt * 128 + r) * D; }, [&](int j) { return Wt + (size_t)(nt * 128 + j) * D; }, D, smc);
#ifndef CPU_EMU
        {
            float* tl = (float*)smc;
            acc_to_lds<4>(acc, tl);
            __syncthreads();
            const int t_ = tid_(); const int row = t_ >> 1, half = t_ & 1;
            const int r = mt * 128 + row, c0 = nt * 128 + half * 64;
            const float* xi = xrow_in(p, l, r) + c0; float* xo = (DRY ? ((float*)p.Y + (size_t)r * D) : xrow_out(p, r)) + c0; const float* gm = modrow(p, l, r) + 2048 + c0;
#pragma unroll
            for (int q = 0; q < 16; ++q) {
                const f32x4_t a = *(const f32x4_t*)(tl + row * 132 + half * 64 + q * 4), xv = *(const f32x4_t*)(xi + q * 4), gv = *(const f32x4_t*)(gm + q * 4);
                f32x4_t o; o[0] = xv[0] + gv[0] * a[0]; o[1] = xv[1] + gv[1] * a[1]; o[2] = xv[2] + gv[2] * a[2]; o[3] = xv[3] + gv[3] * a[3];
                *(f32x4_t*)(xo + q * 4) = o;
            }
        }
#else
        ACC_FOR(4, row, col) {
            const int r = mt * 128 + row, c = nt * 128 + col;
            xrow_out(p, r)[c] = xrow_in(p, l, r)[c] + modrow(p, l, r)[2048 + c] * AV(acc);
        } ACC_END
#endif
    }
}

HD void ph_outproj(const Params& p, int l, int bid, int nb, char* smc) { ph_outproj_t<0>(p, l, bid, nb, smc); }
#ifndef CPU_EMU
template <int DRY> HD void ph_router_t(const Params& p, int l, int bid, int nb, float* smf) {
    char* smc = (char*)smf;
    const int t = tid_(), lane = t & 63, w = t >> 6, fr = lane & 15, fg = lane >> 4;
    const int RQ = (l == 0) ? R : NLAT;
    const float* gN = p.in[I_N2G] + l * D;
    constexpr int WST = 2080;
    float* lgw = (float*)(smc + 66560) + w * (16 * 17);
    int* lcnt = (int*)(smc + 70912); int* gbase = (int*)(smc + 70976);
    __syncthreads();
    for (int k = t; k < 1024; k += 256) {
        const float* wrow = p.in[I_WROUTER] + k * 16;
#pragma unroll
        for (int e = 0; e < 16; ++e) {
            const float v = wrow[e]; const bf16 hi = f2bf(v);
            *(bf16*)(smc + e * WST + k * 2) = hi; *(bf16*)(smc + 33280 + e * WST + k * 2) = f2bf(v - bf2f(hi));
        }
    }
    const int ngroups = RQ / 16;
    for (int g0 = bid * 4; g0 < ngroups; g0 += nb * 4) {
        __syncthreads();
        if (t < 16) lcnt[t] = 0;
        __syncthreads();
        const int gidx = g0 + w;
        const bool active = gidx < ngroups;
        int e1 = 0, e2 = 0, q1 = 0, q2 = 0; const int rsel = gidx * 16 + lane;
        if (active) {
            const int r = gidx * 16 + fr;
            const float* x = xrow_out(p, r);
            const float* m = modrow(p, l, r);
            float ss = 0.f;
#pragma unroll 4
            for (int s_ = 0; s_ < 32; ++s_) {
                const f32x4_t a = *(const f32x4_t*)(x + s_ * 32 + fg * 8), b = *(const f32x4_t*)(x + s_ * 32 + fg * 8 + 4);
                ss += a[0] * a[0] + a[1] * a[1] + a[2] * a[2] + a[3] * a[3] + b[0] * b[0] + b[1] * b[1] + b[2] * b[2] + b[3] * b[3];
            }
            ss += __shfl_xor(ss, 16); ss += __shfl_xor(ss, 32);
            const float rs = 1.0f / sqrtf(ss / D + 1e-6f);
            f32x4_t acc = f32x4_t{0.f, 0.f, 0.f, 0.f};
#pragma unroll 2
            for (int s_ = 0; s_ < 32; ++s_) {
                const int k0 = s_ * 32 + fg * 8;
                float hv[8];
#pragma unroll
                for (int hh = 0; hh < 2; ++hh) {
                    const f32x4_t xv = *(const f32x4_t*)(x + k0 + hh * 4), gv = *(const f32x4_t*)(gN + k0 + hh * 4);
                    const f32x4_t sc = *(const f32x4_t*)(m + 4096 + k0 + hh * 4), sh = *(const f32x4_t*)(m + 3072 + k0 + hh * 4);
#pragma unroll
                    for (int q = 0; q < 4; ++q) hv[hh * 4 + q] = xv[q] * rs * gv[q] * (1.0f + sc[q]) + sh[q];
                }
                unsigned hi[4], lo[4];
#pragma unroll
                for (int q = 0; q < 4; ++q) {
                    hi[q] = cvtpk(hv[2 * q], hv[2 * q + 1]);
                    lo[q] = cvtpk(hv[2 * q] - __uint_as_float(hi[q] << 16), hv[2 * q + 1] - __uint_as_float(hi[q] & 0xffff0000u));
                }
                const i32x4_t hiv = i32x4_t{(int)hi[0], (int)hi[1], (int)hi[2], (int)hi[3]}, lov = i32x4_t{(int)lo[0], (int)lo[1], (int)lo[2], (int)lo[3]};
                { uint2 q8; q8.x = pack_fp8x4(hv[0] * 4.f, hv[1] * 4.f, hv[2] * 4.f, hv[3] * 4.f); q8.y = pack_fp8x4(hv[4] * 4.f, hv[5] * 4.f, hv[6] * 4.f, hv[7] * 4.f);
                  *(uint2*)(h8_of(p) + (size_t)r * D + k0) = q8; }
                const bf16x8_t bh = *(const bf16x8_t*)(smc + fr * WST + s_ * 64 + fg * 16), bl = *(const bf16x8_t*)(smc + 33280 + fr * WST + s_ * 64 + fg * 16);
                acc = __builtin_amdgcn_mfma_f32_16x16x32_bf16(__builtin_bit_cast(bf16x8_t, hiv), bh, acc, 0, 0, 0);
                acc = __builtin_amdgcn_mfma_f32_16x16x32_bf16(__builtin_bit_cast(bf16x8_t, hiv), bl, acc, 0, 0, 0);
                acc = __builtin_amdgcn_mfma_f32_16x16x32_bf16(__builtin_bit_cast(bf16x8_t, lov), bh, acc, 0, 0, 0);
            }
#pragma unroll
            for (int q = 0; q < 4; ++q) lgw[(4 * fg + q) * 17 + fr] = acc[q];
            if (lane < 16) {
                float sc[16], sel[16];
#pragma unroll
                for (int e = 0; e < 16; ++e) { sc[e] = sigmoidf_(lgw[lane * 17 + e]); sel[e] = sc[e] + p.in[I_RBIAS][e]; }
                int best = 0; float bestv = -1e30f;
#pragma unroll
                for (int gph = 0; gph < 4; ++gph) {
                    float t1 = -1e30f, t2 = -1e30f;
#pragma unroll
                    for (int j = 0; j < 4; ++j) { const float v = sel[gph * 4 + j]; if (v > t1) { t2 = t1; t1 = v; } else if (v > t2) t2 = v; }
                    const float gs = t1 + t2;
                    if (gs > bestv) { bestv = gs; best = gph; }
                }
                float v1 = -1e30f, v2 = -1e30f, w1 = 0.f, w2 = 0.f; int i1 = 0, i2 = 0;
#pragma unroll
                for (int e = 0; e < 16; ++e) {
                    if ((e >> 2) == best) {
                        const float v = sel[e];
                        if (v > v1) { v2 = v1; i2 = i1; w2 = w1; v1 = v; i1 = e; w1 = sc[e]; } else if (v > v2) { v2 = v; i2 = e; w2 = sc[e]; }
                    }
                }
                e1 = i1; e2 = i2;
                const float ws_ = w1 + w2;
                p.sel_e[rsel * 2] = i1; p.sel_e[rsel * 2 + 1] = i2;
                p.sel_w[rsel * 2] = w1 / ws_; p.sel_w[rsel * 2 + 1] = w2 / ws_;
                q1 = atomicAdd(&lcnt[i1], 1); q2 = atomicAdd(&lcnt[i2], 1);
            }
        }
        __syncthreads();
        if (t < 16) { const int c = lcnt[t]; gbase[t] = (c && !DRY) ? atomicAdd(&p.cnt[l * 16 + t], c) : 0; }
        __syncthreads();
        if (active && lane < 16 && !DRY) {
            const int p1 = gbase[e1] + q1, p2 = gbase[e2] + q2;
            p.elist[(size_t)e1 * 2 * R + p1] = rsel * 2; p.apos[rsel * 2] = p1;
            p.elist[(size_t)e2 * 2 * R + p2] = rsel * 2 + 1; p.apos[rsel * 2 + 1] = p2;
        }
    }
}
HD void ph_router(const Params& p, int l, int bid, int nb, float* smf) { ph_router_t<0>(p, l, bid, nb, smf); }
#else
HD void ph_router(const Params& p, int l, int bid, int nb, float* sm) {
    const int RQ = (l == 0) ? R : NLAT;
    const float* g = p.in[I_N2G] + l * D;
    const float* wr = p.in[I_WROUTER];
    float* sh = sm + 512;
    float* sl = sm + 2048;
    for (int r = bid; r < RQ; r += nb) {
        const float* x = xrow_out(p, r);
        const float* m = modrow(p, l, r);
        THREADS(t, 256) { float s = 0.f; for (int k = t; k < D; k += 256) s += x[k] * x[k]; sm[t] = s; }
        SYNC
        THREADS(t, 1) { float s = 0.f; for (int i = 0; i < 256; ++i) s += sm[i]; sm[256] = s; }
        SYNC
        THREADS(t, 256) {
            float rs = 1.0f / sqrtf(sm[256] / D + 1e-6f);
            for (int k = t; k < D; k += 256) {
                float v = x[k] * rs * g[k];
                v = v * (1.0f + m[4096 + k]) + m[3072 + k];
                sh[k] = v;
                p.h[(size_t)r * D + k] = f2bf(v);
            }
        }
        SYNC
        THREADS(t, 256) {
            int e = t & 15, ks = t >> 4;
            float acc = 0.f;
            for (int k = ks * 64; k < ks * 64 + 64; ++k) acc += sh[k] * wr[k * 16 + e];
            sl[ks * 16 + e] = acc;
        }
        SYNC
        THREADS(t, 1) {
            float* sc = sm + 2304; float* sel = sm + 2320;
            for (int e = 0; e < 16; ++e) {
                float acc = 0.f;
                for (int ks = 0; ks < 16; ++ks) acc += sl[ks * 16 + e];
                sc[e] = sigmoidf_(acc); sel[e] = sc[e] + p.in[I_RBIAS][e];
            }
            int best = 0; float bestv = -1e30f;
            for (int gph = 0; gph < 4; ++gph) {
                float t1 = -1e30f, t2 = -1e30f;
                for (int j = 0; j < 4; ++j) { float v = sel[gph * 4 + j]; if (v > t1) { t2 = t1; t1 = v; } else if (v > t2) t2 = v; }
                float gs = t1 + t2;
                if (gs > bestv) { bestv = gs; best = gph; }
            }
            int i1 = -1, i2 = -1; float v1 = -1e30f, v2 = -1e30f;
            for (int j = 0; j < 4; ++j) {
                float v = sel[best * 4 + j];
                if (v > v1) { v2 = v1; i2 = i1; v1 = v; i1 = best * 4 + j; } else if (v > v2) { v2 = v; i2 = best * 4 + j; }
            }
            float w1 = sc[i1], w2 = sc[i2], ws = w1 + w2;
            p.sel_e[r * 2] = i1; p.sel_e[r * 2 + 1] = i2;
            p.sel_w[r * 2] = w1 / ws; p.sel_w[r * 2 + 1] = w2 / ws;
            int q1 = ATOMIC_ADD_RET(&p.cnt[l * 16 + i1], 1); p.elist[(size_t)i1 * 2 * R + q1] = r * 2; p.apos[r * 2] = q1;
            int q2 = ATOMIC_ADD_RET(&p.cnt[l * 16 + i2], 1); p.elist[(size_t)i2 * 2 * R + q2] = r * 2 + 1; p.apos[r * 2 + 1] = q2;
        }
        SYNC
    }
}

#endif

struct MoeTiles { int tstart[17]; };
HD MoeTiles moe_tiles(const Params& p, int l) {
    MoeTiles m; int acc = 0;
    for (int e = 0; e < 16; ++e) { m.tstart[e] = acc; acc += (p.cnt[l * 16 + e] + 127) >> 7; }
    m.tstart[16] = acc; return m;
}

HD void ph_ffn1(const Params& p, int l, int bid, int nb, char* smc) {
    int tstart[17];
    { int acc = 0; for (int e = 0; e < 16; ++e) { tstart[e] = acc; acc += (p.cnt[l * 16 + e] + 127) >> 7; } tstart[16] = acc; }
    const int ntiles = tstart[16];
    for (int tile = bid; tile < ntiles * 8; tile += nb) {
        const int rt = tile >> 3, nt = tile & 7;
        int e = 0, ts = 0;
#pragma unroll
        for (int q = 1; q < 16; ++q) if (rt >= tstart[q]) { e = q; ts = tstart[q]; }
        const int mt = rt - ts;
        const int cnt_e = p.cnt[l * 16 + e];
        const int* el = p.elist + (size_t)e * 2 * R;
#ifndef CPU_EMU
        const unsigned char* Wt8 = gu8_of(p) + (size_t)e * 1024 * D;
        AccT<4> acc; acc_zero(acc);
        gemm_accum8<4>(acc, [&](int i) { int q = mt * 128 + i; int a = (q < cnt_e) ? el[q] : el[0]; return (const unsigned char*)h8_of(p) + (size_t)(a >> 1) * D; },
                       [&](int j) { return Wt8 + (size_t)(nt * 128 + j) * D; }, D, smc, SC_H, SC_W);
        {
            float* tl = (float*)smc;
            acc_to_lds<4>(acc, tl);
            __syncthreads();
            const int t_ = tid_(); const int row = t_ >> 1, half = t_ & 1;
            unsigned char* dst = (unsigned char*)p.act + (size_t)(rt * 128 + row) * 512 + nt * 64 + half * 32;
#pragma unroll
            for (int q = 0; q < 2; ++q) {
                float o[16];
#pragma unroll
                for (int c4 = 0; c4 < 4; ++c4) {
                    const f32x4_t gv = *(const f32x4_t*)(tl + row * 132 + half * 64 + q * 32 + c4 * 4), uv = *(const f32x4_t*)(tl + row * 132 + half * 64 + q * 32 + 16 + c4 * 4);
#pragma unroll
                    for (int e_ = 0; e_ < 4; ++e_) o[c4 * 4 + e_] = gv[e_] / (1.0f + __expf(-gv[e_])) * uv[e_] * 16.0f;
                }
                uint4 pk; pk.x = pack_fp8x4(o[0], o[1], o[2], o[3]); pk.y = pack_fp8x4(o[4], o[5], o[6], o[7]);
                pk.z = pack_fp8x4(o[8], o[9], o[10], o[11]); pk.w = pack_fp8x4(o[12], o[13], o[14], o[15]);
                *(uint4*)(dst + q * 16) = pk;
            }
        }
#else
        const bf16* Wt = p.wt_gu + (size_t)e * 1024 * D;
        ACC_DECL(4, acc); acc_zero(acc);
        gemm_accum<4>(acc, [&](int i) { int q = mt * 128 + i; int a = (q < cnt_e) ? el[q] : el[0]; return p.h + (size_t)(a >> 1) * D; },
                      [&](int j) { return Wt + (size_t)(nt * 128 + j) * D; }, D, smc);
        ACC_FOR_PAIR(row, pcol) {
            float gv = AV_G(acc), uv = AV_U(acc);
            p.act[(size_t)(rt * 128 + row) * 512 + nt * 64 + pcol] = f2bf(siluf_(gv) * uv);
        } ACC_END
#endif
    }
}

HD void ph_ffn2(const Params& p, int l, int bid, int nb, char* smc) {
    int tstart[17];
    { int acc = 0; for (int e = 0; e < 16; ++e) { tstart[e] = acc; acc += (p.cnt[l * 16 + e] + 127) >> 7; } tstart[16] = acc; }
    const int ntiles = tstart[16];
    for (int tile = bid; tile < ntiles * 8; tile += nb) {
        const int rt = tile >> 3, nt = tile & 7;
        int e = 0;
#pragma unroll
        for (int q = 1; q < 16; ++q) if (rt >= tstart[q]) e = q;
#ifndef CPU_EMU
        const unsigned char* Wt8 = d8_of(p) + (size_t)e * D * 512;
        AccT<4> acc; acc_zero(acc);
        gemm_accum8<4>(acc, [&](int i) { return (const unsigned char*)p.act + (size_t)(rt * 128 + i) * 512; }, [&](int j) { return Wt8 + (size_t)(nt * 128 + j) * 512; }, 512, smc, SC_ACT, SC_W);
#else
        const bf16* Wt = p.wt_d + (size_t)e * D * 512;
        ACC_DECL(4, acc); acc_zero(acc);
        gemm_accum<4>(acc, [&](int i) { return p.act + (size_t)(rt * 128 + i) * 512; }, [&](int j) { return Wt + (size_t)(nt * 128 + j) * 512; }, 512, smc);
#endif
#ifndef CPU_EMU
        {
            float* tl = (float*)smc;
            acc_to_lds<4>(acc, tl);
            __syncthreads();
            const int t_ = tid_(); const int row = t_ >> 1, half = t_ & 1;
            bf16* dst = p.Y + (size_t)(rt * 128 + row) * D + nt * 128 + half * 64;
#pragma unroll
            for (int q = 0; q < 8; ++q) {
                const f32x4_t a = *(const f32x4_t*)(tl + row * 132 + half * 64 + q * 8), b = *(const f32x4_t*)(tl + row * 132 + half * 64 + q * 8 + 4);
                uint4 pk; pk.x = cvtpk(a[0], a[1]); pk.y = cvtpk(a[2], a[3]); pk.z = cvtpk(b[0], b[1]); pk.w = cvtpk(b[2], b[3]);
                *(uint4*)(dst + q * 8) = pk;
            }
        }
#else
        ACC_FOR(4, row, col) { p.Y[(size_t)(rt * 128 + row) * D + nt * 128 + col] = f2bf(AV(acc)); } ACC_END
#endif
    }
}

#ifndef CPU_EMU
template <int DRY> HD void ph_combine_t(const Params& p, int l, int bid, int nb) {
    const int RQ = (l == 0) ? R : NLAT;
    const int t = tid_(), lane = t & 63, w = t >> 6;
    int tstart[17];
    { int acc = 0;
#pragma unroll
      for (int e = 0; e < 16; ++e) { tstart[e] = acc; acc += (p.cnt[l * 16 + e] + 127) >> 7; } tstart[16] = acc; }
    for (int r = bid * 4 + w; r < RQ; r += nb * 4) {
        float* xo = xrow_out(p, r);
        const float* m = modrow(p, l, r) + 5120;
        const int e0 = p.sel_e[r * 2], e1 = p.sel_e[r * 2 + 1];
        int t0 = 0, t1 = 0;
#pragma unroll
        for (int q = 0; q < 16; ++q) { if (q == e0) t0 = tstart[q]; if (q == e1) t1 = tstart[q]; }
        const bf16* y0 = p.Y + (size_t)(t0 * 128 + p.apos[r * 2]) * D;
        const bf16* y1 = p.Y + (size_t)(t1 * 128 + p.apos[r * 2 + 1]) * D;
        const float w0 = p.sel_w[r * 2], w1 = p.sel_w[r * 2 + 1];
#pragma unroll
        for (int j = 0; j < 4; ++j) {
            const int k = j * 256 + lane * 4;
            f32x4_t xv = *(const f32x4_t*)(xo + k);
            const f32x4_t gv = *(const f32x4_t*)(m + k);
            const uint2 a = *(const uint2*)(y0 + k), b = *(const uint2*)(y1 + k);
            xv[0] += gv[0] * (w0 * __uint_as_float(a.x << 16) + w1 * __uint_as_float(b.x << 16));
            xv[1] += gv[1] * (w0 * __uint_as_float(a.x & 0xffff0000u) + w1 * __uint_as_float(b.x & 0xffff0000u));
            xv[2] += gv[2] * (w0 * __uint_as_float(a.y << 16) + w1 * __uint_as_float(b.y << 16));
            xv[3] += gv[3] * (w0 * __uint_as_float(a.y & 0xffff0000u) + w1 * __uint_as_float(b.y & 0xffff0000u));
            *(f32x4_t*)((DRY ? (float*)p.gq + (size_t)r * 64 : xo) + (DRY ? (k & 63) : k)) = xv;
        }
    }
}
HD void ph_combine(const Params& p, int l, int bid, int nb) { ph_combine_t<0>(p, l, bid, nb); }
#else
HD void ph_combine(const Params& p, int l, int bid, int nb) {
    const int RQ = (l == 0) ? R : NLAT;
    int tstart[17];
    { int acc = 0; for (int e = 0; e < 16; ++e) { tstart[e] = acc; acc += (p.cnt[l * 16 + e] + 127) >> 7; } tstart[16] = acc; }
    for (int r = bid; r < RQ; r += nb) {
        float* xo = xrow_out(p, r);
        const float* m = modrow(p, l, r);
        int e0 = p.sel_e[r * 2], e1 = p.sel_e[r * 2 + 1];
        int t0 = 0, t1 = 0;
#pragma unroll
        for (int q = 0; q < 16; ++q) { if (q == e0) t0 = tstart[q]; if (q == e1) t1 = tstart[q]; }
        const bf16* y0 = p.Y + (size_t)(t0 * 128 + p.apos[r * 2]) * D;
        const bf16* y1 = p.Y + (size_t)(t1 * 128 + p.apos[r * 2 + 1]) * D;
        const float w0 = p.sel_w[r * 2], w1 = p.sel_w[r * 2 + 1];
        THREADS(t, 256) {
            for (int k = t; k < D; k += 256) xo[k] += m[5120 + k] * (w0 * bf2f(y0[k]) + w1 * bf2f(y1[k]));
        }
    }
}

#endif

constexpr int NPHASE_LAYER = 14;
HD void run_phase(const Params& p, int ph, int l, int bid, int nb, float* sm) {
    switch (ph) {
        case 0: ph_norm1(p, l, bid, nb, sm); break;
        case 1: ph_inproj(p, l, bid, nb, (char*)sm); break;
        case 2: ph_prep(p, l, bid, nb); if (FOURIER_GEMM) ph_fourier_s1(p, bid, nb, (char*)sm); break;
        case 3: ph_na(p, l, bid, nb, (char*)sm); break;
        case 4: ph_da(p, l, bid, nb, (char*)sm); break;
        case 5: ph_gdn_chunk(p, l, bid, nb, sm); break;
        case 6: ph_fourier2(p, l, bid, nb); if (FOURIER_GEMM) ph_fourier_sA(p, bid, nb, (char*)sm); break;
        case 7: {
            ph_gdn_scan(p, l, bid, nb, sm);
            const bool split = nb >= 128;
            if (!split || bid >= 64) {
                const int b2 = split ? bid - 64 : bid, n2 = split ? nb - 64 : nb;
                if (FOURIER_GEMM) ph_fourier_sB(p, b2, n2, (char*)sm);
                if (l == 0) convert_static(p, b2, n2, sm, 1);
                convert_moe(p, l, b2, n2, sm);
            }
        } break;
        case 8: ph_gdn_fin(p, l, bid, nb); break;
        case 9: ph_merge(p, l, bid, nb, (char*)sm); break;
        case 10: ph_outproj(p, l, bid, nb, (char*)sm); break;
        case 11: ph_router(p, l, bid, nb, sm); break;
        case 12: ph_ffn1(p, l, bid, nb, (char*)sm); break;
        case 13: ph_ffn2(p, l, bid, nb, (char*)sm); break;
        case 14: ph_combine(p, l, bid, nb); break;
#ifndef CPU_EMU
        case 70: ph_gdn_scan(p, l, bid, nb, sm); break;
        case 71: if (bid >= 64) { if (FOURIER_GEMM) ph_fourier_sB(p, bid - 64, nb - 64, (char*)sm); if (l == 0) convert_static(p, bid - 64, nb - 64, sm, 1); convert_moe(p, l, bid - 64, nb - 64, sm); } break;
        case 110: ph_outproj_t<1>(p, l, bid, nb, (char*)sm); break;
        case 111: ph_router_t<1>(p, l, bid, nb, sm); break;
        case 114: ph_combine_t<1>(p, l, bid, nb); break;
#endif
        default: break;
    }
}

struct WsLayout { size_t ropeT, bar, fa2, fW1, fWA, fWB, mods, cosT, sinT, cs, gg, gbeta, sel_e, sel_w, cnt, elist, apos, cG, wt_in, wt_br, wt_out, wt_gu, wt_d,
                  h, P, gq, fcs, cU, cW, cQK, odir, br, mg, act, Y, total; };
inline WsLayout ws_layout() {
    WsLayout w; size_t o = 0;
    auto take = [&](size_t bytes) { size_t r = o; o += (bytes + 255) & ~(size_t)255; return r; };
    w.bar = take(3456 * 4); w.ropeT = take(128 * 8 * 2 * 4);
    w.mods = take(2 * 3 * 6144 * 4); w.cosT = take(SEQ * 4); w.sinT = take(SEQ * 4); w.cs = take((size_t)NCTX * D * 4);
    w.gg = take((size_t)8 * R * 4); w.gbeta = take((size_t)8 * R * 4); w.sel_e = take((size_t)R * 2 * 4); w.sel_w = take((size_t)R * 2 * 4);
    w.cnt = take(32 * 4); w.elist = take((size_t)16 * 2 * R * 4); w.apos = take((size_t)2 * R * 4); w.cG = take((size_t)NUNIT * 192 * 4);
    w.wt_in = take((size_t)2 * WIN_NP * D * 2); w.wt_br = take((size_t)2 * 4 * D * 256 * 2); w.wt_out = take((size_t)2 * D * D * 2);
    w.wt_gu = take((size_t)16 * 1024 * D * 2); w.wt_d = take((size_t)16 * D * 512 * 2);
    w.h = take((size_t)R * D * 2);
    w.fa2 = take((size_t)NB * 128 * 256 * 2 * 64 * 2); w.fW1 = take(8192 * 2); w.fWA = take(65536 * 2); w.fWB = take(8192 * 2);
    {
        const size_t szP = ((size_t)R * PLD * 2 + 255) & ~(size_t)255, szQ = ((size_t)R * 768 * 2 + 255) & ~(size_t)255;
        const size_t szA = ((size_t)PADROWS * 512 * 2 + 255) & ~(size_t)255, szY = ((size_t)PADROWS * 1024 * 2 + 255) & ~(size_t)255;
        const size_t base = take((szP + szQ) > (szA + szY) ? (szP + szQ) : (szA + szY));
        w.P = base; w.gq = base + szP; w.act = base; w.Y = base + szA;
    }
    w.fcs = take((size_t)R * 512 * 2);
    w.cU = take((size_t)NUNIT * 4096 * 2); w.cW = take((size_t)NUNIT * 4096 * 2); w.cQK = take((size_t)NUNIT * 4096 * 2);
    w.odir = take((size_t)2 * R * 256 * 2); w.br = take((size_t)R * D * 2);
    w.mg = w.cU;
    w.total = o;
    return w;
}
inline void fill_params(Params& p, void* const* d_in, void* d_out, void* d_ws) {
    WsLayout w = ws_layout(); char* b = (char*)d_ws;
    for (int i = 0; i < 30; ++i) p.in[i] = (const float*)d_in[i];
    p.out = (float*)d_out;
    p.mods = (float*)(b + w.mods); p.cosT = (float*)(b + w.cosT); p.sinT = (float*)(b + w.sinT); p.cs = (float*)(b + w.cs);
    p.h = (bf16*)(b + w.h); p.P = (bf16*)(b + w.P); p.gq = (bf16*)(b + w.gq); p.gg = (float*)(b + w.gg); p.gbeta = (float*)(b + w.gbeta);
    p.fcs = (bf16*)(b + w.fcs); p.cU = (bf16*)(b + w.cU); p.cW = (bf16*)(b + w.cW); p.cQK = (bf16*)(b + w.cQK); p.cG = (float*)(b + w.cG);
    p.odir = (bf16*)(b + w.odir); p.br = (bf16*)(b + w.br); p.mg = (bf16*)(b + w.mg); p.sel_e = (int*)(b + w.sel_e);
    p.sel_w = (float*)(b + w.sel_w); p.act = (bf16*)(b + w.act); p.Y = (bf16*)(b + w.Y);
    p.wt_in = (bf16*)(b + w.wt_in); p.wt_br = (bf16*)(b + w.wt_br); p.wt_out = (bf16*)(b + w.wt_out); p.wt_gu = (bf16*)(b + w.wt_gu);
    p.fa2 = (bf16*)(b + w.fa2); p.fW1 = (bf16*)(b + w.fW1); p.fWA = (bf16*)(b + w.fWA); p.fWB = (bf16*)(b + w.fWB);
    p.bar = (unsigned*)(b + w.bar); p.ropeT = (float*)(b + w.ropeT);
    p.wt_d = (bf16*)(b + w.wt_d); p.cnt = (int*)(b + w.cnt); p.elist = (int*)(b + w.elist); p.apos = (int*)(b + w.apos);
}

#if !defined(CPU_EMU) && defined(PHASE_KERNELS)
#define PK(n) __global__ void __launch_bounds__(256, 2) pk_##n(Params p) { __shared__ __attribute__((aligned(16))) float sm[SMEM_FLOATS]; run_phase(p, n, p.layer, blockIdx.x, gridDim.x, sm); }
PK(0) PK(1) PK(2) PK(3) PK(4) PK(5) PK(6) PK(7) PK(8) PK(9) PK(10) PK(11) PK(12) PK(13) PK(14)
__global__ void __launch_bounds__(256, 2) pk_init(Params p) { __shared__ __attribute__((aligned(16))) float sm[SMEM_FLOATS]; ph_init(p, blockIdx.x, gridDim.x, sm); }
#endif
#ifndef CPU_EMU

#define XB_TMO      128
#define XB_XCNT(j)  (256  + 64 * (j))
#define XB_XSUB(j)  (1280 + 64 * (j))
#define XB_XGEN(j)  (2304 + 64 * (j))
#define XB_TOP      3328
#define XB_TOPGEN   3392
#define XCD_BAR_WORDS 3456
#define XB_SPIN_CAP (1u << 22)
#define LAS __attribute__((address_space(3)))
__device__ __forceinline__ unsigned xb_ld(unsigned* p)              { return __hip_atomic_load(p, __ATOMIC_RELAXED, __HIP_MEMORY_SCOPE_AGENT); }
__device__ __forceinline__ unsigned xb_add(unsigned* p, unsigned v) { return __hip_atomic_fetch_add(p, v, __ATOMIC_RELAXED, __HIP_MEMORY_SCOPE_AGENT); }
__device__ __forceinline__ unsigned xb_xcc_id() { return (unsigned)__builtin_amdgcn_s_getreg((3 << 11) | 20) & 0xFu; }
#define XB_SPIN(cond, bar) do { unsigned _sp = 0; while (cond) { __builtin_amdgcn_s_sleep(1); \
    if ((++_sp & 255u) == 0u) { if (xb_ld(&(bar)[XB_TMO])) break; if (_sp > XB_SPIN_CAP) { atomicAdd(&(bar)[XB_TMO], 1u); break; } } } } while (0)
struct XcdBarrier { unsigned* bar; unsigned x; volatile LAS unsigned* st; };
__device__ __forceinline__ XcdBarrier xcd_barrier_post(unsigned* bar, volatile LAS unsigned* st) {
    XcdBarrier b; b.bar = bar; b.x = xb_xcc_id(); b.st = st;
    if (threadIdx.x == 0) (void)xb_add(&bar[XB_XCNT(b.x)], 1u);
    return b;
}
__device__ __forceinline__ void xcd_barrier_complete(unsigned* bar, unsigned x, unsigned& nloc, unsigned& nx) {
    const unsigned G = gridDim.x * gridDim.y * gridDim.z;
    unsigned sum, cnt, mine, sp = 0u;
    for (;;) {
        sum = 0u; cnt = 0u; mine = 0u;
#pragma unroll
        for (unsigned j = 0; j < 16; ++j) { const unsigned c = xb_ld(&bar[XB_XCNT(j)]); sum += c; cnt += (c > 0u) ? 1u : 0u; mine = (j == x) ? c : mine; }
        if (sum == G) break;
        __builtin_amdgcn_s_sleep(1);
        if ((++sp & 255u) == 0u) { if (xb_ld(&bar[XB_TMO])) break; if (sp > XB_SPIN_CAP) { atomicAdd(&bar[XB_TMO], 1u); break; } }
    }
    nloc = mine > 0u ? mine : 1u; nx = cnt > 0u ? cnt : 1u;
}
__device__ __forceinline__ void xcd_barrier(const XcdBarrier& b) {
    asm volatile("s_waitcnt vmcnt(0)" ::: "memory");
    __syncthreads();
    if (threadIdx.x == 0) {
        unsigned* bar = b.bar;
        __builtin_amdgcn_s_waitcnt(0);
        unsigned nloc = b.st[0], nx = b.st[1];
        if (nloc == 0u) { xcd_barrier_complete(bar, b.x, nloc, nx); b.st[0] = nloc; b.st[1] = nx; }
        const unsigned old = xb_add(&bar[XB_XSUB(b.x)], 1u);
        const unsigned gen = old / nloc;
        if (old + 1u == (gen + 1u) * nloc) {
            __builtin_amdgcn_fence(__ATOMIC_RELEASE, "agent");
            asm volatile("s_waitcnt vmcnt(0)" ::: "memory");
            const unsigned og = xb_add(&bar[XB_TOP], 1u);
            const unsigned tg = og / nx;
            if (og + 1u == (tg + 1u) * nx) xb_add(&bar[XB_TOPGEN], 1u);
            else XB_SPIN(xb_ld(&bar[XB_TOPGEN]) == tg, bar);
            __builtin_amdgcn_fence(__ATOMIC_ACQUIRE, "agent");
            xb_add(&bar[XB_XGEN(b.x)], 1u);
            asm volatile("s_waitcnt vmcnt(0)" ::: "memory");
        } else {
            XB_SPIN(xb_ld(&bar[XB_XGEN(b.x)]) == gen, bar);
            __builtin_amdgcn_fence(__ATOMIC_ACQUIRE, "agent");
            asm volatile("s_waitcnt vmcnt(0)" ::: "memory");
        }
    }
    __syncthreads();
}

__global__ void __launch_bounds__(256, 2) fwd_megakernel(Params p) {
    __shared__ __attribute__((aligned(16))) float sm[SMEM_FLOATS];
    cg::grid_group grid = cg::this_grid();
    const int bid = blockIdx.x, nb = gridDim.x;
    volatile LAS unsigned* xst = (volatile LAS unsigned*)(sm + SMEM_FLOATS - 4);
    if (threadIdx.x == 0) { xst[0] = 0u; xst[1] = 0u; }
    __syncthreads();
    XcdBarrier xb = xcd_barrier_post(p.bar, xst);
    ph_init(p, bid, nb, sm);
    grid.sync();
#ifdef PROBE_INIT
    ph_init(p, bid, nb, sm); xcd_barrier(xb); ph_init(p, bid, nb, sm); xcd_barrier(xb);
#endif
#define PH(n, l) run_phase(p, n, l, bid, nb, sm); xcd_barrier(xb);
#define PHN(n, l) run_phase(p, n, l, bid, nb, sm);
#ifndef PROBE_X
#define PROBE_X(n, l)
#endif
#define LAYER(l) PH(0, l) PROBE_X(0, l) PH(1, l) PROBE_X(1, l) PH(2, l) PROBE_X(2, l) PHN(4, l) PHN(3, l) PHN(6, l) PH(5, l) PROBE_X(4, l) PROBE_X(5, l) PROBE_X(3, l) PROBE_X(6, l) \
    PH(7, l) PROBE_X(7, l) PROBE_X(70, l) PROBE_X(71, l) PH(8, l) PROBE_X(8, l) PH(9, l) PROBE_X(9, l) PH(10, l) PH(11, l) PH(12, l) PROBE_X(12, l) \
    PH(13, l) PROBE_X(13, l) PH(14, l)
    LAYER(0)
    LAYER(1)
}

extern "C" void kernel_launch(void* const* d_in, const int* in_sizes, int n_in, void* d_out, int out_size,
                              void* d_ws, size_t ws_size, hipStream_t stream) {
    WsLayout w = ws_layout();
    if (ws_size < w.total) { fprintf(stderr, "ws too small: need %zu have %zu\n", w.total, ws_size); return; }
    static int grid_blocks = 0;
    if (!grid_blocks) {
        int dev = 0, cus = 0, per_cu = 0;
        (void)hipGetDevice(&dev);
        (void)hipDeviceGetAttribute(&cus, hipDeviceAttributeMultiprocessorCount, dev);
        (void)hipOccupancyMaxActiveBlocksPerMultiprocessor(&per_cu, fwd_megakernel, 256, 0);
        if (per_cu < 1) per_cu = 1;
        grid_blocks = cus * per_cu;
    }
    Params p{};
    fill_params(p, d_in, d_out, d_ws);
    (void)hipMemsetAsync(p.bar, 0, XCD_BAR_WORDS * 4, stream);
    void* args[] = {&p};
    hipError_t e = hipLaunchCooperativeKernel((void*)fwd_megakernel, dim3(grid_blocks), dim3(256), args, 0, stream);
    if (e != hipSuccess) fprintf(stderr, "cooperative launch failed: %s (grid %d)\n", hipGetErrorString(e), grid_blocks);
}
#endif
```

```cpp
#ifndef CPU_EMU
#include <hip/hip_runtime.h>
#include <hip/hip_cooperative_groups.h>
#include <cstdio>
namespace cg = cooperative_groups;
#define HD __device__ __forceinline__
__device__ __forceinline__ int tid_() { int v = threadIdx.x; asm volatile("" : "+v"(v)); return v; }
#define THREADS(t, n) for (int t = tid_(); t < (n); t += 256)
#define SYNC __syncthreads();
#define COSPI(x) cospif(x)
#define SINPI(x) sinpif(x)
typedef float4 f4;
#else
#include <cmath>
#include <cstdio>
#include <cstring>
#include <cstddef>
#define HD inline
#define THREADS(t, n) for (int t = 0; t < (n); ++t)
#define SYNC
#define COSPI(x) ((float)cos(M_PI * (double)(x)))
#define SINPI(x) ((float)sin(M_PI * (double)(x)))
struct f4 { float x, y, z, w; };
#endif

#ifndef SEQ
#define SEQ 8192
#endif
#ifndef CTXL
#define CTXL 256
#endif

typedef unsigned short bf16;
#ifndef CPU_EMU
typedef __attribute__((ext_vector_type(8))) short bf16x8_t;
typedef __attribute__((ext_vector_type(4))) float f32x4_t;
typedef __attribute__((ext_vector_type(4))) int i32x4_t;
#define ATOMIC_ADD_RET(ptr, v) atomicAdd((ptr), (v))
#else
HD int atomic_add_ret_(int* p, int v) { int old;
#pragma omp atomic capture
    { old = *p; *p += v; }
    return old; }
#define ATOMIC_ADD_RET(ptr, v) atomic_add_ret_((ptr), (v))
#endif
constexpr int NB = 2, D = 1024, GW = 64, ROWS = SEQ / GW;
constexpr int NLAT = NB * SEQ, NCTX = NB * CTXL, R = NLAT + NCTX;
constexpr int DIN = 6928;
constexpr int PLD = 2816;
constexpr int C_NAQ = 0, C_NAK = 256, C_NAV = 512, C_DAQ = 768, C_DAK = 1024, C_DAV = 1280, C_GQ = 1536, C_Z = 2304,
              C_F = 2560;
constexpr int WIN_N = 6912;
constexpr int WIN_NP = WIN_N + 64;
constexpr int PADROWS = 2 * R + 16 * 128;
constexpr int NCC = CTXL / 64, NCL = SEQ / 64, NCH = NCC + NCL;
constexpr int NUNIT = 2 * NB * 4 * NCH;
constexpr bool FOURIER_GEMM = (SEQ == 8192);
constexpr int SMEM_FLOATS = 73 * 256 + 4;

struct Params {
    const float* in[30];
    float* out;
    float* mods;
    float* cosT;
    float* sinT;
    float* cs;
    bf16* h;
    bf16* P;
    bf16* gq;
    float* gg;
    float* gbeta;
    bf16* fcs;
    bf16* cU;
    bf16* cW;
    bf16* cQK;
    float* cG;
    bf16* odir;
    bf16* br;
    bf16* mg;
    int* sel_e;
    float* sel_w;
    bf16* act;
    bf16* Y;
    bf16* wt_in;
    bf16* wt_br;
    bf16* wt_out;
    bf16* wt_gu;
    bf16* wt_d;
    int* cnt;
    unsigned* bar;
    bf16* fa2;
    bf16* fW1;
    float* ropeT;
    bf16* fWA;
    bf16* fWB;
    int* elist;
    int* apos;
    int phase;
    int layer;
};

enum { I_X = 0, I_C, I_CTX, I_CCTX, I_WMOD, I_BMOD, I_N1G, I_N2G, I_WIN, I_NAQG, I_NAKG, I_RPB, I_DAQG, I_DAKG, I_LQ1, I_LK1,
       I_LQ2, I_LK2, I_SUBLN, I_CONVW, I_ALOG, I_DTB, I_ONORM, I_WBR, I_WOUT, I_WROUTER, I_RBIAS, I_MG, I_MU, I_MD };

HD float bf2f(bf16 v) { union { unsigned u; float f; } x; x.u = ((unsigned)v) << 16; return x.f; }
#ifndef CPU_EMU
typedef float f32x2_t __attribute__((ext_vector_type(2))); typedef __bf16 bf16x2_t __attribute__((ext_vector_type(2)));
typedef short s16x4_t __attribute__((ext_vector_type(4)));
typedef __attribute__((address_space(3))) const char* lds_cptr;
HD unsigned cvtpk(float lo, float hi) { f32x2_t v = {lo, hi}; bf16x2_t b = __builtin_convertvector(v, bf16x2_t); return __builtin_bit_cast(unsigned, b); }
HD bf16 f2bf(float f) { return (bf16)(cvtpk(f, 0.f) & 0xffffu); }
HD s16x4_t lds_tr16(lds_cptr p) { return __builtin_bit_cast(s16x4_t, __builtin_amdgcn_ds_read_tr16_b64_v4i16((__attribute__((address_space(3))) s16x4_t*)p)); }
#else
HD bf16 f2bf(float f) { union { unsigned u; float f; } x; x.f = f; unsigned u = x.u; u += 0x7fffu + ((u >> 16) & 1u); return (bf16)(u >> 16); }
#endif
HD float sigmoidf_(float x) { return 1.0f / (1.0f + expf(-x)); }
HD float siluf_(float x) { return x / (1.0f + expf(-x)); }

struct RowInfo { int seg, b, t, T, base; };
HD RowInfo rowinfo(int r) {
    RowInfo q;
    if (r < NLAT) { q.seg = 0; q.b = r / SEQ; q.t = r % SEQ; q.T = SEQ; q.base = q.b * SEQ; }
    else { int r2 = r - NLAT; q.seg = 1; q.b = r2 / CTXL; q.t = r2 % CTXL; q.T = CTXL; q.base = NLAT + q.b * CTXL; }
    return q;
}
HD const float* xrow_in(const Params& p, int l, int r) {
    if (r < NLAT) return (l == 0 ? p.in[I_X] : p.out) + (size_t)r * D;
    return p.cs + (size_t)(r - NLAT) * D;
}
HD float* xrow_out(const Params& p, int r) {
    if (r < NLAT) return p.out + (size_t)r * D;
    return p.cs + (size_t)(r - NLAT) * D;
}
HD const float* modrow(const Params& p, int l, int r) {
    int s = (r < NLAT) ? (r / SEQ) : 2;
    return p.mods + (size_t)(l * 3 + s) * 6144;
}
#ifndef CPU_EMU
HD unsigned char* gu8_of(const Params& p) { return (unsigned char*)p.wt_gu; }
HD unsigned char* d8_of(const Params& p) { return (unsigned char*)p.wt_gu + (size_t)16 * 1024 * 1024; }
HD unsigned char* h8_of(const Params& p) { return (unsigned char*)p.wt_gu + (size_t)16 * 1024 * 1024 + (size_t)16 * 1024 * 512; }
#endif
HD float lam_init_of(int l) { return l == 0 ? 0.2f : (0.8f - 0.6f * 0.7408182206817179f); }


#ifndef CPU_EMU
template <int NJ> struct AccT { f32x4_t v[4][NJ]; };
#define ACC_DECL(NJ, a) AccT<NJ> a
template <int NJ> HD void acc_zero(AccT<NJ>& a) {
#pragma unroll
    for (int i = 0; i < 4; ++i)
#pragma unroll
        for (int j = 0; j < NJ; ++j) a.v[i][j] = f32x4_t{0.f, 0.f, 0.f, 0.f};
}
#define ACC_FOR(NJ, row, col) { const int _t = tid_(); const int _ln = _t & 63, _w = _t >> 6; \
    _Pragma("unroll") for (int _i = 0; _i < 4; ++_i) _Pragma("unroll") for (int _j = 0; _j < NJ; ++_j) _Pragma("unroll") for (int _r = 0; _r < 4; ++_r) { \
    const int row = (_w >> 1) * 64 + _i * 16 + (_ln >> 4) * 4 + _r; const int col = (_w & 1) * (16 * NJ) + _j * 16 + (_ln & 15);
#define AV(a) a.v[_i][_j][_r]
#define ACC_END }}
#define ACC_FOR_PAIR(row, pcol) { const int _t = tid_(); const int _ln = _t & 63, _w = _t >> 6; \
    _Pragma("unroll") for (int _i = 0; _i < 4; ++_i) _Pragma("unroll") for (int _jj = 0; _jj < 2; ++_jj) _Pragma("unroll") for (int _r = 0; _r < 4; ++_r) { \
    const int row = (_w >> 1) * 64 + _i * 16 + (_ln >> 4) * 4 + _r; const int pcol = (_w & 1) * 32 + _jj * 16 + (_ln & 15);
#define AV_G(a) a.v[_i][2 * _jj][_r]
#define AV_U(a) a.v[_i][2 * _jj + 1][_r]

#define WAIT_VM0() asm volatile("s_waitcnt vmcnt(0)" ::: "memory")
#define GLDS16(gp, lp) __builtin_amdgcn_global_load_lds((const unsigned*)(gp), (unsigned*)(lp), 16, 0, 0)
template <int NJ, class AF, class BF>
HD void gemm_accum(AccT<NJ>& acc, AF arow, BF brow, int K, char* smem) {
    constexpr int NBL = NJ;
    const int t = tid_(), lane = t & 63, w = t >> 6, wr = w >> 1, wc = w & 1;
    const int lr = t >> 3, lc = t & 7;
    const bf16* ap[4]; const bf16* bp[NBL];
#pragma unroll
    for (int i = 0; i < 4; ++i) ap[i] = arow(lr + 32 * i) + ((lc ^ (lr & 7)) << 3);
#pragma unroll
    for (int i = 0; i < NBL; ++i) bp[i] = brow(lr + 32 * i) + ((lc ^ (lr & 7)) << 3);
    char* sA = smem + w * 1024; char* sB = smem + 32768 + w * 1024;
    const int fr = lane & 15, fg = lane >> 4;
    const unsigned aoff0 = (wr * 64 + fr) * 128 + (((fg) ^ (fr & 7)) << 4);
    const unsigned aoff1 = (wr * 64 + fr) * 128 + (((4 + fg) ^ (fr & 7)) << 4);
    const unsigned boff0 = (wc * (16 * NJ) + fr) * 128 + (((fg) ^ (fr & 7)) << 4);
    const unsigned boff1 = (wc * (16 * NJ) + fr) * 128 + (((4 + fg) ^ (fr & 7)) << 4);
    const int KT = K >> 6;
    __syncthreads();
#pragma unroll
    for (int i = 0; i < 4; ++i) GLDS16(ap[i], sA + 4096 * i);
#pragma unroll
    for (int i = 0; i < NBL; ++i) GLDS16(bp[i], sB + 4096 * i);
    WAIT_VM0();
    __syncthreads();
#pragma unroll 1
    for (int kt = 0; kt < KT; ++kt) {
        const int cur = kt & 1;
        if (kt + 1 < KT) {
#pragma unroll
            for (int i = 0; i < 4; ++i) GLDS16(ap[i] + (kt + 1) * 64, sA + (cur ^ 1) * 16384 + 4096 * i);
#pragma unroll
            for (int i = 0; i < NBL; ++i) GLDS16(bp[i] + (kt + 1) * 64, sB + (cur ^ 1) * 16384 + 4096 * i);
        }
        const char* cA = smem + cur * 16384; const char* cB = smem + 32768 + cur * 16384;
#pragma unroll
        for (int s = 0; s < 2; ++s) {
            bf16x8_t af[4], bfr[NJ];
#pragma unroll
            for (int i = 0; i < 4; ++i) af[i] = *(const bf16x8_t*)(cA + (s ? aoff1 : aoff0) + i * 2048);
#pragma unroll
            for (int j = 0; j < NJ; ++j) bfr[j] = *(const bf16x8_t*)(cB + (s ? boff1 : boff0) + j * 2048);
#pragma unroll
            for (int i = 0; i < 4; ++i)
#pragma unroll
                for (int j = 0; j < NJ; ++j) acc.v[i][j] = __builtin_amdgcn_mfma_f32_16x16x32_bf16(af[i], bfr[j], acc.v[i][j], 0, 0, 0);
        }
        WAIT_VM0();
        __syncthreads();
    }
}
template <int NJ> HD void acc_to_lds(const AccT<NJ>& acc, float* tl) {
    const int t = tid_(), lane = t & 63, w = t >> 6;
    constexpr int LD = 32 * NJ + 4;
    float* base = tl + ((w >> 1) * 64 + (lane >> 4) * 4) * LD + (w & 1) * (16 * NJ) + (lane & 15);
#pragma unroll
    for (int i = 0; i < 4; ++i)
#pragma unroll
        for (int j = 0; j < NJ; ++j)
#pragma unroll
            for (int r = 0; r < 4; ++r) base[(i * 16 + r) * LD + j * 16] = acc.v[i][j][r];
}
typedef int i32x8_t __attribute__((ext_vector_type(8)));
typedef unsigned char u8;
template <int NJ, class AF, class BF>
HD void gemm_accum8(AccT<NJ>& acc, AF arow, BF brow, int K, char* smem, int sa, int sb) {
    constexpr int NBL = NJ;
    const int t = tid_(), lane = t & 63, w = t >> 6, wr = w >> 1, wc = w & 1;
    const int lr = t >> 3, lc = t & 7;
    const u8* ap[4]; const u8* bp[NBL];
#pragma unroll
    for (int i = 0; i < 4; ++i) ap[i] = arow(lr + 32 * i) + ((lc ^ (lr & 7)) << 4);
#pragma unroll
    for (int i = 0; i < NBL; ++i) bp[i] = brow(lr + 32 * i) + ((lc ^ (lr & 7)) << 4);
    char* sA = smem + w * 1024; char* sB = smem + 32768 + w * 1024;
    const int fr = lane & 15, fg = lane >> 4;
    const unsigned aoff0 = (wr * 64 + fr) * 128 + (((2 * fg) ^ (fr & 7)) << 4);
    const unsigned aoff1 = (wr * 64 + fr) * 128 + (((2 * fg + 1) ^ (fr & 7)) << 4);
    const unsigned boff0 = (wc * (16 * NJ) + fr) * 128 + (((2 * fg) ^ (fr & 7)) << 4);
    const unsigned boff1 = (wc * (16 * NJ) + fr) * 128 + (((2 * fg + 1) ^ (fr & 7)) << 4);
    const int KT = K >> 7;
    __syncthreads();
#pragma unroll
    for (int i = 0; i < 4; ++i) GLDS16(ap[i], sA + 4096 * i);
#pragma unroll
    for (int i = 0; i < NBL; ++i) GLDS16(bp[i], sB + 4096 * i);
    WAIT_VM0();
    __syncthreads();
#pragma unroll 1
    for (int kt = 0; kt < KT; ++kt) {
        const int cur = kt & 1;
        if (kt + 1 < KT) {
#pragma unroll
            for (int i = 0; i < 4; ++i) GLDS16(ap[i] + (kt + 1) * 128, sA + (cur ^ 1) * 16384 + 4096 * i);
#pragma unroll
            for (int i = 0; i < NBL; ++i) GLDS16(bp[i] + (kt + 1) * 128, sB + (cur ^ 1) * 16384 + 4096 * i);
        }
        const char* cA = smem + cur * 16384; const char* cB = smem + 32768 + cur * 16384;
        i32x8_t af[4], bfr[NJ];
#pragma unroll
        for (int i = 0; i < 4; ++i) {
            const i32x4_t lo = *(const i32x4_t*)(cA + aoff0 + i * 2048), hi = *(const i32x4_t*)(cA + aoff1 + i * 2048);
            af[i] = i32x8_t{lo[0], lo[1], lo[2], lo[3], hi[0], hi[1], hi[2], hi[3]};
        }
#pragma unroll
        for (int j = 0; j < NJ; ++j) {
            const i32x4_t lo = *(const i32x4_t*)(cB + boff0 + j * 2048), hi = *(const i32x4_t*)(cB + boff1 + j * 2048);
            bfr[j] = i32x8_t{lo[0], lo[1], lo[2], lo[3], hi[0], hi[1], hi[2], hi[3]};
        }
#pragma unroll
        for (int i = 0; i < 4; ++i)
#pragma unroll
            for (int j = 0; j < NJ; ++j) acc.v[i][j] = __builtin_amdgcn_mfma_scale_f32_16x16x128_f8f6f4(af[i], bfr[j], acc.v[i][j], 0, 0, 0, sa, 0, sb);
        WAIT_VM0();
        __syncthreads();
    }
}
HD unsigned pack_fp8x4(float a, float b, float c, float d) {
    a = __builtin_amdgcn_fmed3f(a, -448.f, 448.f); b = __builtin_amdgcn_fmed3f(b, -448.f, 448.f);
    c = __builtin_amdgcn_fmed3f(c, -448.f, 448.f); d = __builtin_amdgcn_fmed3f(d, -448.f, 448.f);
    int w = 0;
    w = __builtin_amdgcn_cvt_pk_fp8_f32(a, b, w, false);
    w = __builtin_amdgcn_cvt_pk_fp8_f32(c, d, w, true);
    return (unsigned)w;
}
constexpr int SC_H = 0x7d7d7d7d;
constexpr int SC_W = 0x7a7a7a7a;
constexpr int SC_ACT = 0x7b7b7b7b;
#else
template <int NJ> struct AccT { float v[128][32 * NJ]; };
#define ACC_DECL(NJ, a) static thread_local AccT<NJ> a
template <int NJ> HD void acc_zero(AccT<NJ>& a) { memset(a.v, 0, sizeof(a.v)); }
#define ACC_FOR(NJ, row, col) { for (int row = 0; row < 128; ++row) for (int col = 0; col < 32 * NJ; ++col) {
#define AV(a) a.v[row][col]
#define ACC_END }}
#define ACC_FOR_PAIR(row, pcol) { for (int row = 0; row < 128; ++row) for (int pcol = 0; pcol < 64; ++pcol) {
#define AV_G(a) a.v[row][(pcol / 16) * 32 + (pcol % 16)]
#define AV_U(a) a.v[row][(pcol / 16) * 32 + 16 + (pcol % 16)]
template <int NJ, class AF, class BF>
HD void gemm_accum(AccT<NJ>& acc, AF arow, BF brow, int K, char* smem) {
    for (int i = 0; i < 128; ++i) { const bf16* a = arow(i);
        for (int j = 0; j < 32 * NJ; ++j) { const bf16* b = brow(j); float s = 0.f;
            for (int k = 0; k < K; ++k) s += bf2f(a[k]) * bf2f(b[k]);
            acc.v[i][j] += s; } }
}
#endif

template <class DF>
HD void conv_tile(const float* src, size_t lds_, bf16* dst, size_t ldd, int k0, int nsrc0, DF drow, float* sm) {
    THREADS(t, 4096) { int kk = t >> 6, nn = t & 63; sm[kk * 65 + nn] = src[(size_t)(k0 + kk) * lds_ + nsrc0 + nn]; }
    SYNC
    THREADS(t, 4096) { int nn = t >> 6, kk = t & 63; dst[(size_t)drow(nn) * ldd + k0 + kk] = f2bf(sm[kk * 65 + nn]); }
    SYNC
}
#ifndef CPU_EMU
template <class DF>
HD void conv_tile8(const float* src, size_t lds_, unsigned char* dst, size_t ldd, int k0, int nsrc0, DF drow, float scale, float* sm) {
    THREADS(t, 4096) { int kk = t >> 6, nn = t & 63; sm[kk * 65 + nn] = src[(size_t)(k0 + kk) * lds_ + nsrc0 + nn] * scale; }
    SYNC
    THREADS(t, 1024) { int nn = t >> 4, k4 = (t & 15) * 4;
        *(unsigned*)(dst + (size_t)drow(nn) * ldd + k0 + k4) = pack_fp8x4(sm[k4 * 65 + nn], sm[(k4 + 1) * 65 + nn], sm[(k4 + 2) * 65 + nn], sm[(k4 + 3) * 65 + nn]); }
    SYNC
}
HD void convert_moe(const Params& p, int l, int bid, int nb, float* sm) {
    for (int w = bid; w < 4096 + 2048; w += nb) {
        if (w < 4096) {
            int nt = w & 7, kt = (w >> 3) & 15, gu = (w >> 7) & 1, e = w >> 8;
            const float* src = p.in[gu ? I_MU : I_MG] + (size_t)(l * 16 + e) * D * 512;
            conv_tile8(src, 512, gu8_of(p) + (size_t)e * 1024 * D, D, kt * 64, nt * 64, [&](int nn) { int j = nt * 64 + nn; return (j >> 4) * 32 + (j & 15) + 16 * gu; }, 32.0f, sm);
        } else {
            int w2 = w - 4096; int nt = w2 & 15, kt = (w2 >> 4) & 7, e = w2 >> 7;
            const float* src = p.in[I_MD] + (size_t)(l * 16 + e) * 512 * D;
            conv_tile8(src, D, d8_of(p) + (size_t)e * D * 512, 512, kt * 64, nt * 64, [&](int nn) { return nt * 64 + nn; }, 32.0f, sm);
        }
    }
}
#else
HD void convert_moe(const Params& p, int l, int bid, int nb, float* sm) {
    for (int w = bid; w < 4096 + 2048; w += nb) {
        if (w < 4096) {
            int nt = w & 7, kt = (w >> 3) & 15, gu = (w >> 7) & 1, e = w >> 8;
            const float* src = p.in[gu ? I_MU : I_MG] + (size_t)(l * 16 + e) * D * 512;
            bf16* dst = p.wt_gu + (size_t)e * 1024 * D;
            conv_tile(src, 512, dst, D, kt * 64, nt * 64, [&](int nn) { int j = nt * 64 + nn; return (j >> 4) * 32 + (j & 15) + 16 * gu; }, sm);
        } else {
            int w2 = w - 4096; int nt = w2 & 15, kt = (w2 >> 4) & 7, e = w2 >> 7;
            const float* src = p.in[I_MD] + (size_t)(l * 16 + e) * 512 * D;
            bf16* dst = p.wt_d + (size_t)e * D * 512;
            conv_tile(src, D, dst, 512, kt * 64, nt * 64, [&](int nn) { return nt * 64 + nn; }, sm);
        }
    }
}
#endif
HD void convert_static(const Params& p, int bid, int nb, float* sm, int part) {
    for (int w = bid; w < 3456 + 512 + 512 + 32; w += nb) {
        if ((part == 0) != (w < 3456 || w >= 3456 + 512 + 512)) continue;
        if (w >= 3456 + 512 + 512) {
            int w2 = w - 3456 - 512 - 512; int kt = w2 & 15, l = w2 >> 4;
            conv_tile(p.in[I_WIN] + (size_t)l * D * DIN, DIN, p.wt_in + (size_t)l * WIN_NP * D, D, kt * 64, 2560, [&](int nn) { return WIN_N + nn; }, sm);
        } else if (w < 3456) {
            int nt = w % 108, kt = (w / 108) & 15, l = w / (108 * 16);
            int n0 = nt * 64;
#ifndef CPU_EMU
            if (n0 >= PLD) {
                conv_tile8(p.in[I_WIN] + (size_t)l * D * DIN, DIN, (unsigned char*)(p.wt_in + (size_t)l * WIN_NP * D + (size_t)PLD * D), D, kt * 64, n0 + 16,
                           [&](int nn) { return n0 - PLD + nn; }, 32.0f, sm);
                continue;
            }
#endif
            conv_tile(p.in[I_WIN] + (size_t)l * D * DIN, DIN, p.wt_in + (size_t)l * WIN_NP * D, D, kt * 64, n0 < 2560 ? n0 : n0 + 16,
                      [&](int nn) { return n0 + nn; }, sm);
        } else if (w < 3456 + 512) {
            int w2 = w - 3456; int nt = w2 & 15, kt = (w2 >> 4) & 3, li = w2 >> 6;
            conv_tile(p.in[I_WBR] + (size_t)li * 256 * D, D, p.wt_br + (size_t)li * D * 256, 256, kt * 64, nt * 64, [&](int nn) { return nt * 64 + nn; }, sm);
        } else {
            int w2 = w - 3456 - 512; int nt = w2 & 15, kt = (w2 >> 4) & 15, l = w2 >> 8;
            conv_tile(p.in[I_WOUT] + (size_t)l * D * D, D, p.wt_out + (size_t)l * D * D, D, kt * 64, nt * 64, [&](int nn) { return nt * 64 + nn; }, sm);
        }
    }
}

HD void init_tables(const Params& p, int bid, int nb) {
    for (int u = bid; u < (SEQ + 255) / 256; u += nb) {
        THREADS(t, 256) {
            int j = u * 256 + t;
            if (j < SEQ) { float a = 2.0f * (float)j / (float)SEQ; p.cosT[j] = COSPI(a); p.sinT[j] = SINPI(a); }
        }
    }
    if (bid == 0) {
        THREADS(t, 1024) {
            int pos = t >> 3, f = t & 7; float fr_ = 1.0f;
            for (int q = 0; q < f; ++q) fr_ *= 0.31622776601683794f;
            float ang = (float)pos * fr_;
            p.ropeT[t * 2] = cosf(ang); p.ropeT[t * 2 + 1] = sinf(ang);
        }
    }
    for (int u = bid; u < (8192 + 65536 + 8192) / 256; u += nb) {
        THREADS(t, 256) {
            int i = u * 256 + t;
            if (i < 8192) {
                int j = i >> 6, c = i & 63; int cs = j >> 6, m = j & 63;
                float a = 2.0f * (float)((m * c) & 63) / 64.0f;
                p.fW1[i] = f2bf(cs ? SINPI(a) : COSPI(a));
            } else if (i < 8192 + 65536) {
                int q = i - 8192; int n = q >> 8, k = q & 255;
                int ri = (n >> 4) & 1, k1 = (n >> 5) * 16 + (n & 15); int cs = k >> 7, t1 = k & 127;
                float a = 2.0f * (float)((k1 * t1) & 127) / 128.0f;
                float cv = COSPI(a), sv = SINPI(a);
                float v = (ri == 0) ? (cs == 0 ? cv : -sv) : (cs == 0 ? -sv : -cv);
                p.fWA[q] = f2bf(v);
            } else {
                int q = i - 8192 - 65536; int k2 = q >> 7, k = q & 127; int ri = k >> 6, t2 = k & 63;
                float a = 2.0f * (float)((k2 * t2) & 63) / 64.0f;
                p.fWB[q] = f2bf(ri ? SINPI(a) : COSPI(a));
            }
        }
    }
}

HD void ph_init(const Params& p, int bid, int nb, float* sm) {
    const int NMOD = 2 * 3 * 6144;
    if (bid == 0) { THREADS(t, 32) { p.cnt[t] = 0; } }
#ifndef CPU_EMU
    {
        const int tq = tid_(); const int col = tq & 63, ks = tq >> 6;
        for (int u = nb - 1 - bid; u < 2 * 96; u += nb) {
            const int l = u / 96, c0 = (u % 96) * 64;
            __syncthreads();
            for (int i = tq; i < 3 * D; i += 256) { const int s_ = i / D, k = i % D; const float cv = (s_ < 2) ? p.in[I_C][s_ * D + k] : p.in[I_CCTX][k]; sm[i] = siluf_(cv); }
            __syncthreads();
            const float* wp = p.in[I_WMOD] + (size_t)l * D * 6144 + (size_t)(ks * 256) * 6144 + c0 + col;
            float a0 = 0.f, a1 = 0.f, a2 = 0.f;
#pragma unroll 8
            for (int k = 0; k < 256; ++k) { const float wv = wp[(size_t)k * 6144]; a0 += sm[ks * 256 + k] * wv; a1 += sm[D + ks * 256 + k] * wv; a2 += sm[2 * D + ks * 256 + k] * wv; }
            float* red = sm + 3 * D;
            red[(ks * 3 + 0) * 64 + col] = a0; red[(ks * 3 + 1) * 64 + col] = a1; red[(ks * 3 + 2) * 64 + col] = a2;
            __syncthreads();
            if (tq < 192) {
                const int s_ = tq >> 6, cc = tq & 63;
                const float v = red[(0 * 3 + s_) * 64 + cc] + red[(1 * 3 + s_) * 64 + cc] + red[(2 * 3 + s_) * 64 + cc] + red[(3 * 3 + s_) * 64 + cc];
                p.mods[(size_t)(l * 3 + s_) * 6144 + c0 + cc] = v + p.in[I_BMOD][l * 6144 + c0 + cc];
            }
        }
    }
    convert_static(p, bid, nb, sm, 0);
#else
    convert_static(p, bid, nb, sm, 0);
    for (int u = bid; u < (NMOD + 255) / 256; u += nb) {
        THREADS(t, 256) {
            int idx = u * 256 + t;
            if (idx < NMOD) {
                int l = idx / (3 * 6144), s = (idx / 6144) % 3, col = idx % 6144;
                const float* cv = (s < 2) ? p.in[I_C] + s * D : p.in[I_CCTX];
                const float* w = p.in[I_WMOD] + (size_t)l * D * 6144 + col;
                float acc = 0.f;
                for (int k = 0; k < D; ++k) acc += siluf_(cv[k]) * w[(size_t)k * 6144];
                p.mods[idx] = acc + p.in[I_BMOD][l * 6144 + col];
            }
        }
    }
#endif
    init_tables(p, bid, nb);
    for (int u = bid; u < (NCTX * D) / 256; u += nb) {
        THREADS(t, 256) { int i = u * 256 + t; p.cs[i] = p.in[I_CTX][i]; }
    }

}

#ifndef CPU_EMU
HD float wave_sum(float v) {
#pragma unroll
    for (int o = 32; o >= 1; o >>= 1) v += __shfl_xor(v, o);
    return v;
}
HD void ph_norm1(const Params& p, int l, int bid, int nb, float* sm) {
    const int t = tid_(), lane = t & 63, w = t >> 6;
    const float* g = p.in[I_N1G] + l * D;
    for (int r = bid * 4 + w; r < R; r += nb * 4) {
        const float* x = xrow_in(p, l, r);
        const float* m = modrow(p, l, r);
        f32x4_t xv[4]; float ss = 0.f;
#pragma unroll
        for (int j = 0; j < 4; ++j) { xv[j] = *(const f32x4_t*)(x + j * 256 + lane * 4); ss += xv[j][0] * xv[j][0] + xv[j][1] * xv[j][1] + xv[j][2] * xv[j][2] + xv[j][3] * xv[j][3]; }
        ss = wave_sum(ss);
        const float rs = 1.0f / sqrtf(ss / D + 1e-6f);
#pragma unroll
        for (int j = 0; j < 4; ++j) {
            const int k = j * 256 + lane * 4;
            const f32x4_t gv = *(const f32x4_t*)(g + k), sc = *(const f32x4_t*)(m + 1024 + k), sh = *(const f32x4_t*)(m + k);
            float o[4];
#pragma unroll
            for (int q = 0; q < 4; ++q) o[q] = xv[j][q] * rs * gv[q] * (1.0f + sc[q]) + sh[q];
            uint2 pk; pk.x = cvtpk(o[0], o[1]); pk.y = cvtpk(o[2], o[3]);
            *(uint2*)(p.h + (size_t)r * D + k) = pk;
            *(unsigned*)(h8_of(p) + (size_t)r * D + k) = pack_fp8x4(o[0] * 4.f, o[1] * 4.f, o[2] * 4.f, o[3] * 4.f);
        }
    }
}
#else
HD void ph_norm1(const Params& p, int l, int bid, int nb, float* sm) {
    const float* g = p.in[I_N1G] + l * D;
    for (int r = bid; r < R; r += nb) {
        const float* x = xrow_in(p, l, r);
        const float* m = modrow(p, l, r);
        THREADS(t, 256) { float s = 0.f; for (int k = t; k < D; k += 256) s += x[k] * x[k]; sm[t] = s; }
        SYNC
        THREADS(t, 1) { float s = 0.f; for (int i = 0; i < 256; ++i) s += sm[i]; sm[256] = s; }
        SYNC
        THREADS(t, 256) {
            float rs = 1.0f / sqrtf(sm[256] / D + 1e-6f);
            for (int k = t; k < D; k += 256) {
                float v = x[k] * rs * g[k];
                p.h[(size_t)r * D + k] = f2bf(v * (1.0f + m[1024 + k]) + m[k]);
            }
        }
        SYNC
    }
}
#endif

HD void ph_inproj(const Params& p, int l, int bid, int nb, char* smc) {
    const bf16* Wt = p.wt_in + (size_t)l * WIN_NP * D;
    constexpr int NT = PLD / 128, MT = R / 128;
    for (int mt = bid; mt < MT; mt += nb) {
        ACC_DECL(2, acc); acc_zero(acc);
        gemm_accum<2>(acc, [&](int i) { return p.h + (size_t)(mt * 128 + i) * D; }, [&](int j) { return Wt + (size_t)(WIN_N + j) * D; }, D, smc);
        ACC_FOR(2, row, col) {
            const int r = mt * 128 + row;
            if (col < 8) {
                const float xx = AV(acc) + p.in[I_DTB][l * 8 + col];
                const float sp = xx > 20.f ? xx : log1pf(expf(xx));
                p.gg[(size_t)col * R + r] = -expf(p.in[I_ALOG][l * 8 + col]) * sp;
            } else if (col < 16) p.gbeta[(size_t)(col - 8) * R + r] = sigmoidf_(AV(acc));
        } ACC_END
    }
    for (int tile = bid; tile < MT * NT; tile += nb) {
        const int mt = tile / NT, nt = tile % NT;
        ACC_DECL(4, acc); acc_zero(acc);
        gemm_accum<4>(acc, [&](int i) { return p.h + (size_t)(mt * 128 + i) * D; }, [&](int j) { return Wt + (size_t)(nt * 128 + j) * D; }, D, smc);
#ifndef CPU_EMU
        {
            float* tl = (float*)smc;
            acc_to_lds<4>(acc, tl);
            __syncthreads();
            const int t_ = tid_(); const int row = t_ >> 1, half = t_ & 1;
            const int cb = nt * 128 + half * 64;
            float v[64];
#pragma unroll
            for (int q = 0; q < 16; ++q) { const f32x4_t x4 = *(const f32x4_t*)(tl + row * 132 + half * 64 + q * 4); v[q * 4] = x4[0]; v[q * 4 + 1] = x4[1]; v[q * 4 + 2] = x4[2]; v[q * 4 + 3] = x4[3]; }
            if (cb < 512) {
                const float* gn = (cb < 256 ? p.in[I_NAQG] : p.in[I_NAKG]) + l * 64;
                float ss = 0.f;
#pragma unroll
                for (int c = 0; c < 64; ++c) ss += v[c] * v[c];
                const float rs = __builtin_amdgcn_rsqf(ss * (1.0f / 64.0f) + 1e-6f) * ((cb < 256) ? 0.125f * 1.4426950408889634f : 1.0f);
#pragma unroll
                for (int c = 0; c < 64; ++c) v[c] *= rs * gn[c];
            } else if (cb >= 768 && cb < 1280) {
                const float* gn = (cb < 1024 ? p.in[I_DAQG] : p.in[I_DAKG]) + l * 32;
                const float qs = (cb < 1024) ? 0.17677669529663687f * 1.4426950408889634f : 1.0f;
#pragma unroll
                for (int gp = 0; gp < 2; ++gp) {
                    float ss = 0.f;
#pragma unroll
                    for (int c = 0; c < 32; ++c) ss += v[gp * 32 + c] * v[gp * 32 + c];
                    const float rs = __builtin_amdgcn_rsqf(ss * (1.0f / 32.0f) + 1e-6f) * qs;
#pragma unroll
                    for (int c = 0; c < 32; ++c) v[gp * 32 + c] *= rs * gn[c];
                }
                const int gr_ = mt * 128 + row;
                if (gr_ < NLAT) {
                    const int tt = gr_ % SEQ;
#pragma unroll
                    for (int a = 0; a < 2; ++a) {
                        const float pos = (float)(a == 0 ? tt / GW : tt % GW);
                        float frev = 0.15915494309189535f;
#pragma unroll
                        for (int f = 0; f < 8; ++f) {
                            const float cs = __builtin_amdgcn_cosf(pos * frev), sn = __builtin_amdgcn_sinf(pos * frev);
#pragma unroll
                            for (int gp = 0; gp < 2; ++gp) {
                                const int i1 = gp * 32 + a * 16 + f, i2 = i1 + 8;
                                const float x1 = v[i1], x2 = v[i2];
                                v[i1] = x1 * cs - x2 * sn; v[i2] = x2 * cs + x1 * sn;
                            }
                            frev *= 0.31622776601683794f;
                        }
                    }
                }
            }
            bf16* dst = p.P + (size_t)(mt * 128 + row) * PLD + cb;
#pragma unroll
            for (int q = 0; q < 8; ++q) {
                uint4 pk; pk.x = cvtpk(v[q * 8], v[q * 8 + 1]); pk.y = cvtpk(v[q * 8 + 2], v[q * 8 + 3]); pk.z = cvtpk(v[q * 8 + 4], v[q * 8 + 5]); pk.w = cvtpk(v[q * 8 + 6], v[q * 8 + 7]);
                *(uint4*)(dst + q * 8) = pk;
            }
        }
#else
        ACC_FOR(4, row, col) { p.P[(size_t)(mt * 128 + row) * PLD + nt * 128 + col] = f2bf(AV(acc)); } ACC_END
#endif
    }
}

HD void ph_prep(const Params& p, int l, int bid, int nb) {
#ifdef CPU_EMU
    {
        const float* naq = p.in[I_NAQG] + l * 64; const float* nak = p.in[I_NAKG] + l * 64;
        const float* daq = p.in[I_DAQG] + l * 32; const float* dak = p.in[I_DAKG] + l * 32;
        const int N = R * 24;
        for (int u = bid; u < (N + 255) / 256; u += nb) {
            THREADS(t, 256) {
                int idx = u * 256 + t;
                if (idx < N) {
                    int r = idx / 24, gidx = idx % 24;
                    if (gidx < 8) {
                        int isk = gidx >> 2, hd = gidx & 3;
                        bf16* ptr = p.P + (size_t)r * PLD + (isk ? C_NAK : C_NAQ) + hd * 64;
                        const float* g = isk ? nak : naq;
                        float ss = 0.f;
                        for (int d = 0; d < 64; ++d) { float v = bf2f(ptr[d]); ss += v * v; }
                        float rs = 1.0f / sqrtf(ss / 64.0f + 1e-6f);
#ifndef CPU_EMU
                        if (!isk) rs *= 0.125f * 1.4426950408889634f;
#endif
                        for (int d = 0; d < 64; ++d) ptr[d] = f2bf(bf2f(ptr[d]) * rs * g[d]);
                    } else {
                        int gi = gidx - 8; int isk = gi >> 3; int hm = gi & 7;
                        bf16* ptr = p.P + (size_t)r * PLD + (isk ? C_DAK : C_DAQ) + hm * 32;
                        const float* g = isk ? dak : daq;
                        float ss = 0.f;
                        for (int d = 0; d < 32; ++d) { float v = bf2f(ptr[d]); ss += v * v; }
                        float rs = 1.0f / sqrtf(ss / 32.0f + 1e-6f);
#ifndef CPU_EMU
                        if (!isk) rs *= 0.17677669529663687f * 1.4426950408889634f;
#endif
                        if (r < NLAT) {
                            int tt = r % SEQ; float prow = (float)(tt / GW), pcol = (float)(tt % GW);
                            for (int a = 0; a < 2; ++a) {
                                float pos = a == 0 ? prow : pcol;
                                float fr = 1.0f;
                                for (int f = 0; f < 8; ++f) {
                                    float ang = pos * fr;
                                    float cs = cosf(ang), sn = sinf(ang);
                                    int i1 = a * 16 + f, i2 = a * 16 + 8 + f;
                                    float x1 = bf2f(ptr[i1]) * rs * g[i1], x2 = bf2f(ptr[i2]) * rs * g[i2];
                                    ptr[i1] = f2bf(x1 * cs - x2 * sn);
                                    ptr[i2] = f2bf(x2 * cs + x1 * sn);
                                    fr *= 0.31622776601683794f;
                                }
                            }
                        } else {
                            for (int d = 0; d < 32; ++d) ptr[d] = f2bf(bf2f(ptr[d]) * rs * g[d]);
                        }
                    }
                }
            }
        }
    }
#endif
#ifndef CPU_EMU
    {
        const float* cw = p.in[I_CONVW] + (size_t)l * 5 * 768;
        const int N = R * 96;
        for (int idx = bid * 256 + tid_(); idx < N; idx += nb * 256) {
            const int r = idx / 96, q = idx % 96; const int ph = q >> 3, cg = q & 7; const int part = ph >> 2, hd = ph & 3;
            const RowInfo ri = rowinfo(r);
            const int ch0 = part * 256 + hd * 64 + cg * 8;
            float y[8];
#pragma unroll
            for (int c = 0; c < 8; ++c) y[c] = 0.f;
#pragma unroll
            for (int i = 0; i < 5; ++i) {
                const int tt = ri.t + i - 2;
                if (tt >= 0 && tt < ri.T) {
                    const uint4 raw = *(const uint4*)(p.P + (size_t)(ri.base + tt) * PLD + C_GQ + ch0);
                    const f32x4_t w0 = *(const f32x4_t*)(cw + i * 768 + ch0), w1 = *(const f32x4_t*)(cw + i * 768 + ch0 + 4);
                    y[0] += __uint_as_float(raw.x << 16) * w0[0]; y[1] += __uint_as_float(raw.x & 0xffff0000u) * w0[1];
                    y[2] += __uint_as_float(raw.y << 16) * w0[2]; y[3] += __uint_as_float(raw.y & 0xffff0000u) * w0[3];
                    y[4] += __uint_as_float(raw.z << 16) * w1[0]; y[5] += __uint_as_float(raw.z & 0xffff0000u) * w1[1];
                    y[6] += __uint_as_float(raw.w << 16) * w1[2]; y[7] += __uint_as_float(raw.w & 0xffff0000u) * w1[3];
                }
            }
            float ss = 0.f;
#pragma unroll
            for (int c = 0; c < 8; ++c) { y[c] = siluf_(y[c]); ss += y[c] * y[c]; }
            ss += __shfl_xor(ss, 1); ss += __shfl_xor(ss, 2); ss += __shfl_xor(ss, 4);
            float scl = 1.0f;
            if (part == 0) scl = 0.125f / sqrtf(ss + 1e-6f); else if (part == 1) scl = 1.0f / sqrtf(ss + 1e-6f);
            uint4 pk; pk.x = cvtpk(y[0] * scl, y[1] * scl); pk.y = cvtpk(y[2] * scl, y[3] * scl); pk.z = cvtpk(y[4] * scl, y[5] * scl); pk.w = cvtpk(y[6] * scl, y[7] * scl);
            *(uint4*)(p.gq + (size_t)r * 768 + ch0) = pk;
        }
    }
#else
    {
        const float* cw = p.in[I_CONVW] + (size_t)l * 5 * 768;
        const int N = R * 12;
        for (int u = bid; u < (N + 255) / 256; u += nb) {
            THREADS(t, 256) {
                int idx = u * 256 + t;
                if (idx < N) {
                    int r = idx / 12, ph = idx % 12; int part = ph >> 2, hd = ph & 3;
                    RowInfo ri = rowinfo(r);
                    int ch0 = part * 256 + hd * 64;
                    float ss = 0.f;
                    for (int pass = 0; pass < 2; ++pass) {
                        float scl = 1.0f;
                        if (pass == 1) { if (part == 0) scl = 0.125f / sqrtf(ss + 1e-6f); else if (part == 1) scl = 1.0f / sqrtf(ss + 1e-6f); }
                        if (pass == 0 && part == 2) continue;
                        for (int c = 0; c < 64; ++c) {
                            float y = 0.f;
                            for (int i = 0; i < 5; ++i) {
                                int tt = ri.t + i - 2;
                                if (tt >= 0 && tt < ri.T) y += bf2f(p.P[(size_t)(ri.base + tt) * PLD + C_GQ + ch0 + c]) * cw[i * 768 + ch0 + c];
                            }
                            y = siluf_(y);
                            if (pass == 0) ss += y * y; else p.gq[(size_t)r * 768 + ch0 + c] = f2bf(y * scl);
                        }
                    }
                }
            }
        }
    }
#endif
    {
        const int RQ = (l == 0) ? R : NLAT;
        for (int r = (FOURIER_GEMM ? NLAT : 0) + bid; r < RQ; r += nb) {
            THREADS(t, 256) {
                int g = t >> 6, m = t & 63;
                const bf16* f = p.P + (size_t)r * PLD + C_F + g * 64;
                float fc = 0.f, fs = 0.f;
                for (int c = 0; c < 64; ++c) {
                    int ti = ((m * c) & 63) * (SEQ / 64);
                    float v = bf2f(f[c]);
                    fc += v * p.cosT[ti]; fs += v * p.sinT[ti];
                }
                p.fcs[(size_t)r * 512 + t] = f2bf(fc);
                p.fcs[(size_t)r * 512 + 256 + t] = f2bf(fs);
            }
        }
    }
}

#ifndef CPU_EMU
HD void ph_na(const Params& p, int l, int bid, int nb, char* smc) {
    const int t = tid_(), lane = t & 63, w = t >> 6, fr = lane & 15, fg = lane >> 4;
    const float* rpb = p.in[I_RPB] + (size_t)l * 4 * 15 * 31;
    float* sbias = (float*)(smc + 32768);
    const lds_cptr lds = (lds_cptr)smc;
    constexpr int WH = ROWS < 8 ? ROWS : 8;
    const int nlat = NB * ROWS * 4;
    const int nctx = (l == 0) ? NB * 4 * (CTXL / 64) : 0;
    const int lkey = t >> 3, lc = t & 7;
    const int ksrc = (lc ^ (lkey & 7)) << 3;
    const int vsrc = ((((lc >> 1) ^ ((lkey >> 1) & 3)) << 1) | (lc & 1)) << 3;
    for (int unit = bid; unit < nlat + nctx; unit += nb) {
        int b, hd, qrow, ntl, rs = 0, gr = 0;
        if (unit < nlat) {
            hd = unit & 3; const int br_ = unit >> 2; gr = br_ % ROWS; b = br_ / ROWS;
            qrow = b * SEQ + gr * GW + w * 16 + fr; ntl = WH;
            rs = gr - WH / 2; if (rs < 0) rs = 0; if (rs > ROWS - WH) rs = ROWS - WH;
        } else {
            const int u2 = unit - nlat; const int qt = u2 % (CTXL / 64); const int bh = u2 / (CTXL / 64); hd = bh & 3; b = bh >> 2;
            qrow = NLAT + b * CTXL + qt * 64 + w * 16 + fr; ntl = 0;
        }
        const int ntiles = ntl + NCC;
        const int qcol = w * 16 + fr;
        int cs0 = w * 16 - 8; if (cs0 < 0) cs0 = 0; if (cs0 > GW - 32) cs0 = GW - 32;
        int wsq = qcol - 8; if (wsq < 0) wsq = 0; if (wsq > GW - 16) wsq = GW - 16;
        bf16x8_t qf[2];
#pragma unroll
        for (int s_ = 0; s_ < 2; ++s_) qf[s_] = *(const bf16x8_t*)(p.P + (size_t)qrow * PLD + C_NAQ + hd * 64 + s_ * 32 + fg * 8);
        f32x4_t O[4];
#pragma unroll
        for (int d = 0; d < 4; ++d) O[d] = f32x4_t{0.f, 0.f, 0.f, 0.f};
        float ls = 0.f;
        auto keyrow = [&](int tt, int i) { return (tt < ntl) ? (b * SEQ + (rs + tt) * GW + i) : (NLAT + b * CTXL + (tt - ntl) * 64 + i); };
        char* ldst = smc + w * 1024;
        __syncthreads();
        for (int i = t; i < 15 * 31; i += 256) sbias[i] = rpb[hd * 465 + i] * 1.4426950408889634f;
#pragma unroll
        for (int i = 0; i < 2; ++i) {
            const bf16* src = p.P + (size_t)keyrow(0, lkey + 32 * i) * PLD + hd * 64;
            GLDS16(src + C_NAK + ksrc, ldst + 4096 * i); GLDS16(src + C_NAV + vsrc, ldst + 16384 + 4096 * i);
        }
        WAIT_VM0();
        __syncthreads();
        const int vkl = 4 * fg + (fr >> 2);
        const int vsw = (vkl >> 1) & 3;
        unsigned va[4];
#pragma unroll
        for (int d = 0; d < 4; ++d) va[d] = 16384 + vkl * 128 + ((((d ^ vsw) << 1) | ((fr & 3) >> 1)) << 4) + (fr & 1) * 8;
#pragma unroll 1
        for (int tt = 0; tt < ntiles; ++tt) {
            const int cur = tt & 1;
            if (tt + 1 < ntiles) {
#pragma unroll
                for (int i = 0; i < 2; ++i) {
                    const bf16* src = p.P + (size_t)keyrow(tt + 1, lkey + 32 * i) * PLD + hd * 64;
                    GLDS16(src + C_NAK + ksrc, ldst + (cur ^ 1) * 8192 + 4096 * i); GLDS16(src + C_NAV + vsrc, ldst + 16384 + (cur ^ 1) * 8192 + 4096 * i);
                }
            }
            const char* cK = smc + cur * 8192;
            const lds_cptr cV = lds + cur * 8192;
            const bool local = tt < ntl;
            const int kbase = local ? cs0 : 0;
            const int nkf = local ? 2 : 4;
            unsigned pb[2][4];
#pragma unroll
            for (int f = 0; f < 4; ++f) {
                if (f < nkf) {
                    const int key = kbase + f * 16 + fr;
                    const char* kp = cK + key * 128;
                    const bf16x8_t a0 = *(const bf16x8_t*)(kp + (((fg) ^ (fr & 7)) << 4));
                    const bf16x8_t a1 = *(const bf16x8_t*)(kp + (((4 + fg) ^ (fr & 7)) << 4));
                    f32x4_t S = __builtin_amdgcn_mfma_f32_16x16x32_bf16(a0, qf[0], f32x4_t{0.f, 0.f, 0.f, 0.f}, 0, 0, 0);
                    S = __builtin_amdgcn_mfma_f32_16x16x32_bf16(a1, qf[1], S, 0, 0, 0);
                    float e[4];
#pragma unroll
                    for (int r = 0; r < 4; ++r) {
                        float sv = S[r]; bool ok = true;
                        if (local) {
                            const int kc = kbase + f * 16 + 4 * fg + r;
                            ok = (unsigned)(kc - wsq) < 16u;
                            sv += sbias[((rs + tt) - gr + 7) * 31 + (ok ? (kc - qcol + 15) : 15)];
                        }
                        e[r] = ok ? __builtin_amdgcn_exp2f(sv) : 0.f;
                    }
                    ls += (e[0] + e[1]) + (e[2] + e[3]);
                    pb[f >> 1][(f & 1) * 2] = cvtpk(e[0], e[1]);
                    pb[f >> 1][(f & 1) * 2 + 1] = cvtpk(e[2], e[3]);
                }
            }
#pragma unroll
            for (int ks = 0; ks < 2; ++ks) {
                if (ks * 2 < nkf) {
#pragma unroll
                    for (int d = 0; d < 4; ++d) {
                        const s16x4_t lo = lds_tr16(cV + va[d] + (kbase + ks * 32) * 128);
                        const s16x4_t hi = lds_tr16(cV + va[d] + (kbase + ks * 32 + 16) * 128);
                        const bf16x8_t vf = bf16x8_t{lo[0], lo[1], lo[2], lo[3], hi[0], hi[1], hi[2], hi[3]};
                        const i32x4_t bi = i32x4_t{(int)pb[ks][0], (int)pb[ks][1], (int)pb[ks][2], (int)pb[ks][3]};
                        O[d] = __builtin_amdgcn_mfma_f32_16x16x32_bf16(vf, __builtin_bit_cast(bf16x8_t, bi), O[d], 0, 0, 0);
                    }
                }
            }
            WAIT_VM0();
            __syncthreads();
        }
        ls += __shfl_xor(ls, 16); ls += __shfl_xor(ls, 32);
        const float inv = 1.0f / ls;
        bf16* op = p.br + (size_t)qrow * D + hd * 64;
#pragma unroll
        for (int d = 0; d < 4; ++d) {
            uint2 pk; pk.x = cvtpk(O[d][0] * inv, O[d][1] * inv); pk.y = cvtpk(O[d][2] * inv, O[d][3] * inv);
            *(uint2*)(op + d * 16 + 4 * fg) = pk;
        }
    }
}
#else
HD void ph_na(const Params& p, int l, int bid, int nb, char*) {
    const float* rpb = p.in[I_RPB] + (size_t)l * 4 * 15 * 31;
    const int RQ = (l == 0) ? R : NLAT;
    const int N = RQ * 4;
    const int wh = ROWS < 8 ? ROWS : 8;
    for (int u = bid; u < (N + 255) / 256; u += nb) {
        THREADS(t, 256) {
            int idx = u * 256 + t;
            if (idx < N) {
                int hd = idx / RQ, r = idx % RQ;
                RowInfo ri = rowinfo(r);
                float q[64], o[64];
                const bf16* qp = p.P + (size_t)r * PLD + C_NAQ + hd * 64;
#pragma unroll
                for (int d = 0; d < 64; ++d) { q[d] = bf2f(qp[d]) * 0.125f; o[d] = 0.f; }
                float mx = -1e30f, lsum = 0.f;
                int nloc = 0, rs = 0, ws = 0, gr = 0, gc = 0;
                if (ri.seg == 0) {
                    gr = ri.t / GW; gc = ri.t % GW;
                    rs = gr - wh / 2; if (rs < 0) rs = 0; if (rs > ROWS - wh) rs = ROWS - wh;
                    ws = gc - 8; if (ws < 0) ws = 0; if (ws > GW - 16) ws = GW - 16;
                    nloc = wh * 16;
                }
                int ctxbase = NLAT + ri.b * CTXL;
                for (int kk = 0; kk < nloc + CTXL; ++kk) {
                    int kr; float bias = 0.f;
                    if (kk < nloc) {
                        int a = kk >> 4, c = kk & 15;
                        int krow = rs + a, kcol = ws + c;
                        kr = ri.base + krow * GW + kcol;
                        bias = rpb[(hd * 15 + (krow - gr + 7)) * 31 + (kcol - gc + 15)];
                    } else kr = ctxbase + (kk - nloc);
                    const bf16* kp = p.P + (size_t)kr * PLD + C_NAK + hd * 64;
                    float s = 0.f;
#pragma unroll
                    for (int d = 0; d < 64; ++d) s += q[d] * bf2f(kp[d]);
                    s += bias;
                    if (s > mx) { float f = expf(mx - s); lsum *= f;
#pragma unroll
                        for (int d = 0; d < 64; ++d) o[d] *= f;
                        mx = s; }
                    float e = expf(s - mx);
                    lsum += e;
                    const bf16* vp = p.P + (size_t)kr * PLD + C_NAV + hd * 64;
#pragma unroll
                    for (int d = 0; d < 64; ++d) o[d] += e * bf2f(vp[d]);
                }
                float inv = 1.0f / lsum;
                bf16* op = p.br + (size_t)r * D + hd * 64;
#pragma unroll
                for (int d = 0; d < 64; ++d) op[d] = f2bf(o[d] * inv);
            }
        }
    }
}

#endif

#ifndef CPU_EMU
HD void ph_da(const Params& p, int l, int bid, int nb, char* smc) {
    const int t = tid_(), lane = t & 63, w = t >> 6, fr = lane & 15, fg = lane >> 4;
    const float lam_init = lam_init_of(l);
    float s1 = 0.f, s2 = 0.f;
    for (int d = 0; d < 32; ++d) {
        s1 += p.in[I_LQ1][l * 32 + d] * p.in[I_LK1][l * 32 + d];
        s2 += p.in[I_LQ2][l * 32 + d] * p.in[I_LK2][l * 32 + d];
    }
    const float lam = expf(s1) - expf(s2) + lam_init;
    const float* sg = p.in[I_SUBLN] + l * 64;
    constexpr int NQT = SEQ / 128, NQC = CTXL / 128;
    const int nlat = NB * 4 * NQT;
    const int nctx = (l == 0) ? NB * 4 * NQC : 0;
    const lds_cptr lds = (lds_cptr)smc;
    for (int unit = bid; unit < nlat + nctx; unit += nb) {
        int b, hd, qrow0, kt0;
        if (unit < nlat) { const int qt = unit % NQT, bh = unit / NQT; hd = bh & 3; b = bh >> 2; qrow0 = b * SEQ + qt * 128; kt0 = 0; }
        else { const int u2 = unit - nlat; const int qt = u2 % NQC, bh = u2 / NQC; hd = bh & 3; b = bh >> 2; qrow0 = NLAT + b * CTXL + qt * 128; kt0 = NCL; }
        const int kt1 = NCL + NCC;
        bf16x8_t qf[2][2];
#pragma unroll
        for (int m = 0; m < 2; ++m)
#pragma unroll
            for (int n = 0; n < 2; ++n)
                qf[m][n] = *(const bf16x8_t*)(p.P + (size_t)(qrow0 + w * 32 + n * 16 + fr) * PLD + C_DAQ + hd * 64 + m * 32 + fg * 8);
        f32x4_t O[2][4][2];
#pragma unroll
        for (int m = 0; m < 2; ++m)
#pragma unroll
            for (int d = 0; d < 4; ++d)
#pragma unroll
                for (int n = 0; n < 2; ++n) O[m][d][n] = f32x4_t{0.f, 0.f, 0.f, 0.f};
        float ls[2][2] = {{0.f, 0.f}, {0.f, 0.f}};
        const int lkey = t >> 3, lc = t & 7;
        const int ksrc = (lc ^ (lkey & 7)) << 3;
        const int vsrc = ((((lc >> 1) ^ ((lkey >> 1) & 3)) << 1) | (lc & 1)) << 3;
        auto keyrow = [&](int kt, int i) { return (kt < NCL) ? (b * SEQ + kt * 64 + i) : (NLAT + b * CTXL + (kt - NCL) * 64 + i); };
        char* ldst = smc + w * 1024;
        __syncthreads();
#pragma unroll
        for (int i = 0; i < 2; ++i) {
            const bf16* src = p.P + (size_t)keyrow(kt0, lkey + 32 * i) * PLD + hd * 64;
            GLDS16(src + C_DAK + ksrc, ldst + 4096 * i); GLDS16(src + C_DAV + vsrc, ldst + 16384 + 4096 * i);
        }
        WAIT_VM0();
        __syncthreads();
        const unsigned ka0 = fr * 128 + (((fg) ^ (fr & 7)) << 4);
        const unsigned ka1 = fr * 128 + (((4 + fg) ^ (fr & 7)) << 4);
        const int vkey = 4 * fg + (fr >> 2);
        const int vsw = (vkey >> 1) & 3;
        unsigned va[4];
#pragma unroll
        for (int d = 0; d < 4; ++d) va[d] = 16384 + vkey * 128 + ((((d ^ vsw) << 1) | ((fr & 3) >> 1)) << 4) + (fr & 1) * 8;
#pragma unroll 1
        for (int kt = kt0; kt < kt1; ++kt) {
            const int cur = (kt - kt0) & 1;
            if (kt + 1 < kt1) {
#pragma unroll
                for (int i = 0; i < 2; ++i) {
                    const bf16* src = p.P + (size_t)keyrow(kt + 1, lkey + 32 * i) * PLD + hd * 64;
                    GLDS16(src + C_DAK + ksrc, ldst + (cur ^ 1) * 8192 + 4096 * i); GLDS16(src + C_DAV + vsrc, ldst + 16384 + (cur ^ 1) * 8192 + 4096 * i);
                }
            }
            const char* cK = smc + cur * 8192;
            const lds_cptr cV = lds + cur * 8192;
#pragma unroll
            for (int m = 0; m < 2; ++m) {
                unsigned pb[2][2][4];
                {
                    f32x4_t S[4][2];
#pragma unroll
                    for (int kf = 0; kf < 4; ++kf) {
                        const bf16x8_t a = *(const bf16x8_t*)(cK + (m ? ka1 : ka0) + kf * 2048);
#pragma unroll
                        for (int n = 0; n < 2; ++n) S[kf][n] = __builtin_amdgcn_mfma_f32_16x16x32_bf16(a, qf[m][n], f32x4_t{0.f, 0.f, 0.f, 0.f}, 0, 0, 0);
                    }
#pragma unroll
                    for (int kf = 0; kf < 4; ++kf)
#pragma unroll
                        for (int n = 0; n < 2; ++n) {
                            const float e0 = __builtin_amdgcn_exp2f(S[kf][n][0]), e1 = __builtin_amdgcn_exp2f(S[kf][n][1]);
                            const float e2 = __builtin_amdgcn_exp2f(S[kf][n][2]), e3 = __builtin_amdgcn_exp2f(S[kf][n][3]);
                            ls[m][n] += (e0 + e1) + (e2 + e3);
                            pb[n][kf >> 1][(kf & 1) * 2] = cvtpk(e0, e1);
                            pb[n][kf >> 1][(kf & 1) * 2 + 1] = cvtpk(e2, e3);
                        }
                }
#pragma unroll
                for (int ks = 0; ks < 2; ++ks)
#pragma unroll
                    for (int d = 0; d < 4; ++d) {
                        const s16x4_t lo = lds_tr16(cV + va[d] + ks * 4096);
                        const s16x4_t hi = lds_tr16(cV + va[d] + ks * 4096 + 2048);
                        const bf16x8_t vf = bf16x8_t{lo[0], lo[1], lo[2], lo[3], hi[0], hi[1], hi[2], hi[3]};
#pragma unroll
                        for (int n = 0; n < 2; ++n) {
                            const i32x4_t bi = i32x4_t{(int)pb[n][ks][0], (int)pb[n][ks][1], (int)pb[n][ks][2], (int)pb[n][ks][3]};
                            O[m][d][n] = __builtin_amdgcn_mfma_f32_16x16x32_bf16(vf, __builtin_bit_cast(bf16x8_t, bi), O[m][d][n], 0, 0, 0);
                        }
                    }
                asm volatile("" ::: "memory");
            }
            WAIT_VM0();
            __syncthreads();
        }
#pragma unroll
        for (int n = 0; n < 2; ++n) {
            float l0 = ls[0][n], l1 = ls[1][n];
            l0 += __shfl_xor(l0, 16); l0 += __shfl_xor(l0, 32);
            l1 += __shfl_xor(l1, 16); l1 += __shfl_xor(l1, 32);
            const float i0 = 1.0f / l0, i1 = lam / l1;
            float ss = 0.f;
#pragma unroll
            for (int d = 0; d < 4; ++d)
#pragma unroll
                for (int r = 0; r < 4; ++r) { const float o = O[0][d][n][r] * i0 - O[1][d][n][r] * i1; O[0][d][n][r] = o; ss += o * o; }
            ss += __shfl_xor(ss, 16); ss += __shfl_xor(ss, 32);
            const float rs = (1.0f - lam_init) / sqrtf(ss / 64.0f + 1e-6f);
            bf16* op = p.br + (size_t)(qrow0 + w * 32 + n * 16 + fr) * D + 256 + hd * 64;
#pragma unroll
            for (int d = 0; d < 4; ++d) {
                const int dv = d * 16 + 4 * fg;
                const unsigned lo = cvtpk(O[0][d][n][0] * rs * sg[dv], O[0][d][n][1] * rs * sg[dv + 1]);
                const unsigned hi = cvtpk(O[0][d][n][2] * rs * sg[dv + 2], O[0][d][n][3] * rs * sg[dv + 3]);
                uint2 pk; pk.x = lo; pk.y = hi;
                *(uint2*)(op + dv) = pk;
            }
        }
    }
}
#else
HD void ph_da(const Params& p, int l, int bid, int nb, char*) {
    const int RQ = (l == 0) ? R : NLAT;
    const int N = RQ * 4;
    const float lam_init = lam_init_of(l);
    float s1 = 0.f, s2 = 0.f;
    for (int d = 0; d < 32; ++d) {
        s1 += p.in[I_LQ1][l * 32 + d] * p.in[I_LK1][l * 32 + d];
        s2 += p.in[I_LQ2][l * 32 + d] * p.in[I_LK2][l * 32 + d];
    }
    const float lam = expf(s1) - expf(s2) + lam_init;
    const float* sg = p.in[I_SUBLN] + l * 64;
    const float scale = 0.17677669529663687f;
    for (int u = bid; u < (N + 255) / 256; u += nb) {
        THREADS(t, 256) {
            int idx = u * 256 + t;
            if (idx < N) {
                int hd = idx / RQ, r = idx % RQ;
                RowInfo ri = rowinfo(r);
                float q0[32], q1[32], o0[64], o1[64];
                const bf16* qp = p.P + (size_t)r * PLD + C_DAQ + hd * 64;
#pragma unroll
                for (int d = 0; d < 32; ++d) { q0[d] = bf2f(qp[d]) * scale; q1[d] = bf2f(qp[32 + d]) * scale; }
#pragma unroll
                for (int d = 0; d < 64; ++d) { o0[d] = 0.f; o1[d] = 0.f; }
                float m0 = -1e30f, m1 = -1e30f, l0 = 0.f, l1 = 0.f;
                int nlat = (ri.seg == 0) ? SEQ : 0;
                int latbase = ri.b * SEQ, ctxbase = NLAT + ri.b * CTXL;
                for (int kk = 0; kk < nlat + CTXL; ++kk) {
                    int kr = (kk < nlat) ? latbase + kk : ctxbase + (kk - nlat);
                    const bf16* kp = p.P + (size_t)kr * PLD + C_DAK + hd * 64;
                    const bf16* vp = p.P + (size_t)kr * PLD + C_DAV + hd * 64;
                    float sa = 0.f, sb = 0.f;
#pragma unroll
                    for (int d = 0; d < 32; ++d) { sa += q0[d] * bf2f(kp[d]); sb += q1[d] * bf2f(kp[32 + d]); }
                    if (sa > m0) { float f = expf(m0 - sa); l0 *= f;
#pragma unroll
                        for (int d = 0; d < 64; ++d) o0[d] *= f;
                        m0 = sa; }
                    if (sb > m1) { float f = expf(m1 - sb); l1 *= f;
#pragma unroll
                        for (int d = 0; d < 64; ++d) o1[d] *= f;
                        m1 = sb; }
                    float ea = expf(sa - m0), eb = expf(sb - m1);
                    l0 += ea; l1 += eb;
#pragma unroll
                    for (int d = 0; d < 64; ++d) { float v = bf2f(vp[d]); o0[d] += ea * v; o1[d] += eb * v; }
                }
                float i0 = 1.0f / l0, i1 = lam / l1;
                float ss = 0.f;
#pragma unroll
                for (int d = 0; d < 64; ++d) { o0[d] = o0[d] * i0 - o1[d] * i1; ss += o0[d] * o0[d]; }
                float rs = (1.0f - lam_init) / sqrtf(ss / 64.0f + 1e-6f);
                bf16* op = p.br + (size_t)r * D + 256 + hd * 64;
#pragma unroll
                for (int d = 0; d < 64; ++d) op[d] = f2bf(o0[d] * rs * sg[d]);
            }
        }
    }
}

#endif

struct ChunkInfo { int dir, b, hd, n, seg, T, base, nloc; };
HD ChunkInfo chunkinfo(int unit) {
    ChunkInfo c;
    c.n = unit % NCH; int ch = unit / NCH; c.hd = ch & 3; c.b = (ch >> 2) % NB; c.dir = ch / (4 * NB);
    if (c.n < NCC) { c.seg = 1; c.T = CTXL; c.base = NLAT + c.b * CTXL; c.nloc = c.n; }
    else { c.seg = 0; c.T = SEQ; c.base = c.b * SEQ; c.nloc = c.n - NCC; }
    return c;
}
HD int chunk_row(const ChunkInfo& c, int i) { int pf = c.nloc * 64 + i; return c.base + (c.dir ? (c.T - 1 - pf) : pf); }

#ifndef CPU_EMU
HD void ph_gdn_chunk(const Params& p, int l, int bid, int nb, float* smf) {
    char* smc = (char*)smf;
    const int t = tid_(), lane = t & 63, w = t >> 6, fr = lane & 15, fg = lane >> 4;
    float* sA = (float*)(smc + 24576); float* sG = (float*)(smc + 40960); float* sB = (float*)(smc + 41216);
    const int lkey = t >> 3, lc = t & 7;
    const int ksrc = (lc ^ (lkey & 7)) << 3;
    char* ldst = smc + w * 1024;
    for (int unit = bid; unit < NUNIT; unit += nb) {
        const ChunkInfo c = chunkinfo(unit);
        const int dh = c.dir * 4 + c.hd;
        __syncthreads();
#pragma unroll
        for (int i = 0; i < 2; ++i) {
            const bf16* src = p.gq + (size_t)chunk_row(c, lkey + 32 * i) * 768 + c.hd * 64;
            GLDS16(src + 256 + ksrc, ldst + 4096 * i);
            GLDS16(src + ksrc, ldst + 8192 + 4096 * i);
            GLDS16(src + 512 + lc * 8, ldst + 16384 + 4096 * i);
        }
        if (w == 0) {
            const int row = chunk_row(c, lane);
            float x = p.gg[(size_t)dh * R + row];
#pragma unroll
            for (int off = 1; off < 64; off <<= 1) { const float y = __shfl_up(x, off); if (lane >= off) x += y; }
            sG[lane] = x; sB[lane] = p.gbeta[(size_t)dh * R + row];
            const float x63 = __shfl(x, 63);
            float* cg = p.cG + (size_t)unit * 192;
            cg[lane] = __expf(x); cg[64 + lane] = __expf(x63 - x); cg[128 + lane] = __expf(x63);
        }
        WAIT_VM0();
        __syncthreads();
        {
            const char* kt_ = smc; const char* qt_ = smc + 8192;
            const unsigned ro = (16 * w + fr) * 128;
            const unsigned c0 = ((fg) ^ (fr & 7)) << 4, c1 = ((4 + fg) ^ (fr & 7)) << 4;
            const bf16x8_t ak0 = *(const bf16x8_t*)(kt_ + ro + c0), ak1 = *(const bf16x8_t*)(kt_ + ro + c1);
            const bf16x8_t aq0 = *(const bf16x8_t*)(qt_ + ro + c0), aq1 = *(const bf16x8_t*)(qt_ + ro + c1);
            float gi[4], bi[4];
#pragma unroll
            for (int r = 0; r < 4; ++r) { gi[r] = sG[16 * w + 4 * fg + r]; bi[r] = sB[16 * w + 4 * fg + r]; }
#pragma unroll
            for (int n = 0; n < 4; ++n) {
                const unsigned rb = (16 * n + fr) * 128;
                const bf16x8_t b0 = *(const bf16x8_t*)(kt_ + rb + c0), b1 = *(const bf16x8_t*)(kt_ + rb + c1);
                f32x4_t kk = __builtin_amdgcn_mfma_f32_16x16x32_bf16(ak0, b0, f32x4_t{0.f, 0.f, 0.f, 0.f}, 0, 0, 0);
                kk = __builtin_amdgcn_mfma_f32_16x16x32_bf16(ak1, b1, kk, 0, 0, 0);
                f32x4_t qk = __builtin_amdgcn_mfma_f32_16x16x32_bf16(aq0, b0, f32x4_t{0.f, 0.f, 0.f, 0.f}, 0, 0, 0);
                qk = __builtin_amdgcn_mfma_f32_16x16x32_bf16(aq1, b1, qk, 0, 0, 0);
                const int j = 16 * n + fr; const float gj = sG[j];
#pragma unroll
                for (int r = 0; r < 4; ++r) {
                    const int i = 16 * w + 4 * fg + r;
                    const float dec = (j <= i) ? __expf(gi[r] - gj) : 0.f;
                    sA[i * 64 + j] = (j < i) ? kk[r] * bi[r] * dec : 0.f;
                    p.cQK[(size_t)unit * 4096 + i * 64 + j] = f2bf(qk[r] * dec);
                }
            }
        }
        __syncthreads();
        if (w < 2) {
            float x[64];
            bf16* dst = (w == 0 ? p.cU : p.cW) + (size_t)unit * 4096 + lane;
#pragma unroll
            for (int i = 0; i < 64; ++i) {
                float rhs;
                if (w == 0) rhs = sB[i] * bf2f(*(const bf16*)(smc + 16384 + i * 128 + lane * 2));
                else rhs = sB[i] * __expf(sG[i]) * bf2f(*(const bf16*)(smc + i * 128 + ((((lane >> 3) ^ (i & 7))) << 4) + (lane & 7) * 2));
                float acc = rhs;
#pragma unroll
                for (int j4 = 0; j4 < i; j4 += 4) {
                    const f32x4_t a4 = *(const f32x4_t*)(sA + i * 64 + j4);
                    acc -= a4[0] * x[j4];
                    if (j4 + 1 < i) acc -= a4[1] * x[j4 + 1];
                    if (j4 + 2 < i) acc -= a4[2] * x[j4 + 2];
                    if (j4 + 3 < i) acc -= a4[3] * x[j4 + 3];
                }
                x[i] = acc;
                dst[i * 64] = f2bf(acc);
            }
        }
    }
}
#else
HD void ph_gdn_chunk(const Params& p, int l, int bid, int nb, float* sm) {
    float* sk = sm;
    float* sq = sm + 4096;
    float* sA = sm + 8192;
    float* sXu = sm + 12288;
    float* sXw = sm + 4096;
    float* sG = sm + 16384;
    float* sB = sm + 16448;
    for (int unit = bid; unit < NUNIT; unit += nb) {
        ChunkInfo c = chunkinfo(unit);
        int dh = c.dir * 4 + c.hd;
        THREADS(t, 4096) {
            int i = t >> 6, d = t & 63; int row = chunk_row(c, i);
            sq[t] = bf2f(p.gq[(size_t)row * 768 + c.hd * 64 + d]);
            sk[t] = bf2f(p.gq[(size_t)row * 768 + 256 + c.hd * 64 + d]);
        }
        THREADS(t, 1) {
            float acc = 0.f;
            for (int i = 0; i < 64; ++i) { int row = chunk_row(c, i); acc += p.gg[(size_t)dh * R + row]; sG[i] = acc; sB[i] = p.gbeta[(size_t)dh * R + row]; }
        }
        SYNC
        THREADS(t, 4096) {
            int i = t >> 6, j = t & 63;
            float kk = 0.f, qk = 0.f;
            for (int d = 0; d < 64; ++d) { kk += sk[i * 64 + d] * sk[j * 64 + d]; qk += sq[i * 64 + d] * sk[j * 64 + d]; }
            float dec = (j <= i) ? expf(sG[i] - sG[j]) : 0.f;
            sA[t] = (j < i) ? kk * sB[i] * dec : 0.f;
            p.cQK[(size_t)unit * 4096 + t] = f2bf(qk * dec);
        }
        SYNC
        THREADS(t, 4096) {
            int i = t >> 6, cc = t & 63; int row = chunk_row(c, i);
            sXu[t] = sB[i] * bf2f(p.gq[(size_t)row * 768 + 512 + c.hd * 64 + cc]);
            sXw[t] = sB[i] * expf(sG[i]) * sk[t];
        }
        SYNC
        for (int i = 1; i < 64; ++i) {
            THREADS(cc, 128) {
                float* X = (cc < 64) ? (sXu + cc) : (sXw + cc - 64);
                float acc = X[i * 64];
                for (int j = 0; j < i; ++j) acc -= sA[i * 64 + j] * X[j * 64];
                X[i * 64] = acc;
            }
            SYNC
        }
        THREADS(t, 4096) {
            p.cU[(size_t)unit * 4096 + t] = f2bf(sXu[t]);
            p.cW[(size_t)unit * 4096 + t] = f2bf(sXw[t]);
        }
        THREADS(t, 64) { p.cG[(size_t)unit * 64 + t] = sG[t]; }
        SYNC
    }
}

#endif

HD void ph_fourier2(const Params& p, int l, int bid, int nb) {
    const int RQ = (l == 0) ? R : NLAT;
    for (int r = (FOURIER_GEMM ? NLAT : 0) + bid; r < RQ; r += nb) {
        RowInfo ri = rowinfo(r);
        const float nrm = 1.0f / sqrtf((float)ri.T * 64.0f);
        const int mul = SEQ / ri.T;
        THREADS(ch, 256) {
            float acc = 0.f;
            for (int tt = 0; tt < ri.T; ++tt) {
                int ti = ((ri.t * tt) & (ri.T - 1)) * mul;
                const bf16* f = p.fcs + (size_t)(ri.base + tt) * 512;
                acc += p.cosT[ti] * bf2f(f[ch]) - p.sinT[ti] * bf2f(f[256 + ch]);
            }
            p.br[(size_t)r * D + 768 + ch] = f2bf(acc * nrm);
        }
    }
}


HD void ph_fourier_s1(const Params& p, int bid, int nb, char* smc) {
    for (int tile = bid; tile < NB * 64 * 4; tile += nb) {
        const int g = tile & 3, t2 = (tile >> 2) & 63, b = tile >> 8;
        ACC_DECL(4, acc); acc_zero(acc);
        gemm_accum<4>(acc, [&](int i) { return p.P + (size_t)(b * SEQ + 64 * i + t2) * PLD + C_F + g * 64; },
                      [&](int j) { return p.fW1 + j * 64; }, 64, smc);
        ACC_FOR(4, row, col) {
            const int cs = col >> 6, m = col & 63;
            p.fcs[((((size_t)b * 256 + g * 64 + m) * 64 + t2) * 2 + cs) * 128 + row] = f2bf(AV(acc));
        } ACC_END
    }
}
HD void ph_fourier_sA(const Params& p, int bid, int nb, char* smc) {
    for (int tile = bid; tile < NB * 128 * 2; tile += nb) {
        const int nt = tile & 1, mt = (tile >> 1) & 127, b = tile >> 8;
        ACC_DECL(4, acc); acc_zero(acc);
        gemm_accum<4>(acc, [&](int i) { return p.fcs + ((size_t)b * 16384 + mt * 128 + i) * 256; },
                      [&](int j) { return p.fWA + (size_t)(nt * 128 + j) * 256; }, 256, smc);
        ACC_FOR_PAIR(row, pcol) {
            const int k1 = nt * 64 + pcol; const int rr = mt * 128 + row; const int ch = rr >> 6, t2 = rr & 63;
            const float re = AV_G(acc), im = AV_U(acc);
            const float c = p.cosT[k1 * t2], sn = p.sinT[k1 * t2];
            bf16* o = p.fa2 + ((((size_t)b * 128 + k1) * 256 + ch) * 2) * 64 + t2;
            o[0] = f2bf(re * c + im * sn); o[64] = f2bf(im * c - re * sn);
        } ACC_END
    }
}
HD void ph_fourier_sB(const Params& p, int bid, int nb, char* smc) {
    const float nrm = 1.0f / sqrtf((float)SEQ * 64.0f);
    for (int tile = bid; tile < NB * 128 * 2; tile += nb) {
        const int cht = tile & 1, k1 = (tile >> 1) & 127, b = tile >> 8;
        ACC_DECL(2, acc); acc_zero(acc);
        gemm_accum<2>(acc, [&](int i) { return p.fa2 + (((size_t)b * 128 + k1) * 256 + cht * 128 + i) * 128; },
                      [&](int j) { return p.fWB + j * 128; }, 128, smc);
        ACC_FOR(2, row, col) {
            p.br[(size_t)(b * SEQ + k1 + 128 * col) * D + 768 + cht * 128 + row] = f2bf(AV(acc) * nrm);
        } ACC_END
    }
}

#ifndef CPU_EMU
struct ScanRegs { i32x4_t W[2], k[2]; unsigned u[4]; float g; };
HD bf16* scan_sp(const Params& p) { return p.h; }
HD bf16* scan_vn(const Params& p) { return p.h + (size_t)NUNIT * 4096; }
HD void ph_gdn_scan(const Params& p, int l, int bid, int nb, float* smf) {
    static_assert(NCH % 3 == 0, "scan ring assumes the chunk count is a multiple of 3");
    char* smc = (char*)smf;
    const int t = tid_(), lane = t & 63, w = t >> 6, fr = lane & 15, fg = lane >> 4;
    char* sST = smc + 24576; char* sVT = smc + 26624; char* sVS = smc + 28672; float* sG = (float*)(smc + 30720);
    const lds_cptr lds = (lds_cptr)smc;
    const int lkey = t >> 3, lc = t & 7;
    for (int cu = bid; cu < 2 * NB * 4 * 4; cu += nb) {
        const int chain = cu >> 2, cb = cu & 3;
        const ChunkInfo c0 = chunkinfo(chain * NCH);
        const int hd = c0.hd;
        auto issue = [&](ScanRegs& Rg, int n) {
            const int unit = chain * NCH + n;
            const ChunkInfo c = chunkinfo(unit);
            const bf16* wsrc = p.cW + (size_t)unit * 4096 + (16 * w + fr) * 64 + 8 * fg;
#pragma unroll
            for (int s_ = 0; s_ < 2; ++s_) {
                Rg.W[s_] = *(const i32x4_t*)(wsrc + 32 * s_);
                Rg.k[s_] = *(const i32x4_t*)(p.gq + (size_t)chunk_row(c, lkey + 32 * s_) * 768 + 256 + hd * 64 + lc * 8);
            }
#pragma unroll
            for (int r = 0; r < 4; ++r) Rg.u[r] = p.cU[(size_t)unit * 4096 + (16 * w + 4 * fg + r) * 64 + cb * 16 + fr];
            Rg.g = p.cG[(size_t)unit * 192 + (t < 192 ? t : 191)];
        };
        auto put_k = [&](const ScanRegs& Rg, int buf) {
#pragma unroll
            for (int s_ = 0; s_ < 2; ++s_) {
                const int ci = lkey + 32 * s_;
                const int fsw = ((ci >> 1) & 1) | (((ci >> 3) & 1) << 1);
                *(i32x4_t*)(smc + buf * 8192 + ci * 128 + (((((lc >> 1) ^ fsw) << 1) | (lc & 1)) << 4)) = Rg.k[s_];
            }
            if (t < 192) sG[buf * 192 + t] = Rg.g;
        };
        const int xe = (t >> 3) & 15, xc = (t & 7) ^ (xe & 7);
        const unsigned xsrc = xe * 128 + ((t & 7) << 4);
        const size_t xdst = (size_t)(cb * 16 + xe) * 64 + xc * 8;
        const unsigned c0o = ((fg) ^ (fr & 7)) << 4, c1o = ((4 + fg) ^ (fr & 7)) << 4;
        const unsigned bo0 = fr * 128 + c0o, bo1 = fr * 128 + c1o;
        const unsigned wofs = fr * 128 + ((((2 * w + (fg >> 1)) ^ (fr & 7))) << 4) + (fg & 1) * 8;
        unsigned ka[2][2];
#pragma unroll
        for (int s_ = 0; s_ < 2; ++s_)
#pragma unroll
            for (int h2 = 0; h2 < 2; ++h2) {
                const int cr = 32 * s_ + 8 * fg + (fr >> 2) + 4 * h2;
                const int fsw = ((cr >> 1) & 1) | (((cr >> 3) & 1) << 1);
                ka[s_][h2] = cr * 128 + (((((w ^ fsw) << 1) | ((fr & 3) >> 1))) << 4) + (fr & 1) * 8;
            }
        f32x4_t S = f32x4_t{0.f, 0.f, 0.f, 0.f};
        ScanRegs R0, R1, R2;
        __syncthreads();
        issue(R0, 0); issue(R1, 1);
        ((unsigned*)sST)[t] = 0u; ((unsigned*)sST)[t + 256] = 0u;
        put_k(R0, 0);
        __syncthreads();
#define SCAN_STEP(Rc, Rn, Rnn, nn, b)                                                                                                        \
        {                                                                                                                                    \
            const int n_ = (nn);                                                                                                             \
            issue(Rnn, (n_ + 2 < NCH) ? n_ + 2 : NCH - 1);                  \
            const float* g = sG + (b) * 192;                                                                                                 \
            const f32x4_t eD = *(const f32x4_t*)(g + 64 + 16 * w + 4 * fg);                                                                  \
            const float e63 = g[128];                                                                                                        \
            const bf16x8_t st0 = *(const bf16x8_t*)(sST + bo0), st1 = *(const bf16x8_t*)(sST + bo1);                                         \
            if (t < 128) *(uint4*)(scan_sp(p) + (size_t)(chain * NCH + n_) * 4096 + xdst) = *(const uint4*)(sST + xsrc);                     \
            f32x4_t v = __builtin_amdgcn_mfma_f32_16x16x32_bf16(__builtin_bit_cast(bf16x8_t, Rc.W[0]), st0, f32x4_t{0.f, 0.f, 0.f, 0.f}, 0, 0, 0); \
            v = __builtin_amdgcn_mfma_f32_16x16x32_bf16(__builtin_bit_cast(bf16x8_t, Rc.W[1]), st1, v, 0, 0, 0);                              \
            float vn[4];                                                                                                                     \
            _Pragma("unroll") for (int r = 0; r < 4; ++r) vn[r] = __uint_as_float(Rc.u[r] << 16) - v[r];                                     \
            { uint2 pk; pk.x = cvtpk(vn[0], vn[1]); pk.y = cvtpk(vn[2], vn[3]); *(uint2*)(sVT + wofs) = pk; }                                \
            { uint2 pk; pk.x = cvtpk(vn[0] * eD[0], vn[1] * eD[1]); pk.y = cvtpk(vn[2] * eD[2], vn[3] * eD[3]); *(uint2*)(sVS + wofs) = pk; }  \
            put_k(Rn, ((b) + 1) % 3);                                                                                                        \
            __syncthreads();                                                                                                                 \
            if (t >= 128) *(uint4*)(scan_vn(p) + (size_t)(chain * NCH + n_) * 4096 + xdst) = *(const uint4*)(sVT + xsrc);                    \
            const bf16x8_t vs0 = *(const bf16x8_t*)(sVS + bo0), vs1 = *(const bf16x8_t*)(sVS + bo1);                                         \
            const lds_cptr kb = lds + (b) * 8192;                                                                                            \
            const s16x4_t a00 = lds_tr16(kb + ka[0][0]), a01 = lds_tr16(kb + ka[0][1]);                                                      \
            const s16x4_t a10 = lds_tr16(kb + ka[1][0]), a11 = lds_tr16(kb + ka[1][1]);                                                      \
            f32x4_t dS = __builtin_amdgcn_mfma_f32_16x16x32_bf16(bf16x8_t{a00[0], a00[1], a00[2], a00[3], a01[0], a01[1], a01[2], a01[3]}, vs0, f32x4_t{0.f, 0.f, 0.f, 0.f}, 0, 0, 0); \
            dS = __builtin_amdgcn_mfma_f32_16x16x32_bf16(bf16x8_t{a10[0], a10[1], a10[2], a10[3], a11[0], a11[1], a11[2], a11[3]}, vs1, dS, 0, 0, 0); \
            _Pragma("unroll") for (int r = 0; r < 4; ++r) S[r] = S[r] * e63 + dS[r];                                                         \
            { uint2 pk; pk.x = cvtpk(S[0], S[1]); pk.y = cvtpk(S[2], S[3]); *(uint2*)(sST + wofs) = pk; }                                    \
            __syncthreads();                                                                                                                 \
        }
#pragma unroll 1
        for (int n = 0; n < NCH; n += 3) {
            SCAN_STEP(R0, R1, R2, n, 0)
            SCAN_STEP(R1, R2, R0, n + 1, 1)
            SCAN_STEP(R2, R0, R1, n + 2, 2)
        }
#undef SCAN_STEP
    }
}
HD void ph_gdn_outfin(const Params& p, int l, int bid, int nb, float* smf) {
    const int t = tid_(), lane = t & 63, w = t >> 6, fr = lane & 15, fg = lane >> 4;
    const float* og = p.in[I_ONORM] + l * 64;
    const int nlat = NB * 4 * NCL, nctx = (l == 0) ? NB * 4 * NCC : 0;
    float* so = smf;
    for (int u = bid; u < nlat + nctx; u += nb) {
        int b, hd, seg, nloc, ncs, T, base;
        if (u < nlat) { nloc = u % NCL; const int bh = u / NCL; hd = bh & 3; b = bh >> 2; seg = 0; ncs = NCL; T = SEQ; base = b * SEQ; }
        else { const int u2 = u - nlat; nloc = u2 % NCC; const int bh = u2 / NCC; hd = bh & 3; b = bh >> 2; seg = 1; ncs = NCC; T = CTXL; base = NLAT + b * CTXL; }
        __syncthreads();
#pragma unroll
        for (int dir = 0; dir < 2; ++dir) {
            const int nl = dir ? (ncs - 1 - nloc) : nloc;
            const int unit = ((dir * NB + b) * 4 + hd) * NCH + (seg ? nl : NCC + nl);
            const int ci = 16 * w + fr;
            const int pf = nl * 64 + ci; const int arow_ = base + (dir ? (T - 1 - pf) : pf);
            bf16x8_t qa[2], ka_[2];
#pragma unroll
            for (int s_ = 0; s_ < 2; ++s_) {
                qa[s_] = *(const bf16x8_t*)(p.gq + (size_t)arow_ * 768 + hd * 64 + 32 * s_ + 8 * fg);
                ka_[s_] = *(const bf16x8_t*)(p.cQK + (size_t)unit * 4096 + ci * 64 + 32 * s_ + 8 * fg);
            }
            const f32x4_t eG = *(const f32x4_t*)(p.cG + (size_t)unit * 192 + 16 * w + 4 * fg);
#pragma unroll
            for (int j = 0; j < 4; ++j) {
                const bf16* spr = scan_sp(p) + (size_t)unit * 4096 + (16 * j + fr) * 64 + 8 * fg;
                const bf16* vnr = scan_vn(p) + (size_t)unit * 4096 + (16 * j + fr) * 64 + 8 * fg;
                f32x4_t o1 = __builtin_amdgcn_mfma_f32_16x16x32_bf16(qa[0], *(const bf16x8_t*)(spr), f32x4_t{0.f, 0.f, 0.f, 0.f}, 0, 0, 0);
                o1 = __builtin_amdgcn_mfma_f32_16x16x32_bf16(qa[1], *(const bf16x8_t*)(spr + 32), o1, 0, 0, 0);
                f32x4_t o2 = __builtin_amdgcn_mfma_f32_16x16x32_bf16(ka_[0], *(const bf16x8_t*)(vnr), f32x4_t{0.f, 0.f, 0.f, 0.f}, 0, 0, 0);
                o2 = __builtin_amdgcn_mfma_f32_16x16x32_bf16(ka_[1], *(const bf16x8_t*)(vnr + 32), o2, 0, 0, 0);
#pragma unroll
                for (int r = 0; r < 4; ++r) {
                    const int cpos = 16 * w + 4 * fg + r;
                    const int tok = dir ? (63 - cpos) : cpos;
                    float* dst = so + tok * 65 + 16 * j + fr;
                    const float val = eG[r] * o1[r] + o2[r];
                    if (dir == 0) *dst = val; else *dst += val;
                }
            }
            __syncthreads();
        }
        {
            const int tok = t >> 2, q4 = t & 3;
            const int row = base + nloc * 64 + tok;
            float v[16]; float ss = 0.f;
#pragma unroll
            for (int c = 0; c < 16; ++c) { v[c] = so[tok * 65 + q4 * 16 + c]; ss += v[c] * v[c]; }
            ss += __shfl_xor(ss, 1); ss += __shfl_xor(ss, 2);
            const float rs = 1.0f / sqrtf(ss / 64.0f + 1e-6f);
            const uint4 z0 = *(const uint4*)(p.P + (size_t)row * PLD + C_Z + hd * 64 + q4 * 16), z1 = *(const uint4*)(p.P + (size_t)row * PLD + C_Z + hd * 64 + q4 * 16 + 8);
            const unsigned zz[8] = {z0.x, z0.y, z0.z, z0.w, z1.x, z1.y, z1.z, z1.w};
            unsigned pk[8];
#pragma unroll
            for (int c2 = 0; c2 < 8; ++c2) {
                const float za = __uint_as_float(zz[c2] << 16), zb = __uint_as_float(zz[c2] & 0xffff0000u);
                const float oa = v[2 * c2] * rs * og[q4 * 16 + 2 * c2] * siluf_(za), ob = v[2 * c2 + 1] * rs * og[q4 * 16 + 2 * c2 + 1] * siluf_(zb);
                pk[c2] = cvtpk(oa, ob);
            }
            uint4 p0, p1; p0.x = pk[0]; p0.y = pk[1]; p0.z = pk[2]; p0.w = pk[3]; p1.x = pk[4]; p1.y = pk[5]; p1.z = pk[6]; p1.w = pk[7];
            bf16* dstb = p.br + (size_t)row * D + 512 + hd * 64 + q4 * 16;
            *(uint4*)dstb = p0; *(uint4*)(dstb + 8) = p1;
        }
    }
}
#else
HD void ph_gdn_scan(const Params& p, int l, int bid, int nb, float* sm) {
    float* sQ = sm;
    float* sK = sm + 4096;
    bf16* sW = (bf16*)(sm + 8192);
    bf16* sQK = (bf16*)(sm + 10240);
    float* sS = sm + 12288;
    float* sV = sm + 13312;
    float* sU = sm + 14336;
    float* sG = sm + 15360;
    const int RQ = (l == 0) ? R : NLAT;
    for (int cu = bid; cu < 2 * NB * 4 * 4; cu += nb) {
        int chain = cu >> 2, cb = cu & 3;
        THREADS(t, 1024) { sS[t] = 0.f; }
        SYNC
        for (int n = 0; n < NCH; ++n) {
            int unit = chain * NCH + n;
            ChunkInfo c = chunkinfo(unit);
            THREADS(t, 64) { sG[t] = p.cG[(size_t)unit * 64 + t]; }
            SYNC
            THREADS(t, 4096) {
                int i = t >> 6, d = t & 63; int row = chunk_row(c, i);
                sW[t] = p.cW[(size_t)unit * 4096 + t];
                sQK[t] = p.cQK[(size_t)unit * 4096 + t];
                sQ[t] = bf2f(p.gq[(size_t)row * 768 + c.hd * 64 + d]) * expf(sG[i]);
                sK[t] = bf2f(p.gq[(size_t)row * 768 + 256 + c.hd * 64 + d]) * expf(sG[63] - sG[i]);
            }
            THREADS(t, 1024) { int i = t >> 4, e = t & 15; sU[t] = bf2f(p.cU[(size_t)unit * 4096 + i * 64 + cb * 16 + e]); }
            SYNC
            THREADS(t, 1024) {
                int i = t >> 4, e = t & 15;
                float acc = sU[t];
                for (int d = 0; d < 64; ++d) acc -= bf2f(sW[i * 64 + d]) * sS[d * 16 + e];
                sV[t] = acc;
            }
            SYNC
            THREADS(t, 1024) {
                int i = t >> 4, e = t & 15;
                float acc = 0.f;
                for (int d = 0; d < 64; ++d) acc += sQ[i * 64 + d] * sS[d * 16 + e];
                for (int j = 0; j < 64; ++j) acc += bf2f(sQK[i * 64 + j]) * sV[j * 16 + e];
                int row = chunk_row(c, i);
                if (row < RQ) p.odir[((size_t)c.dir * R + row) * 256 + c.hd * 64 + cb * 16 + e] = f2bf(acc);
            }
            SYNC
            THREADS(t, 1024) {
                int d = t >> 4, e = t & 15;
                float acc = sS[t] * expf(sG[63]);
                for (int i = 0; i < 64; ++i) acc += sK[i * 64 + d] * sV[i * 16 + e];
                sS[t] = acc;
            }
            SYNC
        }
    }
}

#endif

#ifndef CPU_EMU
HD void ph_gdn_fin(const Params& p, int l, int bid, int nb) {
    const int RQ = (l == 0) ? R : NLAT;
    const float* og = p.in[I_ONORM] + l * 64;
    const int N = RQ * 32;
    for (int idx = bid * 256 + tid_(); idx < N; idx += nb * 256) {
        const int r = idx >> 5, q = idx & 31; const int hd = q >> 3, cg = q & 7;
        const uint4 a0 = *(const uint4*)(p.odir + (size_t)r * 256 + hd * 64 + cg * 8);
        const uint4 a1 = *(const uint4*)(p.odir + ((size_t)R + r) * 256 + hd * 64 + cg * 8);
        const uint4 zz = *(const uint4*)(p.P + (size_t)r * PLD + C_Z + hd * 64 + cg * 8);
        float v[8], z[8];
        v[0] = __uint_as_float(a0.x << 16) + __uint_as_float(a1.x << 16); v[1] = __uint_as_float(a0.x & 0xffff0000u) + __uint_as_float(a1.x & 0xffff0000u);
        v[2] = __uint_as_float(a0.y << 16) + __uint_as_float(a1.y << 16); v[3] = __uint_as_float(a0.y & 0xffff0000u) + __uint_as_float(a1.y & 0xffff0000u);
        v[4] = __uint_as_float(a0.z << 16) + __uint_as_float(a1.z << 16); v[5] = __uint_as_float(a0.z & 0xffff0000u) + __uint_as_float(a1.z & 0xffff0000u);
        v[6] = __uint_as_float(a0.w << 16) + __uint_as_float(a1.w << 16); v[7] = __uint_as_float(a0.w & 0xffff0000u) + __uint_as_float(a1.w & 0xffff0000u);
        z[0] = __uint_as_float(zz.x << 16); z[1] = __uint_as_float(zz.x & 0xffff0000u); z[2] = __uint_as_float(zz.y << 16); z[3] = __uint_as_float(zz.y & 0xffff0000u);
        z[4] = __uint_as_float(zz.z << 16); z[5] = __uint_as_float(zz.z & 0xffff0000u); z[6] = __uint_as_float(zz.w << 16); z[7] = __uint_as_float(zz.w & 0xffff0000u);
        float ss = 0.f;
#pragma unroll
        for (int c = 0; c < 8; ++c) ss += v[c] * v[c];
        ss += __shfl_xor(ss, 1); ss += __shfl_xor(ss, 2); ss += __shfl_xor(ss, 4);
        const float rs = 1.0f / sqrtf(ss / 64.0f + 1e-6f);
        float o[8];
#pragma unroll
        for (int c = 0; c < 8; ++c) o[c] = v[c] * rs * og[cg * 8 + c] * siluf_(z[c]);
        uint4 pk; pk.x = cvtpk(o[0], o[1]); pk.y = cvtpk(o[2], o[3]); pk.z = cvtpk(o[4], o[5]); pk.w = cvtpk(o[6], o[7]);
        *(uint4*)(p.br + (size_t)r * D + 512 + hd * 64 + cg * 8) = pk;
    }
}
#else
HD void ph_gdn_fin(const Params& p, int l, int bid, int nb) {
    const int RQ = (l == 0) ? R : NLAT;
    const float* og = p.in[I_ONORM] + l * 64;
    const int N = RQ * 4;
    for (int u = bid; u < (N + 255) / 256; u += nb) {
        THREADS(t, 256) {
            int idx = u * 256 + t;
            if (idx < N) {
                int r = idx >> 2, hd = idx & 3;
                const bf16* o0 = p.odir + (size_t)r * 256 + hd * 64;
                const bf16* o1 = p.odir + ((size_t)R + r) * 256 + hd * 64;
                float ss = 0.f;
                for (int d = 0; d < 64; ++d) { float v = bf2f(o0[d]) + bf2f(o1[d]); ss += v * v; }
                float rs = 1.0f / sqrtf(ss / 64.0f + 1e-6f);
                for (int d = 0; d < 64; ++d) {
                    float v = (bf2f(o0[d]) + bf2f(o1[d])) * rs * og[d];
                    float z = bf2f(p.P[(size_t)r * PLD + C_Z + hd * 64 + d]);
                    p.br[(size_t)r * D + 512 + hd * 64 + d] = f2bf(v * siluf_(z));
                }
            }
        }
    }
}

#endif

#ifndef CPU_EMU
HD void ph_merge(const Params& p, int l, int bid, int nb, char* smc) {
    const int MT = ((l == 0) ? R : NLAT) / 128;
    const bf16* Wg = p.wt_in + (size_t)l * WIN_NP * D + (size_t)PLD * D;
    const bf16* Wb = p.wt_br + (size_t)l * 4 * D * 256;
    for (int tile = bid; tile < MT * 8; tile += nb) {
        const int mt = tile >> 3, nt = tile & 7;
        AccT<4> accM; acc_zero(accM);
#pragma unroll 1
        for (int i = 0; i < 4; ++i) {
            AccT<4> acc; acc_zero(acc);
            gemm_accum8<4>(acc, [&](int r) { return (const unsigned char*)h8_of(p) + (size_t)(mt * 128 + r) * D; },
                           [&](int j) { return (const unsigned char*)Wg + (size_t)(i * 1024 + nt * 128 + j) * D; }, D, smc, SC_H, SC_W);
            unsigned sg[4][4][2];
#pragma unroll
            for (int a_ = 0; a_ < 4; ++a_)
#pragma unroll
                for (int b_ = 0; b_ < 4; ++b_) {
                    float e[4];
#pragma unroll
                    for (int r = 0; r < 4; ++r) e[r] = __builtin_amdgcn_rcpf(1.0f + __expf(-acc.v[a_][b_][r]));
                    sg[a_][b_][0] = cvtpk(e[0], e[1]); sg[a_][b_][1] = cvtpk(e[2], e[3]);
                }
            acc_zero(acc);
            gemm_accum<4>(acc, [&](int r) { return p.br + (size_t)(mt * 128 + r) * D + i * 256; },
                          [&](int j) { return Wb + ((size_t)i * D + nt * 128 + j) * 256; }, 256, smc);
#pragma unroll
            for (int a_ = 0; a_ < 4; ++a_)
#pragma unroll
                for (int b_ = 0; b_ < 4; ++b_) {
                    accM.v[a_][b_][0] += __uint_as_float(sg[a_][b_][0] << 16) * acc.v[a_][b_][0];
                    accM.v[a_][b_][1] += __uint_as_float(sg[a_][b_][0] & 0xffff0000u) * acc.v[a_][b_][1];
                    accM.v[a_][b_][2] += __uint_as_float(sg[a_][b_][1] << 16) * acc.v[a_][b_][2];
                    accM.v[a_][b_][3] += __uint_as_float(sg[a_][b_][1] & 0xffff0000u) * acc.v[a_][b_][3];
                }
        }
        float* tl = (float*)smc;
        acc_to_lds<4>(accM, tl);
        __syncthreads();
        const int t_ = tid_(); const int row = t_ >> 1, half = t_ & 1;
        bf16* dst = p.mg + (size_t)(mt * 128 + row) * D + nt * 128 + half * 64;
#pragma unroll
        for (int q = 0; q < 8; ++q) {
            const f32x4_t a = *(const f32x4_t*)(tl + row * 132 + half * 64 + q * 8), b = *(const f32x4_t*)(tl + row * 132 + half * 64 + q * 8 + 4);
            uint4 pk; pk.x = cvtpk(a[0], a[1]); pk.y = cvtpk(a[2], a[3]); pk.z = cvtpk(b[0], b[1]); pk.w = cvtpk(b[2], b[3]);
            *(uint4*)(dst + q * 8) = pk;
        }
    }
}
#else
HD void ph_merge(const Params& p, int l, int bid, int nb, char* smc) {
    const int MT = ((l == 0) ? R : NLAT) / 128;
    const bf16* Wg = p.wt_in + (size_t)l * WIN_NP * D + (size_t)PLD * D;
    const bf16* Wb = p.wt_br + (size_t)l * 4 * D * 256;
    for (int tile = bid; tile < MT * 16; tile += nb) {
        const int mt = tile >> 4, nt = tile & 15;
        ACC_DECL(2, accM); acc_zero(accM);
        for (int i = 0; i < 4; ++i) {
            ACC_DECL(2, accG); acc_zero(accG);
            ACC_DECL(2, accP); acc_zero(accP);
            gemm_accum<2>(accG, [&](int r) { return p.h + (size_t)(mt * 128 + r) * D; },
                          [&](int j) { return Wg + (size_t)(i * 1024 + nt * 64 + j) * D; }, D, smc);
            gemm_accum<2>(accP, [&](int r) { return p.br + (size_t)(mt * 128 + r) * D + i * 256; },
                          [&](int j) { return Wb + ((size_t)i * D + nt * 64 + j) * 256; }, 256, smc);
            ACC_FOR(2, row, col) { AV(accM) += sigmoidf_(AV(accG)) * AV(accP); } ACC_END
        }
#ifndef CPU_EMU
        {
            float* tl = (float*)smc;
            acc_to_lds<2>(accM, tl);
            __syncthreads();
            const int t_ = tid_(); const int row = t_ >> 1, half = t_ & 1;
            bf16* dst = p.mg + (size_t)(mt * 128 + row) * D + nt * 64 + half * 32;
#pragma unroll
            for (int q = 0; q < 4; ++q) {
                const f32x4_t a = *(const f32x4_t*)(tl + row * 68 + half * 32 + q * 8), b = *(const f32x4_t*)(tl + row * 68 + half * 32 + q * 8 + 4);
                uint4 pk; pk.x = cvtpk(a[0], a[1]); pk.y = cvtpk(a[2], a[3]); pk.z = cvtpk(b[0], b[1]); pk.w = cvtpk(b[2], b[3]);
                *(uint4*)(dst + q * 8) = pk;
            }
        }
#else
        ACC_FOR(2, row, col) { p.mg[(size_t)(mt * 128 + row) * D + nt * 64 + col] = f2bf(AV(accM)); } ACC_END
#endif
    }
}

#endif

template <int DRY> HD void ph_outproj_t(const Params& p, int l, int bid, int nb, char* smc) {
    const int MT = ((l == 0) ? R : NLAT) / 128;
    const bf16* Wt = p.wt_out + (size_t)l * D * D;
    for (int tile = bid; tile < MT * 8; tile += nb) {
        const int mt = tile >> 3, nt = tile & 7;
        ACC_DECL(4, acc); acc_zero(acc);
        gemm_accum<4>(acc, [&](int r) { return p.mg + (size_t)(mt * 128 + r) * D; }, [&](int j) { return Wt + (size_t)(nt * 128 + j) * D; }, D, smc);
#ifndef CPU_EMU
        {
            float* tl = (float*)smc;
            acc_to_lds<4>(acc, tl);
            __syncthreads();
            const int t_ = tid_(); const int row = t_ >> 1, half = t_ & 1;
            const int r = mt * 128 + row, c0 = nt * 128 + half * 64;
            const float* xi = xrow_in(p, l, r) + c0; float* xo = (DRY ? ((float*)p.Y + (size_t)r * D) : xrow_out(p, r)) + c0; const float* gm = modrow(p, l, r) + 2048 + c0;
#pragma unroll
            for (int q = 0; q < 16; ++q) {
                const f32x4_t a = *(const f32x4_t*)(tl + row * 132 + half * 64 + q * 4), xv = *(const f32x4_t*)(xi + q * 4), gv = *(const f32x4_t*)(gm + q * 4);
                f32x4_t o; o[0] = xv[0] + gv[0] * a[0]; o[1] = xv[1] + gv[1] * a[1]; o[2] = xv[2] + gv[2] * a[2]; o[3] = xv[3] + gv[3] * a[3];
                *(f32x4_t*)(xo + q * 4) = o;
            }
        }
#else
        ACC_FOR(4, row, col) {
            const int r = mt * 128 + row, c = nt * 128 + col;
            xrow_out(p, r)[c] = xrow_in(p, l, r)[c] + modrow(p, l, r)[2048 + c] * AV(acc);
        } ACC_END
#endif
    }
}

HD void ph_outproj(const Params& p, int l, int bid, int nb, char* smc) { ph_outproj_t<0>(p, l, bid, nb, smc); }
#ifndef CPU_EMU
template <int DRY> HD void ph_router_t(const Params& p, int l, int bid, int nb, float* smf) {
    char* smc = (char*)smf;
    const int t = tid_(), lane = t & 63, w = t >> 6, fr = lane & 15, fg = lane >> 4;
    const int RQ = (l == 0) ? R : NLAT;
    const float* gN = p.in[I_N2G] + l * D;
    constexpr int WST = 2080;
    float* lgw = (float*)(smc + 66560) + w * (16 * 17);
    int* lcnt = (int*)(smc + 70912); int* gbase = (int*)(smc + 70976);
    __syncthreads();
    for (int k = t; k < 1024; k += 256) {
        const float* wrow = p.in[I_WROUTER] + k * 16;
#pragma unroll
        for (int e = 0; e < 16; ++e) {
            const float v = wrow[e]; const bf16 hi = f2bf(v);
            *(bf16*)(smc + e * WST + k * 2) = hi; *(bf16*)(smc + 33280 + e * WST + k * 2) = f2bf(v - bf2f(hi));
        }
    }
    const int ngroups = RQ / 16;
    for (int g0 = bid * 4; g0 < ngroups; g0 += nb * 4) {
        __syncthreads();
        if (t < 16) lcnt[t] = 0;
        __syncthreads();
        const int gidx = g0 + w;
        const bool active = gidx < ngroups;
        int e1 = 0, e2 = 0, q1 = 0, q2 = 0; const int rsel = gidx * 16 + lane;
        if (active) {
            const int r = gidx * 16 + fr;
            const float* x = xrow_out(p, r);
            const float* m = modrow(p, l, r);
            float ss = 0.f;
#pragma unroll 4
            for (int s_ = 0; s_ < 32; ++s_) {
                const f32x4_t a = *(const f32x4_t*)(x + s_ * 32 + fg * 8), b = *(const f32x4_t*)(x + s_ * 32 + fg * 8 + 4);
                ss += a[0] * a[0] + a[1] * a[1] + a[2] * a[2] + a[3] * a[3] + b[0] * b[0] + b[1] * b[1] + b[2] * b[2] + b[3] * b[3];
            }
            ss += __shfl_xor(ss, 16); ss += __shfl_xor(ss, 32);
            const float rs = 1.0f / sqrtf(ss / D + 1e-6f);
            f32x4_t acc = f32x4_t{0.f, 0.f, 0.f, 0.f};
#pragma unroll 2
            for (int s_ = 0; s_ < 32; ++s_) {
                const int k0 = s_ * 32 + fg * 8;
                float hv[8];
#pragma unroll
                for (int hh = 0; hh < 2; ++hh) {
                    const f32x4_t xv = *(const f32x4_t*)(x + k0 + hh * 4), gv = *(const f32x4_t*)(gN + k0 + hh * 4);
                    const f32x4_t sc = *(const f32x4_t*)(m + 4096 + k0 + hh * 4), sh = *(const f32x4_t*)(m + 3072 + k0 + hh * 4);
#pragma unroll
                    for (int q = 0; q < 4; ++q) hv[hh * 4 + q] = xv[q] * rs * gv[q] * (1.0f + sc[q]) + sh[q];
                }
                unsigned hi[4], lo[4];
#pragma unroll
                for (int q = 0; q < 4; ++q) {
                    hi[q] = cvtpk(hv[2 * q], hv[2 * q + 1]);
                    lo[q] = cvtpk(hv[2 * q] - __uint_as_float(hi[q] << 16), hv[2 * q + 1] - __uint_as_float(hi[q] & 0xffff0000u));
                }
                const i32x4_t hiv = i32x4_t{(int)hi[0], (int)hi[1], (int)hi[2], (int)hi[3]}, lov = i32x4_t{(int)lo[0], (int)lo[1], (int)lo[2], (int)lo[3]};
                { uint2 q8; q8.x = pack_fp8x4(hv[0] * 4.f, hv[1] * 4.f, hv[2] * 4.f, hv[3] * 4.f); q8.y = pack_fp8x4(hv[4] * 4.f, hv[5] * 4.f, hv[6] * 4.f, hv[7] * 4.f);
                  *(uint2*)(h8_of(p) + (size_t)r * D + k0) = q8; }
                const bf16x8_t bh = *(const bf16x8_t*)(smc + fr * WST + s_ * 64 + fg * 16), bl = *(const bf16x8_t*)(smc + 33280 + fr * WST + s_ * 64 + fg * 16);
                acc = __builtin_amdgcn_mfma_f32_16x16x32_bf16(__builtin_bit_cast(bf16x8_t, hiv), bh, acc, 0, 0, 0);
                acc = __builtin_amdgcn_mfma_f32_16x16x32_bf16(__builtin_bit_cast(bf16x8_t, hiv), bl, acc, 0, 0, 0);
                acc = __builtin_amdgcn_mfma_f32_16x16x32_bf16(__builtin_bit_cast(bf16x8_t, lov), bh, acc, 0, 0, 0);
            }
#pragma unroll
            for (int q = 0; q < 4; ++q) lgw[(4 * fg + q) * 17 + fr] = acc[q];
            if (lane < 16) {
                float sc[16], sel[16];
#pragma unroll
                for (int e = 0; e < 16; ++e) { sc[e] = sigmoidf_(lgw[lane * 17 + e]); sel[e] = sc[e] + p.in[I_RBIAS][e]; }
                int best = 0; float bestv = -1e30f;
#pragma unroll
                for (int gph = 0; gph < 4; ++gph) {
                    float t1 = -1e30f, t2 = -1e30f;
#pragma unroll
                    for (int j = 0; j < 4; ++j) { const float v = sel[gph * 4 + j]; if (v > t1) { t2 = t1; t1 = v; } else if (v > t2) t2 = v; }
                    const float gs = t1 + t2;
                    if (gs > bestv) { bestv = gs; best = gph; }
                }
                float v1 = -1e30f, v2 = -1e30f, w1 = 0.f, w2 = 0.f; int i1 = 0, i2 = 0;
#pragma unroll
                for (int e = 0; e < 16; ++e) {
                    if ((e >> 2) == best) {
                        const float v = sel[e];
                        if (v > v1) { v2 = v1; i2 = i1; w2 = w1; v1 = v; i1 = e; w1 = sc[e]; } else if (v > v2) { v2 = v; i2 = e; w2 = sc[e]; }
                    }
                }
                e1 = i1; e2 = i2;
                const float ws_ = w1 + w2;
                p.sel_e[rsel * 2] = i1; p.sel_e[rsel * 2 + 1] = i2;
                p.sel_w[rsel * 2] = w1 / ws_; p.sel_w[rsel * 2 + 1] = w2 / ws_;
                q1 = atomicAdd(&lcnt[i1], 1); q2 = atomicAdd(&lcnt[i2], 1);
            }
        }
        __syncthreads();
        if (t < 16) { const int c = lcnt[t]; gbase[t] = (c && !DRY) ? atomicAdd(&p.cnt[l * 16 + t], c) : 0; }
        __syncthreads();
        if (active && lane < 16 && !DRY) {
            const int p1 = gbase[e1] + q1, p2 = gbase[e2] + q2;
            p.elist[(size_t)e1 * 2 * R + p1] = rsel * 2; p.apos[rsel * 2] = p1;
            p.elist[(size_t)e2 * 2 * R + p2] = rsel * 2 + 1; p.apos[rsel * 2 + 1] = p2;
        }
    }
}
HD void ph_router(const Params& p, int l, int bid, int nb, float* smf) { ph_router_t<0>(p, l, bid, nb, smf); }
#else
HD void ph_router(const Params& p, int l, int bid, int nb, float* sm) {
    const int RQ = (l == 0) ? R : NLAT;
    const float* g = p.in[I_N2G] + l * D;
    const float* wr = p.in[I_WROUTER];
    float* sh = sm + 512;
    float* sl = sm + 2048;
    for (int r = bid; r < RQ; r += nb) {
        const float* x = xrow_out(p, r);
        const float* m = modrow(p, l, r);
        THREADS(t, 256) { float s = 0.f; for (int k = t; k < D; k += 256) s += x[k] * x[k]; sm[t] = s; }
        SYNC
        THREADS(t, 1) { float s = 0.f; for (int i = 0; i < 256; ++i) s += sm[i]; sm[256] = s; }
        SYNC
        THREADS(t, 256) {
            float rs = 1.0f / sqrtf(sm[256] / D + 1e-6f);
            for (int k = t; k < D; k += 256) {
                float v = x[k] * rs * g[k];
                v = v * (1.0f + m[4096 + k]) + m[3072 + k];
                sh[k] = v;
                p.h[(size_t)r * D + k] = f2bf(v);
            }
        }
        SYNC
        THREADS(t, 256) {
            int e = t & 15, ks = t >> 4;
            float acc = 0.f;
            for (int k = ks * 64; k < ks * 64 + 64; ++k) acc += sh[k] * wr[k * 16 + e];
            sl[ks * 16 + e] = acc;
        }
        SYNC
        THREADS(t, 1) {
            float* sc = sm + 2304; float* sel = sm + 2320;
            for (int e = 0; e < 16; ++e) {
                float acc = 0.f;
                for (int ks = 0; ks < 16; ++ks) acc += sl[ks * 16 + e];
                sc[e] = sigmoidf_(acc); sel[e] = sc[e] + p.in[I_RBIAS][e];
            }
            int best = 0; float bestv = -1e30f;
            for (int gph = 0; gph < 4; ++gph) {
                float t1 = -1e30f, t2 = -1e30f;
                for (int j = 0; j < 4; ++j) { float v = sel[gph * 4 + j]; if (v > t1) { t2 = t1; t1 = v; } else if (v > t2) t2 = v; }
                float gs = t1 + t2;
                if (gs > bestv) { bestv = gs; best = gph; }
            }
            int i1 = -1, i2 = -1; float v1 = -1e30f, v2 = -1e30f;
            for (int j = 0; j < 4; ++j) {
                float v = sel[best * 4 + j];
                if (v > v1) { v2 = v1; i2 = i1; v1 = v; i1 = best * 4 + j; } else if (v > v2) { v2 = v; i2 = best * 4 + j; }
            }
            float w1 = sc[i1], w2 = sc[i2], ws = w1 + w2;
            p.sel_e[r * 2] = i1; p.sel_e[r * 2 + 1] = i2;
            p.sel_w[r * 2] = w1 / ws; p.sel_w[r * 2 + 1] = w2 / ws;
            int q1 = ATOMIC_ADD_RET(&p.cnt[l * 16 + i1], 1); p.elist[(size_t)i1 * 2 * R + q1] = r * 2; p.apos[r * 2] = q1;
            int q2 = ATOMIC_ADD_RET(&p.cnt[l * 16 + i2], 1); p.elist[(size_t)i2 * 2 * R + q2] = r * 2 + 1; p.apos[r * 2 + 1] = q2;
        }
        SYNC
    }
}

#endif

struct MoeTiles { int tstart[17]; };
HD MoeTiles moe_tiles(const Params& p, int l) {
    MoeTiles m; int acc = 0;
    for (int e = 0; e < 16; ++e) { m.tstart[e] = acc; acc += (p.cnt[l * 16 + e] + 127) >> 7; }
    m.tstart[16] = acc; return m;
}

HD void ph_ffn1(const Params& p, int l, int bid, int nb, char* smc) {
    int tstart[17];
    { int acc = 0; for (int e = 0; e < 16; ++e) { tstart[e] = acc; acc += (p.cnt[l * 16 + e] + 127) >> 7; } tstart[16] = acc; }
    const int ntiles = tstart[16];
    for (int tile = bid; tile < ntiles * 8; tile += nb) {
        const int rt = tile >> 3, nt = tile & 7;
        int e = 0, ts = 0;
#pragma unroll
        for (int q = 1; q < 16; ++q) if (rt >= tstart[q]) { e = q; ts = tstart[q]; }
        const int mt = rt - ts;
        const int cnt_e = p.cnt[l * 16 + e];
        const int* el = p.elist + (size_t)e * 2 * R;
#ifndef CPU_EMU
        const unsigned char* Wt8 = gu8_of(p) + (size_t)e * 1024 * D;
        AccT<4> acc; acc_zero(acc);
        gemm_accum8<4>(acc, [&](int i) { int q = mt * 128 + i; int a = (q < cnt_e) ? el[q] : el[0]; return (const unsigned char*)h8_of(p) + (size_t)(a >> 1) * D; },
                       [&](int j) { return Wt8 + (size_t)(nt * 128 + j) * D; }, D, smc, SC_H, SC_W);
        {
            float* tl = (float*)smc;
            acc_to_lds<4>(acc, tl);
            __syncthreads();
            const int t_ = tid_(); const int row = t_ >> 1, half = t_ & 1;
            unsigned char* dst = (unsigned char*)p.act + (size_t)(rt * 128 + row) * 512 + nt * 64 + half * 32;
#pragma unroll
            for (int q = 0; q < 2; ++q) {
                float o[16];
#pragma unroll
                for (int c4 = 0; c4 < 4; ++c4) {
                    const f32x4_t gv = *(const f32x4_t*)(tl + row * 132 + half * 64 + q * 32 + c4 * 4), uv = *(const f32x4_t*)(tl + row * 132 + half * 64 + q * 32 + 16 + c4 * 4);
#pragma unroll
                    for (int e_ = 0; e_ < 4; ++e_) o[c4 * 4 + e_] = gv[e_] / (1.0f + __expf(-gv[e_])) * uv[e_] * 16.0f;
                }
                uint4 pk; pk.x = pack_fp8x4(o[0], o[1], o[2], o[3]); pk.y = pack_fp8x4(o[4], o[5], o[6], o[7]);
                pk.z = pack_fp8x4(o[8], o[9], o[10], o[11]); pk.w = pack_fp8x4(o[12], o[13], o[14], o[15]);
                *(uint4*)(dst + q * 16) = pk;
            }
        }
#else
        const bf16* Wt = p.wt_gu + (size_t)e * 1024 * D;
        ACC_DECL(4, acc); acc_zero(acc);
        gemm_accum<4>(acc, [&](int i) { int q = mt * 128 + i; int a = (q < cnt_e) ? el[q] : el[0]; return p.h + (size_t)(a >> 1) * D; },
                      [&](int j) { return Wt + (size_t)(nt * 128 + j) * D; }, D, smc);
        ACC_FOR_PAIR(row, pcol) {
            float gv = AV_G(acc), uv = AV_U(acc);
            p.act[(size_t)(rt * 128 + row) * 512 + nt * 64 + pcol] = f2bf(siluf_(gv) * uv);
        } ACC_END
#endif
    }
}

HD void ph_ffn2(const Params& p, int l, int bid, int nb, char* smc) {
    int tstart[17];
    { int acc = 0; for (int e = 0; e < 16; ++e) { tstart[e] = acc; acc += (p.cnt[l * 16 + e] + 127) >> 7; } tstart[16] = acc; }
    const int ntiles = tstart[16];
    for (int tile = bid; tile < ntiles * 8; tile += nb) {
        const int rt = tile >> 3, nt = tile & 7;
        int e = 0;
#pragma unroll
        for (int q = 1; q < 16; ++q) if (rt >= tstart[q]) e = q;
#ifndef CPU_EMU
        const unsigned char* Wt8 = d8_of(p) + (size_t)e * D * 512;
        AccT<4> acc; acc_zero(acc);
        gemm_accum8<4>(acc, [&](int i) { return (const unsigned char*)p.act + (size_t)(rt * 128 + i) * 512; }, [&](int j) { return Wt8 + (size_t)(nt * 128 + j) * 512; }, 512, smc, SC_ACT, SC_W);
#else
        const bf16* Wt = p.wt_d + (size_t)e * D * 512;
        ACC_DECL(4, acc); acc_zero(acc);
        gemm_accum<4>(acc, [&](int i) { return p.act + (size_t)(rt * 128 + i) * 512; }, [&](int j) { return Wt + (size_t)(nt * 128 + j) * 512; }, 512, smc);
#endif
#ifndef CPU_EMU
        {
            float* tl = (float*)smc;
            acc_to_lds<4>(acc, tl);
            __syncthreads();
            const int t_ = tid_(); const int row = t_ >> 1, half = t_ & 1;
            bf16* dst = p.Y + (size_t)(rt * 128 + row) * D + nt * 128 + half * 64;
#pragma unroll
            for (int q = 0; q < 8; ++q) {
                const f32x4_t a = *(const f32x4_t*)(tl + row * 132 + half * 64 + q * 8), b = *(const f32x4_t*)(tl + row * 132 + half * 64 + q * 8 + 4);
                uint4 pk; pk.x = cvtpk(a[0], a[1]); pk.y = cvtpk(a[2], a[3]); pk.z = cvtpk(b[0], b[1]); pk.w = cvtpk(b[2], b[3]);
                *(uint4*)(dst + q * 8) = pk;
            }
        }
#else
        ACC_FOR(4, row, col) { p.Y[(size_t)(rt * 128 + row) * D + nt * 128 + col] = f2bf(AV(acc)); } ACC_END
#endif
    }
}

#ifndef CPU_EMU
template <int DRY> HD void ph_combine_t(const Params& p, int l, int bid, int nb) {
    const int RQ = (l == 0) ? R : NLAT;
    const int t = tid_(), lane = t & 63, w = t >> 6;
    int tstart[17];
    { int acc = 0;
#pragma unroll
      for (int e = 0; e < 16; ++e) { tstart[e] = acc; acc += (p.cnt[l * 16 + e] + 127) >> 7; } tstart[16] = acc; }
    for (int r = bid * 4 + w; r < RQ; r += nb * 4) {
        float* xo = xrow_out(p, r);
        const float* m = modrow(p, l, r) + 5120;
        const int e0 = p.sel_e[r * 2], e1 = p.sel_e[r * 2 + 1];
        int t0 = 0, t1 = 0;
#pragma unroll
        for (int q = 0; q < 16; ++q) { if (q == e0) t0 = tstart[q]; if (q == e1) t1 = tstart[q]; }
        const bf16* y0 = p.Y + (size_t)(t0 * 128 + p.apos[r * 2]) * D;
        const bf16* y1 = p.Y + (size_t)(t1 * 128 + p.apos[r * 2 + 1]) * D;
        const float w0 = p.sel_w[r * 2], w1 = p.sel_w[r * 2 + 1];
        f32x4_t xs[4]; float ss = 0.f;
#pragma unroll
        for (int j = 0; j < 4; ++j) {
            const int k = j * 256 + lane * 4;
            f32x4_t xv = *(const f32x4_t*)(xo + k);
            const f32x4_t gv = *(const f32x4_t*)(m + k);
            const uint2 a = *(const uint2*)(y0 + k), b = *(const uint2*)(y1 + k);
            xv[0] += gv[0] * (w0 * __uint_as_float(a.x << 16) + w1 * __uint_as_float(b.x << 16));
            xv[1] += gv[1] * (w0 * __uint_as_float(a.x & 0xffff0000u) + w1 * __uint_as_float(b.x & 0xffff0000u));
            xv[2] += gv[2] * (w0 * __uint_as_float(a.y << 16) + w1 * __uint_as_float(b.y << 16));
            xv[3] += gv[3] * (w0 * __uint_as_float(a.y & 0xffff0000u) + w1 * __uint_as_float(b.y & 0xffff0000u));
            *(f32x4_t*)((DRY ? (float*)p.gq + (size_t)r * 64 : xo) + (DRY ? (k & 63) : k)) = xv;
            xs[j] = xv; ss += xv[0] * xv[0] + xv[1] * xv[1] + xv[2] * xv[2] + xv[3] * xv[3];
        }
        if (l == 0 && !DRY) {
            ss = wave_sum(ss);
            const float rs = 1.0f / sqrtf(ss / D + 1e-6f);
            const float* g1 = p.in[I_N1G] + D; const float* m1 = modrow(p, 1, r);
#pragma unroll
            for (int j = 0; j < 4; ++j) {
                const int k = j * 256 + lane * 4;
                const f32x4_t gv = *(const f32x4_t*)(g1 + k), sc = *(const f32x4_t*)(m1 + 1024 + k), sh = *(const f32x4_t*)(m1 + k);
                float o[4];
#pragma unroll
                for (int q = 0; q < 4; ++q) o[q] = xs[j][q] * rs * gv[q] * (1.0f + sc[q]) + sh[q];
                uint2 pk; pk.x = cvtpk(o[0], o[1]); pk.y = cvtpk(o[2], o[3]);
                *(uint2*)(p.h + (size_t)r * D + k) = pk;
                *(unsigned*)(h8_of(p) + (size_t)r * D + k) = pack_fp8x4(o[0] * 4.f, o[1] * 4.f, o[2] * 4.f, o[3] * 4.f);
            }
        }
    }
}
HD void ph_combine(const Params& p, int l, int bid, int nb) { ph_combine_t<0>(p, l, bid, nb); }
#else
HD void ph_combine(const Params& p, int l, int bid, int nb) {
    const int RQ = (l == 0) ? R : NLAT;
    int tstart[17];
    { int acc = 0; for (int e = 0; e < 16; ++e) { tstart[e] = acc; acc += (p.cnt[l * 16 + e] + 127) >> 7; } tstart[16] = acc; }
    for (int r = bid; r < RQ; r += nb) {
        float* xo = xrow_out(p, r);
        const float* m = modrow(p, l, r);
        int e0 = p.sel_e[r * 2], e1 = p.sel_e[r * 2 + 1];
        int t0 = 0, t1 = 0;
#pragma unroll
        for (int q = 0; q < 16; ++q) { if (q == e0) t0 = tstart[q]; if (q == e1) t1 = tstart[q]; }
        const bf16* y0 = p.Y + (size_t)(t0 * 128 + p.apos[r * 2]) * D;
        const bf16* y1 = p.Y + (size_t)(t1 * 128 + p.apos[r * 2 + 1]) * D;
        const float w0 = p.sel_w[r * 2], w1 = p.sel_w[r * 2 + 1];
        THREADS(t, 256) {
            for (int k = t; k < D; k += 256) xo[k] += m[5120 + k] * (w0 * bf2f(y0[k]) + w1 * bf2f(y1[k]));
        }
    }
}

#endif

constexpr int NPHASE_LAYER = 14;
HD void run_phase(const Params& p, int ph, int l, int bid, int nb, float* sm) {
    switch (ph) {
        case 0: ph_norm1(p, l, bid, nb, sm); break;
        case 1: ph_inproj(p, l, bid, nb, (char*)sm); break;
        case 2: ph_prep(p, l, bid, nb); if (FOURIER_GEMM) ph_fourier_s1(p, bid, nb, (char*)sm); break;
        case 3: ph_na(p, l, bid, nb, (char*)sm); break;
        case 4: ph_da(p, l, bid, nb, (char*)sm); break;
        case 5: ph_gdn_chunk(p, l, bid, nb, sm); break;
        case 6: ph_fourier2(p, l, bid, nb); if (FOURIER_GEMM) ph_fourier_sA(p, bid, nb, (char*)sm); break;
        case 7: {
            ph_gdn_scan(p, l, bid, nb, sm);
            const bool split = nb == 512;
            const bool skip = split && (bid < 64 || (bid >= 256 && bid < 320));
            if (!skip) {
                const int b2 = split ? (bid < 256 ? bid - 64 : bid - 128) : bid, n2 = split ? nb - 128 : nb;
                if (FOURIER_GEMM) ph_fourier_sB(p, b2, n2, (char*)sm);
                if (l == 0) convert_static(p, b2, n2, sm, 1);
                convert_moe(p, l, b2, n2, sm);
#ifndef CPU_EMU
                ph_na(p, l, b2, n2, (char*)sm);
#endif
            }
        } break;
#ifndef CPU_EMU
        case 8: ph_gdn_outfin(p, l, bid, nb, sm); break;
#else
        case 8: ph_gdn_fin(p, l, bid, nb); break;
#endif
        case 9: ph_merge(p, l, bid, nb, (char*)sm); break;
        case 10: ph_outproj(p, l, bid, nb, (char*)sm); break;
        case 11: ph_router(p, l, bid, nb, sm); break;
        case 12: ph_ffn1(p, l, bid, nb, (char*)sm); break;
        case 13: ph_ffn2(p, l, bid, nb, (char*)sm); break;
        case 14: ph_combine(p, l, bid, nb); break;
#ifndef CPU_EMU
        case 70: ph_gdn_scan(p, l, bid, nb, sm); break;
        case 71: if (bid >= 64) { if (FOURIER_GEMM) ph_fourier_sB(p, bid - 64, nb - 64, (char*)sm); if (l == 0) convert_static(p, bid - 64, nb - 64, sm, 1); convert_moe(p, l, bid - 64, nb - 64, sm); } break;
        case 110: ph_outproj_t<1>(p, l, bid, nb, (char*)sm); break;
        case 111: ph_router_t<1>(p, l, bid, nb, sm); break;
        case 114: ph_combine_t<1>(p, l, bid, nb); break;
#endif
        default: break;
    }
}

struct WsLayout { size_t ropeT, bar, fa2, fW1, fWA, fWB, mods, cosT, sinT, cs, gg, gbeta, sel_e, sel_w, cnt, elist, apos, cG, wt_in, wt_br, wt_out, wt_gu, wt_d,
                  h, P, gq, fcs, cU, cW, cQK, odir, br, mg, act, Y, total; };
inline WsLayout ws_layout() {
    WsLayout w; size_t o = 0;
    auto take = [&](size_t bytes) { size_t r = o; o += (bytes + 255) & ~(size_t)255; return r; };
    w.bar = take(3456 * 4); w.ropeT = take(128 * 8 * 2 * 4);
    w.mods = take(2 * 3 * 6144 * 4); w.cosT = take(SEQ * 4); w.sinT = take(SEQ * 4); w.cs = take((size_t)NCTX * D * 4);
    w.gg = take((size_t)8 * R * 4); w.gbeta = take((size_t)8 * R * 4); w.sel_e = take((size_t)R * 2 * 4); w.sel_w = take((size_t)R * 2 * 4);
    w.cnt = take(32 * 4); w.elist = take((size_t)16 * 2 * R * 4); w.apos = take((size_t)2 * R * 4); w.cG = take((size_t)NUNIT * 192 * 4);
    w.wt_in = take((size_t)2 * WIN_NP * D * 2); w.wt_br = take((size_t)2 * 4 * D * 256 * 2); w.wt_out = take((size_t)2 * D * D * 2);
    w.wt_gu = take((size_t)16 * 1024 * D * 2); w.wt_d = take((size_t)16 * D * 512 * 2);
    w.h = take((size_t)R * D * 2);
    w.fa2 = take((size_t)NB * 128 * 256 * 2 * 64 * 2); w.fW1 = take(8192 * 2); w.fWA = take(65536 * 2); w.fWB = take(8192 * 2);
    {
        const size_t szP = ((size_t)R * PLD * 2 + 255) & ~(size_t)255, szQ = ((size_t)R * 768 * 2 + 255) & ~(size_t)255;
        const size_t szA = ((size_t)PADROWS * 512 * 2 + 255) & ~(size_t)255, szY = ((size_t)PADROWS * 1024 * 2 + 255) & ~(size_t)255;
        const size_t base = take((szP + szQ) > (szA + szY) ? (szP + szQ) : (szA + szY));
        w.P = base; w.gq = base + szP; w.act = base; w.Y = base + szA;
    }
    w.fcs = take((size_t)R * 512 * 2);
    w.cU = take((size_t)NUNIT * 4096 * 2); w.cW = take((size_t)NUNIT * 4096 * 2); w.cQK = take((size_t)NUNIT * 4096 * 2);
    w.odir = take((size_t)2 * R * 256 * 2); w.br = take((size_t)R * D * 2);
    w.mg = w.cU;
    w.total = o;
    return w;
}
inline void fill_params(Params& p, void* const* d_in, void* d_out, void* d_ws) {
    WsLayout w = ws_layout(); char* b = (char*)d_ws;
    for (int i = 0; i < 30; ++i) p.in[i] = (const float*)d_in[i];
    p.out = (float*)d_out;
    p.mods = (float*)(b + w.mods); p.cosT = (float*)(b + w.cosT); p.sinT = (float*)(b + w.sinT); p.cs = (float*)(b + w.cs);
    p.h = (bf16*)(b + w.h); p.P = (bf16*)(b + w.P); p.gq = (bf16*)(b + w.gq); p.gg = (float*)(b + w.gg); p.gbeta = (float*)(b + w.gbeta);
    p.fcs = (bf16*)(b + w.fcs); p.cU = (bf16*)(b + w.cU); p.cW = (bf16*)(b + w.cW); p.cQK = (bf16*)(b + w.cQK); p.cG = (float*)(b + w.cG);
    p.odir = (bf16*)(b + w.odir); p.br = (bf16*)(b + w.br); p.mg = (bf16*)(b + w.mg); p.sel_e = (int*)(b + w.sel_e);
    p.sel_w = (float*)(b + w.sel_w); p.act = (bf16*)(b + w.act); p.Y = (bf16*)(b + w.Y);
    p.wt_in = (bf16*)(b + w.wt_in); p.wt_br = (bf16*)(b + w.wt_br); p.wt_out = (bf16*)(b + w.wt_out); p.wt_gu = (bf16*)(b + w.wt_gu);
    p.fa2 = (bf16*)(b + w.fa2); p.fW1 = (bf16*)(b + w.fW1); p.fWA = (bf16*)(b + w.fWA); p.fWB = (bf16*)(b + w.fWB);
    p.bar = (unsigned*)(b + w.bar); p.ropeT = (float*)(b + w.ropeT);
    p.wt_d = (bf16*)(b + w.wt_d); p.cnt = (int*)(b + w.cnt); p.elist = (int*)(b + w.elist); p.apos = (int*)(b + w.apos);
}

#if !defined(CPU_EMU) && defined(PHASE_KERNELS)
#define PK(n) __global__ void __launch_bounds__(256, 2) pk_##n(Params p) { __shared__ __attribute__((aligned(16))) float sm[SMEM_FLOATS]; run_phase(p, n, p.layer, blockIdx.x, gridDim.x, sm); }
PK(0) PK(1) PK(2) PK(3) PK(4) PK(5) PK(6) PK(7) PK(8) PK(9) PK(10) PK(11) PK(12) PK(13) PK(14)
__global__ void __launch_bounds__(256, 2) pk_init(Params p) { __shared__ __attribute__((aligned(16))) float sm[SMEM_FLOATS]; ph_init(p, blockIdx.x, gridDim.x, sm); }
#endif
#ifndef CPU_EMU

#define XB_TMO      128
#define XB_XCNT(j)  (256  + 64 * (j))
#define XB_XSUB(j)  (1280 + 64 * (j))
#define XB_XGEN(j)  (2304 + 64 * (j))
#define XB_TOP      3328
#define XB_TOPGEN   3392
#define XCD_BAR_WORDS 3456
#define XB_SPIN_CAP (1u << 22)
#define LAS __attribute__((address_space(3)))
__device__ __forceinline__ unsigned xb_ld(unsigned* p)              { return __hip_atomic_load(p, __ATOMIC_RELAXED, __HIP_MEMORY_SCOPE_AGENT); }
__device__ __forceinline__ unsigned xb_add(unsigned* p, unsigned v) { return __hip_atomic_fetch_add(p, v, __ATOMIC_RELAXED, __HIP_MEMORY_SCOPE_AGENT); }
__device__ __forceinline__ unsigned xb_xcc_id() { return (unsigned)__builtin_amdgcn_s_getreg((3 << 11) | 20) & 0xFu; }
#define XB_SPIN(cond, bar) do { unsigned _sp = 0; while (cond) { __builtin_amdgcn_s_sleep(1); \
    if ((++_sp & 255u) == 0u) { if (xb_ld(&(bar)[XB_TMO])) break; if (_sp > XB_SPIN_CAP) { atomicAdd(&(bar)[XB_TMO], 1u); break; } } } } while (0)
struct XcdBarrier { unsigned* bar; unsigned x; volatile LAS unsigned* st; };
__device__ __forceinline__ XcdBarrier xcd_barrier_post(unsigned* bar, volatile LAS unsigned* st) {
    XcdBarrier b; b.bar = bar; b.x = xb_xcc_id(); b.st = st;
    if (threadIdx.x == 0) (void)xb_add(&bar[XB_XCNT(b.x)], 1u);
    return b;
}
__device__ __forceinline__ void xcd_barrier_complete(unsigned* bar, unsigned x, unsigned& nloc, unsigned& nx) {
    const unsigned G = gridDim.x * gridDim.y * gridDim.z;
    unsigned sum, cnt, mine, sp = 0u;
    for (;;) {
        sum = 0u; cnt = 0u; mine = 0u;
#pragma unroll
        for (unsigned j = 0; j < 16; ++j) { const unsigned c = xb_ld(&bar[XB_XCNT(j)]); sum += c; cnt += (c > 0u) ? 1u : 0u; mine = (j == x) ? c : mine; }
        if (sum == G) break;
        __builtin_amdgcn_s_sleep(1);
        if ((++sp & 255u) == 0u) { if (xb_ld(&bar[XB_TMO])) break; if (sp > XB_SPIN_CAP) { atomicAdd(&bar[XB_TMO], 1u); break; } }
    }
    nloc = mine > 0u ? mine : 1u; nx = cnt > 0u ? cnt : 1u;
}
__device__ __forceinline__ void xcd_barrier(const XcdBarrier& b) {
    asm volatile("s_waitcnt vmcnt(0)" ::: "memory");
    __syncthreads();
    if (threadIdx.x == 0) {
        unsigned* bar = b.bar;
        __builtin_amdgcn_s_waitcnt(0);
        unsigned nloc = b.st[0], nx = b.st[1];
        if (nloc == 0u) { xcd_barrier_complete(bar, b.x, nloc, nx); b.st[0] = nloc; b.st[1] = nx; }
        const unsigned old = xb_add(&bar[XB_XSUB(b.x)], 1u);
        const unsigned gen = old / nloc;
        if (old + 1u == (gen + 1u) * nloc) {
            __builtin_amdgcn_fence(__ATOMIC_RELEASE, "agent");
            asm volatile("s_waitcnt vmcnt(0)" ::: "memory");
            const unsigned og = xb_add(&bar[XB_TOP], 1u);
            const unsigned tg = og / nx;
            if (og + 1u == (tg + 1u) * nx) xb_add(&bar[XB_TOPGEN], 1u);
            else XB_SPIN(xb_ld(&bar[XB_TOPGEN]) == tg, bar);
            __builtin_amdgcn_fence(__ATOMIC_ACQUIRE, "agent");
            xb_add(&bar[XB_XGEN(b.x)], 1u);
            asm volatile("s_waitcnt vmcnt(0)" ::: "memory");
        } else {
            XB_SPIN(xb_ld(&bar[XB_XGEN(b.x)]) == gen, bar);
            __builtin_amdgcn_fence(__ATOMIC_ACQUIRE, "agent");
            asm volatile("s_waitcnt vmcnt(0)" ::: "memory");
        }
    }
    __syncthreads();
}

__global__ void __launch_bounds__(256, 2) fwd_megakernel(Params p) {
    __shared__ __attribute__((aligned(16))) float sm[SMEM_FLOATS];
    cg::grid_group grid = cg::this_grid();
    const int bid = blockIdx.x, nb = gridDim.x;
    volatile LAS unsigned* xst = (volatile LAS unsigned*)(sm + SMEM_FLOATS - 4);
    if (threadIdx.x == 0) { xst[0] = 0u; xst[1] = 0u; }
    __syncthreads();
    XcdBarrier xb = xcd_barrier_post(p.bar, xst);
    ph_init(p, bid, nb, sm);
    xcd_barrier(xb);
#ifdef PROBE_INIT
    ph_init(p, bid, nb, sm); xcd_barrier(xb); ph_init(p, bid, nb, sm); xcd_barrier(xb);
#endif
#define PH(n, l) run_phase(p, n, l, bid, nb, sm); xcd_barrier(xb);
#define PHN(n, l) run_phase(p, n, l, bid, nb, sm);
#ifndef PROBE_X
#define PROBE_X(n, l)
#endif
#define LAYER(l) PH(0, l) PROBE_X(0, l) PH(1, l) PROBE_X(1, l) PH(2, l) PROBE_X(2, l) PHN(4, l) PHN(6, l) PH(5, l) PROBE_X(4, l) PROBE_X(5, l) PROBE_X(3, l) PROBE_X(6, l) \
    PH(7, l) PROBE_X(7, l) PROBE_X(70, l) PROBE_X(71, l) PH(8, l) PROBE_X(8, l) PH(9, l) PROBE_X(9, l) PH(10, l) PH(11, l) PH(12, l) PROBE_X(12, l) \
    PH(13, l) PROBE_X(13, l) PH(14, l)
    LAYER(0)
#undef LAYER
#define LAYER(l) PH(1, l) PROBE_X(1, l) PH(2, l) PROBE_X(2, l) PHN(4, l) PHN(6, l) PH(5, l) PROBE_X(4, l) PROBE_X(5, l) PROBE_X(3, l) PROBE_X(6, l) \
    PH(7, l) PROBE_X(7, l) PROBE_X(70, l) PROBE_X(71, l) PH(8, l) PROBE_X(8, l) PH(9, l) PROBE_X(9, l) PH(10, l) PROBE_X(110, l) PH(11, l) PROBE_X(111, l) PH(12, l) PROBE_X(12, l) \
    PH(13, l) PROBE_X(13, l) PH(14, l) PROBE_X(114, l)
    LAYER(1)
}

extern "C" void kernel_launch(void* const* d_in, const int* in_sizes, int n_in, void* d_out, int out_size,
                              void* d_ws, size_t ws_size, hipStream_t stream) {
    WsLayout w = ws_layout();
    if (ws_size < w.total) { fprintf(stderr, "ws too small: need %zu have %zu\n", w.total, ws_size); return; }
    static int grid_blocks = 0;
    if (!grid_blocks) {
        int dev = 0, cus = 0, per_cu = 0;
        (void)hipGetDevice(&dev);
        (void)hipDeviceGetAttribute(&cus, hipDeviceAttributeMultiprocessorCount, dev);
        (void)hipOccupancyMaxActiveBlocksPerMultiprocessor(&per_cu, fwd_megakernel, 256, 0);
        if (per_cu < 1) per_cu = 1;
        grid_blocks = cus * per_cu;
    }
    Params p{};
    fill_params(p, d_in, d_out, d_ws);
    (void)hipMemsetAsync(p.bar, 0, XCD_BAR_WORDS * 4, stream);
    void* args[] = {&p};
    hipError_t e = hipLaunchCooperativeKernel((void*)fwd_megakernel, dim3(grid_blocks), dim3(256), args, 0, stream);
    if (e != hipSuccess) fprintf(stderr, "cooperative launch failed: %s (grid %d)\n", hipGetErrorString(e), grid_blocks);
}
#endif
```

```cpp
#ifndef CPU_EMU
#include <hip/hip_runtime.h>
#include <hip/hip_cooperative_groups.h>
#include <cstdio>
namespace cg = cooperative_groups;
#define HD __device__ __forceinline__
__device__ __forceinline__ int tid_() { int v = threadIdx.x; asm volatile("" : "+v"(v)); return v; }
#define THREADS(t, n) for (int t = tid_(); t < (n); t += 256)
#define SYNC __syncthreads();
#define COSPI(x) cospif(x)
#define SINPI(x) sinpif(x)
typedef float4 f4;
#else
#include <cmath>
#include <cstdio>
#include <cstring>
#include <cstddef>
#define HD inline
#define THREADS(t, n) for (int t = 0; t < (n); ++t)
#define SYNC
#define COSPI(x) ((float)cos(M_PI * (double)(x)))
#define SINPI(x) ((float)sin(M_PI * (double)(x)))
struct f4 { float x, y, z, w; };
#endif

#ifndef SEQ
#define SEQ 8192
#endif
#ifndef CTXL
#define CTXL 256
#endif

typedef unsigned short bf16;
#ifndef CPU_EMU
typedef __attribute__((ext_vector_type(8))) short bf16x8_t;
typedef __attribute__((ext_vector_type(4))) float f32x4_t;
typedef __attribute__((ext_vector_type(4))) int i32x4_t;
#define ATOMIC_ADD_RET(ptr, v) atomicAdd((ptr), (v))
#else
HD int atomic_add_ret_(int* p, int v) { int old;
#pragma omp atomic capture
    { old = *p; *p += v; }
    return old; }
#define ATOMIC_ADD_RET(ptr, v) atomic_add_ret_((ptr), (v))
#endif
constexpr int NB = 2, D = 1024, GW = 64, ROWS = SEQ / GW;
constexpr int NLAT = NB * SEQ, NCTX = NB * CTXL, R = NLAT + NCTX;
constexpr int DIN = 6928;
constexpr int PLD = 2816;
constexpr int C_NAQ = 0, C_NAK = 256, C_NAV = 512, C_DAQ = 768, C_DAK = 1024, C_DAV = 1280, C_GQ = 1536, C_Z = 2304,
              C_F = 2560;
constexpr int WIN_N = 6912;
constexpr int WIN_NP = WIN_N + 64;
constexpr int PADROWS = 2 * R + 16 * 128;
constexpr int NCC = CTXL / 64, NCL = SEQ / 64, NCH = NCC + NCL;
constexpr int NUNIT = 2 * NB * 4 * NCH;
constexpr bool FOURIER_GEMM = (SEQ == 8192);
constexpr int SMEM_FLOATS = 73 * 256 + 4;

struct Params {
    const float* in[30];
    float* out;
    float* mods;
    float* cosT;
    float* sinT;
    float* cs;
    bf16* h;
    bf16* P;
    bf16* gq;
    float* gg;
    float* gbeta;
    bf16* fcs;
    bf16* cU;
    bf16* cW;
    bf16* cQK;
    float* cG;
    bf16* odir;
    bf16* br;
    bf16* mg;
    int* sel_e;
    float* sel_w;
    bf16* act;
    bf16* Y;
    bf16* wt_in;
    bf16* wt_br;
    bf16* wt_out;
    bf16* wt_gu;
    bf16* wt_d;
    int* cnt;
    unsigned* bar;
    bf16* fa2;
    bf16* fW1;
    float* ropeT;
    bf16* fWA;
    bf16* fWB;
    bf16* fWC;
    bf16* fXC;
    int* elist;
    int* apos;
    int phase;
    int layer;
};

enum { I_X = 0, I_C, I_CTX, I_CCTX, I_WMOD, I_BMOD, I_N1G, I_N2G, I_WIN, I_NAQG, I_NAKG, I_RPB, I_DAQG, I_DAKG, I_LQ1, I_LK1,
       I_LQ2, I_LK2, I_SUBLN, I_CONVW, I_ALOG, I_DTB, I_ONORM, I_WBR, I_WOUT, I_WROUTER, I_RBIAS, I_MG, I_MU, I_MD };

HD float bf2f(bf16 v) { union { unsigned u; float f; } x; x.u = ((unsigned)v) << 16; return x.f; }
#ifndef CPU_EMU
typedef float f32x2_t __attribute__((ext_vector_type(2))); typedef __bf16 bf16x2_t __attribute__((ext_vector_type(2)));
typedef short s16x4_t __attribute__((ext_vector_type(4)));
typedef __attribute__((address_space(3))) const char* lds_cptr;
HD unsigned cvtpk(float lo, float hi) { f32x2_t v = {lo, hi}; bf16x2_t b = __builtin_convertvector(v, bf16x2_t); return __builtin_bit_cast(unsigned, b); }
HD bf16 f2bf(float f) { return (bf16)(cvtpk(f, 0.f) & 0xffffu); }
HD s16x4_t lds_tr16(lds_cptr p) { return __builtin_bit_cast(s16x4_t, __builtin_amdgcn_ds_read_tr16_b64_v4i16((__attribute__((address_space(3))) s16x4_t*)p)); }
#else
HD bf16 f2bf(float f) { union { unsigned u; float f; } x; x.f = f; unsigned u = x.u; u += 0x7fffu + ((u >> 16) & 1u); return (bf16)(u >> 16); }
#endif
HD float sigmoidf_(float x) { return 1.0f / (1.0f + expf(-x)); }
HD float siluf_(float x) { return x / (1.0f + expf(-x)); }

struct RowInfo { int seg, b, t, T, base; };
HD RowInfo rowinfo(int r) {
    RowInfo q;
    if (r < NLAT) { q.seg = 0; q.b = r / SEQ; q.t = r % SEQ; q.T = SEQ; q.base = q.b * SEQ; }
    else { int r2 = r - NLAT; q.seg = 1; q.b = r2 / CTXL; q.t = r2 % CTXL; q.T = CTXL; q.base = NLAT + q.b * CTXL; }
    return q;
}
HD const float* xrow_in(const Params& p, int l, int r) {
    if (r < NLAT) return (l == 0 ? p.in[I_X] : p.out) + (size_t)r * D;
    return p.cs + (size_t)(r - NLAT) * D;
}
HD float* xrow_out(const Params& p, int r) {
    if (r < NLAT) return p.out + (size_t)r * D;
    return p.cs + (size_t)(r - NLAT) * D;
}
HD const float* modrow(const Params& p, int l, int r) {
    int s = (r < NLAT) ? (r / SEQ) : 2;
    return p.mods + (size_t)(l * 3 + s) * 6144;
}
#ifndef CPU_EMU
HD unsigned char* gu8_of(const Params& p) { return (unsigned char*)p.wt_gu; }
HD unsigned char* d8_of(const Params& p) { return (unsigned char*)p.wt_gu + (size_t)16 * 1024 * 1024; }
HD unsigned char* h8_of(const Params& p) { return (unsigned char*)p.wt_gu + (size_t)16 * 1024 * 1024 + (size_t)16 * 1024 * 512; }
#endif
HD float lam_init_of(int l) { return l == 0 ? 0.2f : (0.8f - 0.6f * 0.7408182206817179f); }


#ifndef CPU_EMU
template <int NJ> struct AccT { f32x4_t v[4][NJ]; };
#define ACC_DECL(NJ, a) AccT<NJ> a
template <int NJ> HD void acc_zero(AccT<NJ>& a) {
#pragma unroll
    for (int i = 0; i < 4; ++i)
#pragma unroll
        for (int j = 0; j < NJ; ++j) a.v[i][j] = f32x4_t{0.f, 0.f, 0.f, 0.f};
}
#define ACC_FOR(NJ, row, col) { const int _t = tid_(); const int _ln = _t & 63, _w = _t >> 6; \
    _Pragma("unroll") for (int _i = 0; _i < 4; ++_i) _Pragma("unroll") for (int _j = 0; _j < NJ; ++_j) _Pragma("unroll") for (int _r = 0; _r < 4; ++_r) { \
    const int row = (_w >> 1) * 64 + _i * 16 + (_ln >> 4) * 4 + _r; const int col = (_w & 1) * (16 * NJ) + _j * 16 + (_ln & 15);
#define AV(a) a.v[_i][_j][_r]
#define ACC_END }}
#define ACC_FOR_PAIR(row, pcol) { const int _t = tid_(); const int _ln = _t & 63, _w = _t >> 6; \
    _Pragma("unroll") for (int _i = 0; _i < 4; ++_i) _Pragma("unroll") for (int _jj = 0; _jj < 2; ++_jj) _Pragma("unroll") for (int _r = 0; _r < 4; ++_r) { \
    const int row = (_w >> 1) * 64 + _i * 16 + (_ln >> 4) * 4 + _r; const int pcol = (_w & 1) * 32 + _jj * 16 + (_ln & 15);
#define AV_G(a) a.v[_i][2 * _jj][_r]
#define AV_U(a) a.v[_i][2 * _jj + 1][_r]

#define WAIT_VM0() asm volatile("s_waitcnt vmcnt(0)" ::: "memory")
#define GLDS16(gp, lp) __builtin_amdgcn_global_load_lds((const unsigned*)(gp), (unsigned*)(lp), 16, 0, 0)
template <int NJ, class AF, class BF>
HD void gemm_accum(AccT<NJ>& acc, AF arow, BF brow, int K, char* smem) {
    constexpr int NBL = NJ;
    const int t = tid_(), lane = t & 63, w = t >> 6, wr = w >> 1, wc = w & 1;
    const int lr = t >> 3, lc = t & 7;
    const bf16* ap[4]; const bf16* bp[NBL];
#pragma unroll
    for (int i = 0; i < 4; ++i) ap[i] = arow(lr + 32 * i) + ((lc ^ (lr & 7)) << 3);
#pragma unroll
    for (int i = 0; i < NBL; ++i) bp[i] = brow(lr + 32 * i) + ((lc ^ (lr & 7)) << 3);
    char* sA = smem + w * 1024; char* sB = smem + 32768 + w * 1024;
    const int fr = lane & 15, fg = lane >> 4;
    const unsigned aoff0 = (wr * 64 + fr) * 128 + (((fg) ^ (fr & 7)) << 4);
    const unsigned aoff1 = (wr * 64 + fr) * 128 + (((4 + fg) ^ (fr & 7)) << 4);
    const unsigned boff0 = (wc * (16 * NJ) + fr) * 128 + (((fg) ^ (fr & 7)) << 4);
    const unsigned boff1 = (wc * (16 * NJ) + fr) * 128 + (((4 + fg) ^ (fr & 7)) << 4);
    const int KT = K >> 6;
    __syncthreads();
#pragma unroll
    for (int i = 0; i < 4; ++i) GLDS16(ap[i], sA + 4096 * i);
#pragma unroll
    for (int i = 0; i < NBL; ++i) GLDS16(bp[i], sB + 4096 * i);
    WAIT_VM0();
    __syncthreads();
#pragma unroll 1
    for (int kt = 0; kt < KT; ++kt) {
        const int cur = kt & 1;
        if (kt + 1 < KT) {
#pragma unroll
            for (int i = 0; i < 4; ++i) GLDS16(ap[i] + (kt + 1) * 64, sA + (cur ^ 1) * 16384 + 4096 * i);
#pragma unroll
            for (int i = 0; i < NBL; ++i) GLDS16(bp[i] + (kt + 1) * 64, sB + (cur ^ 1) * 16384 + 4096 * i);
        }
        const char* cA = smem + cur * 16384; const char* cB = smem + 32768 + cur * 16384;
#pragma unroll
        for (int s = 0; s < 2; ++s) {
            bf16x8_t af[4], bfr[NJ];
#pragma unroll
            for (int i = 0; i < 4; ++i) af[i] = *(const bf16x8_t*)(cA + (s ? aoff1 : aoff0) + i * 2048);
#pragma unroll
            for (int j = 0; j < NJ; ++j) bfr[j] = *(const bf16x8_t*)(cB + (s ? boff1 : boff0) + j * 2048);
#pragma unroll
            for (int i = 0; i < 4; ++i)
#pragma unroll
                for (int j = 0; j < NJ; ++j) acc.v[i][j] = __builtin_amdgcn_mfma_f32_16x16x32_bf16(af[i], bfr[j], acc.v[i][j], 0, 0, 0);
        }
        WAIT_VM0();
        __syncthreads();
    }
}
template <int NJ> HD void acc_to_lds(const AccT<NJ>& acc, float* tl) {
    const int t = tid_(), lane = t & 63, w = t >> 6;
    constexpr int LD = 32 * NJ + 4;
    float* base = tl + ((w >> 1) * 64 + (lane >> 4) * 4) * LD + (w & 1) * (16 * NJ) + (lane & 15);
#pragma unroll
    for (int i = 0; i < 4; ++i)
#pragma unroll
        for (int j = 0; j < NJ; ++j)
#pragma unroll
            for (int r = 0; r < 4; ++r) base[(i * 16 + r) * LD + j * 16] = acc.v[i][j][r];
}
typedef int i32x8_t __attribute__((ext_vector_type(8)));
typedef unsigned char u8;
template <int NJ, class AF, class BF>
HD void gemm_accum8(AccT<NJ>& acc, AF arow, BF brow, int K, char* smem, int sa, int sb) {
    constexpr int NBL = NJ;
    const int t = tid_(), lane = t & 63, w = t >> 6, wr = w >> 1, wc = w & 1;
    const int lr = t >> 3, lc = t & 7;
    const u8* ap[4]; const u8* bp[NBL];
#pragma unroll
    for (int i = 0; i < 4; ++i) ap[i] = arow(lr + 32 * i) + ((lc ^ (lr & 7)) << 4);
#pragma unroll
    for (int i = 0; i < NBL; ++i) bp[i] = brow(lr + 32 * i) + ((lc ^ (lr & 7)) << 4);
    char* sA = smem + w * 1024; char* sB = smem + 32768 + w * 1024;
    const int fr = lane & 15, fg = lane >> 4;
    const unsigned aoff0 = (wr * 64 + fr) * 128 + (((2 * fg) ^ (fr & 7)) << 4);
    const unsigned aoff1 = (wr * 64 + fr) * 128 + (((2 * fg + 1) ^ (fr & 7)) << 4);
    const unsigned boff0 = (wc * (16 * NJ) + fr) * 128 + (((2 * fg) ^ (fr & 7)) << 4);
    const unsigned boff1 = (wc * (16 * NJ) + fr) * 128 + (((2 * fg + 1) ^ (fr & 7)) << 4);
    const int KT = K >> 7;
    __syncthreads();
#pragma unroll
    for (int i = 0; i < 4; ++i) GLDS16(ap[i], sA + 4096 * i);
#pragma unroll
    for (int i = 0; i < NBL; ++i) GLDS16(bp[i], sB + 4096 * i);
    WAIT_VM0();
    __syncthreads();
#pragma unroll 1
    for (int kt = 0; kt < KT; ++kt) {
        const int cur = kt & 1;
        if (kt + 1 < KT) {
#pragma unroll
            for (int i = 0; i < 4; ++i) GLDS16(ap[i] + (kt + 1) * 128, sA + (cur ^ 1) * 16384 + 4096 * i);
#pragma unroll
            for (int i = 0; i < NBL; ++i) GLDS16(bp[i] + (kt + 1) * 128, sB + (cur ^ 1) * 16384 + 4096 * i);
        }
        const char* cA = smem + cur * 16384; const char* cB = smem + 32768 + cur * 16384;
        i32x8_t af[4], bfr[NJ];
#pragma unroll
        for (int i = 0; i < 4; ++i) {
            const i32x4_t lo = *(const i32x4_t*)(cA + aoff0 + i * 2048), hi = *(const i32x4_t*)(cA + aoff1 + i * 2048);
            af[i] = i32x8_t{lo[0], lo[1], lo[2], lo[3], hi[0], hi[1], hi[2], hi[3]};
        }
#pragma unroll
        for (int j = 0; j < NJ; ++j) {
            const i32x4_t lo = *(const i32x4_t*)(cB + boff0 + j * 2048), hi = *(const i32x4_t*)(cB + boff1 + j * 2048);
            bfr[j] = i32x8_t{lo[0], lo[1], lo[2], lo[3], hi[0], hi[1], hi[2], hi[3]};
        }
#pragma unroll
        for (int i = 0; i < 4; ++i)
#pragma unroll
            for (int j = 0; j < NJ; ++j) acc.v[i][j] = __builtin_amdgcn_mfma_scale_f32_16x16x128_f8f6f4(af[i], bfr[j], acc.v[i][j], 0, 0, 0, sa, 0, sb);
        WAIT_VM0();
        __syncthreads();
    }
}
HD unsigned pack_fp8x4(float a, float b, float c, float d) {
    a = __builtin_amdgcn_fmed3f(a, -448.f, 448.f); b = __builtin_amdgcn_fmed3f(b, -448.f, 448.f);
    c = __builtin_amdgcn_fmed3f(c, -448.f, 448.f); d = __builtin_amdgcn_fmed3f(d, -448.f, 448.f);
    int w = 0;
    w = __builtin_amdgcn_cvt_pk_fp8_f32(a, b, w, false);
    w = __builtin_amdgcn_cvt_pk_fp8_f32(c, d, w, true);
    return (unsigned)w;
}
constexpr int SC_H = 0x7d7d7d7d;
constexpr int SC_W = 0x7a7a7a7a;
constexpr int SC_ACT = 0x7b7b7b7b;
template <int NJ, class AF, class BF>
HD void gemm_stage0(AF arow, BF brow, int ebytes, char* smem, int buf) {
    const int t = tid_(), w = t >> 6, lr = t >> 3, lc = t & 7;
    char* sA = smem + w * 1024 + buf * 16384; char* sB = smem + 32768 + w * 1024 + buf * 16384;
    (void)ebytes;
#pragma unroll
    for (int i = 0; i < 4; ++i) GLDS16((const char*)arow(lr + 32 * i) + ((lc ^ (lr & 7)) << 4), sA + 4096 * i);
#pragma unroll
    for (int i = 0; i < NJ; ++i) GLDS16((const char*)brow(lr + 32 * i) + ((lc ^ (lr & 7)) << 4), sB + 4096 * i);
}
template <int NJ, bool FP8, class AF, class BF, class NF>
HD void gemm_chain(AccT<NJ>& acc, AF arow, BF brow, int K, char* smem, int& cur, NF next_stage, int sa, int sb) {
    const int t = tid_(), lane = t & 63, w = t >> 6, wr = w >> 1, wc = w & 1;
    const int lr = t >> 3, lc = t & 7;
    const char* ap[4]; const char* bp[NJ];
#pragma unroll
    for (int i = 0; i < 4; ++i) ap[i] = (const char*)arow(lr + 32 * i) + ((lc ^ (lr & 7)) << 4);
#pragma unroll
    for (int i = 0; i < NJ; ++i) bp[i] = (const char*)brow(lr + 32 * i) + ((lc ^ (lr & 7)) << 4);
    char* sA = smem + w * 1024; char* sB = smem + 32768 + w * 1024;
    const int fr = lane & 15, fg = lane >> 4;
    const unsigned rA = (wr * 64 + fr) * 128, rB = (wc * (16 * NJ) + fr) * 128;
    const int KT = K >> (FP8 ? 7 : 6);
#pragma unroll 1
    for (int kt = 0; kt < KT; ++kt) {
        WAIT_VM0();
        __syncthreads();
        if (kt + 1 < KT) {
#pragma unroll
            for (int i = 0; i < 4; ++i) GLDS16(ap[i] + (kt + 1) * 128, sA + (cur ^ 1) * 16384 + 4096 * i);
#pragma unroll
            for (int i = 0; i < NJ; ++i) GLDS16(bp[i] + (kt + 1) * 128, sB + (cur ^ 1) * 16384 + 4096 * i);
        } else next_stage(cur ^ 1);
        const char* cA = smem + cur * 16384; const char* cB = smem + 32768 + cur * 16384;
        if (FP8) {
            i32x8_t af[4], bfr[NJ];
#pragma unroll
            for (int i = 0; i < 4; ++i) {
                const i32x4_t lo = *(const i32x4_t*)(cA + rA + (((2 * fg) ^ (fr & 7)) << 4) + i * 2048), hi = *(const i32x4_t*)(cA + rA + (((2 * fg + 1) ^ (fr & 7)) << 4) + i * 2048);
                af[i] = i32x8_t{lo[0], lo[1], lo[2], lo[3], hi[0], hi[1], hi[2], hi[3]};
            }
#pragma unroll
            for (int j = 0; j < NJ; ++j) {
                const i32x4_t lo = *(const i32x4_t*)(cB + rB + (((2 * fg) ^ (fr & 7)) << 4) + j * 2048), hi = *(const i32x4_t*)(cB + rB + (((2 * fg + 1) ^ (fr & 7)) << 4) + j * 2048);
                bfr[j] = i32x8_t{lo[0], lo[1], lo[2], lo[3], hi[0], hi[1], hi[2], hi[3]};
            }
#pragma unroll
            for (int i = 0; i < 4; ++i)
#pragma unroll
                for (int j = 0; j < NJ; ++j) acc.v[i][j] = __builtin_amdgcn_mfma_scale_f32_16x16x128_f8f6f4(af[i], bfr[j], acc.v[i][j], 0, 0, 0, sa, 0, sb);
        } else {
#pragma unroll
            for (int s_ = 0; s_ < 2; ++s_) {
                bf16x8_t af[4], bfr[NJ];
#pragma unroll
                for (int i = 0; i < 4; ++i) af[i] = *(const bf16x8_t*)(cA + rA + (((4 * s_ + fg) ^ (fr & 7)) << 4) + i * 2048);
#pragma unroll
                for (int j = 0; j < NJ; ++j) bfr[j] = *(const bf16x8_t*)(cB + rB + (((4 * s_ + fg) ^ (fr & 7)) << 4) + j * 2048);
#pragma unroll
                for (int i = 0; i < 4; ++i)
#pragma unroll
                    for (int j = 0; j < NJ; ++j) acc.v[i][j] = __builtin_amdgcn_mfma_f32_16x16x32_bf16(af[i], bfr[j], acc.v[i][j], 0, 0, 0);
            }
        }
        cur ^= 1;
    }
}
#else
template <int NJ> struct AccT { float v[128][32 * NJ]; };
#define ACC_DECL(NJ, a) static thread_local AccT<NJ> a
template <int NJ> HD void acc_zero(AccT<NJ>& a) { memset(a.v, 0, sizeof(a.v)); }
#define ACC_FOR(NJ, row, col) { for (int row = 0; row < 128; ++row) for (int col = 0; col < 32 * NJ; ++col) {
#define AV(a) a.v[row][col]
#define ACC_END }}
#define ACC_FOR_PAIR(row, pcol) { for (int row = 0; row < 128; ++row) for (int pcol = 0; pcol < 64; ++pcol) {
#define AV_G(a) a.v[row][(pcol / 16) * 32 + (pcol % 16)]
#define AV_U(a) a.v[row][(pcol / 16) * 32 + 16 + (pcol % 16)]
template <int NJ, class AF, class BF>
HD void gemm_accum(AccT<NJ>& acc, AF arow, BF brow, int K, char* smem) {
    for (int i = 0; i < 128; ++i) { const bf16* a = arow(i);
        for (int j = 0; j < 32 * NJ; ++j) { const bf16* b = brow(j); float s = 0.f;
            for (int k = 0; k < K; ++k) s += bf2f(a[k]) * bf2f(b[k]);
            acc.v[i][j] += s; } }
}
#endif

template <class DF>
HD void conv_tile(const float* src, size_t lds_, bf16* dst, size_t ldd, int k0, int nsrc0, DF drow, float* sm) {
    THREADS(t, 4096) { int kk = t >> 6, nn = t & 63; sm[kk * 65 + nn] = src[(size_t)(k0 + kk) * lds_ + nsrc0 + nn]; }
    SYNC
    THREADS(t, 4096) { int nn = t >> 6, kk = t & 63; dst[(size_t)drow(nn) * ldd + k0 + kk] = f2bf(sm[kk * 65 + nn]); }
    SYNC
}
#ifndef CPU_EMU
template <class DF>
HD void conv_tile8(const float* src, size_t lds_, unsigned char* dst, size_t ldd, int k0, int nsrc0, DF drow, float scale, float* sm) {
    THREADS(t, 4096) { int kk = t >> 6, nn = t & 63; sm[kk * 65 + nn] = src[(size_t)(k0 + kk) * lds_ + nsrc0 + nn] * scale; }
    SYNC
    THREADS(t, 1024) { int nn = t >> 4, k4 = (t & 15) * 4;
        *(unsigned*)(dst + (size_t)drow(nn) * ldd + k0 + k4) = pack_fp8x4(sm[k4 * 65 + nn], sm[(k4 + 1) * 65 + nn], sm[(k4 + 2) * 65 + nn], sm[(k4 + 3) * 65 + nn]); }
    SYNC
}
HD void convert_moe(const Params& p, int l, int bid, int nb, float* sm) {
    for (int w = bid; w < 4096 + 2048; w += nb) {
        if (w < 4096) {
            int nt = w & 7, kt = (w >> 3) & 15, gu = (w >> 7) & 1, e = w >> 8;
            const float* src = p.in[gu ? I_MU : I_MG] + (size_t)(l * 16 + e) * D * 512;
            conv_tile8(src, 512, gu8_of(p) + (size_t)e * 1024 * D, D, kt * 64, nt * 64, [&](int nn) { int j = nt * 64 + nn; return (j >> 4) * 32 + (j & 15) + 16 * gu; }, 32.0f, sm);
        } else {
            int w2 = w - 4096; int nt = w2 & 15, kt = (w2 >> 4) & 7, e = w2 >> 7;
            const float* src = p.in[I_MD] + (size_t)(l * 16 + e) * 512 * D;
            conv_tile8(src, D, d8_of(p) + (size_t)e * D * 512, 512, kt * 64, nt * 64, [&](int nn) { return nt * 64 + nn; }, 32.0f, sm);
        }
    }
}
#else
HD void convert_moe(const Params& p, int l, int bid, int nb, float* sm) {
    for (int w = bid; w < 4096 + 2048; w += nb) {
        if (w < 4096) {
            int nt = w & 7, kt = (w >> 3) & 15, gu = (w >> 7) & 1, e = w >> 8;
            const float* src = p.in[gu ? I_MU : I_MG] + (size_t)(l * 16 + e) * D * 512;
            bf16* dst = p.wt_gu + (size_t)e * 1024 * D;
            conv_tile(src, 512, dst, D, kt * 64, nt * 64, [&](int nn) { int j = nt * 64 + nn; return (j >> 4) * 32 + (j & 15) + 16 * gu; }, sm);
        } else {
            int w2 = w - 4096; int nt = w2 & 15, kt = (w2 >> 4) & 7, e = w2 >> 7;
            const float* src = p.in[I_MD] + (size_t)(l * 16 + e) * 512 * D;
            bf16* dst = p.wt_d + (size_t)e * D * 512;
            conv_tile(src, D, dst, 512, kt * 64, nt * 64, [&](int nn) { return nt * 64 + nn; }, sm);
        }
    }
}
#endif
HD void convert_static(const Params& p, int bid, int nb, float* sm, int part) {
    for (int w = bid; w < 3456 + 512 + 512 + 32; w += nb) {
        if ((part == 0) != (w < 3456 || w >= 3456 + 512 + 512)) continue;
        if (w >= 3456 + 512 + 512) {
            int w2 = w - 3456 - 512 - 512; int kt = w2 & 15, l = w2 >> 4;
            conv_tile(p.in[I_WIN] + (size_t)l * D * DIN, DIN, p.wt_in + (size_t)l * WIN_NP * D, D, kt * 64, 2560, [&](int nn) { return WIN_N + nn; }, sm);
        } else if (w < 3456) {
            int nt = w % 108, kt = (w / 108) & 15, l = w / (108 * 16);
            int n0 = nt * 64;
#ifndef CPU_EMU
            if (n0 >= PLD) {
                conv_tile8(p.in[I_WIN] + (size_t)l * D * DIN, DIN, (unsigned char*)(p.wt_in + (size_t)l * WIN_NP * D + (size_t)PLD * D), D, kt * 64, n0 + 16,
                           [&](int nn) { return n0 - PLD + nn; }, 32.0f, sm);
                continue;
            }
#endif
            conv_tile(p.in[I_WIN] + (size_t)l * D * DIN, DIN, p.wt_in + (size_t)l * WIN_NP * D, D, kt * 64, n0 < 2560 ? n0 : n0 + 16,
                      [&](int nn) { return n0 + nn; }, sm);
        } else if (w < 3456 + 512) {
            int w2 = w - 3456; int nt = w2 & 15, kt = (w2 >> 4) & 3, li = w2 >> 6;
            conv_tile(p.in[I_WBR] + (size_t)li * 256 * D, D, p.wt_br + (size_t)li * D * 256, 256, kt * 64, nt * 64, [&](int nn) { return nt * 64 + nn; }, sm);
        } else {
            int w2 = w - 3456 - 512; int nt = w2 & 15, kt = (w2 >> 4) & 15, l = w2 >> 8;
            conv_tile(p.in[I_WOUT] + (size_t)l * D * D, D, p.wt_out + (size_t)l * D * D, D, kt * 64, nt * 64, [&](int nn) { return nt * 64 + nn; }, sm);
        }
    }
}

HD void init_tables(const Params& p, int bid, int nb) {
    for (int u = bid; u < (SEQ + 255) / 256; u += nb) {
        THREADS(t, 256) {
            int j = u * 256 + t;
            if (j < SEQ) { float a = 2.0f * (float)j / (float)SEQ; p.cosT[j] = COSPI(a); p.sinT[j] = SINPI(a); }
        }
    }
    if (bid == 0) {
        THREADS(t, 1024) {
            int pos = t >> 3, f = t & 7; float fr_ = 1.0f;
            for (int q = 0; q < f; ++q) fr_ *= 0.31622776601683794f;
            float ang = (float)pos * fr_;
            p.ropeT[t * 2] = cosf(ang); p.ropeT[t * 2 + 1] = sinf(ang);
        }
    }
    for (int u = bid; u < (CTXL * 2 * CTXL) / 256; u += nb) {
        THREADS(t, 256) {
            int i = u * 256 + t; int k = i / (2 * CTXL), q = i % (2 * CTXL); int cs = q / CTXL, tt = q % CTXL;
            float a = 2.0f * (float)((k * tt) % CTXL) / (float)CTXL;
            p.fWC[i] = f2bf(cs ? -SINPI(a) : COSPI(a));
        }
    }
    for (int u = bid; u < (8192 + 65536 + 8192) / 256; u += nb) {
        THREADS(t, 256) {
            int i = u * 256 + t;
            if (i < 8192) {
                int j = i >> 6, c = i & 63; int cs = j >> 6, m = j & 63;
                float a = 2.0f * (float)((m * c) & 63) / 64.0f;
                p.fW1[i] = f2bf(cs ? SINPI(a) : COSPI(a));
            } else if (i < 8192 + 65536) {
                int q = i - 8192; int n = q >> 8, k = q & 255;
                int ri = (n >> 4) & 1, k1 = (n >> 5) * 16 + (n & 15); int cs = k >> 7, t1 = k & 127;
                float a = 2.0f * (float)((k1 * t1) & 127) / 128.0f;
                float cv = COSPI(a), sv = SINPI(a);
                float v = (ri == 0) ? (cs == 0 ? cv : -sv) : (cs == 0 ? -sv : -cv);
                p.fWA[q] = f2bf(v);
            } else {
                int q = i - 8192 - 65536; int k2 = q >> 7, k = q & 127; int ri = k >> 6, t2 = k & 63;
                float a = 2.0f * (float)((k2 * t2) & 63) / 64.0f;
                p.fWB[q] = f2bf(ri ? SINPI(a) : COSPI(a));
            }
        }
    }
}

HD void ph_init(const Params& p, int bid, int nb, float* sm) {
    const int NMOD = 2 * 3 * 6144;
    if (bid == 0) { THREADS(t, 32) { p.cnt[t] = 0; } }
#ifndef CPU_EMU
    {
        const int tq = tid_(); const int col = tq & 63, ks = tq >> 6;
        for (int u = nb - 1 - bid; u < 2 * 96; u += nb) {
            const int l = u / 96, c0 = (u % 96) * 64;
            __syncthreads();
            for (int i = tq; i < 3 * D; i += 256) { const int s_ = i / D, k = i % D; const float cv = (s_ < 2) ? p.in[I_C][s_ * D + k] : p.in[I_CCTX][k]; sm[i] = siluf_(cv); }
            __syncthreads();
            const float* wp = p.in[I_WMOD] + (size_t)l * D * 6144 + (size_t)(ks * 256) * 6144 + c0 + col;
            float a0 = 0.f, a1 = 0.f, a2 = 0.f;
#pragma unroll 8
            for (int k = 0; k < 256; ++k) { const float wv = wp[(size_t)k * 6144]; a0 += sm[ks * 256 + k] * wv; a1 += sm[D + ks * 256 + k] * wv; a2 += sm[2 * D + ks * 256 + k] * wv; }
            float* red = sm + 3 * D;
            red[(ks * 3 + 0) * 64 + col] = a0; red[(ks * 3 + 1) * 64 + col] = a1; red[(ks * 3 + 2) * 64 + col] = a2;
            __syncthreads();
            if (tq < 192) {
                const int s_ = tq >> 6, cc = tq & 63;
                const float v = red[(0 * 3 + s_) * 64 + cc] + red[(1 * 3 + s_) * 64 + cc] + red[(2 * 3 + s_) * 64 + cc] + red[(3 * 3 + s_) * 64 + cc];
                p.mods[(size_t)(l * 3 + s_) * 6144 + c0 + cc] = v + p.in[I_BMOD][l * 6144 + c0 + cc];
            }
        }
    }
    convert_static(p, bid, nb, sm, 0);
#else
    convert_static(p, bid, nb, sm, 0);
    for (int u = bid; u < (NMOD + 255) / 256; u += nb) {
        THREADS(t, 256) {
            int idx = u * 256 + t;
            if (idx < NMOD) {
                int l = idx / (3 * 6144), s = (idx / 6144) % 3, col = idx % 6144;
                const float* cv = (s < 2) ? p.in[I_C] + s * D : p.in[I_CCTX];
                const float* w = p.in[I_WMOD] + (size_t)l * D * 6144 + col;
                float acc = 0.f;
                for (int k = 0; k < D; ++k) acc += siluf_(cv[k]) * w[(size_t)k * 6144];
                p.mods[idx] = acc + p.in[I_BMOD][l * 6144 + col];
            }
        }
    }
#endif
    init_tables(p, bid, nb);
    for (int u = bid; u < (NCTX * D) / 256; u += nb) {
        THREADS(t, 256) { int i = u * 256 + t; p.cs[i] = p.in[I_CTX][i]; }
    }

}

#ifndef CPU_EMU
HD float wave_sum(float v) {
#pragma unroll
    for (int o = 32; o >= 1; o >>= 1) v += __shfl_xor(v, o);
    return v;
}
HD void ph_norm1(const Params& p, int l, int bid, int nb, float* sm) {
    const int t = tid_(), lane = t & 63, w = t >> 6;
    const float* g = p.in[I_N1G] + l * D;
    for (int r = bid * 4 + w; r < R; r += nb * 4) {
        const float* x = xrow_in(p, l, r);
        const float* m = modrow(p, l, r);
        f32x4_t xv[4]; float ss = 0.f;
#pragma unroll
        for (int j = 0; j < 4; ++j) { xv[j] = *(const f32x4_t*)(x + j * 256 + lane * 4); ss += xv[j][0] * xv[j][0] + xv[j][1] * xv[j][1] + xv[j][2] * xv[j][2] + xv[j][3] * xv[j][3]; }
        ss = wave_sum(ss);
        const float rs = 1.0f / sqrtf(ss / D + 1e-6f);
#pragma unroll
        for (int j = 0; j < 4; ++j) {
            const int k = j * 256 + lane * 4;
            const f32x4_t gv = *(const f32x4_t*)(g + k), sc = *(const f32x4_t*)(m + 1024 + k), sh = *(const f32x4_t*)(m + k);
            float o[4];
#pragma unroll
            for (int q = 0; q < 4; ++q) o[q] = xv[j][q] * rs * gv[q] * (1.0f + sc[q]) + sh[q];
            uint2 pk; pk.x = cvtpk(o[0], o[1]); pk.y = cvtpk(o[2], o[3]);
            *(uint2*)(p.h + (size_t)r * D + k) = pk;
            *(unsigned*)(h8_of(p) + (size_t)r * D + k) = pack_fp8x4(o[0] * 4.f, o[1] * 4.f, o[2] * 4.f, o[3] * 4.f);
        }
    }
}
#else
HD void ph_norm1(const Params& p, int l, int bid, int nb, float* sm) {
    const float* g = p.in[I_N1G] + l * D;
    for (int r = bid; r < R; r += nb) {
        const float* x = xrow_in(p, l, r);
        const float* m = modrow(p, l, r);
        THREADS(t, 256) { float s = 0.f; for (int k = t; k < D; k += 256) s += x[k] * x[k]; sm[t] = s; }
        SYNC
        THREADS(t, 1) { float s = 0.f; for (int i = 0; i < 256; ++i) s += sm[i]; sm[256] = s; }
        SYNC
        THREADS(t, 256) {
            float rs = 1.0f / sqrtf(sm[256] / D + 1e-6f);
            for (int k = t; k < D; k += 256) {
                float v = x[k] * rs * g[k];
                p.h[(size_t)r * D + k] = f2bf(v * (1.0f + m[1024 + k]) + m[k]);
            }
        }
        SYNC
    }
}
#endif

HD void ph_inproj(const Params& p, int l, int bid, int nb, char* smc) {
    const bf16* Wt = p.wt_in + (size_t)l * WIN_NP * D;
    constexpr int NT = PLD / 128, MT = R / 128;
    for (int mt = bid; mt < MT; mt += nb) {
        ACC_DECL(2, acc); acc_zero(acc);
        gemm_accum<2>(acc, [&](int i) { return p.h + (size_t)(mt * 128 + i) * D; }, [&](int j) { return Wt + (size_t)(WIN_N + j) * D; }, D, smc);
        ACC_FOR(2, row, col) {
            const int r = mt * 128 + row;
            if (col < 8) {
                const float xx = AV(acc) + p.in[I_DTB][l * 8 + col];
                const float sp = xx > 20.f ? xx : log1pf(expf(xx));
                p.gg[(size_t)col * R + r] = -expf(p.in[I_ALOG][l * 8 + col]) * sp;
            } else if (col < 16) p.gbeta[(size_t)(col - 8) * R + r] = sigmoidf_(AV(acc));
        } ACC_END
    }
    for (int tile = bid; tile < MT * NT; tile += nb) {
        const int mt = tile / NT, nt = tile % NT;
        ACC_DECL(4, acc); acc_zero(acc);
        gemm_accum<4>(acc, [&](int i) { return p.h + (size_t)(mt * 128 + i) * D; }, [&](int j) { return Wt + (size_t)(nt * 128 + j) * D; }, D, smc);
#ifndef CPU_EMU
        {
            float* tl = (float*)smc;
            acc_to_lds<4>(acc, tl);
            __syncthreads();
            const int t_ = tid_(); const int row = t_ >> 1, half = t_ & 1;
            const int cb = nt * 128 + half * 64;
            float v[64];
#pragma unroll
            for (int q = 0; q < 16; ++q) { const f32x4_t x4 = *(const f32x4_t*)(tl + row * 132 + half * 64 + q * 4); v[q * 4] = x4[0]; v[q * 4 + 1] = x4[1]; v[q * 4 + 2] = x4[2]; v[q * 4 + 3] = x4[3]; }
            if (cb < 512) {
                const float* gn = (cb < 256 ? p.in[I_NAQG] : p.in[I_NAKG]) + l * 64;
                float ss = 0.f;
#pragma unroll
                for (int c = 0; c < 64; ++c) ss += v[c] * v[c];
                const float rs = __builtin_amdgcn_rsqf(ss * (1.0f / 64.0f) + 1e-6f) * ((cb < 256) ? 0.125f * 1.4426950408889634f : 1.0f);
#pragma unroll
                for (int c = 0; c < 64; ++c) v[c] *= rs * gn[c];
            } else if (cb >= 768 && cb < 1280) {
                const float* gn = (cb < 1024 ? p.in[I_DAQG] : p.in[I_DAKG]) + l * 32;
                const float qs = (cb < 1024) ? 0.17677669529663687f * 1.4426950408889634f : 1.0f;
#pragma unroll
                for (int gp = 0; gp < 2; ++gp) {
                    float ss = 0.f;
#pragma unroll
                    for (int c = 0; c < 32; ++c) ss += v[gp * 32 + c] * v[gp * 32 + c];
                    const float rs = __builtin_amdgcn_rsqf(ss * (1.0f / 32.0f) + 1e-6f) * qs;
#pragma unroll
                    for (int c = 0; c < 32; ++c) v[gp * 32 + c] *= rs * gn[c];
                }
                const int gr_ = mt * 128 + row;
                if (gr_ < NLAT) {
                    const int tt = gr_ % SEQ;
#pragma unroll
                    for (int a = 0; a < 2; ++a) {
                        const float pos = (float)(a == 0 ? tt / GW : tt % GW);
                        float frev = 0.15915494309189535f;
#pragma unroll
                        for (int f = 0; f < 8; ++f) {
                            const float cs = __builtin_amdgcn_cosf(pos * frev), sn = __builtin_amdgcn_sinf(pos * frev);
#pragma unroll
                            for (int gp = 0; gp < 2; ++gp) {
                                const int i1 = gp * 32 + a * 16 + f, i2 = i1 + 8;
                                const float x1 = v[i1], x2 = v[i2];
                                v[i1] = x1 * cs - x2 * sn; v[i2] = x2 * cs + x1 * sn;
                            }
                            frev *= 0.31622776601683794f;
                        }
                    }
                }
            }
            bf16* dst = p.P + (size_t)(mt * 128 + row) * PLD + cb;
#pragma unroll
            for (int q = 0; q < 8; ++q) {
                uint4 pk; pk.x = cvtpk(v[q * 8], v[q * 8 + 1]); pk.y = cvtpk(v[q * 8 + 2], v[q * 8 + 3]); pk.z = cvtpk(v[q * 8 + 4], v[q * 8 + 5]); pk.w = cvtpk(v[q * 8 + 6], v[q * 8 + 7]);
                *(uint4*)(dst + q * 8) = pk;
            }
        }
#else
        ACC_FOR(4, row, col) { p.P[(size_t)(mt * 128 + row) * PLD + nt * 128 + col] = f2bf(AV(acc)); } ACC_END
#endif
    }
}

HD void ph_prep(const Params& p, int l, int bid, int nb) {
#ifdef CPU_EMU
    {
        const float* naq = p.in[I_NAQG] + l * 64; const float* nak = p.in[I_NAKG] + l * 64;
        const float* daq = p.in[I_DAQG] + l * 32; const float* dak = p.in[I_DAKG] + l * 32;
        const int N = R * 24;
        for (int u = bid; u < (N + 255) / 256; u += nb) {
            THREADS(t, 256) {
                int idx = u * 256 + t;
                if (idx < N) {
                    int r = idx / 24, gidx = idx % 24;
                    if (gidx < 8) {
                        int isk = gidx >> 2, hd = gidx & 3;
                        bf16* ptr = p.P + (size_t)r * PLD + (isk ? C_NAK : C_NAQ) + hd * 64;
                        const float* g = isk ? nak : naq;
                        float ss = 0.f;
                        for (int d = 0; d < 64; ++d) { float v = bf2f(ptr[d]); ss += v * v; }
                        float rs = 1.0f / sqrtf(ss / 64.0f + 1e-6f);
#ifndef CPU_EMU
                        if (!isk) rs *= 0.125f * 1.4426950408889634f;
#endif
                        for (int d = 0; d < 64; ++d) ptr[d] = f2bf(bf2f(ptr[d]) * rs * g[d]);
                    } else {
                        int gi = gidx - 8; int isk = gi >> 3; int hm = gi & 7;
                        bf16* ptr = p.P + (size_t)r * PLD + (isk ? C_DAK : C_DAQ) + hm * 32;
                        const float* g = isk ? dak : daq;
                        float ss = 0.f;
                        for (int d = 0; d < 32; ++d) { float v = bf2f(ptr[d]); ss += v * v; }
                        float rs = 1.0f / sqrtf(ss / 32.0f + 1e-6f);
#ifndef CPU_EMU
                        if (!isk) rs *= 0.17677669529663687f * 1.4426950408889634f;
#endif
                        if (r < NLAT) {
                            int tt = r % SEQ; float prow = (float)(tt / GW), pcol = (float)(tt % GW);
                            for (int a = 0; a < 2; ++a) {
                                float pos = a == 0 ? prow : pcol;
                                float fr = 1.0f;
                                for (int f = 0; f < 8; ++f) {
                                    float ang = pos * fr;
                                    float cs = cosf(ang), sn = sinf(ang);
                                    int i1 = a * 16 + f, i2 = a * 16 + 8 + f;
                                    float x1 = bf2f(ptr[i1]) * rs * g[i1], x2 = bf2f(ptr[i2]) * rs * g[i2];
                                    ptr[i1] = f2bf(x1 * cs - x2 * sn);
                                    ptr[i2] = f2bf(x2 * cs + x1 * sn);
                                    fr *= 0.31622776601683794f;
                                }
                            }
                        } else {
                            for (int d = 0; d < 32; ++d) ptr[d] = f2bf(bf2f(ptr[d]) * rs * g[d]);
                        }
                    }
                }
            }
        }
    }
#endif
#ifndef CPU_EMU
    {
        const float* cw = p.in[I_CONVW] + (size_t)l * 5 * 768;
        const int N = R * 96;
        for (int idx = bid * 256 + tid_(); idx < N; idx += nb * 256) {
            const int r = idx / 96, q = idx % 96; const int ph = q >> 3, cg = q & 7; const int part = ph >> 2, hd = ph & 3;
            const RowInfo ri = rowinfo(r);
            const int ch0 = part * 256 + hd * 64 + cg * 8;
            float y[8];
#pragma unroll
            for (int c = 0; c < 8; ++c) y[c] = 0.f;
#pragma unroll
            for (int i = 0; i < 5; ++i) {
                const int tt = ri.t + i - 2;
                if (tt >= 0 && tt < ri.T) {
                    const uint4 raw = *(const uint4*)(p.P + (size_t)(ri.base + tt) * PLD + C_GQ + ch0);
                    const f32x4_t w0 = *(const f32x4_t*)(cw + i * 768 + ch0), w1 = *(const f32x4_t*)(cw + i * 768 + ch0 + 4);
                    y[0] += __uint_as_float(raw.x << 16) * w0[0]; y[1] += __uint_as_float(raw.x & 0xffff0000u) * w0[1];
                    y[2] += __uint_as_float(raw.y << 16) * w0[2]; y[3] += __uint_as_float(raw.y & 0xffff0000u) * w0[3];
                    y[4] += __uint_as_float(raw.z << 16) * w1[0]; y[5] += __uint_as_float(raw.z & 0xffff0000u) * w1[1];
                    y[6] += __uint_as_float(raw.w << 16) * w1[2]; y[7] += __uint_as_float(raw.w & 0xffff0000u) * w1[3];
                }
            }
            float ss = 0.f;
#pragma unroll
            for (int c = 0; c < 8; ++c) { y[c] = siluf_(y[c]); ss += y[c] * y[c]; }
            ss += __shfl_xor(ss, 1); ss += __shfl_xor(ss, 2); ss += __shfl_xor(ss, 4);
            float scl = 1.0f;
            if (part == 0) scl = 0.125f / sqrtf(ss + 1e-6f); else if (part == 1) scl = 1.0f / sqrtf(ss + 1e-6f);
            uint4 pk; pk.x = cvtpk(y[0] * scl, y[1] * scl); pk.y = cvtpk(y[2] * scl, y[3] * scl); pk.z = cvtpk(y[4] * scl, y[5] * scl); pk.w = cvtpk(y[6] * scl, y[7] * scl);
            *(uint4*)(p.gq + (size_t)r * 768 + ch0) = pk;
        }
    }
#else
    {
        const float* cw = p.in[I_CONVW] + (size_t)l * 5 * 768;
        const int N = R * 12;
        for (int u = bid; u < (N + 255) / 256; u += nb) {
            THREADS(t, 256) {
                int idx = u * 256 + t;
                if (idx < N) {
                    int r = idx / 12, ph = idx % 12; int part = ph >> 2, hd = ph & 3;
                    RowInfo ri = rowinfo(r);
                    int ch0 = part * 256 + hd * 64;
                    float ss = 0.f;
                    for (int pass = 0; pass < 2; ++pass) {
                        float scl = 1.0f;
                        if (pass == 1) { if (part == 0) scl = 0.125f / sqrtf(ss + 1e-6f); else if (part == 1) scl = 1.0f / sqrtf(ss + 1e-6f); }
                        if (pass == 0 && part == 2) continue;
                        for (int c = 0; c < 64; ++c) {
                            float y = 0.f;
                            for (int i = 0; i < 5; ++i) {
                                int tt = ri.t + i - 2;
                                if (tt >= 0 && tt < ri.T) y += bf2f(p.P[(size_t)(ri.base + tt) * PLD + C_GQ + ch0 + c]) * cw[i * 768 + ch0 + c];
                            }
                            y = siluf_(y);
                            if (pass == 0) ss += y * y; else p.gq[(size_t)r * 768 + ch0 + c] = f2bf(y * scl);
                        }
                    }
                }
            }
        }
    }
#endif
    {
        const int RQ = (l == 0) ? R : NLAT;
        for (int r = (FOURIER_GEMM ? NLAT : 0) + bid; r < RQ; r += nb) {
            THREADS(t, 256) {
                int g = t >> 6, m = t & 63;
                const bf16* f = p.P + (size_t)r * PLD + C_F + g * 64;
                float fc = 0.f, fs = 0.f;
                for (int c = 0; c < 64; ++c) {
                    int ti = ((m * c) & 63) * (SEQ / 64);
                    float v = bf2f(f[c]);
                    fc += v * p.cosT[ti]; fs += v * p.sinT[ti];
                }
                p.fcs[(size_t)r * 512 + t] = f2bf(fc);
                p.fcs[(size_t)r * 512 + 256 + t] = f2bf(fs);
                if (FOURIER_GEMM && r >= NLAT) {
                    const int rc = r - NLAT; const int bb = rc / CTXL, tt = rc % CTXL;
                    bf16* xc = p.fXC + (((size_t)bb * 256 + t) * 2) * CTXL + tt;
                    xc[0] = f2bf(fc); xc[CTXL] = f2bf(fs);
                }
            }
        }
    }
}

#ifndef CPU_EMU
HD void ph_na(const Params& p, int l, int bid, int nb, char* smc) {
    const int t = tid_(), lane = t & 63, w = t >> 6, fr = lane & 15, fg = lane >> 4;
    const float* rpb = p.in[I_RPB] + (size_t)l * 4 * 15 * 31;
    float* sbias = (float*)(smc + 32768);
    const lds_cptr lds = (lds_cptr)smc;
    constexpr int WH = ROWS < 8 ? ROWS : 8;
    const int nlat = NB * ROWS * 4;
    const int nctx = (l == 0) ? NB * 4 * (CTXL / 64) : 0;
    const int lkey = t >> 3, lc = t & 7;
    const int ksrc = (lc ^ (lkey & 7)) << 3;
    const int vsrc = ((((lc >> 1) ^ ((lkey >> 1) & 3)) << 1) | (lc & 1)) << 3;
    for (int unit = bid; unit < nlat + nctx; unit += nb) {
        int b, hd, qrow, ntl, rs = 0, gr = 0;
        if (unit < nlat) {
            hd = unit & 3; const int br_ = unit >> 2; gr = br_ % ROWS; b = br_ / ROWS;
            qrow = b * SEQ + gr * GW + w * 16 + fr; ntl = WH;
            rs = gr - WH / 2; if (rs < 0) rs = 0; if (rs > ROWS - WH) rs = ROWS - WH;
        } else {
            const int u2 = unit - nlat; const int qt = u2 % (CTXL / 64); const int bh = u2 / (CTXL / 64); hd = bh & 3; b = bh >> 2;
            qrow = NLAT + b * CTXL + qt * 64 + w * 16 + fr; ntl = 0;
        }
        const int ntiles = ntl + NCC;
        const int qcol = w * 16 + fr;
        int cs0 = w * 16 - 8; if (cs0 < 0) cs0 = 0; if (cs0 > GW - 32) cs0 = GW - 32;
        int wsq = qcol - 8; if (wsq < 0) wsq = 0; if (wsq > GW - 16) wsq = GW - 16;
        bf16x8_t qf[2];
#pragma unroll
        for (int s_ = 0; s_ < 2; ++s_) qf[s_] = *(const bf16x8_t*)(p.P + (size_t)qrow * PLD + C_NAQ + hd * 64 + s_ * 32 + fg * 8);
        f32x4_t O[4];
#pragma unroll
        for (int d = 0; d < 4; ++d) O[d] = f32x4_t{0.f, 0.f, 0.f, 0.f};
        float ls = 0.f;
        auto keyrow = [&](int tt, int i) { return (tt < ntl) ? (b * SEQ + (rs + tt) * GW + i) : (NLAT + b * CTXL + (tt - ntl) * 64 + i); };
        char* ldst = smc + w * 1024;
        __syncthreads();
        for (int i = t; i < 15 * 31; i += 256) sbias[i] = rpb[hd * 465 + i] * 1.4426950408889634f;
#pragma unroll
        for (int i = 0; i < 2; ++i) {
            const bf16* src = p.P + (size_t)keyrow(0, lkey + 32 * i) * PLD + hd * 64;
            GLDS16(src + C_NAK + ksrc, ldst + 4096 * i); GLDS16(src + C_NAV + vsrc, ldst + 16384 + 4096 * i);
        }
        WAIT_VM0();
        __syncthreads();
        const int vkl = 4 * fg + (fr >> 2);
        const int vsw = (vkl >> 1) & 3;
        unsigned va[4];
#pragma unroll
        for (int d = 0; d < 4; ++d) va[d] = 16384 + vkl * 128 + ((((d ^ vsw) << 1) | ((fr & 3) >> 1)) << 4) + (fr & 1) * 8;
#pragma unroll 1
        for (int tt = 0; tt < ntiles; ++tt) {
            const int cur = tt & 1;
            if (tt + 1 < ntiles) {
#pragma unroll
                for (int i = 0; i < 2; ++i) {
                    const bf16* src = p.P + (size_t)keyrow(tt + 1, lkey + 32 * i) * PLD + hd * 64;
                    GLDS16(src + C_NAK + ksrc, ldst + (cur ^ 1) * 8192 + 4096 * i); GLDS16(src + C_NAV + vsrc, ldst + 16384 + (cur ^ 1) * 8192 + 4096 * i);
                }
            }
            const char* cK = smc + cur * 8192;
            const lds_cptr cV = lds + cur * 8192;
            const bool local = tt < ntl;
            const int kbase = local ? cs0 : 0;
            const int nkf = local ? 2 : 4;
            unsigned pb[2][4];
#pragma unroll
            for (int f = 0; f < 4; ++f) {
                if (f < nkf) {
                    const int key = kbase + f * 16 + fr;
                    const char* kp = cK + key * 128;
                    const bf16x8_t a0 = *(const bf16x8_t*)(kp + (((fg) ^ (fr & 7)) << 4));
                    const bf16x8_t a1 = *(const bf16x8_t*)(kp + (((4 + fg) ^ (fr & 7)) << 4));
                    f32x4_t S = __builtin_amdgcn_mfma_f32_16x16x32_bf16(a0, qf[0], f32x4_t{0.f, 0.f, 0.f, 0.f}, 0, 0, 0);
                    S = __builtin_amdgcn_mfma_f32_16x16x32_bf16(a1, qf[1], S, 0, 0, 0);
                    float e[4];
#pragma unroll
                    for (int r = 0; r < 4; ++r) {
                        float sv = S[r]; bool ok = true;
                        if (local) {
                            const int kc = kbase + f * 16 + 4 * fg + r;
                            ok = (unsigned)(kc - wsq) < 16u;
                            sv += sbias[((rs + tt) - gr + 7) * 31 + (ok ? (kc - qcol + 15) : 15)];
                        }
                        e[r] = ok ? __builtin_amdgcn_exp2f(sv) : 0.f;
                    }
                    ls += (e[0] + e[1]) + (e[2] + e[3]);
                    pb[f >> 1][(f & 1) * 2] = cvtpk(e[0], e[1]);
                    pb[f >> 1][(f & 1) * 2 + 1] = cvtpk(e[2], e[3]);
                }
            }
#pragma unroll
            for (int ks = 0; ks < 2; ++ks) {
                if (ks * 2 < nkf) {
#pragma unroll
                    for (int d = 0; d < 4; ++d) {
                        const s16x4_t lo = lds_tr16(cV + va[d] + (kbase + ks * 32) * 128);
                        const s16x4_t hi = lds_tr16(cV + va[d] + (kbase + ks * 32 + 16) * 128);
                        const bf16x8_t vf = bf16x8_t{lo[0], lo[1], lo[2], lo[3], hi[0], hi[1], hi[2], hi[3]};
                        const i32x4_t bi = i32x4_t{(int)pb[ks][0], (int)pb[ks][1], (int)pb[ks][2], (int)pb[ks][3]};
                        O[d] = __builtin_amdgcn_mfma_f32_16x16x32_bf16(vf, __builtin_bit_cast(bf16x8_t, bi), O[d], 0, 0, 0);
                    }
                }
            }
            WAIT_VM0();
            __syncthreads();
        }
        ls += __shfl_xor(ls, 16); ls += __shfl_xor(ls, 32);
        const float inv = 1.0f / ls;
        bf16* op = p.br + (size_t)qrow * D + hd * 64;
#pragma unroll
        for (int d = 0; d < 4; ++d) {
            uint2 pk; pk.x = cvtpk(O[d][0] * inv, O[d][1] * inv); pk.y = cvtpk(O[d][2] * inv, O[d][3] * inv);
            *(uint2*)(op + d * 16 + 4 * fg) = pk;
        }
    }
}
#else
HD void ph_na(const Params& p, int l, int bid, int nb, char*) {
    const float* rpb = p.in[I_RPB] + (size_t)l * 4 * 15 * 31;
    const int RQ = (l == 0) ? R : NLAT;
    const int N = RQ * 4;
    const int wh = ROWS < 8 ? ROWS : 8;
    for (int u = bid; u < (N + 255) / 256; u += nb) {
        THREADS(t, 256) {
            int idx = u * 256 + t;
            if (idx < N) {
                int hd = idx / RQ, r = idx % RQ;
                RowInfo ri = rowinfo(r);
                float q[64], o[64];
                const bf16* qp = p.P + (size_t)r * PLD + C_NAQ + hd * 64;
#pragma unroll
                for (int d = 0; d < 64; ++d) { q[d] = bf2f(qp[d]) * 0.125f; o[d] = 0.f; }
                float mx = -1e30f, lsum = 0.f;
                int nloc = 0, rs = 0, ws = 0, gr = 0, gc = 0;
                if (ri.seg == 0) {
                    gr = ri.t / GW; gc = ri.t % GW;
                    rs = gr - wh / 2; if (rs < 0) rs = 0; if (rs > ROWS - wh) rs = ROWS - wh;
                    ws = gc - 8; if (ws < 0) ws = 0; if (ws > GW - 16) ws = GW - 16;
                    nloc = wh * 16;
                }
                int ctxbase = NLAT + ri.b * CTXL;
                for (int kk = 0; kk < nloc + CTXL; ++kk) {
                    int kr; float bias = 0.f;
                    if (kk < nloc) {
                        int a = kk >> 4, c = kk & 15;
                        int krow = rs + a, kcol = ws + c;
                        kr = ri.base + krow * GW + kcol;
                        bias = rpb[(hd * 15 + (krow - gr + 7)) * 31 + (kcol - gc + 15)];
                    } else kr = ctxbase + (kk - nloc);
                    const bf16* kp = p.P + (size_t)kr * PLD + C_NAK + hd * 64;
                    float s = 0.f;
#pragma unroll
                    for (int d = 0; d < 64; ++d) s += q[d] * bf2f(kp[d]);
                    s += bias;
                    if (s > mx) { float f = expf(mx - s); lsum *= f;
#pragma unroll
                        for (int d = 0; d < 64; ++d) o[d] *= f;
                        mx = s; }
                    float e = expf(s - mx);
                    lsum += e;
                    const bf16* vp = p.P + (size_t)kr * PLD + C_NAV + hd * 64;
#pragma unroll
                    for (int d = 0; d < 64; ++d) o[d] += e * bf2f(vp[d]);
                }
                float inv = 1.0f / lsum;
                bf16* op = p.br + (size_t)r * D + hd * 64;
#pragma unroll
                for (int d = 0; d < 64; ++d) op[d] = f2bf(o[d] * inv);
            }
        }
    }
}

#endif

#ifndef CPU_EMU
HD void ph_da(const Params& p, int l, int bid, int nb, char* smc) {
    const int t = tid_(), lane = t & 63, w = t >> 6, fr = lane & 15, fg = lane >> 4;
    const float lam_init = lam_init_of(l);
    float s1 = 0.f, s2 = 0.f;
    for (int d = 0; d < 32; ++d) {
        s1 += p.in[I_LQ1][l * 32 + d] * p.in[I_LK1][l * 32 + d];
        s2 += p.in[I_LQ2][l * 32 + d] * p.in[I_LK2][l * 32 + d];
    }
    const float lam = expf(s1) - expf(s2) + lam_init;
    const float* sg = p.in[I_SUBLN] + l * 64;
    constexpr int NQT = SEQ / 128, NQC = CTXL / 128;
    const int nlat = NB * 4 * NQT;
    const int nctx = (l == 0) ? NB * 4 * NQC : 0;
    const lds_cptr lds = (lds_cptr)smc;
    for (int unit = bid; unit < nlat + nctx; unit += nb) {
        int b, hd, qrow0, kt0;
        if (unit < nlat) { const int qt = unit % NQT, bh = unit / NQT; hd = bh & 3; b = bh >> 2; qrow0 = b * SEQ + qt * 128; kt0 = 0; }
        else { const int u2 = unit - nlat; const int qt = u2 % NQC, bh = u2 / NQC; hd = bh & 3; b = bh >> 2; qrow0 = NLAT + b * CTXL + qt * 128; kt0 = NCL; }
        const int kt1 = NCL + NCC;
        bf16x8_t qf[2][2];
#pragma unroll
        for (int m = 0; m < 2; ++m)
#pragma unroll
            for (int n = 0; n < 2; ++n)
                qf[m][n] = *(const bf16x8_t*)(p.P + (size_t)(qrow0 + w * 32 + n * 16 + fr) * PLD + C_DAQ + hd * 64 + m * 32 + fg * 8);
        f32x4_t O[2][4][2];
#pragma unroll
        for (int m = 0; m < 2; ++m)
#pragma unroll
            for (int d = 0; d < 4; ++d)
#pragma unroll
                for (int n = 0; n < 2; ++n) O[m][d][n] = f32x4_t{0.f, 0.f, 0.f, 0.f};
        float ls[2][2] = {{0.f, 0.f}, {0.f, 0.f}};
        const int lkey = t >> 3, lc = t & 7;
        const int ksrc = (lc ^ (lkey & 7)) << 3;
        const int vsrc = ((((lc >> 1) ^ ((lkey >> 1) & 3)) << 1) | (lc & 1)) << 3;
        auto keyrow = [&](int kt, int i) { return (kt < NCL) ? (b * SEQ + kt * 64 + i) : (NLAT + b * CTXL + (kt - NCL) * 64 + i); };
        char* ldst = smc + w * 1024;
        __syncthreads();
#pragma unroll
        for (int i = 0; i < 2; ++i) {
            const bf16* src = p.P + (size_t)keyrow(kt0, lkey + 32 * i) * PLD + hd * 64;
            GLDS16(src + C_DAK + ksrc, ldst + 4096 * i); GLDS16(src + C_DAV + vsrc, ldst + 16384 + 4096 * i);
        }
        WAIT_VM0();
        __syncthreads();
        const unsigned ka0 = fr * 128 + (((fg) ^ (fr & 7)) << 4);
        const unsigned ka1 = fr * 128 + (((4 + fg) ^ (fr & 7)) << 4);
        const int vkey = 4 * fg + (fr >> 2);
        const int vsw = (vkey >> 1) & 3;
        unsigned va[4];
#pragma unroll
        for (int d = 0; d < 4; ++d) va[d] = 16384 + vkey * 128 + ((((d ^ vsw) << 1) | ((fr & 3) >> 1)) << 4) + (fr & 1) * 8;
#pragma unroll 1
        for (int kt = kt0; kt < kt1; ++kt) {
            const int cur = (kt - kt0) & 1;
            if (kt + 1 < kt1) {
#pragma unroll
                for (int i = 0; i < 2; ++i) {
                    const bf16* src = p.P + (size_t)keyrow(kt + 1, lkey + 32 * i) * PLD + hd * 64;
                    GLDS16(src + C_DAK + ksrc, ldst + (cur ^ 1) * 8192 + 4096 * i); GLDS16(src + C_DAV + vsrc, ldst + 16384 + (cur ^ 1) * 8192 + 4096 * i);
                }
            }
            const char* cK = smc + cur * 8192;
            const lds_cptr cV = lds + cur * 8192;
#pragma unroll
            for (int m = 0; m < 2; ++m) {
                unsigned pb[2][2][4];
                {
                    f32x4_t S[4][2];
#pragma unroll
                    for (int kf = 0; kf < 4; ++kf) {
                        const bf16x8_t a = *(const bf16x8_t*)(cK + (m ? ka1 : ka0) + kf * 2048);
#pragma unroll
                        for (int n = 0; n < 2; ++n) S[kf][n] = __builtin_amdgcn_mfma_f32_16x16x32_bf16(a, qf[m][n], f32x4_t{0.f, 0.f, 0.f, 0.f}, 0, 0, 0);
                    }
#pragma unroll
                    for (int kf = 0; kf < 4; ++kf)
#pragma unroll
                        for (int n = 0; n < 2; ++n) {
                            const float e0 = __builtin_amdgcn_exp2f(S[kf][n][0]), e1 = __builtin_amdgcn_exp2f(S[kf][n][1]);
                            const float e2 = __builtin_amdgcn_exp2f(S[kf][n][2]), e3 = __builtin_amdgcn_exp2f(S[kf][n][3]);
                            ls[m][n] += (e0 + e1) + (e2 + e3);
                            pb[n][kf >> 1][(kf & 1) * 2] = cvtpk(e0, e1);
                            pb[n][kf >> 1][(kf & 1) * 2 + 1] = cvtpk(e2, e3);
                        }
                }
#pragma unroll
                for (int ks = 0; ks < 2; ++ks)
#pragma unroll
                    for (int d = 0; d < 4; ++d) {
                        const s16x4_t lo = lds_tr16(cV + va[d] + ks * 4096);
                        const s16x4_t hi = lds_tr16(cV + va[d] + ks * 4096 + 2048);
                        const bf16x8_t vf = bf16x8_t{lo[0], lo[1], lo[2], lo[3], hi[0], hi[1], hi[2], hi[3]};
#pragma unroll
                        for (int n = 0; n < 2; ++n) {
                            const i32x4_t bi = i32x4_t{(int)pb[n][ks][0], (int)pb[n][ks][1], (int)pb[n][ks][2], (int)pb[n][ks][3]};
                            O[m][d][n] = __builtin_amdgcn_mfma_f32_16x16x32_bf16(vf, __builtin_bit_cast(bf16x8_t, bi), O[m][d][n], 0, 0, 0);
                        }
                    }
                asm volatile("" ::: "memory");
            }
            WAIT_VM0();
            __syncthreads();
        }
#pragma unroll
        for (int n = 0; n < 2; ++n) {
            float l0 = ls[0][n], l1 = ls[1][n];
            l0 += __shfl_xor(l0, 16); l0 += __shfl_xor(l0, 32);
            l1 += __shfl_xor(l1, 16); l1 += __shfl_xor(l1, 32);
            const float i0 = 1.0f / l0, i1 = lam / l1;
            float ss = 0.f;
#pragma unroll
            for (int d = 0; d < 4; ++d)
#pragma unroll
                for (int r = 0; r < 4; ++r) { const float o = O[0][d][n][r] * i0 - O[1][d][n][r] * i1; O[0][d][n][r] = o; ss += o * o; }
            ss += __shfl_xor(ss, 16); ss += __shfl_xor(ss, 32);
            const float rs = (1.0f - lam_init) / sqrtf(ss / 64.0f + 1e-6f);
            bf16* op = p.br + (size_t)(qrow0 + w * 32 + n * 16 + fr) * D + 256 + hd * 64;
#pragma unroll
            for (int d = 0; d < 4; ++d) {
                const int dv = d * 16 + 4 * fg;
                const unsigned lo = cvtpk(O[0][d][n][0] * rs * sg[dv], O[0][d][n][1] * rs * sg[dv + 1]);
                const unsigned hi = cvtpk(O[0][d][n][2] * rs * sg[dv + 2], O[0][d][n][3] * rs * sg[dv + 3]);
                uint2 pk; pk.x = lo; pk.y = hi;
                *(uint2*)(op + dv) = pk;
            }
        }
    }
}
#else
HD void ph_da(const Params& p, int l, int bid, int nb, char*) {
    const int RQ = (l == 0) ? R : NLAT;
    const int N = RQ * 4;
    const float lam_init = lam_init_of(l);
    float s1 = 0.f, s2 = 0.f;
    for (int d = 0; d < 32; ++d) {
        s1 += p.in[I_LQ1][l * 32 + d] * p.in[I_LK1][l * 32 + d];
        s2 += p.in[I_LQ2][l * 32 + d] * p.in[I_LK2][l * 32 + d];
    }
    const float lam = expf(s1) - expf(s2) + lam_init;
    const float* sg = p.in[I_SUBLN] + l * 64;
    const float scale = 0.17677669529663687f;
    for (int u = bid; u < (N + 255) / 256; u += nb) {
        THREADS(t, 256) {
            int idx = u * 256 + t;
            if (idx < N) {
                int hd = idx / RQ, r = idx % RQ;
                RowInfo ri = rowinfo(r);
                float q0[32], q1[32], o0[64], o1[64];
                const bf16* qp = p.P + (size_t)r * PLD + C_DAQ + hd * 64;
#pragma unroll
                for (int d = 0; d < 32; ++d) { q0[d] = bf2f(qp[d]) * scale; q1[d] = bf2f(qp[32 + d]) * scale; }
#pragma unroll
                for (int d = 0; d < 64; ++d) { o0[d] = 0.f; o1[d] = 0.f; }
                float m0 = -1e30f, m1 = -1e30f, l0 = 0.f, l1 = 0.f;
                int nlat = (ri.seg == 0) ? SEQ : 0;
                int latbase = ri.b * SEQ, ctxbase = NLAT + ri.b * CTXL;
                for (int kk = 0; kk < nlat + CTXL; ++kk) {
                    int kr = (kk < nlat) ? latbase + kk : ctxbase + (kk - nlat);
                    const bf16* kp = p.P + (size_t)kr * PLD + C_DAK + hd * 64;
                    const bf16* vp = p.P + (size_t)kr * PLD + C_DAV + hd * 64;
                    float sa = 0.f, sb = 0.f;
#pragma unroll
                    for (int d = 0; d < 32; ++d) { sa += q0[d] * bf2f(kp[d]); sb += q1[d] * bf2f(kp[32 + d]); }
                    if (sa > m0) { float f = expf(m0 - sa); l0 *= f;
#pragma unroll
                        for (int d = 0; d < 64; ++d) o0[d] *= f;
                        m0 = sa; }
                    if (sb > m1) { float f = expf(m1 - sb); l1 *= f;
#pragma unroll
                        for (int d = 0; d < 64; ++d) o1[d] *= f;
                        m1 = sb; }
                    float ea = expf(sa - m0), eb = expf(sb - m1);
                    l0 += ea; l1 += eb;
#pragma unroll
                    for (int d = 0; d < 64; ++d) { float v = bf2f(vp[d]); o0[d] += ea * v; o1[d] += eb * v; }
                }
                float i0 = 1.0f / l0, i1 = lam / l1;
                float ss = 0.f;
#pragma unroll
                for (int d = 0; d < 64; ++d) { o0[d] = o0[d] * i0 - o1[d] * i1; ss += o0[d] * o0[d]; }
                float rs = (1.0f - lam_init) / sqrtf(ss / 64.0f + 1e-6f);
                bf16* op = p.br + (size_t)r * D + 256 + hd * 64;
#pragma unroll
                for (int d = 0; d < 64; ++d) op[d] = f2bf(o0[d] * rs * sg[d]);
            }
        }
    }
}

#endif

struct ChunkInfo { int dir, b, hd, n, seg, T, base, nloc; };
HD ChunkInfo chunkinfo(int unit) {
    ChunkInfo c;
    c.n = unit % NCH; int ch = unit / NCH; c.hd = ch & 3; c.b = (ch >> 2) % NB; c.dir = ch / (4 * NB);
    if (c.n < NCC) { c.seg = 1; c.T = CTXL; c.base = NLAT + c.b * CTXL; c.nloc = c.n; }
    else { c.seg = 0; c.T = SEQ; c.base = c.b * SEQ; c.nloc = c.n - NCC; }
    return c;
}
HD int chunk_row(const ChunkInfo& c, int i) { int pf = c.nloc * 64 + i; return c.base + (c.dir ? (c.T - 1 - pf) : pf); }

#ifndef CPU_EMU
HD void ph_gdn_chunk(const Params& p, int l, int bid, int nb, float* smf) {
    char* smc = (char*)smf;
    const int t = tid_(), lane = t & 63, w = t >> 6, fr = lane & 15, fg = lane >> 4;
    float* sA = (float*)(smc + 24576); float* sG = (float*)(smc + 40960); float* sB = (float*)(smc + 41216);
    const int lkey = t >> 3, lc = t & 7;
    const int ksrc = (lc ^ (lkey & 7)) << 3;
    char* ldst = smc + w * 1024;
    for (int unit = bid; unit < NUNIT; unit += nb) {
        const ChunkInfo c = chunkinfo(unit);
        const int dh = c.dir * 4 + c.hd;
        __syncthreads();
#pragma unroll
        for (int i = 0; i < 2; ++i) {
            const bf16* src = p.gq + (size_t)chunk_row(c, lkey + 32 * i) * 768 + c.hd * 64;
            GLDS16(src + 256 + ksrc, ldst + 4096 * i);
            GLDS16(src + ksrc, ldst + 8192 + 4096 * i);
            GLDS16(src + 512 + lc * 8, ldst + 16384 + 4096 * i);
        }
        if (w == 0) {
            const int row = chunk_row(c, lane);
            float x = p.gg[(size_t)dh * R + row];
#pragma unroll
            for (int off = 1; off < 64; off <<= 1) { const float y = __shfl_up(x, off); if (lane >= off) x += y; }
            sG[lane] = x; sB[lane] = p.gbeta[(size_t)dh * R + row];
            const float x63 = __shfl(x, 63);
            float* cg = p.cG + (size_t)unit * 192;
            cg[lane] = __expf(x); cg[64 + lane] = __expf(x63 - x); cg[128 + lane] = __expf(x63);
        }
        WAIT_VM0();
        __syncthreads();
        {
            const char* kt_ = smc; const char* qt_ = smc + 8192;
            const unsigned ro = (16 * w + fr) * 128;
            const unsigned c0 = ((fg) ^ (fr & 7)) << 4, c1 = ((4 + fg) ^ (fr & 7)) << 4;
            const bf16x8_t ak0 = *(const bf16x8_t*)(kt_ + ro + c0), ak1 = *(const bf16x8_t*)(kt_ + ro + c1);
            const bf16x8_t aq0 = *(const bf16x8_t*)(qt_ + ro + c0), aq1 = *(const bf16x8_t*)(qt_ + ro + c1);
            float gi[4], bi[4];
#pragma unroll
            for (int r = 0; r < 4; ++r) { gi[r] = sG[16 * w + 4 * fg + r]; bi[r] = sB[16 * w + 4 * fg + r]; }
#pragma unroll
            for (int n = 0; n < 4; ++n) {
                const unsigned rb = (16 * n + fr) * 128;
                const bf16x8_t b0 = *(const bf16x8_t*)(kt_ + rb + c0), b1 = *(const bf16x8_t*)(kt_ + rb + c1);
                f32x4_t kk = __builtin_amdgcn_mfma_f32_16x16x32_bf16(ak0, b0, f32x4_t{0.f, 0.f, 0.f, 0.f}, 0, 0, 0);
                kk = __builtin_amdgcn_mfma_f32_16x16x32_bf16(ak1, b1, kk, 0, 0, 0);
                f32x4_t qk = __builtin_amdgcn_mfma_f32_16x16x32_bf16(aq0, b0, f32x4_t{0.f, 0.f, 0.f, 0.f}, 0, 0, 0);
                qk = __builtin_amdgcn_mfma_f32_16x16x32_bf16(aq1, b1, qk, 0, 0, 0);
                const int j = 16 * n + fr; const float gj = sG[j];
#pragma unroll
                for (int r = 0; r < 4; ++r) {
                    const int i = 16 * w + 4 * fg + r;
                    const float dec = (j <= i) ? __expf(gi[r] - gj) : 0.f;
                    sA[i * 64 + j] = (j < i) ? kk[r] * bi[r] * dec : 0.f;
                    p.cQK[(size_t)unit * 4096 + i * 64 + j] = f2bf(qk[r] * dec);
                }
            }
        }
        __syncthreads();
        if (w < 2) {
            float x[64];
            bf16* dst = (w == 0 ? p.cU : p.cW) + (size_t)unit * 4096 + lane;
#pragma unroll
            for (int i = 0; i < 64; ++i) {
                float rhs;
                if (w == 0) rhs = sB[i] * bf2f(*(const bf16*)(smc + 16384 + i * 128 + lane * 2));
                else rhs = sB[i] * __expf(sG[i]) * bf2f(*(const bf16*)(smc + i * 128 + ((((lane >> 3) ^ (i & 7))) << 4) + (lane & 7) * 2));
                float acc = rhs;
#pragma unroll
                for (int j4 = 0; j4 < i; j4 += 4) {
                    const f32x4_t a4 = *(const f32x4_t*)(sA + i * 64 + j4);
                    acc -= a4[0] * x[j4];
                    if (j4 + 1 < i) acc -= a4[1] * x[j4 + 1];
                    if (j4 + 2 < i) acc -= a4[2] * x[j4 + 2];
                    if (j4 + 3 < i) acc -= a4[3] * x[j4 + 3];
                }
                x[i] = acc;
                dst[i * 64] = f2bf(acc);
            }
        }
    }
}
#else
HD void ph_gdn_chunk(const Params& p, int l, int bid, int nb, float* sm) {
    float* sk = sm;
    float* sq = sm + 4096;
    float* sA = sm + 8192;
    float* sXu = sm + 12288;
    float* sXw = sm + 4096;
    float* sG = sm + 16384;
    float* sB = sm + 16448;
    for (int unit = bid; unit < NUNIT; unit += nb) {
        ChunkInfo c = chunkinfo(unit);
        int dh = c.dir * 4 + c.hd;
        THREADS(t, 4096) {
            int i = t >> 6, d = t & 63; int row = chunk_row(c, i);
            sq[t] = bf2f(p.gq[(size_t)row * 768 + c.hd * 64 + d]);
            sk[t] = bf2f(p.gq[(size_t)row * 768 + 256 + c.hd * 64 + d]);
        }
        THREADS(t, 1) {
            float acc = 0.f;
            for (int i = 0; i < 64; ++i) { int row = chunk_row(c, i); acc += p.gg[(size_t)dh * R + row]; sG[i] = acc; sB[i] = p.gbeta[(size_t)dh * R + row]; }
        }
        SYNC
        THREADS(t, 4096) {
            int i = t >> 6, j = t & 63;
            float kk = 0.f, qk = 0.f;
            for (int d = 0; d < 64; ++d) { kk += sk[i * 64 + d] * sk[j * 64 + d]; qk += sq[i * 64 + d] * sk[j * 64 + d]; }
            float dec = (j <= i) ? expf(sG[i] - sG[j]) : 0.f;
            sA[t] = (j < i) ? kk * sB[i] * dec : 0.f;
            p.cQK[(size_t)unit * 4096 + t] = f2bf(qk * dec);
        }
        SYNC
        THREADS(t, 4096) {
            int i = t >> 6, cc = t & 63; int row = chunk_row(c, i);
            sXu[t] = sB[i] * bf2f(p.gq[(size_t)row * 768 + 512 + c.hd * 64 + cc]);
            sXw[t] = sB[i] * expf(sG[i]) * sk[t];
        }
        SYNC
        for (int i = 1; i < 64; ++i) {
            THREADS(cc, 128) {
                float* X = (cc < 64) ? (sXu + cc) : (sXw + cc - 64);
                float acc = X[i * 64];
                for (int j = 0; j < i; ++j) acc -= sA[i * 64 + j] * X[j * 64];
                X[i * 64] = acc;
            }
            SYNC
        }
        THREADS(t, 4096) {
            p.cU[(size_t)unit * 4096 + t] = f2bf(sXu[t]);
            p.cW[(size_t)unit * 4096 + t] = f2bf(sXw[t]);
        }
        THREADS(t, 64) { p.cG[(size_t)unit * 64 + t] = sG[t]; }
        SYNC
    }
}

#endif

HD void ph_fourier2(const Params& p, int l, int bid, int nb) {
    const int RQ = (l == 0) ? R : NLAT;
    for (int r = (FOURIER_GEMM ? NLAT : 0) + bid; r < RQ; r += nb) {
        RowInfo ri = rowinfo(r);
        const float nrm = 1.0f / sqrtf((float)ri.T * 64.0f);
        const int mul = SEQ / ri.T;
        THREADS(ch, 256) {
            float acc = 0.f;
            for (int tt = 0; tt < ri.T; ++tt) {
                int ti = ((ri.t * tt) & (ri.T - 1)) * mul;
                const bf16* f = p.fcs + (size_t)(ri.base + tt) * 512;
                acc += p.cosT[ti] * bf2f(f[ch]) - p.sinT[ti] * bf2f(f[256 + ch]);
            }
            p.br[(size_t)r * D + 768 + ch] = f2bf(acc * nrm);
        }
    }
}


HD void ph_fourier_s1(const Params& p, int bid, int nb, char* smc) {
    for (int tile = bid; tile < NB * 64 * 4; tile += nb) {
        const int g = tile & 3, t2 = (tile >> 2) & 63, b = tile >> 8;
        ACC_DECL(4, acc); acc_zero(acc);
        gemm_accum<4>(acc, [&](int i) { return p.P + (size_t)(b * SEQ + 64 * i + t2) * PLD + C_F + g * 64; },
                      [&](int j) { return p.fW1 + j * 64; }, 64, smc);
#ifndef CPU_EMU
        {
            float* tl = (float*)smc;
            acc_to_lds<4>(acc, tl);
            __syncthreads();
            const int t_ = tid_(); const int col = t_ >> 1, half = t_ & 1;
            const int cs = col >> 6, m = col & 63;
            bf16* dst = p.fcs + ((((size_t)b * 256 + g * 64 + m) * 64 + t2) * 2 + cs) * 128 + half * 64;
#pragma unroll
            for (int q = 0; q < 8; ++q) {
                float v[8];
#pragma unroll
                for (int e = 0; e < 8; ++e) v[e] = tl[(half * 64 + q * 8 + e) * 132 + col];
                uint4 pk; pk.x = cvtpk(v[0], v[1]); pk.y = cvtpk(v[2], v[3]); pk.z = cvtpk(v[4], v[5]); pk.w = cvtpk(v[6], v[7]);
                *(uint4*)(dst + q * 8) = pk;
            }
        }
#else
        ACC_FOR(4, row, col) {
            const int cs = col >> 6, m = col & 63;
            p.fcs[((((size_t)b * 256 + g * 64 + m) * 64 + t2) * 2 + cs) * 128 + row] = f2bf(AV(acc));
        } ACC_END
#endif
    }
}
HD void ph_fourier_sA(const Params& p, int bid, int nb, char* smc) {
    for (int tile = bid; tile < NB * 128 * 2; tile += nb) {
        const int nt = tile & 1, mt = (tile >> 1) & 127, b = tile >> 8;
        ACC_DECL(4, acc); acc_zero(acc);
        gemm_accum<4>(acc, [&](int i) { return p.fcs + ((size_t)b * 16384 + mt * 128 + i) * 256; },
                      [&](int j) { return p.fWA + (size_t)(nt * 128 + j) * 256; }, 256, smc);
#ifndef CPU_EMU
        {
            float* tl = (float*)smc;
            acc_to_lds<4>(acc, tl);
            __syncthreads();
            const int t_ = tid_(); const int pcol = t_ >> 2, chl = (t_ >> 1) & 1, th = t_ & 1;
            const int k1 = nt * 64 + pcol; const int ch = mt * 2 + chl;
            const int cre = (pcol >> 4) * 32 + (pcol & 15), cim = cre + 16;
            bf16* o = p.fa2 + ((((size_t)b * 128 + k1) * 256 + ch) * 2) * 64 + th * 32;
#pragma unroll
            for (int q = 0; q < 4; ++q) {
                float vr[8], vi[8];
#pragma unroll
                for (int e = 0; e < 8; ++e) {
                    const int t2 = th * 32 + q * 8 + e;
                    const float re = tl[(chl * 64 + t2) * 132 + cre], im = tl[(chl * 64 + t2) * 132 + cim];
                    const float c = p.cosT[k1 * t2], sn = p.sinT[k1 * t2];
                    vr[e] = re * c + im * sn; vi[e] = im * c - re * sn;
                }
                uint4 pr, pi;
                pr.x = cvtpk(vr[0], vr[1]); pr.y = cvtpk(vr[2], vr[3]); pr.z = cvtpk(vr[4], vr[5]); pr.w = cvtpk(vr[6], vr[7]);
                pi.x = cvtpk(vi[0], vi[1]); pi.y = cvtpk(vi[2], vi[3]); pi.z = cvtpk(vi[4], vi[5]); pi.w = cvtpk(vi[6], vi[7]);
                *(uint4*)(o + q * 8) = pr; *(uint4*)(o + 64 + q * 8) = pi;
            }
        }
#else
        ACC_FOR_PAIR(row, pcol) {
            const int k1 = nt * 64 + pcol; const int rr = mt * 128 + row; const int ch = rr >> 6, t2 = rr & 63;
            const float re = AV_G(acc), im = AV_U(acc);
            const float c = p.cosT[k1 * t2], sn = p.sinT[k1 * t2];
            bf16* o = p.fa2 + ((((size_t)b * 128 + k1) * 256 + ch) * 2) * 64 + t2;
            o[0] = f2bf(re * c + im * sn); o[64] = f2bf(im * c - re * sn);
        } ACC_END
#endif
    }
}
HD void ph_fourier_sB(const Params& p, int bid, int nb, char* smc) {
    const float nrm = 1.0f / sqrtf((float)SEQ * 64.0f);
    for (int tile = bid; tile < NB * 128 * 2; tile += nb) {
        const int cht = tile & 1, k1 = (tile >> 1) & 127, b = tile >> 8;
        ACC_DECL(2, acc); acc_zero(acc);
        gemm_accum<2>(acc, [&](int i) { return p.fa2 + (((size_t)b * 128 + k1) * 256 + cht * 128 + i) * 128; },
                      [&](int j) { return p.fWB + j * 128; }, 128, smc);
        ACC_FOR(2, row, col) {
            p.br[(size_t)(b * SEQ + k1 + 128 * col) * D + 768 + cht * 128 + row] = f2bf(AV(acc) * nrm);
        } ACC_END
    }
}


HD void ph_fourier_ctx(const Params& p, int bid, int nb, char* smc) {
    static_assert(CTXL % 128 == 0 || !FOURIER_GEMM, "context DFT GEMM needs CTXL % 128 == 0");
    const float nrm = 1.0f / sqrtf((float)CTXL * 64.0f);
    constexpr int MTc = CTXL / 128;
    for (int tile = bid; tile < NB * MTc * 2; tile += nb) {
        const int nt = tile & 1, mt = (tile >> 1) % MTc, b = tile / (2 * MTc);
        ACC_DECL(4, acc); acc_zero(acc);
        gemm_accum<4>(acc, [&](int i) { return p.fWC + (size_t)(mt * 128 + i) * (2 * CTXL); },
                      [&](int j) { return p.fXC + ((size_t)b * 256 + nt * 128 + j) * (2 * CTXL); }, 2 * CTXL, smc);
        ACC_FOR(4, row, col) { p.br[(size_t)(NLAT + b * CTXL + mt * 128 + row) * D + 768 + nt * 128 + col] = f2bf(AV(acc) * nrm); } ACC_END
    }
}
#ifndef CPU_EMU
struct ScanRegs { i32x4_t W[2], k[2]; unsigned u[4]; float g; };
HD bf16* scan_sp(const Params& p) { return p.h; }
HD bf16* scan_vn(const Params& p) { return p.h + (size_t)NUNIT * 4096; }
HD void ph_gdn_scan(const Params& p, int l, int bid, int nb, float* smf) {
    static_assert(NCH % 3 == 0, "scan ring assumes the chunk count is a multiple of 3");
    char* smc = (char*)smf;
    const int t = tid_(), lane = t & 63, w = t >> 6, fr = lane & 15, fg = lane >> 4;
    char* sST = smc + 24576; char* sVT = smc + 26624; char* sVS = smc + 28672; float* sG = (float*)(smc + 30720);
    const lds_cptr lds = (lds_cptr)smc;
    const int lkey = t >> 3, lc = t & 7;
    for (int cu = bid; cu < 2 * NB * 4 * 4; cu += nb) {
        const int chain = cu >> 2, cb = cu & 3;
        const ChunkInfo c0 = chunkinfo(chain * NCH);
        const int hd = c0.hd;
        auto issue = [&](ScanRegs& Rg, int n) {
            const int unit = chain * NCH + n;
            const ChunkInfo c = chunkinfo(unit);
            const bf16* wsrc = p.cW + (size_t)unit * 4096 + (16 * w + fr) * 64 + 8 * fg;
#pragma unroll
            for (int s_ = 0; s_ < 2; ++s_) {
                Rg.W[s_] = *(const i32x4_t*)(wsrc + 32 * s_);
                Rg.k[s_] = *(const i32x4_t*)(p.gq + (size_t)chunk_row(c, lkey + 32 * s_) * 768 + 256 + hd * 64 + lc * 8);
            }
#pragma unroll
            for (int r = 0; r < 4; ++r) Rg.u[r] = p.cU[(size_t)unit * 4096 + (16 * w + 4 * fg + r) * 64 + cb * 16 + fr];
            Rg.g = p.cG[(size_t)unit * 192 + (t < 192 ? t : 191)];
        };
        auto put_k = [&](const ScanRegs& Rg, int buf) {
#pragma unroll
            for (int s_ = 0; s_ < 2; ++s_) {
                const int ci = lkey + 32 * s_;
                const int fsw = ((ci >> 1) & 1) | (((ci >> 3) & 1) << 1);
                *(i32x4_t*)(smc + buf * 8192 + ci * 128 + (((((lc >> 1) ^ fsw) << 1) | (lc & 1)) << 4)) = Rg.k[s_];
            }
            if (t < 192) sG[buf * 192 + t] = Rg.g;
        };
        const int xe = (t >> 3) & 15, xc = (t & 7) ^ (xe & 7);
        const unsigned xsrc = xe * 128 + ((t & 7) << 4);
        const size_t xdst = (size_t)(cb * 16 + xe) * 64 + xc * 8;
        const unsigned c0o = ((fg) ^ (fr & 7)) << 4, c1o = ((4 + fg) ^ (fr & 7)) << 4;
        const unsigned bo0 = fr * 128 + c0o, bo1 = fr * 128 + c1o;
        const unsigned wofs = fr * 128 + ((((2 * w + (fg >> 1)) ^ (fr & 7))) << 4) + (fg & 1) * 8;
        unsigned ka[2][2];
#pragma unroll
        for (int s_ = 0; s_ < 2; ++s_)
#pragma unroll
            for (int h2 = 0; h2 < 2; ++h2) {
                const int cr = 32 * s_ + 8 * fg + (fr >> 2) + 4 * h2;
                const int fsw = ((cr >> 1) & 1) | (((cr >> 3) & 1) << 1);
                ka[s_][h2] = cr * 128 + (((((w ^ fsw) << 1) | ((fr & 3) >> 1))) << 4) + (fr & 1) * 8;
            }
        f32x4_t S = f32x4_t{0.f, 0.f, 0.f, 0.f};
        ScanRegs R0, R1, R2;
        __syncthreads();
        issue(R0, 0); issue(R1, 1);
        ((unsigned*)sST)[t] = 0u; ((unsigned*)sST)[t + 256] = 0u;
        put_k(R0, 0);
        __syncthreads();
#define SCAN_STEP(Rc, Rn, Rnn, nn, b)                                                                                                        \
        {                                                                                                                                    \
            const int n_ = (nn);                                                                                                             \
            issue(Rnn, (n_ + 2 < NCH) ? n_ + 2 : NCH - 1);                  \
            const float* g = sG + (b) * 192;                                                                                                 \
            const f32x4_t eD = *(const f32x4_t*)(g + 64 + 16 * w + 4 * fg);                                                                  \
            const float e63 = g[128];                                                                                                        \
            const bf16x8_t st0 = *(const bf16x8_t*)(sST + bo0), st1 = *(const bf16x8_t*)(sST + bo1);                                         \
            if (t < 128) *(uint4*)(scan_sp(p) + (size_t)(chain * NCH + n_) * 4096 + xdst) = *(const uint4*)(sST + xsrc);                     \
            f32x4_t v = __builtin_amdgcn_mfma_f32_16x16x32_bf16(__builtin_bit_cast(bf16x8_t, Rc.W[0]), st0, f32x4_t{0.f, 0.f, 0.f, 0.f}, 0, 0, 0); \
            v = __builtin_amdgcn_mfma_f32_16x16x32_bf16(__builtin_bit_cast(bf16x8_t, Rc.W[1]), st1, v, 0, 0, 0);                              \
            float vn[4];                                                                                                                     \
            _Pragma("unroll") for (int r = 0; r < 4; ++r) vn[r] = __uint_as_float(Rc.u[r] << 16) - v[r];                                     \
            { uint2 pk; pk.x = cvtpk(vn[0], vn[1]); pk.y = cvtpk(vn[2], vn[3]); *(uint2*)(sVT + wofs) = pk; }                                \
            { uint2 pk; pk.x = cvtpk(vn[0] * eD[0], vn[1] * eD[1]); pk.y = cvtpk(vn[2] * eD[2], vn[3] * eD[3]); *(uint2*)(sVS + wofs) = pk; }  \
            put_k(Rn, ((b) + 1) % 3);                                                                                                        \
            __syncthreads();                                                                                                                 \
            if (t >= 128) *(uint4*)(scan_vn(p) + (size_t)(chain * NCH + n_) * 4096 + xdst) = *(const uint4*)(sVT + xsrc);                    \
            const bf16x8_t vs0 = *(const bf16x8_t*)(sVS + bo0), vs1 = *(const bf16x8_t*)(sVS + bo1);                                         \
            const lds_cptr kb = lds + (b) * 8192;                                                                                            \
            const s16x4_t a00 = lds_tr16(kb + ka[0][0]), a01 = lds_tr16(kb + ka[0][1]);                                                      \
            const s16x4_t a10 = lds_tr16(kb + ka[1][0]), a11 = lds_tr16(kb + ka[1][1]);                                                      \
            f32x4_t dS = __builtin_amdgcn_mfma_f32_16x16x32_bf16(bf16x8_t{a00[0], a00[1], a00[2], a00[3], a01[0], a01[1], a01[2], a01[3]}, vs0, f32x4_t{0.f, 0.f, 0.f, 0.f}, 0, 0, 0); \
            dS = __builtin_amdgcn_mfma_f32_16x16x32_bf16(bf16x8_t{a10[0], a10[1], a10[2], a10[3], a11[0], a11[1], a11[2], a11[3]}, vs1, dS, 0, 0, 0); \
            _Pragma("unroll") for (int r = 0; r < 4; ++r) S[r] = S[r] * e63 + dS[r];                                                         \
            { uint2 pk; pk.x = cvtpk(S[0], S[1]); pk.y = cvtpk(S[2], S[3]); *(uint2*)(sST + wofs) = pk; }                                    \
            __syncthreads();                                                                                                                 \
        }
#pragma unroll 1
        for (int n = 0; n < NCH; n += 3) {
            SCAN_STEP(R0, R1, R2, n, 0)
            SCAN_STEP(R1, R2, R0, n + 1, 1)
            SCAN_STEP(R2, R0, R1, n + 2, 2)
        }
#undef SCAN_STEP
    }
}
HD void ph_gdn_outfin(const Params& p, int l, int bid, int nb, float* smf) {
    const int t = tid_(), lane = t & 63, w = t >> 6, fr = lane & 15, fg = lane >> 4;
    const float* og = p.in[I_ONORM] + l * 64;
    const int nlat = NB * 4 * NCL, nctx = (l == 0) ? NB * 4 * NCC : 0;
    float* so = smf;
    for (int u = bid; u < nlat + nctx; u += nb) {
        int b, hd, seg, nloc, ncs, T, base;
        if (u < nlat) { nloc = u % NCL; const int bh = u / NCL; hd = bh & 3; b = bh >> 2; seg = 0; ncs = NCL; T = SEQ; base = b * SEQ; }
        else { const int u2 = u - nlat; nloc = u2 % NCC; const int bh = u2 / NCC; hd = bh & 3; b = bh >> 2; seg = 1; ncs = NCC; T = CTXL; base = NLAT + b * CTXL; }
        __syncthreads();
#pragma unroll
        for (int dir = 0; dir < 2; ++dir) {
            const int nl = dir ? (ncs - 1 - nloc) : nloc;
            const int unit = ((dir * NB + b) * 4 + hd) * NCH + (seg ? nl : NCC + nl);
            const int ci = 16 * w + fr;
            const int pf = nl * 64 + ci; const int arow_ = base + (dir ? (T - 1 - pf) : pf);
            bf16x8_t qa[2], ka_[2];
#pragma unroll
            for (int s_ = 0; s_ < 2; ++s_) {
                qa[s_] = *(const bf16x8_t*)(p.gq + (size_t)arow_ * 768 + hd * 64 + 32 * s_ + 8 * fg);
                ka_[s_] = *(const bf16x8_t*)(p.cQK + (size_t)unit * 4096 + ci * 64 + 32 * s_ + 8 * fg);
            }
            const f32x4_t eG = *(const f32x4_t*)(p.cG + (size_t)unit * 192 + 16 * w + 4 * fg);
#pragma unroll
            for (int j = 0; j < 4; ++j) {
                const bf16* spr = scan_sp(p) + (size_t)unit * 4096 + (16 * j + fr) * 64 + 8 * fg;
                const bf16* vnr = scan_vn(p) + (size_t)unit * 4096 + (16 * j + fr) * 64 + 8 * fg;
                f32x4_t o1 = __builtin_amdgcn_mfma_f32_16x16x32_bf16(qa[0], *(const bf16x8_t*)(spr), f32x4_t{0.f, 0.f, 0.f, 0.f}, 0, 0, 0);
                o1 = __builtin_amdgcn_mfma_f32_16x16x32_bf16(qa[1], *(const bf16x8_t*)(spr + 32), o1, 0, 0, 0);
                f32x4_t o2 = __builtin_amdgcn_mfma_f32_16x16x32_bf16(ka_[0], *(const bf16x8_t*)(vnr), f32x4_t{0.f, 0.f, 0.f, 0.f}, 0, 0, 0);
                o2 = __builtin_amdgcn_mfma_f32_16x16x32_bf16(ka_[1], *(const bf16x8_t*)(vnr + 32), o2, 0, 0, 0);
#pragma unroll
                for (int r = 0; r < 4; ++r) {
                    const int cpos = 16 * w + 4 * fg + r;
                    const int tok = dir ? (63 - cpos) : cpos;
                    float* dst = so + tok * 65 + 16 * j + fr;
                    const float val = eG[r] * o1[r] + o2[r];
                    if (dir == 0) *dst = val; else *dst += val;
                }
            }
            __syncthreads();
        }
        {
            const int tok = t >> 2, q4 = t & 3;
            const int row = base + nloc * 64 + tok;
            float v[16]; float ss = 0.f;
#pragma unroll
            for (int c = 0; c < 16; ++c) { v[c] = so[tok * 65 + q4 * 16 + c]; ss += v[c] * v[c]; }
            ss += __shfl_xor(ss, 1); ss += __shfl_xor(ss, 2);
            const float rs = 1.0f / sqrtf(ss / 64.0f + 1e-6f);
            const uint4 z0 = *(const uint4*)(p.P + (size_t)row * PLD + C_Z + hd * 64 + q4 * 16), z1 = *(const uint4*)(p.P + (size_t)row * PLD + C_Z + hd * 64 + q4 * 16 + 8);
            const unsigned zz[8] = {z0.x, z0.y, z0.z, z0.w, z1.x, z1.y, z1.z, z1.w};
            unsigned pk[8];
#pragma unroll
            for (int c2 = 0; c2 < 8; ++c2) {
                const float za = __uint_as_float(zz[c2] << 16), zb = __uint_as_float(zz[c2] & 0xffff0000u);
                const float oa = v[2 * c2] * rs * og[q4 * 16 + 2 * c2] * siluf_(za), ob = v[2 * c2 + 1] * rs * og[q4 * 16 + 2 * c2 + 1] * siluf_(zb);
                pk[c2] = cvtpk(oa, ob);
            }
            uint4 p0, p1; p0.x = pk[0]; p0.y = pk[1]; p0.z = pk[2]; p0.w = pk[3]; p1.x = pk[4]; p1.y = pk[5]; p1.z = pk[6]; p1.w = pk[7];
            bf16* dstb = p.br + (size_t)row * D + 512 + hd * 64 + q4 * 16;
            *(uint4*)dstb = p0; *(uint4*)(dstb + 8) = p1;
        }
    }
}
#else
HD void ph_gdn_scan(const Params& p, int l, int bid, int nb, float* sm) {
    float* sQ = sm;
    float* sK = sm + 4096;
    bf16* sW = (bf16*)(sm + 8192);
    bf16* sQK = (bf16*)(sm + 10240);
    float* sS = sm + 12288;
    float* sV = sm + 13312;
    float* sU = sm + 14336;
    float* sG = sm + 15360;
    const int RQ = (l == 0) ? R : NLAT;
    for (int cu = bid; cu < 2 * NB * 4 * 4; cu += nb) {
        int chain = cu >> 2, cb = cu & 3;
        THREADS(t, 1024) { sS[t] = 0.f; }
        SYNC
        for (int n = 0; n < NCH; ++n) {
            int unit = chain * NCH + n;
            ChunkInfo c = chunkinfo(unit);
            THREADS(t, 64) { sG[t] = p.cG[(size_t)unit * 64 + t]; }
            SYNC
            THREADS(t, 4096) {
                int i = t >> 6, d = t & 63; int row = chunk_row(c, i);
                sW[t] = p.cW[(size_t)unit * 4096 + t];
                sQK[t] = p.cQK[(size_t)unit * 4096 + t];
                sQ[t] = bf2f(p.gq[(size_t)row * 768 + c.hd * 64 + d]) * expf(sG[i]);
                sK[t] = bf2f(p.gq[(size_t)row * 768 + 256 + c.hd * 64 + d]) * expf(sG[63] - sG[i]);
            }
            THREADS(t, 1024) { int i = t >> 4, e = t & 15; sU[t] = bf2f(p.cU[(size_t)unit * 4096 + i * 64 + cb * 16 + e]); }
            SYNC
            THREADS(t, 1024) {
                int i = t >> 4, e = t & 15;
                float acc = sU[t];
                for (int d = 0; d < 64; ++d) acc -= bf2f(sW[i * 64 + d]) * sS[d * 16 + e];
                sV[t] = acc;
            }
            SYNC
            THREADS(t, 1024) {
                int i = t >> 4, e = t & 15;
                float acc = 0.f;
                for (int d = 0; d < 64; ++d) acc += sQ[i * 64 + d] * sS[d * 16 + e];
                for (int j = 0; j < 64; ++j) acc += bf2f(sQK[i * 64 + j]) * sV[j * 16 + e];
                int row = chunk_row(c, i);
                if (row < RQ) p.odir[((size_t)c.dir * R + row) * 256 + c.hd * 64 + cb * 16 + e] = f2bf(acc);
            }
            SYNC
            THREADS(t, 1024) {
                int d = t >> 4, e = t & 15;
                float acc = sS[t] * expf(sG[63]);
                for (int i = 0; i < 64; ++i) acc += sK[i * 64 + d] * sV[i * 16 + e];
                sS[t] = acc;
            }
            SYNC
        }
    }
}

#endif

#ifndef CPU_EMU
HD void ph_gdn_fin(const Params& p, int l, int bid, int nb) {
    const int RQ = (l == 0) ? R : NLAT;
    const float* og = p.in[I_ONORM] + l * 64;
    const int N = RQ * 32;
    for (int idx = bid * 256 + tid_(); idx < N; idx += nb * 256) {
        const int r = idx >> 5, q = idx & 31; const int hd = q >> 3, cg = q & 7;
        const uint4 a0 = *(const uint4*)(p.odir + (size_t)r * 256 + hd * 64 + cg * 8);
        const uint4 a1 = *(const uint4*)(p.odir + ((size_t)R + r) * 256 + hd * 64 + cg * 8);
        const uint4 zz = *(const uint4*)(p.P + (size_t)r * PLD + C_Z + hd * 64 + cg * 8);
        float v[8], z[8];
        v[0] = __uint_as_float(a0.x << 16) + __uint_as_float(a1.x << 16); v[1] = __uint_as_float(a0.x & 0xffff0000u) + __uint_as_float(a1.x & 0xffff0000u);
        v[2] = __uint_as_float(a0.y << 16) + __uint_as_float(a1.y << 16); v[3] = __uint_as_float(a0.y & 0xffff0000u) + __uint_as_float(a1.y & 0xffff0000u);
        v[4] = __uint_as_float(a0.z << 16) + __uint_as_float(a1.z << 16); v[5] = __uint_as_float(a0.z & 0xffff0000u) + __uint_as_float(a1.z & 0xffff0000u);
        v[6] = __uint_as_float(a0.w << 16) + __uint_as_float(a1.w << 16); v[7] = __uint_as_float(a0.w & 0xffff0000u) + __uint_as_float(a1.w & 0xffff0000u);
        z[0] = __uint_as_float(zz.x << 16); z[1] = __uint_as_float(zz.x & 0xffff0000u); z[2] = __uint_as_float(zz.y << 16); z[3] = __uint_as_float(zz.y & 0xffff0000u);
        z[4] = __uint_as_float(zz.z << 16); z[5] = __uint_as_float(zz.z & 0xffff0000u); z[6] = __uint_as_float(zz.w << 16); z[7] = __uint_as_float(zz.w & 0xffff0000u);
        float ss = 0.f;
#pragma unroll
        for (int c = 0; c < 8; ++c) ss += v[c] * v[c];
        ss += __shfl_xor(ss, 1); ss += __shfl_xor(ss, 2); ss += __shfl_xor(ss, 4);
        const float rs = 1.0f / sqrtf(ss / 64.0f + 1e-6f);
        float o[8];
#pragma unroll
        for (int c = 0; c < 8; ++c) o[c] = v[c] * rs * og[cg * 8 + c] * siluf_(z[c]);
        uint4 pk; pk.x = cvtpk(o[0], o[1]); pk.y = cvtpk(o[2], o[3]); pk.z = cvtpk(o[4], o[5]); pk.w = cvtpk(o[6], o[7]);
        *(uint4*)(p.br + (size_t)r * D + 512 + hd * 64 + cg * 8) = pk;
    }
}
#else
HD void ph_gdn_fin(const Params& p, int l, int bid, int nb) {
    const int RQ = (l == 0) ? R : NLAT;
    const float* og = p.in[I_ONORM] + l * 64;
    const int N = RQ * 4;
    for (int u = bid; u < (N + 255) / 256; u += nb) {
        THREADS(t, 256) {
            int idx = u * 256 + t;
            if (idx < N) {
                int r = idx >> 2, hd = idx & 3;
                const bf16* o0 = p.odir + (size_t)r * 256 + hd * 64;
                const bf16* o1 = p.odir + ((size_t)R + r) * 256 + hd * 64;
                float ss = 0.f;
                for (int d = 0; d < 64; ++d) { float v = bf2f(o0[d]) + bf2f(o1[d]); ss += v * v; }
                float rs = 1.0f / sqrtf(ss / 64.0f + 1e-6f);
                for (int d = 0; d < 64; ++d) {
                    float v = (bf2f(o0[d]) + bf2f(o1[d])) * rs * og[d];
                    float z = bf2f(p.P[(size_t)r * PLD + C_Z + hd * 64 + d]);
                    p.br[(size_t)r * D + 512 + hd * 64 + d] = f2bf(v * siluf_(z));
                }
            }
        }
    }
}

#endif

#ifndef CPU_EMU
HD void ph_merge(const Params& p, int l, int bid, int nb, char* smc) {
    const int MT = ((l == 0) ? R : NLAT) / 128;
    const bf16* Wg = p.wt_in + (size_t)l * WIN_NP * D + (size_t)PLD * D;
    const bf16* Wb = p.wt_br + (size_t)l * 4 * D * 256;
    for (int tile = bid; tile < MT * 8; tile += nb) {
        const int mt = tile >> 3, nt = tile & 7;
        AccT<4> accM; acc_zero(accM);
        const unsigned char* h8 = (const unsigned char*)h8_of(p);
        auto aG = [&](int r) { return (const void*)(h8 + (size_t)(mt * 128 + r) * D); };
        int cur = 0;
        __syncthreads();
        gemm_stage0<4>(aG, [&](int j) { return (const void*)((const unsigned char*)Wg + (size_t)(nt * 128 + j) * D); }, 1, smc, 0);
#pragma unroll 1
        for (int i = 0; i < 4; ++i) {
            AccT<4> acc; acc_zero(acc);
            auto bG = [&](int j) { return (const void*)((const unsigned char*)Wg + (size_t)(i * 1024 + nt * 128 + j) * D); };
            auto aP = [&](int r) { return (const void*)(p.br + (size_t)(mt * 128 + r) * D + i * 256); };
            auto bP = [&](int j) { return (const void*)(Wb + ((size_t)i * D + nt * 128 + j) * 256); };
            gemm_chain<4, true>(acc, aG, bG, D, smc, cur, [&](int buf) { gemm_stage0<4>(aP, bP, 2, smc, buf); }, SC_H, SC_W);
            unsigned sg[4][4][2];
#pragma unroll
            for (int a_ = 0; a_ < 4; ++a_)
#pragma unroll
                for (int b_ = 0; b_ < 4; ++b_) {
                    float e[4];
#pragma unroll
                    for (int r = 0; r < 4; ++r) e[r] = __builtin_amdgcn_rcpf(1.0f + __expf(-acc.v[a_][b_][r]));
                    sg[a_][b_][0] = cvtpk(e[0], e[1]); sg[a_][b_][1] = cvtpk(e[2], e[3]);
                }
            acc_zero(acc);
            auto bGn = [&](int j) { return (const void*)((const unsigned char*)Wg + (size_t)((i + 1) * 1024 + nt * 128 + j) * D); };
            gemm_chain<4, false>(acc, aP, bP, 256, smc, cur, [&](int buf) { if (i < 3) gemm_stage0<4>(aG, bGn, 1, smc, buf); }, 0, 0);
#pragma unroll
            for (int a_ = 0; a_ < 4; ++a_)
#pragma unroll
                for (int b_ = 0; b_ < 4; ++b_) {
                    accM.v[a_][b_][0] += __uint_as_float(sg[a_][b_][0] << 16) * acc.v[a_][b_][0];
                    accM.v[a_][b_][1] += __uint_as_float(sg[a_][b_][0] & 0xffff0000u) * acc.v[a_][b_][1];
                    accM.v[a_][b_][2] += __uint_as_float(sg[a_][b_][1] << 16) * acc.v[a_][b_][2];
                    accM.v[a_][b_][3] += __uint_as_float(sg[a_][b_][1] & 0xffff0000u) * acc.v[a_][b_][3];
                }
        }
        __syncthreads();
        float* tl = (float*)smc;
        acc_to_lds<4>(accM, tl);
        __syncthreads();
        const int t_ = tid_(); const int row = t_ >> 1, half = t_ & 1;
        bf16* dst = p.mg + (size_t)(mt * 128 + row) * D + nt * 128 + half * 64;
#pragma unroll
        for (int q = 0; q < 8; ++q) {
            const f32x4_t a = *(const f32x4_t*)(tl + row * 132 + half * 64 + q * 8), b = *(const f32x4_t*)(tl + row * 132 + half * 64 + q * 8 + 4);
            uint4 pk; pk.x = cvtpk(a[0], a[1]); pk.y = cvtpk(a[2], a[3]); pk.z = cvtpk(b[0], b[1]); pk.w = cvtpk(b[2], b[3]);
            *(uint4*)(dst + q * 8) = pk;
        }
    }
}
#else
HD void ph_merge(const Params& p, int l, int bid, int nb, char* smc) {
    const int MT = ((l == 0) ? R : NLAT) / 128;
    const bf16* Wg = p.wt_in + (size_t)l * WIN_NP * D + (size_t)PLD * D;
    const bf16* Wb = p.wt_br + (size_t)l * 4 * D * 256;
    for (int tile = bid; tile < MT * 16; tile += nb) {
        const int mt = tile >> 4, nt = tile & 15;
        ACC_DECL(2, accM); acc_zero(accM);
        for (int i = 0; i < 4; ++i) {
            ACC_DECL(2, accG); acc_zero(accG);
            ACC_DECL(2, accP); acc_zero(accP);
            gemm_accum<2>(accG, [&](int r) { return p.h + (size_t)(mt * 128 + r) * D; },
                          [&](int j) { return Wg + (size_t)(i * 1024 + nt * 64 + j) * D; }, D, smc);
            gemm_accum<2>(accP, [&](int r) { return p.br + (size_t)(mt * 128 + r) * D + i * 256; },
                          [&](int j) { return Wb + ((size_t)i * D + nt * 64 + j) * 256; }, 256, smc);
            ACC_FOR(2, row, col) { AV(accM) += sigmoidf_(AV(accG)) * AV(accP); } ACC_END
        }
#ifndef CPU_EMU
        {
            float* tl = (float*)smc;
            acc_to_lds<2>(accM, tl);
            __syncthreads();
            const int t_ = tid_(); const int row = t_ >> 1, half = t_ & 1;
            bf16* dst = p.mg + (size_t)(mt * 128 + row) * D + nt * 64 + half * 32;
#pragma unroll
            for (int q = 0; q < 4; ++q) {
                const f32x4_t a = *(const f32x4_t*)(tl + row * 68 + half * 32 + q * 8), b = *(const f32x4_t*)(tl + row * 68 + half * 32 + q * 8 + 4);
                uint4 pk; pk.x = cvtpk(a[0], a[1]); pk.y = cvtpk(a[2], a[3]); pk.z = cvtpk(b[0], b[1]); pk.w = cvtpk(b[2], b[3]);
                *(uint4*)(dst + q * 8) = pk;
            }
        }
#else
        ACC_FOR(2, row, col) { p.mg[(size_t)(mt * 128 + row) * D + nt * 64 + col] = f2bf(AV(accM)); } ACC_END
#endif
    }
}

#endif

template <int DRY> HD void ph_outproj_t(const Params& p, int l, int bid, int nb, char* smc) {
    const int MT = ((l == 0) ? R : NLAT) / 128;
    const bf16* Wt = p.wt_out + (size_t)l * D * D;
    for (int tile = bid; tile < MT * 8; tile += nb) {
        const int mt = tile >> 3, nt = tile & 7;
        ACC_DECL(4, acc); acc_zero(acc);
        gemm_accum<4>(acc, [&](int r) { return p.mg + (size_t)(mt * 128 + r) * D; }, [&](int j) { return Wt + (size_t)(nt * 128 + j) * D; }, D, smc);
#ifndef CPU_EMU
        {
            float* tl = (float*)smc;
            acc_to_lds<4>(acc, tl);
            __syncthreads();
            const int t_ = tid_(); const int row = t_ >> 1, half = t_ & 1;
            const int r = mt * 128 + row, c0 = nt * 128 + half * 64;
            const float* xi = xrow_in(p, l, r) + c0; float* xo = (DRY ? ((float*)p.Y + (size_t)r * D) : xrow_out(p, r)) + c0; const float* gm = modrow(p, l, r) + 2048 + c0;
#pragma unroll
            for (int q = 0; q < 16; ++q) {
                const f32x4_t a = *(const f32x4_t*)(tl + row * 132 + half * 64 + q * 4), xv = *(const f32x4_t*)(xi + q * 4), gv = *(const f32x4_t*)(gm + q * 4);
                f32x4_t o; o[0] = xv[0] + gv[0] * a[0]; o[1] = xv[1] + gv[1] * a[1]; o[2] = xv[2] + gv[2] * a[2]; o[3] = xv[3] + gv[3] * a[3];
                *(f32x4_t*)(xo + q * 4) = o;
            }
        }
#else
        ACC_FOR(4, row, col) {
            const int r = mt * 128 + row, c = nt * 128 + col;
            xrow_out(p, r)[c] = xrow_in(p, l, r)[c] + modrow(p, l, r)[2048 + c] * AV(acc);
        } ACC_END
#endif
    }
}

HD void ph_outproj(const Params& p, int l, int bid, int nb, char* smc) { ph_outproj_t<0>(p, l, bid, nb, smc); }
#ifndef CPU_EMU
template <int DRY> HD void ph_router_t(const Params& p, int l, int bid, int nb, float* smf) {
    char* smc = (char*)smf;
    const int t = tid_(), lane = t & 63, w = t >> 6, fr = lane & 15, fg = lane >> 4;
    const int RQ = (l == 0) ? R : NLAT;
    const float* gN = p.in[I_N2G] + l * D;
    constexpr int WST = 2080;
    float* lgw = (float*)(smc + 66560) + w * (16 * 17);
    int* lcnt = (int*)(smc + 70912); int* gbase = (int*)(smc + 70976);
    __syncthreads();
    for (int k = t; k < 1024; k += 256) {
        const float* wrow = p.in[I_WROUTER] + k * 16;
#pragma unroll
        for (int e = 0; e < 16; ++e) {
            const float v = wrow[e]; const bf16 hi = f2bf(v);
            *(bf16*)(smc + e * WST + k * 2) = hi; *(bf16*)(smc + 33280 + e * WST + k * 2) = f2bf(v - bf2f(hi));
        }
    }
    const int ngroups = RQ / 16;
    for (int g0 = bid * 4; g0 < ngroups; g0 += nb * 4) {
        __syncthreads();
        if (t < 16) lcnt[t] = 0;
        __syncthreads();
        const int gidx = g0 + w;
        const bool active = gidx < ngroups;
        int e1 = 0, e2 = 0, q1 = 0, q2 = 0; const int rsel = gidx * 16 + lane;
        if (active) {
            const int r = gidx * 16 + fr;
            const float* x = xrow_out(p, r);
            const float* m = modrow(p, l, r);
            float ss = 0.f;
#pragma unroll 4
            for (int s_ = 0; s_ < 32; ++s_) {
                const f32x4_t a = *(const f32x4_t*)(x + s_ * 32 + fg * 8), b = *(const f32x4_t*)(x + s_ * 32 + fg * 8 + 4);
                ss += a[0] * a[0] + a[1] * a[1] + a[2] * a[2] + a[3] * a[3] + b[0] * b[0] + b[1] * b[1] + b[2] * b[2] + b[3] * b[3];
            }
            ss += __shfl_xor(ss, 16); ss += __shfl_xor(ss, 32);
            const float rs = 1.0f / sqrtf(ss / D + 1e-6f);
            f32x4_t acc = f32x4_t{0.f, 0.f, 0.f, 0.f};
#pragma unroll 2
            for (int s_ = 0; s_ < 32; ++s_) {
                const int k0 = s_ * 32 + fg * 8;
                float hv[8];
#pragma unroll
                for (int hh = 0; hh < 2; ++hh) {
                    const f32x4_t xv = *(const f32x4_t*)(x + k0 + hh * 4), gv = *(const f32x4_t*)(gN + k0 + hh * 4);
                    const f32x4_t sc = *(const f32x4_t*)(m + 4096 + k0 + hh * 4), sh = *(const f32x4_t*)(m + 3072 + k0 + hh * 4);
#pragma unroll
                    for (int q = 0; q < 4; ++q) hv[hh * 4 + q] = xv[q] * rs * gv[q] * (1.0f + sc[q]) + sh[q];
                }
                unsigned hi[4], lo[4];
#pragma unroll
                for (int q = 0; q < 4; ++q) {
                    hi[q] = cvtpk(hv[2 * q], hv[2 * q + 1]);
                    lo[q] = cvtpk(hv[2 * q] - __uint_as_float(hi[q] << 16), hv[2 * q + 1] - __uint_as_float(hi[q] & 0xffff0000u));
                }
                const i32x4_t hiv = i32x4_t{(int)hi[0], (int)hi[1], (int)hi[2], (int)hi[3]}, lov = i32x4_t{(int)lo[0], (int)lo[1], (int)lo[2], (int)lo[3]};
                { uint2 q8; q8.x = pack_fp8x4(hv[0] * 4.f, hv[1] * 4.f, hv[2] * 4.f, hv[3] * 4.f); q8.y = pack_fp8x4(hv[4] * 4.f, hv[5] * 4.f, hv[6] * 4.f, hv[7] * 4.f);
                  *(uint2*)(h8_of(p) + (size_t)r * D + k0) = q8; }
                const bf16x8_t bh = *(const bf16x8_t*)(smc + fr * WST + s_ * 64 + fg * 16), bl = *(const bf16x8_t*)(smc + 33280 + fr * WST + s_ * 64 + fg * 16);
                acc = __builtin_amdgcn_mfma_f32_16x16x32_bf16(__builtin_bit_cast(bf16x8_t, hiv), bh, acc, 0, 0, 0);
                acc = __builtin_amdgcn_mfma_f32_16x16x32_bf16(__builtin_bit_cast(bf16x8_t, hiv), bl, acc, 0, 0, 0);
                acc = __builtin_amdgcn_mfma_f32_16x16x32_bf16(__builtin_bit_cast(bf16x8_t, lov), bh, acc, 0, 0, 0);
            }
#pragma unroll
            for (int q = 0; q < 4; ++q) lgw[(4 * fg + q) * 17 + fr] = acc[q];
            if (lane < 16) {
                float sc[16], sel[16];
#pragma unroll
                for (int e = 0; e < 16; ++e) { sc[e] = sigmoidf_(lgw[lane * 17 + e]); sel[e] = sc[e] + p.in[I_RBIAS][e]; }
                int best = 0; float bestv = -1e30f;
#pragma unroll
                for (int gph = 0; gph < 4; ++gph) {
                    float t1 = -1e30f, t2 = -1e30f;
#pragma unroll
                    for (int j = 0; j < 4; ++j) { const float v = sel[gph * 4 + j]; if (v > t1) { t2 = t1; t1 = v; } else if (v > t2) t2 = v; }
                    const float gs = t1 + t2;
                    if (gs > bestv) { bestv = gs; best = gph; }
                }
                float v1 = -1e30f, v2 = -1e30f, w1 = 0.f, w2 = 0.f; int i1 = 0, i2 = 0;
#pragma unroll
                for (int e = 0; e < 16; ++e) {
                    if ((e >> 2) == best) {
                        const float v = sel[e];
                        if (v > v1) { v2 = v1; i2 = i1; w2 = w1; v1 = v; i1 = e; w1 = sc[e]; } else if (v > v2) { v2 = v; i2 = e; w2 = sc[e]; }
                    }
                }
                e1 = i1; e2 = i2;
                const float ws_ = w1 + w2;
                p.sel_e[rsel * 2] = i1; p.sel_e[rsel * 2 + 1] = i2;
                p.sel_w[rsel * 2] = w1 / ws_; p.sel_w[rsel * 2 + 1] = w2 / ws_;
                q1 = atomicAdd(&lcnt[i1], 1); q2 = atomicAdd(&lcnt[i2], 1);
            }
        }
        __syncthreads();
        if (t < 16) { const int c = lcnt[t]; gbase[t] = (c && !DRY) ? atomicAdd(&p.cnt[l * 16 + t], c) : 0; }
        __syncthreads();
        if (active && lane < 16 && !DRY) {
            const int p1 = gbase[e1] + q1, p2 = gbase[e2] + q2;
            p.elist[(size_t)e1 * 2 * R + p1] = rsel * 2; p.apos[rsel * 2] = p1;
            p.elist[(size_t)e2 * 2 * R + p2] = rsel * 2 + 1; p.apos[rsel * 2 + 1] = p2;
        }
    }
}
HD void ph_router(const Params& p, int l, int bid, int nb, float* smf) { ph_router_t<0>(p, l, bid, nb, smf); }
#else
HD void ph_router(const Params& p, int l, int bid, int nb, float* sm) {
    const int RQ = (l == 0) ? R : NLAT;
    const float* g = p.in[I_N2G] + l * D;
    const float* wr = p.in[I_WROUTER];
    float* sh = sm + 512;
    float* sl = sm + 2048;
    for (int r = bid; r < RQ; r += nb) {
        const float* x = xrow_out(p, r);
        const float* m = modrow(p, l, r);
        THREADS(t, 256) { float s = 0.f; for (int k = t; k < D; k += 256) s += x[k] * x[k]; sm[t] = s; }
        SYNC
        THREADS(t, 1) { float s = 0.f; for (int i = 0; i < 256; ++i) s += sm[i]; sm[256] = s; }
        SYNC
        THREADS(t, 256) {
            float rs = 1.0f / sqrtf(sm[256] / D + 1e-6f);
            for (int k = t; k < D; k += 256) {
                float v = x[k] * rs * g[k];
                v = v * (1.0f + m[4096 + k]) + m[3072 + k];
                sh[k] = v;
                p.h[(size_t)r * D + k] = f2bf(v);
            }
        }
        SYNC
        THREADS(t, 256) {
            int e = t & 15, ks = t >> 4;
            float acc = 0.f;
            for (int k = ks * 64; k < ks * 64 + 64; ++k) acc += sh[k] * wr[k * 16 + e];
            sl[ks * 16 + e] = acc;
        }
        SYNC
        THREADS(t, 1) {
            float* sc = sm + 2304; float* sel = sm + 2320;
            for (int e = 0; e < 16; ++e) {
                float acc = 0.f;
                for (int ks = 0; ks < 16; ++ks) acc += sl[ks * 16 + e];
                sc[e] = sigmoidf_(acc); sel[e] = sc[e] + p.in[I_RBIAS][e];
            }
            int best = 0; float bestv = -1e30f;
            for (int gph = 0; gph < 4; ++gph) {
                float t1 = -1e30f, t2 = -1e30f;
                for (int j = 0; j < 4; ++j) { float v = sel[gph * 4 + j]; if (v > t1) { t2 = t1; t1 = v; } else if (v > t2) t2 = v; }
                float gs = t1 + t2;
                if (gs > bestv) { bestv = gs; best = gph; }
            }
            int i1 = -1, i2 = -1; float v1 = -1e30f, v2 = -1e30f;
            for (int j = 0; j < 4; ++j) {
                float v = sel[best * 4 + j];
                if (v > v1) { v2 = v1; i2 = i1; v1 = v; i1 = best * 4 + j; } else if (v > v2) { v2 = v; i2 = best * 4 + j; }
            }
            float w1 = sc[i1], w2 = sc[i2], ws = w1 + w2;
            p.sel_e[r * 2] = i1; p.sel_e[r * 2 + 1] = i2;
            p.sel_w[r * 2] = w1 / ws; p.sel_w[r * 2 + 1] = w2 / ws;
            int q1 = ATOMIC_ADD_RET(&p.cnt[l * 16 + i1], 1); p.elist[(size_t)i1 * 2 * R + q1] = r * 2; p.apos[r * 2] = q1;
            int q2 = ATOMIC_ADD_RET(&p.cnt[l * 16 + i2], 1); p.elist[(size_t)i2 * 2 * R + q2] = r * 2 + 1; p.apos[r * 2 + 1] = q2;
        }
        SYNC
    }
}

#endif

struct MoeTiles { int tstart[17]; };
HD MoeTiles moe_tiles(const Params& p, int l) {
    MoeTiles m; int acc = 0;
    for (int e = 0; e < 16; ++e) { m.tstart[e] = acc; acc += (p.cnt[l * 16 + e] + 127) >> 7; }
    m.tstart[16] = acc; return m;
}

HD void ph_ffn1(const Params& p, int l, int bid, int nb, char* smc) {
    int tstart[17];
    { int acc = 0; for (int e = 0; e < 16; ++e) { tstart[e] = acc; acc += (p.cnt[l * 16 + e] + 127) >> 7; } tstart[16] = acc; }
    const int ntiles = tstart[16];
    for (int tile = bid; tile < ntiles * 8; tile += nb) {
        const int rt = tile >> 3, nt = tile & 7;
        int e = 0, ts = 0;
#pragma unroll
        for (int q = 1; q < 16; ++q) if (rt >= tstart[q]) { e = q; ts = tstart[q]; }
        const int mt = rt - ts;
        const int cnt_e = p.cnt[l * 16 + e];
        const int* el = p.elist + (size_t)e * 2 * R;
#ifndef CPU_EMU
        const unsigned char* Wt8 = gu8_of(p) + (size_t)e * 1024 * D;
        AccT<4> acc; acc_zero(acc);
        gemm_accum8<4>(acc, [&](int i) { int q = mt * 128 + i; int a = (q < cnt_e) ? el[q] : el[0]; return (const unsigned char*)h8_of(p) + (size_t)(a >> 1) * D; },
                       [&](int j) { return Wt8 + (size_t)(nt * 128 + j) * D; }, D, smc, SC_H, SC_W);
        {
            float* tl = (float*)smc;
            acc_to_lds<4>(acc, tl);
            __syncthreads();
            const int t_ = tid_(); const int row = t_ >> 1, half = t_ & 1;
            unsigned char* dst = (unsigned char*)p.act + (size_t)(rt * 128 + row) * 512 + nt * 64 + half * 32;
#pragma unroll
            for (int q = 0; q < 2; ++q) {
                float o[16];
#pragma unroll
                for (int c4 = 0; c4 < 4; ++c4) {
                    const f32x4_t gv = *(const f32x4_t*)(tl + row * 132 + half * 64 + q * 32 + c4 * 4), uv = *(const f32x4_t*)(tl + row * 132 + half * 64 + q * 32 + 16 + c4 * 4);
#pragma unroll
                    for (int e_ = 0; e_ < 4; ++e_) o[c4 * 4 + e_] = gv[e_] / (1.0f + __expf(-gv[e_])) * uv[e_] * 16.0f;
                }
                uint4 pk; pk.x = pack_fp8x4(o[0], o[1], o[2], o[3]); pk.y = pack_fp8x4(o[4], o[5], o[6], o[7]);
                pk.z = pack_fp8x4(o[8], o[9], o[10], o[11]); pk.w = pack_fp8x4(o[12], o[13], o[14], o[15]);
                *(uint4*)(dst + q * 16) = pk;
            }
        }
#else
        const bf16* Wt = p.wt_gu + (size_t)e * 1024 * D;
        ACC_DECL(4, acc); acc_zero(acc);
        gemm_accum<4>(acc, [&](int i) { int q = mt * 128 + i; int a = (q < cnt_e) ? el[q] : el[0]; return p.h + (size_t)(a >> 1) * D; },
                      [&](int j) { return Wt + (size_t)(nt * 128 + j) * D; }, D, smc);
        ACC_FOR_PAIR(row, pcol) {
            float gv = AV_G(acc), uv = AV_U(acc);
            p.act[(size_t)(rt * 128 + row) * 512 + nt * 64 + pcol] = f2bf(siluf_(gv) * uv);
        } ACC_END
#endif
    }
}

HD void ph_ffn2(const Params& p, int l, int bid, int nb, char* smc) {
    int tstart[17];
    { int acc = 0; for (int e = 0; e < 16; ++e) { tstart[e] = acc; acc += (p.cnt[l * 16 + e] + 127) >> 7; } tstart[16] = acc; }
    const int ntiles = tstart[16];
    for (int tile = bid; tile < ntiles * 8; tile += nb) {
        const int rt = tile >> 3, nt = tile & 7;
        int e = 0;
#pragma unroll
        for (int q = 1; q < 16; ++q) if (rt >= tstart[q]) e = q;
#ifndef CPU_EMU
        const unsigned char* Wt8 = d8_of(p) + (size_t)e * D * 512;
        AccT<4> acc; acc_zero(acc);
        gemm_accum8<4>(acc, [&](int i) { return (const unsigned char*)p.act + (size_t)(rt * 128 + i) * 512; }, [&](int j) { return Wt8 + (size_t)(nt * 128 + j) * 512; }, 512, smc, SC_ACT, SC_W);
#else
        const bf16* Wt = p.wt_d + (size_t)e * D * 512;
        ACC_DECL(4, acc); acc_zero(acc);
        gemm_accum<4>(acc, [&](int i) { return p.act + (size_t)(rt * 128 + i) * 512; }, [&](int j) { return Wt + (size_t)(nt * 128 + j) * 512; }, 512, smc);
#endif
#ifndef CPU_EMU
        {
            float* tl = (float*)smc;
            acc_to_lds<4>(acc, tl);
            __syncthreads();
            const int t_ = tid_(); const int row = t_ >> 1, half = t_ & 1;
            bf16* dst = p.Y + (size_t)(rt * 128 + row) * D + nt * 128 + half * 64;
#pragma unroll
            for (int q = 0; q < 8; ++q) {
                const f32x4_t a = *(const f32x4_t*)(tl + row * 132 + half * 64 + q * 8), b = *(const f32x4_t*)(tl + row * 132 + half * 64 + q * 8 + 4);
                uint4 pk; pk.x = cvtpk(a[0], a[1]); pk.y = cvtpk(a[2], a[3]); pk.z = cvtpk(b[0], b[1]); pk.w = cvtpk(b[2], b[3]);
                *(uint4*)(dst + q * 8) = pk;
            }
        }
#else
        ACC_FOR(4, row, col) { p.Y[(size_t)(rt * 128 + row) * D + nt * 128 + col] = f2bf(AV(acc)); } ACC_END
#endif
    }
}

#ifndef CPU_EMU
template <int DRY> HD void ph_combine_t(const Params& p, int l, int bid, int nb) {
    const int RQ = (l == 0) ? R : NLAT;
    const int t = tid_(), lane = t & 63, w = t >> 6;
    int tstart[17];
    { int acc = 0;
#pragma unroll
      for (int e = 0; e < 16; ++e) { tstart[e] = acc; acc += (p.cnt[l * 16 + e] + 127) >> 7; } tstart[16] = acc; }
    for (int r = bid * 4 + w; r < RQ; r += nb * 4) {
        float* xo = xrow_out(p, r);
        const float* m = modrow(p, l, r) + 5120;
        const int e0 = p.sel_e[r * 2], e1 = p.sel_e[r * 2 + 1];
        int t0 = 0, t1 = 0;
#pragma unroll
        for (int q = 0; q < 16; ++q) { if (q == e0) t0 = tstart[q]; if (q == e1) t1 = tstart[q]; }
        const bf16* y0 = p.Y + (size_t)(t0 * 128 + p.apos[r * 2]) * D;
        const bf16* y1 = p.Y + (size_t)(t1 * 128 + p.apos[r * 2 + 1]) * D;
        const float w0 = p.sel_w[r * 2], w1 = p.sel_w[r * 2 + 1];
        f32x4_t xs[4]; float ss = 0.f;
#pragma unroll
        for (int j = 0; j < 4; ++j) {
            const int k = j * 256 + lane * 4;
            f32x4_t xv = *(const f32x4_t*)(xo + k);
            const f32x4_t gv = *(const f32x4_t*)(m + k);
            const uint2 a = *(const uint2*)(y0 + k), b = *(const uint2*)(y1 + k);
            xv[0] += gv[0] * (w0 * __uint_as_float(a.x << 16) + w1 * __uint_as_float(b.x << 16));
            xv[1] += gv[1] * (w0 * __uint_as_float(a.x & 0xffff0000u) + w1 * __uint_as_float(b.x & 0xffff0000u));
            xv[2] += gv[2] * (w0 * __uint_as_float(a.y << 16) + w1 * __uint_as_float(b.y << 16));
            xv[3] += gv[3] * (w0 * __uint_as_float(a.y & 0xffff0000u) + w1 * __uint_as_float(b.y & 0xffff0000u));
            *(f32x4_t*)((DRY ? (float*)p.gq + (size_t)r * 64 : xo) + (DRY ? (k & 63) : k)) = xv;
            xs[j] = xv; ss += xv[0] * xv[0] + xv[1] * xv[1] + xv[2] * xv[2] + xv[3] * xv[3];
        }
        if (l == 0 && !DRY) {
            ss = wave_sum(ss);
            const float rs = 1.0f / sqrtf(ss / D + 1e-6f);
            const float* g1 = p.in[I_N1G] + D; const float* m1 = modrow(p, 1, r);
#pragma unroll
            for (int j = 0; j < 4; ++j) {
                const int k = j * 256 + lane * 4;
                const f32x4_t gv = *(const f32x4_t*)(g1 + k), sc = *(const f32x4_t*)(m1 + 1024 + k), sh = *(const f32x4_t*)(m1 + k);
                float o[4];
#pragma unroll
                for (int q = 0; q < 4; ++q) o[q] = xs[j][q] * rs * gv[q] * (1.0f + sc[q]) + sh[q];
                uint2 pk; pk.x = cvtpk(o[0], o[1]); pk.y = cvtpk(o[2], o[3]);
                *(uint2*)(p.h + (size_t)r * D + k) = pk;
                *(unsigned*)(h8_of(p) + (size_t)r * D + k) = pack_fp8x4(o[0] * 4.f, o[1] * 4.f, o[2] * 4.f, o[3] * 4.f);
            }
        }
    }
}
HD void ph_combine(const Params& p, int l, int bid, int nb) { ph_combine_t<0>(p, l, bid, nb); }
#else
HD void ph_combine(const Params& p, int l, int bid, int nb) {
    const int RQ = (l == 0) ? R : NLAT;
    int tstart[17];
    { int acc = 0; for (int e = 0; e < 16; ++e) { tstart[e] = acc; acc += (p.cnt[l * 16 + e] + 127) >> 7; } tstart[16] = acc; }
    for (int r = bid; r < RQ; r += nb) {
        float* xo = xrow_out(p, r);
        const float* m = modrow(p, l, r);
        int e0 = p.sel_e[r * 2], e1 = p.sel_e[r * 2 + 1];
        int t0 = 0, t1 = 0;
#pragma unroll
        for (int q = 0; q < 16; ++q) { if (q == e0) t0 = tstart[q]; if (q == e1) t1 = tstart[q]; }
        const bf16* y0 = p.Y + (size_t)(t0 * 128 + p.apos[r * 2]) * D;
        const bf16* y1 = p.Y + (size_t)(t1 * 128 + p.apos[r * 2 + 1]) * D;
        const float w0 = p.sel_w[r * 2], w1 = p.sel_w[r * 2 + 1];
        THREADS(t, 256) {
            for (int k = t; k < D; k += 256) xo[k] += m[5120 + k] * (w0 * bf2f(y0[k]) + w1 * bf2f(y1[k]));
        }
    }
}

#endif

constexpr int NPHASE_LAYER = 14;
HD void run_phase(const Params& p, int ph, int l, int bid, int nb, float* sm) {
    switch (ph) {
        case 0: ph_norm1(p, l, bid, nb, sm); break;
        case 1: ph_inproj(p, l, bid, nb, (char*)sm); break;
        case 2: ph_prep(p, l, bid, nb); if (FOURIER_GEMM) ph_fourier_s1(p, bid, nb, (char*)sm); break;
        case 3: ph_na(p, l, bid, nb, (char*)sm); break;
        case 4: ph_da(p, l, bid, nb, (char*)sm); break;
        case 5: ph_gdn_chunk(p, l, bid, nb, sm); break;
        case 6: if (FOURIER_GEMM) { if (l == 0) ph_fourier_ctx(p, bid, nb, (char*)sm); ph_fourier_sA(p, bid, nb, (char*)sm); } else ph_fourier2(p, l, bid, nb); break;
        case 7: {
            ph_gdn_scan(p, l, bid, nb, sm);
            const bool split = nb == 512;
            const bool skip = split && (bid < 64 || (bid >= 256 && bid < 320));
            if (!skip) {
                const int b2 = split ? (bid < 256 ? bid - 64 : bid - 128) : bid, n2 = split ? nb - 128 : nb;
                if (FOURIER_GEMM) ph_fourier_sB(p, b2, n2, (char*)sm);
                if (l == 0) convert_static(p, b2, n2, sm, 1);
                convert_moe(p, l, b2, n2, sm);
#ifndef CPU_EMU
                ph_na(p, l, b2, n2, (char*)sm);
#endif
            }
        } break;
#ifndef CPU_EMU
        case 8: ph_gdn_outfin(p, l, bid, nb, sm); break;
#else
        case 8: ph_gdn_fin(p, l, bid, nb); break;
#endif
        case 9: ph_merge(p, l, bid, nb, (char*)sm); break;
        case 10: ph_outproj(p, l, bid, nb, (char*)sm); break;
        case 11: ph_router(p, l, bid, nb, sm); break;
        case 12: ph_ffn1(p, l, bid, nb, (char*)sm); break;
        case 13: ph_ffn2(p, l, bid, nb, (char*)sm); break;
        case 14: ph_combine(p, l, bid, nb); break;
#ifndef CPU_EMU
        case 70: ph_gdn_scan(p, l, bid, nb, sm); break;
        case 71: if (bid >= 64) { if (FOURIER_GEMM) ph_fourier_sB(p, bid - 64, nb - 64, (char*)sm); if (l == 0) convert_static(p, bid - 64, nb - 64, sm, 1); convert_moe(p, l, bid - 64, nb - 64, sm); } break;
        case 110: ph_outproj_t<1>(p, l, bid, nb, (char*)sm); break;
        case 111: ph_router_t<1>(p, l, bid, nb, sm); break;
        case 114: ph_combine_t<1>(p, l, bid, nb); break;
#endif
        default: break;
    }
}

struct WsLayout { size_t fWC, fXC, ropeT, bar, fa2, fW1, fWA, fWB, mods, cosT, sinT, cs, gg, gbeta, sel_e, sel_w, cnt, elist, apos, cG, wt_in, wt_br, wt_out, wt_gu, wt_d,
                  h, P, gq, fcs, cU, cW, cQK, odir, br, mg, act, Y, total; };
inline WsLayout ws_layout() {
    WsLayout w; size_t o = 0;
    auto take = [&](size_t bytes) { size_t r = o; o += (bytes + 255) & ~(size_t)255; return r; };
    w.bar = take(3456 * 4); w.ropeT = take(128 * 8 * 2 * 4); w.fWC = take((size_t)CTXL * 2 * CTXL * 2); w.fXC = take((size_t)NB * 256 * 2 * CTXL * 2);
    w.mods = take(2 * 3 * 6144 * 4); w.cosT = take(SEQ * 4); w.sinT = take(SEQ * 4); w.cs = take((size_t)NCTX * D * 4);
    w.gg = take((size_t)8 * R * 4); w.gbeta = take((size_t)8 * R * 4); w.sel_e = take((size_t)R * 2 * 4); w.sel_w = take((size_t)R * 2 * 4);
    w.cnt = take(32 * 4); w.elist = take((size_t)16 * 2 * R * 4); w.apos = take((size_t)2 * R * 4); w.cG = take((size_t)NUNIT * 192 * 4);
    w.wt_in = take((size_t)2 * WIN_NP * D * 2); w.wt_br = take((size_t)2 * 4 * D * 256 * 2); w.wt_out = take((size_t)2 * D * D * 2);
    w.wt_gu = take((size_t)16 * 1024 * D * 2); w.wt_d = take((size_t)16 * D * 512 * 2);
    w.h = take((size_t)R * D * 2);
    w.fa2 = take((size_t)NB * 128 * 256 * 2 * 64 * 2); w.fW1 = take(8192 * 2); w.fWA = take(65536 * 2); w.fWB = take(8192 * 2);
    {
        const size_t szP = ((size_t)R * PLD * 2 + 255) & ~(size_t)255, szQ = ((size_t)R * 768 * 2 + 255) & ~(size_t)255;
        const size_t szA = ((size_t)PADROWS * 512 * 2 + 255) & ~(size_t)255, szY = ((size_t)PADROWS * 1024 * 2 + 255) & ~(size_t)255;
        const size_t base = take((szP + szQ) > (szA + szY) ? (szP + szQ) : (szA + szY));
        w.P = base; w.gq = base + szP; w.act = base; w.Y = base + szA;
    }
    w.fcs = take((size_t)R * 512 * 2);
    w.cU = take((size_t)NUNIT * 4096 * 2); w.cW = take((size_t)NUNIT * 4096 * 2); w.cQK = take((size_t)NUNIT * 4096 * 2);
    w.odir = take((size_t)2 * R * 256 * 2); w.br = take((size_t)R * D * 2);
    w.mg = w.cU;
    w.total = o;
    return w;
}
inline void fill_params(Params& p, void* const* d_in, void* d_out, void* d_ws) {
    WsLayout w = ws_layout(); char* b = (char*)d_ws;
    for (int i = 0; i < 30; ++i) p.in[i] = (const float*)d_in[i];
    p.out = (float*)d_out;
    p.mods = (float*)(b + w.mods); p.cosT = (float*)(b + w.cosT); p.sinT = (float*)(b + w.sinT); p.cs = (float*)(b + w.cs);
    p.h = (bf16*)(b + w.h); p.P = (bf16*)(b + w.P); p.gq = (bf16*)(b + w.gq); p.gg = (float*)(b + w.gg); p.gbeta = (float*)(b + w.gbeta);
    p.fcs = (bf16*)(b + w.fcs); p.cU = (bf16*)(b + w.cU); p.cW = (bf16*)(b + w.cW); p.cQK = (bf16*)(b + w.cQK); p.cG = (float*)(b + w.cG);
    p.odir = (bf16*)(b + w.odir); p.br = (bf16*)(b + w.br); p.mg = (bf16*)(b + w.mg); p.sel_e = (int*)(b + w.sel_e);
    p.sel_w = (float*)(b + w.sel_w); p.act = (bf16*)(b + w.act); p.Y = (bf16*)(b + w.Y);
    p.wt_in = (bf16*)(b + w.wt_in); p.wt_br = (bf16*)(b + w.wt_br); p.wt_out = (bf16*)(b + w.wt_out); p.wt_gu = (bf16*)(b + w.wt_gu);
    p.fa2 = (bf16*)(b + w.fa2); p.fW1 = (bf16*)(b + w.fW1); p.fWA = (bf16*)(b + w.fWA); p.fWB = (bf16*)(b + w.fWB);
    p.bar = (unsigned*)(b + w.bar); p.ropeT = (float*)(b + w.ropeT); p.fWC = (bf16*)(b + w.fWC); p.fXC = (bf16*)(b + w.fXC);
    p.wt_d = (bf16*)(b + w.wt_d); p.cnt = (int*)(b + w.cnt); p.elist = (int*)(b + w.elist); p.apos = (int*)(b + w.apos);
}

#if !defined(CPU_EMU) && defined(PHASE_KERNELS)
#define PK(n) __global__ void __launch_bounds__(256, 2) pk_##n(Params p) { __shared__ __attribute__((aligned(16))) float sm[SMEM_FLOATS]; run_phase(p, n, p.layer, blockIdx.x, gridDim.x, sm); }
PK(0) PK(1) PK(2) PK(3) PK(4) PK(5) PK(6) PK(7) PK(8) PK(9) PK(10) PK(11) PK(12) PK(13) PK(14)
__global__ void __launch_bounds__(256, 2) pk_init(Params p) { __shared__ __attribute__((aligned(16))) float sm[SMEM_FLOATS]; ph_init(p, blockIdx.x, gridDim.x, sm); }
#endif
#ifndef CPU_EMU

#define XB_TMO      128
#define XB_XCNT(j)  (256  + 64 * (j))
#define XB_XSUB(j)  (1280 + 64 * (j))
#define XB_XGEN(j)  (2304 + 64 * (j))
#define XB_TOP      3328
#define XB_TOPGEN   3392
#define XCD_BAR_WORDS 3456
#define XB_SPIN_CAP (1u << 22)
#define LAS __attribute__((address_space(3)))
__device__ __forceinline__ unsigned xb_ld(unsigned* p)              { return __hip_atomic_load(p, __ATOMIC_RELAXED, __HIP_MEMORY_SCOPE_AGENT); }
__device__ __forceinline__ unsigned xb_add(unsigned* p, unsigned v) { return __hip_atomic_fetch_add(p, v, __ATOMIC_RELAXED, __HIP_MEMORY_SCOPE_AGENT); }
__device__ __forceinline__ unsigned xb_xcc_id() { return (unsigned)__builtin_amdgcn_s_getreg((3 << 11) | 20) & 0xFu; }
#define XB_SPIN(cond, bar) do { unsigned _sp = 0; while (cond) { __builtin_amdgcn_s_sleep(1); \
    if ((++_sp & 255u) == 0u) { if (xb_ld(&(bar)[XB_TMO])) break; if (_sp > XB_SPIN_CAP) { atomicAdd(&(bar)[XB_TMO], 1u); break; } } } } while (0)
struct XcdBarrier { unsigned* bar; unsigned x; volatile LAS unsigned* st; };
__device__ __forceinline__ XcdBarrier xcd_barrier_post(unsigned* bar, volatile LAS unsigned* st) {
    XcdBarrier b; b.bar = bar; b.x = xb_xcc_id(); b.st = st;
    if (threadIdx.x == 0) (void)xb_add(&bar[XB_XCNT(b.x)], 1u);
    return b;
}
__device__ __forceinline__ void xcd_barrier_complete(unsigned* bar, unsigned x, unsigned& nloc, unsigned& nx) {
    const unsigned G = gridDim.x * gridDim.y * gridDim.z;
    unsigned sum, cnt, mine, sp = 0u;
    for (;;) {
        sum = 0u; cnt = 0u; mine = 0u;
#pragma unroll
        for (unsigned j = 0; j < 16; ++j) { const unsigned c = xb_ld(&bar[XB_XCNT(j)]); sum += c; cnt += (c > 0u) ? 1u : 0u; mine = (j == x) ? c : mine; }
        if (sum == G) break;
        __builtin_amdgcn_s_sleep(1);
        if ((++sp & 255u) == 0u) { if (xb_ld(&bar[XB_TMO])) break; if (sp > XB_SPIN_CAP) { atomicAdd(&bar[XB_TMO], 1u); break; } }
    }
    nloc = mine > 0u ? mine : 1u; nx = cnt > 0u ? cnt : 1u;
}
__device__ __forceinline__ void xcd_barrier(const XcdBarrier& b) {
    asm volatile("s_waitcnt vmcnt(0)" ::: "memory");
    __syncthreads();
    if (threadIdx.x == 0) {
        unsigned* bar = b.bar;
        __builtin_amdgcn_s_waitcnt(0);
        unsigned nloc = b.st[0], nx = b.st[1];
        if (nloc == 0u) { xcd_barrier_complete(bar, b.x, nloc, nx); b.st[0] = nloc; b.st[1] = nx; }
        const unsigned old = xb_add(&bar[XB_XSUB(b.x)], 1u);
        const unsigned gen = old / nloc;
        if (old + 1u == (gen + 1u) * nloc) {
            __builtin_amdgcn_fence(__ATOMIC_RELEASE, "agent");
            asm volatile("s_waitcnt vmcnt(0)" ::: "memory");
            const unsigned og = xb_add(&bar[XB_TOP], 1u);
            const unsigned tg = og / nx;
            if (og + 1u == (tg + 1u) * nx) xb_add(&bar[XB_TOPGEN], 1u);
            else XB_SPIN(xb_ld(&bar[XB_TOPGEN]) == tg, bar);
            __builtin_amdgcn_fence(__ATOMIC_ACQUIRE, "agent");
            xb_add(&bar[XB_XGEN(b.x)], 1u);
            asm volatile("s_waitcnt vmcnt(0)" ::: "memory");
        } else {
            XB_SPIN(xb_ld(&bar[XB_XGEN(b.x)]) == gen, bar);
            __builtin_amdgcn_fence(__ATOMIC_ACQUIRE, "agent");
            asm volatile("s_waitcnt vmcnt(0)" ::: "memory");
        }
    }
    __syncthreads();
}

__global__ void __launch_bounds__(256, 2) fwd_megakernel(Params p) {
    __shared__ __attribute__((aligned(16))) float sm[SMEM_FLOATS];
    cg::grid_group grid = cg::this_grid();
    const int bid = blockIdx.x, nb = gridDim.x;
    volatile LAS unsigned* xst = (volatile LAS unsigned*)(sm + SMEM_FLOATS - 4);
    if (threadIdx.x == 0) { xst[0] = 0u; xst[1] = 0u; }
    __syncthreads();
    XcdBarrier xb = xcd_barrier_post(p.bar, xst);
    ph_init(p, bid, nb, sm);
    xcd_barrier(xb);
#ifdef PROBE_INIT
    ph_init(p, bid, nb, sm); xcd_barrier(xb); ph_init(p, bid, nb, sm); xcd_barrier(xb);
#endif
#define PH(n, l) run_phase(p, n, l, bid, nb, sm); xcd_barrier(xb);
#define PHN(n, l) run_phase(p, n, l, bid, nb, sm);
#ifndef PROBE_X
#define PROBE_X(n, l)
#endif
#define LAYER(l) PH(0, l) PROBE_X(0, l) PH(1, l) PROBE_X(1, l) PH(2, l) PROBE_X(2, l) PHN(4, l) PHN(6, l) PH(5, l) PROBE_X(4, l) PROBE_X(5, l) PROBE_X(3, l) PROBE_X(6, l) \
    PH(7, l) PROBE_X(7, l) PROBE_X(70, l) PROBE_X(71, l) PH(8, l) PROBE_X(8, l) PH(9, l) PROBE_X(9, l) PH(10, l) PH(11, l) PH(12, l) PROBE_X(12, l) \
    PH(13, l) PROBE_X(13, l) PH(14, l)
    LAYER(0)
#undef LAYER
#define LAYER(l) PH(1, l) PROBE_X(1, l) PH(2, l) PROBE_X(2, l) PHN(4, l) PHN(6, l) PH(5, l) PROBE_X(4, l) PROBE_X(5, l) PROBE_X(3, l) PROBE_X(6, l) \
    PH(7, l) PROBE_X(7, l) PROBE_X(70, l) PROBE_X(71, l) PH(8, l) PROBE_X(8, l) PH(9, l) PROBE_X(9, l) PH(10, l) PROBE_X(110, l) PH(11, l) PROBE_X(111, l) PH(12, l) PROBE_X(12, l) \
    PH(13, l) PROBE_X(13, l) PH(14, l) PROBE_X(114, l)
    LAYER(1)
}

extern "C" void kernel_launch(void* const* d_in, const int* in_sizes, int n_in, void* d_out, int out_size,
                              void* d_ws, size_t ws_size, hipStream_t stream) {
    WsLayout w = ws_layout();
    if (ws_size < w.total) { fprintf(stderr, "ws too small: need %zu have %zu\n", w.total, ws_size); return; }
    static int grid_blocks = 0;
    if (!grid_blocks) {
        int dev = 0, cus = 0, per_cu = 0;
        (void)hipGetDevice(&dev);
        (void)hipDeviceGetAttribute(&cus, hipDeviceAttributeMultiprocessorCount, dev);
        (void)hipOccupancyMaxActiveBlocksPerMultiprocessor(&per_cu, fwd_megakernel, 256, 0);
        if (per_cu < 1) per_cu = 1;
        grid_blocks = cus * per_cu;
    }
    Params p{};
    fill_params(p, d_in, d_out, d_ws);
    (void)hipMemsetAsync(p.bar, 0, XCD_BAR_WORDS * 4, stream);
    void* args[] = {&p};
    hipError_t e = hipLaunchCooperativeKernel((void*)fwd_megakernel, dim3(grid_blocks), dim3(256), args, 0, stream);
    if (e != hipSuccess) fprintf(stderr, "cooperative launch failed: %s (grid %d)\n", hipGetErrorString(e), grid_blocks);
}
#endif
```

```cpp
#ifndef CPU_EMU
#include <hip/hip_runtime.h>
#include <hip/hip_cooperative_groups.h>
#include <cstdio>
namespace cg = cooperative_groups;
#define HD __device__ __forceinline__
__device__ __forceinline__ int tid_() { int v = threadIdx.x; asm volatile("" : "+v"(v)); return v; }
#define THREADS(t, n) for (int t = tid_(); t < (n); t += 256)
#define SYNC __syncthreads();
#define COSPI(x) cospif(x)
#define SINPI(x) sinpif(x)
typedef float4 f4;
#else
#include <cmath>
#include <cstdio>
#include <cstring>
#include <cstddef>
#define HD inline
#define THREADS(t, n) for (int t = 0; t < (n); ++t)
#define SYNC
#define COSPI(x) ((float)cos(M_PI * (double)(x)))
#define SINPI(x) ((float)sin(M_PI * (double)(x)))
struct f4 { float x, y, z, w; };
#endif

#ifndef SEQ
#define SEQ 8192
#endif
#ifndef CTXL
#define CTXL 256
#endif

typedef unsigned short bf16;
#ifndef CPU_EMU
typedef __attribute__((ext_vector_type(8))) short bf16x8_t;
typedef __attribute__((ext_vector_type(4))) float f32x4_t;
typedef __attribute__((ext_vector_type(4))) int i32x4_t;
#define ATOMIC_ADD_RET(ptr, v) atomicAdd((ptr), (v))
#else
HD int atomic_add_ret_(int* p, int v) { int old;
#pragma omp atomic capture
    { old = *p; *p += v; }
    return old; }
#define ATOMIC_ADD_RET(ptr, v) atomic_add_ret_((ptr), (v))
#endif
constexpr int NB = 2, D = 1024, GW = 64, ROWS = SEQ / GW;
constexpr int NLAT = NB * SEQ, NCTX = NB * CTXL, R = NLAT + NCTX;
constexpr int DIN = 6928;
constexpr int PLD = 2816;
constexpr int C_NAQ = 0, C_NAK = 256, C_NAV = 512, C_DAQ = 768, C_DAK = 1024, C_DAV = 1280, C_GQ = 1536, C_Z = 2304,
              C_F = 2560;
constexpr int WIN_N = 6912;
constexpr int WIN_NP = WIN_N + 64;
constexpr int PADROWS = 2 * R + 16 * 128;
constexpr int NCC = CTXL / 64, NCL = SEQ / 64, NCH = NCC + NCL;
constexpr int NUNIT = 2 * NB * 4 * NCH;
constexpr bool FOURIER_GEMM = (SEQ == 8192);
constexpr int SMEM_FLOATS = 73 * 256 + 4;

struct Params {
    const float* in[30];
    float* out;
    float* mods;
    float* cosT;
    float* sinT;
    float* cs;
    bf16* h;
    bf16* P;
    bf16* gq;
    float* gg;
    float* gbeta;
    bf16* fcs;
    bf16* cU;
    bf16* cW;
    bf16* cQK;
    float* cG;
    bf16* odir;
    bf16* br;
    bf16* mg;
    int* sel_e;
    float* sel_w;
    bf16* act;
    bf16* Y;
    bf16* wt_in;
    bf16* wt_br;
    bf16* wt_out;
    bf16* wt_gu;
    bf16* wt_d;
    int* cnt;
    unsigned* bar;
    bf16* fa2;
    bf16* fW1;
    float* ropeT;
    bf16* fWA;
    bf16* fWB;
    bf16* fWC;
    bf16* fXC;
    int* elist;
    int* apos;
    int phase;
    int layer;
};

enum { I_X = 0, I_C, I_CTX, I_CCTX, I_WMOD, I_BMOD, I_N1G, I_N2G, I_WIN, I_NAQG, I_NAKG, I_RPB, I_DAQG, I_DAKG, I_LQ1, I_LK1,
       I_LQ2, I_LK2, I_SUBLN, I_CONVW, I_ALOG, I_DTB, I_ONORM, I_WBR, I_WOUT, I_WROUTER, I_RBIAS, I_MG, I_MU, I_MD };

HD float bf2f(bf16 v) { union { unsigned u; float f; } x; x.u = ((unsigned)v) << 16; return x.f; }
#ifndef CPU_EMU
typedef float f32x2_t __attribute__((ext_vector_type(2))); typedef __bf16 bf16x2_t __attribute__((ext_vector_type(2)));
typedef short s16x4_t __attribute__((ext_vector_type(4)));
typedef __attribute__((address_space(3))) const char* lds_cptr;
HD unsigned cvtpk(float lo, float hi) { f32x2_t v = {lo, hi}; bf16x2_t b = __builtin_convertvector(v, bf16x2_t); return __builtin_bit_cast(unsigned, b); }
HD bf16 f2bf(float f) { return (bf16)(cvtpk(f, 0.f) & 0xffffu); }
HD s16x4_t lds_tr16(lds_cptr p) { return __builtin_bit_cast(s16x4_t, __builtin_amdgcn_ds_read_tr16_b64_v4i16((__attribute__((address_space(3))) s16x4_t*)p)); }
#else
HD bf16 f2bf(float f) { union { unsigned u; float f; } x; x.f = f; unsigned u = x.u; u += 0x7fffu + ((u >> 16) & 1u); return (bf16)(u >> 16); }
#endif
HD float sigmoidf_(float x) { return 1.0f / (1.0f + expf(-x)); }
HD float siluf_(float x) { return x / (1.0f + expf(-x)); }

struct RowInfo { int seg, b, t, T, base; };
HD RowInfo rowinfo(int r) {
    RowInfo q;
    if (r < NLAT) { q.seg = 0; q.b = r / SEQ; q.t = r % SEQ; q.T = SEQ; q.base = q.b * SEQ; }
    else { int r2 = r - NLAT; q.seg = 1; q.b = r2 / CTXL; q.t = r2 % CTXL; q.T = CTXL; q.base = NLAT + q.b * CTXL; }
    return q;
}
HD const float* xrow_in(const Params& p, int l, int r) {
    if (r < NLAT) return (l == 0 ? p.in[I_X] : p.out) + (size_t)r * D;
    return p.cs + (size_t)(r - NLAT) * D;
}
HD float* xrow_out(const Params& p, int r) {
    if (r < NLAT) return p.out + (size_t)r * D;
    return p.cs + (size_t)(r - NLAT) * D;
}
HD const float* modrow(const Params& p, int l, int r) {
    int s = (r < NLAT) ? (r / SEQ) : 2;
    return p.mods + (size_t)(l * 3 + s) * 6144;
}
#ifndef CPU_EMU
HD unsigned char* gu8_of(const Params& p) { return (unsigned char*)p.wt_gu; }
HD unsigned char* d8_of(const Params& p) { return (unsigned char*)p.wt_gu + (size_t)16 * 1024 * 1024; }
HD unsigned char* h8_of(const Params& p) { return (unsigned char*)p.wt_gu + (size_t)16 * 1024 * 1024 + (size_t)16 * 1024 * 512; }
#endif
HD float lam_init_of(int l) { return l == 0 ? 0.2f : (0.8f - 0.6f * 0.7408182206817179f); }


#ifndef CPU_EMU
template <int NJ> struct AccT { f32x4_t v[4][NJ]; };
#define ACC_DECL(NJ, a) AccT<NJ> a
template <int NJ> HD void acc_zero(AccT<NJ>& a) {
#pragma unroll
    for (int i = 0; i < 4; ++i)
#pragma unroll
        for (int j = 0; j < NJ; ++j) a.v[i][j] = f32x4_t{0.f, 0.f, 0.f, 0.f};
}
#define ACC_FOR(NJ, row, col) { const int _t = tid_(); const int _ln = _t & 63, _w = _t >> 6; \
    _Pragma("unroll") for (int _i = 0; _i < 4; ++_i) _Pragma("unroll") for (int _j = 0; _j < NJ; ++_j) _Pragma("unroll") for (int _r = 0; _r < 4; ++_r) { \
    const int row = (_w >> 1) * 64 + _i * 16 + (_ln >> 4) * 4 + _r; const int col = (_w & 1) * (16 * NJ) + _j * 16 + (_ln & 15);
#define AV(a) a.v[_i][_j][_r]
#define ACC_END }}
#define ACC_FOR_PAIR(row, pcol) { const int _t = tid_(); const int _ln = _t & 63, _w = _t >> 6; \
    _Pragma("unroll") for (int _i = 0; _i < 4; ++_i) _Pragma("unroll") for (int _jj = 0; _jj < 2; ++_jj) _Pragma("unroll") for (int _r = 0; _r < 4; ++_r) { \
    const int row = (_w >> 1) * 64 + _i * 16 + (_ln >> 4) * 4 + _r; const int pcol = (_w & 1) * 32 + _jj * 16 + (_ln & 15);
#define AV_G(a) a.v[_i][2 * _jj][_r]
#define AV_U(a) a.v[_i][2 * _jj + 1][_r]

#define WAIT_VM0() asm volatile("s_waitcnt vmcnt(0)" ::: "memory")
#define GLDS16(gp, lp) __builtin_amdgcn_global_load_lds((const unsigned*)(gp), (unsigned*)(lp), 16, 0, 0)
template <int NJ, class AF, class BF>
HD void gemm_accum(AccT<NJ>& acc, AF arow, BF brow, int K, char* smem) {
    constexpr int NBL = NJ;
    const int t = tid_(), lane = t & 63, w = t >> 6, wr = w >> 1, wc = w & 1;
    const int lr = t >> 3, lc = t & 7;
    const bf16* ap[4]; const bf16* bp[NBL];
#pragma unroll
    for (int i = 0; i < 4; ++i) ap[i] = arow(lr + 32 * i) + ((lc ^ (lr & 7)) << 3);
#pragma unroll
    for (int i = 0; i < NBL; ++i) bp[i] = brow(lr + 32 * i) + ((lc ^ (lr & 7)) << 3);
    char* sA = smem + w * 1024; char* sB = smem + 32768 + w * 1024;
    const int fr = lane & 15, fg = lane >> 4;
    const unsigned aoff0 = (wr * 64 + fr) * 128 + (((fg) ^ (fr & 7)) << 4);
    const unsigned aoff1 = (wr * 64 + fr) * 128 + (((4 + fg) ^ (fr & 7)) << 4);
    const unsigned boff0 = (wc * (16 * NJ) + fr) * 128 + (((fg) ^ (fr & 7)) << 4);
    const unsigned boff1 = (wc * (16 * NJ) + fr) * 128 + (((4 + fg) ^ (fr & 7)) << 4);
    const int KT = K >> 6;
    __syncthreads();
#pragma unroll
    for (int i = 0; i < 4; ++i) GLDS16(ap[i], sA + 4096 * i);
#pragma unroll
    for (int i = 0; i < NBL; ++i) GLDS16(bp[i], sB + 4096 * i);
    WAIT_VM0();
    __syncthreads();
#pragma unroll 1
    for (int kt = 0; kt < KT; ++kt) {
        const int cur = kt & 1;
        if (kt + 1 < KT) {
#pragma unroll
            for (int i = 0; i < 4; ++i) GLDS16(ap[i] + (kt + 1) * 64, sA + (cur ^ 1) * 16384 + 4096 * i);
#pragma unroll
            for (int i = 0; i < NBL; ++i) GLDS16(bp[i] + (kt + 1) * 64, sB + (cur ^ 1) * 16384 + 4096 * i);
        }
        const char* cA = smem + cur * 16384; const char* cB = smem + 32768 + cur * 16384;
#pragma unroll
        for (int s = 0; s < 2; ++s) {
            bf16x8_t af[4], bfr[NJ];
#pragma unroll
            for (int i = 0; i < 4; ++i) af[i] = *(const bf16x8_t*)(cA + (s ? aoff1 : aoff0) + i * 2048);
#pragma unroll
            for (int j = 0; j < NJ; ++j) bfr[j] = *(const bf16x8_t*)(cB + (s ? boff1 : boff0) + j * 2048);
#pragma unroll
            for (int i = 0; i < 4; ++i)
#pragma unroll
                for (int j = 0; j < NJ; ++j) acc.v[i][j] = __builtin_amdgcn_mfma_f32_16x16x32_bf16(af[i], bfr[j], acc.v[i][j], 0, 0, 0);
        }
        WAIT_VM0();
        __syncthreads();
    }
}
template <int NJ> HD void acc_to_lds(const AccT<NJ>& acc, float* tl) {
    const int t = tid_(), lane = t & 63, w = t >> 6;
    constexpr int LD = 32 * NJ + 4;
    float* base = tl + ((w >> 1) * 64 + (lane >> 4) * 4) * LD + (w & 1) * (16 * NJ) + (lane & 15);
#pragma unroll
    for (int i = 0; i < 4; ++i)
#pragma unroll
        for (int j = 0; j < NJ; ++j)
#pragma unroll
            for (int r = 0; r < 4; ++r) base[(i * 16 + r) * LD + j * 16] = acc.v[i][j][r];
}
typedef int i32x8_t __attribute__((ext_vector_type(8)));
typedef unsigned char u8;
template <int NJ, class AF, class BF>
HD void gemm_accum8(AccT<NJ>& acc, AF arow, BF brow, int K, char* smem, int sa, int sb) {
    constexpr int NBL = NJ;
    const int t = tid_(), lane = t & 63, w = t >> 6, wr = w >> 1, wc = w & 1;
    const int lr = t >> 3, lc = t & 7;
    const u8* ap[4]; const u8* bp[NBL];
#pragma unroll
    for (int i = 0; i < 4; ++i) ap[i] = arow(lr + 32 * i) + ((lc ^ (lr & 7)) << 4);
#pragma unroll
    for (int i = 0; i < NBL; ++i) bp[i] = brow(lr + 32 * i) + ((lc ^ (lr & 7)) << 4);
    char* sA = smem + w * 1024; char* sB = smem + 32768 + w * 1024;
    const int fr = lane & 15, fg = lane >> 4;
    const unsigned aoff0 = (wr * 64 + fr) * 128 + (((2 * fg) ^ (fr & 7)) << 4);
    const unsigned aoff1 = (wr * 64 + fr) * 128 + (((2 * fg + 1) ^ (fr & 7)) << 4);
    const unsigned boff0 = (wc * (16 * NJ) + fr) * 128 + (((2 * fg) ^ (fr & 7)) << 4);
    const unsigned boff1 = (wc * (16 * NJ) + fr) * 128 + (((2 * fg + 1) ^ (fr & 7)) << 4);
    const int KT = K >> 7;
    __syncthreads();
#pragma unroll
    for (int i = 0; i < 4; ++i) GLDS16(ap[i], sA + 4096 * i);
#pragma unroll
    for (int i = 0; i < NBL; ++i) GLDS16(bp[i], sB + 4096 * i);
    WAIT_VM0();
    __syncthreads();
#pragma unroll 1
    for (int kt = 0; kt < KT; ++kt) {
        const int cur = kt & 1;
        if (kt + 1 < KT) {
#pragma unroll
            for (int i = 0; i < 4; ++i) GLDS16(ap[i] + (kt + 1) * 128, sA + (cur ^ 1) * 16384 + 4096 * i);
#pragma unroll
            for (int i = 0; i < NBL; ++i) GLDS16(bp[i] + (kt + 1) * 128, sB + (cur ^ 1) * 16384 + 4096 * i);
        }
        const char* cA = smem + cur * 16384; const char* cB = smem + 32768 + cur * 16384;
        i32x8_t af[4], bfr[NJ];
#pragma unroll
        for (int i = 0; i < 4; ++i) {
            const i32x4_t lo = *(const i32x4_t*)(cA + aoff0 + i * 2048), hi = *(const i32x4_t*)(cA + aoff1 + i * 2048);
            af[i] = i32x8_t{lo[0], lo[1], lo[2], lo[3], hi[0], hi[1], hi[2], hi[3]};
        }
#pragma unroll
        for (int j = 0; j < NJ; ++j) {
            const i32x4_t lo = *(const i32x4_t*)(cB + boff0 + j * 2048), hi = *(const i32x4_t*)(cB + boff1 + j * 2048);
            bfr[j] = i32x8_t{lo[0], lo[1], lo[2], lo[3], hi[0], hi[1], hi[2], hi[3]};
        }
#pragma unroll
        for (int i = 0; i < 4; ++i)
#pragma unroll
            for (int j = 0; j < NJ; ++j) acc.v[i][j] = __builtin_amdgcn_mfma_scale_f32_16x16x128_f8f6f4(af[i], bfr[j], acc.v[i][j], 0, 0, 0, sa, 0, sb);
        WAIT_VM0();
        __syncthreads();
    }
}
HD unsigned pack_fp8x4(float a, float b, float c, float d) {
    a = __builtin_amdgcn_fmed3f(a, -448.f, 448.f); b = __builtin_amdgcn_fmed3f(b, -448.f, 448.f);
    c = __builtin_amdgcn_fmed3f(c, -448.f, 448.f); d = __builtin_amdgcn_fmed3f(d, -448.f, 448.f);
    int w = 0;
    w = __builtin_amdgcn_cvt_pk_fp8_f32(a, b, w, false);
    w = __builtin_amdgcn_cvt_pk_fp8_f32(c, d, w, true);
    return (unsigned)w;
}
constexpr int SC_H = 0x7d7d7d7d;
constexpr int SC_W = 0x7a7a7a7a;
constexpr int SC_ACT = 0x7b7b7b7b;
template <int NJ, class AF, class BF>
HD void gemm_stage0(AF arow, BF brow, int ebytes, char* smem, int buf) {
    const int t = tid_(), w = t >> 6, lr = t >> 3, lc = t & 7;
    char* sA = smem + w * 1024 + buf * 16384; char* sB = smem + 32768 + w * 1024 + buf * 16384;
    (void)ebytes;
#pragma unroll
    for (int i = 0; i < 4; ++i) GLDS16((const char*)arow(lr + 32 * i) + ((lc ^ (lr & 7)) << 4), sA + 4096 * i);
#pragma unroll
    for (int i = 0; i < NJ; ++i) GLDS16((const char*)brow(lr + 32 * i) + ((lc ^ (lr & 7)) << 4), sB + 4096 * i);
}
template <int NJ, bool FP8, class AF, class BF, class NF>
HD void gemm_chain(AccT<NJ>& acc, AF arow, BF brow, int K, char* smem, int& cur, NF next_stage, int sa, int sb) {
    const int t = tid_(), lane = t & 63, w = t >> 6, wr = w >> 1, wc = w & 1;
    const int lr = t >> 3, lc = t & 7;
    const char* ap[4]; const char* bp[NJ];
#pragma unroll
    for (int i = 0; i < 4; ++i) ap[i] = (const char*)arow(lr + 32 * i) + ((lc ^ (lr & 7)) << 4);
#pragma unroll
    for (int i = 0; i < NJ; ++i) bp[i] = (const char*)brow(lr + 32 * i) + ((lc ^ (lr & 7)) << 4);
    char* sA = smem + w * 1024; char* sB = smem + 32768 + w * 1024;
    const int fr = lane & 15, fg = lane >> 4;
    const unsigned rA = (wr * 64 + fr) * 128, rB = (wc * (16 * NJ) + fr) * 128;
    const int KT = K >> (FP8 ? 7 : 6);
#pragma unroll 1
    for (int kt = 0; kt < KT; ++kt) {
        WAIT_VM0();
        __syncthreads();
        if (kt + 1 < KT) {
#pragma unroll
            for (int i = 0; i < 4; ++i) GLDS16(ap[i] + (kt + 1) * 128, sA + (cur ^ 1) * 16384 + 4096 * i);
#pragma unroll
            for (int i = 0; i < NJ; ++i) GLDS16(bp[i] + (kt + 1) * 128, sB + (cur ^ 1) * 16384 + 4096 * i);
        } else next_stage(cur ^ 1);
        const char* cA = smem + cur * 16384; const char* cB = smem + 32768 + cur * 16384;
        if (FP8) {
            i32x8_t af[4], bfr[NJ];
#pragma unroll
            for (int i = 0; i < 4; ++i) {
                const i32x4_t lo = *(const i32x4_t*)(cA + rA + (((2 * fg) ^ (fr & 7)) << 4) + i * 2048), hi = *(const i32x4_t*)(cA + rA + (((2 * fg + 1) ^ (fr & 7)) << 4) + i * 2048);
                af[i] = i32x8_t{lo[0], lo[1], lo[2], lo[3], hi[0], hi[1], hi[2], hi[3]};
            }
#pragma unroll
            for (int j = 0; j < NJ; ++j) {
                const i32x4_t lo = *(const i32x4_t*)(cB + rB + (((2 * fg) ^ (fr & 7)) << 4) + j * 2048), hi = *(const i32x4_t*)(cB + rB + (((2 * fg + 1) ^ (fr & 7)) << 4) + j * 2048);
                bfr[j] = i32x8_t{lo[0], lo[1], lo[2], lo[3], hi[0], hi[1], hi[2], hi[3]};
            }
#pragma unroll
            for (int i = 0; i < 4; ++i)
#pragma unroll
                for (int j = 0; j < NJ; ++j) acc.v[i][j] = __builtin_amdgcn_mfma_scale_f32_16x16x128_f8f6f4(af[i], bfr[j], acc.v[i][j], 0, 0, 0, sa, 0, sb);
        } else {
#pragma unroll
            for (int s_ = 0; s_ < 2; ++s_) {
                bf16x8_t af[4], bfr[NJ];
#pragma unroll
                for (int i = 0; i < 4; ++i) af[i] = *(const bf16x8_t*)(cA + rA + (((4 * s_ + fg) ^ (fr & 7)) << 4) + i * 2048);
#pragma unroll
                for (int j = 0; j < NJ; ++j) bfr[j] = *(const bf16x8_t*)(cB + rB + (((4 * s_ + fg) ^ (fr & 7)) << 4) + j * 2048);
#pragma unroll
                for (int i = 0; i < 4; ++i)
#pragma unroll
                    for (int j = 0; j < NJ; ++j) acc.v[i][j] = __builtin_amdgcn_mfma_f32_16x16x32_bf16(af[i], bfr[j], acc.v[i][j], 0, 0, 0);
            }
        }
        cur ^= 1;
    }
}
#else
template <int NJ> struct AccT { float v[128][32 * NJ]; };
#define ACC_DECL(NJ, a) static thread_local AccT<NJ> a
template <int NJ> HD void acc_zero(AccT<NJ>& a) { memset(a.v, 0, sizeof(a.v)); }
#define ACC_FOR(NJ, row, col) { for (int row = 0; row < 128; ++row) for (int col = 0; col < 32 * NJ; ++col) {
#define AV(a) a.v[row][col]
#define ACC_END }}
#define ACC_FOR_PAIR(row, pcol) { for (int row = 0; row < 128; ++row) for (int pcol = 0; pcol < 64; ++pcol) {
#define AV_G(a) a.v[row][(pcol / 16) * 32 + (pcol % 16)]
#define AV_U(a) a.v[row][(pcol / 16) * 32 + 16 + (pcol % 16)]
template <int NJ, class AF, class BF>
HD void gemm_accum(AccT<NJ>& acc, AF arow, BF brow, int K, char* smem) {
    for (int i = 0; i < 128; ++i) { const bf16* a = arow(i);
        for (int j = 0; j < 32 * NJ; ++j) { const bf16* b = brow(j); float s = 0.f;
            for (int k = 0; k < K; ++k) s += bf2f(a[k]) * bf2f(b[k]);
            acc.v[i][j] += s; } }
}
#endif

template <class DF>
HD void conv_tile(const float* src, size_t lds_, bf16* dst, size_t ldd, int k0, int nsrc0, DF drow, float* sm) {
    THREADS(t, 4096) { int kk = t >> 6, nn = t & 63; sm[kk * 65 + nn] = src[(size_t)(k0 + kk) * lds_ + nsrc0 + nn]; }
    SYNC
    THREADS(t, 4096) { int nn = t >> 6, kk = t & 63; dst[(size_t)drow(nn) * ldd + k0 + kk] = f2bf(sm[kk * 65 + nn]); }
    SYNC
}
#ifndef CPU_EMU
template <class DF>
HD void conv_tile8(const float* src, size_t lds_, unsigned char* dst, size_t ldd, int k0, int nsrc0, DF drow, float scale, float* sm) {
    THREADS(t, 4096) { int kk = t >> 6, nn = t & 63; sm[kk * 65 + nn] = src[(size_t)(k0 + kk) * lds_ + nsrc0 + nn] * scale; }
    SYNC
    THREADS(t, 1024) { int nn = t >> 4, k4 = (t & 15) * 4;
        *(unsigned*)(dst + (size_t)drow(nn) * ldd + k0 + k4) = pack_fp8x4(sm[k4 * 65 + nn], sm[(k4 + 1) * 65 + nn], sm[(k4 + 2) * 65 + nn], sm[(k4 + 3) * 65 + nn]); }
    SYNC
}
HD void convert_moe(const Params& p, int l, int bid, int nb, float* sm) {
    for (int w = bid; w < 4096 + 2048; w += nb) {
        if (w < 4096) {
            int nt = w & 7, kt = (w >> 3) & 15, gu = (w >> 7) & 1, e = w >> 8;
            const float* src = p.in[gu ? I_MU : I_MG] + (size_t)(l * 16 + e) * D * 512;
            conv_tile8(src, 512, gu8_of(p) + (size_t)e * 1024 * D, D, kt * 64, nt * 64, [&](int nn) { int j = nt * 64 + nn; return (j >> 4) * 32 + (j & 15) + 16 * gu; }, 32.0f, sm);
        } else {
            int w2 = w - 4096; int nt = w2 & 15, kt = (w2 >> 4) & 7, e = w2 >> 7;
            const float* src = p.in[I_MD] + (size_t)(l * 16 + e) * 512 * D;
            conv_tile8(src, D, d8_of(p) + (size_t)e * D * 512, 512, kt * 64, nt * 64, [&](int nn) { return nt * 64 + nn; }, 32.0f, sm);
        }
    }
}
#else
HD void convert_moe(const Params& p, int l, int bid, int nb, float* sm) {
    for (int w = bid; w < 4096 + 2048; w += nb) {
        if (w < 4096) {
            int nt = w & 7, kt = (w >> 3) & 15, gu = (w >> 7) & 1, e = w >> 8;
            const float* src = p.in[gu ? I_MU : I_MG] + (size_t)(l * 16 + e) * D * 512;
            bf16* dst = p.wt_gu + (size_t)e * 1024 * D;
            conv_tile(src, 512, dst, D, kt * 64, nt * 64, [&](int nn) { int j = nt * 64 + nn; return (j >> 4) * 32 + (j & 15) + 16 * gu; }, sm);
        } else {
            int w2 = w - 4096; int nt = w2 & 15, kt = (w2 >> 4) & 7, e = w2 >> 7;
            const float* src = p.in[I_MD] + (size_t)(l * 16 + e) * 512 * D;
            bf16* dst = p.wt_d + (size_t)e * D * 512;
            conv_tile(src, D, dst, 512, kt * 64, nt * 64, [&](int nn) { return nt * 64 + nn; }, sm);
        }
    }
}
#endif
HD void convert_static(const Params& p, int bid, int nb, float* sm, int part) {
    for (int w = bid; w < 3456 + 512 + 512 + 32; w += nb) {
        {
            const bool is_win = (w < 3456), is_ab = (w >= 3456 + 512 + 512);
            const int wl = is_win ? (w / (108 * 16)) : (is_ab ? ((w - 3456 - 512 - 512) >> 4) : 1);
            const bool early = (is_win || is_ab) && wl == 0;
            if ((part == 0) != early) continue;
        }
        if (w >= 3456 + 512 + 512) {
            int w2 = w - 3456 - 512 - 512; int kt = w2 & 15, l = w2 >> 4;
            conv_tile(p.in[I_WIN] + (size_t)l * D * DIN, DIN, p.wt_in + (size_t)l * WIN_NP * D, D, kt * 64, 2560, [&](int nn) { return WIN_N + nn; }, sm);
        } else if (w < 3456) {
            int nt = w % 108, kt = (w / 108) & 15, l = w / (108 * 16);
            int n0 = nt * 64;
#ifndef CPU_EMU
            if (n0 >= PLD) {
                conv_tile8(p.in[I_WIN] + (size_t)l * D * DIN, DIN, (unsigned char*)(p.wt_in + (size_t)l * WIN_NP * D + (size_t)PLD * D), D, kt * 64, n0 + 16,
                           [&](int nn) { return n0 - PLD + nn; }, 32.0f, sm);
                continue;
            }
#endif
            conv_tile(p.in[I_WIN] + (size_t)l * D * DIN, DIN, p.wt_in + (size_t)l * WIN_NP * D, D, kt * 64, n0 < 2560 ? n0 : n0 + 16,
                      [&](int nn) { return n0 + nn; }, sm);
        } else if (w < 3456 + 512) {
            int w2 = w - 3456; int nt = w2 & 15, kt = (w2 >> 4) & 3, li = w2 >> 6;
            conv_tile(p.in[I_WBR] + (size_t)li * 256 * D, D, p.wt_br + (size_t)li * D * 256, 256, kt * 64, nt * 64, [&](int nn) { return nt * 64 + nn; }, sm);
        } else {
            int w2 = w - 3456 - 512; int nt = w2 & 15, kt = (w2 >> 4) & 15, l = w2 >> 8;
            conv_tile(p.in[I_WOUT] + (size_t)l * D * D, D, p.wt_out + (size_t)l * D * D, D, kt * 64, nt * 64, [&](int nn) { return nt * 64 + nn; }, sm);
        }
    }
}

HD void init_tables(const Params& p, int bid, int nb) {
    for (int u = bid; u < (SEQ + 255) / 256; u += nb) {
        THREADS(t, 256) {
            int j = u * 256 + t;
            if (j < SEQ) { float a = 2.0f * (float)j / (float)SEQ; p.cosT[j] = COSPI(a); p.sinT[j] = SINPI(a); }
        }
    }
    if (bid == 0) {
        THREADS(t, 1024) {
            int pos = t >> 3, f = t & 7; float fr_ = 1.0f;
            for (int q = 0; q < f; ++q) fr_ *= 0.31622776601683794f;
            float ang = (float)pos * fr_;
            p.ropeT[t * 2] = cosf(ang); p.ropeT[t * 2 + 1] = sinf(ang);
        }
    }
    for (int u = bid; u < (CTXL * 2 * CTXL) / 256; u += nb) {
        THREADS(t, 256) {
            int i = u * 256 + t; int k = i / (2 * CTXL), q = i % (2 * CTXL); int cs = q / CTXL, tt = q % CTXL;
            float a = 2.0f * (float)((k * tt) % CTXL) / (float)CTXL;
            p.fWC[i] = f2bf(cs ? -SINPI(a) : COSPI(a));
        }
    }
    for (int u = bid; u < (8192 + 65536 + 8192) / 256; u += nb) {
        THREADS(t, 256) {
            int i = u * 256 + t;
            if (i < 8192) {
                int j = i >> 6, c = i & 63; int cs = j >> 6, m = j & 63;
                float a = 2.0f * (float)((m * c) & 63) / 64.0f;
                p.fW1[i] = f2bf(cs ? SINPI(a) : COSPI(a));
            } else if (i < 8192 + 65536) {
                int q = i - 8192; int n = q >> 8, k = q & 255;
                int ri = (n >> 4) & 1, k1 = (n >> 5) * 16 + (n & 15); int cs = k >> 7, t1 = k & 127;
                float a = 2.0f * (float)((k1 * t1) & 127) / 128.0f;
                float cv = COSPI(a), sv = SINPI(a);
                float v = (ri == 0) ? (cs == 0 ? cv : -sv) : (cs == 0 ? -sv : -cv);
                p.fWA[q] = f2bf(v);
            } else {
                int q = i - 8192 - 65536; int k2 = q >> 7, k = q & 127; int ri = k >> 6, t2 = k & 63;
                float a = 2.0f * (float)((k2 * t2) & 63) / 64.0f;
                p.fWB[q] = f2bf(ri ? SINPI(a) : COSPI(a));
            }
        }
    }
}

HD void ph_init(const Params& p, int bid, int nb, float* sm) {
    const int NMOD = 2 * 3 * 6144;
    if (bid == 0) { THREADS(t, 32) { p.cnt[t] = 0; } }
#ifndef CPU_EMU
    {
        const int tq = tid_(); const int col = tq & 63, ks = tq >> 6;
        for (int u = nb - 1 - bid; u < 2 * 96; u += nb) {
            const int l = u / 96, c0 = (u % 96) * 64;
            __syncthreads();
            for (int i = tq; i < 3 * D; i += 256) { const int s_ = i / D, k = i % D; const float cv = (s_ < 2) ? p.in[I_C][s_ * D + k] : p.in[I_CCTX][k]; sm[i] = siluf_(cv); }
            __syncthreads();
            const float* wp = p.in[I_WMOD] + (size_t)l * D * 6144 + (size_t)(ks * 256) * 6144 + c0 + col;
            float a0 = 0.f, a1 = 0.f, a2 = 0.f;
#pragma unroll 8
            for (int k = 0; k < 256; ++k) { const float wv = wp[(size_t)k * 6144]; a0 += sm[ks * 256 + k] * wv; a1 += sm[D + ks * 256 + k] * wv; a2 += sm[2 * D + ks * 256 + k] * wv; }
            float* red = sm + 3 * D;
            red[(ks * 3 + 0) * 64 + col] = a0; red[(ks * 3 + 1) * 64 + col] = a1; red[(ks * 3 + 2) * 64 + col] = a2;
            __syncthreads();
            if (tq < 192) {
                const int s_ = tq >> 6, cc = tq & 63;
                const float v = red[(0 * 3 + s_) * 64 + cc] + red[(1 * 3 + s_) * 64 + cc] + red[(2 * 3 + s_) * 64 + cc] + red[(3 * 3 + s_) * 64 + cc];
                p.mods[(size_t)(l * 3 + s_) * 6144 + c0 + cc] = v + p.in[I_BMOD][l * 6144 + c0 + cc];
            }
        }
    }
    convert_static(p, bid, nb, sm, 0);
#else
    convert_static(p, bid, nb, sm, 0);
    for (int u = bid; u < (NMOD + 255) / 256; u += nb) {
        THREADS(t, 256) {
            int idx = u * 256 + t;
            if (idx < NMOD) {
                int l = idx / (3 * 6144), s = (idx / 6144) % 3, col = idx % 6144;
                const float* cv = (s < 2) ? p.in[I_C] + s * D : p.in[I_CCTX];
                const float* w = p.in[I_WMOD] + (size_t)l * D * 6144 + col;
                float acc = 0.f;
                for (int k = 0; k < D; ++k) acc += siluf_(cv[k]) * w[(size_t)k * 6144];
                p.mods[idx] = acc + p.in[I_BMOD][l * 6144 + col];
            }
        }
    }
#endif
    init_tables(p, bid, nb);
    for (int u = bid; u < (NCTX * D) / 256; u += nb) {
        THREADS(t, 256) { int i = u * 256 + t; p.cs[i] = p.in[I_CTX][i]; }
    }

}

#ifndef CPU_EMU
HD float wave_sum(float v) {
#pragma unroll
    for (int o = 32; o >= 1; o >>= 1) v += __shfl_xor(v, o);
    return v;
}
HD void ph_norm1(const Params& p, int l, int bid, int nb, float* sm) {
    const int t = tid_(), lane = t & 63, w = t >> 6;
    const float* g = p.in[I_N1G] + l * D;
    for (int r = bid * 4 + w; r < R; r += nb * 4) {
        const float* x = xrow_in(p, l, r);
        const float* m = modrow(p, l, r);
        f32x4_t xv[4]; float ss = 0.f;
#pragma unroll
        for (int j = 0; j < 4; ++j) { xv[j] = *(const f32x4_t*)(x + j * 256 + lane * 4); ss += xv[j][0] * xv[j][0] + xv[j][1] * xv[j][1] + xv[j][2] * xv[j][2] + xv[j][3] * xv[j][3]; }
        ss = wave_sum(ss);
        const float rs = 1.0f / sqrtf(ss / D + 1e-6f);
#pragma unroll
        for (int j = 0; j < 4; ++j) {
            const int k = j * 256 + lane * 4;
            const f32x4_t gv = *(const f32x4_t*)(g + k), sc = *(const f32x4_t*)(m + 1024 + k), sh = *(const f32x4_t*)(m + k);
            float o[4];
#pragma unroll
            for (int q = 0; q < 4; ++q) o[q] = xv[j][q] * rs * gv[q] * (1.0f + sc[q]) + sh[q];
            uint2 pk; pk.x = cvtpk(o[0], o[1]); pk.y = cvtpk(o[2], o[3]);
            *(uint2*)(p.h + (size_t)r * D + k) = pk;
            *(unsigned*)(h8_of(p) + (size_t)r * D + k) = pack_fp8x4(o[0] * 4.f, o[1] * 4.f, o[2] * 4.f, o[3] * 4.f);
        }
    }
}
#else
HD void ph_norm1(const Params& p, int l, int bid, int nb, float* sm) {
    const float* g = p.in[I_N1G] + l * D;
    for (int r = bid; r < R; r += nb) {
        const float* x = xrow_in(p, l, r);
        const float* m = modrow(p, l, r);
        THREADS(t, 256) { float s = 0.f; for (int k = t; k < D; k += 256) s += x[k] * x[k]; sm[t] = s; }
        SYNC
        THREADS(t, 1) { float s = 0.f; for (int i = 0; i < 256; ++i) s += sm[i]; sm[256] = s; }
        SYNC
        THREADS(t, 256) {
            float rs = 1.0f / sqrtf(sm[256] / D + 1e-6f);
            for (int k = t; k < D; k += 256) {
                float v = x[k] * rs * g[k];
                p.h[(size_t)r * D + k] = f2bf(v * (1.0f + m[1024 + k]) + m[k]);
            }
        }
        SYNC
    }
}
#endif

HD void ph_inproj(const Params& p, int l, int bid, int nb, char* smc) {
    const bf16* Wt = p.wt_in + (size_t)l * WIN_NP * D;
    constexpr int NT = PLD / 128, MT = R / 128;
    for (int mt = bid; mt < MT; mt += nb) {
        ACC_DECL(2, acc); acc_zero(acc);
        gemm_accum<2>(acc, [&](int i) { return p.h + (size_t)(mt * 128 + i) * D; }, [&](int j) { return Wt + (size_t)(WIN_N + j) * D; }, D, smc);
        ACC_FOR(2, row, col) {
            const int r = mt * 128 + row;
            if (col < 8) {
                const float xx = AV(acc) + p.in[I_DTB][l * 8 + col];
                const float sp = xx > 20.f ? xx : log1pf(expf(xx));
                p.gg[(size_t)col * R + r] = -expf(p.in[I_ALOG][l * 8 + col]) * sp;
            } else if (col < 16) p.gbeta[(size_t)(col - 8) * R + r] = sigmoidf_(AV(acc));
        } ACC_END
    }
    for (int tile = bid; tile < MT * NT; tile += nb) {
        const int mt = tile / NT, nt = tile % NT;
        ACC_DECL(4, acc); acc_zero(acc);
        gemm_accum<4>(acc, [&](int i) { return p.h + (size_t)(mt * 128 + i) * D; }, [&](int j) { return Wt + (size_t)(nt * 128 + j) * D; }, D, smc);
#ifndef CPU_EMU
        {
            float* tl = (float*)smc;
            acc_to_lds<4>(acc, tl);
            __syncthreads();
            const int t_ = tid_(); const int row = t_ >> 1, half = t_ & 1;
            const int cb = nt * 128 + half * 64;
            float v[64];
#pragma unroll
            for (int q = 0; q < 16; ++q) { const f32x4_t x4 = *(const f32x4_t*)(tl + row * 132 + half * 64 + q * 4); v[q * 4] = x4[0]; v[q * 4 + 1] = x4[1]; v[q * 4 + 2] = x4[2]; v[q * 4 + 3] = x4[3]; }
            if (cb < 512) {
                const float* gn = (cb < 256 ? p.in[I_NAQG] : p.in[I_NAKG]) + l * 64;
                float ss = 0.f;
#pragma unroll
                for (int c = 0; c < 64; ++c) ss += v[c] * v[c];
                const float rs = __builtin_amdgcn_rsqf(ss * (1.0f / 64.0f) + 1e-6f) * ((cb < 256) ? 0.125f * 1.4426950408889634f : 1.0f);
#pragma unroll
                for (int c = 0; c < 64; ++c) v[c] *= rs * gn[c];
            } else if (cb >= 768 && cb < 1280) {
                const float* gn = (cb < 1024 ? p.in[I_DAQG] : p.in[I_DAKG]) + l * 32;
                const float qs = (cb < 1024) ? 0.17677669529663687f * 1.4426950408889634f : 1.0f;
#pragma unroll
                for (int gp = 0; gp < 2; ++gp) {
                    float ss = 0.f;
#pragma unroll
                    for (int c = 0; c < 32; ++c) ss += v[gp * 32 + c] * v[gp * 32 + c];
                    const float rs = __builtin_amdgcn_rsqf(ss * (1.0f / 32.0f) + 1e-6f) * qs;
#pragma unroll
                    for (int c = 0; c < 32; ++c) v[gp * 32 + c] *= rs * gn[c];
                }
                const int gr_ = mt * 128 + row;
                if (gr_ < NLAT) {
                    const int tt = gr_ % SEQ;
#pragma unroll
                    for (int a = 0; a < 2; ++a) {
                        const float pos = (float)(a == 0 ? tt / GW : tt % GW);
                        float frev = 0.15915494309189535f;
#pragma unroll
                        for (int f = 0; f < 8; ++f) {
                            const float cs = __builtin_amdgcn_cosf(pos * frev), sn = __builtin_amdgcn_sinf(pos * frev);
#pragma unroll
                            for (int gp = 0; gp < 2; ++gp) {
                                const int i1 = gp * 32 + a * 16 + f, i2 = i1 + 8;
                                const float x1 = v[i1], x2 = v[i2];
                                v[i1] = x1 * cs - x2 * sn; v[i2] = x2 * cs + x1 * sn;
                            }
                            frev *= 0.31622776601683794f;
                        }
                    }
                }
            }
            bf16* dst = p.P + (size_t)(mt * 128 + row) * PLD + cb;
#pragma unroll
            for (int q = 0; q < 8; ++q) {
                uint4 pk; pk.x = cvtpk(v[q * 8], v[q * 8 + 1]); pk.y = cvtpk(v[q * 8 + 2], v[q * 8 + 3]); pk.z = cvtpk(v[q * 8 + 4], v[q * 8 + 5]); pk.w = cvtpk(v[q * 8 + 6], v[q * 8 + 7]);
                *(uint4*)(dst + q * 8) = pk;
            }
        }
#else
        ACC_FOR(4, row, col) { p.P[(size_t)(mt * 128 + row) * PLD + nt * 128 + col] = f2bf(AV(acc)); } ACC_END
#endif
    }
}

HD void ph_prep(const Params& p, int l, int bid, int nb) {
#ifdef CPU_EMU
    {
        const float* naq = p.in[I_NAQG] + l * 64; const float* nak = p.in[I_NAKG] + l * 64;
        const float* daq = p.in[I_DAQG] + l * 32; const float* dak = p.in[I_DAKG] + l * 32;
        const int N = R * 24;
        for (int u = bid; u < (N + 255) / 256; u += nb) {
            THREADS(t, 256) {
                int idx = u * 256 + t;
                if (idx < N) {
                    int r = idx / 24, gidx = idx % 24;
                    if (gidx < 8) {
                        int isk = gidx >> 2, hd = gidx & 3;
                        bf16* ptr = p.P + (size_t)r * PLD + (isk ? C_NAK : C_NAQ) + hd * 64;
                        const float* g = isk ? nak : naq;
                        float ss = 0.f;
                        for (int d = 0; d < 64; ++d) { float v = bf2f(ptr[d]); ss += v * v; }
                        float rs = 1.0f / sqrtf(ss / 64.0f + 1e-6f);
#ifndef CPU_EMU
                        if (!isk) rs *= 0.125f * 1.4426950408889634f;
#endif
                        for (int d = 0; d < 64; ++d) ptr[d] = f2bf(bf2f(ptr[d]) * rs * g[d]);
                    } else {
                        int gi = gidx - 8; int isk = gi >> 3; int hm = gi & 7;
                        bf16* ptr = p.P + (size_t)r * PLD + (isk ? C_DAK : C_DAQ) + hm * 32;
                        const float* g = isk ? dak : daq;
                        float ss = 0.f;
                        for (int d = 0; d < 32; ++d) { float v = bf2f(ptr[d]); ss += v * v; }
                        float rs = 1.0f / sqrtf(ss / 32.0f + 1e-6f);
#ifndef CPU_EMU
                        if (!isk) rs *= 0.17677669529663687f * 1.4426950408889634f;
#endif
                        if (r < NLAT) {
                            int tt = r % SEQ; float prow = (float)(tt / GW), pcol = (float)(tt % GW);
                            for (int a = 0; a < 2; ++a) {
                                float pos = a == 0 ? prow : pcol;
                                float fr = 1.0f;
                                for (int f = 0; f < 8; ++f) {
                                    float ang = pos * fr;
                                    float cs = cosf(ang), sn = sinf(ang);
                                    int i1 = a * 16 + f, i2 = a * 16 + 8 + f;
                                    float x1 = bf2f(ptr[i1]) * rs * g[i1], x2 = bf2f(ptr[i2]) * rs * g[i2];
                                    ptr[i1] = f2bf(x1 * cs - x2 * sn);
                                    ptr[i2] = f2bf(x2 * cs + x1 * sn);
                                    fr *= 0.31622776601683794f;
                                }
                            }
                        } else {
                            for (int d = 0; d < 32; ++d) ptr[d] = f2bf(bf2f(ptr[d]) * rs * g[d]);
                        }
                    }
                }
            }
        }
    }
#endif
#ifndef CPU_EMU
    {
        const float* cw = p.in[I_CONVW] + (size_t)l * 5 * 768;
        const int N = R * 96;
        for (int idx = bid * 256 + tid_(); idx < N; idx += nb * 256) {
            const int r = idx / 96, q = idx % 96; const int ph = q >> 3, cg = q & 7; const int part = ph >> 2, hd = ph & 3;
            const RowInfo ri = rowinfo(r);
            const int ch0 = part * 256 + hd * 64 + cg * 8;
            float y[8];
#pragma unroll
            for (int c = 0; c < 8; ++c) y[c] = 0.f;
#pragma unroll
            for (int i = 0; i < 5; ++i) {
                const int tt = ri.t + i - 2;
                if (tt >= 0 && tt < ri.T) {
                    const uint4 raw = *(const uint4*)(p.P + (size_t)(ri.base + tt) * PLD + C_GQ + ch0);
                    const f32x4_t w0 = *(const f32x4_t*)(cw + i * 768 + ch0), w1 = *(const f32x4_t*)(cw + i * 768 + ch0 + 4);
                    y[0] += __uint_as_float(raw.x << 16) * w0[0]; y[1] += __uint_as_float(raw.x & 0xffff0000u) * w0[1];
                    y[2] += __uint_as_float(raw.y << 16) * w0[2]; y[3] += __uint_as_float(raw.y & 0xffff0000u) * w0[3];
                    y[4] += __uint_as_float(raw.z << 16) * w1[0]; y[5] += __uint_as_float(raw.z & 0xffff0000u) * w1[1];
                    y[6] += __uint_as_float(raw.w << 16) * w1[2]; y[7] += __uint_as_float(raw.w & 0xffff0000u) * w1[3];
                }
            }
            float ss = 0.f;
#pragma unroll
            for (int c = 0; c < 8; ++c) { y[c] = siluf_(y[c]); ss += y[c] * y[c]; }
            ss += __shfl_xor(ss, 1); ss += __shfl_xor(ss, 2); ss += __shfl_xor(ss, 4);
            float scl = 1.0f;
            if (part == 0) scl = 0.125f / sqrtf(ss + 1e-6f); else if (part == 1) scl = 1.0f / sqrtf(ss + 1e-6f);
            uint4 pk; pk.x = cvtpk(y[0] * scl, y[1] * scl); pk.y = cvtpk(y[2] * scl, y[3] * scl); pk.z = cvtpk(y[4] * scl, y[5] * scl); pk.w = cvtpk(y[6] * scl, y[7] * scl);
            *(uint4*)(p.gq + (size_t)r * 768 + ch0) = pk;
        }
    }
#else
    {
        const float* cw = p.in[I_CONVW] + (size_t)l * 5 * 768;
        const int N = R * 12;
        for (int u = bid; u < (N + 255) / 256; u += nb) {
            THREADS(t, 256) {
                int idx = u * 256 + t;
                if (idx < N) {
                    int r = idx / 12, ph = idx % 12; int part = ph >> 2, hd = ph & 3;
                    RowInfo ri = rowinfo(r);
                    int ch0 = part * 256 + hd * 64;
                    float ss = 0.f;
                    for (int pass = 0; pass < 2; ++pass) {
                        float scl = 1.0f;
                        if (pass == 1) { if (part == 0) scl = 0.125f / sqrtf(ss + 1e-6f); else if (part == 1) scl = 1.0f / sqrtf(ss + 1e-6f); }
                        if (pass == 0 && part == 2) continue;
                        for (int c = 0; c < 64; ++c) {
                            float y = 0.f;
                            for (int i = 0; i < 5; ++i) {
                                int tt = ri.t + i - 2;
                                if (tt >= 0 && tt < ri.T) y += bf2f(p.P[(size_t)(ri.base + tt) * PLD + C_GQ + ch0 + c]) * cw[i * 768 + ch0 + c];
                            }
                            y = siluf_(y);
                            if (pass == 0) ss += y * y; else p.gq[(size_t)r * 768 + ch0 + c] = f2bf(y * scl);
                        }
                    }
                }
            }
        }
    }
#endif
    {
        const int RQ = (l == 0) ? R : NLAT;
        for (int r = (FOURIER_GEMM ? RQ : 0) + bid; r < RQ; r += nb) {
            THREADS(t, 256) {
                int g = t >> 6, m = t & 63;
                const bf16* f = p.P + (size_t)r * PLD + C_F + g * 64;
                float fc = 0.f, fs = 0.f;
                for (int c = 0; c < 64; ++c) {
                    int ti = ((m * c) & 63) * (SEQ / 64);
                    float v = bf2f(f[c]);
                    fc += v * p.cosT[ti]; fs += v * p.sinT[ti];
                }
                p.fcs[(size_t)r * 512 + t] = f2bf(fc);
                p.fcs[(size_t)r * 512 + 256 + t] = f2bf(fs);
                if (FOURIER_GEMM && r >= NLAT) {
                    const int rc = r - NLAT; const int bb = rc / CTXL, tt = rc % CTXL;
                    bf16* xc = p.fXC + (((size_t)bb * 256 + t) * 2) * CTXL + tt;
                    xc[0] = f2bf(fc); xc[CTXL] = f2bf(fs);
                }
            }
        }
    }
}

#ifndef CPU_EMU
HD void ph_na(const Params& p, int l, int bid, int nb, char* smc) {
    const int t = tid_(), lane = t & 63, w = t >> 6, fr = lane & 15, fg = lane >> 4;
    const float* rpb = p.in[I_RPB] + (size_t)l * 4 * 15 * 31;
    float* sbias = (float*)(smc + 32768);
    const lds_cptr lds = (lds_cptr)smc;
    constexpr int WH = ROWS < 8 ? ROWS : 8;
    const int nlat = NB * ROWS * 4;
    const int nctx = (l == 0) ? NB * 4 * (CTXL / 64) : 0;
    const int lkey = t >> 3, lc = t & 7;
    const int ksrc = (lc ^ (lkey & 7)) << 3;
    const int vsrc = ((((lc >> 1) ^ ((lkey >> 1) & 3)) << 1) | (lc & 1)) << 3;
    for (int unit = bid; unit < nlat + nctx; unit += nb) {
        int b, hd, qrow, ntl, rs = 0, gr = 0;
        if (unit < nlat) {
            hd = unit & 3; const int br_ = unit >> 2; gr = br_ % ROWS; b = br_ / ROWS;
            qrow = b * SEQ + gr * GW + w * 16 + fr; ntl = WH;
            rs = gr - WH / 2; if (rs < 0) rs = 0; if (rs > ROWS - WH) rs = ROWS - WH;
        } else {
            const int u2 = unit - nlat; const int qt = u2 % (CTXL / 64); const int bh = u2 / (CTXL / 64); hd = bh & 3; b = bh >> 2;
            qrow = NLAT + b * CTXL + qt * 64 + w * 16 + fr; ntl = 0;
        }
        const int ntiles = ntl + NCC;
        const int qcol = w * 16 + fr;
        int cs0 = w * 16 - 8; if (cs0 < 0) cs0 = 0; if (cs0 > GW - 32) cs0 = GW - 32;
        int wsq = qcol - 8; if (wsq < 0) wsq = 0; if (wsq > GW - 16) wsq = GW - 16;
        bf16x8_t qf[2];
#pragma unroll
        for (int s_ = 0; s_ < 2; ++s_) qf[s_] = *(const bf16x8_t*)(p.P + (size_t)qrow * PLD + C_NAQ + hd * 64 + s_ * 32 + fg * 8);
        f32x4_t O[4];
#pragma unroll
        for (int d = 0; d < 4; ++d) O[d] = f32x4_t{0.f, 0.f, 0.f, 0.f};
        float ls = 0.f;
        auto keyrow = [&](int tt, int i) { return (tt < ntl) ? (b * SEQ + (rs + tt) * GW + i) : (NLAT + b * CTXL + (tt - ntl) * 64 + i); };
        char* ldst = smc + w * 1024;
        __syncthreads();
        for (int i = t; i < 15 * 31; i += 256) sbias[i] = rpb[hd * 465 + i] * 1.4426950408889634f;
#pragma unroll
        for (int i = 0; i < 2; ++i) {
            const bf16* src = p.P + (size_t)keyrow(0, lkey + 32 * i) * PLD + hd * 64;
            GLDS16(src + C_NAK + ksrc, ldst + 4096 * i); GLDS16(src + C_NAV + vsrc, ldst + 16384 + 4096 * i);
        }
        WAIT_VM0();
        __syncthreads();
        const int vkl = 4 * fg + (fr >> 2);
        const int vsw = (vkl >> 1) & 3;
        unsigned va[4];
#pragma unroll
        for (int d = 0; d < 4; ++d) va[d] = 16384 + vkl * 128 + ((((d ^ vsw) << 1) | ((fr & 3) >> 1)) << 4) + (fr & 1) * 8;
#pragma unroll 1
        for (int tt = 0; tt < ntiles; ++tt) {
            const int cur = tt & 1;
            if (tt + 1 < ntiles) {
#pragma unroll
                for (int i = 0; i < 2; ++i) {
                    const bf16* src = p.P + (size_t)keyrow(tt + 1, lkey + 32 * i) * PLD + hd * 64;
                    GLDS16(src + C_NAK + ksrc, ldst + (cur ^ 1) * 8192 + 4096 * i); GLDS16(src + C_NAV + vsrc, ldst + 16384 + (cur ^ 1) * 8192 + 4096 * i);
                }
            }
            const char* cK = smc + cur * 8192;
            const lds_cptr cV = lds + cur * 8192;
            const bool local = tt < ntl;
            const int kbase = local ? cs0 : 0;
            const int nkf = local ? 2 : 4;
            unsigned pb[2][4];
#pragma unroll
            for (int f = 0; f < 4; ++f) {
                if (f < nkf) {
                    const int key = kbase + f * 16 + fr;
                    const char* kp = cK + key * 128;
                    const bf16x8_t a0 = *(const bf16x8_t*)(kp + (((fg) ^ (fr & 7)) << 4));
                    const bf16x8_t a1 = *(const bf16x8_t*)(kp + (((4 + fg) ^ (fr & 7)) << 4));
                    f32x4_t S = __builtin_amdgcn_mfma_f32_16x16x32_bf16(a0, qf[0], f32x4_t{0.f, 0.f, 0.f, 0.f}, 0, 0, 0);
                    S = __builtin_amdgcn_mfma_f32_16x16x32_bf16(a1, qf[1], S, 0, 0, 0);
                    float e[4];
#pragma unroll
                    for (int r = 0; r < 4; ++r) {
                        float sv = S[r]; bool ok = true;
                        if (local) {
                            const int kc = kbase + f * 16 + 4 * fg + r;
                            ok = (unsigned)(kc - wsq) < 16u;
                            sv += sbias[((rs + tt) - gr + 7) * 31 + (ok ? (kc - qcol + 15) : 15)];
                        }
                        e[r] = ok ? __builtin_amdgcn_exp2f(sv) : 0.f;
                    }
                    ls += (e[0] + e[1]) + (e[2] + e[3]);
                    pb[f >> 1][(f & 1) * 2] = cvtpk(e[0], e[1]);
                    pb[f >> 1][(f & 1) * 2 + 1] = cvtpk(e[2], e[3]);
                }
            }
#pragma unroll
            for (int ks = 0; ks < 2; ++ks) {
                if (ks * 2 < nkf) {
#pragma unroll
                    for (int d = 0; d < 4; ++d) {
                        const s16x4_t lo = lds_tr16(cV + va[d] + (kbase + ks * 32) * 128);
                        const s16x4_t hi = lds_tr16(cV + va[d] + (kbase + ks * 32 + 16) * 128);
                        const bf16x8_t vf = bf16x8_t{lo[0], lo[1], lo[2], lo[3], hi[0], hi[1], hi[2], hi[3]};
                        const i32x4_t bi = i32x4_t{(int)pb[ks][0], (int)pb[ks][1], (int)pb[ks][2], (int)pb[ks][3]};
                        O[d] = __builtin_amdgcn_mfma_f32_16x16x32_bf16(vf, __builtin_bit_cast(bf16x8_t, bi), O[d], 0, 0, 0);
                    }
                }
            }
            WAIT_VM0();
            __syncthreads();
        }
        ls += __shfl_xor(ls, 16); ls += __shfl_xor(ls, 32);
        const float inv = 1.0f / ls;
        bf16* op = p.br + (size_t)qrow * D + hd * 64;
#pragma unroll
        for (int d = 0; d < 4; ++d) {
            uint2 pk; pk.x = cvtpk(O[d][0] * inv, O[d][1] * inv); pk.y = cvtpk(O[d][2] * inv, O[d][3] * inv);
            *(uint2*)(op + d * 16 + 4 * fg) = pk;
        }
    }
}
#else
HD void ph_na(const Params& p, int l, int bid, int nb, char*) {
    const float* rpb = p.in[I_RPB] + (size_t)l * 4 * 15 * 31;
    const int RQ = (l == 0) ? R : NLAT;
    const int N = RQ * 4;
    const int wh = ROWS < 8 ? ROWS : 8;
    for (int u = bid; u < (N + 255) / 256; u += nb) {
        THREADS(t, 256) {
            int idx = u * 256 + t;
            if (idx < N) {
                int hd = idx / RQ, r = idx % RQ;
                RowInfo ri = rowinfo(r);
                float q[64], o[64];
                const bf16* qp = p.P + (size_t)r * PLD + C_NAQ + hd * 64;
#pragma unroll
                for (int d = 0; d < 64; ++d) { q[d] = bf2f(qp[d]) * 0.125f; o[d] = 0.f; }
                float mx = -1e30f, lsum = 0.f;
                int nloc = 0, rs = 0, ws = 0, gr = 0, gc = 0;
                if (ri.seg == 0) {
                    gr = ri.t / GW; gc = ri.t % GW;
                    rs = gr - wh / 2; if (rs < 0) rs = 0; if (rs > ROWS - wh) rs = ROWS - wh;
                    ws = gc - 8; if (ws < 0) ws = 0; if (ws > GW - 16) ws = GW - 16;
                    nloc = wh * 16;
                }
                int ctxbase = NLAT + ri.b * CTXL;
                for (int kk = 0; kk < nloc + CTXL; ++kk) {
                    int kr; float bias = 0.f;
                    if (kk < nloc) {
                        int a = kk >> 4, c = kk & 15;
                        int krow = rs + a, kcol = ws + c;
                        kr = ri.base + krow * GW + kcol;
                        bias = rpb[(hd * 15 + (krow - gr + 7)) * 31 + (kcol - gc + 15)];
                    } else kr = ctxbase + (kk - nloc);
                    const bf16* kp = p.P + (size_t)kr * PLD + C_NAK + hd * 64;
                    float s = 0.f;
#pragma unroll
                    for (int d = 0; d < 64; ++d) s += q[d] * bf2f(kp[d]);
                    s += bias;
                    if (s > mx) { float f = expf(mx - s); lsum *= f;
#pragma unroll
                        for (int d = 0; d < 64; ++d) o[d] *= f;
                        mx = s; }
                    float e = expf(s - mx);
                    lsum += e;
                    const bf16* vp = p.P + (size_t)kr * PLD + C_NAV + hd * 64;
#pragma unroll
                    for (int d = 0; d < 64; ++d) o[d] += e * bf2f(vp[d]);
                }
                float inv = 1.0f / lsum;
                bf16* op = p.br + (size_t)r * D + hd * 64;
#pragma unroll
                for (int d = 0; d < 64; ++d) op[d] = f2bf(o[d] * inv);
            }
        }
    }
}

#endif

#ifndef CPU_EMU
HD void ph_da(const Params& p, int l, int bid, int nb, char* smc) {
    const int t = tid_(), lane = t & 63, w = t >> 6, fr = lane & 15, fg = lane >> 4;
    const float lam_init = lam_init_of(l);
    float s1 = 0.f, s2 = 0.f;
    for (int d = 0; d < 32; ++d) {
        s1 += p.in[I_LQ1][l * 32 + d] * p.in[I_LK1][l * 32 + d];
        s2 += p.in[I_LQ2][l * 32 + d] * p.in[I_LK2][l * 32 + d];
    }
    const float lam = expf(s1) - expf(s2) + lam_init;
    const float* sg = p.in[I_SUBLN] + l * 64;
    constexpr int NQT = SEQ / 128, NQC = CTXL / 128;
    const int nlat = NB * 4 * NQT;
    const int nctx = (l == 0) ? NB * 4 * NQC : 0;
    const lds_cptr lds = (lds_cptr)smc;
    for (int unit = bid; unit < nlat + nctx; unit += nb) {
        int b, hd, qrow0, kt0;
        if (unit < nlat) { const int qt = unit % NQT, bh = unit / NQT; hd = bh & 3; b = bh >> 2; qrow0 = b * SEQ + qt * 128; kt0 = 0; }
        else { const int u2 = unit - nlat; const int qt = u2 % NQC, bh = u2 / NQC; hd = bh & 3; b = bh >> 2; qrow0 = NLAT + b * CTXL + qt * 128; kt0 = NCL; }
        const int kt1 = NCL + NCC;
        bf16x8_t qf[2][2];
#pragma unroll
        for (int m = 0; m < 2; ++m)
#pragma unroll
            for (int n = 0; n < 2; ++n)
                qf[m][n] = *(const bf16x8_t*)(p.P + (size_t)(qrow0 + w * 32 + n * 16 + fr) * PLD + C_DAQ + hd * 64 + m * 32 + fg * 8);
        f32x4_t O[2][4][2];
#pragma unroll
        for (int m = 0; m < 2; ++m)
#pragma unroll
            for (int d = 0; d < 4; ++d)
#pragma unroll
                for (int n = 0; n < 2; ++n) O[m][d][n] = f32x4_t{0.f, 0.f, 0.f, 0.f};
        f32x4_t L5[2][2];
#pragma unroll
        for (int m = 0; m < 2; ++m)
#pragma unroll
            for (int n = 0; n < 2; ++n) L5[m][n] = f32x4_t{0.f, 0.f, 0.f, 0.f};
        const short one_ = (fr == 0) ? (short)0x3f80 : (short)0;
        const bf16x8_t onesf = bf16x8_t{one_, one_, one_, one_, one_, one_, one_, one_};
        const int lkey = t >> 3, lc = t & 7;
        const int ksrc = (lc ^ (lkey & 7)) << 3;
        const int vsrc = ((((lc >> 1) ^ ((lkey >> 1) & 3)) << 1) | (lc & 1)) << 3;
        auto keyrow = [&](int kt, int i) { return (kt < NCL) ? (b * SEQ + kt * 64 + i) : (NLAT + b * CTXL + (kt - NCL) * 64 + i); };
        char* ldst = smc + w * 1024;
        __syncthreads();
#pragma unroll
        for (int i = 0; i < 2; ++i) {
            const bf16* src = p.P + (size_t)keyrow(kt0, lkey + 32 * i) * PLD + hd * 64;
            GLDS16(src + C_DAK + ksrc, ldst + 4096 * i); GLDS16(src + C_DAV + vsrc, ldst + 16384 + 4096 * i);
        }
        WAIT_VM0();
        __syncthreads();
        const unsigned ka0 = fr * 128 + (((fg) ^ (fr & 7)) << 4);
        const unsigned ka1 = fr * 128 + (((4 + fg) ^ (fr & 7)) << 4);
        const int vkey = 4 * fg + (fr >> 2);
        const int vsw = (vkey >> 1) & 3;
        unsigned va[4];
#pragma unroll
        for (int d = 0; d < 4; ++d) va[d] = 16384 + vkey * 128 + ((((d ^ vsw) << 1) | ((fr & 3) >> 1)) << 4) + (fr & 1) * 8;
#pragma unroll 1
        for (int kt = kt0; kt < kt1; ++kt) {
            const int cur = (kt - kt0) & 1;
            if (kt + 1 < kt1) {
#pragma unroll
                for (int i = 0; i < 2; ++i) {
                    const bf16* src = p.P + (size_t)keyrow(kt + 1, lkey + 32 * i) * PLD + hd * 64;
                    GLDS16(src + C_DAK + ksrc, ldst + (cur ^ 1) * 8192 + 4096 * i); GLDS16(src + C_DAV + vsrc, ldst + 16384 + (cur ^ 1) * 8192 + 4096 * i);
                }
            }
            const char* cK = smc + cur * 8192;
            const lds_cptr cV = lds + cur * 8192;
#pragma unroll
            for (int m = 0; m < 2; ++m) {
                unsigned pb[2][2][4];
                {
                    f32x4_t S[4][2];
#pragma unroll
                    for (int kf = 0; kf < 4; ++kf) {
                        const bf16x8_t a = *(const bf16x8_t*)(cK + (m ? ka1 : ka0) + kf * 2048);
#pragma unroll
                        for (int n = 0; n < 2; ++n) S[kf][n] = __builtin_amdgcn_mfma_f32_16x16x32_bf16(a, qf[m][n], f32x4_t{0.f, 0.f, 0.f, 0.f}, 0, 0, 0);
                    }
#pragma unroll
                    for (int kf = 0; kf < 4; ++kf)
#pragma unroll
                        for (int n = 0; n < 2; ++n) {
                            const float e0 = __builtin_amdgcn_exp2f(S[kf][n][0]), e1 = __builtin_amdgcn_exp2f(S[kf][n][1]);
                            const float e2 = __builtin_amdgcn_exp2f(S[kf][n][2]), e3 = __builtin_amdgcn_exp2f(S[kf][n][3]);
                            pb[n][kf >> 1][(kf & 1) * 2] = cvtpk(e0, e1);
                            pb[n][kf >> 1][(kf & 1) * 2 + 1] = cvtpk(e2, e3);
                        }
                }
#pragma unroll
                for (int ks = 0; ks < 2; ++ks)
#pragma unroll
                    for (int d = 0; d < 4; ++d) {
                        const s16x4_t lo = lds_tr16(cV + va[d] + ks * 4096);
                        const s16x4_t hi = lds_tr16(cV + va[d] + ks * 4096 + 2048);
                        const bf16x8_t vf = bf16x8_t{lo[0], lo[1], lo[2], lo[3], hi[0], hi[1], hi[2], hi[3]};
#pragma unroll
                        for (int n = 0; n < 2; ++n) {
                            const i32x4_t bi = i32x4_t{(int)pb[n][ks][0], (int)pb[n][ks][1], (int)pb[n][ks][2], (int)pb[n][ks][3]};
                            O[m][d][n] = __builtin_amdgcn_mfma_f32_16x16x32_bf16(vf, __builtin_bit_cast(bf16x8_t, bi), O[m][d][n], 0, 0, 0);
                            if (d == 0) L5[m][n] = __builtin_amdgcn_mfma_f32_16x16x32_bf16(onesf, __builtin_bit_cast(bf16x8_t, bi), L5[m][n], 0, 0, 0);
                        }
                    }
                asm volatile("" ::: "memory");
            }
            WAIT_VM0();
            __syncthreads();
        }
#pragma unroll
        for (int n = 0; n < 2; ++n) {
            const float l0 = __shfl(L5[0][n][0], fr), l1 = __shfl(L5[1][n][0], fr);
            const float i0 = 1.0f / l0, i1 = lam / l1;
            float ss = 0.f;
#pragma unroll
            for (int d = 0; d < 4; ++d)
#pragma unroll
                for (int r = 0; r < 4; ++r) { const float o = O[0][d][n][r] * i0 - O[1][d][n][r] * i1; O[0][d][n][r] = o; ss += o * o; }
            ss += __shfl_xor(ss, 16); ss += __shfl_xor(ss, 32);
            const float rs = (1.0f - lam_init) / sqrtf(ss / 64.0f + 1e-6f);
            bf16* op = p.br + (size_t)(qrow0 + w * 32 + n * 16 + fr) * D + 256 + hd * 64;
#pragma unroll
            for (int d = 0; d < 4; ++d) {
                const int dv = d * 16 + 4 * fg;
                const unsigned lo = cvtpk(O[0][d][n][0] * rs * sg[dv], O[0][d][n][1] * rs * sg[dv + 1]);
                const unsigned hi = cvtpk(O[0][d][n][2] * rs * sg[dv + 2], O[0][d][n][3] * rs * sg[dv + 3]);
                uint2 pk; pk.x = lo; pk.y = hi;
                *(uint2*)(op + dv) = pk;
            }
        }
    }
}
#else
HD void ph_da(const Params& p, int l, int bid, int nb, char*) {
    const int RQ = (l == 0) ? R : NLAT;
    const int N = RQ * 4;
    const float lam_init = lam_init_of(l);
    float s1 = 0.f, s2 = 0.f;
    for (int d = 0; d < 32; ++d) {
        s1 += p.in[I_LQ1][l * 32 + d] * p.in[I_LK1][l * 32 + d];
        s2 += p.in[I_LQ2][l * 32 + d] * p.in[I_LK2][l * 32 + d];
    }
    const float lam = expf(s1) - expf(s2) + lam_init;
    const float* sg = p.in[I_SUBLN] + l * 64;
    const float scale = 0.17677669529663687f;
    for (int u = bid; u < (N + 255) / 256; u += nb) {
        THREADS(t, 256) {
            int idx = u * 256 + t;
            if (idx < N) {
                int hd = idx / RQ, r = idx % RQ;
                RowInfo ri = rowinfo(r);
                float q0[32], q1[32], o0[64], o1[64];
                const bf16* qp = p.P + (size_t)r * PLD + C_DAQ + hd * 64;
#pragma unroll
                for (int d = 0; d < 32; ++d) { q0[d] = bf2f(qp[d]) * scale; q1[d] = bf2f(qp[32 + d]) * scale; }
#pragma unroll
                for (int d = 0; d < 64; ++d) { o0[d] = 0.f; o1[d] = 0.f; }
                float m0 = -1e30f, m1 = -1e30f, l0 = 0.f, l1 = 0.f;
                int nlat = (ri.seg == 0) ? SEQ : 0;
                int latbase = ri.b * SEQ, ctxbase = NLAT + ri.b * CTXL;
                for (int kk = 0; kk < nlat + CTXL; ++kk) {
                    int kr = (kk < nlat) ? latbase + kk : ctxbase + (kk - nlat);
                    const bf16* kp = p.P + (size_t)kr * PLD + C_DAK + hd * 64;
                    const bf16* vp = p.P + (size_t)kr * PLD + C_DAV + hd * 64;
                    float sa = 0.f, sb = 0.f;
#pragma unroll
                    for (int d = 0; d < 32; ++d) { sa += q0[d] * bf2f(kp[d]); sb += q1[d] * bf2f(kp[32 + d]); }
                    if (sa > m0) { float f = expf(m0 - sa); l0 *= f;
#pragma unroll
                        for (int d = 0; d < 64; ++d) o0[d] *= f;
                        m0 = sa; }
                    if (sb > m1) { float f = expf(m1 - sb); l1 *= f;
#pragma unroll
                        for (int d = 0; d < 64; ++d) o1[d] *= f;
                        m1 = sb; }
                    float ea = expf(sa - m0), eb = expf(sb - m1);
                    l0 += ea; l1 += eb;
#pragma unroll
                    for (int d = 0; d < 64; ++d) { float v = bf2f(vp[d]); o0[d] += ea * v; o1[d] += eb * v; }
                }
                float i0 = 1.0f / l0, i1 = lam / l1;
                float ss = 0.f;
#pragma unroll
                for (int d = 0; d < 64; ++d) { o0[d] = o0[d] * i0 - o1[d] * i1; ss += o0[d] * o0[d]; }
                float rs = (1.0f - lam_init) / sqrtf(ss / 64.0f + 1e-6f);
                bf16* op = p.br + (size_t)r * D + 256 + hd * 64;
#pragma unroll
                for (int d = 0; d < 64; ++d) op[d] = f2bf(o0[d] * rs * sg[d]);
            }
        }
    }
}

#endif

struct ChunkInfo { int dir, b, hd, n, seg, T, base, nloc; };
HD ChunkInfo chunkinfo(int unit) {
    ChunkInfo c;
    c.n = unit % NCH; int ch = unit / NCH; c.hd = ch & 3; c.b = (ch >> 2) % NB; c.dir = ch / (4 * NB);
    if (c.n < NCC) { c.seg = 1; c.T = CTXL; c.base = NLAT + c.b * CTXL; c.nloc = c.n; }
    else { c.seg = 0; c.T = SEQ; c.base = c.b * SEQ; c.nloc = c.n - NCC; }
    return c;
}
HD int chunk_row(const ChunkInfo& c, int i) { int pf = c.nloc * 64 + i; return c.base + (c.dir ? (c.T - 1 - pf) : pf); }

#ifndef CPU_EMU
HD void ph_gdn_chunk(const Params& p, int l, int bid, int nb, float* smf) {
    char* smc = (char*)smf;
    const int t = tid_(), lane = t & 63, w = t >> 6, fr = lane & 15, fg = lane >> 4;
    float* sA = (float*)(smc + 24576); float* sG = (float*)(smc + 40960); float* sB = (float*)(smc + 41216);
    const int lkey = t >> 3, lc = t & 7;
    const int ksrc = (lc ^ (lkey & 7)) << 3;
    char* ldst = smc + w * 1024;
    for (int unit = bid; unit < NUNIT; unit += nb) {
        const ChunkInfo c = chunkinfo(unit);
        const int dh = c.dir * 4 + c.hd;
        __syncthreads();
#pragma unroll
        for (int i = 0; i < 2; ++i) {
            const bf16* src = p.gq + (size_t)chunk_row(c, lkey + 32 * i) * 768 + c.hd * 64;
            GLDS16(src + 256 + ksrc, ldst + 4096 * i);
            GLDS16(src + ksrc, ldst + 8192 + 4096 * i);
            GLDS16(src + 512 + lc * 8, ldst + 16384 + 4096 * i);
        }
        if (w == 0) {
            const int row = chunk_row(c, lane);
            float x = p.gg[(size_t)dh * R + row];
#pragma unroll
            for (int off = 1; off < 64; off <<= 1) { const float y = __shfl_up(x, off); if (lane >= off) x += y; }
            sG[lane] = x; sB[lane] = p.gbeta[(size_t)dh * R + row];
            const float x63 = __shfl(x, 63);
            float* cg = p.cG + (size_t)unit * 192;
            cg[lane] = __expf(x); cg[64 + lane] = __expf(x63 - x); cg[128 + lane] = __expf(x63);
        }
        WAIT_VM0();
        __syncthreads();
        {
            const char* kt_ = smc; const char* qt_ = smc + 8192;
            const unsigned ro = (16 * w + fr) * 128;
            const unsigned c0 = ((fg) ^ (fr & 7)) << 4, c1 = ((4 + fg) ^ (fr & 7)) << 4;
            const bf16x8_t ak0 = *(const bf16x8_t*)(kt_ + ro + c0), ak1 = *(const bf16x8_t*)(kt_ + ro + c1);
            const bf16x8_t aq0 = *(const bf16x8_t*)(qt_ + ro + c0), aq1 = *(const bf16x8_t*)(qt_ + ro + c1);
            float gi[4], bi[4];
#pragma unroll
            for (int r = 0; r < 4; ++r) { gi[r] = sG[16 * w + 4 * fg + r]; bi[r] = sB[16 * w + 4 * fg + r]; }
#pragma unroll
            for (int n = 0; n < 4; ++n) {
                const unsigned rb = (16 * n + fr) * 128;
                const bf16x8_t b0 = *(const bf16x8_t*)(kt_ + rb + c0), b1 = *(const bf16x8_t*)(kt_ + rb + c1);
                f32x4_t kk = __builtin_amdgcn_mfma_f32_16x16x32_bf16(ak0, b0, f32x4_t{0.f, 0.f, 0.f, 0.f}, 0, 0, 0);
                kk = __builtin_amdgcn_mfma_f32_16x16x32_bf16(ak1, b1, kk, 0, 0, 0);
                f32x4_t qk = __builtin_amdgcn_mfma_f32_16x16x32_bf16(aq0, b0, f32x4_t{0.f, 0.f, 0.f, 0.f}, 0, 0, 0);
                qk = __builtin_amdgcn_mfma_f32_16x16x32_bf16(aq1, b1, qk, 0, 0, 0);
                const int j = 16 * n + fr; const float gj = sG[j];
#pragma unroll
                for (int r = 0; r < 4; ++r) {
                    const int i = 16 * w + 4 * fg + r;
                    const float dec = (j <= i) ? __expf(gi[r] - gj) : 0.f;
                    sA[i * 64 + j] = (j < i) ? kk[r] * bi[r] * dec : 0.f;
                    p.cQK[(size_t)unit * 4096 + i * 64 + j] = f2bf(qk[r] * dec);
                }
            }
        }
        __syncthreads();
        if (w < 2) {
            float x[64];
            bf16* dst = (w == 0 ? p.cU : p.cW) + (size_t)unit * 4096 + lane;
#pragma unroll
            for (int i = 0; i < 64; ++i) {
                float rhs;
                if (w == 0) rhs = sB[i] * bf2f(*(const bf16*)(smc + 16384 + i * 128 + lane * 2));
                else rhs = sB[i] * __expf(sG[i]) * bf2f(*(const bf16*)(smc + i * 128 + ((((lane >> 3) ^ (i & 7))) << 4) + (lane & 7) * 2));
                float acc = rhs;
#pragma unroll
                for (int j4 = 0; j4 < i; j4 += 4) {
                    const f32x4_t a4 = *(const f32x4_t*)(sA + i * 64 + j4);
                    acc -= a4[0] * x[j4];
                    if (j4 + 1 < i) acc -= a4[1] * x[j4 + 1];
                    if (j4 + 2 < i) acc -= a4[2] * x[j4 + 2];
                    if (j4 + 3 < i) acc -= a4[3] * x[j4 + 3];
                }
                x[i] = acc;
                dst[i * 64] = f2bf(acc);
            }
        }
    }
}
#else
HD void ph_gdn_chunk(const Params& p, int l, int bid, int nb, float* sm) {
    float* sk = sm;
    float* sq = sm + 4096;
    float* sA = sm + 8192;
    float* sXu = sm + 12288;
    float* sXw = sm + 4096;
    float* sG = sm + 16384;
    float* sB = sm + 16448;
    for (int unit = bid; unit < NUNIT; unit += nb) {
        ChunkInfo c = chunkinfo(unit);
        int dh = c.dir * 4 + c.hd;
        THREADS(t, 4096) {
            int i = t >> 6, d = t & 63; int row = chunk_row(c, i);
            sq[t] = bf2f(p.gq[(size_t)row * 768 + c.hd * 64 + d]);
            sk[t] = bf2f(p.gq[(size_t)row * 768 + 256 + c.hd * 64 + d]);
        }
        THREADS(t, 1) {
            float acc = 0.f;
            for (int i = 0; i < 64; ++i) { int row = chunk_row(c, i); acc += p.gg[(size_t)dh * R + row]; sG[i] = acc; sB[i] = p.gbeta[(size_t)dh * R + row]; }
        }
        SYNC
        THREADS(t, 4096) {
            int i = t >> 6, j = t & 63;
            float kk = 0.f, qk = 0.f;
            for (int d = 0; d < 64; ++d) { kk += sk[i * 64 + d] * sk[j * 64 + d]; qk += sq[i * 64 + d] * sk[j * 64 + d]; }
            float dec = (j <= i) ? expf(sG[i] - sG[j]) : 0.f;
            sA[t] = (j < i) ? kk * sB[i] * dec : 0.f;
            p.cQK[(size_t)unit * 4096 + t] = f2bf(qk * dec);
        }
        SYNC
        THREADS(t, 4096) {
            int i = t >> 6, cc = t & 63; int row = chunk_row(c, i);
            sXu[t] = sB[i] * bf2f(p.gq[(size_t)row * 768 + 512 + c.hd * 64 + cc]);
            sXw[t] = sB[i] * expf(sG[i]) * sk[t];
        }
        SYNC
        for (int i = 1; i < 64; ++i) {
            THREADS(cc, 128) {
                float* X = (cc < 64) ? (sXu + cc) : (sXw + cc - 64);
                float acc = X[i * 64];
                for (int j = 0; j < i; ++j) acc -= sA[i * 64 + j] * X[j * 64];
                X[i * 64] = acc;
            }
            SYNC
        }
        THREADS(t, 4096) {
            p.cU[(size_t)unit * 4096 + t] = f2bf(sXu[t]);
            p.cW[(size_t)unit * 4096 + t] = f2bf(sXw[t]);
        }
        THREADS(t, 64) { p.cG[(size_t)unit * 64 + t] = sG[t]; }
        SYNC
    }
}

#endif

HD void ph_fourier2(const Params& p, int l, int bid, int nb) {
    const int RQ = (l == 0) ? R : NLAT;
    for (int r = (FOURIER_GEMM ? NLAT : 0) + bid; r < RQ; r += nb) {
        RowInfo ri = rowinfo(r);
        const float nrm = 1.0f / sqrtf((float)ri.T * 64.0f);
        const int mul = SEQ / ri.T;
        THREADS(ch, 256) {
            float acc = 0.f;
            for (int tt = 0; tt < ri.T; ++tt) {
                int ti = ((ri.t * tt) & (ri.T - 1)) * mul;
                const bf16* f = p.fcs + (size_t)(ri.base + tt) * 512;
                acc += p.cosT[ti] * bf2f(f[ch]) - p.sinT[ti] * bf2f(f[256 + ch]);
            }
            p.br[(size_t)r * D + 768 + ch] = f2bf(acc * nrm);
        }
    }
}


HD void ph_fourier_s1c(const Params& p, int bid, int nb, char* smc) {
    constexpr int MTc = CTXL / 128;
    for (int tile = bid; tile < NB * MTc * 4; tile += nb) {
        const int g = tile & 3, mtc = (tile >> 2) % MTc, b = tile / (4 * MTc);
        ACC_DECL(4, acc); acc_zero(acc);
        gemm_accum<4>(acc, [&](int i) { return p.P + (size_t)(NLAT + b * CTXL + mtc * 128 + i) * PLD + C_F + g * 64; },
                      [&](int j) { return p.fW1 + j * 64; }, 64, smc);
        ACC_FOR(4, row, col) {
            const int cs = col >> 6, m = col & 63;
            p.fXC[(((size_t)b * 256 + g * 64 + m) * 2 + cs) * CTXL + mtc * 128 + row] = f2bf(AV(acc));
        } ACC_END
    }
}
HD void ph_fourier_s1(const Params& p, int bid, int nb, char* smc) {
    for (int tile = bid; tile < NB * 64 * 4; tile += nb) {
        const int g = tile & 3, t2 = (tile >> 2) & 63, b = tile >> 8;
        ACC_DECL(4, acc); acc_zero(acc);
        gemm_accum<4>(acc, [&](int i) { return p.P + (size_t)(b * SEQ + 64 * i + t2) * PLD + C_F + g * 64; },
                      [&](int j) { return p.fW1 + j * 64; }, 64, smc);
#ifndef CPU_EMU
        {
            float* tl = (float*)smc;
            acc_to_lds<4>(acc, tl);
            __syncthreads();
            const int t_ = tid_(); const int col = t_ >> 1, half = t_ & 1;
            const int cs = col >> 6, m = col & 63;
            bf16* dst = p.fcs + ((((size_t)b * 256 + g * 64 + m) * 64 + t2) * 2 + cs) * 128 + half * 64;
#pragma unroll
            for (int q = 0; q < 8; ++q) {
                float v[8];
#pragma unroll
                for (int e = 0; e < 8; ++e) v[e] = tl[(half * 64 + q * 8 + e) * 132 + col];
                uint4 pk; pk.x = cvtpk(v[0], v[1]); pk.y = cvtpk(v[2], v[3]); pk.z = cvtpk(v[4], v[5]); pk.w = cvtpk(v[6], v[7]);
                *(uint4*)(dst + q * 8) = pk;
            }
        }
#else
        ACC_FOR(4, row, col) {
            const int cs = col >> 6, m = col & 63;
            p.fcs[((((size_t)b * 256 + g * 64 + m) * 64 + t2) * 2 + cs) * 128 + row] = f2bf(AV(acc));
        } ACC_END
#endif
    }
}
HD void ph_fourier_sA(const Params& p, int bid, int nb, char* smc) {
    for (int tile = bid; tile < NB * 128 * 2; tile += nb) {
        const int nt = tile & 1, mt = (tile >> 1) & 127, b = tile >> 8;
        ACC_DECL(4, acc); acc_zero(acc);
        gemm_accum<4>(acc, [&](int i) { return p.fcs + ((size_t)b * 16384 + mt * 128 + i) * 256; },
                      [&](int j) { return p.fWA + (size_t)(nt * 128 + j) * 256; }, 256, smc);
#ifndef CPU_EMU
        {
            float* tl = (float*)smc;
            acc_to_lds<4>(acc, tl);
            __syncthreads();
            const int t_ = tid_(); const int pcol = t_ >> 2, chl = (t_ >> 1) & 1, th = t_ & 1;
            const int k1 = nt * 64 + pcol; const int ch = mt * 2 + chl;
            const int cre = (pcol >> 4) * 32 + (pcol & 15), cim = cre + 16;
            bf16* o = p.fa2 + ((((size_t)b * 128 + k1) * 256 + ch) * 2) * 64 + th * 32;
#pragma unroll
            for (int q = 0; q < 4; ++q) {
                float vr[8], vi[8];
#pragma unroll
                for (int e = 0; e < 8; ++e) {
                    const int t2 = th * 32 + q * 8 + e;
                    const float re = tl[(chl * 64 + t2) * 132 + cre], im = tl[(chl * 64 + t2) * 132 + cim];
                    const float c = p.cosT[k1 * t2], sn = p.sinT[k1 * t2];
                    vr[e] = re * c + im * sn; vi[e] = im * c - re * sn;
                }
                uint4 pr, pi;
                pr.x = cvtpk(vr[0], vr[1]); pr.y = cvtpk(vr[2], vr[3]); pr.z = cvtpk(vr[4], vr[5]); pr.w = cvtpk(vr[6], vr[7]);
                pi.x = cvtpk(vi[0], vi[1]); pi.y = cvtpk(vi[2], vi[3]); pi.z = cvtpk(vi[4], vi[5]); pi.w = cvtpk(vi[6], vi[7]);
                *(uint4*)(o + q * 8) = pr; *(uint4*)(o + 64 + q * 8) = pi;
            }
        }
#else
        ACC_FOR_PAIR(row, pcol) {
            const int k1 = nt * 64 + pcol; const int rr = mt * 128 + row; const int ch = rr >> 6, t2 = rr & 63;
            const float re = AV_G(acc), im = AV_U(acc);
            const float c = p.cosT[k1 * t2], sn = p.sinT[k1 * t2];
            bf16* o = p.fa2 + ((((size_t)b * 128 + k1) * 256 + ch) * 2) * 64 + t2;
            o[0] = f2bf(re * c + im * sn); o[64] = f2bf(im * c - re * sn);
        } ACC_END
#endif
    }
}
HD void ph_fourier_sB(const Params& p, int bid, int nb, char* smc) {
    const float nrm = 1.0f / sqrtf((float)SEQ * 64.0f);
    for (int tile = bid; tile < NB * 128 * 2; tile += nb) {
        const int cht = tile & 1, k1 = (tile >> 1) & 127, b = tile >> 8;
        ACC_DECL(2, acc); acc_zero(acc);
        gemm_accum<2>(acc, [&](int i) { return p.fa2 + (((size_t)b * 128 + k1) * 256 + cht * 128 + i) * 128; },
                      [&](int j) { return p.fWB + j * 128; }, 128, smc);
        ACC_FOR(2, row, col) {
            p.br[(size_t)(b * SEQ + k1 + 128 * col) * D + 768 + cht * 128 + row] = f2bf(AV(acc) * nrm);
        } ACC_END
    }
}


HD void ph_fourier_ctx(const Params& p, int bid, int nb, char* smc) {
    static_assert(CTXL % 128 == 0 || !FOURIER_GEMM, "context DFT GEMM needs CTXL % 128 == 0");
    const float nrm = 1.0f / sqrtf((float)CTXL * 64.0f);
    constexpr int MTc = CTXL / 128;
    for (int tile = bid; tile < NB * MTc * 2; tile += nb) {
        const int nt = tile & 1, mt = (tile >> 1) % MTc, b = tile / (2 * MTc);
        ACC_DECL(4, acc); acc_zero(acc);
        gemm_accum<4>(acc, [&](int i) { return p.fWC + (size_t)(mt * 128 + i) * (2 * CTXL); },
                      [&](int j) { return p.fXC + ((size_t)b * 256 + nt * 128 + j) * (2 * CTXL); }, 2 * CTXL, smc);
        ACC_FOR(4, row, col) { p.br[(size_t)(NLAT + b * CTXL + mt * 128 + row) * D + 768 + nt * 128 + col] = f2bf(AV(acc) * nrm); } ACC_END
    }
}
#ifndef CPU_EMU
struct ScanRegs { i32x4_t W[2], k[2]; unsigned u[4]; float g; };
HD bf16* scan_sp(const Params& p) { return p.h; }
HD bf16* scan_vn(const Params& p) { return p.h + (size_t)NUNIT * 4096; }
HD void ph_gdn_scan(const Params& p, int l, int bid, int nb, float* smf) {
    static_assert(NCH % 3 == 0, "scan ring assumes the chunk count is a multiple of 3");
    char* smc = (char*)smf;
    const int t = tid_(), lane = t & 63, w = t >> 6, fr = lane & 15, fg = lane >> 4;
    char* sST = smc + 24576; char* sVT = smc + 26624; char* sVS = smc + 28672; float* sG = (float*)(smc + 30720);
    const lds_cptr lds = (lds_cptr)smc;
    const int lkey = t >> 3, lc = t & 7;
    for (int cu = bid; cu < 2 * NB * 4 * 4; cu += nb) {
        const int chain = cu >> 2, cb = cu & 3;
        const ChunkInfo c0 = chunkinfo(chain * NCH);
        const int hd = c0.hd;
        auto issue = [&](ScanRegs& Rg, int n) {
            const int unit = chain * NCH + n;
            const ChunkInfo c = chunkinfo(unit);
            const bf16* wsrc = p.cW + (size_t)unit * 4096 + (16 * w + fr) * 64 + 8 * fg;
#pragma unroll
            for (int s_ = 0; s_ < 2; ++s_) {
                Rg.W[s_] = *(const i32x4_t*)(wsrc + 32 * s_);
                Rg.k[s_] = *(const i32x4_t*)(p.gq + (size_t)chunk_row(c, lkey + 32 * s_) * 768 + 256 + hd * 64 + lc * 8);
            }
#pragma unroll
            for (int r = 0; r < 4; ++r) Rg.u[r] = p.cU[(size_t)unit * 4096 + (16 * w + 4 * fg + r) * 64 + cb * 16 + fr];
            Rg.g = p.cG[(size_t)unit * 192 + (t < 192 ? t : 191)];
        };
        auto put_k = [&](const ScanRegs& Rg, int buf) {
#pragma unroll
            for (int s_ = 0; s_ < 2; ++s_) {
                const int ci = lkey + 32 * s_;
                const int fsw = ((ci >> 1) & 1) | (((ci >> 3) & 1) << 1);
                *(i32x4_t*)(smc + buf * 8192 + ci * 128 + (((((lc >> 1) ^ fsw) << 1) | (lc & 1)) << 4)) = Rg.k[s_];
            }
            if (t < 192) sG[buf * 192 + t] = Rg.g;
        };
        const int xe = (t >> 3) & 15, xc = (t & 7) ^ (xe & 7);
        const unsigned xsrc = xe * 128 + ((t & 7) << 4);
        const size_t xdst = (size_t)(cb * 16 + xe) * 64 + xc * 8;
        const unsigned c0o = ((fg) ^ (fr & 7)) << 4, c1o = ((4 + fg) ^ (fr & 7)) << 4;
        const unsigned bo0 = fr * 128 + c0o, bo1 = fr * 128 + c1o;
        const unsigned wofs = fr * 128 + ((((2 * w + (fg >> 1)) ^ (fr & 7))) << 4) + (fg & 1) * 8;
        unsigned ka[2][2];
#pragma unroll
        for (int s_ = 0; s_ < 2; ++s_)
#pragma unroll
            for (int h2 = 0; h2 < 2; ++h2) {
                const int cr = 32 * s_ + 8 * fg + (fr >> 2) + 4 * h2;
                const int fsw = ((cr >> 1) & 1) | (((cr >> 3) & 1) << 1);
                ka[s_][h2] = cr * 128 + (((((w ^ fsw) << 1) | ((fr & 3) >> 1))) << 4) + (fr & 1) * 8;
            }
        f32x4_t S = f32x4_t{0.f, 0.f, 0.f, 0.f};
        ScanRegs R0, R1, R2;
        __syncthreads();
        issue(R0, 0); issue(R1, 1);
        ((unsigned*)sST)[t] = 0u; ((unsigned*)sST)[t + 256] = 0u;
        put_k(R0, 0);
        __syncthreads();
#define SCAN_STEP(Rc, Rn, Rnn, nn, b)                                                                                                        \
        {                                                                                                                                    \
            const int n_ = (nn);                                                                                                             \
            issue(Rnn, (n_ + 2 < NCH) ? n_ + 2 : NCH - 1);                  \
            const float* g = sG + (b) * 192;                                                                                                 \
            const f32x4_t eD = *(const f32x4_t*)(g + 64 + 16 * w + 4 * fg);                                                                  \
            const float e63 = g[128];                                                                                                        \
            const bf16x8_t st0 = *(const bf16x8_t*)(sST + bo0), st1 = *(const bf16x8_t*)(sST + bo1);                                         \
            if (t < 128) *(uint4*)(scan_sp(p) + (size_t)(chain * NCH + n_) * 4096 + xdst) = *(const uint4*)(sST + xsrc);                     \
            f32x4_t v = __builtin_amdgcn_mfma_f32_16x16x32_bf16(__builtin_bit_cast(bf16x8_t, Rc.W[0]), st0, f32x4_t{0.f, 0.f, 0.f, 0.f}, 0, 0, 0); \
            v = __builtin_amdgcn_mfma_f32_16x16x32_bf16(__builtin_bit_cast(bf16x8_t, Rc.W[1]), st1, v, 0, 0, 0);                              \
            float vn[4];                                                                                                                     \
            _Pragma("unroll") for (int r = 0; r < 4; ++r) vn[r] = __uint_as_float(Rc.u[r] << 16) - v[r];                                     \
            { uint2 pk; pk.x = cvtpk(vn[0], vn[1]); pk.y = cvtpk(vn[2], vn[3]); *(uint2*)(sVT + wofs) = pk; }                                \
            { uint2 pk; pk.x = cvtpk(vn[0] * eD[0], vn[1] * eD[1]); pk.y = cvtpk(vn[2] * eD[2], vn[3] * eD[3]); *(uint2*)(sVS + wofs) = pk; }  \
            put_k(Rn, ((b) + 1) % 3);                                                                                                        \
            __syncthreads();                                                                                                                 \
            if (t >= 128) *(uint4*)(scan_vn(p) + (size_t)(chain * NCH + n_) * 4096 + xdst) = *(const uint4*)(sVT + xsrc);                    \
            const bf16x8_t vs0 = *(const bf16x8_t*)(sVS + bo0), vs1 = *(const bf16x8_t*)(sVS + bo1);                                         \
            const lds_cptr kb = lds + (b) * 8192;                                                                                            \
            const s16x4_t a00 = lds_tr16(kb + ka[0][0]), a01 = lds_tr16(kb + ka[0][1]);                                                      \
            const s16x4_t a10 = lds_tr16(kb + ka[1][0]), a11 = lds_tr16(kb + ka[1][1]);                                                      \
            f32x4_t dS = __builtin_amdgcn_mfma_f32_16x16x32_bf16(bf16x8_t{a00[0], a00[1], a00[2], a00[3], a01[0], a01[1], a01[2], a01[3]}, vs0, f32x4_t{0.f, 0.f, 0.f, 0.f}, 0, 0, 0); \
            dS = __builtin_amdgcn_mfma_f32_16x16x32_bf16(bf16x8_t{a10[0], a10[1], a10[2], a10[3], a11[0], a11[1], a11[2], a11[3]}, vs1, dS, 0, 0, 0); \
            _Pragma("unroll") for (int r = 0; r < 4; ++r) S[r] = S[r] * e63 + dS[r];                                                         \
            { uint2 pk; pk.x = cvtpk(S[0], S[1]); pk.y = cvtpk(S[2], S[3]); *(uint2*)(sST + wofs) = pk; }                                    \
            __syncthreads();                                                                                                                 \
        }
#pragma unroll 1
        for (int n = 0; n < NCH; n += 3) {
            SCAN_STEP(R0, R1, R2, n, 0)
            SCAN_STEP(R1, R2, R0, n + 1, 1)
            SCAN_STEP(R2, R0, R1, n + 2, 2)
        }
#undef SCAN_STEP
    }
}
HD void ph_gdn_outfin(const Params& p, int l, int bid, int nb, float* smf) {
    const int t = tid_(), lane = t & 63, w = t >> 6, fr = lane & 15, fg = lane >> 4;
    const float* og = p.in[I_ONORM] + l * 64;
    const int nlat = NB * 4 * NCL, nctx = (l == 0) ? NB * 4 * NCC : 0;
    float* so = smf;
    for (int u = bid; u < nlat + nctx; u += nb) {
        int b, hd, seg, nloc, ncs, T, base;
        if (u < nlat) { nloc = u % NCL; const int bh = u / NCL; hd = bh & 3; b = bh >> 2; seg = 0; ncs = NCL; T = SEQ; base = b * SEQ; }
        else { const int u2 = u - nlat; nloc = u2 % NCC; const int bh = u2 / NCC; hd = bh & 3; b = bh >> 2; seg = 1; ncs = NCC; T = CTXL; base = NLAT + b * CTXL; }
        __syncthreads();
#pragma unroll
        for (int dir = 0; dir < 2; ++dir) {
            const int nl = dir ? (ncs - 1 - nloc) : nloc;
            const int unit = ((dir * NB + b) * 4 + hd) * NCH + (seg ? nl : NCC + nl);
            const int ci = 16 * w + fr;
            const int pf = nl * 64 + ci; const int arow_ = base + (dir ? (T - 1 - pf) : pf);
            bf16x8_t qa[2], ka_[2];
#pragma unroll
            for (int s_ = 0; s_ < 2; ++s_) {
                qa[s_] = *(const bf16x8_t*)(p.gq + (size_t)arow_ * 768 + hd * 64 + 32 * s_ + 8 * fg);
                ka_[s_] = *(const bf16x8_t*)(p.cQK + (size_t)unit * 4096 + ci * 64 + 32 * s_ + 8 * fg);
            }
            const f32x4_t eG = *(const f32x4_t*)(p.cG + (size_t)unit * 192 + 16 * w + 4 * fg);
#pragma unroll
            for (int j = 0; j < 4; ++j) {
                const bf16* spr = scan_sp(p) + (size_t)unit * 4096 + (16 * j + fr) * 64 + 8 * fg;
                const bf16* vnr = scan_vn(p) + (size_t)unit * 4096 + (16 * j + fr) * 64 + 8 * fg;
                f32x4_t o1 = __builtin_amdgcn_mfma_f32_16x16x32_bf16(qa[0], *(const bf16x8_t*)(spr), f32x4_t{0.f, 0.f, 0.f, 0.f}, 0, 0, 0);
                o1 = __builtin_amdgcn_mfma_f32_16x16x32_bf16(qa[1], *(const bf16x8_t*)(spr + 32), o1, 0, 0, 0);
                f32x4_t o2 = __builtin_amdgcn_mfma_f32_16x16x32_bf16(ka_[0], *(const bf16x8_t*)(vnr), f32x4_t{0.f, 0.f, 0.f, 0.f}, 0, 0, 0);
                o2 = __builtin_amdgcn_mfma_f32_16x16x32_bf16(ka_[1], *(const bf16x8_t*)(vnr + 32), o2, 0, 0, 0);
#pragma unroll
                for (int r = 0; r < 4; ++r) {
                    const int cpos = 16 * w + 4 * fg + r;
                    const int tok = dir ? (63 - cpos) : cpos;
                    float* dst = so + tok * 65 + 16 * j + fr;
                    const float val = eG[r] * o1[r] + o2[r];
                    if (dir == 0) *dst = val; else *dst += val;
                }
            }
            __syncthreads();
        }
        {
            const int tok = t >> 2, q4 = t & 3;
            const int row = base + nloc * 64 + tok;
            float v[16]; float ss = 0.f;
#pragma unroll
            for (int c = 0; c < 16; ++c) { v[c] = so[tok * 65 + q4 * 16 + c]; ss += v[c] * v[c]; }
            ss += __shfl_xor(ss, 1); ss += __shfl_xor(ss, 2);
            const float rs = 1.0f / sqrtf(ss / 64.0f + 1e-6f);
            const uint4 z0 = *(const uint4*)(p.P + (size_t)row * PLD + C_Z + hd * 64 + q4 * 16), z1 = *(const uint4*)(p.P + (size_t)row * PLD + C_Z + hd * 64 + q4 * 16 + 8);
            const unsigned zz[8] = {z0.x, z0.y, z0.z, z0.w, z1.x, z1.y, z1.z, z1.w};
            unsigned pk[8];
#pragma unroll
            for (int c2 = 0; c2 < 8; ++c2) {
                const float za = __uint_as_float(zz[c2] << 16), zb = __uint_as_float(zz[c2] & 0xffff0000u);
                const float oa = v[2 * c2] * rs * og[q4 * 16 + 2 * c2] * siluf_(za), ob = v[2 * c2 + 1] * rs * og[q4 * 16 + 2 * c2 + 1] * siluf_(zb);
                pk[c2] = cvtpk(oa, ob);
            }
            uint4 p0, p1; p0.x = pk[0]; p0.y = pk[1]; p0.z = pk[2]; p0.w = pk[3]; p1.x = pk[4]; p1.y = pk[5]; p1.z = pk[6]; p1.w = pk[7];
            bf16* dstb = p.br + (size_t)row * D + 512 + hd * 64 + q4 * 16;
            *(uint4*)dstb = p0; *(uint4*)(dstb + 8) = p1;
        }
    }
}
#else
HD void ph_gdn_scan(const Params& p, int l, int bid, int nb, float* sm) {
    float* sQ = sm;
    float* sK = sm + 4096;
    bf16* sW = (bf16*)(sm + 8192);
    bf16* sQK = (bf16*)(sm + 10240);
    float* sS = sm + 12288;
    float* sV = sm + 13312;
    float* sU = sm + 14336;
    float* sG = sm + 15360;
    const int RQ = (l == 0) ? R : NLAT;
    for (int cu = bid; cu < 2 * NB * 4 * 4; cu += nb) {
        int chain = cu >> 2, cb = cu & 3;
        THREADS(t, 1024) { sS[t] = 0.f; }
        SYNC
        for (int n = 0; n < NCH; ++n) {
            int unit = chain * NCH + n;
            ChunkInfo c = chunkinfo(unit);
            THREADS(t, 64) { sG[t] = p.cG[(size_t)unit * 64 + t]; }
            SYNC
            THREADS(t, 4096) {
                int i = t >> 6, d = t & 63; int row = chunk_row(c, i);
                sW[t] = p.cW[(size_t)unit * 4096 + t];
                sQK[t] = p.cQK[(size_t)unit * 4096 + t];
                sQ[t] = bf2f(p.gq[(size_t)row * 768 + c.hd * 64 + d]) * expf(sG[i]);
                sK[t] = bf2f(p.gq[(size_t)row * 768 + 256 + c.hd * 64 + d]) * expf(sG[63] - sG[i]);
            }
            THREADS(t, 1024) { int i = t >> 4, e = t & 15; sU[t] = bf2f(p.cU[(size_t)unit * 4096 + i * 64 + cb * 16 + e]); }
            SYNC
            THREADS(t, 1024) {
                int i = t >> 4, e = t & 15;
                float acc = sU[t];
                for (int d = 0; d < 64; ++d) acc -= bf2f(sW[i * 64 + d]) * sS[d * 16 + e];
                sV[t] = acc;
            }
            SYNC
            THREADS(t, 1024) {
                int i = t >> 4, e = t & 15;
                float acc = 0.f;
                for (int d = 0; d < 64; ++d) acc += sQ[i * 64 + d] * sS[d * 16 + e];
                for (int j = 0; j < 64; ++j) acc += bf2f(sQK[i * 64 + j]) * sV[j * 16 + e];
                int row = chunk_row(c, i);
                if (row < RQ) p.odir[((size_t)c.dir * R + row) * 256 + c.hd * 64 + cb * 16 + e] = f2bf(acc);
            }
            SYNC
            THREADS(t, 1024) {
                int d = t >> 4, e = t & 15;
                float acc = sS[t] * expf(sG[63]);
                for (int i = 0; i < 64; ++i) acc += sK[i * 64 + d] * sV[i * 16 + e];
                sS[t] = acc;
            }
            SYNC
        }
    }
}

#endif

#ifndef CPU_EMU
HD void ph_gdn_fin(const Params& p, int l, int bid, int nb) {
    const int RQ = (l == 0) ? R : NLAT;
    const float* og = p.in[I_ONORM] + l * 64;
    const int N = RQ * 32;
    for (int idx = bid * 256 + tid_(); idx < N; idx += nb * 256) {
        const int r = idx >> 5, q = idx & 31; const int hd = q >> 3, cg = q & 7;
        const uint4 a0 = *(const uint4*)(p.odir + (size_t)r * 256 + hd * 64 + cg * 8);
        const uint4 a1 = *(const uint4*)(p.odir + ((size_t)R + r) * 256 + hd * 64 + cg * 8);
        const uint4 zz = *(const uint4*)(p.P + (size_t)r * PLD + C_Z + hd * 64 + cg * 8);
        float v[8], z[8];
        v[0] = __uint_as_float(a0.x << 16) + __uint_as_float(a1.x << 16); v[1] = __uint_as_float(a0.x & 0xffff0000u) + __uint_as_float(a1.x & 0xffff0000u);
        v[2] = __uint_as_float(a0.y << 16) + __uint_as_float(a1.y << 16); v[3] = __uint_as_float(a0.y & 0xffff0000u) + __uint_as_float(a1.y & 0xffff0000u);
        v[4] = __uint_as_float(a0.z << 16) + __uint_as_float(a1.z << 16); v[5] = __uint_as_float(a0.z & 0xffff0000u) + __uint_as_float(a1.z & 0xffff0000u);
        v[6] = __uint_as_float(a0.w << 16) + __uint_as_float(a1.w << 16); v[7] = __uint_as_float(a0.w & 0xffff0000u) + __uint_as_float(a1.w & 0xffff0000u);
        z[0] = __uint_as_float(zz.x << 16); z[1] = __uint_as_float(zz.x & 0xffff0000u); z[2] = __uint_as_float(zz.y << 16); z[3] = __uint_as_float(zz.y & 0xffff0000u);
        z[4] = __uint_as_float(zz.z << 16); z[5] = __uint_as_float(zz.z & 0xffff0000u); z[6] = __uint_as_float(zz.w << 16); z[7] = __uint_as_float(zz.w & 0xffff0000u);
        float ss = 0.f;
#pragma unroll
        for (int c = 0; c < 8; ++c) ss += v[c] * v[c];
        ss += __shfl_xor(ss, 1); ss += __shfl_xor(ss, 2); ss += __shfl_xor(ss, 4);
        const float rs = 1.0f / sqrtf(ss / 64.0f + 1e-6f);
        float o[8];
#pragma unroll
        for (int c = 0; c < 8; ++c) o[c] = v[c] * rs * og[cg * 8 + c] * siluf_(z[c]);
        uint4 pk; pk.x = cvtpk(o[0], o[1]); pk.y = cvtpk(o[2], o[3]); pk.z = cvtpk(o[4], o[5]); pk.w = cvtpk(o[6], o[7]);
        *(uint4*)(p.br + (size_t)r * D + 512 + hd * 64 + cg * 8) = pk;
    }
}
#else
HD void ph_gdn_fin(const Params& p, int l, int bid, int nb) {
    const int RQ = (l == 0) ? R : NLAT;
    const float* og = p.in[I_ONORM] + l * 64;
    const int N = RQ * 4;
    for (int u = bid; u < (N + 255) / 256; u += nb) {
        THREADS(t, 256) {
            int idx = u * 256 + t;
            if (idx < N) {
                int r = idx >> 2, hd = idx & 3;
                const bf16* o0 = p.odir + (size_t)r * 256 + hd * 64;
                const bf16* o1 = p.odir + ((size_t)R + r) * 256 + hd * 64;
                float ss = 0.f;
                for (int d = 0; d < 64; ++d) { float v = bf2f(o0[d]) + bf2f(o1[d]); ss += v * v; }
                float rs = 1.0f / sqrtf(ss / 64.0f + 1e-6f);
                for (int d = 0; d < 64; ++d) {
                    float v = (bf2f(o0[d]) + bf2f(o1[d])) * rs * og[d];
                    float z = bf2f(p.P[(size_t)r * PLD + C_Z + hd * 64 + d]);
                    p.br[(size_t)r * D + 512 + hd * 64 + d] = f2bf(v * siluf_(z));
                }
            }
        }
    }
}

#endif

#ifndef CPU_EMU
HD void ph_merge(const Params& p, int l, int bid, int nb, char* smc) {
    const int MT = ((l == 0) ? R : NLAT) / 128;
    const bf16* Wg = p.wt_in + (size_t)l * WIN_NP * D + (size_t)PLD * D;
    const bf16* Wb = p.wt_br + (size_t)l * 4 * D * 256;
    for (int tile = bid; tile < MT * 8; tile += nb) {
        const int mt = tile >> 3, nt = tile & 7;
        AccT<4> accM; acc_zero(accM);
        const unsigned char* h8 = (const unsigned char*)h8_of(p);
        auto aG = [&](int r) { return (const void*)(h8 + (size_t)(mt * 128 + r) * D); };
        int cur = 0;
        __syncthreads();
        gemm_stage0<4>(aG, [&](int j) { return (const void*)((const unsigned char*)Wg + (size_t)(nt * 128 + j) * D); }, 1, smc, 0);
#pragma unroll 1
        for (int i = 0; i < 4; ++i) {
            AccT<4> acc; acc_zero(acc);
            auto bG = [&](int j) { return (const void*)((const unsigned char*)Wg + (size_t)(i * 1024 + nt * 128 + j) * D); };
            auto aP = [&](int r) { return (const void*)(p.br + (size_t)(mt * 128 + r) * D + i * 256); };
            auto bP = [&](int j) { return (const void*)(Wb + ((size_t)i * D + nt * 128 + j) * 256); };
            gemm_chain<4, true>(acc, aG, bG, D, smc, cur, [&](int buf) { gemm_stage0<4>(aP, bP, 2, smc, buf); }, SC_H, SC_W);
            unsigned sg[4][4][2];
#pragma unroll
            for (int a_ = 0; a_ < 4; ++a_)
#pragma unroll
                for (int b_ = 0; b_ < 4; ++b_) {
                    float e[4];
#pragma unroll
                    for (int r = 0; r < 4; ++r) e[r] = __builtin_amdgcn_rcpf(1.0f + __expf(-acc.v[a_][b_][r]));
                    sg[a_][b_][0] = cvtpk(e[0], e[1]); sg[a_][b_][1] = cvtpk(e[2], e[3]);
                }
            acc_zero(acc);
            auto bGn = [&](int j) { return (const void*)((const unsigned char*)Wg + (size_t)((i + 1) * 1024 + nt * 128 + j) * D); };
            gemm_chain<4, false>(acc, aP, bP, 256, smc, cur, [&](int buf) { if (i < 3) gemm_stage0<4>(aG, bGn, 1, smc, buf); }, 0, 0);
#pragma unroll
            for (int a_ = 0; a_ < 4; ++a_)
#pragma unroll
                for (int b_ = 0; b_ < 4; ++b_) {
                    accM.v[a_][b_][0] += __uint_as_float(sg[a_][b_][0] << 16) * acc.v[a_][b_][0];
                    accM.v[a_][b_][1] += __uint_as_float(sg[a_][b_][0] & 0xffff0000u) * acc.v[a_][b_][1];
                    accM.v[a_][b_][2] += __uint_as_float(sg[a_][b_][1] << 16) * acc.v[a_][b_][2];
                    accM.v[a_][b_][3] += __uint_as_float(sg[a_][b_][1] & 0xffff0000u) * acc.v[a_][b_][3];
                }
        }
        __syncthreads();
        float* tl = (float*)smc;
        acc_to_lds<4>(accM, tl);
        __syncthreads();
        const int t_ = tid_(); const int row = t_ >> 1, half = t_ & 1;
        bf16* dst = p.mg + (size_t)(mt * 128 + row) * D + nt * 128 + half * 64;
#pragma unroll
        for (int q = 0; q < 8; ++q) {
            const f32x4_t a = *(const f32x4_t*)(tl + row * 132 + half * 64 + q * 8), b = *(const f32x4_t*)(tl + row * 132 + half * 64 + q * 8 + 4);
            uint4 pk; pk.x = cvtpk(a[0], a[1]); pk.y = cvtpk(a[2], a[3]); pk.z = cvtpk(b[0], b[1]); pk.w = cvtpk(b[2], b[3]);
            *(uint4*)(dst + q * 8) = pk;
        }
    }
}
#else
HD void ph_merge(const Params& p, int l, int bid, int nb, char* smc) {
    const int MT = ((l == 0) ? R : NLAT) / 128;
    const bf16* Wg = p.wt_in + (size_t)l * WIN_NP * D + (size_t)PLD * D;
    const bf16* Wb = p.wt_br + (size_t)l * 4 * D * 256;
    for (int tile = bid; tile < MT * 16; tile += nb) {
        const int mt = tile >> 4, nt = tile & 15;
        ACC_DECL(2, accM); acc_zero(accM);
        for (int i = 0; i < 4; ++i) {
            ACC_DECL(2, accG); acc_zero(accG);
            ACC_DECL(2, accP); acc_zero(accP);
            gemm_accum<2>(accG, [&](int r) { return p.h + (size_t)(mt * 128 + r) * D; },
                          [&](int j) { return Wg + (size_t)(i * 1024 + nt * 64 + j) * D; }, D, smc);
            gemm_accum<2>(accP, [&](int r) { return p.br + (size_t)(mt * 128 + r) * D + i * 256; },
                          [&](int j) { return Wb + ((size_t)i * D + nt * 64 + j) * 256; }, 256, smc);
            ACC_FOR(2, row, col) { AV(accM) += sigmoidf_(AV(accG)) * AV(accP); } ACC_END
        }
#ifndef CPU_EMU
        {
            float* tl = (float*)smc;
            acc_to_lds<2>(accM, tl);
            __syncthreads();
            const int t_ = tid_(); const int row = t_ >> 1, half = t_ & 1;
            bf16* dst = p.mg + (size_t)(mt * 128 + row) * D + nt * 64 + half * 32;
#pragma unroll
            for (int q = 0; q < 4; ++q) {
                const f32x4_t a = *(const f32x4_t*)(tl + row * 68 + half * 32 + q * 8), b = *(const f32x4_t*)(tl + row * 68 + half * 32 + q * 8 + 4);
                uint4 pk; pk.x = cvtpk(a[0], a[1]); pk.y = cvtpk(a[2], a[3]); pk.z = cvtpk(b[0], b[1]); pk.w = cvtpk(b[2], b[3]);
                *(uint4*)(dst + q * 8) = pk;
            }
        }
#else
        ACC_FOR(2, row, col) { p.mg[(size_t)(mt * 128 + row) * D + nt * 64 + col] = f2bf(AV(accM)); } ACC_END
#endif
    }
}

#endif

template <int DRY> HD void ph_outproj_t(const Params& p, int l, int bid, int nb, char* smc) {
    const int MT = ((l == 0) ? R : NLAT) / 128;
    const bf16* Wt = p.wt_out + (size_t)l * D * D;
    for (int tile = bid; tile < MT * 8; tile += nb) {
        const int mt = tile >> 3, nt = tile & 7;
        ACC_DECL(4, acc); acc_zero(acc);
        gemm_accum<4>(acc, [&](int r) { return p.mg + (size_t)(mt * 128 + r) * D; }, [&](int j) { return Wt + (size_t)(nt * 128 + j) * D; }, D, smc);
#ifndef CPU_EMU
        {
            float* tl = (float*)smc;
            acc_to_lds<4>(acc, tl);
            __syncthreads();
            const int t_ = tid_(); const int row = t_ >> 1, half = t_ & 1;
            const int r = mt * 128 + row, c0 = nt * 128 + half * 64;
            const float* xi = xrow_in(p, l, r) + c0; float* xo = (DRY ? ((float*)p.Y + (size_t)r * D) : xrow_out(p, r)) + c0; const float* gm = modrow(p, l, r) + 2048 + c0;
#pragma unroll
            for (int q = 0; q < 16; ++q) {
                const f32x4_t a = *(const f32x4_t*)(tl + row * 132 + half * 64 + q * 4), xv = *(const f32x4_t*)(xi + q * 4), gv = *(const f32x4_t*)(gm + q * 4);
                f32x4_t o; o[0] = xv[0] + gv[0] * a[0]; o[1] = xv[1] + gv[1] * a[1]; o[2] = xv[2] + gv[2] * a[2]; o[3] = xv[3] + gv[3] * a[3];
                *(f32x4_t*)(xo + q * 4) = o;
            }
        }
#else
        ACC_FOR(4, row, col) {
            const int r = mt * 128 + row, c = nt * 128 + col;
            xrow_out(p, r)[c] = xrow_in(p, l, r)[c] + modrow(p, l, r)[2048 + c] * AV(acc);
        } ACC_END
#endif
    }
}

HD void ph_outproj(const Params& p, int l, int bid, int nb, char* smc) { ph_outproj_t<0>(p, l, bid, nb, smc); }
#ifndef CPU_EMU
template <int DRY> HD void ph_router_t(const Params& p, int l, int bid, int nb, float* smf) {
    char* smc = (char*)smf;
    const int t = tid_(), lane = t & 63, w = t >> 6, fr = lane & 15, fg = lane >> 4;
    const int RQ = (l == 0) ? R : NLAT;
    const float* gN = p.in[I_N2G] + l * D;
    constexpr int WST = 2080;
    float* lgw = (float*)(smc + 66560) + w * (16 * 17);
    int* lcnt = (int*)(smc + 70912); int* gbase = (int*)(smc + 70976);
    __syncthreads();
    for (int k = t; k < 1024; k += 256) {
        const float* wrow = p.in[I_WROUTER] + k * 16;
#pragma unroll
        for (int e = 0; e < 16; ++e) {
            const float v = wrow[e]; const bf16 hi = f2bf(v);
            *(bf16*)(smc + e * WST + k * 2) = hi; *(bf16*)(smc + 33280 + e * WST + k * 2) = f2bf(v - bf2f(hi));
        }
    }
    const int ngroups = RQ / 16;
    for (int g0 = bid * 4; g0 < ngroups; g0 += nb * 4) {
        __syncthreads();
        if (t < 16) lcnt[t] = 0;
        __syncthreads();
        const int gidx = g0 + w;
        const bool active = gidx < ngroups;
        int e1 = 0, e2 = 0, q1 = 0, q2 = 0; const int rsel = gidx * 16 + lane;
        if (active) {
            const int r = gidx * 16 + fr;
            const float* x = xrow_out(p, r);
            const float* m = modrow(p, l, r);
            float ss = 0.f;
#pragma unroll 4
            for (int s_ = 0; s_ < 32; ++s_) {
                const f32x4_t a = *(const f32x4_t*)(x + s_ * 32 + fg * 8), b = *(const f32x4_t*)(x + s_ * 32 + fg * 8 + 4);
                ss += a[0] * a[0] + a[1] * a[1] + a[2] * a[2] + a[3] * a[3] + b[0] * b[0] + b[1] * b[1] + b[2] * b[2] + b[3] * b[3];
            }
            ss += __shfl_xor(ss, 16); ss += __shfl_xor(ss, 32);
            const float rs = 1.0f / sqrtf(ss / D + 1e-6f);
            f32x4_t acc = f32x4_t{0.f, 0.f, 0.f, 0.f};
#pragma unroll 2
            for (int s_ = 0; s_ < 32; ++s_) {
                const int k0 = s_ * 32 + fg * 8;
                float hv[8];
#pragma unroll
                for (int hh = 0; hh < 2; ++hh) {
                    const f32x4_t xv = *(const f32x4_t*)(x + k0 + hh * 4), gv = *(const f32x4_t*)(gN + k0 + hh * 4);
                    const f32x4_t sc = *(const f32x4_t*)(m + 4096 + k0 + hh * 4), sh = *(const f32x4_t*)(m + 3072 + k0 + hh * 4);
#pragma unroll
                    for (int q = 0; q < 4; ++q) hv[hh * 4 + q] = xv[q] * rs * gv[q] * (1.0f + sc[q]) + sh[q];
                }
                unsigned hi[4], lo[4];
#pragma unroll
                for (int q = 0; q < 4; ++q) {
                    hi[q] = cvtpk(hv[2 * q], hv[2 * q + 1]);
                    lo[q] = cvtpk(hv[2 * q] - __uint_as_float(hi[q] << 16), hv[2 * q + 1] - __uint_as_float(hi[q] & 0xffff0000u));
                }
                const i32x4_t hiv = i32x4_t{(int)hi[0], (int)hi[1], (int)hi[2], (int)hi[3]}, lov = i32x4_t{(int)lo[0], (int)lo[1], (int)lo[2], (int)lo[3]};
                { uint2 q8; q8.x = pack_fp8x4(hv[0] * 4.f, hv[1] * 4.f, hv[2] * 4.f, hv[3] * 4.f); q8.y = pack_fp8x4(hv[4] * 4.f, hv[5] * 4.f, hv[6] * 4.f, hv[7] * 4.f);
                  *(uint2*)(h8_of(p) + (size_t)r * D + k0) = q8; }
                const bf16x8_t bh = *(const bf16x8_t*)(smc + fr * WST + s_ * 64 + fg * 16), bl = *(const bf16x8_t*)(smc + 33280 + fr * WST + s_ * 64 + fg * 16);
                acc = __builtin_amdgcn_mfma_f32_16x16x32_bf16(__builtin_bit_cast(bf16x8_t, hiv), bh, acc, 0, 0, 0);
                acc = __builtin_amdgcn_mfma_f32_16x16x32_bf16(__builtin_bit_cast(bf16x8_t, hiv), bl, acc, 0, 0, 0);
                acc = __builtin_amdgcn_mfma_f32_16x16x32_bf16(__builtin_bit_cast(bf16x8_t, lov), bh, acc, 0, 0, 0);
            }
#pragma unroll
            for (int q = 0; q < 4; ++q) lgw[(4 * fg + q) * 17 + fr] = acc[q];
            if (lane < 16) {
                float sc[16], sel[16];
#pragma unroll
                for (int e = 0; e < 16; ++e) { sc[e] = sigmoidf_(lgw[lane * 17 + e]); sel[e] = sc[e] + p.in[I_RBIAS][e]; }
                int best = 0; float bestv = -1e30f;
#pragma unroll
                for (int gph = 0; gph < 4; ++gph) {
                    float t1 = -1e30f, t2 = -1e30f;
#pragma unroll
                    for (int j = 0; j < 4; ++j) { const float v = sel[gph * 4 + j]; if (v > t1) { t2 = t1; t1 = v; } else if (v > t2) t2 = v; }
                    const float gs = t1 + t2;
                    if (gs > bestv) { bestv = gs; best = gph; }
                }
                float v1 = -1e30f, v2 = -1e30f, w1 = 0.f, w2 = 0.f; int i1 = 0, i2 = 0;
#pragma unroll
                for (int e = 0; e < 16; ++e) {
                    if ((e >> 2) == best) {
                        const float v = sel[e];
                        if (v > v1) { v2 = v1; i2 = i1; w2 = w1; v1 = v; i1 = e; w1 = sc[e]; } else if (v > v2) { v2 = v; i2 = e; w2 = sc[e]; }
                    }
                }
                e1 = i1; e2 = i2;
                const float ws_ = w1 + w2;
                p.sel_e[rsel * 2] = i1; p.sel_e[rsel * 2 + 1] = i2;
                p.sel_w[rsel * 2] = w1 / ws_; p.sel_w[rsel * 2 + 1] = w2 / ws_;
                q1 = atomicAdd(&lcnt[i1], 1); q2 = atomicAdd(&lcnt[i2], 1);
            }
        }
        __syncthreads();
        if (t < 16) { const int c = lcnt[t]; gbase[t] = (c && !DRY) ? atomicAdd(&p.cnt[l * 16 + t], c) : 0; }
        __syncthreads();
        if (active && lane < 16 && !DRY) {
            const int p1 = gbase[e1] + q1, p2 = gbase[e2] + q2;
            p.elist[(size_t)e1 * 2 * R + p1] = rsel * 2; p.apos[rsel * 2] = p1;
            p.elist[(size_t)e2 * 2 * R + p2] = rsel * 2 + 1; p.apos[rsel * 2 + 1] = p2;
        }
    }
}
HD void ph_router(const Params& p, int l, int bid, int nb, float* smf) { ph_router_t<0>(p, l, bid, nb, smf); }
#else
HD void ph_router(const Params& p, int l, int bid, int nb, float* sm) {
    const int RQ = (l == 0) ? R : NLAT;
    const float* g = p.in[I_N2G] + l * D;
    const float* wr = p.in[I_WROUTER];
    float* sh = sm + 512;
    float* sl = sm + 2048;
    for (int r = bid; r < RQ; r += nb) {
        const float* x = xrow_out(p, r);
        const float* m = modrow(p, l, r);
        THREADS(t, 256) { float s = 0.f; for (int k = t; k < D; k += 256) s += x[k] * x[k]; sm[t] = s; }
        SYNC
        THREADS(t, 1) { float s = 0.f; for (int i = 0; i < 256; ++i) s += sm[i]; sm[256] = s; }
        SYNC
        THREADS(t, 256) {
            float rs = 1.0f / sqrtf(sm[256] / D + 1e-6f);
            for (int k = t; k < D; k += 256) {
                float v = x[k] * rs * g[k];
                v = v * (1.0f + m[4096 + k]) + m[3072 + k];
                sh[k] = v;
                p.h[(size_t)r * D + k] = f2bf(v);
            }
        }
        SYNC
        THREADS(t, 256) {
            int e = t & 15, ks = t >> 4;
            float acc = 0.f;
            for (int k = ks * 64; k < ks * 64 + 64; ++k) acc += sh[k] * wr[k * 16 + e];
            sl[ks * 16 + e] = acc;
        }
        SYNC
        THREADS(t, 1) {
            float* sc = sm + 2304; float* sel = sm + 2320;
            for (int e = 0; e < 16; ++e) {
                float acc = 0.f;
                for (int ks = 0; ks < 16; ++ks) acc += sl[ks * 16 + e];
                sc[e] = sigmoidf_(acc); sel[e] = sc[e] + p.in[I_RBIAS][e];
            }
            int best = 0; float bestv = -1e30f;
            for (int gph = 0; gph < 4; ++gph) {
                float t1 = -1e30f, t2 = -1e30f;
                for (int j = 0; j < 4; ++j) { float v = sel[gph * 4 + j]; if (v > t1) { t2 = t1; t1 = v; } else if (v > t2) t2 = v; }
                float gs = t1 + t2;
                if (gs > bestv) { bestv = gs; best = gph; }
            }
            int i1 = -1, i2 = -1; float v1 = -1e30f, v2 = -1e30f;
            for (int j = 0; j < 4; ++j) {
                float v = sel[best * 4 + j];
                if (v > v1) { v2 = v1; i2 = i1; v1 = v; i1 = best * 4 + j; } else if (v > v2) { v2 = v; i2 = best * 4 + j; }
            }
            float w1 = sc[i1], w2 = sc[i2], ws = w1 + w2;
            p.sel_e[r * 2] = i1; p.sel_e[r * 2 + 1] = i2;
            p.sel_w[r * 2] = w1 / ws; p.sel_w[r * 2 + 1] = w2 / ws;
            int q1 = ATOMIC_ADD_RET(&p.cnt[l * 16 + i1], 1); p.elist[(size_t)i1 * 2 * R + q1] = r * 2; p.apos[r * 2] = q1;
            int q2 = ATOMIC_ADD_RET(&p.cnt[l * 16 + i2], 1); p.elist[(size_t)i2 * 2 * R + q2] = r * 2 + 1; p.apos[r * 2 + 1] = q2;
        }
        SYNC
    }
}

#endif

struct MoeTiles { int tstart[17]; };
HD MoeTiles moe_tiles(const Params& p, int l) {
    MoeTiles m; int acc = 0;
    for (int e = 0; e < 16; ++e) { m.tstart[e] = acc; acc += (p.cnt[l * 16 + e] + 127) >> 7; }
    m.tstart[16] = acc; return m;
}

HD void ph_ffn1(const Params& p, int l, int bid, int nb, char* smc) {
    int tstart[17];
    { int acc = 0; for (int e = 0; e < 16; ++e) { tstart[e] = acc; acc += (p.cnt[l * 16 + e] + 127) >> 7; } tstart[16] = acc; }
    const int ntiles = tstart[16];
    for (int tile = bid; tile < ntiles * 8; tile += nb) {
        const int rt = tile >> 3, nt = tile & 7;
        int e = 0, ts = 0;
#pragma unroll
        for (int q = 1; q < 16; ++q) if (rt >= tstart[q]) { e = q; ts = tstart[q]; }
        const int mt = rt - ts;
        const int cnt_e = p.cnt[l * 16 + e];
        const int* el = p.elist + (size_t)e * 2 * R;
#ifndef CPU_EMU
        const unsigned char* Wt8 = gu8_of(p) + (size_t)e * 1024 * D;
        AccT<4> acc; acc_zero(acc);
        gemm_accum8<4>(acc, [&](int i) { int q = mt * 128 + i; int a = (q < cnt_e) ? el[q] : el[0]; return (const unsigned char*)h8_of(p) + (size_t)(a >> 1) * D; },
                       [&](int j) { return Wt8 + (size_t)(nt * 128 + j) * D; }, D, smc, SC_H, SC_W);
        {
            float* tl = (float*)smc;
            acc_to_lds<4>(acc, tl);
            __syncthreads();
            const int t_ = tid_(); const int row = t_ >> 1, half = t_ & 1;
            unsigned char* dst = (unsigned char*)p.act + (size_t)(rt * 128 + row) * 512 + nt * 64 + half * 32;
#pragma unroll
            for (int q = 0; q < 2; ++q) {
                float o[16];
#pragma unroll
                for (int c4 = 0; c4 < 4; ++c4) {
                    const f32x4_t gv = *(const f32x4_t*)(tl + row * 132 + half * 64 + q * 32 + c4 * 4), uv = *(const f32x4_t*)(tl + row * 132 + half * 64 + q * 32 + 16 + c4 * 4);
#pragma unroll
                    for (int e_ = 0; e_ < 4; ++e_) o[c4 * 4 + e_] = gv[e_] / (1.0f + __expf(-gv[e_])) * uv[e_] * 16.0f;
                }
                uint4 pk; pk.x = pack_fp8x4(o[0], o[1], o[2], o[3]); pk.y = pack_fp8x4(o[4], o[5], o[6], o[7]);
                pk.z = pack_fp8x4(o[8], o[9], o[10], o[11]); pk.w = pack_fp8x4(o[12], o[13], o[14], o[15]);
                *(uint4*)(dst + q * 16) = pk;
            }
        }
#else
        const bf16* Wt = p.wt_gu + (size_t)e * 1024 * D;
        ACC_DECL(4, acc); acc_zero(acc);
        gemm_accum<4>(acc, [&](int i) { int q = mt * 128 + i; int a = (q < cnt_e) ? el[q] : el[0]; return p.h + (size_t)(a >> 1) * D; },
                      [&](int j) { return Wt + (size_t)(nt * 128 + j) * D; }, D, smc);
        ACC_FOR_PAIR(row, pcol) {
            float gv = AV_G(acc), uv = AV_U(acc);
            p.act[(size_t)(rt * 128 + row) * 512 + nt * 64 + pcol] = f2bf(siluf_(gv) * uv);
        } ACC_END
#endif
    }
}

HD void ph_ffn2(const Params& p, int l, int bid, int nb, char* smc) {
    int tstart[17];
    { int acc = 0; for (int e = 0; e < 16; ++e) { tstart[e] = acc; acc += (p.cnt[l * 16 + e] + 127) >> 7; } tstart[16] = acc; }
    const int ntiles = tstart[16];
    for (int tile = bid; tile < ntiles * 8; tile += nb) {
        const int rt = tile >> 3, nt = tile & 7;
        int e = 0;
#pragma unroll
        for (int q = 1; q < 16; ++q) if (rt >= tstart[q]) e = q;
#ifndef CPU_EMU
        const unsigned char* Wt8 = d8_of(p) + (size_t)e * D * 512;
        AccT<4> acc; acc_zero(acc);
        gemm_accum8<4>(acc, [&](int i) { return (const unsigned char*)p.act + (size_t)(rt * 128 + i) * 512; }, [&](int j) { return Wt8 + (size_t)(nt * 128 + j) * 512; }, 512, smc, SC_ACT, SC_W);
#else
        const bf16* Wt = p.wt_d + (size_t)e * D * 512;
        ACC_DECL(4, acc); acc_zero(acc);
        gemm_accum<4>(acc, [&](int i) { return p.act + (size_t)(rt * 128 + i) * 512; }, [&](int j) { return Wt + (size_t)(nt * 128 + j) * 512; }, 512, smc);
#endif
#ifndef CPU_EMU
        {
            float* tl = (float*)smc;
            acc_to_lds<4>(acc, tl);
            __syncthreads();
            const int t_ = tid_(); const int row = t_ >> 1, half = t_ & 1;
            bf16* dst = p.Y + (size_t)(rt * 128 + row) * D + nt * 128 + half * 64;
#pragma unroll
            for (int q = 0; q < 8; ++q) {
                const f32x4_t a = *(const f32x4_t*)(tl + row * 132 + half * 64 + q * 8), b = *(const f32x4_t*)(tl + row * 132 + half * 64 + q * 8 + 4);
                uint4 pk; pk.x = cvtpk(a[0], a[1]); pk.y = cvtpk(a[2], a[3]); pk.z = cvtpk(b[0], b[1]); pk.w = cvtpk(b[2], b[3]);
                *(uint4*)(dst + q * 8) = pk;
            }
        }
#else
        ACC_FOR(4, row, col) { p.Y[(size_t)(rt * 128 + row) * D + nt * 128 + col] = f2bf(AV(acc)); } ACC_END
#endif
    }
}

#ifndef CPU_EMU
template <int DRY> HD void ph_combine_t(const Params& p, int l, int bid, int nb) {
    const int RQ = (l == 0) ? R : NLAT;
    const int t = tid_(), lane = t & 63, w = t >> 6;
    int tstart[17];
    { int acc = 0;
#pragma unroll
      for (int e = 0; e < 16; ++e) { tstart[e] = acc; acc += (p.cnt[l * 16 + e] + 127) >> 7; } tstart[16] = acc; }
    for (int r = bid * 4 + w; r < RQ; r += nb * 4) {
        float* xo = xrow_out(p, r);
        const float* m = modrow(p, l, r) + 5120;
        const int e0 = p.sel_e[r * 2], e1 = p.sel_e[r * 2 + 1];
        int t0 = 0, t1 = 0;
#pragma unroll
        for (int q = 0; q < 16; ++q) { if (q == e0) t0 = tstart[q]; if (q == e1) t1 = tstart[q]; }
        const bf16* y0 = p.Y + (size_t)(t0 * 128 + p.apos[r * 2]) * D;
        const bf16* y1 = p.Y + (size_t)(t1 * 128 + p.apos[r * 2 + 1]) * D;
        const float w0 = p.sel_w[r * 2], w1 = p.sel_w[r * 2 + 1];
        f32x4_t xs[4]; float ss = 0.f;
#pragma unroll
        for (int j = 0; j < 4; ++j) {
            const int k = j * 256 + lane * 4;
            f32x4_t xv = *(const f32x4_t*)(xo + k);
            const f32x4_t gv = *(const f32x4_t*)(m + k);
            const uint2 a = *(const uint2*)(y0 + k), b = *(const uint2*)(y1 + k);
            xv[0] += gv[0] * (w0 * __uint_as_float(a.x << 16) + w1 * __uint_as_float(b.x << 16));
            xv[1] += gv[1] * (w0 * __uint_as_float(a.x & 0xffff0000u) + w1 * __uint_as_float(b.x & 0xffff0000u));
            xv[2] += gv[2] * (w0 * __uint_as_float(a.y << 16) + w1 * __uint_as_float(b.y << 16));
            xv[3] += gv[3] * (w0 * __uint_as_float(a.y & 0xffff0000u) + w1 * __uint_as_float(b.y & 0xffff0000u));
            *(f32x4_t*)((DRY ? (float*)p.gq + (size_t)r * 64 : xo) + (DRY ? (k & 63) : k)) = xv;
            xs[j] = xv; ss += xv[0] * xv[0] + xv[1] * xv[1] + xv[2] * xv[2] + xv[3] * xv[3];
        }
        if (l == 0 && !DRY) {
            ss = wave_sum(ss);
            const float rs = 1.0f / sqrtf(ss / D + 1e-6f);
            const float* g1 = p.in[I_N1G] + D; const float* m1 = modrow(p, 1, r);
#pragma unroll
            for (int j = 0; j < 4; ++j) {
                const int k = j * 256 + lane * 4;
                const f32x4_t gv = *(const f32x4_t*)(g1 + k), sc = *(const f32x4_t*)(m1 + 1024 + k), sh = *(const f32x4_t*)(m1 + k);
                float o[4];
#pragma unroll
                for (int q = 0; q < 4; ++q) o[q] = xs[j][q] * rs * gv[q] * (1.0f + sc[q]) + sh[q];
                uint2 pk; pk.x = cvtpk(o[0], o[1]); pk.y = cvtpk(o[2], o[3]);
                *(uint2*)(p.h + (size_t)r * D + k) = pk;
                *(unsigned*)(h8_of(p) + (size_t)r * D + k) = pack_fp8x4(o[0] * 4.f, o[1] * 4.f, o[2] * 4.f, o[3] * 4.f);
            }
        }
    }
}
HD void ph_combine(const Params& p, int l, int bid, int nb) { ph_combine_t<0>(p, l, bid, nb); }
#else
HD void ph_combine(const Params& p, int l, int bid, int nb) {
    const int RQ = (l == 0) ? R : NLAT;
    int tstart[17];
    { int acc = 0; for (int e = 0; e < 16; ++e) { tstart[e] = acc; acc += (p.cnt[l * 16 + e] + 127) >> 7; } tstart[16] = acc; }
    for (int r = bid; r < RQ; r += nb) {
        float* xo = xrow_out(p, r);
        const float* m = modrow(p, l, r);
        int e0 = p.sel_e[r * 2], e1 = p.sel_e[r * 2 + 1];
        int t0 = 0, t1 = 0;
#pragma unroll
        for (int q = 0; q < 16; ++q) { if (q == e0) t0 = tstart[q]; if (q == e1) t1 = tstart[q]; }
        const bf16* y0 = p.Y + (size_t)(t0 * 128 + p.apos[r * 2]) * D;
        const bf16* y1 = p.Y + (size_t)(t1 * 128 + p.apos[r * 2 + 1]) * D;
        const float w0 = p.sel_w[r * 2], w1 = p.sel_w[r * 2 + 1];
        THREADS(t, 256) {
            for (int k = t; k < D; k += 256) xo[k] += m[5120 + k] * (w0 * bf2f(y0[k]) + w1 * bf2f(y1[k]));
        }
    }
}

#endif

constexpr int NPHASE_LAYER = 14;
HD void run_phase(const Params& p, int ph, int l, int bid, int nb, float* sm) {
    switch (ph) {
        case 0: ph_norm1(p, l, bid, nb, sm); break;
        case 1: ph_inproj(p, l, bid, nb, (char*)sm); break;
        case 2: ph_prep(p, l, bid, nb); if (FOURIER_GEMM) { if (l == 0) ph_fourier_s1c(p, nb - 1 - bid, nb, (char*)sm); ph_fourier_s1(p, bid, nb, (char*)sm); } break;
        case 3: ph_na(p, l, bid, nb, (char*)sm); break;
        case 4: ph_da(p, l, bid, nb, (char*)sm); break;
        case 5: ph_gdn_chunk(p, l, bid, nb, sm); break;
        case 6: if (FOURIER_GEMM) { if (l == 0) ph_fourier_ctx(p, bid, nb, (char*)sm); ph_fourier_sA(p, bid, nb, (char*)sm); } else ph_fourier2(p, l, bid, nb); break;
        case 7: {
            ph_gdn_scan(p, l, bid, nb, sm);
            const bool split = nb == 512;
            const bool skip = split && (bid < 64 || (bid >= 256 && bid < 320));
            if (!skip) {
                const int b2 = split ? (bid < 256 ? bid - 64 : bid - 128) : bid, n2 = split ? nb - 128 : nb;
                if (FOURIER_GEMM) ph_fourier_sB(p, b2, n2, (char*)sm);
                if (l == 0) convert_static(p, b2, n2, sm, 1);
                convert_moe(p, l, b2, n2, sm);
#ifndef CPU_EMU
                ph_na(p, l, b2, n2, (char*)sm);
#endif
            }
        } break;
#ifndef CPU_EMU
        case 8: ph_gdn_outfin(p, l, bid, nb, sm); break;
#else
        case 8: ph_gdn_fin(p, l, bid, nb); break;
#endif
        case 9: ph_merge(p, l, bid, nb, (char*)sm); break;
        case 10: ph_outproj(p, l, bid, nb, (char*)sm); break;
        case 11: ph_router(p, l, bid, nb, sm); break;
        case 12: ph_ffn1(p, l, bid, nb, (char*)sm); break;
        case 13: ph_ffn2(p, l, bid, nb, (char*)sm); break;
        case 14: ph_combine(p, l, bid, nb); break;
#ifndef CPU_EMU
        case 70: ph_gdn_scan(p, l, bid, nb, sm); break;
        case 71: if (bid >= 64) { if (FOURIER_GEMM) ph_fourier_sB(p, bid - 64, nb - 64, (char*)sm); if (l == 0) convert_static(p, bid - 64, nb - 64, sm, 1); convert_moe(p, l, bid - 64, nb - 64, sm); } break;
        case 110: ph_outproj_t<1>(p, l, bid, nb, (char*)sm); break;
        case 111: ph_router_t<1>(p, l, bid, nb, sm); break;
        case 114: ph_combine_t<1>(p, l, bid, nb); break;
#endif
        default: break;
    }
}

struct WsLayout { size_t fWC, fXC, ropeT, bar, fa2, fW1, fWA, fWB, mods, cosT, sinT, cs, gg, gbeta, sel_e, sel_w, cnt, elist, apos, cG, wt_in, wt_br, wt_out, wt_gu, wt_d,
                  h, P, gq, fcs, cU, cW, cQK, odir, br, mg, act, Y, total; };
inline WsLayout ws_layout() {
    WsLayout w; size_t o = 0;
    auto take = [&](size_t bytes) { size_t r = o; o += (bytes + 255) & ~(size_t)255; return r; };
    w.bar = take(3456 * 4); w.ropeT = take(128 * 8 * 2 * 4); w.fWC = take((size_t)CTXL * 2 * CTXL * 2); w.fXC = take((size_t)NB * 256 * 2 * CTXL * 2);
    w.mods = take(2 * 3 * 6144 * 4); w.cosT = take(SEQ * 4); w.sinT = take(SEQ * 4); w.cs = take((size_t)NCTX * D * 4);
    w.gg = take((size_t)8 * R * 4); w.gbeta = take((size_t)8 * R * 4); w.sel_e = take((size_t)R * 2 * 4); w.sel_w = take((size_t)R * 2 * 4);
    w.cnt = take(32 * 4); w.elist = take((size_t)16 * 2 * R * 4); w.apos = take((size_t)2 * R * 4); w.cG = take((size_t)NUNIT * 192 * 4);
    w.wt_in = take((size_t)2 * WIN_NP * D * 2); w.wt_br = take((size_t)2 * 4 * D * 256 * 2); w.wt_out = take((size_t)2 * D * D * 2);
    w.wt_gu = take((size_t)16 * 1024 * D * 2); w.wt_d = take((size_t)16 * D * 512 * 2);
    w.h = take((size_t)R * D * 2);
    w.fa2 = take((size_t)NB * 128 * 256 * 2 * 64 * 2); w.fW1 = take(8192 * 2); w.fWA = take(65536 * 2); w.fWB = take(8192 * 2);
    {
        const size_t szP = ((size_t)R * PLD * 2 + 255) & ~(size_t)255, szQ = ((size_t)R * 768 * 2 + 255) & ~(size_t)255;
        const size_t szA = ((size_t)PADROWS * 512 * 2 + 255) & ~(size_t)255, szY = ((size_t)PADROWS * 1024 * 2 + 255) & ~(size_t)255;
        const size_t base = take((szP + szQ) > (szA + szY) ? (szP + szQ) : (szA + szY));
        w.P = base; w.gq = base + szP; w.act = base; w.Y = base + szA;
    }
    w.fcs = take((size_t)R * 512 * 2);
    w.cU = take((size_t)NUNIT * 4096 * 2); w.cW = take((size_t)NUNIT * 4096 * 2); w.cQK = take((size_t)NUNIT * 4096 * 2);
    w.odir = take((size_t)2 * R * 256 * 2); w.br = take((size_t)R * D * 2);
    w.mg = w.cU;
    w.total = o;
    return w;
}
inline void fill_params(Params& p, void* const* d_in, void* d_out, void* d_ws) {
    WsLayout w = ws_layout(); char* b = (char*)d_ws;
    for (int i = 0; i < 30; ++i) p.in[i] = (const float*)d_in[i];
    p.out = (float*)d_out;
    p.mods = (float*)(b + w.mods); p.cosT = (float*)(b + w.cosT); p.sinT = (float*)(b + w.sinT); p.cs = (float*)(b + w.cs);
    p.h = (bf16*)(b + w.h); p.P = (bf16*)(b + w.P); p.gq = (bf16*)(b + w.gq); p.gg = (float*)(b + w.gg); p.gbeta = (float*)(b + w.gbeta);
    p.fcs = (bf16*)(b + w.fcs); p.cU = (bf16*)(b + w.cU); p.cW = (bf16*)(b + w.cW); p.cQK = (bf16*)(b + w.cQK); p.cG = (float*)(b + w.cG);
    p.odir = (bf16*)(b + w.odir); p.br = (bf16*)(b + w.br); p.mg = (bf16*)(b + w.mg); p.sel_e = (int*)(b + w.sel_e);
    p.sel_w = (float*)(b + w.sel_w); p.act = (bf16*)(b + w.act); p.Y = (bf16*)(b + w.Y);
    p.wt_in = (bf16*)(b + w.wt_in); p.wt_br = (bf16*)(b + w.wt_br); p.wt_out = (bf16*)(b + w.wt_out); p.wt_gu = (bf16*)(b + w.wt_gu);
    p.fa2 = (bf16*)(b + w.fa2); p.fW1 = (bf16*)(b + w.fW1); p.fWA = (bf16*)(b + w.fWA); p.fWB = (bf16*)(b + w.fWB);
    p.bar = (unsigned*)(b + w.bar); p.ropeT = (float*)(b + w.ropeT); p.fWC = (bf16*)(b + w.fWC); p.fXC = (bf16*)(b + w.fXC);
    p.wt_d = (bf16*)(b + w.wt_d); p.cnt = (int*)(b + w.cnt); p.elist = (int*)(b + w.elist); p.apos = (int*)(b + w.apos);
}

#if !defined(CPU_EMU) && defined(PHASE_KERNELS)
#define PK(n) __global__ void __launch_bounds__(256, 2) pk_##n(Params p) { __shared__ __attribute__((aligned(16))) float sm[SMEM_FLOATS]; run_phase(p, n, p.layer, blockIdx.x, gridDim.x, sm); }
PK(0) PK(1) PK(2) PK(3) PK(4) PK(5) PK(6) PK(7) PK(8) PK(9) PK(10) PK(11) PK(12) PK(13) PK(14)
__global__ void __launch_bounds__(256, 2) pk_init(Params p) { __shared__ __attribute__((aligned(16))) float sm[SMEM_FLOATS]; ph_init(p, blockIdx.x, gridDim.x, sm); }
#endif
#ifndef CPU_EMU

#define XB_TMO      128
#define XB_XCNT(j)  (256  + 64 * (j))
#define XB_XSUB(j)  (1280 + 64 * (j))
#define XB_XGEN(j)  (2304 + 64 * (j))
#define XB_TOP      3328
#define XB_TOPGEN   3392
#define XCD_BAR_WORDS 3456
#define XB_SPIN_CAP (1u << 22)
#define LAS __attribute__((address_space(3)))
__device__ __forceinline__ unsigned xb_ld(unsigned* p)              { return __hip_atomic_load(p, __ATOMIC_RELAXED, __HIP_MEMORY_SCOPE_AGENT); }
__device__ __forceinline__ unsigned xb_add(unsigned* p, unsigned v) { return __hip_atomic_fetch_add(p, v, __ATOMIC_RELAXED, __HIP_MEMORY_SCOPE_AGENT); }
__device__ __forceinline__ unsigned xb_xcc_id() { return (unsigned)__builtin_amdgcn_s_getreg((3 << 11) | 20) & 0xFu; }
#define XB_SPIN(cond, bar) do { unsigned _sp = 0; while (cond) { __builtin_amdgcn_s_sleep(1); \
    if ((++_sp & 255u) == 0u) { if (xb_ld(&(bar)[XB_TMO])) break; if (_sp > XB_SPIN_CAP) { atomicAdd(&(bar)[XB_TMO], 1u); break; } } } } while (0)
struct XcdBarrier { unsigned* bar; unsigned x; volatile LAS unsigned* st; };
__device__ __forceinline__ XcdBarrier xcd_barrier_post(unsigned* bar, volatile LAS unsigned* st) {
    XcdBarrier b; b.bar = bar; b.x = xb_xcc_id(); b.st = st;
    if (threadIdx.x == 0) (void)xb_add(&bar[XB_XCNT(b.x)], 1u);
    return b;
}
__device__ __forceinline__ void xcd_barrier_complete(unsigned* bar, unsigned x, unsigned& nloc, unsigned& nx) {
    const unsigned G = gridDim.x * gridDim.y * gridDim.z;
    unsigned sum, cnt, mine, sp = 0u;
    for (;;) {
        sum = 0u; cnt = 0u; mine = 0u;
#pragma unroll
        for (unsigned j = 0; j < 16; ++j) { const unsigned c = xb_ld(&bar[XB_XCNT(j)]); sum += c; cnt += (c > 0u) ? 1u : 0u; mine = (j == x) ? c : mine; }
        if (sum == G) break;
        __builtin_amdgcn_s_sleep(1);
        if ((++sp & 255u) == 0u) { if (xb_ld(&bar[XB_TMO])) break; if (sp > XB_SPIN_CAP) { atomicAdd(&bar[XB_TMO], 1u); break; } }
    }
    nloc = mine > 0u ? mine : 1u; nx = cnt > 0u ? cnt : 1u;
}
__device__ __forceinline__ void xcd_barrier(const XcdBarrier& b) {
    asm volatile("s_waitcnt vmcnt(0)" ::: "memory");
    __syncthreads();
    if (threadIdx.x == 0) {
        unsigned* bar = b.bar;
        __builtin_amdgcn_s_waitcnt(0);
        unsigned nloc = b.st[0], nx = b.st[1];
        if (nloc == 0u) { xcd_barrier_complete(bar, b.x, nloc, nx); b.st[0] = nloc; b.st[1] = nx; }
        const unsigned old = xb_add(&bar[XB_XSUB(b.x)], 1u);
        const unsigned gen = old / nloc;
        if (old + 1u == (gen + 1u) * nloc) {
            __builtin_amdgcn_fence(__ATOMIC_RELEASE, "agent");
            asm volatile("s_waitcnt vmcnt(0)" ::: "memory");
            const unsigned og = xb_add(&bar[XB_TOP], 1u);
            const unsigned tg = og / nx;
            if (og + 1u == (tg + 1u) * nx) xb_add(&bar[XB_TOPGEN], 1u);
            else XB_SPIN(xb_ld(&bar[XB_TOPGEN]) == tg, bar);
            __builtin_amdgcn_fence(__ATOMIC_ACQUIRE, "agent");
            xb_add(&bar[XB_XGEN(b.x)], 1u);
            asm volatile("s_waitcnt vmcnt(0)" ::: "memory");
        } else {
            XB_SPIN(xb_ld(&bar[XB_XGEN(b.x)]) == gen, bar);
            __builtin_amdgcn_fence(__ATOMIC_ACQUIRE, "agent");
            asm volatile("s_waitcnt vmcnt(0)" ::: "memory");
        }
    }
    __syncthreads();
}

__global__ void __launch_bounds__(256, 2) fwd_megakernel(Params p) {
    __shared__ __attribute__((aligned(16))) float sm[SMEM_FLOATS];
    cg::grid_group grid = cg::this_grid();
    const int bid = blockIdx.x, nb = gridDim.x;
    volatile LAS unsigned* xst = (volatile LAS unsigned*)(sm + SMEM_FLOATS - 4);
    if (threadIdx.x == 0) { xst[0] = 0u; xst[1] = 0u; }
    __syncthreads();
    XcdBarrier xb = xcd_barrier_post(p.bar, xst);
    ph_init(p, bid, nb, sm);
    xcd_barrier(xb);
#ifdef PROBE_INIT
    ph_init(p, bid, nb, sm); xcd_barrier(xb); ph_init(p, bid, nb, sm); xcd_barrier(xb);
#endif
#define PH(n, l) run_phase(p, n, l, bid, nb, sm); xcd_barrier(xb);
#define PHN(n, l) run_phase(p, n, l, bid, nb, sm);
#ifndef PROBE_X
#define PROBE_X(n, l)
#endif
#define LAYER(l) PH(0, l) PROBE_X(0, l) PH(1, l) PROBE_X(1, l) PH(2, l) PROBE_X(2, l) PHN(4, l) PHN(6, l) PH(5, l) PROBE_X(4, l) PROBE_X(5, l) PROBE_X(3, l) PROBE_X(6, l) \
    PH(7, l) PROBE_X(7, l) PROBE_X(70, l) PROBE_X(71, l) PH(8, l) PROBE_X(8, l) PH(9, l) PROBE_X(9, l) PH(10, l) PH(11, l) PH(12, l) PROBE_X(12, l) \
    PH(13, l) PROBE_X(13, l) PH(14, l)
    LAYER(0)
#undef LAYER
#define LAYER(l) PH(1, l) PROBE_X(1, l) PH(2, l) PROBE_X(2, l) PHN(4, l) PHN(6, l) PH(5, l) PROBE_X(4, l) PROBE_X(5, l) PROBE_X(3, l) PROBE_X(6, l) \
    PH(7, l) PROBE_X(7, l) PROBE_X(70, l) PROBE_X(71, l) PH(8, l) PROBE_X(8, l) PH(9, l) PROBE_X(9, l) PH(10, l) PROBE_X(110, l) PH(11, l) PROBE_X(111, l) PH(12, l) PROBE_X(12, l) \
    PH(13, l) PROBE_X(13, l) PH(14, l) PROBE_X(114, l)
    LAYER(1)
}

extern "C" void kernel_launch(void* const* d_in, const int* in_sizes, int n_in, void* d_out, int out_size,
                              void* d_ws, size_t ws_size, hipStream_t stream) {
    WsLayout w = ws_layout();
    if (ws_size < w.total) { fprintf(stderr, "ws too small: need %zu have %zu\n", w.total, ws_size); return; }
    static int grid_blocks = 0;
    if (!grid_blocks) {
        int dev = 0, cus = 0, per_cu = 0;
        (void)hipGetDevice(&dev);
        (void)hipDeviceGetAttribute(&cus, hipDeviceAttributeMultiprocessorCount, dev);
        (void)hipOccupancyMaxActiveBlocksPerMultiprocessor(&per_cu, fwd_megakernel, 256, 0);
        if (per_cu < 1) per_cu = 1;
        grid_blocks = cus * per_cu;
    }
    Params p{};
    fill_params(p, d_in, d_out, d_ws);
    (void)hipMemsetAsync(p.bar, 0, XCD_BAR_WORDS * 4, stream);
    void* args[] = {&p};
    hipError_t e = hipLaunchCooperativeKernel((void*)fwd_megakernel, dim3(grid_blocks), dim3(256), args, 0, stream);
    if (e != hipSuccess) fprintf(stderr, "cooperative launch failed: %s (grid %d)\n", hipGetErrorString(e), grid_blocks);
}
#endif
```

```cpp
#ifndef CPU_EMU
#include <hip/hip_runtime.h>
#include <hip/hip_cooperative_groups.h>
#include <cstdio>
namespace cg = cooperative_groups;
#define HD __device__ __forceinline__
__device__ __forceinline__ int tid_() { int v = threadIdx.x; asm volatile("" : "+v"(v)); return v; }
#define THREADS(t, n) for (int t = tid_(); t < (n); t += 256)
#define SYNC __syncthreads();
#define COSPI(x) cospif(x)
#define SINPI(x) sinpif(x)
typedef float4 f4;
#else
#include <cmath>
#include <cstdio>
#include <cstring>
#include <cstddef>
#define HD inline
#define THREADS(t, n) for (int t = 0; t < (n); ++t)
#define SYNC
#define COSPI(x) ((float)cos(M_PI * (double)(x)))
#define SINPI(x) ((float)sin(M_PI * (double)(x)))
struct f4 { float x, y, z, w; };
#endif

#ifndef SEQ
#define SEQ 8192
#endif
#ifndef CTXL
#define CTXL 256
#endif

typedef unsigned short bf16;
#ifndef CPU_EMU
typedef __attribute__((ext_vector_type(8))) short bf16x8_t;
typedef __attribute__((ext_vector_type(4))) float f32x4_t;
typedef __attribute__((ext_vector_type(4))) int i32x4_t;
#define ATOMIC_ADD_RET(ptr, v) atomicAdd((ptr), (v))
#else
HD int atomic_add_ret_(int* p, int v) { int old;
#pragma omp atomic capture
    { old = *p; *p += v; }
    return old; }
#define ATOMIC_ADD_RET(ptr, v) atomic_add_ret_((ptr), (v))
#endif
constexpr int NB = 2, D = 1024, GW = 64, ROWS = SEQ / GW;
constexpr int NLAT = NB * SEQ, NCTX = NB * CTXL, R = NLAT + NCTX;
constexpr int DIN = 6928;
constexpr int PLD = 2816;
constexpr int C_NAQ = 0, C_NAK = 256, C_NAV = 512, C_DAQ = 768, C_DAK = 1024, C_DAV = 1280, C_GQ = 1536, C_Z = 2304,
              C_F = 2560;
constexpr int WIN_N = 6912;
constexpr int WIN_NP = WIN_N + 64;
constexpr int PADROWS = 2 * R + 16 * 128;
constexpr int NCC = CTXL / 64, NCL = SEQ / 64, NCH = NCC + NCL;
constexpr int NUNIT = 2 * NB * 4 * NCH;
constexpr bool FOURIER_GEMM = (SEQ == 8192);
constexpr int SMEM_FLOATS = 73 * 256 + 4;

struct Params {
    const float* in[30];
    float* out;
    float* mods;
    float* cosT;
    float* sinT;
    float* cs;
    bf16* h;
    bf16* P;
    bf16* gq;
    float* gg;
    float* gbeta;
    bf16* fcs;
    bf16* cU;
    bf16* cW;
    bf16* cQK;
    float* cG;
    bf16* odir;
    bf16* br;
    bf16* mg;
    int* sel_e;
    float* sel_w;
    bf16* act;
    bf16* Y;
    bf16* wt_in;
    bf16* wt_br;
    bf16* wt_out;
    bf16* wt_gu;
    bf16* wt_d;
    int* cnt;
    unsigned* bar;
    bf16* fa2;
    bf16* fW1;
    float* ropeT;
    bf16* fWA;
    bf16* fWB;
    bf16* fWC;
    bf16* fXC;
    int* elist;
    int* apos;
    int phase;
    int layer;
};

enum { I_X = 0, I_C, I_CTX, I_CCTX, I_WMOD, I_BMOD, I_N1G, I_N2G, I_WIN, I_NAQG, I_NAKG, I_RPB, I_DAQG, I_DAKG, I_LQ1, I_LK1,
       I_LQ2, I_LK2, I_SUBLN, I_CONVW, I_ALOG, I_DTB, I_ONORM, I_WBR, I_WOUT, I_WROUTER, I_RBIAS, I_MG, I_MU, I_MD };

HD float bf2f(bf16 v) { union { unsigned u; float f; } x; x.u = ((unsigned)v) << 16; return x.f; }
#ifndef CPU_EMU
typedef float f32x2_t __attribute__((ext_vector_type(2))); typedef __bf16 bf16x2_t __attribute__((ext_vector_type(2)));
typedef short s16x4_t __attribute__((ext_vector_type(4)));
typedef __attribute__((address_space(3))) const char* lds_cptr;
HD unsigned cvtpk(float lo, float hi) { f32x2_t v = {lo, hi}; bf16x2_t b = __builtin_convertvector(v, bf16x2_t); return __builtin_bit_cast(unsigned, b); }
HD bf16 f2bf(float f) { return (bf16)(cvtpk(f, 0.f) & 0xffffu); }
HD s16x4_t lds_tr16(lds_cptr p) { return __builtin_bit_cast(s16x4_t, __builtin_amdgcn_ds_read_tr16_b64_v4i16((__attribute__((address_space(3))) s16x4_t*)p)); }
#else
HD bf16 f2bf(float f) { union { unsigned u; float f; } x; x.f = f; unsigned u = x.u; u += 0x7fffu + ((u >> 16) & 1u); return (bf16)(u >> 16); }
#endif
HD float sigmoidf_(float x) { return 1.0f / (1.0f + expf(-x)); }
HD float siluf_(float x) { return x / (1.0f + expf(-x)); }

struct RowInfo { int seg, b, t, T, base; };
HD RowInfo rowinfo(int r) {
    RowInfo q;
    if (r < NLAT) { q.seg = 0; q.b = r / SEQ; q.t = r % SEQ; q.T = SEQ; q.base = q.b * SEQ; }
    else { int r2 = r - NLAT; q.seg = 1; q.b = r2 / CTXL; q.t = r2 % CTXL; q.T = CTXL; q.base = NLAT + q.b * CTXL; }
    return q;
}
HD const float* xrow_in(const Params& p, int l, int r) {
    if (r < NLAT) return (l == 0 ? p.in[I_X] : p.out) + (size_t)r * D;
    return p.cs + (size_t)(r - NLAT) * D;
}
HD float* xrow_out(const Params& p, int r) {
    if (r < NLAT) return p.out + (size_t)r * D;
    return p.cs + (size_t)(r - NLAT) * D;
}
HD const float* modrow(const Params& p, int l, int r) {
    int s = (r < NLAT) ? (r / SEQ) : 2;
    return p.mods + (size_t)(l * 3 + s) * 6144;
}
#ifndef CPU_EMU
HD unsigned char* gu8_of(const Params& p) { return (unsigned char*)p.wt_gu; }
HD unsigned char* d8_of(const Params& p) { return (unsigned char*)p.wt_gu + (size_t)16 * 1024 * 1024; }
HD unsigned char* h8_of(const Params& p) { return (unsigned char*)p.wt_gu + (size_t)16 * 1024 * 1024 + (size_t)16 * 1024 * 512; }
#endif
HD float lam_init_of(int l) { return l == 0 ? 0.2f : (0.8f - 0.6f * 0.7408182206817179f); }


#ifndef CPU_EMU
template <int NJ> struct AccT { f32x4_t v[4][NJ]; };
#define ACC_DECL(NJ, a) AccT<NJ> a
template <int NJ> HD void acc_zero(AccT<NJ>& a) {
#pragma unroll
    for (int i = 0; i < 4; ++i)
#pragma unroll
        for (int j = 0; j < NJ; ++j) a.v[i][j] = f32x4_t{0.f, 0.f, 0.f, 0.f};
}
#define ACC_FOR(NJ, row, col) { const int _t = tid_(); const int _ln = _t & 63, _w = _t >> 6; \
    _Pragma("unroll") for (int _i = 0; _i < 4; ++_i) _Pragma("unroll") for (int _j = 0; _j < NJ; ++_j) _Pragma("unroll") for (int _r = 0; _r < 4; ++_r) { \
    const int row = (_w >> 1) * 64 + _i * 16 + (_ln >> 4) * 4 + _r; const int col = (_w & 1) * (16 * NJ) + _j * 16 + (_ln & 15);
#define AV(a) a.v[_i][_j][_r]
#define ACC_END }}
#define ACC_FOR_PAIR(row, pcol) { const int _t = tid_(); const int _ln = _t & 63, _w = _t >> 6; \
    _Pragma("unroll") for (int _i = 0; _i < 4; ++_i) _Pragma("unroll") for (int _jj = 0; _jj < 2; ++_jj) _Pragma("unroll") for (int _r = 0; _r < 4; ++_r) { \
    const int row = (_w >> 1) * 64 + _i * 16 + (_ln >> 4) * 4 + _r; const int pcol = (_w & 1) * 32 + _jj * 16 + (_ln & 15);
#define AV_G(a) a.v[_i][2 * _jj][_r]
#define AV_U(a) a.v[_i][2 * _jj + 1][_r]

#define WAIT_VM0() asm volatile("s_waitcnt vmcnt(0)" ::: "memory")
#define GLDS16(gp, lp) __builtin_amdgcn_global_load_lds((const unsigned*)(gp), (unsigned*)(lp), 16, 0, 0)
template <int NJ, class AF, class BF>
HD void gemm_accum(AccT<NJ>& acc, AF arow, BF brow, int K, char* smem) {
    constexpr int NBL = NJ;
    const int t = tid_(), lane = t & 63, w = t >> 6, wr = w >> 1, wc = w & 1;
    const int lr = t >> 3, lc = t & 7;
    const bf16* ap[4]; const bf16* bp[NBL];
#pragma unroll
    for (int i = 0; i < 4; ++i) ap[i] = arow(lr + 32 * i) + ((lc ^ (lr & 7)) << 3);
#pragma unroll
    for (int i = 0; i < NBL; ++i) bp[i] = brow(lr + 32 * i) + ((lc ^ (lr & 7)) << 3);
    char* sA = smem + w * 1024; char* sB = smem + 32768 + w * 1024;
    const int fr = lane & 15, fg = lane >> 4;
    const unsigned aoff0 = (wr * 64 + fr) * 128 + (((fg) ^ (fr & 7)) << 4);
    const unsigned aoff1 = (wr * 64 + fr) * 128 + (((4 + fg) ^ (fr & 7)) << 4);
    const unsigned boff0 = (wc * (16 * NJ) + fr) * 128 + (((fg) ^ (fr & 7)) << 4);
    const unsigned boff1 = (wc * (16 * NJ) + fr) * 128 + (((4 + fg) ^ (fr & 7)) << 4);
    const int KT = K >> 6;
    __syncthreads();
#pragma unroll
    for (int i = 0; i < 4; ++i) GLDS16(ap[i], sA + 4096 * i);
#pragma unroll
    for (int i = 0; i < NBL; ++i) GLDS16(bp[i], sB + 4096 * i);
    WAIT_VM0();
    __syncthreads();
#pragma unroll 1
    for (int kt = 0; kt < KT; ++kt) {
        const int cur = kt & 1;
        if (kt + 1 < KT) {
#pragma unroll
            for (int i = 0; i < 4; ++i) GLDS16(ap[i] + (kt + 1) * 64, sA + (cur ^ 1) * 16384 + 4096 * i);
#pragma unroll
            for (int i = 0; i < NBL; ++i) GLDS16(bp[i] + (kt + 1) * 64, sB + (cur ^ 1) * 16384 + 4096 * i);
        }
        const char* cA = smem + cur * 16384; const char* cB = smem + 32768 + cur * 16384;
#pragma unroll
        for (int s = 0; s < 2; ++s) {
            bf16x8_t af[4], bfr[NJ];
#pragma unroll
            for (int i = 0; i < 4; ++i) af[i] = *(const bf16x8_t*)(cA + (s ? aoff1 : aoff0) + i * 2048);
#pragma unroll
            for (int j = 0; j < NJ; ++j) bfr[j] = *(const bf16x8_t*)(cB + (s ? boff1 : boff0) + j * 2048);
#pragma unroll
            for (int i = 0; i < 4; ++i)
#pragma unroll
                for (int j = 0; j < NJ; ++j) acc.v[i][j] = __builtin_amdgcn_mfma_f32_16x16x32_bf16(af[i], bfr[j], acc.v[i][j], 0, 0, 0);
        }
        WAIT_VM0();
        __syncthreads();
    }
}
template <int NJ> HD void acc_to_lds(const AccT<NJ>& acc, float* tl) {
    const int t = tid_(), lane = t & 63, w = t >> 6;
    constexpr int LD = 32 * NJ + 4;
    float* base = tl + ((w >> 1) * 64 + (lane >> 4) * 4) * LD + (w & 1) * (16 * NJ) + (lane & 15);
#pragma unroll
    for (int i = 0; i < 4; ++i)
#pragma unroll
        for (int j = 0; j < NJ; ++j)
#pragma unroll
            for (int r = 0; r < 4; ++r) base[(i * 16 + r) * LD + j * 16] = acc.v[i][j][r];
}
typedef int i32x8_t __attribute__((ext_vector_type(8)));
typedef unsigned char u8;
template <int NJ, class AF, class BF>
HD void gemm_accum8(AccT<NJ>& acc, AF arow, BF brow, int K, char* smem, int sa, int sb) {
    constexpr int NBL = NJ;
    const int t = tid_(), lane = t & 63, w = t >> 6, wr = w >> 1, wc = w & 1;
    const int lr = t >> 3, lc = t & 7;
    const u8* ap[4]; const u8* bp[NBL];
#pragma unroll
    for (int i = 0; i < 4; ++i) ap[i] = arow(lr + 32 * i) + ((lc ^ (lr & 7)) << 4);
#pragma unroll
    for (int i = 0; i < NBL; ++i) bp[i] = brow(lr + 32 * i) + ((lc ^ (lr & 7)) << 4);
    char* sA = smem + w * 1024; char* sB = smem + 32768 + w * 1024;
    const int fr = lane & 15, fg = lane >> 4;
    const unsigned aoff0 = (wr * 64 + fr) * 128 + (((2 * fg) ^ (fr & 7)) << 4);
    const unsigned aoff1 = (wr * 64 + fr) * 128 + (((2 * fg + 1) ^ (fr & 7)) << 4);
    const unsigned boff0 = (wc * (16 * NJ) + fr) * 128 + (((2 * fg) ^ (fr & 7)) << 4);
    const unsigned boff1 = (wc * (16 * NJ) + fr) * 128 + (((2 * fg + 1) ^ (fr & 7)) << 4);
    const int KT = K >> 7;
    __syncthreads();
#pragma unroll
    for (int i = 0; i < 4; ++i) GLDS16(ap[i], sA + 4096 * i);
#pragma unroll
    for (int i = 0; i < NBL; ++i) GLDS16(bp[i], sB + 4096 * i);
    WAIT_VM0();
    __syncthreads();
#pragma unroll 1
    for (int kt = 0; kt < KT; ++kt) {
        const int cur = kt & 1;
        if (kt + 1 < KT) {
#pragma unroll
            for (int i = 0; i < 4; ++i) GLDS16(ap[i] + (kt + 1) * 128, sA + (cur ^ 1) * 16384 + 4096 * i);
#pragma unroll
            for (int i = 0; i < NBL; ++i) GLDS16(bp[i] + (kt + 1) * 128, sB + (cur ^ 1) * 16384 + 4096 * i);
        }
        const char* cA = smem + cur * 16384; const char* cB = smem + 32768 + cur * 16384;
        i32x8_t af[4], bfr[NJ];
#pragma unroll
        for (int i = 0; i < 4; ++i) {
            const i32x4_t lo = *(const i32x4_t*)(cA + aoff0 + i * 2048), hi = *(const i32x4_t*)(cA + aoff1 + i * 2048);
            af[i] = i32x8_t{lo[0], lo[1], lo[2], lo[3], hi[0], hi[1], hi[2], hi[3]};
        }
#pragma unroll
        for (int j = 0; j < NJ; ++j) {
            const i32x4_t lo = *(const i32x4_t*)(cB + boff0 + j * 2048), hi = *(const i32x4_t*)(cB + boff1 + j * 2048);
            bfr[j] = i32x8_t{lo[0], lo[1], lo[2], lo[3], hi[0], hi[1], hi[2], hi[3]};
        }
#pragma unroll
        for (int i = 0; i < 4; ++i)
#pragma unroll
            for (int j = 0; j < NJ; ++j) acc.v[i][j] = __builtin_amdgcn_mfma_scale_f32_16x16x128_f8f6f4(af[i], bfr[j], acc.v[i][j], 0, 0, 0, sa, 0, sb);
        WAIT_VM0();
        __syncthreads();
    }
}
HD unsigned pack_fp8x4(float a, float b, float c, float d) {
    a = __builtin_amdgcn_fmed3f(a, -448.f, 448.f); b = __builtin_amdgcn_fmed3f(b, -448.f, 448.f);
    c = __builtin_amdgcn_fmed3f(c, -448.f, 448.f); d = __builtin_amdgcn_fmed3f(d, -448.f, 448.f);
    int w = 0;
    w = __builtin_amdgcn_cvt_pk_fp8_f32(a, b, w, false);
    w = __builtin_amdgcn_cvt_pk_fp8_f32(c, d, w, true);
    return (unsigned)w;
}
constexpr int SC_H = 0x7d7d7d7d;
constexpr int SC_W = 0x7a7a7a7a;
constexpr int SC_ACT = 0x7b7b7b7b;
template <int NJ, class AF, class BF>
HD void gemm_stage0(AF arow, BF brow, int ebytes, char* smem, int buf) {
    const int t = tid_(), w = t >> 6, lr = t >> 3, lc = t & 7;
    char* sA = smem + w * 1024 + buf * 16384; char* sB = smem + 32768 + w * 1024 + buf * 16384;
    (void)ebytes;
#pragma unroll
    for (int i = 0; i < 4; ++i) GLDS16((const char*)arow(lr + 32 * i) + ((lc ^ (lr & 7)) << 4), sA + 4096 * i);
#pragma unroll
    for (int i = 0; i < NJ; ++i) GLDS16((const char*)brow(lr + 32 * i) + ((lc ^ (lr & 7)) << 4), sB + 4096 * i);
}
template <int NJ, bool FP8, class AF, class BF, class NF>
HD void gemm_chain(AccT<NJ>& acc, AF arow, BF brow, int K, char* smem, int& cur, NF next_stage, int sa, int sb) {
    const int t = tid_(), lane = t & 63, w = t >> 6, wr = w >> 1, wc = w & 1;
    const int lr = t >> 3, lc = t & 7;
    const char* ap[4]; const char* bp[NJ];
#pragma unroll
    for (int i = 0; i < 4; ++i) ap[i] = (const char*)arow(lr + 32 * i) + ((lc ^ (lr & 7)) << 4);
#pragma unroll
    for (int i = 0; i < NJ; ++i) bp[i] = (const char*)brow(lr + 32 * i) + ((lc ^ (lr & 7)) << 4);
    char* sA = smem + w * 1024; char* sB = smem + 32768 + w * 1024;
    const int fr = lane & 15, fg = lane >> 4;
    const unsigned rA = (wr * 64 + fr) * 128, rB = (wc * (16 * NJ) + fr) * 128;
    const int KT = K >> (FP8 ? 7 : 6);
#pragma unroll 1
    for (int kt = 0; kt < KT; ++kt) {
        WAIT_VM0();
        __syncthreads();
        if (kt + 1 < KT) {
#pragma unroll
            for (int i = 0; i < 4; ++i) GLDS16(ap[i] + (kt + 1) * 128, sA + (cur ^ 1) * 16384 + 4096 * i);
#pragma unroll
            for (int i = 0; i < NJ; ++i) GLDS16(bp[i] + (kt + 1) * 128, sB + (cur ^ 1) * 16384 + 4096 * i);
        } else next_stage(cur ^ 1);
        const char* cA = smem + cur * 16384; const char* cB = smem + 32768 + cur * 16384;
        if (FP8) {
            i32x8_t af[4], bfr[NJ];
#pragma unroll
            for (int i = 0; i < 4; ++i) {
                const i32x4_t lo = *(const i32x4_t*)(cA + rA + (((2 * fg) ^ (fr & 7)) << 4) + i * 2048), hi = *(const i32x4_t*)(cA + rA + (((2 * fg + 1) ^ (fr & 7)) << 4) + i * 2048);
                af[i] = i32x8_t{lo[0], lo[1], lo[2], lo[3], hi[0], hi[1], hi[2], hi[3]};
            }
#pragma unroll
            for (int j = 0; j < NJ; ++j) {
                const i32x4_t lo = *(const i32x4_t*)(cB + rB + (((2 * fg) ^ (fr & 7)) << 4) + j * 2048), hi = *(const i32x4_t*)(cB + rB + (((2 * fg + 1) ^ (fr & 7)) << 4) + j * 2048);
                bfr[j] = i32x8_t{lo[0], lo[1], lo[2], lo[3], hi[0], hi[1], hi[2], hi[3]};
            }
#pragma unroll
            for (int i = 0; i < 4; ++i)
#pragma unroll
                for (int j = 0; j < NJ; ++j) acc.v[i][j] = __builtin_amdgcn_mfma_scale_f32_16x16x128_f8f6f4(af[i], bfr[j], acc.v[i][j], 0, 0, 0, sa, 0, sb);
        } else {
#pragma unroll
            for (int s_ = 0; s_ < 2; ++s_) {
                bf16x8_t af[4], bfr[NJ];
#pragma unroll
                for (int i = 0; i < 4; ++i) af[i] = *(const bf16x8_t*)(cA + rA + (((4 * s_ + fg) ^ (fr & 7)) << 4) + i * 2048);
#pragma unroll
                for (int j = 0; j < NJ; ++j) bfr[j] = *(const bf16x8_t*)(cB + rB + (((4 * s_ + fg) ^ (fr & 7)) << 4) + j * 2048);
#pragma unroll
                for (int i = 0; i < 4; ++i)
#pragma unroll
                    for (int j = 0; j < NJ; ++j) acc.v[i][j] = __builtin_amdgcn_mfma_f32_16x16x32_bf16(af[i], bfr[j], acc.v[i][j], 0, 0, 0);
            }
        }
        cur ^= 1;
    }
}
#else
template <int NJ> struct AccT { float v[128][32 * NJ]; };
#define ACC_DECL(NJ, a) static thread_local AccT<NJ> a
template <int NJ> HD void acc_zero(AccT<NJ>& a) { memset(a.v, 0, sizeof(a.v)); }
#define ACC_FOR(NJ, row, col) { for (int row = 0; row < 128; ++row) for (int col = 0; col < 32 * NJ; ++col) {
#define AV(a) a.v[row][col]
#define ACC_END }}
#define ACC_FOR_PAIR(row, pcol) { for (int row = 0; row < 128; ++row) for (int pcol = 0; pcol < 64; ++pcol) {
#define AV_G(a) a.v[row][(pcol / 16) * 32 + (pcol % 16)]
#define AV_U(a) a.v[row][(pcol / 16) * 32 + 16 + (pcol % 16)]
template <int NJ, class AF, class BF>
HD void gemm_accum(AccT<NJ>& acc, AF arow, BF brow, int K, char* smem) {
    for (int i = 0; i < 128; ++i) { const bf16* a = arow(i);
        for (int j = 0; j < 32 * NJ; ++j) { const bf16* b = brow(j); float s = 0.f;
            for (int k = 0; k < K; ++k) s += bf2f(a[k]) * bf2f(b[k]);
            acc.v[i][j] += s; } }
}
#endif

template <class DF>
HD void conv_tile(const float* src, size_t lds_, bf16* dst, size_t ldd, int k0, int nsrc0, DF drow, float* sm) {
    THREADS(t, 4096) { int kk = t >> 6, nn = t & 63; sm[kk * 65 + nn] = src[(size_t)(k0 + kk) * lds_ + nsrc0 + nn]; }
    SYNC
    THREADS(t, 4096) { int nn = t >> 6, kk = t & 63; dst[(size_t)drow(nn) * ldd + k0 + kk] = f2bf(sm[kk * 65 + nn]); }
    SYNC
}
#ifndef CPU_EMU
template <class DF>
HD void conv_tile8(const float* src, size_t lds_, unsigned char* dst, size_t ldd, int k0, int nsrc0, DF drow, float scale, float* sm) {
    THREADS(t, 4096) { int kk = t >> 6, nn = t & 63; sm[kk * 65 + nn] = src[(size_t)(k0 + kk) * lds_ + nsrc0 + nn] * scale; }
    SYNC
    THREADS(t, 1024) { int nn = t >> 4, k4 = (t & 15) * 4;
        *(unsigned*)(dst + (size_t)drow(nn) * ldd + k0 + k4) = pack_fp8x4(sm[k4 * 65 + nn], sm[(k4 + 1) * 65 + nn], sm[(k4 + 2) * 65 + nn], sm[(k4 + 3) * 65 + nn]); }
    SYNC
}
HD void convert_moe(const Params& p, int l, int bid, int nb, float* sm) {
    for (int w = bid; w < 4096 + 2048; w += nb) {
        if (w < 4096) {
            int nt = w & 7, kt = (w >> 3) & 15, gu = (w >> 7) & 1, e = w >> 8;
            const float* src = p.in[gu ? I_MU : I_MG] + (size_t)(l * 16 + e) * D * 512;
            conv_tile8(src, 512, gu8_of(p) + (size_t)e * 1024 * D, D, kt * 64, nt * 64, [&](int nn) { int j = nt * 64 + nn; return (j >> 4) * 32 + (j & 15) + 16 * gu; }, 32.0f, sm);
        } else {
            int w2 = w - 4096; int nt = w2 & 15, kt = (w2 >> 4) & 7, e = w2 >> 7;
            const float* src = p.in[I_MD] + (size_t)(l * 16 + e) * 512 * D;
            conv_tile8(src, D, d8_of(p) + (size_t)e * D * 512, 512, kt * 64, nt * 64, [&](int nn) { return nt * 64 + nn; }, 32.0f, sm);
        }
    }
}
#else
HD void convert_moe(const Params& p, int l, int bid, int nb, float* sm) {
    for (int w = bid; w < 4096 + 2048; w += nb) {
        if (w < 4096) {
            int nt = w & 7, kt = (w >> 3) & 15, gu = (w >> 7) & 1, e = w >> 8;
            const float* src = p.in[gu ? I_MU : I_MG] + (size_t)(l * 16 + e) * D * 512;
            bf16* dst = p.wt_gu + (size_t)e * 1024 * D;
            conv_tile(src, 512, dst, D, kt * 64, nt * 64, [&](int nn) { int j = nt * 64 + nn; return (j >> 4) * 32 + (j & 15) + 16 * gu; }, sm);
        } else {
            int w2 = w - 4096; int nt = w2 & 15, kt = (w2 >> 4) & 7, e = w2 >> 7;
            const float* src = p.in[I_MD] + (size_t)(l * 16 + e) * 512 * D;
            bf16* dst = p.wt_d + (size_t)e * D * 512;
            conv_tile(src, D, dst, 512, kt * 64, nt * 64, [&](int nn) { return nt * 64 + nn; }, sm);
        }
    }
}
#endif
HD void convert_static(const Params& p, int bid, int nb, float* sm, int part) {
    for (int w = bid; w < 3456 + 512 + 512 + 32; w += nb) {
        {
            const bool is_win = (w < 3456), is_ab = (w >= 3456 + 512 + 512);
            const int wl = is_win ? (w / (108 * 16)) : (is_ab ? ((w - 3456 - 512 - 512) >> 4) : 1);
            const bool early = (is_win || is_ab) && wl == 0;
            if ((part == 0) != early) continue;
        }
        if (w >= 3456 + 512 + 512) {
            int w2 = w - 3456 - 512 - 512; int kt = w2 & 15, l = w2 >> 4;
            conv_tile(p.in[I_WIN] + (size_t)l * D * DIN, DIN, p.wt_in + (size_t)l * WIN_NP * D, D, kt * 64, 2560, [&](int nn) { return WIN_N + nn; }, sm);
        } else if (w < 3456) {
            int nt = w % 108, kt = (w / 108) & 15, l = w / (108 * 16);
            int n0 = nt * 64;
#ifndef CPU_EMU
            if (n0 >= PLD) {
                conv_tile8(p.in[I_WIN] + (size_t)l * D * DIN, DIN, (unsigned char*)(p.wt_in + (size_t)l * WIN_NP * D + (size_t)PLD * D), D, kt * 64, n0 + 16,
                           [&](int nn) { return n0 - PLD + nn; }, 32.0f, sm);
                continue;
            }
#endif
            conv_tile(p.in[I_WIN] + (size_t)l * D * DIN, DIN, p.wt_in + (size_t)l * WIN_NP * D, D, kt * 64, n0 < 2560 ? n0 : n0 + 16,
                      [&](int nn) { return n0 + nn; }, sm);
        } else if (w < 3456 + 512) {
            int w2 = w - 3456; int nt = w2 & 15, kt = (w2 >> 4) & 3, li = w2 >> 6;
            conv_tile(p.in[I_WBR] + (size_t)li * 256 * D, D, p.wt_br + (size_t)li * D * 256, 256, kt * 64, nt * 64, [&](int nn) { return nt * 64 + nn; }, sm);
        } else {
            int w2 = w - 3456 - 512; int nt = w2 & 15, kt = (w2 >> 4) & 15, l = w2 >> 8;
            conv_tile(p.in[I_WOUT] + (size_t)l * D * D, D, p.wt_out + (size_t)l * D * D, D, kt * 64, nt * 64, [&](int nn) { return nt * 64 + nn; }, sm);
        }
    }
}

HD void init_tables(const Params& p, int bid, int nb) {
    for (int u = bid; u < (SEQ + 255) / 256; u += nb) {
        THREADS(t, 256) {
            int j = u * 256 + t;
            if (j < SEQ) { float a = 2.0f * (float)j / (float)SEQ; p.cosT[j] = COSPI(a); p.sinT[j] = SINPI(a); }
        }
    }
    if (bid == 0) {
        THREADS(t, 1024) {
            int pos = t >> 3, f = t & 7; float fr_ = 1.0f;
            for (int q = 0; q < f; ++q) fr_ *= 0.31622776601683794f;
            float ang = (float)pos * fr_;
            p.ropeT[t * 2] = cosf(ang); p.ropeT[t * 2 + 1] = sinf(ang);
        }
    }
    for (int u = bid; u < (CTXL * 2 * CTXL) / 256; u += nb) {
        THREADS(t, 256) {
            int i = u * 256 + t; int k = i / (2 * CTXL), q = i % (2 * CTXL); int cs = q / CTXL, tt = q % CTXL;
            float a = 2.0f * (float)((k * tt) % CTXL) / (float)CTXL;
            p.fWC[i] = f2bf(cs ? -SINPI(a) : COSPI(a));
        }
    }
    for (int u = bid; u < (8192 + 65536 + 8192) / 256; u += nb) {
        THREADS(t, 256) {
            int i = u * 256 + t;
            if (i < 8192) {
                int j = i >> 6, c = i & 63; int cs = j >> 6, m = j & 63;
                float a = 2.0f * (float)((m * c) & 63) / 64.0f;
                p.fW1[i] = f2bf(cs ? SINPI(a) : COSPI(a));
            } else if (i < 8192 + 65536) {
                int q = i - 8192; int n = q >> 8, k = q & 255;
                int ri = (n >> 4) & 1, k1 = (n >> 5) * 16 + (n & 15); int cs = k >> 7, t1 = k & 127;
                float a = 2.0f * (float)((k1 * t1) & 127) / 128.0f;
                float cv = COSPI(a), sv = SINPI(a);
                float v = (ri == 0) ? (cs == 0 ? cv : -sv) : (cs == 0 ? -sv : -cv);
                p.fWA[q] = f2bf(v);
            } else {
                int q = i - 8192 - 65536; int k2 = q >> 7, k = q & 127; int ri = k >> 6, t2 = k & 63;
                float a = 2.0f * (float)((k2 * t2) & 63) / 64.0f;
                p.fWB[q] = f2bf(ri ? SINPI(a) : COSPI(a));
            }
        }
    }
}

HD void ph_init(const Params& p, int bid, int nb, float* sm) {
    const int NMOD = 2 * 3 * 6144;
    if (bid == 0) { THREADS(t, 32) { p.cnt[t] = 0; } }
#ifndef CPU_EMU
    {
        const int tq = tid_(); const int col = tq & 63, ks = tq >> 6;
        for (int u = nb - 1 - bid; u < 2 * 96; u += nb) {
            const int l = u / 96, c0 = (u % 96) * 64;
            __syncthreads();
            for (int i = tq; i < 3 * D; i += 256) { const int s_ = i / D, k = i % D; const float cv = (s_ < 2) ? p.in[I_C][s_ * D + k] : p.in[I_CCTX][k]; sm[i] = siluf_(cv); }
            __syncthreads();
            const float* wp = p.in[I_WMOD] + (size_t)l * D * 6144 + (size_t)(ks * 256) * 6144 + c0 + col;
            float a0 = 0.f, a1 = 0.f, a2 = 0.f;
#pragma unroll 8
            for (int k = 0; k < 256; ++k) { const float wv = wp[(size_t)k * 6144]; a0 += sm[ks * 256 + k] * wv; a1 += sm[D + ks * 256 + k] * wv; a2 += sm[2 * D + ks * 256 + k] * wv; }
            float* red = sm + 3 * D;
            red[(ks * 3 + 0) * 64 + col] = a0; red[(ks * 3 + 1) * 64 + col] = a1; red[(ks * 3 + 2) * 64 + col] = a2;
            __syncthreads();
            if (tq < 192) {
                const int s_ = tq >> 6, cc = tq & 63;
                const float v = red[(0 * 3 + s_) * 64 + cc] + red[(1 * 3 + s_) * 64 + cc] + red[(2 * 3 + s_) * 64 + cc] + red[(3 * 3 + s_) * 64 + cc];
                p.mods[(size_t)(l * 3 + s_) * 6144 + c0 + cc] = v + p.in[I_BMOD][l * 6144 + c0 + cc];
            }
        }
    }
    convert_static(p, bid, nb, sm, 0);
#else
    convert_static(p, bid, nb, sm, 0);
    for (int u = bid; u < (NMOD + 255) / 256; u += nb) {
        THREADS(t, 256) {
            int idx = u * 256 + t;
            if (idx < NMOD) {
                int l = idx / (3 * 6144), s = (idx / 6144) % 3, col = idx % 6144;
                const float* cv = (s < 2) ? p.in[I_C] + s * D : p.in[I_CCTX];
                const float* w = p.in[I_WMOD] + (size_t)l * D * 6144 + col;
                float acc = 0.f;
                for (int k = 0; k < D; ++k) acc += siluf_(cv[k]) * w[(size_t)k * 6144];
                p.mods[idx] = acc + p.in[I_BMOD][l * 6144 + col];
            }
        }
    }
#endif
    init_tables(p, bid, nb);
    for (int u = bid; u < (NCTX * D) / 256; u += nb) {
        THREADS(t, 256) { int i = u * 256 + t; p.cs[i] = p.in[I_CTX][i]; }
    }

}

#ifndef CPU_EMU
HD float wave_sum(float v) {
#pragma unroll
    for (int o = 32; o >= 1; o >>= 1) v += __shfl_xor(v, o);
    return v;
}
HD void ph_norm1(const Params& p, int l, int bid, int nb, float* sm) {
    const int t = tid_(), lane = t & 63, w = t >> 6;
    const float* g = p.in[I_N1G] + l * D;
    for (int r = bid * 4 + w; r < R; r += nb * 4) {
        const float* x = xrow_in(p, l, r);
        const float* m = modrow(p, l, r);
        f32x4_t xv[4]; float ss = 0.f;
#pragma unroll
        for (int j = 0; j < 4; ++j) { xv[j] = *(const f32x4_t*)(x + j * 256 + lane * 4); ss += xv[j][0] * xv[j][0] + xv[j][1] * xv[j][1] + xv[j][2] * xv[j][2] + xv[j][3] * xv[j][3]; }
        ss = wave_sum(ss);
        const float rs = 1.0f / sqrtf(ss / D + 1e-6f);
#pragma unroll
        for (int j = 0; j < 4; ++j) {
            const int k = j * 256 + lane * 4;
            const f32x4_t gv = *(const f32x4_t*)(g + k), sc = *(const f32x4_t*)(m + 1024 + k), sh = *(const f32x4_t*)(m + k);
            float o[4];
#pragma unroll
            for (int q = 0; q < 4; ++q) o[q] = xv[j][q] * rs * gv[q] * (1.0f + sc[q]) + sh[q];
            uint2 pk; pk.x = cvtpk(o[0], o[1]); pk.y = cvtpk(o[2], o[3]);
            *(uint2*)(p.h + (size_t)r * D + k) = pk;
            *(unsigned*)(h8_of(p) + (size_t)r * D + k) = pack_fp8x4(o[0] * 4.f, o[1] * 4.f, o[2] * 4.f, o[3] * 4.f);
        }
    }
}
#else
HD void ph_norm1(const Params& p, int l, int bid, int nb, float* sm) {
    const float* g = p.in[I_N1G] + l * D;
    for (int r = bid; r < R; r += nb) {
        const float* x = xrow_in(p, l, r);
        const float* m = modrow(p, l, r);
        THREADS(t, 256) { float s = 0.f; for (int k = t; k < D; k += 256) s += x[k] * x[k]; sm[t] = s; }
        SYNC
        THREADS(t, 1) { float s = 0.f; for (int i = 0; i < 256; ++i) s += sm[i]; sm[256] = s; }
        SYNC
        THREADS(t, 256) {
            float rs = 1.0f / sqrtf(sm[256] / D + 1e-6f);
            for (int k = t; k < D; k += 256) {
                float v = x[k] * rs * g[k];
                p.h[(size_t)r * D + k] = f2bf(v * (1.0f + m[1024 + k]) + m[k]);
            }
        }
        SYNC
    }
}
#endif

HD void ph_inproj(const Params& p, int l, int bid, int nb, char* smc) {
    const bf16* Wt = p.wt_in + (size_t)l * WIN_NP * D;
    constexpr int NT = PLD / 128, MT = R / 128;
    for (int mt = bid; mt < MT; mt += nb) {
        ACC_DECL(2, acc); acc_zero(acc);
        gemm_accum<2>(acc, [&](int i) { return p.h + (size_t)(mt * 128 + i) * D; }, [&](int j) { return Wt + (size_t)(WIN_N + j) * D; }, D, smc);
        ACC_FOR(2, row, col) {
            const int r = mt * 128 + row;
            if (col < 8) {
                const float xx = AV(acc) + p.in[I_DTB][l * 8 + col];
                const float sp = xx > 20.f ? xx : log1pf(expf(xx));
                p.gg[(size_t)col * R + r] = -expf(p.in[I_ALOG][l * 8 + col]) * sp;
            } else if (col < 16) p.gbeta[(size_t)(col - 8) * R + r] = sigmoidf_(AV(acc));
        } ACC_END
    }
    for (int tile = bid; tile < MT * NT; tile += nb) {
        const int mt = tile / NT, nt = tile % NT;
        ACC_DECL(4, acc); acc_zero(acc);
        gemm_accum<4>(acc, [&](int i) { return p.h + (size_t)(mt * 128 + i) * D; }, [&](int j) { return Wt + (size_t)(nt * 128 + j) * D; }, D, smc);
#ifndef CPU_EMU
        {
            float* tl = (float*)smc;
            acc_to_lds<4>(acc, tl);
            __syncthreads();
            const int t_ = tid_(); const int row = t_ >> 1, half = t_ & 1;
            const int cb = nt * 128 + half * 64;
            float v[64];
#pragma unroll
            for (int q = 0; q < 16; ++q) { const f32x4_t x4 = *(const f32x4_t*)(tl + row * 132 + half * 64 + q * 4); v[q * 4] = x4[0]; v[q * 4 + 1] = x4[1]; v[q * 4 + 2] = x4[2]; v[q * 4 + 3] = x4[3]; }
            if (cb < 512) {
                const float* gn = (cb < 256 ? p.in[I_NAQG] : p.in[I_NAKG]) + l * 64;
                float ss = 0.f;
#pragma unroll
                for (int c = 0; c < 64; ++c) ss += v[c] * v[c];
                const float rs = __builtin_amdgcn_rsqf(ss * (1.0f / 64.0f) + 1e-6f) * ((cb < 256) ? 0.125f * 1.4426950408889634f : 1.0f);
#pragma unroll
                for (int c = 0; c < 64; ++c) v[c] *= rs * gn[c];
            } else if (cb >= 768 && cb < 1280) {
                const float* gn = (cb < 1024 ? p.in[I_DAQG] : p.in[I_DAKG]) + l * 32;
                const float qs = (cb < 1024) ? 0.17677669529663687f * 1.4426950408889634f : 1.0f;
#pragma unroll
                for (int gp = 0; gp < 2; ++gp) {
                    float ss = 0.f;
#pragma unroll
                    for (int c = 0; c < 32; ++c) ss += v[gp * 32 + c] * v[gp * 32 + c];
                    const float rs = __builtin_amdgcn_rsqf(ss * (1.0f / 32.0f) + 1e-6f) * qs;
#pragma unroll
                    for (int c = 0; c < 32; ++c) v[gp * 32 + c] *= rs * gn[c];
                }
                const int gr_ = mt * 128 + row;
                if (gr_ < NLAT) {
                    const int tt = gr_ % SEQ;
#pragma unroll
                    for (int a = 0; a < 2; ++a) {
                        const float pos = (float)(a == 0 ? tt / GW : tt % GW);
                        float frev = 0.15915494309189535f;
#pragma unroll
                        for (int f = 0; f < 8; ++f) {
                            const float cs = __builtin_amdgcn_cosf(pos * frev), sn = __builtin_amdgcn_sinf(pos * frev);
#pragma unroll
                            for (int gp = 0; gp < 2; ++gp) {
                                const int i1 = gp * 32 + a * 16 + f, i2 = i1 + 8;
                                const float x1 = v[i1], x2 = v[i2];
                                v[i1] = x1 * cs - x2 * sn; v[i2] = x2 * cs + x1 * sn;
                            }
                            frev *= 0.31622776601683794f;
                        }
                    }
                }
            }
            bf16* dst = p.P + (size_t)(mt * 128 + row) * PLD + cb;
#pragma unroll
            for (int q = 0; q < 8; ++q) {
                uint4 pk; pk.x = cvtpk(v[q * 8], v[q * 8 + 1]); pk.y = cvtpk(v[q * 8 + 2], v[q * 8 + 3]); pk.z = cvtpk(v[q * 8 + 4], v[q * 8 + 5]); pk.w = cvtpk(v[q * 8 + 6], v[q * 8 + 7]);
                *(uint4*)(dst + q * 8) = pk;
            }
        }
#else
        ACC_FOR(4, row, col) { p.P[(size_t)(mt * 128 + row) * PLD + nt * 128 + col] = f2bf(AV(acc)); } ACC_END
#endif
    }
}

HD void ph_prep(const Params& p, int l, int bid, int nb) {
#ifdef CPU_EMU
    {
        const float* naq = p.in[I_NAQG] + l * 64; const float* nak = p.in[I_NAKG] + l * 64;
        const float* daq = p.in[I_DAQG] + l * 32; const float* dak = p.in[I_DAKG] + l * 32;
        const int N = R * 24;
        for (int u = bid; u < (N + 255) / 256; u += nb) {
            THREADS(t, 256) {
                int idx = u * 256 + t;
                if (idx < N) {
                    int r = idx / 24, gidx = idx % 24;
                    if (gidx < 8) {
                        int isk = gidx >> 2, hd = gidx & 3;
                        bf16* ptr = p.P + (size_t)r * PLD + (isk ? C_NAK : C_NAQ) + hd * 64;
                        const float* g = isk ? nak : naq;
                        float ss = 0.f;
                        for (int d = 0; d < 64; ++d) { float v = bf2f(ptr[d]); ss += v * v; }
                        float rs = 1.0f / sqrtf(ss / 64.0f + 1e-6f);
#ifndef CPU_EMU
                        if (!isk) rs *= 0.125f * 1.4426950408889634f;
#endif
                        for (int d = 0; d < 64; ++d) ptr[d] = f2bf(bf2f(ptr[d]) * rs * g[d]);
                    } else {
                        int gi = gidx - 8; int isk = gi >> 3; int hm = gi & 7;
                        bf16* ptr = p.P + (size_t)r * PLD + (isk ? C_DAK : C_DAQ) + hm * 32;
                        const float* g = isk ? dak : daq;
                        float ss = 0.f;
                        for (int d = 0; d < 32; ++d) { float v = bf2f(ptr[d]); ss += v * v; }
                        float rs = 1.0f / sqrtf(ss / 32.0f + 1e-6f);
#ifndef CPU_EMU
                        if (!isk) rs *= 0.17677669529663687f * 1.4426950408889634f;
#endif
                        if (r < NLAT) {
                            int tt = r % SEQ; float prow = (float)(tt / GW), pcol = (float)(tt % GW);
                            for (int a = 0; a < 2; ++a) {
                                float pos = a == 0 ? prow : pcol;
                                float fr = 1.0f;
                                for (int f = 0; f < 8; ++f) {
                                    float ang = pos * fr;
                                    float cs = cosf(ang), sn = sinf(ang);
                                    int i1 = a * 16 + f, i2 = a * 16 + 8 + f;
                                    float x1 = bf2f(ptr[i1]) * rs * g[i1], x2 = bf2f(ptr[i2]) * rs * g[i2];
                                    ptr[i1] = f2bf(x1 * cs - x2 * sn);
                                    ptr[i2] = f2bf(x2 * cs + x1 * sn);
                                    fr *= 0.31622776601683794f;
                                }
                            }
                        } else {
                            for (int d = 0; d < 32; ++d) ptr[d] = f2bf(bf2f(ptr[d]) * rs * g[d]);
                        }
                    }
                }
            }
        }
    }
#endif
#ifndef CPU_EMU
    {
        const float* cw = p.in[I_CONVW] + (size_t)l * 5 * 768;
        const int N = R * 96;
        for (int idx = bid * 256 + tid_(); idx < N; idx += nb * 256) {
            const int r = idx / 96, q = idx % 96; const int ph = q >> 3, cg = q & 7; const int part = ph >> 2, hd = ph & 3;
            const RowInfo ri = rowinfo(r);
            const int ch0 = part * 256 + hd * 64 + cg * 8;
            float y[8];
#pragma unroll
            for (int c = 0; c < 8; ++c) y[c] = 0.f;
#pragma unroll
            for (int i = 0; i < 5; ++i) {
                const int tt = ri.t + i - 2;
                if (tt >= 0 && tt < ri.T) {
                    const uint4 raw = *(const uint4*)(p.P + (size_t)(ri.base + tt) * PLD + C_GQ + ch0);
                    const f32x4_t w0 = *(const f32x4_t*)(cw + i * 768 + ch0), w1 = *(const f32x4_t*)(cw + i * 768 + ch0 + 4);
                    y[0] += __uint_as_float(raw.x << 16) * w0[0]; y[1] += __uint_as_float(raw.x & 0xffff0000u) * w0[1];
                    y[2] += __uint_as_float(raw.y << 16) * w0[2]; y[3] += __uint_as_float(raw.y & 0xffff0000u) * w0[3];
                    y[4] += __uint_as_float(raw.z << 16) * w1[0]; y[5] += __uint_as_float(raw.z & 0xffff0000u) * w1[1];
                    y[6] += __uint_as_float(raw.w << 16) * w1[2]; y[7] += __uint_as_float(raw.w & 0xffff0000u) * w1[3];
                }
            }
            float ss = 0.f;
#pragma unroll
            for (int c = 0; c < 8; ++c) { y[c] = siluf_(y[c]); ss += y[c] * y[c]; }
            ss += __shfl_xor(ss, 1); ss += __shfl_xor(ss, 2); ss += __shfl_xor(ss, 4);
            float scl = 1.0f;
            if (part == 0) scl = 0.125f / sqrtf(ss + 1e-6f); else if (part == 1) scl = 1.0f / sqrtf(ss + 1e-6f);
            uint4 pk; pk.x = cvtpk(y[0] * scl, y[1] * scl); pk.y = cvtpk(y[2] * scl, y[3] * scl); pk.z = cvtpk(y[4] * scl, y[5] * scl); pk.w = cvtpk(y[6] * scl, y[7] * scl);
            *(uint4*)(p.gq + (size_t)r * 768 + ch0) = pk;
        }
    }
#else
    {
        const float* cw = p.in[I_CONVW] + (size_t)l * 5 * 768;
        const int N = R * 12;
        for (int u = bid; u < (N + 255) / 256; u += nb) {
            THREADS(t, 256) {
                int idx = u * 256 + t;
                if (idx < N) {
                    int r = idx / 12, ph = idx % 12; int part = ph >> 2, hd = ph & 3;
                    RowInfo ri = rowinfo(r);
                    int ch0 = part * 256 + hd * 64;
                    float ss = 0.f;
                    for (int pass = 0; pass < 2; ++pass) {
                        float scl = 1.0f;
                        if (pass == 1) { if (part == 0) scl = 0.125f / sqrtf(ss + 1e-6f); else if (part == 1) scl = 1.0f / sqrtf(ss + 1e-6f); }
                        if (pass == 0 && part == 2) continue;
                        for (int c = 0; c < 64; ++c) {
                            float y = 0.f;
                            for (int i = 0; i < 5; ++i) {
                                int tt = ri.t + i - 2;
                                if (tt >= 0 && tt < ri.T) y += bf2f(p.P[(size_t)(ri.base + tt) * PLD + C_GQ + ch0 + c]) * cw[i * 768 + ch0 + c];
                            }
                            y = siluf_(y);
                            if (pass == 0) ss += y * y; else p.gq[(size_t)r * 768 + ch0 + c] = f2bf(y * scl);
                        }
                    }
                }
            }
        }
    }
#endif
    {
        const int RQ = (l == 0) ? R : NLAT;
        for (int r = (FOURIER_GEMM ? RQ : 0) + bid; r < RQ; r += nb) {
            THREADS(t, 256) {
                int g = t >> 6, m = t & 63;
                const bf16* f = p.P + (size_t)r * PLD + C_F + g * 64;
                float fc = 0.f, fs = 0.f;
                for (int c = 0; c < 64; ++c) {
                    int ti = ((m * c) & 63) * (SEQ / 64);
                    float v = bf2f(f[c]);
                    fc += v * p.cosT[ti]; fs += v * p.sinT[ti];
                }
                p.fcs[(size_t)r * 512 + t] = f2bf(fc);
                p.fcs[(size_t)r * 512 + 256 + t] = f2bf(fs);
                if (FOURIER_GEMM && r >= NLAT) {
                    const int rc = r - NLAT; const int bb = rc / CTXL, tt = rc % CTXL;
                    bf16* xc = p.fXC + (((size_t)bb * 256 + t) * 2) * CTXL + tt;
                    xc[0] = f2bf(fc); xc[CTXL] = f2bf(fs);
                }
            }
        }
    }
}

#ifndef CPU_EMU
HD void ph_na(const Params& p, int l, int bid, int nb, char* smc) {
    const int t = tid_(), lane = t & 63, w = t >> 6, fr = lane & 15, fg = lane >> 4;
    const float* rpb = p.in[I_RPB] + (size_t)l * 4 * 15 * 31;
    float* sbias = (float*)(smc + 32768);
    const lds_cptr lds = (lds_cptr)smc;
    constexpr int WH = ROWS < 8 ? ROWS : 8;
    const int nlat = NB * ROWS * 4;
    const int nctx = (l == 0) ? NB * 4 * (CTXL / 64) : 0;
    const int lkey = t >> 3, lc = t & 7;
    const int ksrc = (lc ^ (lkey & 7)) << 3;
    const int vsrc = ((((lc >> 1) ^ ((lkey >> 1) & 3)) << 1) | (lc & 1)) << 3;
    for (int unit = bid; unit < nlat + nctx; unit += nb) {
        int b, hd, qrow, ntl, rs = 0, gr = 0;
        if (unit < nlat) {
            hd = unit & 3; const int br_ = unit >> 2; gr = br_ % ROWS; b = br_ / ROWS;
            qrow = b * SEQ + gr * GW + w * 16 + fr; ntl = WH;
            rs = gr - WH / 2; if (rs < 0) rs = 0; if (rs > ROWS - WH) rs = ROWS - WH;
        } else {
            const int u2 = unit - nlat; const int qt = u2 % (CTXL / 64); const int bh = u2 / (CTXL / 64); hd = bh & 3; b = bh >> 2;
            qrow = NLAT + b * CTXL + qt * 64 + w * 16 + fr; ntl = 0;
        }
        const int ntiles = ntl + NCC;
        const int qcol = w * 16 + fr;
        int cs0 = w * 16 - 8; if (cs0 < 0) cs0 = 0; if (cs0 > GW - 32) cs0 = GW - 32;
        int wsq = qcol - 8; if (wsq < 0) wsq = 0; if (wsq > GW - 16) wsq = GW - 16;
        bf16x8_t qf[2];
#pragma unroll
        for (int s_ = 0; s_ < 2; ++s_) qf[s_] = *(const bf16x8_t*)(p.P + (size_t)qrow * PLD + C_NAQ + hd * 64 + s_ * 32 + fg * 8);
        f32x4_t O[4];
#pragma unroll
        for (int d = 0; d < 4; ++d) O[d] = f32x4_t{0.f, 0.f, 0.f, 0.f};
        float ls = 0.f;
        auto keyrow = [&](int tt, int i) { return (tt < ntl) ? (b * SEQ + (rs + tt) * GW + i) : (NLAT + b * CTXL + (tt - ntl) * 64 + i); };
        char* ldst = smc + w * 1024;
        __syncthreads();
        for (int i = t; i < 15 * 31; i += 256) sbias[i] = rpb[hd * 465 + i] * 1.4426950408889634f;
#pragma unroll
        for (int i = 0; i < 2; ++i) {
            const bf16* src = p.P + (size_t)keyrow(0, lkey + 32 * i) * PLD + hd * 64;
            GLDS16(src + C_NAK + ksrc, ldst + 4096 * i); GLDS16(src + C_NAV + vsrc, ldst + 16384 + 4096 * i);
        }
        WAIT_VM0();
        __syncthreads();
        const int vkl = 4 * fg + (fr >> 2);
        const int vsw = (vkl >> 1) & 3;
        unsigned va[4];
#pragma unroll
        for (int d = 0; d < 4; ++d) va[d] = 16384 + vkl * 128 + ((((d ^ vsw) << 1) | ((fr & 3) >> 1)) << 4) + (fr & 1) * 8;
#pragma unroll 1
        for (int tt = 0; tt < ntiles; ++tt) {
            const int cur = tt & 1;
            if (tt + 1 < ntiles) {
#pragma unroll
                for (int i = 0; i < 2; ++i) {
                    const bf16* src = p.P + (size_t)keyrow(tt + 1, lkey + 32 * i) * PLD + hd * 64;
                    GLDS16(src + C_NAK + ksrc, ldst + (cur ^ 1) * 8192 + 4096 * i); GLDS16(src + C_NAV + vsrc, ldst + 16384 + (cur ^ 1) * 8192 + 4096 * i);
                }
            }
            const char* cK = smc + cur * 8192;
            const lds_cptr cV = lds + cur * 8192;
            const bool local = tt < ntl;
            const int kbase = local ? cs0 : 0;
            const int nkf = local ? 2 : 4;
            unsigned pb[2][4];
#pragma unroll
            for (int f = 0; f < 4; ++f) {
                if (f < nkf) {
                    const int key = kbase + f * 16 + fr;
                    const char* kp = cK + key * 128;
                    const bf16x8_t a0 = *(const bf16x8_t*)(kp + (((fg) ^ (fr & 7)) << 4));
                    const bf16x8_t a1 = *(const bf16x8_t*)(kp + (((4 + fg) ^ (fr & 7)) << 4));
                    f32x4_t S = __builtin_amdgcn_mfma_f32_16x16x32_bf16(a0, qf[0], f32x4_t{0.f, 0.f, 0.f, 0.f}, 0, 0, 0);
                    S = __builtin_amdgcn_mfma_f32_16x16x32_bf16(a1, qf[1], S, 0, 0, 0);
                    float e[4];
#pragma unroll
                    for (int r = 0; r < 4; ++r) {
                        float sv = S[r]; bool ok = true;
                        if (local) {
                            const int kc = kbase + f * 16 + 4 * fg + r;
                            ok = (unsigned)(kc - wsq) < 16u;
                            sv += sbias[((rs + tt) - gr + 7) * 31 + (ok ? (kc - qcol + 15) : 15)];
                        }
                        e[r] = ok ? __builtin_amdgcn_exp2f(sv) : 0.f;
                    }
                    ls += (e[0] + e[1]) + (e[2] + e[3]);
                    pb[f >> 1][(f & 1) * 2] = cvtpk(e[0], e[1]);
                    pb[f >> 1][(f & 1) * 2 + 1] = cvtpk(e[2], e[3]);
                }
            }
#pragma unroll
            for (int ks = 0; ks < 2; ++ks) {
                if (ks * 2 < nkf) {
#pragma unroll
                    for (int d = 0; d < 4; ++d) {
                        const s16x4_t lo = lds_tr16(cV + va[d] + (kbase + ks * 32) * 128);
                        const s16x4_t hi = lds_tr16(cV + va[d] + (kbase + ks * 32 + 16) * 128);
                        const bf16x8_t vf = bf16x8_t{lo[0], lo[1], lo[2], lo[3], hi[0], hi[1], hi[2], hi[3]};
                        const i32x4_t bi = i32x4_t{(int)pb[ks][0], (int)pb[ks][1], (int)pb[ks][2], (int)pb[ks][3]};
                        O[d] = __builtin_amdgcn_mfma_f32_16x16x32_bf16(vf, __builtin_bit_cast(bf16x8_t, bi), O[d], 0, 0, 0);
                    }
                }
            }
            WAIT_VM0();
            __syncthreads();
        }
        ls += __shfl_xor(ls, 16); ls += __shfl_xor(ls, 32);
        const float inv = 1.0f / ls;
        bf16* op = p.br + (size_t)qrow * D + hd * 64;
#pragma unroll
        for (int d = 0; d < 4; ++d) {
            uint2 pk; pk.x = cvtpk(O[d][0] * inv, O[d][1] * inv); pk.y = cvtpk(O[d][2] * inv, O[d][3] * inv);
            *(uint2*)(op + d * 16 + 4 * fg) = pk;
        }
    }
}
#else
HD void ph_na(const Params& p, int l, int bid, int nb, char*) {
    const float* rpb = p.in[I_RPB] + (size_t)l * 4 * 15 * 31;
    const int RQ = (l == 0) ? R : NLAT;
    const int N = RQ * 4;
    const int wh = ROWS < 8 ? ROWS : 8;
    for (int u = bid; u < (N + 255) / 256; u += nb) {
        THREADS(t, 256) {
            int idx = u * 256 + t;
            if (idx < N) {
                int hd = idx / RQ, r = idx % RQ;
                RowInfo ri = rowinfo(r);
                float q[64], o[64];
                const bf16* qp = p.P + (size_t)r * PLD + C_NAQ + hd * 64;
#pragma unroll
                for (int d = 0; d < 64; ++d) { q[d] = bf2f(qp[d]) * 0.125f; o[d] = 0.f; }
                float mx = -1e30f, lsum = 0.f;
                int nloc = 0, rs = 0, ws = 0, gr = 0, gc = 0;
                if (ri.seg == 0) {
                    gr = ri.t / GW; gc = ri.t % GW;
                    rs = gr - wh / 2; if (rs < 0) rs = 0; if (rs > ROWS - wh) rs = ROWS - wh;
                    ws = gc - 8; if (ws < 0) ws = 0; if (ws > GW - 16) ws = GW - 16;
                    nloc = wh * 16;
                }
                int ctxbase = NLAT + ri.b * CTXL;
                for (int kk = 0; kk < nloc + CTXL; ++kk) {
                    int kr; float bias = 0.f;
                    if (kk < nloc) {
                        int a = kk >> 4, c = kk & 15;
                        int krow = rs + a, kcol = ws + c;
                        kr = ri.base + krow * GW + kcol;
                        bias = rpb[(hd * 15 + (krow - gr + 7)) * 31 + (kcol - gc + 15)];
                    } else kr = ctxbase + (kk - nloc);
                    const bf16* kp = p.P + (size_t)kr * PLD + C_NAK + hd * 64;
                    float s = 0.f;
#pragma unroll
                    for (int d = 0; d < 64; ++d) s += q[d] * bf2f(kp[d]);
                    s += bias;
                    if (s > mx) { float f = expf(mx - s); lsum *= f;
#pragma unroll
                        for (int d = 0; d < 64; ++d) o[d] *= f;
                        mx = s; }
                    float e = expf(s - mx);
                    lsum += e;
                    const bf16* vp = p.P + (size_t)kr * PLD + C_NAV + hd * 64;
#pragma unroll
                    for (int d = 0; d < 64; ++d) o[d] += e * bf2f(vp[d]);
                }
                float inv = 1.0f / lsum;
                bf16* op = p.br + (size_t)r * D + hd * 64;
#pragma unroll
                for (int d = 0; d < 64; ++d) op[d] = f2bf(o[d] * inv);
            }
        }
    }
}

#endif

#ifndef CPU_EMU
HD void ph_da(const Params& p, int l, int bid, int nb, char* smc) {
    const int t = tid_(), lane = t & 63, w = t >> 6, fr = lane & 15, fg = lane >> 4;
    const float lam_init = lam_init_of(l);
    float s1 = 0.f, s2 = 0.f;
    for (int d = 0; d < 32; ++d) {
        s1 += p.in[I_LQ1][l * 32 + d] * p.in[I_LK1][l * 32 + d];
        s2 += p.in[I_LQ2][l * 32 + d] * p.in[I_LK2][l * 32 + d];
    }
    const float lam = expf(s1) - expf(s2) + lam_init;
    const float* sg = p.in[I_SUBLN] + l * 64;
    constexpr int NQT = SEQ / 128, NQC = CTXL / 128;
    const int nlat = NB * 4 * NQT;
    const int nctx = (l == 0) ? NB * 4 * NQC : 0;
    const lds_cptr lds = (lds_cptr)smc;
    for (int unit = bid; unit < nlat + nctx; unit += nb) {
        int b, hd, qrow0, kt0;
        if (unit < nlat) { const int qt = unit % NQT, bh = unit / NQT; hd = bh & 3; b = bh >> 2; qrow0 = b * SEQ + qt * 128; kt0 = 0; }
        else { const int u2 = unit - nlat; const int qt = u2 % NQC, bh = u2 / NQC; hd = bh & 3; b = bh >> 2; qrow0 = NLAT + b * CTXL + qt * 128; kt0 = NCL; }
        const int kt1 = NCL + NCC;
        bf16x8_t qf[2][2];
#pragma unroll
        for (int m = 0; m < 2; ++m)
#pragma unroll
            for (int n = 0; n < 2; ++n)
                qf[m][n] = *(const bf16x8_t*)(p.P + (size_t)(qrow0 + w * 32 + n * 16 + fr) * PLD + C_DAQ + hd * 64 + m * 32 + fg * 8);
        f32x4_t O[2][4][2];
#pragma unroll
        for (int m = 0; m < 2; ++m)
#pragma unroll
            for (int d = 0; d < 4; ++d)
#pragma unroll
                for (int n = 0; n < 2; ++n) O[m][d][n] = f32x4_t{0.f, 0.f, 0.f, 0.f};
        f32x4_t L5[2][2];
#pragma unroll
        for (int m = 0; m < 2; ++m)
#pragma unroll
            for (int n = 0; n < 2; ++n) L5[m][n] = f32x4_t{0.f, 0.f, 0.f, 0.f};
        const short one_ = (fr == 0) ? (short)0x3f80 : (short)0;
        const bf16x8_t onesf = bf16x8_t{one_, one_, one_, one_, one_, one_, one_, one_};
        const int lkey = t >> 3, lc = t & 7;
        const int ksrc = (lc ^ (lkey & 7)) << 3;
        const int vsrc = ((((lc >> 1) ^ ((lkey >> 1) & 3)) << 1) | (lc & 1)) << 3;
        auto keyrow = [&](int kt, int i) { return (kt < NCL) ? (b * SEQ + kt * 64 + i) : (NLAT + b * CTXL + (kt - NCL) * 64 + i); };
        char* ldst = smc + w * 1024;
        __syncthreads();
#pragma unroll
        for (int i = 0; i < 2; ++i) {
            const bf16* src = p.P + (size_t)keyrow(kt0, lkey + 32 * i) * PLD + hd * 64;
            GLDS16(src + C_DAK + ksrc, ldst + 4096 * i); GLDS16(src + C_DAV + vsrc, ldst + 16384 + 4096 * i);
        }
        WAIT_VM0();
        __syncthreads();
        const unsigned ka0 = fr * 128 + (((fg) ^ (fr & 7)) << 4);
        const unsigned ka1 = fr * 128 + (((4 + fg) ^ (fr & 7)) << 4);
        const int vkey = 4 * fg + (fr >> 2);
        const int vsw = (vkey >> 1) & 3;
        unsigned va[4];
#pragma unroll
        for (int d = 0; d < 4; ++d) va[d] = 16384 + vkey * 128 + ((((d ^ vsw) << 1) | ((fr & 3) >> 1)) << 4) + (fr & 1) * 8;
#pragma unroll 1
        for (int kt = kt0; kt < kt1; ++kt) {
            const int cur = (kt - kt0) & 1;
            if (kt + 1 < kt1) {
#pragma unroll
                for (int i = 0; i < 2; ++i) {
                    const bf16* src = p.P + (size_t)keyrow(kt + 1, lkey + 32 * i) * PLD + hd * 64;
                    GLDS16(src + C_DAK + ksrc, ldst + (cur ^ 1) * 8192 + 4096 * i); GLDS16(src + C_DAV + vsrc, ldst + 16384 + (cur ^ 1) * 8192 + 4096 * i);
                }
            }
            const char* cK = smc + cur * 8192;
            const lds_cptr cV = lds + cur * 8192;
#pragma unroll
            for (int m = 0; m < 2; ++m) {
                unsigned pb[2][2][4];
                {
                    f32x4_t S[4][2];
#pragma unroll
                    for (int kf = 0; kf < 4; ++kf) {
                        const bf16x8_t a = *(const bf16x8_t*)(cK + (m ? ka1 : ka0) + kf * 2048);
#pragma unroll
                        for (int n = 0; n < 2; ++n) S[kf][n] = __builtin_amdgcn_mfma_f32_16x16x32_bf16(a, qf[m][n], f32x4_t{0.f, 0.f, 0.f, 0.f}, 0, 0, 0);
                    }
#pragma unroll
                    for (int kf = 0; kf < 4; ++kf)
#pragma unroll
                        for (int n = 0; n < 2; ++n) {
                            const float e0 = __builtin_amdgcn_exp2f(S[kf][n][0]), e1 = __builtin_amdgcn_exp2f(S[kf][n][1]);
                            const float e2 = __builtin_amdgcn_exp2f(S[kf][n][2]), e3 = __builtin_amdgcn_exp2f(S[kf][n][3]);
                            pb[n][kf >> 1][(kf & 1) * 2] = cvtpk(e0, e1);
                            pb[n][kf >> 1][(kf & 1) * 2 + 1] = cvtpk(e2, e3);
                        }
                }
#pragma unroll
                for (int ks = 0; ks < 2; ++ks)
#pragma unroll
                    for (int d = 0; d < 4; ++d) {
                        const s16x4_t lo = lds_tr16(cV + va[d] + ks * 4096);
                        const s16x4_t hi = lds_tr16(cV + va[d] + ks * 4096 + 2048);
                        const bf16x8_t vf = bf16x8_t{lo[0], lo[1], lo[2], lo[3], hi[0], hi[1], hi[2], hi[3]};
#pragma unroll
                        for (int n = 0; n < 2; ++n) {
                            const i32x4_t bi = i32x4_t{(int)pb[n][ks][0], (int)pb[n][ks][1], (int)pb[n][ks][2], (int)pb[n][ks][3]};
                            O[m][d][n] = __builtin_amdgcn_mfma_f32_16x16x32_bf16(vf, __builtin_bit_cast(bf16x8_t, bi), O[m][d][n], 0, 0, 0);
                            if (d == 0) L5[m][n] = __builtin_amdgcn_mfma_f32_16x16x32_bf16(onesf, __builtin_bit_cast(bf16x8_t, bi), L5[m][n], 0, 0, 0);
                        }
                    }
                asm volatile("" ::: "memory");
            }
            WAIT_VM0();
            __syncthreads();
        }
#pragma unroll
        for (int n = 0; n < 2; ++n) {
            const float l0 = __shfl(L5[0][n][0], fr), l1 = __shfl(L5[1][n][0], fr);
            const float i0 = 1.0f / l0, i1 = lam / l1;
            float ss = 0.f;
#pragma unroll
            for (int d = 0; d < 4; ++d)
#pragma unroll
                for (int r = 0; r < 4; ++r) { const float o = O[0][d][n][r] * i0 - O[1][d][n][r] * i1; O[0][d][n][r] = o; ss += o * o; }
            ss += __shfl_xor(ss, 16); ss += __shfl_xor(ss, 32);
            const float rs = (1.0f - lam_init) / sqrtf(ss / 64.0f + 1e-6f);
            bf16* op = p.br + (size_t)(qrow0 + w * 32 + n * 16 + fr) * D + 256 + hd * 64;
#pragma unroll
            for (int d = 0; d < 4; ++d) {
                const int dv = d * 16 + 4 * fg;
                const unsigned lo = cvtpk(O[0][d][n][0] * rs * sg[dv], O[0][d][n][1] * rs * sg[dv + 1]);
                const unsigned hi = cvtpk(O[0][d][n][2] * rs * sg[dv + 2], O[0][d][n][3] * rs * sg[dv + 3]);
                uint2 pk; pk.x = lo; pk.y = hi;
                *(uint2*)(op + dv) = pk;
            }
        }
    }
}
#else
HD void ph_da(const Params& p, int l, int bid, int nb, char*) {
    const int RQ = (l == 0) ? R : NLAT;
    const int N = RQ * 4;
    const float lam_init = lam_init_of(l);
    float s1 = 0.f, s2 = 0.f;
    for (int d = 0; d < 32; ++d) {
        s1 += p.in[I_LQ1][l * 32 + d] * p.in[I_LK1][l * 32 + d];
        s2 += p.in[I_LQ2][l * 32 + d] * p.in[I_LK2][l * 32 + d];
    }
    const float lam = expf(s1) - expf(s2) + lam_init;
    const float* sg = p.in[I_SUBLN] + l * 64;
    const float scale = 0.17677669529663687f;
    for (int u = bid; u < (N + 255) / 256; u += nb) {
        THREADS(t, 256) {
            int idx = u * 256 + t;
            if (idx < N) {
                int hd = idx / RQ, r = idx % RQ;
                RowInfo ri = rowinfo(r);
                float q0[32], q1[32], o0[64], o1[64];
                const bf16* qp = p.P + (size_t)r * PLD + C_DAQ + hd * 64;
#pragma unroll
                for (int d = 0; d < 32; ++d) { q0[d] = bf2f(qp[d]) * scale; q1[d] = bf2f(qp[32 + d]) * scale; }
#pragma unroll
                for (int d = 0; d < 64; ++d) { o0[d] = 0.f; o1[d] = 0.f; }
                float m0 = -1e30f, m1 = -1e30f, l0 = 0.f, l1 = 0.f;
                int nlat = (ri.seg == 0) ? SEQ : 0;
                int latbase = ri.b * SEQ, ctxbase = NLAT + ri.b * CTXL;
                for (int kk = 0; kk < nlat + CTXL; ++kk) {
                    int kr = (kk < nlat) ? latbase + kk : ctxbase + (kk - nlat);
                    const bf16* kp = p.P + (size_t)kr * PLD + C_DAK + hd * 64;
                    const bf16* vp = p.P + (size_t)kr * PLD + C_DAV + hd * 64;
                    float sa = 0.f, sb = 0.f;
#pragma unroll
                    for (int d = 0; d < 32; ++d) { sa += q0[d] * bf2f(kp[d]); sb += q1[d] * bf2f(kp[32 + d]); }
                    if (sa > m0) { float f = expf(m0 - sa); l0 *= f;
#pragma unroll
                        for (int d = 0; d < 64; ++d) o0[d] *= f;
                        m0 = sa; }
                    if (sb > m1) { float f = expf(m1 - sb); l1 *= f;
#pragma unroll
                        for (int d = 0; d < 64; ++d) o1[d] *= f;
                        m1 = sb; }
                    float ea = expf(sa - m0), eb = expf(sb - m1);
                    l0 += ea; l1 += eb;
#pragma unroll
                    for (int d = 0; d < 64; ++d) { float v = bf2f(vp[d]); o0[d] += ea * v; o1[d] += eb * v; }
                }
                float i0 = 1.0f / l0, i1 = lam / l1;
                float ss = 0.f;
#pragma unroll
                for (int d = 0; d < 64; ++d) { o0[d] = o0[d] * i0 - o1[d] * i1; ss += o0[d] * o0[d]; }
                float rs = (1.0f - lam_init) / sqrtf(ss / 64.0f + 1e-6f);
                bf16* op = p.br + (size_t)r * D + 256 + hd * 64;
#pragma unroll
                for (int d = 0; d < 64; ++d) op[d] = f2bf(o0[d] * rs * sg[d]);
            }
        }
    }
}

#endif

struct ChunkInfo { int dir, b, hd, n, seg, T, base, nloc; };
HD ChunkInfo chunkinfo(int unit) {
    ChunkInfo c;
    c.n = unit % NCH; int ch = unit / NCH; c.hd = ch & 3; c.b = (ch >> 2) % NB; c.dir = ch / (4 * NB);
    if (c.n < NCC) { c.seg = 1; c.T = CTXL; c.base = NLAT + c.b * CTXL; c.nloc = c.n; }
    else { c.seg = 0; c.T = SEQ; c.base = c.b * SEQ; c.nloc = c.n - NCC; }
    return c;
}
HD int chunk_row(const ChunkInfo& c, int i) { int pf = c.nloc * 64 + i; return c.base + (c.dir ? (c.T - 1 - pf) : pf); }

#ifndef CPU_EMU
HD void ph_gdn_chunk(const Params& p, int l, int bid, int nb, float* smf) {
    char* smc = (char*)smf;
    const int t = tid_(), lane = t & 63, w = t >> 6, fr = lane & 15, fg = lane >> 4;
    float* sA = (float*)(smc + 24576); float* sG = (float*)(smc + 40960); float* sB = (float*)(smc + 41216);
    const int lkey = t >> 3, lc = t & 7;
    const int ksrc = (lc ^ (lkey & 7)) << 3;
    char* ldst = smc + w * 1024;
    for (int unit = bid; unit < NUNIT; unit += nb) {
        const ChunkInfo c = chunkinfo(unit);
        const int dh = c.dir * 4 + c.hd;
        __syncthreads();
#pragma unroll
        for (int i = 0; i < 2; ++i) {
            const bf16* src = p.gq + (size_t)chunk_row(c, lkey + 32 * i) * 768 + c.hd * 64;
            GLDS16(src + 256 + ksrc, ldst + 4096 * i);
            GLDS16(src + ksrc, ldst + 8192 + 4096 * i);
            GLDS16(src + 512 + lc * 8, ldst + 16384 + 4096 * i);
        }
        if (w == 0) {
            const int row = chunk_row(c, lane);
            float x = p.gg[(size_t)dh * R + row];
#pragma unroll
            for (int off = 1; off < 64; off <<= 1) { const float y = __shfl_up(x, off); if (lane >= off) x += y; }
            sG[lane] = x; sB[lane] = p.gbeta[(size_t)dh * R + row];
            const float x63 = __shfl(x, 63);
            float* cg = p.cG + (size_t)unit * 192;
            cg[lane] = __expf(x); cg[64 + lane] = __expf(x63 - x); cg[128 + lane] = __expf(x63);
        }
        WAIT_VM0();
        __syncthreads();
        {
            const char* kt_ = smc; const char* qt_ = smc + 8192;
            const unsigned ro = (16 * w + fr) * 128;
            const unsigned c0 = ((fg) ^ (fr & 7)) << 4, c1 = ((4 + fg) ^ (fr & 7)) << 4;
            const bf16x8_t ak0 = *(const bf16x8_t*)(kt_ + ro + c0), ak1 = *(const bf16x8_t*)(kt_ + ro + c1);
            const bf16x8_t aq0 = *(const bf16x8_t*)(qt_ + ro + c0), aq1 = *(const bf16x8_t*)(qt_ + ro + c1);
            float gi[4], bi[4];
#pragma unroll
            for (int r = 0; r < 4; ++r) { gi[r] = sG[16 * w + 4 * fg + r]; bi[r] = sB[16 * w + 4 * fg + r]; }
#pragma unroll
            for (int n = 0; n < 4; ++n) {
                const unsigned rb = (16 * n + fr) * 128;
                const bf16x8_t b0 = *(const bf16x8_t*)(kt_ + rb + c0), b1 = *(const bf16x8_t*)(kt_ + rb + c1);
                f32x4_t kk = __builtin_amdgcn_mfma_f32_16x16x32_bf16(ak0, b0, f32x4_t{0.f, 0.f, 0.f, 0.f}, 0, 0, 0);
                kk = __builtin_amdgcn_mfma_f32_16x16x32_bf16(ak1, b1, kk, 0, 0, 0);
                f32x4_t qk = __builtin_amdgcn_mfma_f32_16x16x32_bf16(aq0, b0, f32x4_t{0.f, 0.f, 0.f, 0.f}, 0, 0, 0);
                qk = __builtin_amdgcn_mfma_f32_16x16x32_bf16(aq1, b1, qk, 0, 0, 0);
                const int j = 16 * n + fr; const float gj = sG[j];
#pragma unroll
                for (int r = 0; r < 4; ++r) {
                    const int i = 16 * w + 4 * fg + r;
                    const float dec = (j <= i) ? __expf(gi[r] - gj) : 0.f;
                    sA[i * 64 + j] = (j < i) ? kk[r] * bi[r] * dec : 0.f;
                    p.cQK[(size_t)unit * 4096 + i * 64 + j] = f2bf(qk[r] * dec);
                }
            }
        }
        __syncthreads();
        if (w < 2) {
            float x[64];
            bf16* dst = (w == 0 ? p.cU : p.cW) + (size_t)unit * 4096 + lane;
#pragma unroll
            for (int i = 0; i < 64; ++i) {
                float rhs;
                if (w == 0) rhs = sB[i] * bf2f(*(const bf16*)(smc + 16384 + i * 128 + lane * 2));
                else rhs = sB[i] * __expf(sG[i]) * bf2f(*(const bf16*)(smc + i * 128 + ((((lane >> 3) ^ (i & 7))) << 4) + (lane & 7) * 2));
                float acc = rhs;
#pragma unroll
                for (int j4 = 0; j4 < i; j4 += 4) {
                    const f32x4_t a4 = *(const f32x4_t*)(sA + i * 64 + j4);
                    acc -= a4[0] * x[j4];
                    if (j4 + 1 < i) acc -= a4[1] * x[j4 + 1];
                    if (j4 + 2 < i) acc -= a4[2] * x[j4 + 2];
                    if (j4 + 3 < i) acc -= a4[3] * x[j4 + 3];
                }
                x[i] = acc;
                dst[i * 64] = f2bf(acc);
            }
        }
    }
}
#else
HD void ph_gdn_chunk(const Params& p, int l, int bid, int nb, float* sm) {
    float* sk = sm;
    float* sq = sm + 4096;
    float* sA = sm + 8192;
    float* sXu = sm + 12288;
    float* sXw = sm + 4096;
    float* sG = sm + 16384;
    float* sB = sm + 16448;
    for (int unit = bid; unit < NUNIT; unit += nb) {
        ChunkInfo c = chunkinfo(unit);
        int dh = c.dir * 4 + c.hd;
        THREADS(t, 4096) {
            int i = t >> 6, d = t & 63; int row = chunk_row(c, i);
            sq[t] = bf2f(p.gq[(size_t)row * 768 + c.hd * 64 + d]);
            sk[t] = bf2f(p.gq[(size_t)row * 768 + 256 + c.hd * 64 + d]);
        }
        THREADS(t, 1) {
            float acc = 0.f;
            for (int i = 0; i < 64; ++i) { int row = chunk_row(c, i); acc += p.gg[(size_t)dh * R + row]; sG[i] = acc; sB[i] = p.gbeta[(size_t)dh * R + row]; }
        }
        SYNC
        THREADS(t, 4096) {
            int i = t >> 6, j = t & 63;
            float kk = 0.f, qk = 0.f;
            for (int d = 0; d < 64; ++d) { kk += sk[i * 64 + d] * sk[j * 64 + d]; qk += sq[i * 64 + d] * sk[j * 64 + d]; }
            float dec = (j <= i) ? expf(sG[i] - sG[j]) : 0.f;
            sA[t] = (j < i) ? kk * sB[i] * dec : 0.f;
            p.cQK[(size_t)unit * 4096 + t] = f2bf(qk * dec);
        }
        SYNC
        THREADS(t, 4096) {
            int i = t >> 6, cc = t & 63; int row = chunk_row(c, i);
            sXu[t] = sB[i] * bf2f(p.gq[(size_t)row * 768 + 512 + c.hd * 64 + cc]);
            sXw[t] = sB[i] * expf(sG[i]) * sk[t];
        }
        SYNC
        for (int i = 1; i < 64; ++i) {
            THREADS(cc, 128) {
                float* X = (cc < 64) ? (sXu + cc) : (sXw + cc - 64);
                float acc = X[i * 64];
                for (int j = 0; j < i; ++j) acc -= sA[i * 64 + j] * X[j * 64];
                X[i * 64] = acc;
            }
            SYNC
        }
        THREADS(t, 4096) {
            p.cU[(size_t)unit * 4096 + t] = f2bf(sXu[t]);
            p.cW[(size_t)unit * 4096 + t] = f2bf(sXw[t]);
        }
        THREADS(t, 64) { p.cG[(size_t)unit * 64 + t] = sG[t]; }
        SYNC
    }
}

#endif

HD void ph_fourier2(const Params& p, int l, int bid, int nb) {
    const int RQ = (l == 0) ? R : NLAT;
    for (int r = (FOURIER_GEMM ? NLAT : 0) + bid; r < RQ; r += nb) {
        RowInfo ri = rowinfo(r);
        const float nrm = 1.0f / sqrtf((float)ri.T * 64.0f);
        const int mul = SEQ / ri.T;
        THREADS(ch, 256) {
            float acc = 0.f;
            for (int tt = 0; tt < ri.T; ++tt) {
                int ti = ((ri.t * tt) & (ri.T - 1)) * mul;
                const bf16* f = p.fcs + (size_t)(ri.base + tt) * 512;
                acc += p.cosT[ti] * bf2f(f[ch]) - p.sinT[ti] * bf2f(f[256 + ch]);
            }
            p.br[(size_t)r * D + 768 + ch] = f2bf(acc * nrm);
        }
    }
}


HD void ph_fourier_s1c(const Params& p, int bid, int nb, char* smc) {
    constexpr int MTc = CTXL / 128;
    for (int tile = bid; tile < NB * MTc * 4; tile += nb) {
        const int g = tile & 3, mtc = (tile >> 2) % MTc, b = tile / (4 * MTc);
        ACC_DECL(4, acc); acc_zero(acc);
        gemm_accum<4>(acc, [&](int i) { return p.P + (size_t)(NLAT + b * CTXL + mtc * 128 + i) * PLD + C_F + g * 64; },
                      [&](int j) { return p.fW1 + j * 64; }, 64, smc);
        ACC_FOR(4, row, col) {
            const int cs = col >> 6, m = col & 63;
            p.fXC[(((size_t)b * 256 + g * 64 + m) * 2 + cs) * CTXL + mtc * 128 + row] = f2bf(AV(acc));
        } ACC_END
    }
}
HD void ph_fourier_s1(const Params& p, int bid, int nb, char* smc) {
    for (int tile = bid; tile < NB * 64 * 4; tile += nb) {
        const int g = tile & 3, t2 = (tile >> 2) & 63, b = tile >> 8;
        ACC_DECL(4, acc); acc_zero(acc);
        gemm_accum<4>(acc, [&](int i) { return p.P + (size_t)(b * SEQ + 64 * i + t2) * PLD + C_F + g * 64; },
                      [&](int j) { return p.fW1 + j * 64; }, 64, smc);
#ifndef CPU_EMU
        {
            float* tl = (float*)smc;
            acc_to_lds<4>(acc, tl);
            __syncthreads();
            const int t_ = tid_(); const int col = t_ >> 1, half = t_ & 1;
            const int cs = col >> 6, m = col & 63;
            bf16* dst = p.fcs + ((((size_t)b * 256 + g * 64 + m) * 64 + t2) * 2 + cs) * 128 + half * 64;
#pragma unroll
            for (int q = 0; q < 8; ++q) {
                float v[8];
#pragma unroll
                for (int e = 0; e < 8; ++e) v[e] = tl[(half * 64 + q * 8 + e) * 132 + col];
                uint4 pk; pk.x = cvtpk(v[0], v[1]); pk.y = cvtpk(v[2], v[3]); pk.z = cvtpk(v[4], v[5]); pk.w = cvtpk(v[6], v[7]);
                *(uint4*)(dst + q * 8) = pk;
            }
        }
#else
        ACC_FOR(4, row, col) {
            const int cs = col >> 6, m = col & 63;
            p.fcs[((((size_t)b * 256 + g * 64 + m) * 64 + t2) * 2 + cs) * 128 + row] = f2bf(AV(acc));
        } ACC_END
#endif
    }
}
HD void ph_fourier_sA(const Params& p, int bid, int nb, char* smc) {
    for (int tile = bid; tile < NB * 128 * 2; tile += nb) {
        const int nt = tile & 1, mt = (tile >> 1) & 127, b = tile >> 8;
        ACC_DECL(4, acc); acc_zero(acc);
        gemm_accum<4>(acc, [&](int i) { return p.fcs + ((size_t)b * 16384 + mt * 128 + i) * 256; },
                      [&](int j) { return p.fWA + (size_t)(nt * 128 + j) * 256; }, 256, smc);
#ifndef CPU_EMU
        {
            float* tl = (float*)smc;
            acc_to_lds<4>(acc, tl);
            __syncthreads();
            const int t_ = tid_(); const int pcol = t_ >> 2, chl = (t_ >> 1) & 1, th = t_ & 1;
            const int k1 = nt * 64 + pcol; const int ch = mt * 2 + chl;
            const int cre = (pcol >> 4) * 32 + (pcol & 15), cim = cre + 16;
            bf16* o = p.fa2 + ((((size_t)b * 128 + k1) * 256 + ch) * 2) * 64 + th * 32;
#pragma unroll
            for (int q = 0; q < 4; ++q) {
                float vr[8], vi[8];
#pragma unroll
                for (int e = 0; e < 8; ++e) {
                    const int t2 = th * 32 + q * 8 + e;
                    const float re = tl[(chl * 64 + t2) * 132 + cre], im = tl[(chl * 64 + t2) * 132 + cim];
                    const float c = p.cosT[k1 * t2], sn = p.sinT[k1 * t2];
                    vr[e] = re * c + im * sn; vi[e] = im * c - re * sn;
                }
                uint4 pr, pi;
                pr.x = cvtpk(vr[0], vr[1]); pr.y = cvtpk(vr[2], vr[3]); pr.z = cvtpk(vr[4], vr[5]); pr.w = cvtpk(vr[6], vr[7]);
                pi.x = cvtpk(vi[0], vi[1]); pi.y = cvtpk(vi[2], vi[3]); pi.z = cvtpk(vi[4], vi[5]); pi.w = cvtpk(vi[6], vi[7]);
                *(uint4*)(o + q * 8) = pr; *(uint4*)(o + 64 + q * 8) = pi;
            }
        }
#else
        ACC_FOR_PAIR(row, pcol) {
            const int k1 = nt * 64 + pcol; const int rr = mt * 128 + row; const int ch = rr >> 6, t2 = rr & 63;
            const float re = AV_G(acc), im = AV_U(acc);
            const float c = p.cosT[k1 * t2], sn = p.sinT[k1 * t2];
            bf16* o = p.fa2 + ((((size_t)b * 128 + k1) * 256 + ch) * 2) * 64 + t2;
            o[0] = f2bf(re * c + im * sn); o[64] = f2bf(im * c - re * sn);
        } ACC_END
#endif
    }
}
HD void ph_fourier_sB(const Params& p, int bid, int nb, char* smc) {
    const float nrm = 1.0f / sqrtf((float)SEQ * 64.0f);
    for (int tile = bid; tile < NB * 128 * 2; tile += nb) {
        const int cht = tile & 1, k1 = (tile >> 1) & 127, b = tile >> 8;
        ACC_DECL(2, acc); acc_zero(acc);
        gemm_accum<2>(acc, [&](int i) { return p.fa2 + (((size_t)b * 128 + k1) * 256 + cht * 128 + i) * 128; },
                      [&](int j) { return p.fWB + j * 128; }, 128, smc);
        ACC_FOR(2, row, col) {
            p.br[(size_t)(b * SEQ + k1 + 128 * col) * D + 768 + cht * 128 + row] = f2bf(AV(acc) * nrm);
        } ACC_END
    }
}


HD void ph_fourier_ctx(const Params& p, int bid, int nb, char* smc) {
    static_assert(CTXL % 128 == 0 || !FOURIER_GEMM, "context DFT GEMM needs CTXL % 128 == 0");
    const float nrm = 1.0f / sqrtf((float)CTXL * 64.0f);
    constexpr int MTc = CTXL / 128;
    for (int tile = bid; tile < NB * MTc * 2; tile += nb) {
        const int nt = tile & 1, mt = (tile >> 1) % MTc, b = tile / (2 * MTc);
        ACC_DECL(4, acc); acc_zero(acc);
        gemm_accum<4>(acc, [&](int i) { return p.fWC + (size_t)(mt * 128 + i) * (2 * CTXL); },
                      [&](int j) { return p.fXC + ((size_t)b * 256 + nt * 128 + j) * (2 * CTXL); }, 2 * CTXL, smc);
        ACC_FOR(4, row, col) { p.br[(size_t)(NLAT + b * CTXL + mt * 128 + row) * D + 768 + nt * 128 + col] = f2bf(AV(acc) * nrm); } ACC_END
    }
}
#ifndef CPU_EMU
struct ScanRegs { i32x4_t W[2], k[2]; unsigned u[4]; float g; };
HD bf16* scan_sp(const Params& p) { return p.h; }
HD bf16* scan_vn(const Params& p) { return p.h + (size_t)NUNIT * 4096; }
HD void ph_gdn_scan(const Params& p, int l, int bid, int nb, float* smf) {
    static_assert(NCH % 3 == 0, "scan ring assumes the chunk count is a multiple of 3");
    char* smc = (char*)smf;
    const int t = tid_(), lane = t & 63, w = t >> 6, fr = lane & 15, fg = lane >> 4;
    char* sST = smc + 24576; char* sVT = smc + 26624; char* sVS = smc + 28672; float* sG = (float*)(smc + 30720);
    const lds_cptr lds = (lds_cptr)smc;
    const int lkey = t >> 3, lc = t & 7;
    for (int cu = bid; cu < 2 * NB * 4 * 4; cu += nb) {
        const int chain = cu >> 2, cb = cu & 3;
        const ChunkInfo c0 = chunkinfo(chain * NCH);
        const int hd = c0.hd;
        auto issue = [&](ScanRegs& Rg, int n) {
            const int unit = chain * NCH + n;
            const ChunkInfo c = chunkinfo(unit);
            const bf16* wsrc = p.cW + (size_t)unit * 4096 + (16 * w + fr) * 64 + 8 * fg;
#pragma unroll
            for (int s_ = 0; s_ < 2; ++s_) {
                Rg.W[s_] = *(const i32x4_t*)(wsrc + 32 * s_);
                Rg.k[s_] = *(const i32x4_t*)(p.gq + (size_t)chunk_row(c, lkey + 32 * s_) * 768 + 256 + hd * 64 + lc * 8);
            }
#pragma unroll
            for (int r = 0; r < 4; ++r) Rg.u[r] = p.cU[(size_t)unit * 4096 + (16 * w + 4 * fg + r) * 64 + cb * 16 + fr];
            Rg.g = p.cG[(size_t)unit * 192 + (t < 192 ? t : 191)];
        };
        auto put_k = [&](const ScanRegs& Rg, int buf) {
#pragma unroll
            for (int s_ = 0; s_ < 2; ++s_) {
                const int ci = lkey + 32 * s_;
                const int fsw = ((ci >> 1) & 1) | (((ci >> 3) & 1) << 1);
                *(i32x4_t*)(smc + buf * 8192 + ci * 128 + (((((lc >> 1) ^ fsw) << 1) | (lc & 1)) << 4)) = Rg.k[s_];
            }
            if (t < 192) sG[buf * 192 + t] = Rg.g;
        };
        const int xe = (t >> 3) & 15, xc = (t & 7) ^ (xe & 7);
        const unsigned xsrc = xe * 128 + ((t & 7) << 4);
        const size_t xdst = (size_t)(cb * 16 + xe) * 64 + xc * 8;
        const unsigned c0o = ((fg) ^ (fr & 7)) << 4, c1o = ((4 + fg) ^ (fr & 7)) << 4;
        const unsigned bo0 = fr * 128 + c0o, bo1 = fr * 128 + c1o;
        const unsigned wofs = fr * 128 + ((((2 * w + (fg >> 1)) ^ (fr & 7))) << 4) + (fg & 1) * 8;
        unsigned ka[2][2];
#pragma unroll
        for (int s_ = 0; s_ < 2; ++s_)
#pragma unroll
            for (int h2 = 0; h2 < 2; ++h2) {
                const int cr = 32 * s_ + 8 * fg + (fr >> 2) + 4 * h2;
                const int fsw = ((cr >> 1) & 1) | (((cr >> 3) & 1) << 1);
                ka[s_][h2] = cr * 128 + (((((w ^ fsw) << 1) | ((fr & 3) >> 1))) << 4) + (fr & 1) * 8;
            }
        f32x4_t S = f32x4_t{0.f, 0.f, 0.f, 0.f};
        ScanRegs R0, R1, R2;
        __syncthreads();
        issue(R0, 0); issue(R1, 1);
        ((unsigned*)sST)[t] = 0u; ((unsigned*)sST)[t + 256] = 0u;
        put_k(R0, 0);
        __syncthreads();
#define SCAN_STEP(Rc, Rn, Rnn, nn, b)                                                                                                        \
        {                                                                                                                                    \
            const int n_ = (nn);                                                                                                             \
            issue(Rnn, (n_ + 2 < NCH) ? n_ + 2 : NCH - 1);                  \
            const float* g = sG + (b) * 192;                                                                                                 \
            const f32x4_t eD = *(const f32x4_t*)(g + 64 + 16 * w + 4 * fg);                                                                  \
            const float e63 = g[128];                                                                                                        \
            const bf16x8_t st0 = *(const bf16x8_t*)(sST + bo0), st1 = *(const bf16x8_t*)(sST + bo1);                                         \
            if (t < 128) *(uint4*)(scan_sp(p) + (size_t)(chain * NCH + n_) * 4096 + xdst) = *(const uint4*)(sST + xsrc);                     \
            f32x4_t v = __builtin_amdgcn_mfma_f32_16x16x32_bf16(__builtin_bit_cast(bf16x8_t, Rc.W[0]), st0, f32x4_t{0.f, 0.f, 0.f, 0.f}, 0, 0, 0); \
            v = __builtin_amdgcn_mfma_f32_16x16x32_bf16(__builtin_bit_cast(bf16x8_t, Rc.W[1]), st1, v, 0, 0, 0);                              \
            float vn[4];                                                                                                                     \
            _Pragma("unroll") for (int r = 0; r < 4; ++r) vn[r] = __uint_as_float(Rc.u[r] << 16) - v[r];                                     \
            { uint2 pk; pk.x = cvtpk(vn[0], vn[1]); pk.y = cvtpk(vn[2], vn[3]); *(uint2*)(sVT + wofs) = pk; }                                \
            { uint2 pk; pk.x = cvtpk(vn[0] * eD[0], vn[1] * eD[1]); pk.y = cvtpk(vn[2] * eD[2], vn[3] * eD[3]); *(uint2*)(sVS + wofs) = pk; }  \
            put_k(Rn, ((b) + 1) % 3);                                                                                                        \
            __syncthreads();                                                                                                                 \
            if (t >= 128) *(uint4*)(scan_vn(p) + (size_t)(chain * NCH + n_) * 4096 + xdst) = *(const uint4*)(sVT + xsrc);                    \
            const bf16x8_t vs0 = *(const bf16x8_t*)(sVS + bo0), vs1 = *(const bf16x8_t*)(sVS + bo1);                                         \
            const lds_cptr kb = lds + (b) * 8192;                                                                                            \
            const s16x4_t a00 = lds_tr16(kb + ka[0][0]), a01 = lds_tr16(kb + ka[0][1]);                                                      \
            const s16x4_t a10 = lds_tr16(kb + ka[1][0]), a11 = lds_tr16(kb + ka[1][1]);                                                      \
            f32x4_t dS = __builtin_amdgcn_mfma_f32_16x16x32_bf16(bf16x8_t{a00[0], a00[1], a00[2], a00[3], a01[0], a01[1], a01[2], a01[3]}, vs0, f32x4_t{0.f, 0.f, 0.f, 0.f}, 0, 0, 0); \
            dS = __builtin_amdgcn_mfma_f32_16x16x32_bf16(bf16x8_t{a10[0], a10[1], a10[2], a10[3], a11[0], a11[1], a11[2], a11[3]}, vs1, dS, 0, 0, 0); \
            _Pragma("unroll") for (int r = 0; r < 4; ++r) S[r] = S[r] * e63 + dS[r];                                                         \
            { uint2 pk; pk.x = cvtpk(S[0], S[1]); pk.y = cvtpk(S[2], S[3]); *(uint2*)(sST + wofs) = pk; }                                    \
            __syncthreads();                                                                                                                 \
        }
#pragma unroll 1
        for (int n = 0; n < NCH; n += 3) {
            SCAN_STEP(R0, R1, R2, n, 0)
            SCAN_STEP(R1, R2, R0, n + 1, 1)
            SCAN_STEP(R2, R0, R1, n + 2, 2)
        }
#undef SCAN_STEP
    }
}
HD void ph_gdn_outfin(const Params& p, int l, int bid, int nb, float* smf) {
    const int t = tid_(), lane = t & 63, w = t >> 6, fr = lane & 15, fg = lane >> 4;
    const float* og = p.in[I_ONORM] + l * 64;
    const int nlat = NB * 4 * NCL, nctx = (l == 0) ? NB * 4 * NCC : 0;
    float* so = smf;
    for (int u = bid; u < nlat + nctx; u += nb) {
        int b, hd, seg, nloc, ncs, T, base;
        if (u < nlat) { nloc = u % NCL; const int bh = u / NCL; hd = bh & 3; b = bh >> 2; seg = 0; ncs = NCL; T = SEQ; base = b * SEQ; }
        else { const int u2 = u - nlat; nloc = u2 % NCC; const int bh = u2 / NCC; hd = bh & 3; b = bh >> 2; seg = 1; ncs = NCC; T = CTXL; base = NLAT + b * CTXL; }
        __syncthreads();
#pragma unroll
        for (int dir = 0; dir < 2; ++dir) {
            const int nl = dir ? (ncs - 1 - nloc) : nloc;
            const int unit = ((dir * NB + b) * 4 + hd) * NCH + (seg ? nl : NCC + nl);
            const int ci = 16 * w + fr;
            const int pf = nl * 64 + ci; const int arow_ = base + (dir ? (T - 1 - pf) : pf);
            bf16x8_t qa[2], ka_[2];
#pragma unroll
            for (int s_ = 0; s_ < 2; ++s_) {
                qa[s_] = *(const bf16x8_t*)(p.gq + (size_t)arow_ * 768 + hd * 64 + 32 * s_ + 8 * fg);
                ka_[s_] = *(const bf16x8_t*)(p.cQK + (size_t)unit * 4096 + ci * 64 + 32 * s_ + 8 * fg);
            }
            const f32x4_t eG = *(const f32x4_t*)(p.cG + (size_t)unit * 192 + 16 * w + 4 * fg);
#pragma unroll
            for (int j = 0; j < 4; ++j) {
                const bf16* spr = scan_sp(p) + (size_t)unit * 4096 + (16 * j + fr) * 64 + 8 * fg;
                const bf16* vnr = scan_vn(p) + (size_t)unit * 4096 + (16 * j + fr) * 64 + 8 * fg;
                f32x4_t o1 = __builtin_amdgcn_mfma_f32_16x16x32_bf16(qa[0], *(const bf16x8_t*)(spr), f32x4_t{0.f, 0.f, 0.f, 0.f}, 0, 0, 0);
                o1 = __builtin_amdgcn_mfma_f32_16x16x32_bf16(qa[1], *(const bf16x8_t*)(spr + 32), o1, 0, 0, 0);
                f32x4_t o2 = __builtin_amdgcn_mfma_f32_16x16x32_bf16(ka_[0], *(const bf16x8_t*)(vnr), f32x4_t{0.f, 0.f, 0.f, 0.f}, 0, 0, 0);
                o2 = __builtin_amdgcn_mfma_f32_16x16x32_bf16(ka_[1], *(const bf16x8_t*)(vnr + 32), o2, 0, 0, 0);
#pragma unroll
                for (int r = 0; r < 4; ++r) {
                    const int cpos = 16 * w + 4 * fg + r;
                    const int tok = dir ? (63 - cpos) : cpos;
                    float* dst = so + tok * 65 + 16 * j + fr;
                    const float val = eG[r] * o1[r] + o2[r];
                    if (dir == 0) *dst = val; else *dst += val;
                }
            }
            __syncthreads();
        }
        {
            const int tok = t >> 2, q4 = t & 3;
            const int row = base + nloc * 64 + tok;
            float v[16]; float ss = 0.f;
#pragma unroll
            for (int c = 0; c < 16; ++c) { v[c] = so[tok * 65 + q4 * 16 + c]; ss += v[c] * v[c]; }
            ss += __shfl_xor(ss, 1); ss += __shfl_xor(ss, 2);
            const float rs = 1.0f / sqrtf(ss / 64.0f + 1e-6f);
            const uint4 z0 = *(const uint4*)(p.P + (size_t)row * PLD + C_Z + hd * 64 + q4 * 16), z1 = *(const uint4*)(p.P + (size_t)row * PLD + C_Z + hd * 64 + q4 * 16 + 8);
            const unsigned zz[8] = {z0.x, z0.y, z0.z, z0.w, z1.x, z1.y, z1.z, z1.w};
            unsigned pk[8];
#pragma unroll
            for (int c2 = 0; c2 < 8; ++c2) {
                const float za = __uint_as_float(zz[c2] << 16), zb = __uint_as_float(zz[c2] & 0xffff0000u);
                const float oa = v[2 * c2] * rs * og[q4 * 16 + 2 * c2] * siluf_(za), ob = v[2 * c2 + 1] * rs * og[q4 * 16 + 2 * c2 + 1] * siluf_(zb);
                pk[c2] = cvtpk(oa, ob);
            }
            uint4 p0, p1; p0.x = pk[0]; p0.y = pk[1]; p0.z = pk[2]; p0.w = pk[3]; p1.x = pk[4]; p1.y = pk[5]; p1.z = pk[6]; p1.w = pk[7];
            bf16* dstb = p.br + (size_t)row * D + 512 + hd * 64 + q4 * 16;
            *(uint4*)dstb = p0; *(uint4*)(dstb + 8) = p1;
        }
    }
}
#else
HD void ph_gdn_scan(const Params& p, int l, int bid, int nb, float* sm) {
    float* sQ = sm;
    float* sK = sm + 4096;
    bf16* sW = (bf16*)(sm + 8192);
    bf16* sQK = (bf16*)(sm + 10240);
    float* sS = sm + 12288;
    float* sV = sm + 13312;
    float* sU = sm + 14336;
    float* sG = sm + 15360;
    const int RQ = (l == 0) ? R : NLAT;
    for (int cu = bid; cu < 2 * NB * 4 * 4; cu += nb) {
        int chain = cu >> 2, cb = cu & 3;
        THREADS(t, 1024) { sS[t] = 0.f; }
        SYNC
        for (int n = 0; n < NCH; ++n) {
            int unit = chain * NCH + n;
            ChunkInfo c = chunkinfo(unit);
            THREADS(t, 64) { sG[t] = p.cG[(size_t)unit * 64 + t]; }
            SYNC
            THREADS(t, 4096) {
                int i = t >> 6, d = t & 63; int row = chunk_row(c, i);
                sW[t] = p.cW[(size_t)unit * 4096 + t];
                sQK[t] = p.cQK[(size_t)unit * 4096 + t];
                sQ[t] = bf2f(p.gq[(size_t)row * 768 + c.hd * 64 + d]) * expf(sG[i]);
                sK[t] = bf2f(p.gq[(size_t)row * 768 + 256 + c.hd * 64 + d]) * expf(sG[63] - sG[i]);
            }
            THREADS(t, 1024) { int i = t >> 4, e = t & 15; sU[t] = bf2f(p.cU[(size_t)unit * 4096 + i * 64 + cb * 16 + e]); }
            SYNC
            THREADS(t, 1024) {
                int i = t >> 4, e = t & 15;
                float acc = sU[t];
                for (int d = 0; d < 64; ++d) acc -= bf2f(sW[i * 64 + d]) * sS[d * 16 + e];
                sV[t] = acc;
            }
            SYNC
            THREADS(t, 1024) {
                int i = t >> 4, e = t & 15;
                float acc = 0.f;
                for (int d = 0; d < 64; ++d) acc += sQ[i * 64 + d] * sS[d * 16 + e];
                for (int j = 0; j < 64; ++j) acc += bf2f(sQK[i * 64 + j]) * sV[j * 16 + e];
                int row = chunk_row(c, i);
                if (row < RQ) p.odir[((size_t)c.dir * R + row) * 256 + c.hd * 64 + cb * 16 + e] = f2bf(acc);
            }
            SYNC
            THREADS(t, 1024) {
                int d = t >> 4, e = t & 15;
                float acc = sS[t] * expf(sG[63]);
                for (int i = 0; i < 64; ++i) acc += sK[i * 64 + d] * sV[i * 16 + e];
                sS[t] = acc;
            }
            SYNC
        }
    }
}

#endif

#ifndef CPU_EMU
HD void ph_gdn_fin(const Params& p, int l, int bid, int nb) {
    const int RQ = (l == 0) ? R : NLAT;
    const float* og = p.in[I_ONORM] + l * 64;
    const int N = RQ * 32;
    for (int idx = bid * 256 + tid_(); idx < N; idx += nb * 256) {
        const int r = idx >> 5, q = idx & 31; const int hd = q >> 3, cg = q & 7;
        const uint4 a0 = *(const uint4*)(p.odir + (size_t)r * 256 + hd * 64 + cg * 8);
        const uint4 a1 = *(const uint4*)(p.odir + ((size_t)R + r) * 256 + hd * 64 + cg * 8);
        const uint4 zz = *(const uint4*)(p.P + (size_t)r * PLD + C_Z + hd * 64 + cg * 8);
        float v[8], z[8];
        v[0] = __uint_as_float(a0.x << 16) + __uint_as_float(a1.x << 16); v[1] = __uint_as_float(a0.x & 0xffff0000u) + __uint_as_float(a1.x & 0xffff0000u);
        v[2] = __uint_as_float(a0.y << 16) + __uint_as_float(a1.y << 16); v[3] = __uint_as_float(a0.y & 0xffff0000u) + __uint_as_float(a1.y & 0xffff0000u);
        v[4] = __uint_as_float(a0.z << 16) + __uint_as_float(a1.z << 16); v[5] = __uint_as_float(a0.z & 0xffff0000u) + __uint_as_float(a1.z & 0xffff0000u);
        v[6] = __uint_as_float(a0.w << 16) + __uint_as_float(a1.w << 16); v[7] = __uint_as_float(a0.w & 0xffff0000u) + __uint_as_float(a1.w & 0xffff0000u);
        z[0] = __uint_as_float(zz.x << 16); z[1] = __uint_as_float(zz.x & 0xffff0000u); z[2] = __uint_as_float(zz.y << 16); z[3] = __uint_as_float(zz.y & 0xffff0000u);
        z[4] = __uint_as_float(zz.z << 16); z[5] = __uint_as_float(zz.z & 0xffff0000u); z[6] = __uint_as_float(zz.w << 16); z[7] = __uint_as_float(zz.w & 0xffff0000u);
        float ss = 0.f;
#pragma unroll
        for (int c = 0; c < 8; ++c) ss += v[c] * v[c];
        ss += __shfl_xor(ss, 1); ss += __shfl_xor(ss, 2); ss += __shfl_xor(ss, 4);
        const float rs = 1.0f / sqrtf(ss / 64.0f + 1e-6f);
        float o[8];
#pragma unroll
        for (int c = 0; c < 8; ++c) o[c] = v[c] * rs * og[cg * 8 + c] * siluf_(z[c]);
        uint4 pk; pk.x = cvtpk(o[0], o[1]); pk.y = cvtpk(o[2], o[3]); pk.z = cvtpk(o[4], o[5]); pk.w = cvtpk(o[6], o[7]);
        *(uint4*)(p.br + (size_t)r * D + 512 + hd * 64 + cg * 8) = pk;
    }
}
#else
HD void ph_gdn_fin(const Params& p, int l, int bid, int nb) {
    const int RQ = (l == 0) ? R : NLAT;
    const float* og = p.in[I_ONORM] + l * 64;
    const int N = RQ * 4;
    for (int u = bid; u < (N + 255) / 256; u += nb) {
        THREADS(t, 256) {
            int idx = u * 256 + t;
            if (idx < N) {
                int r = idx >> 2, hd = idx & 3;
                const bf16* o0 = p.odir + (size_t)r * 256 + hd * 64;
                const bf16* o1 = p.odir + ((size_t)R + r) * 256 + hd * 64;
                float ss = 0.f;
                for (int d = 0; d < 64; ++d) { float v = bf2f(o0[d]) + bf2f(o1[d]); ss += v * v; }
                float rs = 1.0f / sqrtf(ss / 64.0f + 1e-6f);
                for (int d = 0; d < 64; ++d) {
                    float v = (bf2f(o0[d]) + bf2f(o1[d])) * rs * og[d];
                    float z = bf2f(p.P[(size_t)r * PLD + C_Z + hd * 64 + d]);
                    p.br[(size_t)r * D + 512 + hd * 64 + d] = f2bf(v * siluf_(z));
                }
            }
        }
    }
}

#endif

#ifndef CPU_EMU
template <int NJ>
HD void merge_tile(const Params& p, int l, int mt, int nt, char* smc) {
    constexpr int NW = 32 * NJ;
    const bf16* Wg = p.wt_in + (size_t)l * WIN_NP * D + (size_t)PLD * D;
    const bf16* Wb = p.wt_br + (size_t)l * 4 * D * 256;
    AccT<NJ> accM; acc_zero(accM);
    const unsigned char* h8 = (const unsigned char*)h8_of(p);
    auto aG = [&](int r) { return (const void*)(h8 + (size_t)(mt * 128 + r) * D); };
    int cur = 0;
    __syncthreads();
    gemm_stage0<NJ>(aG, [&](int j) { return (const void*)((const unsigned char*)Wg + (size_t)(nt * NW + j) * D); }, 1, smc, 0);
#pragma unroll 1
    for (int i = 0; i < 4; ++i) {
        AccT<NJ> acc; acc_zero(acc);
        auto bG = [&](int j) { return (const void*)((const unsigned char*)Wg + (size_t)(i * 1024 + nt * NW + j) * D); };
        auto aP = [&](int r) { return (const void*)(p.br + (size_t)(mt * 128 + r) * D + i * 256); };
        auto bP = [&](int j) { return (const void*)(Wb + ((size_t)i * D + nt * NW + j) * 256); };
        gemm_chain<NJ, true>(acc, aG, bG, D, smc, cur, [&](int buf) { gemm_stage0<NJ>(aP, bP, 2, smc, buf); }, SC_H, SC_W);
        unsigned sg[4][NJ][2];
#pragma unroll
        for (int a_ = 0; a_ < 4; ++a_)
#pragma unroll
            for (int b_ = 0; b_ < NJ; ++b_) {
                float e[4];
#pragma unroll
                for (int r = 0; r < 4; ++r) e[r] = __builtin_amdgcn_rcpf(1.0f + __expf(-acc.v[a_][b_][r]));
                sg[a_][b_][0] = cvtpk(e[0], e[1]); sg[a_][b_][1] = cvtpk(e[2], e[3]);
            }
        acc_zero(acc);
        auto bGn = [&](int j) { return (const void*)((const unsigned char*)Wg + (size_t)((i + 1) * 1024 + nt * NW + j) * D); };
        gemm_chain<NJ, false>(acc, aP, bP, 256, smc, cur, [&](int buf) { if (i < 3) gemm_stage0<NJ>(aG, bGn, 1, smc, buf); }, 0, 0);
#pragma unroll
        for (int a_ = 0; a_ < 4; ++a_)
#pragma unroll
            for (int b_ = 0; b_ < NJ; ++b_) {
                accM.v[a_][b_][0] += __uint_as_float(sg[a_][b_][0] << 16) * acc.v[a_][b_][0];
                accM.v[a_][b_][1] += __uint_as_float(sg[a_][b_][0] & 0xffff0000u) * acc.v[a_][b_][1];
                accM.v[a_][b_][2] += __uint_as_float(sg[a_][b_][1] << 16) * acc.v[a_][b_][2];
                accM.v[a_][b_][3] += __uint_as_float(sg[a_][b_][1] & 0xffff0000u) * acc.v[a_][b_][3];
            }
    }
    __syncthreads();
    float* tl = (float*)smc;
    acc_to_lds<NJ>(accM, tl);
    __syncthreads();
    const int t_ = tid_(); const int row = t_ >> 1, half = t_ & 1;
    constexpr int LD = NW + 4, HW = NW / 2;
    bf16* dst = p.mg + (size_t)(mt * 128 + row) * D + nt * NW + half * HW;
#pragma unroll
    for (int q = 0; q < HW / 8; ++q) {
        const f32x4_t a = *(const f32x4_t*)(tl + row * LD + half * HW + q * 8), b = *(const f32x4_t*)(tl + row * LD + half * HW + q * 8 + 4);
        uint4 pk; pk.x = cvtpk(a[0], a[1]); pk.y = cvtpk(a[2], a[3]); pk.z = cvtpk(b[0], b[1]); pk.w = cvtpk(b[2], b[3]);
        *(uint4*)(dst + q * 8) = pk;
    }
}
HD void ph_merge(const Params& p, int l, int bid, int nb, char* smc) {
    constexpr int MTL = NLAT / 128, MTC = NCTX / 128;
    const int nfull = MTL * 8, nhalf = (l == 0) ? MTC * 16 : 0;
    for (int tile = bid; tile < nfull + nhalf; tile += nb) {
        if (tile < nfull) merge_tile<4>(p, l, tile >> 3, tile & 7, smc);
        else { const int t2 = tile - nfull; merge_tile<2>(p, l, MTL + (t2 >> 4), t2 & 15, smc); }
    }
}
#else
HD void ph_merge(const Params& p, int l, int bid, int nb, char* smc) {
    const int MT = ((l == 0) ? R : NLAT) / 128;
    const bf16* Wg = p.wt_in + (size_t)l * WIN_NP * D + (size_t)PLD * D;
    const bf16* Wb = p.wt_br + (size_t)l * 4 * D * 256;
    for (int tile = bid; tile < MT * 16; tile += nb) {
        const int mt = tile >> 4, nt = tile & 15;
        ACC_DECL(2, accM); acc_zero(accM);
        for (int i = 0; i < 4; ++i) {
            ACC_DECL(2, accG); acc_zero(accG);
            ACC_DECL(2, accP); acc_zero(accP);
            gemm_accum<2>(accG, [&](int r) { return p.h + (size_t)(mt * 128 + r) * D; },
                          [&](int j) { return Wg + (size_t)(i * 1024 + nt * 64 + j) * D; }, D, smc);
            gemm_accum<2>(accP, [&](int r) { return p.br + (size_t)(mt * 128 + r) * D + i * 256; },
                          [&](int j) { return Wb + ((size_t)i * D + nt * 64 + j) * 256; }, 256, smc);
            ACC_FOR(2, row, col) { AV(accM) += sigmoidf_(AV(accG)) * AV(accP); } ACC_END
        }
#ifndef CPU_EMU
        {
            float* tl = (float*)smc;
            acc_to_lds<2>(accM, tl);
            __syncthreads();
            const int t_ = tid_(); const int row = t_ >> 1, half = t_ & 1;
            bf16* dst = p.mg + (size_t)(mt * 128 + row) * D + nt * 64 + half * 32;
#pragma unroll
            for (int q = 0; q < 4; ++q) {
                const f32x4_t a = *(const f32x4_t*)(tl + row * 68 + half * 32 + q * 8), b = *(const f32x4_t*)(tl + row * 68 + half * 32 + q * 8 + 4);
                uint4 pk; pk.x = cvtpk(a[0], a[1]); pk.y = cvtpk(a[2], a[3]); pk.z = cvtpk(b[0], b[1]); pk.w = cvtpk(b[2], b[3]);
                *(uint4*)(dst + q * 8) = pk;
            }
        }
#else
        ACC_FOR(2, row, col) { p.mg[(size_t)(mt * 128 + row) * D + nt * 64 + col] = f2bf(AV(accM)); } ACC_END
#endif
    }
}

#endif

template <int DRY> HD void ph_outproj_t(const Params& p, int l, int bid, int nb, char* smc) {
    const int MT = ((l == 0) ? R : NLAT) / 128;
    const bf16* Wt = p.wt_out + (size_t)l * D * D;
#ifndef CPU_EMU
    constexpr int MTL_ = NLAT / 128;
    const int nfull_ = MTL_ * 8, nhalf_ = (MT - MTL_) * 16;
    for (int tile = bid + nfull_; tile < nfull_ + nhalf_; tile += nb) {
        const int t2 = tile - nfull_; const int mt = MTL_ + (t2 >> 4), nt = t2 & 15;
        AccT<2> acc; acc_zero(acc);
        gemm_accum<2>(acc, [&](int r) { return p.mg + (size_t)(mt * 128 + r) * D; }, [&](int j) { return Wt + (size_t)(nt * 64 + j) * D; }, D, smc);
        float* tl = (float*)smc;
        acc_to_lds<2>(acc, tl);
        __syncthreads();
        const int t_ = tid_(); const int row = t_ >> 1, half = t_ & 1;
        const int r = mt * 128 + row, c0 = nt * 64 + half * 32;
        const float* xi = xrow_in(p, l, r) + c0; float* xo = (DRY ? ((float*)p.Y + (size_t)r * D) : xrow_out(p, r)) + c0; const float* gm = modrow(p, l, r) + 2048 + c0;
#pragma unroll
        for (int q = 0; q < 8; ++q) {
            const f32x4_t a = *(const f32x4_t*)(tl + row * 68 + half * 32 + q * 4), xv = *(const f32x4_t*)(xi + q * 4), gv = *(const f32x4_t*)(gm + q * 4);
            f32x4_t o; o[0] = xv[0] + gv[0] * a[0]; o[1] = xv[1] + gv[1] * a[1]; o[2] = xv[2] + gv[2] * a[2]; o[3] = xv[3] + gv[3] * a[3];
            *(f32x4_t*)(xo + q * 4) = o;
        }
        __syncthreads();
    }
    const int MTF = MTL_;
#else
    const int MTF = MT;
#endif
    for (int tile = bid; tile < MTF * 8; tile += nb) {
        const int mt = tile >> 3, nt = tile & 7;
        ACC_DECL(4, acc); acc_zero(acc);
        gemm_accum<4>(acc, [&](int r) { return p.mg + (size_t)(mt * 128 + r) * D; }, [&](int j) { return Wt + (size_t)(nt * 128 + j) * D; }, D, smc);
#ifndef CPU_EMU
        {
            float* tl = (float*)smc;
            acc_to_lds<4>(acc, tl);
            __syncthreads();
            const int t_ = tid_(); const int row = t_ >> 1, half = t_ & 1;
            const int r = mt * 128 + row, c0 = nt * 128 + half * 64;
            const float* xi = xrow_in(p, l, r) + c0; float* xo = (DRY ? ((float*)p.Y + (size_t)r * D) : xrow_out(p, r)) + c0; const float* gm = modrow(p, l, r) + 2048 + c0;
#pragma unroll
            for (int q = 0; q < 16; ++q) {
                const f32x4_t a = *(const f32x4_t*)(tl + row * 132 + half * 64 + q * 4), xv = *(const f32x4_t*)(xi + q * 4), gv = *(const f32x4_t*)(gm + q * 4);
                f32x4_t o; o[0] = xv[0] + gv[0] * a[0]; o[1] = xv[1] + gv[1] * a[1]; o[2] = xv[2] + gv[2] * a[2]; o[3] = xv[3] + gv[3] * a[3];
                *(f32x4_t*)(xo + q * 4) = o;
            }
        }
#else
        ACC_FOR(4, row, col) {
            const int r = mt * 128 + row, c = nt * 128 + col;
            xrow_out(p, r)[c] = xrow_in(p, l, r)[c] + modrow(p, l, r)[2048 + c] * AV(acc);
        } ACC_END
#endif
    }
}

HD void ph_outproj(const Params& p, int l, int bid, int nb, char* smc) { ph_outproj_t<0>(p, l, bid, nb, smc); }
#ifndef CPU_EMU
template <int DRY> HD void ph_router_t(const Params& p, int l, int bid, int nb, float* smf) {
    char* smc = (char*)smf;
    const int t = tid_(), lane = t & 63, w = t >> 6, fr = lane & 15, fg = lane >> 4;
    const int RQ = (l == 0) ? R : NLAT;
    const float* gN = p.in[I_N2G] + l * D;
    constexpr int WST = 2080;
    float* lgw = (float*)(smc + 66560) + w * (16 * 17);
    int* lcnt = (int*)(smc + 70912); int* gbase = (int*)(smc + 70976);
    __syncthreads();
    for (int k = t; k < 1024; k += 256) {
        const float* wrow = p.in[I_WROUTER] + k * 16;
#pragma unroll
        for (int e = 0; e < 16; ++e) {
            const float v = wrow[e]; const bf16 hi = f2bf(v);
            *(bf16*)(smc + e * WST + k * 2) = hi; *(bf16*)(smc + 33280 + e * WST + k * 2) = f2bf(v - bf2f(hi));
        }
    }
    const int ngroups = RQ / 16;
    for (int g0 = bid * 4; g0 < ngroups; g0 += nb * 4) {
        __syncthreads();
        if (t < 16) lcnt[t] = 0;
        __syncthreads();
        const int gidx = g0 + w;
        const bool active = gidx < ngroups;
        int e1 = 0, e2 = 0, q1 = 0, q2 = 0; const int rsel = gidx * 16 + lane;
        if (active) {
            const int r = gidx * 16 + fr;
            const float* x = xrow_out(p, r);
            const float* m = modrow(p, l, r);
            float ss = 0.f;
#pragma unroll 4
            for (int s_ = 0; s_ < 32; ++s_) {
                const f32x4_t a = *(const f32x4_t*)(x + s_ * 32 + fg * 8), b = *(const f32x4_t*)(x + s_ * 32 + fg * 8 + 4);
                ss += a[0] * a[0] + a[1] * a[1] + a[2] * a[2] + a[3] * a[3] + b[0] * b[0] + b[1] * b[1] + b[2] * b[2] + b[3] * b[3];
            }
            ss += __shfl_xor(ss, 16); ss += __shfl_xor(ss, 32);
            const float rs = 1.0f / sqrtf(ss / D + 1e-6f);
            f32x4_t acc = f32x4_t{0.f, 0.f, 0.f, 0.f};
#pragma unroll 2
            for (int s_ = 0; s_ < 32; ++s_) {
                const int k0 = s_ * 32 + fg * 8;
                float hv[8];
#pragma unroll
                for (int hh = 0; hh < 2; ++hh) {
                    const f32x4_t xv = *(const f32x4_t*)(x + k0 + hh * 4), gv = *(const f32x4_t*)(gN + k0 + hh * 4);
                    const f32x4_t sc = *(const f32x4_t*)(m + 4096 + k0 + hh * 4), sh = *(const f32x4_t*)(m + 3072 + k0 + hh * 4);
#pragma unroll
                    for (int q = 0; q < 4; ++q) hv[hh * 4 + q] = xv[q] * rs * gv[q] * (1.0f + sc[q]) + sh[q];
                }
                unsigned hi[4], lo[4];
#pragma unroll
                for (int q = 0; q < 4; ++q) {
                    hi[q] = cvtpk(hv[2 * q], hv[2 * q + 1]);
                    lo[q] = cvtpk(hv[2 * q] - __uint_as_float(hi[q] << 16), hv[2 * q + 1] - __uint_as_float(hi[q] & 0xffff0000u));
                }
                const i32x4_t hiv = i32x4_t{(int)hi[0], (int)hi[1], (int)hi[2], (int)hi[3]}, lov = i32x4_t{(int)lo[0], (int)lo[1], (int)lo[2], (int)lo[3]};
                { uint2 q8; q8.x = pack_fp8x4(hv[0] * 4.f, hv[1] * 4.f, hv[2] * 4.f, hv[3] * 4.f); q8.y = pack_fp8x4(hv[4] * 4.f, hv[5] * 4.f, hv[6] * 4.f, hv[7] * 4.f);
                  *(uint2*)(h8_of(p) + (size_t)r * D + k0) = q8; }
                const bf16x8_t bh = *(const bf16x8_t*)(smc + fr * WST + s_ * 64 + fg * 16), bl = *(const bf16x8_t*)(smc + 33280 + fr * WST + s_ * 64 + fg * 16);
                acc = __builtin_amdgcn_mfma_f32_16x16x32_bf16(__builtin_bit_cast(bf16x8_t, hiv), bh, acc, 0, 0, 0);
                acc = __builtin_amdgcn_mfma_f32_16x16x32_bf16(__builtin_bit_cast(bf16x8_t, hiv), bl, acc, 0, 0, 0);
                acc = __builtin_amdgcn_mfma_f32_16x16x32_bf16(__builtin_bit_cast(bf16x8_t, lov), bh, acc, 0, 0, 0);
            }
#pragma unroll
            for (int q = 0; q < 4; ++q) lgw[(4 * fg + q) * 17 + fr] = acc[q];
            if (lane < 16) {
                float sc[16], sel[16];
#pragma unroll
                for (int e = 0; e < 16; ++e) { sc[e] = sigmoidf_(lgw[lane * 17 + e]); sel[e] = sc[e] + p.in[I_RBIAS][e]; }
                int best = 0; float bestv = -1e30f;
#pragma unroll
                for (int gph = 0; gph < 4; ++gph) {
                    float t1 = -1e30f, t2 = -1e30f;
#pragma unroll
                    for (int j = 0; j < 4; ++j) { const float v = sel[gph * 4 + j]; if (v > t1) { t2 = t1; t1 = v; } else if (v > t2) t2 = v; }
                    const float gs = t1 + t2;
                    if (gs > bestv) { bestv = gs; best = gph; }
                }
                float v1 = -1e30f, v2 = -1e30f, w1 = 0.f, w2 = 0.f; int i1 = 0, i2 = 0;
#pragma unroll
                for (int e = 0; e < 16; ++e) {
                    if ((e >> 2) == best) {
                        const float v = sel[e];
                        if (v > v1) { v2 = v1; i2 = i1; w2 = w1; v1 = v; i1 = e; w1 = sc[e]; } else if (v > v2) { v2 = v; i2 = e; w2 = sc[e]; }
                    }
                }
                e1 = i1; e2 = i2;
                const float ws_ = w1 + w2;
                p.sel_e[rsel * 2] = i1; p.sel_e[rsel * 2 + 1] = i2;
                p.sel_w[rsel * 2] = w1 / ws_; p.sel_w[rsel * 2 + 1] = w2 / ws_;
                q1 = atomicAdd(&lcnt[i1], 1); q2 = atomicAdd(&lcnt[i2], 1);
            }
        }
        __syncthreads();
        if (t < 16) { const int c = lcnt[t]; gbase[t] = (c && !DRY) ? atomicAdd(&p.cnt[l * 16 + t], c) : 0; }
        __syncthreads();
        if (active && lane < 16 && !DRY) {
            const int p1 = gbase[e1] + q1, p2 = gbase[e2] + q2;
            p.elist[(size_t)e1 * 2 * R + p1] = rsel * 2; p.apos[rsel * 2] = p1;
            p.elist[(size_t)e2 * 2 * R + p2] = rsel * 2 + 1; p.apos[rsel * 2 + 1] = p2;
        }
    }
}
HD void ph_router(const Params& p, int l, int bid, int nb, float* smf) { ph_router_t<0>(p, l, bid, nb, smf); }
#else
HD void ph_router(const Params& p, int l, int bid, int nb, float* sm) {
    const int RQ = (l == 0) ? R : NLAT;
    const float* g = p.in[I_N2G] + l * D;
    const float* wr = p.in[I_WROUTER];
    float* sh = sm + 512;
    float* sl = sm + 2048;
    for (int r = bid; r < RQ; r += nb) {
        const float* x = xrow_out(p, r);
        const float* m = modrow(p, l, r);
        THREADS(t, 256) { float s = 0.f; for (int k = t; k < D; k += 256) s += x[k] * x[k]; sm[t] = s; }
        SYNC
        THREADS(t, 1) { float s = 0.f; for (int i = 0; i < 256; ++i) s += sm[i]; sm[256] = s; }
        SYNC
        THREADS(t, 256) {
            float rs = 1.0f / sqrtf(sm[256] / D + 1e-6f);
            for (int k = t; k < D; k += 256) {
                float v = x[k] * rs * g[k];
                v = v * (1.0f + m[4096 + k]) + m[3072 + k];
                sh[k] = v;
                p.h[(size_t)r * D + k] = f2bf(v);
            }
        }
        SYNC
        THREADS(t, 256) {
            int e = t & 15, ks = t >> 4;
            float acc = 0.f;
            for (int k = ks * 64; k < ks * 64 + 64; ++k) acc += sh[k] * wr[k * 16 + e];
            sl[ks * 16 + e] = acc;
        }
        SYNC
        THREADS(t, 1) {
            float* sc = sm + 2304; float* sel = sm + 2320;
            for (int e = 0; e < 16; ++e) {
                float acc = 0.f;
                for (int ks = 0; ks < 16; ++ks) acc += sl[ks * 16 + e];
                sc[e] = sigmoidf_(acc); sel[e] = sc[e] + p.in[I_RBIAS][e];
            }
            int best = 0; float bestv = -1e30f;
            for (int gph = 0; gph < 4; ++gph) {
                float t1 = -1e30f, t2 = -1e30f;
                for (int j = 0; j < 4; ++j) { float v = sel[gph * 4 + j]; if (v > t1) { t2 = t1; t1 = v; } else if (v > t2) t2 = v; }
                float gs = t1 + t2;
                if (gs > bestv) { bestv = gs; best = gph; }
            }
            int i1 = -1, i2 = -1; float v1 = -1e30f, v2 = -1e30f;
            for (int j = 0; j < 4; ++j) {
                float v = sel[best * 4 + j];
                if (v > v1) { v2 = v1; i2 = i1; v1 = v; i1 = best * 4 + j; } else if (v > v2) { v2 = v; i2 = best * 4 + j; }
            }
            float w1 = sc[i1], w2 = sc[i2], ws = w1 + w2;
            p.sel_e[r * 2] = i1; p.sel_e[r * 2 + 1] = i2;
            p.sel_w[r * 2] = w1 / ws; p.sel_w[r * 2 + 1] = w2 / ws;
            int q1 = ATOMIC_ADD_RET(&p.cnt[l * 16 + i1], 1); p.elist[(size_t)i1 * 2 * R + q1] = r * 2; p.apos[r * 2] = q1;
            int q2 = ATOMIC_ADD_RET(&p.cnt[l * 16 + i2], 1); p.elist[(size_t)i2 * 2 * R + q2] = r * 2 + 1; p.apos[r * 2 + 1] = q2;
        }
        SYNC
    }
}

#endif

struct MoeTiles { int tstart[17]; };
HD MoeTiles moe_tiles(const Params& p, int l) {
    MoeTiles m; int acc = 0;
    for (int e = 0; e < 16; ++e) { m.tstart[e] = acc; acc += (p.cnt[l * 16 + e] + 127) >> 7; }
    m.tstart[16] = acc; return m;
}

HD void ph_ffn1(const Params& p, int l, int bid, int nb, char* smc) {
    int tstart[17];
    { int acc = 0; for (int e = 0; e < 16; ++e) { tstart[e] = acc; acc += (p.cnt[l * 16 + e] + 127) >> 7; } tstart[16] = acc; }
    const int ntiles = tstart[16];
    for (int tile = bid; tile < ntiles * 8; tile += nb) {
        const int rt = tile >> 3, nt = tile & 7;
        int e = 0, ts = 0;
#pragma unroll
        for (int q = 1; q < 16; ++q) if (rt >= tstart[q]) { e = q; ts = tstart[q]; }
        const int mt = rt - ts;
        const int cnt_e = p.cnt[l * 16 + e];
        const int* el = p.elist + (size_t)e * 2 * R;
#ifndef CPU_EMU
        const unsigned char* Wt8 = gu8_of(p) + (size_t)e * 1024 * D;
        AccT<4> acc; acc_zero(acc);
        gemm_accum8<4>(acc, [&](int i) { int q = mt * 128 + i; int a = (q < cnt_e) ? el[q] : el[0]; return (const unsigned char*)h8_of(p) + (size_t)(a >> 1) * D; },
                       [&](int j) { return Wt8 + (size_t)(nt * 128 + j) * D; }, D, smc, SC_H, SC_W);
        {
            float* tl = (float*)smc;
            acc_to_lds<4>(acc, tl);
            __syncthreads();
            const int t_ = tid_(); const int row = t_ >> 1, half = t_ & 1;
            unsigned char* dst = (unsigned char*)p.act + (size_t)(rt * 128 + row) * 512 + nt * 64 + half * 32;
#pragma unroll
            for (int q = 0; q < 2; ++q) {
                float o[16];
#pragma unroll
                for (int c4 = 0; c4 < 4; ++c4) {
                    const f32x4_t gv = *(const f32x4_t*)(tl + row * 132 + half * 64 + q * 32 + c4 * 4), uv = *(const f32x4_t*)(tl + row * 132 + half * 64 + q * 32 + 16 + c4 * 4);
#pragma unroll
                    for (int e_ = 0; e_ < 4; ++e_) o[c4 * 4 + e_] = gv[e_] / (1.0f + __expf(-gv[e_])) * uv[e_] * 16.0f;
                }
                uint4 pk; pk.x = pack_fp8x4(o[0], o[1], o[2], o[3]); pk.y = pack_fp8x4(o[4], o[5], o[6], o[7]);
                pk.z = pack_fp8x4(o[8], o[9], o[10], o[11]); pk.w = pack_fp8x4(o[12], o[13], o[14], o[15]);
                *(uint4*)(dst + q * 16) = pk;
            }
        }
#else
        const bf16* Wt = p.wt_gu + (size_t)e * 1024 * D;
        ACC_DECL(4, acc); acc_zero(acc);
        gemm_accum<4>(acc, [&](int i) { int q = mt * 128 + i; int a = (q < cnt_e) ? el[q] : el[0]; return p.h + (size_t)(a >> 1) * D; },
                      [&](int j) { return Wt + (size_t)(nt * 128 + j) * D; }, D, smc);
        ACC_FOR_PAIR(row, pcol) {
            float gv = AV_G(acc), uv = AV_U(acc);
            p.act[(size_t)(rt * 128 + row) * 512 + nt * 64 + pcol] = f2bf(siluf_(gv) * uv);
        } ACC_END
#endif
    }
}

HD void ph_ffn2(const Params& p, int l, int bid, int nb, char* smc) {
    int tstart[17];
    { int acc = 0; for (int e = 0; e < 16; ++e) { tstart[e] = acc; acc += (p.cnt[l * 16 + e] + 127) >> 7; } tstart[16] = acc; }
    const int ntiles = tstart[16];
    for (int tile = bid; tile < ntiles * 8; tile += nb) {
        const int rt = tile >> 3, nt = tile & 7;
        int e = 0;
#pragma unroll
        for (int q = 1; q < 16; ++q) if (rt >= tstart[q]) e = q;
#ifndef CPU_EMU
        const unsigned char* Wt8 = d8_of(p) + (size_t)e * D * 512;
        AccT<4> acc; acc_zero(acc);
        gemm_accum8<4>(acc, [&](int i) { return (const unsigned char*)p.act + (size_t)(rt * 128 + i) * 512; }, [&](int j) { return Wt8 + (size_t)(nt * 128 + j) * 512; }, 512, smc, SC_ACT, SC_W);
#else
        const bf16* Wt = p.wt_d + (size_t)e * D * 512;
        ACC_DECL(4, acc); acc_zero(acc);
        gemm_accum<4>(acc, [&](int i) { return p.act + (size_t)(rt * 128 + i) * 512; }, [&](int j) { return Wt + (size_t)(nt * 128 + j) * 512; }, 512, smc);
#endif
#ifndef CPU_EMU
        {
            float* tl = (float*)smc;
            acc_to_lds<4>(acc, tl);
            __syncthreads();
            const int t_ = tid_(); const int row = t_ >> 1, half = t_ & 1;
            bf16* dst = p.Y + (size_t)(rt * 128 + row) * D + nt * 128 + half * 64;
#pragma unroll
            for (int q = 0; q < 8; ++q) {
                const f32x4_t a = *(const f32x4_t*)(tl + row * 132 + half * 64 + q * 8), b = *(const f32x4_t*)(tl + row * 132 + half * 64 + q * 8 + 4);
                uint4 pk; pk.x = cvtpk(a[0], a[1]); pk.y = cvtpk(a[2], a[3]); pk.z = cvtpk(b[0], b[1]); pk.w = cvtpk(b[2], b[3]);
                *(uint4*)(dst + q * 8) = pk;
            }
        }
#else
        ACC_FOR(4, row, col) { p.Y[(size_t)(rt * 128 + row) * D + nt * 128 + col] = f2bf(AV(acc)); } ACC_END
#endif
    }
}

#ifndef CPU_EMU
template <int DRY> HD void ph_combine_t(const Params& p, int l, int bid, int nb) {
    const int RQ = (l == 0) ? R : NLAT;
    const int t = tid_(), lane = t & 63, w = t >> 6;
    int tstart[17];
    { int acc = 0;
#pragma unroll
      for (int e = 0; e < 16; ++e) { tstart[e] = acc; acc += (p.cnt[l * 16 + e] + 127) >> 7; } tstart[16] = acc; }
    for (int r = bid * 4 + w; r < RQ; r += nb * 4) {
        float* xo = xrow_out(p, r);
        const float* m = modrow(p, l, r) + 5120;
        const int e0 = p.sel_e[r * 2], e1 = p.sel_e[r * 2 + 1];
        int t0 = 0, t1 = 0;
#pragma unroll
        for (int q = 0; q < 16; ++q) { if (q == e0) t0 = tstart[q]; if (q == e1) t1 = tstart[q]; }
        const bf16* y0 = p.Y + (size_t)(t0 * 128 + p.apos[r * 2]) * D;
        const bf16* y1 = p.Y + (size_t)(t1 * 128 + p.apos[r * 2 + 1]) * D;
        const float w0 = p.sel_w[r * 2], w1 = p.sel_w[r * 2 + 1];
        f32x4_t xs[4]; float ss = 0.f;
#pragma unroll
        for (int j = 0; j < 4; ++j) {
            const int k = j * 256 + lane * 4;
            f32x4_t xv = *(const f32x4_t*)(xo + k);
            const f32x4_t gv = *(const f32x4_t*)(m + k);
            const uint2 a = *(const uint2*)(y0 + k), b = *(const uint2*)(y1 + k);
            xv[0] += gv[0] * (w0 * __uint_as_float(a.x << 16) + w1 * __uint_as_float(b.x << 16));
            xv[1] += gv[1] * (w0 * __uint_as_float(a.x & 0xffff0000u) + w1 * __uint_as_float(b.x & 0xffff0000u));
            xv[2] += gv[2] * (w0 * __uint_as_float(a.y << 16) + w1 * __uint_as_float(b.y << 16));
            xv[3] += gv[3] * (w0 * __uint_as_float(a.y & 0xffff0000u) + w1 * __uint_as_float(b.y & 0xffff0000u));
            *(f32x4_t*)((DRY ? (float*)p.gq + (size_t)r * 64 : xo) + (DRY ? (k & 63) : k)) = xv;
            xs[j] = xv; ss += xv[0] * xv[0] + xv[1] * xv[1] + xv[2] * xv[2] + xv[3] * xv[3];
        }
        if (l == 0 && !DRY) {
            ss = wave_sum(ss);
            const float rs = 1.0f / sqrtf(ss / D + 1e-6f);
            const float* g1 = p.in[I_N1G] + D; const float* m1 = modrow(p, 1, r);
#pragma unroll
            for (int j = 0; j < 4; ++j) {
                const int k = j * 256 + lane * 4;
                const f32x4_t gv = *(const f32x4_t*)(g1 + k), sc = *(const f32x4_t*)(m1 + 1024 + k), sh = *(const f32x4_t*)(m1 + k);
                float o[4];
#pragma unroll
                for (int q = 0; q < 4; ++q) o[q] = xs[j][q] * rs * gv[q] * (1.0f + sc[q]) + sh[q];
                uint2 pk; pk.x = cvtpk(o[0], o[1]); pk.y = cvtpk(o[2], o[3]);
                *(uint2*)(p.h + (size_t)r * D + k) = pk;
                *(unsigned*)(h8_of(p) + (size_t)r * D + k) = pack_fp8x4(o[0] * 4.f, o[1] * 4.f, o[2] * 4.f, o[3] * 4.f);
            }
        }
    }
}
HD void ph_combine(const Params& p, int l, int bid, int nb) { ph_combine_t<0>(p, l, bid, nb); }
#else
HD void ph_combine(const Params& p, int l, int bid, int nb) {
    const int RQ = (l == 0) ? R : NLAT;
    int tstart[17];
    { int acc = 0; for (int e = 0; e < 16; ++e) { tstart[e] = acc; acc += (p.cnt[l * 16 + e] + 127) >> 7; } tstart[16] = acc; }
    for (int r = bid; r < RQ; r += nb) {
        float* xo = xrow_out(p, r);
        const float* m = modrow(p, l, r);
        int e0 = p.sel_e[r * 2], e1 = p.sel_e[r * 2 + 1];
        int t0 = 0, t1 = 0;
#pragma unroll
        for (int q = 0; q < 16; ++q) { if (q == e0) t0 = tstart[q]; if (q == e1) t1 = tstart[q]; }
        const bf16* y0 = p.Y + (size_t)(t0 * 128 + p.apos[r * 2]) * D;
        const bf16* y1 = p.Y + (size_t)(t1 * 128 + p.apos[r * 2 + 1]) * D;
        const float w0 = p.sel_w[r * 2], w1 = p.sel_w[r * 2 + 1];
        THREADS(t, 256) {
            for (int k = t; k < D; k += 256) xo[k] += m[5120 + k] * (w0 * bf2f(y0[k]) + w1 * bf2f(y1[k]));
        }
    }
}

#endif

constexpr int NPHASE_LAYER = 14;
HD void run_phase(const Params& p, int ph, int l, int bid, int nb, float* sm) {
    switch (ph) {
        case 0: ph_norm1(p, l, bid, nb, sm); break;
        case 1: ph_inproj(p, l, bid, nb, (char*)sm); break;
        case 2: ph_prep(p, l, bid, nb); if (FOURIER_GEMM) { if (l == 0) ph_fourier_s1c(p, nb - 1 - bid, nb, (char*)sm); ph_fourier_s1(p, bid, nb, (char*)sm); } break;
        case 3: ph_na(p, l, bid, nb, (char*)sm); break;
        case 4: ph_da(p, l, bid, nb, (char*)sm); break;
        case 5: ph_gdn_chunk(p, l, bid, nb, sm); break;
        case 6: if (FOURIER_GEMM) { if (l == 0) ph_fourier_ctx(p, bid, nb, (char*)sm); ph_fourier_sA(p, bid, nb, (char*)sm); } else ph_fourier2(p, l, bid, nb); break;
        case 7: {
            ph_gdn_scan(p, l, bid, nb, sm);
            const bool split = nb == 512;
            const bool skip = split && (bid < 64 || (bid >= 256 && bid < 320));
            if (!skip) {
                const int b2 = split ? (bid < 256 ? bid - 64 : bid - 128) : bid, n2 = split ? nb - 128 : nb;
                if (FOURIER_GEMM) ph_fourier_sB(p, b2, n2, (char*)sm);
                if (l == 0) convert_static(p, b2, n2, sm, 1);
                convert_moe(p, l, b2, n2, sm);
#ifndef CPU_EMU
                ph_na(p, l, b2, n2, (char*)sm);
#endif
            }
        } break;
#ifndef CPU_EMU
        case 8: ph_gdn_outfin(p, l, bid, nb, sm); break;
#else
        case 8: ph_gdn_fin(p, l, bid, nb); break;
#endif
        case 9: ph_merge(p, l, bid, nb, (char*)sm); break;
        case 10: ph_outproj(p, l, bid, nb, (char*)sm); break;
        case 11: ph_router(p, l, bid, nb, sm); break;
        case 12: ph_ffn1(p, l, bid, nb, (char*)sm); break;
        case 13: ph_ffn2(p, l, bid, nb, (char*)sm); break;
        case 14: ph_combine(p, l, bid, nb); break;
#ifndef CPU_EMU
        case 70: ph_gdn_scan(p, l, bid, nb, sm); break;
        case 71: if (bid >= 64) { if (FOURIER_GEMM) ph_fourier_sB(p, bid - 64, nb - 64, (char*)sm); if (l == 0) convert_static(p, bid - 64, nb - 64, sm, 1); convert_moe(p, l, bid - 64, nb - 64, sm); } break;
        case 110: ph_outproj_t<1>(p, l, bid, nb, (char*)sm); break;
        case 111: ph_router_t<1>(p, l, bid, nb, sm); break;
        case 114: ph_combine_t<1>(p, l, bid, nb); break;
#endif
        default: break;
    }
}

struct WsLayout { size_t fWC, fXC, ropeT, bar, fa2, fW1, fWA, fWB, mods, cosT, sinT, cs, gg, gbeta, sel_e, sel_w, cnt, elist, apos, cG, wt_in, wt_br, wt_out, wt_gu, wt_d,
                  h, P, gq, fcs, cU, cW, cQK, odir, br, mg, act, Y, total; };
inline WsLayout ws_layout() {
    WsLayout w; size_t o = 0;
    auto take = [&](size_t bytes) { size_t r = o; o += (bytes + 255) & ~(size_t)255; return r; };
    w.bar = take(3456 * 4); w.ropeT = take(128 * 8 * 2 * 4); w.fWC = take((size_t)CTXL * 2 * CTXL * 2); w.fXC = take((size_t)NB * 256 * 2 * CTXL * 2);
    w.mods = take(2 * 3 * 6144 * 4); w.cosT = take(SEQ * 4); w.sinT = take(SEQ * 4); w.cs = take((size_t)NCTX * D * 4);
    w.gg = take((size_t)8 * R * 4); w.gbeta = take((size_t)8 * R * 4); w.sel_e = take((size_t)R * 2 * 4); w.sel_w = take((size_t)R * 2 * 4);
    w.cnt = take(32 * 4); w.elist = take((size_t)16 * 2 * R * 4); w.apos = take((size_t)2 * R * 4); w.cG = take((size_t)NUNIT * 192 * 4);
    w.wt_in = take((size_t)2 * WIN_NP * D * 2); w.wt_br = take((size_t)2 * 4 * D * 256 * 2); w.wt_out = take((size_t)2 * D * D * 2);
    w.wt_gu = take((size_t)16 * 1024 * D * 2); w.wt_d = take((size_t)16 * D * 512 * 2);
    w.h = take((size_t)R * D * 2);
    w.fa2 = take((size_t)NB * 128 * 256 * 2 * 64 * 2); w.fW1 = take(8192 * 2); w.fWA = take(65536 * 2); w.fWB = take(8192 * 2);
    {
        const size_t szP = ((size_t)R * PLD * 2 + 255) & ~(size_t)255, szQ = ((size_t)R * 768 * 2 + 255) & ~(size_t)255;
        const size_t szA = ((size_t)PADROWS * 512 * 2 + 255) & ~(size_t)255, szY = ((size_t)PADROWS * 1024 * 2 + 255) & ~(size_t)255;
        const size_t base = take((szP + szQ) > (szA + szY) ? (szP + szQ) : (szA + szY));
        w.P = base; w.gq = base + szP; w.act = base; w.Y = base + szA;
    }
    w.fcs = take((size_t)R * 512 * 2);
    w.cU = take((size_t)NUNIT * 4096 * 2); w.cW = take((size_t)NUNIT * 4096 * 2); w.cQK = take((size_t)NUNIT * 4096 * 2);
    w.odir = take((size_t)2 * R * 256 * 2); w.br = take((size_t)R * D * 2);
    w.mg = w.cU;
    w.total = o;
    return w;
}
inline void fill_params(Params& p, void* const* d_in, void* d_out, void* d_ws) {
    WsLayout w = ws_layout(); char* b = (char*)d_ws;
    for (int i = 0; i < 30; ++i) p.in[i] = (const float*)d_in[i];
    p.out = (float*)d_out;
    p.mods = (float*)(b + w.mods); p.cosT = (float*)(b + w.cosT); p.sinT = (float*)(b + w.sinT); p.cs = (float*)(b + w.cs);
    p.h = (bf16*)(b + w.h); p.P = (bf16*)(b + w.P); p.gq = (bf16*)(b + w.gq); p.gg = (float*)(b + w.gg); p.gbeta = (float*)(b + w.gbeta);
    p.fcs = (bf16*)(b + w.fcs); p.cU = (bf16*)(b + w.cU); p.cW = (bf16*)(b + w.cW); p.cQK = (bf16*)(b + w.cQK); p.cG = (float*)(b + w.cG);
    p.odir = (bf16*)(b + w.odir); p.br = (bf16*)(b + w.br); p.mg = (bf16*)(b + w.mg); p.sel_e = (int*)(b + w.sel_e);
    p.sel_w = (float*)(b + w.sel_w); p.act = (bf16*)(b + w.act); p.Y = (bf16*)(b + w.Y);
    p.wt_in = (bf16*)(b + w.wt_in); p.wt_br = (bf16*)(b + w.wt_br); p.wt_out = (bf16*)(b + w.wt_out); p.wt_gu = (bf16*)(b + w.wt_gu);
    p.fa2 = (bf16*)(b + w.fa2); p.fW1 = (bf16*)(b + w.fW1); p.fWA = (bf16*)(b + w.fWA); p.fWB = (bf16*)(b + w.fWB);
    p.bar = (unsigned*)(b + w.bar); p.ropeT = (float*)(b + w.ropeT); p.fWC = (bf16*)(b + w.fWC); p.fXC = (bf16*)(b + w.fXC);
    p.wt_d = (bf16*)(b + w.wt_d); p.cnt = (int*)(b + w.cnt); p.elist = (int*)(b + w.elist); p.apos = (int*)(b + w.apos);
}

#if !defined(CPU_EMU) && defined(PHASE_KERNELS)
#define PK(n) __global__ void __launch_bounds__(256, 2) pk_##n(Params p) { __shared__ __attribute__((aligned(16))) float sm[SMEM_FLOATS]; run_phase(p, n, p.layer, blockIdx.x, gridDim.x, sm); }
PK(0) PK(1) PK(2) PK(3) PK(4) PK(5) PK(6) PK(7) PK(8) PK(9) PK(10) PK(11) PK(12) PK(13) PK(14)
__global__ void __launch_bounds__(256, 2) pk_init(Params p) { __shared__ __attribute__((aligned(16))) float sm[SMEM_FLOATS]; ph_init(p, blockIdx.x, gridDim.x, sm); }
#endif
#ifndef CPU_EMU

#define XB_TMO      128
#define XB_XCNT(j)  (256  + 64 * (j))
#define XB_XSUB(j)  (1280 + 64 * (j))
#define XB_XGEN(j)  (2304 + 64 * (j))
#define XB_TOP      3328
#define XB_TOPGEN   3392
#define XCD_BAR_WORDS 3456
#define XB_SPIN_CAP (1u << 22)
#define LAS __attribute__((address_space(3)))
__device__ __forceinline__ unsigned xb_ld(unsigned* p)              { return __hip_atomic_load(p, __ATOMIC_RELAXED, __HIP_MEMORY_SCOPE_AGENT); }
__device__ __forceinline__ unsigned xb_add(unsigned* p, unsigned v) { return __hip_atomic_fetch_add(p, v, __ATOMIC_RELAXED, __HIP_MEMORY_SCOPE_AGENT); }
__device__ __forceinline__ unsigned xb_xcc_id() { return (unsigned)__builtin_amdgcn_s_getreg((3 << 11) | 20) & 0xFu; }
#define XB_SPIN(cond, bar) do { unsigned _sp = 0; while (cond) { __builtin_amdgcn_s_sleep(1); \
    if ((++_sp & 255u) == 0u) { if (xb_ld(&(bar)[XB_TMO])) break; if (_sp > XB_SPIN_CAP) { atomicAdd(&(bar)[XB_TMO], 1u); break; } } } } while (0)
struct XcdBarrier { unsigned* bar; unsigned x; volatile LAS unsigned* st; };
__device__ __forceinline__ XcdBarrier xcd_barrier_post(unsigned* bar, volatile LAS unsigned* st) {
    XcdBarrier b; b.bar = bar; b.x = xb_xcc_id(); b.st = st;
    if (threadIdx.x == 0) (void)xb_add(&bar[XB_XCNT(b.x)], 1u);
    return b;
}
__device__ __forceinline__ void xcd_barrier_complete(unsigned* bar, unsigned x, unsigned& nloc, unsigned& nx) {
    const unsigned G = gridDim.x * gridDim.y * gridDim.z;
    unsigned sum, cnt, mine, sp = 0u;
    for (;;) {
        sum = 0u; cnt = 0u; mine = 0u;
#pragma unroll
        for (unsigned j = 0; j < 16; ++j) { const unsigned c = xb_ld(&bar[XB_XCNT(j)]); sum += c; cnt += (c > 0u) ? 1u : 0u; mine = (j == x) ? c : mine; }
        if (sum == G) break;
        __builtin_amdgcn_s_sleep(1);
        if ((++sp & 255u) == 0u) { if (xb_ld(&bar[XB_TMO])) break; if (sp > XB_SPIN_CAP) { atomicAdd(&bar[XB_TMO], 1u); break; } }
    }
    nloc = mine > 0u ? mine : 1u; nx = cnt > 0u ? cnt : 1u;
}
__device__ __forceinline__ void xcd_barrier(const XcdBarrier& b) {
    asm volatile("s_waitcnt vmcnt(0)" ::: "memory");
    __syncthreads();
    if (threadIdx.x == 0) {
        unsigned* bar = b.bar;
        __builtin_amdgcn_s_waitcnt(0);
        unsigned nloc = b.st[0], nx = b.st[1];
        if (nloc == 0u) { xcd_barrier_complete(bar, b.x, nloc, nx); b.st[0] = nloc; b.st[1] = nx; }
        const unsigned old = xb_add(&bar[XB_XSUB(b.x)], 1u);
        const unsigned gen = old / nloc;
        if (old + 1u == (gen + 1u) * nloc) {
            __builtin_amdgcn_fence(__ATOMIC_RELEASE, "agent");
            asm volatile("s_waitcnt vmcnt(0)" ::: "memory");
            const unsigned og = xb_add(&bar[XB_TOP], 1u);
            const unsigned tg = og / nx;
            if (og + 1u == (tg + 1u) * nx) xb_add(&bar[XB_TOPGEN], 1u);
            else XB_SPIN(xb_ld(&bar[XB_TOPGEN]) == tg, bar);
            __builtin_amdgcn_fence(__ATOMIC_ACQUIRE, "agent");
            xb_add(&bar[XB_XGEN(b.x)], 1u);
            asm volatile("s_waitcnt vmcnt(0)" ::: "memory");
        } else {
            XB_SPIN(xb_ld(&bar[XB_XGEN(b.x)]) == gen, bar);
            __builtin_amdgcn_fence(__ATOMIC_ACQUIRE, "agent");
            asm volatile("s_waitcnt vmcnt(0)" ::: "memory");
        }
    }
    __syncthreads();
}

__global__ void __launch_bounds__(256, 2) fwd_megakernel(Params p) {
    __shared__ __attribute__((aligned(16))) float sm[SMEM_FLOATS];
    cg::grid_group grid = cg::this_grid();
    const int bid = blockIdx.x, nb = gridDim.x;
    volatile LAS unsigned* xst = (volatile LAS unsigned*)(sm + SMEM_FLOATS - 4);
    if (threadIdx.x == 0) { xst[0] = 0u; xst[1] = 0u; }
    __syncthreads();
    XcdBarrier xb = xcd_barrier_post(p.bar, xst);
    ph_init(p, bid, nb, sm);
    xcd_barrier(xb);
#ifdef PROBE_INIT
    ph_init(p, bid, nb, sm); xcd_barrier(xb); ph_init(p, bid, nb, sm); xcd_barrier(xb);
#endif
#define PH(n, l) run_phase(p, n, l, bid, nb, sm); xcd_barrier(xb);
#define PHN(n, l) run_phase(p, n, l, bid, nb, sm);
#ifndef PROBE_X
#define PROBE_X(n, l)
#endif
#define LAYER(l) PH(0, l) PROBE_X(0, l) PH(1, l) PROBE_X(1, l) PH(2, l) PROBE_X(2, l) PHN(4, l) PHN(6, l) PH(5, l) PROBE_X(4, l) PROBE_X(5, l) PROBE_X(3, l) PROBE_X(6, l) \
    PH(7, l) PROBE_X(7, l) PROBE_X(70, l) PROBE_X(71, l) PH(8, l) PROBE_X(8, l) PH(9, l) PROBE_X(9, l) PH(10, l) PH(11, l) PH(12, l) PROBE_X(12, l) \
    PH(13, l) PROBE_X(13, l) PH(14, l)
    LAYER(0)
#undef LAYER
#define LAYER(l) PH(1, l) PROBE_X(1, l) PH(2, l) PROBE_X(2, l) PHN(4, l) PHN(6, l) PH(5, l) PROBE_X(4, l) PROBE_X(5, l) PROBE_X(3, l) PROBE_X(6, l) \
    PH(7, l) PROBE_X(7, l) PROBE_X(70, l) PROBE_X(71, l) PH(8, l) PROBE_X(8, l) PH(9, l) PROBE_X(9, l) PH(10, l) PROBE_X(110, l) PH(11, l) PROBE_X(111, l) PH(12, l) PROBE_X(12, l) \
    PH(13, l) PROBE_X(13, l) PH(14, l) PROBE_X(114, l)
    LAYER(1)
}

extern "C" void kernel_launch(void* const* d_in, const int* in_sizes, int n_in, void* d_out, int out_size,
                              void* d_ws, size_t ws_size, hipStream_t stream) {
    WsLayout w = ws_layout();
    if (ws_size < w.total) { fprintf(stderr, "ws too small: need %zu have %zu\n", w.total, ws_size); return; }
    static int grid_blocks = 0;
    if (!grid_blocks) {
        int dev = 0, cus = 0, per_cu = 0;
        (void)hipGetDevice(&dev);
        (void)hipDeviceGetAttribute(&cus, hipDeviceAttributeMultiprocessorCount, dev);
        (void)hipOccupancyMaxActiveBlocksPerMultiprocessor(&per_cu, fwd_megakernel, 256, 0);
        if (per_cu < 1) per_cu = 1;
        grid_blocks = cus * per_cu;
    }
    Params p{};
    fill_params(p, d_in, d_out, d_ws);
    (void)hipMemsetAsync(p.bar, 0, XCD_BAR_WORDS * 4, stream);
    void* args[] = {&p};
    hipError_t e = hipLaunchCooperativeKernel((void*)fwd_megakernel, dim3(grid_blocks), dim3(256), args, 0, stream);
    if (e != hipSuccess) fprintf(stderr, "cooperative launch failed: %s (grid %d)\n", hipGetErrorString(e), grid_blocks);
}
#endif
```

```cpp
#ifndef CPU_EMU
#include <hip/hip_runtime.h>
#include <hip/hip_cooperative_groups.h>
#include <cstdio>
namespace cg = cooperative_groups;
#define HD __device__ __forceinline__
__device__ __forceinline__ int tid_() { int v = threadIdx.x; asm volatile("" : "+v"(v)); return v; }
#define THREADS(t, n) for (int t = tid_(); t < (n); t += 256)
#define SYNC __syncthreads();
#define COSPI(x) cospif(x)
#define SINPI(x) sinpif(x)
typedef float4 f4;
#else
#include <cmath>
#include <cstdio>
#include <cstring>
#include <cstddef>
#define HD inline
#define THREADS(t, n) for (int t = 0; t < (n); ++t)
#define SYNC
#define COSPI(x) ((float)cos(M_PI * (double)(x)))
#define SINPI(x) ((float)sin(M_PI * (double)(x)))
struct f4 { float x, y, z, w; };
#endif

#ifndef SEQ
#define SEQ 8192
#endif
#ifndef CTXL
#define CTXL 256
#endif

typedef unsigned short bf16;
#ifndef CPU_EMU
typedef __attribute__((ext_vector_type(8))) short bf16x8_t;
typedef __attribute__((ext_vector_type(4))) float f32x4_t;
typedef __attribute__((ext_vector_type(4))) int i32x4_t;
#define ATOMIC_ADD_RET(ptr, v) atomicAdd((ptr), (v))
#else
HD int atomic_add_ret_(int* p, int v) { int old;
#pragma omp atomic capture
    { old = *p; *p += v; }
    return old; }
#define ATOMIC_ADD_RET(ptr, v) atomic_add_ret_((ptr), (v))
#endif
constexpr int NB = 2, D = 1024, GW = 64, ROWS = SEQ / GW;
constexpr int NLAT = NB * SEQ, NCTX = NB * CTXL, R = NLAT + NCTX;
constexpr int DIN = 6928;
constexpr int PLD = 2816;
constexpr int C_NAQ = 0, C_NAK = 256, C_NAV = 512, C_DAQ = 768, C_DAK = 1024, C_DAV = 1280, C_GQ = 1536, C_Z = 2304,
              C_F = 2560;
constexpr int WIN_N = 6912;
constexpr int WIN_NP = WIN_N + 64;
constexpr int PADROWS = 2 * R + 16 * 128;
constexpr int NCC = CTXL / 64, NCL = SEQ / 64, NCH = NCC + NCL;
constexpr int NUNIT = 2 * NB * 4 * NCH;
constexpr bool FOURIER_GEMM = (SEQ == 8192);
constexpr int SMEM_FLOATS = 73 * 256 + 4;

struct Params {
    const float* in[30];
    float* out;
    float* mods;
    float* cosT;
    float* sinT;
    float* cs;
    bf16* h;
    bf16* P;
    bf16* gq;
    float* gg;
    float* gbeta;
    bf16* fcs;
    bf16* cU;
    bf16* cW;
    bf16* cQK;
    float* cG;
    bf16* odir;
    bf16* br;
    bf16* mg;
    int* sel_e;
    float* sel_w;
    bf16* act;
    bf16* Y;
    bf16* wt_in;
    bf16* wt_br;
    bf16* wt_out;
    bf16* wt_gu;
    bf16* wt_d;
    int* cnt;
    int* dep;
    unsigned* bar;
    bf16* fa2;
    bf16* fW1;
    float* ropeT;
    bf16* fWA;
    bf16* fWB;
    bf16* fWC;
    bf16* fXC;
    int* elist;
    int* apos;
    int phase;
    int layer;
};

enum { I_X = 0, I_C, I_CTX, I_CCTX, I_WMOD, I_BMOD, I_N1G, I_N2G, I_WIN, I_NAQG, I_NAKG, I_RPB, I_DAQG, I_DAKG, I_LQ1, I_LK1,
       I_LQ2, I_LK2, I_SUBLN, I_CONVW, I_ALOG, I_DTB, I_ONORM, I_WBR, I_WOUT, I_WROUTER, I_RBIAS, I_MG, I_MU, I_MD };

HD float bf2f(bf16 v) { union { unsigned u; float f; } x; x.u = ((unsigned)v) << 16; return x.f; }
#ifndef CPU_EMU
typedef float f32x2_t __attribute__((ext_vector_type(2))); typedef __bf16 bf16x2_t __attribute__((ext_vector_type(2)));
typedef short s16x4_t __attribute__((ext_vector_type(4)));
typedef __attribute__((address_space(3))) const char* lds_cptr;
HD unsigned cvtpk(float lo, float hi) { f32x2_t v = {lo, hi}; bf16x2_t b = __builtin_convertvector(v, bf16x2_t); return __builtin_bit_cast(unsigned, b); }
HD bf16 f2bf(float f) { return (bf16)(cvtpk(f, 0.f) & 0xffffu); }
HD s16x4_t lds_tr16(lds_cptr p) { return __builtin_bit_cast(s16x4_t, __builtin_amdgcn_ds_read_tr16_b64_v4i16((__attribute__((address_space(3))) s16x4_t*)p)); }
#else
HD bf16 f2bf(float f) { union { unsigned u; float f; } x; x.f = f; unsigned u = x.u; u += 0x7fffu + ((u >> 16) & 1u); return (bf16)(u >> 16); }
#endif
HD float sigmoidf_(float x) { return 1.0f / (1.0f + expf(-x)); }
HD float siluf_(float x) { return x / (1.0f + expf(-x)); }

struct RowInfo { int seg, b, t, T, base; };
HD RowInfo rowinfo(int r) {
    RowInfo q;
    if (r < NLAT) { q.seg = 0; q.b = r / SEQ; q.t = r % SEQ; q.T = SEQ; q.base = q.b * SEQ; }
    else { int r2 = r - NLAT; q.seg = 1; q.b = r2 / CTXL; q.t = r2 % CTXL; q.T = CTXL; q.base = NLAT + q.b * CTXL; }
    return q;
}
HD const float* xrow_in(const Params& p, int l, int r) {
    if (r < NLAT) return (l == 0 ? p.in[I_X] : p.out) + (size_t)r * D;
    return p.cs + (size_t)(r - NLAT) * D;
}
HD float* xrow_out(const Params& p, int r) {
    if (r < NLAT) return p.out + (size_t)r * D;
    return p.cs + (size_t)(r - NLAT) * D;
}
HD const float* modrow(const Params& p, int l, int r) {
    int s = (r < NLAT) ? (r / SEQ) : 2;
    return p.mods + (size_t)(l * 3 + s) * 6144;
}
#ifndef CPU_EMU
HD unsigned char* gu8_of(const Params& p) { return (unsigned char*)p.wt_gu; }
HD unsigned char* d8_of(const Params& p) { return (unsigned char*)p.wt_gu + (size_t)16 * 1024 * 1024; }
HD unsigned char* h8_of(const Params& p) { return (unsigned char*)p.wt_gu + (size_t)16 * 1024 * 1024 + (size_t)16 * 1024 * 512; }
#endif
HD float lam_init_of(int l) { return l == 0 ? 0.2f : (0.8f - 0.6f * 0.7408182206817179f); }


#ifndef CPU_EMU
template <int NJ> struct AccT { f32x4_t v[4][NJ]; };
#define ACC_DECL(NJ, a) AccT<NJ> a
template <int NJ> HD void acc_zero(AccT<NJ>& a) {
#pragma unroll
    for (int i = 0; i < 4; ++i)
#pragma unroll
        for (int j = 0; j < NJ; ++j) a.v[i][j] = f32x4_t{0.f, 0.f, 0.f, 0.f};
}
#define ACC_FOR(NJ, row, col) { const int _t = tid_(); const int _ln = _t & 63, _w = _t >> 6; \
    _Pragma("unroll") for (int _i = 0; _i < 4; ++_i) _Pragma("unroll") for (int _j = 0; _j < NJ; ++_j) _Pragma("unroll") for (int _r = 0; _r < 4; ++_r) { \
    const int row = (_w >> 1) * 64 + _i * 16 + (_ln >> 4) * 4 + _r; const int col = (_w & 1) * (16 * NJ) + _j * 16 + (_ln & 15);
#define AV(a) a.v[_i][_j][_r]
#define ACC_END }}
#define ACC_FOR_PAIR(row, pcol) { const int _t = tid_(); const int _ln = _t & 63, _w = _t >> 6; \
    _Pragma("unroll") for (int _i = 0; _i < 4; ++_i) _Pragma("unroll") for (int _jj = 0; _jj < 2; ++_jj) _Pragma("unroll") for (int _r = 0; _r < 4; ++_r) { \
    const int row = (_w >> 1) * 64 + _i * 16 + (_ln >> 4) * 4 + _r; const int pcol = (_w & 1) * 32 + _jj * 16 + (_ln & 15);
#define AV_G(a) a.v[_i][2 * _jj][_r]
#define AV_U(a) a.v[_i][2 * _jj + 1][_r]

#define WAIT_VM0() asm volatile("s_waitcnt vmcnt(0)" ::: "memory")
#define GLDS16(gp, lp) __builtin_amdgcn_global_load_lds((const unsigned*)(gp), (unsigned*)(lp), 16, 0, 0)
template <int NJ, class AF, class BF>
HD void gemm_accum(AccT<NJ>& acc, AF arow, BF brow, int K, char* smem) {
    constexpr int NBL = NJ;
    const int t = tid_(), lane = t & 63, w = t >> 6, wr = w >> 1, wc = w & 1;
    const int lr = t >> 3, lc = t & 7;
    const bf16* ap[4]; const bf16* bp[NBL];
#pragma unroll
    for (int i = 0; i < 4; ++i) ap[i] = arow(lr + 32 * i) + ((lc ^ (lr & 7)) << 3);
#pragma unroll
    for (int i = 0; i < NBL; ++i) bp[i] = brow(lr + 32 * i) + ((lc ^ (lr & 7)) << 3);
    char* sA = smem + w * 1024; char* sB = smem + 32768 + w * 1024;
    const int fr = lane & 15, fg = lane >> 4;
    const unsigned aoff0 = (wr * 64 + fr) * 128 + (((fg) ^ (fr & 7)) << 4);
    const unsigned aoff1 = (wr * 64 + fr) * 128 + (((4 + fg) ^ (fr & 7)) << 4);
    const unsigned boff0 = (wc * (16 * NJ) + fr) * 128 + (((fg) ^ (fr & 7)) << 4);
    const unsigned boff1 = (wc * (16 * NJ) + fr) * 128 + (((4 + fg) ^ (fr & 7)) << 4);
    const int KT = K >> 6;
    __syncthreads();
#pragma unroll
    for (int i = 0; i < 4; ++i) GLDS16(ap[i], sA + 4096 * i);
#pragma unroll
    for (int i = 0; i < NBL; ++i) GLDS16(bp[i], sB + 4096 * i);
    WAIT_VM0();
    __syncthreads();
#pragma unroll 1
    for (int kt = 0; kt < KT; ++kt) {
        const int cur = kt & 1;
        if (kt + 1 < KT) {
#pragma unroll
            for (int i = 0; i < 4; ++i) GLDS16(ap[i] + (kt + 1) * 64, sA + (cur ^ 1) * 16384 + 4096 * i);
#pragma unroll
            for (int i = 0; i < NBL; ++i) GLDS16(bp[i] + (kt + 1) * 64, sB + (cur ^ 1) * 16384 + 4096 * i);
        }
        const char* cA = smem + cur * 16384; const char* cB = smem + 32768 + cur * 16384;
#pragma unroll
        for (int s = 0; s < 2; ++s) {
            bf16x8_t af[4], bfr[NJ];
#pragma unroll
            for (int i = 0; i < 4; ++i) af[i] = *(const bf16x8_t*)(cA + (s ? aoff1 : aoff0) + i * 2048);
#pragma unroll
            for (int j = 0; j < NJ; ++j) bfr[j] = *(const bf16x8_t*)(cB + (s ? boff1 : boff0) + j * 2048);
#pragma unroll
            for (int i = 0; i < 4; ++i)
#pragma unroll
                for (int j = 0; j < NJ; ++j) acc.v[i][j] = __builtin_amdgcn_mfma_f32_16x16x32_bf16(af[i], bfr[j], acc.v[i][j], 0, 0, 0);
        }
        WAIT_VM0();
        __syncthreads();
    }
}
template <int NJ> HD void acc_to_lds(const AccT<NJ>& acc, float* tl) {
    const int t = tid_(), lane = t & 63, w = t >> 6;
    constexpr int LD = 32 * NJ + 4;
    float* base = tl + ((w >> 1) * 64 + (lane >> 4) * 4) * LD + (w & 1) * (16 * NJ) + (lane & 15);
#pragma unroll
    for (int i = 0; i < 4; ++i)
#pragma unroll
        for (int j = 0; j < NJ; ++j)
#pragma unroll
            for (int r = 0; r < 4; ++r) base[(i * 16 + r) * LD + j * 16] = acc.v[i][j][r];
}
typedef int i32x8_t __attribute__((ext_vector_type(8)));
typedef unsigned char u8;
template <int NJ, class AF, class BF>
HD void gemm_accum8(AccT<NJ>& acc, AF arow, BF brow, int K, char* smem, int sa, int sb) {
    constexpr int NBL = NJ;
    const int t = tid_(), lane = t & 63, w = t >> 6, wr = w >> 1, wc = w & 1;
    const int lr = t >> 3, lc = t & 7;
    const u8* ap[4]; const u8* bp[NBL];
#pragma unroll
    for (int i = 0; i < 4; ++i) ap[i] = arow(lr + 32 * i) + ((lc ^ (lr & 7)) << 4);
#pragma unroll
    for (int i = 0; i < NBL; ++i) bp[i] = brow(lr + 32 * i) + ((lc ^ (lr & 7)) << 4);
    char* sA = smem + w * 1024; char* sB = smem + 32768 + w * 1024;
    const int fr = lane & 15, fg = lane >> 4;
    const unsigned aoff0 = (wr * 64 + fr) * 128 + (((2 * fg) ^ (fr & 7)) << 4);
    const unsigned aoff1 = (wr * 64 + fr) * 128 + (((2 * fg + 1) ^ (fr & 7)) << 4);
    const unsigned boff0 = (wc * (16 * NJ) + fr) * 128 + (((2 * fg) ^ (fr & 7)) << 4);
    const unsigned boff1 = (wc * (16 * NJ) + fr) * 128 + (((2 * fg + 1) ^ (fr & 7)) << 4);
    const int KT = K >> 7;
    __syncthreads();
#pragma unroll
    for (int i = 0; i < 4; ++i) GLDS16(ap[i], sA + 4096 * i);
#pragma unroll
    for (int i = 0; i < NBL; ++i) GLDS16(bp[i], sB + 4096 * i);
    WAIT_VM0();
    __syncthreads();
#pragma unroll 1
    for (int kt = 0; kt < KT; ++kt) {
        const int cur = kt & 1;
        if (kt + 1 < KT) {
#pragma unroll
            for (int i = 0; i < 4; ++i) GLDS16(ap[i] + (kt + 1) * 128, sA + (cur ^ 1) * 16384 + 4096 * i);
#pragma unroll
            for (int i = 0; i < NBL; ++i) GLDS16(bp[i] + (kt + 1) * 128, sB + (cur ^ 1) * 16384 + 4096 * i);
        }
        const char* cA = smem + cur * 16384; const char* cB = smem + 32768 + cur * 16384;
        i32x8_t af[4], bfr[NJ];
#pragma unroll
        for (int i = 0; i < 4; ++i) {
            const i32x4_t lo = *(const i32x4_t*)(cA + aoff0 + i * 2048), hi = *(const i32x4_t*)(cA + aoff1 + i * 2048);
            af[i] = i32x8_t{lo[0], lo[1], lo[2], lo[3], hi[0], hi[1], hi[2], hi[3]};
        }
#pragma unroll
        for (int j = 0; j < NJ; ++j) {
            const i32x4_t lo = *(const i32x4_t*)(cB + boff0 + j * 2048), hi = *(const i32x4_t*)(cB + boff1 + j * 2048);
            bfr[j] = i32x8_t{lo[0], lo[1], lo[2], lo[3], hi[0], hi[1], hi[2], hi[3]};
        }
#pragma unroll
        for (int i = 0; i < 4; ++i)
#pragma unroll
            for (int j = 0; j < NJ; ++j) acc.v[i][j] = __builtin_amdgcn_mfma_scale_f32_16x16x128_f8f6f4(af[i], bfr[j], acc.v[i][j], 0, 0, 0, sa, 0, sb);
        WAIT_VM0();
        __syncthreads();
    }
}
HD unsigned pack_fp8x4(float a, float b, float c, float d) {
    a = __builtin_amdgcn_fmed3f(a, -448.f, 448.f); b = __builtin_amdgcn_fmed3f(b, -448.f, 448.f);
    c = __builtin_amdgcn_fmed3f(c, -448.f, 448.f); d = __builtin_amdgcn_fmed3f(d, -448.f, 448.f);
    int w = 0;
    w = __builtin_amdgcn_cvt_pk_fp8_f32(a, b, w, false);
    w = __builtin_amdgcn_cvt_pk_fp8_f32(c, d, w, true);
    return (unsigned)w;
}
constexpr int SC_H = 0x7d7d7d7d;
constexpr int SC_W = 0x7a7a7a7a;
constexpr int SC_ACT = 0x7b7b7b7b;
template <int NJ, class AF, class BF>
HD void gemm_stage0(AF arow, BF brow, int ebytes, char* smem, int buf) {
    const int t = tid_(), w = t >> 6, lr = t >> 3, lc = t & 7;
    char* sA = smem + w * 1024 + buf * 16384; char* sB = smem + 32768 + w * 1024 + buf * 16384;
    (void)ebytes;
#pragma unroll
    for (int i = 0; i < 4; ++i) GLDS16((const char*)arow(lr + 32 * i) + ((lc ^ (lr & 7)) << 4), sA + 4096 * i);
#pragma unroll
    for (int i = 0; i < NJ; ++i) GLDS16((const char*)brow(lr + 32 * i) + ((lc ^ (lr & 7)) << 4), sB + 4096 * i);
}
template <int NJ, bool FP8, class AF, class BF, class NF>
HD void gemm_chain(AccT<NJ>& acc, AF arow, BF brow, int K, char* smem, int& cur, NF next_stage, int sa, int sb) {
    const int t = tid_(), lane = t & 63, w = t >> 6, wr = w >> 1, wc = w & 1;
    const int lr = t >> 3, lc = t & 7;
    const char* ap[4]; const char* bp[NJ];
#pragma unroll
    for (int i = 0; i < 4; ++i) ap[i] = (const char*)arow(lr + 32 * i) + ((lc ^ (lr & 7)) << 4);
#pragma unroll
    for (int i = 0; i < NJ; ++i) bp[i] = (const char*)brow(lr + 32 * i) + ((lc ^ (lr & 7)) << 4);
    char* sA = smem + w * 1024; char* sB = smem + 32768 + w * 1024;
    const int fr = lane & 15, fg = lane >> 4;
    const unsigned rA = (wr * 64 + fr) * 128, rB = (wc * (16 * NJ) + fr) * 128;
    const int KT = K >> (FP8 ? 7 : 6);
#pragma unroll 1
    for (int kt = 0; kt < KT; ++kt) {
        WAIT_VM0();
        __syncthreads();
        if (kt + 1 < KT) {
#pragma unroll
            for (int i = 0; i < 4; ++i) GLDS16(ap[i] + (kt + 1) * 128, sA + (cur ^ 1) * 16384 + 4096 * i);
#pragma unroll
            for (int i = 0; i < NJ; ++i) GLDS16(bp[i] + (kt + 1) * 128, sB + (cur ^ 1) * 16384 + 4096 * i);
        } else next_stage(cur ^ 1);
        const char* cA = smem + cur * 16384; const char* cB = smem + 32768 + cur * 16384;
        if (FP8) {
            i32x8_t af[4], bfr[NJ];
#pragma unroll
            for (int i = 0; i < 4; ++i) {
                const i32x4_t lo = *(const i32x4_t*)(cA + rA + (((2 * fg) ^ (fr & 7)) << 4) + i * 2048), hi = *(const i32x4_t*)(cA + rA + (((2 * fg + 1) ^ (fr & 7)) << 4) + i * 2048);
                af[i] = i32x8_t{lo[0], lo[1], lo[2], lo[3], hi[0], hi[1], hi[2], hi[3]};
            }
#pragma unroll
            for (int j = 0; j < NJ; ++j) {
                const i32x4_t lo = *(const i32x4_t*)(cB + rB + (((2 * fg) ^ (fr & 7)) << 4) + j * 2048), hi = *(const i32x4_t*)(cB + rB + (((2 * fg + 1) ^ (fr & 7)) << 4) + j * 2048);
                bfr[j] = i32x8_t{lo[0], lo[1], lo[2], lo[3], hi[0], hi[1], hi[2], hi[3]};
            }
#pragma unroll
            for (int i = 0; i < 4; ++i)
#pragma unroll
                for (int j = 0; j < NJ; ++j) acc.v[i][j] = __builtin_amdgcn_mfma_scale_f32_16x16x128_f8f6f4(af[i], bfr[j], acc.v[i][j], 0, 0, 0, sa, 0, sb);
        } else {
#pragma unroll
            for (int s_ = 0; s_ < 2; ++s_) {
                bf16x8_t af[4], bfr[NJ];
#pragma unroll
                for (int i = 0; i < 4; ++i) af[i] = *(const bf16x8_t*)(cA + rA + (((4 * s_ + fg) ^ (fr & 7)) << 4) + i * 2048);
#pragma unroll
                for (int j = 0; j < NJ; ++j) bfr[j] = *(const bf16x8_t*)(cB + rB + (((4 * s_ + fg) ^ (fr & 7)) << 4) + j * 2048);
#pragma unroll
                for (int i = 0; i < 4; ++i)
#pragma unroll
                    for (int j = 0; j < NJ; ++j) acc.v[i][j] = __builtin_amdgcn_mfma_f32_16x16x32_bf16(af[i], bfr[j], acc.v[i][j], 0, 0, 0);
            }
        }
        cur ^= 1;
    }
}
#else
template <int NJ> struct AccT { float v[128][32 * NJ]; };
#define ACC_DECL(NJ, a) static thread_local AccT<NJ> a
template <int NJ> HD void acc_zero(AccT<NJ>& a) { memset(a.v, 0, sizeof(a.v)); }
#define ACC_FOR(NJ, row, col) { for (int row = 0; row < 128; ++row) for (int col = 0; col < 32 * NJ; ++col) {
#define AV(a) a.v[row][col]
#define ACC_END }}
#define ACC_FOR_PAIR(row, pcol) { for (int row = 0; row < 128; ++row) for (int pcol = 0; pcol < 64; ++pcol) {
#define AV_G(a) a.v[row][(pcol / 16) * 32 + (pcol % 16)]
#define AV_U(a) a.v[row][(pcol / 16) * 32 + 16 + (pcol % 16)]
template <int NJ, class AF, class BF>
HD void gemm_accum(AccT<NJ>& acc, AF arow, BF brow, int K, char* smem) {
    for (int i = 0; i < 128; ++i) { const bf16* a = arow(i);
        for (int j = 0; j < 32 * NJ; ++j) { const bf16* b = brow(j); float s = 0.f;
            for (int k = 0; k < K; ++k) s += bf2f(a[k]) * bf2f(b[k]);
            acc.v[i][j] += s; } }
}
#endif

template <class DF>
HD void conv_tile(const float* src, size_t lds_, bf16* dst, size_t ldd, int k0, int nsrc0, DF drow, float* sm) {
    THREADS(t, 4096) { int kk = t >> 6, nn = t & 63; sm[kk * 65 + nn] = src[(size_t)(k0 + kk) * lds_ + nsrc0 + nn]; }
    SYNC
    THREADS(t, 4096) { int nn = t >> 6, kk = t & 63; dst[(size_t)drow(nn) * ldd + k0 + kk] = f2bf(sm[kk * 65 + nn]); }
    SYNC
}
#ifndef CPU_EMU
template <class DF>
HD void conv_tile8(const float* src, size_t lds_, unsigned char* dst, size_t ldd, int k0, int nsrc0, DF drow, float scale, float* sm) {
    THREADS(t, 4096) { int kk = t >> 6, nn = t & 63; sm[kk * 65 + nn] = src[(size_t)(k0 + kk) * lds_ + nsrc0 + nn] * scale; }
    SYNC
    THREADS(t, 1024) { int nn = t >> 4, k4 = (t & 15) * 4;
        *(unsigned*)(dst + (size_t)drow(nn) * ldd + k0 + k4) = pack_fp8x4(sm[k4 * 65 + nn], sm[(k4 + 1) * 65 + nn], sm[(k4 + 2) * 65 + nn], sm[(k4 + 3) * 65 + nn]); }
    SYNC
}
HD void convert_moe(const Params& p, int l, int bid, int nb, float* sm) {
    for (int w = bid; w < 4096 + 2048; w += nb) {
        if (w < 4096) {
            int nt = w & 7, kt = (w >> 3) & 15, gu = (w >> 7) & 1, e = w >> 8;
            const float* src = p.in[gu ? I_MU : I_MG] + (size_t)(l * 16 + e) * D * 512;
            conv_tile8(src, 512, gu8_of(p) + (size_t)e * 1024 * D, D, kt * 64, nt * 64, [&](int nn) { int j = nt * 64 + nn; return (j >> 4) * 32 + (j & 15) + 16 * gu; }, 32.0f, sm);
        } else {
            int w2 = w - 4096; int nt = w2 & 15, kt = (w2 >> 4) & 7, e = w2 >> 7;
            const float* src = p.in[I_MD] + (size_t)(l * 16 + e) * 512 * D;
            conv_tile8(src, D, d8_of(p) + (size_t)e * D * 512, 512, kt * 64, nt * 64, [&](int nn) { return nt * 64 + nn; }, 32.0f, sm);
        }
    }
}
#else
HD void convert_moe(const Params& p, int l, int bid, int nb, float* sm) {
    for (int w = bid; w < 4096 + 2048; w += nb) {
        if (w < 4096) {
            int nt = w & 7, kt = (w >> 3) & 15, gu = (w >> 7) & 1, e = w >> 8;
            const float* src = p.in[gu ? I_MU : I_MG] + (size_t)(l * 16 + e) * D * 512;
            bf16* dst = p.wt_gu + (size_t)e * 1024 * D;
            conv_tile(src, 512, dst, D, kt * 64, nt * 64, [&](int nn) { int j = nt * 64 + nn; return (j >> 4) * 32 + (j & 15) + 16 * gu; }, sm);
        } else {
            int w2 = w - 4096; int nt = w2 & 15, kt = (w2 >> 4) & 7, e = w2 >> 7;
            const float* src = p.in[I_MD] + (size_t)(l * 16 + e) * 512 * D;
            bf16* dst = p.wt_d + (size_t)e * D * 512;
            conv_tile(src, D, dst, 512, kt * 64, nt * 64, [&](int nn) { return nt * 64 + nn; }, sm);
        }
    }
}
#endif
HD void convert_static(const Params& p, int bid, int nb, float* sm, int part) {
    for (int w = bid; w < 3456 + 512 + 512 + 32; w += nb) {
        {
            const bool is_win = (w < 3456), is_ab = (w >= 3456 + 512 + 512);
            const int wl = is_win ? (w / (108 * 16)) : (is_ab ? ((w - 3456 - 512 - 512) >> 4) : 1);
            const bool early = (is_win || is_ab) && wl == 0;
            if ((part == 0) != early) continue;
        }
        if (w >= 3456 + 512 + 512) {
            int w2 = w - 3456 - 512 - 512; int kt = w2 & 15, l = w2 >> 4;
            conv_tile(p.in[I_WIN] + (size_t)l * D * DIN, DIN, p.wt_in + (size_t)l * WIN_NP * D, D, kt * 64, 2560, [&](int nn) { return WIN_N + nn; }, sm);
        } else if (w < 3456) {
            int nt = w % 108, kt = (w / 108) & 15, l = w / (108 * 16);
            int n0 = nt * 64;
#ifndef CPU_EMU
            if (n0 >= PLD) {
                conv_tile8(p.in[I_WIN] + (size_t)l * D * DIN, DIN, (unsigned char*)(p.wt_in + (size_t)l * WIN_NP * D + (size_t)PLD * D), D, kt * 64, n0 + 16,
                           [&](int nn) { return n0 - PLD + nn; }, 32.0f, sm);
                continue;
            }
#endif
            conv_tile(p.in[I_WIN] + (size_t)l * D * DIN, DIN, p.wt_in + (size_t)l * WIN_NP * D, D, kt * 64, n0 < 2560 ? n0 : n0 + 16,
                      [&](int nn) { return n0 + nn; }, sm);
        } else if (w < 3456 + 512) {
            int w2 = w - 3456; int nt = w2 & 15, kt = (w2 >> 4) & 3, li = w2 >> 6;
            conv_tile(p.in[I_WBR] + (size_t)li * 256 * D, D, p.wt_br + (size_t)li * D * 256, 256, kt * 64, nt * 64, [&](int nn) { return nt * 64 + nn; }, sm);
        } else {
            int w2 = w - 3456 - 512; int nt = w2 & 15, kt = (w2 >> 4) & 15, l = w2 >> 8;
            conv_tile(p.in[I_WOUT] + (size_t)l * D * D, D, p.wt_out + (size_t)l * D * D, D, kt * 64, nt * 64, [&](int nn) { return nt * 64 + nn; }, sm);
        }
    }
}

#ifndef CPU_EMU
HD void dep_signal(int* cnt) {
    asm volatile("s_waitcnt vmcnt(0)" ::: "memory");
    __syncthreads();
    if (tid_() == 0) {
        __builtin_amdgcn_fence(__ATOMIC_RELEASE, "agent");
        asm volatile("s_waitcnt vmcnt(0)" ::: "memory");
        (void)__hip_atomic_fetch_add(cnt, 1, __ATOMIC_RELAXED, __HIP_MEMORY_SCOPE_AGENT);
    }
}
HD void dep_wait(int* cnt, int target) {
    if (tid_() == 0) {
        unsigned sp = 0;
        while (__hip_atomic_load(cnt, __ATOMIC_RELAXED, __HIP_MEMORY_SCOPE_AGENT) < target) { __builtin_amdgcn_s_sleep(4); if (++sp > (1u << 22)) break; }
        __builtin_amdgcn_fence(__ATOMIC_ACQUIRE, "agent");
        asm volatile("s_waitcnt vmcnt(0)" ::: "memory");
    }
    __syncthreads();
}
#endif
HD void init_tables(const Params& p, int bid, int nb) {
    for (int u = bid; u < (SEQ + 255) / 256; u += nb) {
        THREADS(t, 256) {
            int j = u * 256 + t;
            if (j < SEQ) { float a = 2.0f * (float)j / (float)SEQ; p.cosT[j] = COSPI(a); p.sinT[j] = SINPI(a); }
        }
    }
    if (bid == 0) {
        THREADS(t, 1024) {
            int pos = t >> 3, f = t & 7; float fr_ = 1.0f;
            for (int q = 0; q < f; ++q) fr_ *= 0.31622776601683794f;
            float ang = (float)pos * fr_;
            p.ropeT[t * 2] = cosf(ang); p.ropeT[t * 2 + 1] = sinf(ang);
        }
    }
    for (int u = bid; u < (CTXL * 2 * CTXL) / 256; u += nb) {
        THREADS(t, 256) {
            int i = u * 256 + t; int k = i / (2 * CTXL), q = i % (2 * CTXL); int cs = q / CTXL, tt = q % CTXL;
            float a = 2.0f * (float)((k * tt) % CTXL) / (float)CTXL;
            p.fWC[i] = f2bf(cs ? -SINPI(a) : COSPI(a));
        }
    }
    for (int u = bid; u < (8192 + 65536 + 8192) / 256; u += nb) {
        THREADS(t, 256) {
            int i = u * 256 + t;
            if (i < 8192) {
                int j = i >> 6, c = i & 63; int cs = j >> 6, m = j & 63;
                float a = 2.0f * (float)((m * c) & 63) / 64.0f;
                p.fW1[i] = f2bf(cs ? SINPI(a) : COSPI(a));
            } else if (i < 8192 + 65536) {
                int q = i - 8192; int n = q >> 8, k = q & 255;
                int ri = (n >> 4) & 1, k1 = (n >> 5) * 16 + (n & 15); int cs = k >> 7, t1 = k & 127;
                float a = 2.0f * (float)((k1 * t1) & 127) / 128.0f;
                float cv = COSPI(a), sv = SINPI(a);
                float v = (ri == 0) ? (cs == 0 ? cv : -sv) : (cs == 0 ? -sv : -cv);
                p.fWA[q] = f2bf(v);
            } else {
                int q = i - 8192 - 65536; int k2 = q >> 7, k = q & 127; int ri = k >> 6, t2 = k & 63;
                float a = 2.0f * (float)((k2 * t2) & 63) / 64.0f;
                p.fWB[q] = f2bf(ri ? SINPI(a) : COSPI(a));
            }
        }
    }
}

HD void ph_init(const Params& p, int bid, int nb, float* sm) {
    const int NMOD = 2 * 3 * 6144;
    if (bid == 0) { THREADS(t, 32) { p.cnt[t] = 0; } }
#ifndef CPU_EMU
    {
        const int tq = tid_(); const int col = tq & 63, ks = tq >> 6;
        for (int u = nb - 1 - bid; u < 2 * 96; u += nb) {
            const int l = u / 96, c0 = (u % 96) * 64;
            __syncthreads();
            for (int i = tq; i < 3 * D; i += 256) { const int s_ = i / D, k = i % D; const float cv = (s_ < 2) ? p.in[I_C][s_ * D + k] : p.in[I_CCTX][k]; sm[i] = siluf_(cv); }
            __syncthreads();
            const float* wp = p.in[I_WMOD] + (size_t)l * D * 6144 + (size_t)(ks * 256) * 6144 + c0 + col;
            float a0 = 0.f, a1 = 0.f, a2 = 0.f;
#pragma unroll 8
            for (int k = 0; k < 256; ++k) { const float wv = wp[(size_t)k * 6144]; a0 += sm[ks * 256 + k] * wv; a1 += sm[D + ks * 256 + k] * wv; a2 += sm[2 * D + ks * 256 + k] * wv; }
            float* red = sm + 3 * D;
            red[(ks * 3 + 0) * 64 + col] = a0; red[(ks * 3 + 1) * 64 + col] = a1; red[(ks * 3 + 2) * 64 + col] = a2;
            __syncthreads();
            if (tq < 192) {
                const int s_ = tq >> 6, cc = tq & 63;
                const float v = red[(0 * 3 + s_) * 64 + cc] + red[(1 * 3 + s_) * 64 + cc] + red[(2 * 3 + s_) * 64 + cc] + red[(3 * 3 + s_) * 64 + cc];
                p.mods[(size_t)(l * 3 + s_) * 6144 + c0 + cc] = v + p.in[I_BMOD][l * 6144 + c0 + cc];
            }
            if (l == 0) dep_signal(p.dep);
        }
    }
    convert_static(p, bid, nb, sm, 0);
#else
    convert_static(p, bid, nb, sm, 0);
    for (int u = bid; u < (NMOD + 255) / 256; u += nb) {
        THREADS(t, 256) {
            int idx = u * 256 + t;
            if (idx < NMOD) {
                int l = idx / (3 * 6144), s = (idx / 6144) % 3, col = idx % 6144;
                const float* cv = (s < 2) ? p.in[I_C] + s * D : p.in[I_CCTX];
                const float* w = p.in[I_WMOD] + (size_t)l * D * 6144 + col;
                float acc = 0.f;
                for (int k = 0; k < D; ++k) acc += siluf_(cv[k]) * w[(size_t)k * 6144];
                p.mods[idx] = acc + p.in[I_BMOD][l * 6144 + col];
            }
        }
    }
#endif
    init_tables(p, bid, nb);
    for (int u = bid; u < (NCTX * D) / 256; u += nb) {
        THREADS(t, 256) { int i = u * 256 + t; p.cs[i] = p.in[I_CTX][i]; }
    }

}

#ifndef CPU_EMU
HD float wave_sum(float v) {
#pragma unroll
    for (int o = 32; o >= 1; o >>= 1) v += __shfl_xor(v, o);
    return v;
}
HD void ph_norm1(const Params& p, int l, int bid, int nb, float* sm) {
    const int t = tid_(), lane = t & 63, w = t >> 6;
    const float* g = p.in[I_N1G] + l * D;
    for (int r = bid * 4 + w; r < R; r += nb * 4) {
        const float* x = xrow_in(p, l, r);
        const float* m = modrow(p, l, r);
        f32x4_t xv[4]; float ss = 0.f;
#pragma unroll
        for (int j = 0; j < 4; ++j) { xv[j] = *(const f32x4_t*)(x + j * 256 + lane * 4); ss += xv[j][0] * xv[j][0] + xv[j][1] * xv[j][1] + xv[j][2] * xv[j][2] + xv[j][3] * xv[j][3]; }
        ss = wave_sum(ss);
        const float rs = 1.0f / sqrtf(ss / D + 1e-6f);
#pragma unroll
        for (int j = 0; j < 4; ++j) {
            const int k = j * 256 + lane * 4;
            const f32x4_t gv = *(const f32x4_t*)(g + k), sc = *(const f32x4_t*)(m + 1024 + k), sh = *(const f32x4_t*)(m + k);
            float o[4];
#pragma unroll
            for (int q = 0; q < 4; ++q) o[q] = xv[j][q] * rs * gv[q] * (1.0f + sc[q]) + sh[q];
            uint2 pk; pk.x = cvtpk(o[0], o[1]); pk.y = cvtpk(o[2], o[3]);
            *(uint2*)(p.h + (size_t)r * D + k) = pk;
            *(unsigned*)(h8_of(p) + (size_t)r * D + k) = pack_fp8x4(o[0] * 4.f, o[1] * 4.f, o[2] * 4.f, o[3] * 4.f);
        }
    }
}
#else
HD void ph_norm1(const Params& p, int l, int bid, int nb, float* sm) {
    const float* g = p.in[I_N1G] + l * D;
    for (int r = bid; r < R; r += nb) {
        const float* x = xrow_in(p, l, r);
        const float* m = modrow(p, l, r);
        THREADS(t, 256) { float s = 0.f; for (int k = t; k < D; k += 256) s += x[k] * x[k]; sm[t] = s; }
        SYNC
        THREADS(t, 1) { float s = 0.f; for (int i = 0; i < 256; ++i) s += sm[i]; sm[256] = s; }
        SYNC
        THREADS(t, 256) {
            float rs = 1.0f / sqrtf(sm[256] / D + 1e-6f);
            for (int k = t; k < D; k += 256) {
                float v = x[k] * rs * g[k];
                p.h[(size_t)r * D + k] = f2bf(v * (1.0f + m[1024 + k]) + m[k]);
            }
        }
        SYNC
    }
}
#endif

HD void ph_inproj(const Params& p, int l, int bid, int nb, char* smc) {
    const bf16* Wt = p.wt_in + (size_t)l * WIN_NP * D;
    constexpr int NT = PLD / 128, MT = R / 128;
    for (int mt = bid; mt < MT; mt += nb) {
        ACC_DECL(2, acc); acc_zero(acc);
        gemm_accum<2>(acc, [&](int i) { return p.h + (size_t)(mt * 128 + i) * D; }, [&](int j) { return Wt + (size_t)(WIN_N + j) * D; }, D, smc);
        ACC_FOR(2, row, col) {
            const int r = mt * 128 + row;
            if (col < 8) {
                const float xx = AV(acc) + p.in[I_DTB][l * 8 + col];
                const float sp = xx > 20.f ? xx : log1pf(expf(xx));
                p.gg[(size_t)col * R + r] = -expf(p.in[I_ALOG][l * 8 + col]) * sp;
            } else if (col < 16) p.gbeta[(size_t)(col - 8) * R + r] = sigmoidf_(AV(acc));
        } ACC_END
    }
    for (int tile = bid; tile < MT * NT; tile += nb) {
        const int mt = tile / NT, nt = tile % NT;
        ACC_DECL(4, acc); acc_zero(acc);
        gemm_accum<4>(acc, [&](int i) { return p.h + (size_t)(mt * 128 + i) * D; }, [&](int j) { return Wt + (size_t)(nt * 128 + j) * D; }, D, smc);
#ifndef CPU_EMU
        {
            float* tl = (float*)smc;
            acc_to_lds<4>(acc, tl);
            __syncthreads();
            const int t_ = tid_(); const int row = t_ >> 1, half = t_ & 1;
            const int cb = nt * 128 + half * 64;
            float v[64];
#pragma unroll
            for (int q = 0; q < 16; ++q) { const f32x4_t x4 = *(const f32x4_t*)(tl + row * 132 + half * 64 + q * 4); v[q * 4] = x4[0]; v[q * 4 + 1] = x4[1]; v[q * 4 + 2] = x4[2]; v[q * 4 + 3] = x4[3]; }
            if (cb < 512) {
                const float* gn = (cb < 256 ? p.in[I_NAQG] : p.in[I_NAKG]) + l * 64;
                float ss = 0.f;
#pragma unroll
                for (int c = 0; c < 64; ++c) ss += v[c] * v[c];
                const float rs = __builtin_amdgcn_rsqf(ss * (1.0f / 64.0f) + 1e-6f) * ((cb < 256) ? 0.125f * 1.4426950408889634f : 1.0f);
#pragma unroll
                for (int c = 0; c < 64; ++c) v[c] *= rs * gn[c];
            } else if (cb >= 768 && cb < 1280) {
                const float* gn = (cb < 1024 ? p.in[I_DAQG] : p.in[I_DAKG]) + l * 32;
                const float qs = (cb < 1024) ? 0.17677669529663687f * 1.4426950408889634f : 1.0f;
#pragma unroll
                for (int gp = 0; gp < 2; ++gp) {
                    float ss = 0.f;
#pragma unroll
                    for (int c = 0; c < 32; ++c) ss += v[gp * 32 + c] * v[gp * 32 + c];
                    const float rs = __builtin_amdgcn_rsqf(ss * (1.0f / 32.0f) + 1e-6f) * qs;
#pragma unroll
                    for (int c = 0; c < 32; ++c) v[gp * 32 + c] *= rs * gn[c];
                }
                const int gr_ = mt * 128 + row;
                if (gr_ < NLAT) {
                    const int tt = gr_ % SEQ;
#pragma unroll
                    for (int a = 0; a < 2; ++a) {
                        const float pos = (float)(a == 0 ? tt / GW : tt % GW);
                        float frev = 0.15915494309189535f;
#pragma unroll
                        for (int f = 0; f < 8; ++f) {
                            const float cs = __builtin_amdgcn_cosf(pos * frev), sn = __builtin_amdgcn_sinf(pos * frev);
#pragma unroll
                            for (int gp = 0; gp < 2; ++gp) {
                                const int i1 = gp * 32 + a * 16 + f, i2 = i1 + 8;
                                const float x1 = v[i1], x2 = v[i2];
                                v[i1] = x1 * cs - x2 * sn; v[i2] = x2 * cs + x1 * sn;
                            }
                            frev *= 0.31622776601683794f;
                        }
                    }
                }
            }
            bf16* dst = p.P + (size_t)(mt * 128 + row) * PLD + cb;
#pragma unroll
            for (int q = 0; q < 8; ++q) {
                uint4 pk; pk.x = cvtpk(v[q * 8], v[q * 8 + 1]); pk.y = cvtpk(v[q * 8 + 2], v[q * 8 + 3]); pk.z = cvtpk(v[q * 8 + 4], v[q * 8 + 5]); pk.w = cvtpk(v[q * 8 + 6], v[q * 8 + 7]);
                *(uint4*)(dst + q * 8) = pk;
            }
        }
#else
        ACC_FOR(4, row, col) { p.P[(size_t)(mt * 128 + row) * PLD + nt * 128 + col] = f2bf(AV(acc)); } ACC_END
#endif
    }
}

HD void ph_prep(const Params& p, int l, int bid, int nb) {
#ifdef CPU_EMU
    {
        const float* naq = p.in[I_NAQG] + l * 64; const float* nak = p.in[I_NAKG] + l * 64;
        const float* daq = p.in[I_DAQG] + l * 32; const float* dak = p.in[I_DAKG] + l * 32;
        const int N = R * 24;
        for (int u = bid; u < (N + 255) / 256; u += nb) {
            THREADS(t, 256) {
                int idx = u * 256 + t;
                if (idx < N) {
                    int r = idx / 24, gidx = idx % 24;
                    if (gidx < 8) {
                        int isk = gidx >> 2, hd = gidx & 3;
                        bf16* ptr = p.P + (size_t)r * PLD + (isk ? C_NAK : C_NAQ) + hd * 64;
                        const float* g = isk ? nak : naq;
                        float ss = 0.f;
                        for (int d = 0; d < 64; ++d) { float v = bf2f(ptr[d]); ss += v * v; }
                        float rs = 1.0f / sqrtf(ss / 64.0f + 1e-6f);
#ifndef CPU_EMU
                        if (!isk) rs *= 0.125f * 1.4426950408889634f;
#endif
                        for (int d = 0; d < 64; ++d) ptr[d] = f2bf(bf2f(ptr[d]) * rs * g[d]);
                    } else {
                        int gi = gidx - 8; int isk = gi >> 3; int hm = gi & 7;
                        bf16* ptr = p.P + (size_t)r * PLD + (isk ? C_DAK : C_DAQ) + hm * 32;
                        const float* g = isk ? dak : daq;
                        float ss = 0.f;
                        for (int d = 0; d < 32; ++d) { float v = bf2f(ptr[d]); ss += v * v; }
                        float rs = 1.0f / sqrtf(ss / 32.0f + 1e-6f);
#ifndef CPU_EMU
                        if (!isk) rs *= 0.17677669529663687f * 1.4426950408889634f;
#endif
                        if (r < NLAT) {
                            int tt = r % SEQ; float prow = (float)(tt / GW), pcol = (float)(tt % GW);
                            for (int a = 0; a < 2; ++a) {
                                float pos = a == 0 ? prow : pcol;
                                float fr = 1.0f;
                                for (int f = 0; f < 8; ++f) {
                                    float ang = pos * fr;
                                    float cs = cosf(ang), sn = sinf(ang);
                                    int i1 = a * 16 + f, i2 = a * 16 + 8 + f;
                                    float x1 = bf2f(ptr[i1]) * rs * g[i1], x2 = bf2f(ptr[i2]) * rs * g[i2];
                                    ptr[i1] = f2bf(x1 * cs - x2 * sn);
                                    ptr[i2] = f2bf(x2 * cs + x1 * sn);
                                    fr *= 0.31622776601683794f;
                                }
                            }
                        } else {
                            for (int d = 0; d < 32; ++d) ptr[d] = f2bf(bf2f(ptr[d]) * rs * g[d]);
                        }
                    }
                }
            }
        }
    }
#endif
#ifndef CPU_EMU
    {
        const float* cw = p.in[I_CONVW] + (size_t)l * 5 * 768;
        const int N = R * 96;
        for (int idx = bid * 256 + tid_(); idx < N; idx += nb * 256) {
            const int r = idx / 96, q = idx % 96; const int ph = q >> 3, cg = q & 7; const int part = ph >> 2, hd = ph & 3;
            const RowInfo ri = rowinfo(r);
            const int ch0 = part * 256 + hd * 64 + cg * 8;
            float y[8];
#pragma unroll
            for (int c = 0; c < 8; ++c) y[c] = 0.f;
#pragma unroll
            for (int i = 0; i < 5; ++i) {
                const int tt = ri.t + i - 2;
                if (tt >= 0 && tt < ri.T) {
                    const uint4 raw = *(const uint4*)(p.P + (size_t)(ri.base + tt) * PLD + C_GQ + ch0);
                    const f32x4_t w0 = *(const f32x4_t*)(cw + i * 768 + ch0), w1 = *(const f32x4_t*)(cw + i * 768 + ch0 + 4);
                    y[0] += __uint_as_float(raw.x << 16) * w0[0]; y[1] += __uint_as_float(raw.x & 0xffff0000u) * w0[1];
                    y[2] += __uint_as_float(raw.y << 16) * w0[2]; y[3] += __uint_as_float(raw.y & 0xffff0000u) * w0[3];
                    y[4] += __uint_as_float(raw.z << 16) * w1[0]; y[5] += __uint_as_float(raw.z & 0xffff0000u) * w1[1];
                    y[6] += __uint_as_float(raw.w << 16) * w1[2]; y[7] += __uint_as_float(raw.w & 0xffff0000u) * w1[3];
                }
            }
            float ss = 0.f;
#pragma unroll
            for (int c = 0; c < 8; ++c) { y[c] = siluf_(y[c]); ss += y[c] * y[c]; }
            ss += __shfl_xor(ss, 1); ss += __shfl_xor(ss, 2); ss += __shfl_xor(ss, 4);
            float scl = 1.0f;
            if (part == 0) scl = 0.125f / sqrtf(ss + 1e-6f); else if (part == 1) scl = 1.0f / sqrtf(ss + 1e-6f);
            uint4 pk; pk.x = cvtpk(y[0] * scl, y[1] * scl); pk.y = cvtpk(y[2] * scl, y[3] * scl); pk.z = cvtpk(y[4] * scl, y[5] * scl); pk.w = cvtpk(y[6] * scl, y[7] * scl);
            *(uint4*)(p.gq + (size_t)r * 768 + ch0) = pk;
        }
    }
#else
    {
        const float* cw = p.in[I_CONVW] + (size_t)l * 5 * 768;
        const int N = R * 12;
        for (int u = bid; u < (N + 255) / 256; u += nb) {
            THREADS(t, 256) {
                int idx = u * 256 + t;
                if (idx < N) {
                    int r = idx / 12, ph = idx % 12; int part = ph >> 2, hd = ph & 3;
                    RowInfo ri = rowinfo(r);
                    int ch0 = part * 256 + hd * 64;
                    float ss = 0.f;
                    for (int pass = 0; pass < 2; ++pass) {
                        float scl = 1.0f;
                        if (pass == 1) { if (part == 0) scl = 0.125f / sqrtf(ss + 1e-6f); else if (part == 1) scl = 1.0f / sqrtf(ss + 1e-6f); }
                        if (pass == 0 && part == 2) continue;
                        for (int c = 0; c < 64; ++c) {
                            float y = 0.f;
                            for (int i = 0; i < 5; ++i) {
                                int tt = ri.t + i - 2;
                                if (tt >= 0 && tt < ri.T) y += bf2f(p.P[(size_t)(ri.base + tt) * PLD + C_GQ + ch0 + c]) * cw[i * 768 + ch0 + c];
                            }
                            y = siluf_(y);
                            if (pass == 0) ss += y * y; else p.gq[(size_t)r * 768 + ch0 + c] = f2bf(y * scl);
                        }
                    }
                }
            }
        }
    }
#endif
    {
        const int RQ = (l == 0) ? R : NLAT;
        for (int r = (FOURIER_GEMM ? RQ : 0) + bid; r < RQ; r += nb) {
            THREADS(t, 256) {
                int g = t >> 6, m = t & 63;
                const bf16* f = p.P + (size_t)r * PLD + C_F + g * 64;
                float fc = 0.f, fs = 0.f;
                for (int c = 0; c < 64; ++c) {
                    int ti = ((m * c) & 63) * (SEQ / 64);
                    float v = bf2f(f[c]);
                    fc += v * p.cosT[ti]; fs += v * p.sinT[ti];
                }
                p.fcs[(size_t)r * 512 + t] = f2bf(fc);
                p.fcs[(size_t)r * 512 + 256 + t] = f2bf(fs);
                if (FOURIER_GEMM && r >= NLAT) {
                    const int rc = r - NLAT; const int bb = rc / CTXL, tt = rc % CTXL;
                    bf16* xc = p.fXC + (((size_t)bb * 256 + t) * 2) * CTXL + tt;
                    xc[0] = f2bf(fc); xc[CTXL] = f2bf(fs);
                }
            }
        }
    }
}

#ifndef CPU_EMU
HD void ph_na(const Params& p, int l, int bid, int nb, char* smc) {
    const int t = tid_(), lane = t & 63, w = t >> 6, fr = lane & 15, fg = lane >> 4;
    const float* rpb = p.in[I_RPB] + (size_t)l * 4 * 15 * 31;
    float* sbias = (float*)(smc + 32768);
    const lds_cptr lds = (lds_cptr)smc;
    constexpr int WH = ROWS < 8 ? ROWS : 8;
    const int nlat = NB * ROWS * 4;
    const int nctx = (l == 0) ? NB * 4 * (CTXL / 64) : 0;
    const int lkey = t >> 3, lc = t & 7;
    const int ksrc = (lc ^ (lkey & 7)) << 3;
    const int vsrc = ((((lc >> 1) ^ ((lkey >> 1) & 3)) << 1) | (lc & 1)) << 3;
    for (int unit = bid; unit < nlat + nctx; unit += nb) {
        int b, hd, qrow, ntl, rs = 0, gr = 0;
        if (unit < nlat) {
            hd = unit & 3; const int br_ = unit >> 2; gr = br_ % ROWS; b = br_ / ROWS;
            qrow = b * SEQ + gr * GW + w * 16 + fr; ntl = WH;
            rs = gr - WH / 2; if (rs < 0) rs = 0; if (rs > ROWS - WH) rs = ROWS - WH;
        } else {
            const int u2 = unit - nlat; const int qt = u2 % (CTXL / 64); const int bh = u2 / (CTXL / 64); hd = bh & 3; b = bh >> 2;
            qrow = NLAT + b * CTXL + qt * 64 + w * 16 + fr; ntl = 0;
        }
        const int ntiles = ntl + NCC;
        const int qcol = w * 16 + fr;
        int cs0 = w * 16 - 8; if (cs0 < 0) cs0 = 0; if (cs0 > GW - 32) cs0 = GW - 32;
        int wsq = qcol - 8; if (wsq < 0) wsq = 0; if (wsq > GW - 16) wsq = GW - 16;
        bf16x8_t qf[2];
#pragma unroll
        for (int s_ = 0; s_ < 2; ++s_) qf[s_] = *(const bf16x8_t*)(p.P + (size_t)qrow * PLD + C_NAQ + hd * 64 + s_ * 32 + fg * 8);
        f32x4_t O[4];
#pragma unroll
        for (int d = 0; d < 4; ++d) O[d] = f32x4_t{0.f, 0.f, 0.f, 0.f};
        float ls = 0.f;
        auto keyrow = [&](int tt, int i) { return (tt < ntl) ? (b * SEQ + (rs + tt) * GW + i) : (NLAT + b * CTXL + (tt - ntl) * 64 + i); };
        char* ldst = smc + w * 1024;
        __syncthreads();
        for (int i = t; i < 15 * 31; i += 256) sbias[i] = rpb[hd * 465 + i] * 1.4426950408889634f;
#pragma unroll
        for (int i = 0; i < 2; ++i) {
            const bf16* src = p.P + (size_t)keyrow(0, lkey + 32 * i) * PLD + hd * 64;
            GLDS16(src + C_NAK + ksrc, ldst + 4096 * i); GLDS16(src + C_NAV + vsrc, ldst + 16384 + 4096 * i);
        }
        WAIT_VM0();
        __syncthreads();
        const int vkl = 4 * fg + (fr >> 2);
        const int vsw = (vkl >> 1) & 3;
        unsigned va[4];
#pragma unroll
        for (int d = 0; d < 4; ++d) va[d] = 16384 + vkl * 128 + ((((d ^ vsw) << 1) | ((fr & 3) >> 1)) << 4) + (fr & 1) * 8;
#pragma unroll 1
        for (int tt = 0; tt < ntiles; ++tt) {
            const int cur = tt & 1;
            if (tt + 1 < ntiles) {
#pragma unroll
                for (int i = 0; i < 2; ++i) {
                    const bf16* src = p.P + (size_t)keyrow(tt + 1, lkey + 32 * i) * PLD + hd * 64;
                    GLDS16(src + C_NAK + ksrc, ldst + (cur ^ 1) * 8192 + 4096 * i); GLDS16(src + C_NAV + vsrc, ldst + 16384 + (cur ^ 1) * 8192 + 4096 * i);
                }
            }
            const char* cK = smc + cur * 8192;
            const lds_cptr cV = lds + cur * 8192;
            const bool local = tt < ntl;
            const int kbase = local ? cs0 : 0;
            const int nkf = local ? 2 : 4;
            unsigned pb[2][4];
#pragma unroll
            for (int f = 0; f < 4; ++f) {
                if (f < nkf) {
                    const int key = kbase + f * 16 + fr;
                    const char* kp = cK + key * 128;
                    const bf16x8_t a0 = *(const bf16x8_t*)(kp + (((fg) ^ (fr & 7)) << 4));
                    const bf16x8_t a1 = *(const bf16x8_t*)(kp + (((4 + fg) ^ (fr & 7)) << 4));
                    f32x4_t S = __builtin_amdgcn_mfma_f32_16x16x32_bf16(a0, qf[0], f32x4_t{0.f, 0.f, 0.f, 0.f}, 0, 0, 0);
                    S = __builtin_amdgcn_mfma_f32_16x16x32_bf16(a1, qf[1], S, 0, 0, 0);
                    float e[4];
#pragma unroll
                    for (int r = 0; r < 4; ++r) {
                        float sv = S[r]; bool ok = true;
                        if (local) {
                            const int kc = kbase + f * 16 + 4 * fg + r;
                            ok = (unsigned)(kc - wsq) < 16u;
                            sv += sbias[((rs + tt) - gr + 7) * 31 + (ok ? (kc - qcol + 15) : 15)];
                        }
                        e[r] = ok ? __builtin_amdgcn_exp2f(sv) : 0.f;
                    }
                    ls += (e[0] + e[1]) + (e[2] + e[3]);
                    pb[f >> 1][(f & 1) * 2] = cvtpk(e[0], e[1]);
                    pb[f >> 1][(f & 1) * 2 + 1] = cvtpk(e[2], e[3]);
                }
            }
#pragma unroll
            for (int ks = 0; ks < 2; ++ks) {
                if (ks * 2 < nkf) {
#pragma unroll
                    for (int d = 0; d < 4; ++d) {
                        const s16x4_t lo = lds_tr16(cV + va[d] + (kbase + ks * 32) * 128);
                        const s16x4_t hi = lds_tr16(cV + va[d] + (kbase + ks * 32 + 16) * 128);
                        const bf16x8_t vf = bf16x8_t{lo[0], lo[1], lo[2], lo[3], hi[0], hi[1], hi[2], hi[3]};
                        const i32x4_t bi = i32x4_t{(int)pb[ks][0], (int)pb[ks][1], (int)pb[ks][2], (int)pb[ks][3]};
                        O[d] = __builtin_amdgcn_mfma_f32_16x16x32_bf16(vf, __builtin_bit_cast(bf16x8_t, bi), O[d], 0, 0, 0);
                    }
                }
            }
            WAIT_VM0();
            __syncthreads();
        }
        ls += __shfl_xor(ls, 16); ls += __shfl_xor(ls, 32);
        const float inv = 1.0f / ls;
        bf16* op = p.br + (size_t)qrow * D + hd * 64;
#pragma unroll
        for (int d = 0; d < 4; ++d) {
            uint2 pk; pk.x = cvtpk(O[d][0] * inv, O[d][1] * inv); pk.y = cvtpk(O[d][2] * inv, O[d][3] * inv);
            *(uint2*)(op + d * 16 + 4 * fg) = pk;
        }
    }
}
#else
HD void ph_na(const Params& p, int l, int bid, int nb, char*) {
    const float* rpb = p.in[I_RPB] + (size_t)l * 4 * 15 * 31;
    const int RQ = (l == 0) ? R : NLAT;
    const int N = RQ * 4;
    const int wh = ROWS < 8 ? ROWS : 8;
    for (int u = bid; u < (N + 255) / 256; u += nb) {
        THREADS(t, 256) {
            int idx = u * 256 + t;
            if (idx < N) {
                int hd = idx / RQ, r = idx % RQ;
                RowInfo ri = rowinfo(r);
                float q[64], o[64];
                const bf16* qp = p.P + (size_t)r * PLD + C_NAQ + hd * 64;
#pragma unroll
                for (int d = 0; d < 64; ++d) { q[d] = bf2f(qp[d]) * 0.125f; o[d] = 0.f; }
                float mx = -1e30f, lsum = 0.f;
                int nloc = 0, rs = 0, ws = 0, gr = 0, gc = 0;
                if (ri.seg == 0) {
                    gr = ri.t / GW; gc = ri.t % GW;
                    rs = gr - wh / 2; if (rs < 0) rs = 0; if (rs > ROWS - wh) rs = ROWS - wh;
                    ws = gc - 8; if (ws < 0) ws = 0; if (ws > GW - 16) ws = GW - 16;
                    nloc = wh * 16;
                }
                int ctxbase = NLAT + ri.b * CTXL;
                for (int kk = 0; kk < nloc + CTXL; ++kk) {
                    int kr; float bias = 0.f;
                    if (kk < nloc) {
                        int a = kk >> 4, c = kk & 15;
                        int krow = rs + a, kcol = ws + c;
                        kr = ri.base + krow * GW + kcol;
                        bias = rpb[(hd * 15 + (krow - gr + 7)) * 31 + (kcol - gc + 15)];
                    } else kr = ctxbase + (kk - nloc);
                    const bf16* kp = p.P + (size_t)kr * PLD + C_NAK + hd * 64;
                    float s = 0.f;
#pragma unroll
                    for (int d = 0; d < 64; ++d) s += q[d] * bf2f(kp[d]);
                    s += bias;
                    if (s > mx) { float f = expf(mx - s); lsum *= f;
#pragma unroll
                        for (int d = 0; d < 64; ++d) o[d] *= f;
                        mx = s; }
                    float e = expf(s - mx);
                    lsum += e;
                    const bf16* vp = p.P + (size_t)kr * PLD + C_NAV + hd * 64;
#pragma unroll
                    for (int d = 0; d < 64; ++d) o[d] += e * bf2f(vp[d]);
                }
                float inv = 1.0f / lsum;
                bf16* op = p.br + (size_t)r * D + hd * 64;
#pragma unroll
                for (int d = 0; d < 64; ++d) op[d] = f2bf(o[d] * inv);
            }
        }
    }
}

#endif

#ifndef CPU_EMU
HD void ph_da(const Params& p, int l, int bid, int nb, char* smc) {
    const int t = tid_(), lane = t & 63, w = t >> 6, fr = lane & 15, fg = lane >> 4;
    const float lam_init = lam_init_of(l);
    float s1 = 0.f, s2 = 0.f;
    for (int d = 0; d < 32; ++d) {
        s1 += p.in[I_LQ1][l * 32 + d] * p.in[I_LK1][l * 32 + d];
        s2 += p.in[I_LQ2][l * 32 + d] * p.in[I_LK2][l * 32 + d];
    }
    const float lam = expf(s1) - expf(s2) + lam_init;
    const float* sg = p.in[I_SUBLN] + l * 64;
    constexpr int NQT = SEQ / 128, NQC = CTXL / 128;
    const int nlat = NB * 4 * NQT;
    const int nctx = (l == 0) ? NB * 4 * NQC : 0;
    const lds_cptr lds = (lds_cptr)smc;
    for (int unit = bid; unit < nlat + nctx; unit += nb) {
        int b, hd, qrow0, kt0;
        if (unit < nlat) { const int qt = unit % NQT, bh = unit / NQT; hd = bh & 3; b = bh >> 2; qrow0 = b * SEQ + qt * 128; kt0 = 0; }
        else { const int u2 = unit - nlat; const int qt = u2 % NQC, bh = u2 / NQC; hd = bh & 3; b = bh >> 2; qrow0 = NLAT + b * CTXL + qt * 128; kt0 = NCL; }
        const int kt1 = NCL + NCC;
        bf16x8_t qf[2][2];
#pragma unroll
        for (int m = 0; m < 2; ++m)
#pragma unroll
            for (int n = 0; n < 2; ++n)
                qf[m][n] = *(const bf16x8_t*)(p.P + (size_t)(qrow0 + w * 32 + n * 16 + fr) * PLD + C_DAQ + hd * 64 + m * 32 + fg * 8);
        f32x4_t O[2][4][2];
#pragma unroll
        for (int m = 0; m < 2; ++m)
#pragma unroll
            for (int d = 0; d < 4; ++d)
#pragma unroll
                for (int n = 0; n < 2; ++n) O[m][d][n] = f32x4_t{0.f, 0.f, 0.f, 0.f};
        f32x4_t L5[2][2];
#pragma unroll
        for (int m = 0; m < 2; ++m)
#pragma unroll
            for (int n = 0; n < 2; ++n) L5[m][n] = f32x4_t{0.f, 0.f, 0.f, 0.f};
        const short one_ = (fr == 0) ? (short)0x3f80 : (short)0;
        const bf16x8_t onesf = bf16x8_t{one_, one_, one_, one_, one_, one_, one_, one_};
        const int lkey = t >> 3, lc = t & 7;
        const int ksrc = (lc ^ (lkey & 7)) << 3;
        const int vsrc = ((((lc >> 1) ^ ((lkey >> 1) & 3)) << 1) | (lc & 1)) << 3;
        auto keyrow = [&](int kt, int i) { return (kt < NCL) ? (b * SEQ + kt * 64 + i) : (NLAT + b * CTXL + (kt - NCL) * 64 + i); };
        char* ldst = smc + w * 1024;
        __syncthreads();
#pragma unroll
        for (int i = 0; i < 2; ++i) {
            const bf16* src = p.P + (size_t)keyrow(kt0, lkey + 32 * i) * PLD + hd * 64;
            GLDS16(src + C_DAK + ksrc, ldst + 4096 * i); GLDS16(src + C_DAV + vsrc, ldst + 16384 + 4096 * i);
        }
        WAIT_VM0();
        __syncthreads();
        const unsigned ka0 = fr * 128 + (((fg) ^ (fr & 7)) << 4);
        const unsigned ka1 = fr * 128 + (((4 + fg) ^ (fr & 7)) << 4);
        const int vkey = 4 * fg + (fr >> 2);
        const int vsw = (vkey >> 1) & 3;
        unsigned va[4];
#pragma unroll
        for (int d = 0; d < 4; ++d) va[d] = 16384 + vkey * 128 + ((((d ^ vsw) << 1) | ((fr & 3) >> 1)) << 4) + (fr & 1) * 8;
#pragma unroll 1
        for (int kt = kt0; kt < kt1; ++kt) {
            const int cur = (kt - kt0) & 1;
            if (kt + 1 < kt1) {
#pragma unroll
                for (int i = 0; i < 2; ++i) {
                    const bf16* src = p.P + (size_t)keyrow(kt + 1, lkey + 32 * i) * PLD + hd * 64;
                    GLDS16(src + C_DAK + ksrc, ldst + (cur ^ 1) * 8192 + 4096 * i); GLDS16(src + C_DAV + vsrc, ldst + 16384 + (cur ^ 1) * 8192 + 4096 * i);
                }
            }
            const char* cK = smc + cur * 8192;
            const lds_cptr cV = lds + cur * 8192;
#pragma unroll
            for (int m = 0; m < 2; ++m) {
                unsigned pb[2][2][4];
                {
                    f32x4_t S[4][2];
#pragma unroll
                    for (int kf = 0; kf < 4; ++kf) {
                        const bf16x8_t a = *(const bf16x8_t*)(cK + (m ? ka1 : ka0) + kf * 2048);
#pragma unroll
                        for (int n = 0; n < 2; ++n) S[kf][n] = __builtin_amdgcn_mfma_f32_16x16x32_bf16(a, qf[m][n], f32x4_t{0.f, 0.f, 0.f, 0.f}, 0, 0, 0);
                    }
#pragma unroll
                    for (int kf = 0; kf < 4; ++kf)
#pragma unroll
                        for (int n = 0; n < 2; ++n) {
                            const float e0 = __builtin_amdgcn_exp2f(S[kf][n][0]), e1 = __builtin_amdgcn_exp2f(S[kf][n][1]);
                            const float e2 = __builtin_amdgcn_exp2f(S[kf][n][2]), e3 = __builtin_amdgcn_exp2f(S[kf][n][3]);
                            pb[n][kf >> 1][(kf & 1) * 2] = cvtpk(e0, e1);
                            pb[n][kf >> 1][(kf & 1) * 2 + 1] = cvtpk(e2, e3);
                        }
                }
#pragma unroll
                for (int ks = 0; ks < 2; ++ks)
#pragma unroll
                    for (int d = 0; d < 4; ++d) {
                        const s16x4_t lo = lds_tr16(cV + va[d] + ks * 4096);
                        const s16x4_t hi = lds_tr16(cV + va[d] + ks * 4096 + 2048);
                        const bf16x8_t vf = bf16x8_t{lo[0], lo[1], lo[2], lo[3], hi[0], hi[1], hi[2], hi[3]};
#pragma unroll
                        for (int n = 0; n < 2; ++n) {
                            const i32x4_t bi = i32x4_t{(int)pb[n][ks][0], (int)pb[n][ks][1], (int)pb[n][ks][2], (int)pb[n][ks][3]};
                            O[m][d][n] = __builtin_amdgcn_mfma_f32_16x16x32_bf16(vf, __builtin_bit_cast(bf16x8_t, bi), O[m][d][n], 0, 0, 0);
                            if (d == 0) L5[m][n] = __builtin_amdgcn_mfma_f32_16x16x32_bf16(onesf, __builtin_bit_cast(bf16x8_t, bi), L5[m][n], 0, 0, 0);
                        }
                    }
                asm volatile("" ::: "memory");
            }
            WAIT_VM0();
            __syncthreads();
        }
#pragma unroll
        for (int n = 0; n < 2; ++n) {
            const float l0 = __shfl(L5[0][n][0], fr), l1 = __shfl(L5[1][n][0], fr);
            const float i0 = 1.0f / l0, i1 = lam / l1;
            float ss = 0.f;
#pragma unroll
            for (int d = 0; d < 4; ++d)
#pragma unroll
                for (int r = 0; r < 4; ++r) { const float o = O[0][d][n][r] * i0 - O[1][d][n][r] * i1; O[0][d][n][r] = o; ss += o * o; }
            ss += __shfl_xor(ss, 16); ss += __shfl_xor(ss, 32);
            const float rs = (1.0f - lam_init) / sqrtf(ss / 64.0f + 1e-6f);
            bf16* op = p.br + (size_t)(qrow0 + w * 32 + n * 16 + fr) * D + 256 + hd * 64;
#pragma unroll
            for (int d = 0; d < 4; ++d) {
                const int dv = d * 16 + 4 * fg;
                const unsigned lo = cvtpk(O[0][d][n][0] * rs * sg[dv], O[0][d][n][1] * rs * sg[dv + 1]);
                const unsigned hi = cvtpk(O[0][d][n][2] * rs * sg[dv + 2], O[0][d][n][3] * rs * sg[dv + 3]);
                uint2 pk; pk.x = lo; pk.y = hi;
                *(uint2*)(op + dv) = pk;
            }
        }
    }
}
#else
HD void ph_da(const Params& p, int l, int bid, int nb, char*) {
    const int RQ = (l == 0) ? R : NLAT;
    const int N = RQ * 4;
    const float lam_init = lam_init_of(l);
    float s1 = 0.f, s2 = 0.f;
    for (int d = 0; d < 32; ++d) {
        s1 += p.in[I_LQ1][l * 32 + d] * p.in[I_LK1][l * 32 + d];
        s2 += p.in[I_LQ2][l * 32 + d] * p.in[I_LK2][l * 32 + d];
    }
    const float lam = expf(s1) - expf(s2) + lam_init;
    const float* sg = p.in[I_SUBLN] + l * 64;
    const float scale = 0.17677669529663687f;
    for (int u = bid; u < (N + 255) / 256; u += nb) {
        THREADS(t, 256) {
            int idx = u * 256 + t;
            if (idx < N) {
                int hd = idx / RQ, r = idx % RQ;
                RowInfo ri = rowinfo(r);
                float q0[32], q1[32], o0[64], o1[64];
                const bf16* qp = p.P + (size_t)r * PLD + C_DAQ + hd * 64;
#pragma unroll
                for (int d = 0; d < 32; ++d) { q0[d] = bf2f(qp[d]) * scale; q1[d] = bf2f(qp[32 + d]) * scale; }
#pragma unroll
                for (int d = 0; d < 64; ++d) { o0[d] = 0.f; o1[d] = 0.f; }
                float m0 = -1e30f, m1 = -1e30f, l0 = 0.f, l1 = 0.f;
                int nlat = (ri.seg == 0) ? SEQ : 0;
                int latbase = ri.b * SEQ, ctxbase = NLAT + ri.b * CTXL;
                for (int kk = 0; kk < nlat + CTXL; ++kk) {
                    int kr = (kk < nlat) ? latbase + kk : ctxbase + (kk - nlat);
                    const bf16* kp = p.P + (size_t)kr * PLD + C_DAK + hd * 64;
                    const bf16* vp = p.P + (size_t)kr * PLD + C_DAV + hd * 64;
                    float sa = 0.f, sb = 0.f;
#pragma unroll
                    for (int d = 0; d < 32; ++d) { sa += q0[d] * bf2f(kp[d]); sb += q1[d] * bf2f(kp[32 + d]); }
                    if (sa > m0) { float f = expf(m0 - sa); l0 *= f;
#pragma unroll
                        for (int d = 0; d < 64; ++d) o0[d] *= f;
                        m0 = sa; }
                    if (sb > m1) { float f = expf(m1 - sb); l1 *= f;
#pragma unroll
                        for (int d = 0; d < 64; ++d) o1[d] *= f;
                        m1 = sb; }
                    float ea = expf(sa - m0), eb = expf(sb - m1);
                    l0 += ea; l1 += eb;
#pragma unroll
                    for (int d = 0; d < 64; ++d) { float v = bf2f(vp[d]); o0[d] += ea * v; o1[d] += eb * v; }
                }
                float i0 = 1.0f / l0, i1 = lam / l1;
                float ss = 0.f;
#pragma unroll
                for (int d = 0; d < 64; ++d) { o0[d] = o0[d] * i0 - o1[d] * i1; ss += o0[d] * o0[d]; }
                float rs = (1.0f - lam_init) / sqrtf(ss / 64.0f + 1e-6f);
                bf16* op = p.br + (size_t)r * D + 256 + hd * 64;
#pragma unroll
                for (int d = 0; d < 64; ++d) op[d] = f2bf(o0[d] * rs * sg[d]);
            }
        }
    }
}

#endif

struct ChunkInfo { int dir, b, hd, n, seg, T, base, nloc; };
HD ChunkInfo chunkinfo(int unit) {
    ChunkInfo c;
    c.n = unit % NCH; int ch = unit / NCH; c.hd = ch & 3; c.b = (ch >> 2) % NB; c.dir = ch / (4 * NB);
    if (c.n < NCC) { c.seg = 1; c.T = CTXL; c.base = NLAT + c.b * CTXL; c.nloc = c.n; }
    else { c.seg = 0; c.T = SEQ; c.base = c.b * SEQ; c.nloc = c.n - NCC; }
    return c;
}
HD int chunk_row(const ChunkInfo& c, int i) { int pf = c.nloc * 64 + i; return c.base + (c.dir ? (c.T - 1 - pf) : pf); }

#ifndef CPU_EMU
HD void ph_gdn_chunk(const Params& p, int l, int bid, int nb, float* smf) {
    char* smc = (char*)smf;
    const int t = tid_(), lane = t & 63, w = t >> 6, fr = lane & 15, fg = lane >> 4;
    float* sA = (float*)(smc + 24576); float* sG = (float*)(smc + 40960); float* sB = (float*)(smc + 41216);
    const int lkey = t >> 3, lc = t & 7;
    const int ksrc = (lc ^ (lkey & 7)) << 3;
    char* ldst = smc + w * 1024;
    for (int unit = bid; unit < NUNIT; unit += nb) {
        const ChunkInfo c = chunkinfo(unit);
        const int dh = c.dir * 4 + c.hd;
        __syncthreads();
#pragma unroll
        for (int i = 0; i < 2; ++i) {
            const bf16* src = p.gq + (size_t)chunk_row(c, lkey + 32 * i) * 768 + c.hd * 64;
            GLDS16(src + 256 + ksrc, ldst + 4096 * i);
            GLDS16(src + ksrc, ldst + 8192 + 4096 * i);
            GLDS16(src + 512 + lc * 8, ldst + 16384 + 4096 * i);
        }
        if (w == 0) {
            const int row = chunk_row(c, lane);
            float x = p.gg[(size_t)dh * R + row];
#pragma unroll
            for (int off = 1; off < 64; off <<= 1) { const float y = __shfl_up(x, off); if (lane >= off) x += y; }
            sG[lane] = x; sB[lane] = p.gbeta[(size_t)dh * R + row];
            const float x63 = __shfl(x, 63);
            float* cg = p.cG + (size_t)unit * 192;
            cg[lane] = __expf(x); cg[64 + lane] = __expf(x63 - x); cg[128 + lane] = __expf(x63);
        }
        WAIT_VM0();
        __syncthreads();
        {
            const char* kt_ = smc; const char* qt_ = smc + 8192;
            const unsigned ro = (16 * w + fr) * 128;
            const unsigned c0 = ((fg) ^ (fr & 7)) << 4, c1 = ((4 + fg) ^ (fr & 7)) << 4;
            const bf16x8_t ak0 = *(const bf16x8_t*)(kt_ + ro + c0), ak1 = *(const bf16x8_t*)(kt_ + ro + c1);
            const bf16x8_t aq0 = *(const bf16x8_t*)(qt_ + ro + c0), aq1 = *(const bf16x8_t*)(qt_ + ro + c1);
            float gi[4], bi[4];
#pragma unroll
            for (int r = 0; r < 4; ++r) { gi[r] = sG[16 * w + 4 * fg + r]; bi[r] = sB[16 * w + 4 * fg + r]; }
#pragma unroll
            for (int n = 0; n < 4; ++n) {
                const unsigned rb = (16 * n + fr) * 128;
                const bf16x8_t b0 = *(const bf16x8_t*)(kt_ + rb + c0), b1 = *(const bf16x8_t*)(kt_ + rb + c1);
                f32x4_t kk = __builtin_amdgcn_mfma_f32_16x16x32_bf16(ak0, b0, f32x4_t{0.f, 0.f, 0.f, 0.f}, 0, 0, 0);
                kk = __builtin_amdgcn_mfma_f32_16x16x32_bf16(ak1, b1, kk, 0, 0, 0);
                f32x4_t qk = __builtin_amdgcn_mfma_f32_16x16x32_bf16(aq0, b0, f32x4_t{0.f, 0.f, 0.f, 0.f}, 0, 0, 0);
                qk = __builtin_amdgcn_mfma_f32_16x16x32_bf16(aq1, b1, qk, 0, 0, 0);
                const int j = 16 * n + fr; const float gj = sG[j];
#pragma unroll
                for (int r = 0; r < 4; ++r) {
                    const int i = 16 * w + 4 * fg + r;
                    const float dec = (j <= i) ? __expf(gi[r] - gj) : 0.f;
                    sA[i * 64 + j] = (j < i) ? kk[r] * bi[r] * dec : 0.f;
                    p.cQK[(size_t)unit * 4096 + i * 64 + j] = f2bf(qk[r] * dec);
                }
            }
        }
        __syncthreads();
        if (w < 2) {
            float x[64];
            bf16* dst = (w == 0 ? p.cU : p.cW) + (size_t)unit * 4096 + lane;
#pragma unroll
            for (int i = 0; i < 64; ++i) {
                float rhs;
                if (w == 0) rhs = sB[i] * bf2f(*(const bf16*)(smc + 16384 + i * 128 + lane * 2));
                else rhs = sB[i] * __expf(sG[i]) * bf2f(*(const bf16*)(smc + i * 128 + ((((lane >> 3) ^ (i & 7))) << 4) + (lane & 7) * 2));
                float acc = rhs;
#pragma unroll
                for (int j4 = 0; j4 < i; j4 += 4) {
                    const f32x4_t a4 = *(const f32x4_t*)(sA + i * 64 + j4);
                    acc -= a4[0] * x[j4];
                    if (j4 + 1 < i) acc -= a4[1] * x[j4 + 1];
                    if (j4 + 2 < i) acc -= a4[2] * x[j4 + 2];
                    if (j4 + 3 < i) acc -= a4[3] * x[j4 + 3];
                }
                x[i] = acc;
                dst[i * 64] = f2bf(acc);
            }
        }
    }
}
#else
HD void ph_gdn_chunk(const Params& p, int l, int bid, int nb, float* sm) {
    float* sk = sm;
    float* sq = sm + 4096;
    float* sA = sm + 8192;
    float* sXu = sm + 12288;
    float* sXw = sm + 4096;
    float* sG = sm + 16384;
    float* sB = sm + 16448;
    for (int unit = bid; unit < NUNIT; unit += nb) {
        ChunkInfo c = chunkinfo(unit);
        int dh = c.dir * 4 + c.hd;
        THREADS(t, 4096) {
            int i = t >> 6, d = t & 63; int row = chunk_row(c, i);
            sq[t] = bf2f(p.gq[(size_t)row * 768 + c.hd * 64 + d]);
            sk[t] = bf2f(p.gq[(size_t)row * 768 + 256 + c.hd * 64 + d]);
        }
        THREADS(t, 1) {
            float acc = 0.f;
            for (int i = 0; i < 64; ++i) { int row = chunk_row(c, i); acc += p.gg[(size_t)dh * R + row]; sG[i] = acc; sB[i] = p.gbeta[(size_t)dh * R + row]; }
        }
        SYNC
        THREADS(t, 4096) {
            int i = t >> 6, j = t & 63;
            float kk = 0.f, qk = 0.f;
            for (int d = 0; d < 64; ++d) { kk += sk[i * 64 + d] * sk[j * 64 + d]; qk += sq[i * 64 + d] * sk[j * 64 + d]; }
            float dec = (j <= i) ? expf(sG[i] - sG[j]) : 0.f;
            sA[t] = (j < i) ? kk * sB[i] * dec : 0.f;
            p.cQK[(size_t)unit * 4096 + t] = f2bf(qk * dec);
        }
        SYNC
        THREADS(t, 4096) {
            int i = t >> 6, cc = t & 63; int row = chunk_row(c, i);
            sXu[t] = sB[i] * bf2f(p.gq[(size_t)row * 768 + 512 + c.hd * 64 + cc]);
            sXw[t] = sB[i] * expf(sG[i]) * sk[t];
        }
        SYNC
        for (int i = 1; i < 64; ++i) {
            THREADS(cc, 128) {
                float* X = (cc < 64) ? (sXu + cc) : (sXw + cc - 64);
                float acc = X[i * 64];
                for (int j = 0; j < i; ++j) acc -= sA[i * 64 + j] * X[j * 64];
                X[i * 64] = acc;
            }
            SYNC
        }
        THREADS(t, 4096) {
            p.cU[(size_t)unit * 4096 + t] = f2bf(sXu[t]);
            p.cW[(size_t)unit * 4096 + t] = f2bf(sXw[t]);
        }
        THREADS(t, 64) { p.cG[(size_t)unit * 64 + t] = sG[t]; }
        SYNC
    }
}

#endif

HD void ph_fourier2(const Params& p, int l, int bid, int nb) {
    const int RQ = (l == 0) ? R : NLAT;
    for (int r = (FOURIER_GEMM ? NLAT : 0) + bid; r < RQ; r += nb) {
        RowInfo ri = rowinfo(r);
        const float nrm = 1.0f / sqrtf((float)ri.T * 64.0f);
        const int mul = SEQ / ri.T;
        THREADS(ch, 256) {
            float acc = 0.f;
            for (int tt = 0; tt < ri.T; ++tt) {
                int ti = ((ri.t * tt) & (ri.T - 1)) * mul;
                const bf16* f = p.fcs + (size_t)(ri.base + tt) * 512;
                acc += p.cosT[ti] * bf2f(f[ch]) - p.sinT[ti] * bf2f(f[256 + ch]);
            }
            p.br[(size_t)r * D + 768 + ch] = f2bf(acc * nrm);
        }
    }
}


HD void ph_fourier_s1c(const Params& p, int bid, int nb, char* smc) {
    constexpr int MTc = CTXL / 128;
    for (int tile = bid; tile < NB * MTc * 4; tile += nb) {
        const int g = tile & 3, mtc = (tile >> 2) % MTc, b = tile / (4 * MTc);
        ACC_DECL(4, acc); acc_zero(acc);
        gemm_accum<4>(acc, [&](int i) { return p.P + (size_t)(NLAT + b * CTXL + mtc * 128 + i) * PLD + C_F + g * 64; },
                      [&](int j) { return p.fW1 + j * 64; }, 64, smc);
        ACC_FOR(4, row, col) {
            const int cs = col >> 6, m = col & 63;
            p.fXC[(((size_t)b * 256 + g * 64 + m) * 2 + cs) * CTXL + mtc * 128 + row] = f2bf(AV(acc));
        } ACC_END
    }
}
HD void ph_fourier_s1(const Params& p, int bid, int nb, char* smc) {
    for (int tile = bid; tile < NB * 64 * 4; tile += nb) {
        const int g = tile & 3, t2 = (tile >> 2) & 63, b = tile >> 8;
        ACC_DECL(4, acc); acc_zero(acc);
        gemm_accum<4>(acc, [&](int i) { return p.P + (size_t)(b * SEQ + 64 * i + t2) * PLD + C_F + g * 64; },
                      [&](int j) { return p.fW1 + j * 64; }, 64, smc);
#ifndef CPU_EMU
        {
            float* tl = (float*)smc;
            acc_to_lds<4>(acc, tl);
            __syncthreads();
            const int t_ = tid_(); const int col = t_ >> 1, half = t_ & 1;
            const int cs = col >> 6, m = col & 63;
            bf16* dst = p.fcs + ((((size_t)b * 256 + g * 64 + m) * 64 + t2) * 2 + cs) * 128 + half * 64;
#pragma unroll
            for (int q = 0; q < 8; ++q) {
                float v[8];
#pragma unroll
                for (int e = 0; e < 8; ++e) v[e] = tl[(half * 64 + q * 8 + e) * 132 + col];
                uint4 pk; pk.x = cvtpk(v[0], v[1]); pk.y = cvtpk(v[2], v[3]); pk.z = cvtpk(v[4], v[5]); pk.w = cvtpk(v[6], v[7]);
                *(uint4*)(dst + q * 8) = pk;
            }
        }
#else
        ACC_FOR(4, row, col) {
            const int cs = col >> 6, m = col & 63;
            p.fcs[((((size_t)b * 256 + g * 64 + m) * 64 + t2) * 2 + cs) * 128 + row] = f2bf(AV(acc));
        } ACC_END
#endif
    }
}
HD void ph_fourier_sA(const Params& p, int bid, int nb, char* smc) {
    for (int tile = bid; tile < NB * 128 * 2; tile += nb) {
        const int nt = tile & 1, mt = (tile >> 1) & 127, b = tile >> 8;
        ACC_DECL(4, acc); acc_zero(acc);
        gemm_accum<4>(acc, [&](int i) { return p.fcs + ((size_t)b * 16384 + mt * 128 + i) * 256; },
                      [&](int j) { return p.fWA + (size_t)(nt * 128 + j) * 256; }, 256, smc);
#ifndef CPU_EMU
        {
            float* tl = (float*)smc;
            acc_to_lds<4>(acc, tl);
            __syncthreads();
            const int t_ = tid_(); const int pcol = t_ >> 2, chl = (t_ >> 1) & 1, th = t_ & 1;
            const int k1 = nt * 64 + pcol; const int ch = mt * 2 + chl;
            const int cre = (pcol >> 4) * 32 + (pcol & 15), cim = cre + 16;
            bf16* o = p.fa2 + ((((size_t)b * 128 + k1) * 256 + ch) * 2) * 64 + th * 32;
#pragma unroll
            for (int q = 0; q < 4; ++q) {
                float vr[8], vi[8];
#pragma unroll
                for (int e = 0; e < 8; ++e) {
                    const int t2 = th * 32 + q * 8 + e;
                    const float re = tl[(chl * 64 + t2) * 132 + cre], im = tl[(chl * 64 + t2) * 132 + cim];
                    const float c = p.cosT[k1 * t2], sn = p.sinT[k1 * t2];
                    vr[e] = re * c + im * sn; vi[e] = im * c - re * sn;
                }
                uint4 pr, pi;
                pr.x = cvtpk(vr[0], vr[1]); pr.y = cvtpk(vr[2], vr[3]); pr.z = cvtpk(vr[4], vr[5]); pr.w = cvtpk(vr[6], vr[7]);
                pi.x = cvtpk(vi[0], vi[1]); pi.y = cvtpk(vi[2], vi[3]); pi.z = cvtpk(vi[4], vi[5]); pi.w = cvtpk(vi[6], vi[7]);
                *(uint4*)(o + q * 8) = pr; *(uint4*)(o + 64 + q * 8) = pi;
            }
        }
#else
        ACC_FOR_PAIR(row, pcol) {
            const int k1 = nt * 64 + pcol; const int rr = mt * 128 + row; const int ch = rr >> 6, t2 = rr & 63;
            const float re = AV_G(acc), im = AV_U(acc);
            const float c = p.cosT[k1 * t2], sn = p.sinT[k1 * t2];
            bf16* o = p.fa2 + ((((size_t)b * 128 + k1) * 256 + ch) * 2) * 64 + t2;
            o[0] = f2bf(re * c + im * sn); o[64] = f2bf(im * c - re * sn);
        } ACC_END
#endif
    }
}
HD void ph_fourier_sB(const Params& p, int bid, int nb, char* smc) {
    const float nrm = 1.0f / sqrtf((float)SEQ * 64.0f);
    for (int tile = bid; tile < NB * 128 * 2; tile += nb) {
        const int cht = tile & 1, k1 = (tile >> 1) & 127, b = tile >> 8;
        ACC_DECL(2, acc); acc_zero(acc);
        gemm_accum<2>(acc, [&](int i) { return p.fa2 + (((size_t)b * 128 + k1) * 256 + cht * 128 + i) * 128; },
                      [&](int j) { return p.fWB + j * 128; }, 128, smc);
        ACC_FOR(2, row, col) {
            p.br[(size_t)(b * SEQ + k1 + 128 * col) * D + 768 + cht * 128 + row] = f2bf(AV(acc) * nrm);
        } ACC_END
    }
}


HD void ph_fourier_ctx(const Params& p, int bid, int nb, char* smc) {
    static_assert(CTXL % 128 == 0 || !FOURIER_GEMM, "context DFT GEMM needs CTXL % 128 == 0");
    const float nrm = 1.0f / sqrtf((float)CTXL * 64.0f);
    constexpr int MTc = CTXL / 128;
    for (int tile = bid; tile < NB * MTc * 2; tile += nb) {
        const int nt = tile & 1, mt = (tile >> 1) % MTc, b = tile / (2 * MTc);
        ACC_DECL(4, acc); acc_zero(acc);
        gemm_accum<4>(acc, [&](int i) { return p.fWC + (size_t)(mt * 128 + i) * (2 * CTXL); },
                      [&](int j) { return p.fXC + ((size_t)b * 256 + nt * 128 + j) * (2 * CTXL); }, 2 * CTXL, smc);
        ACC_FOR(4, row, col) { p.br[(size_t)(NLAT + b * CTXL + mt * 128 + row) * D + 768 + nt * 128 + col] = f2bf(AV(acc) * nrm); } ACC_END
    }
}
#ifndef CPU_EMU
struct ScanRegs { i32x4_t W[2], k[2]; unsigned u[4]; float g; };
HD bf16* scan_sp(const Params& p) { return p.h; }
HD bf16* scan_vn(const Params& p) { return p.h + (size_t)NUNIT * 4096; }
HD void ph_gdn_scan(const Params& p, int l, int bid, int nb, float* smf) {
    static_assert(NCH % 3 == 0, "scan ring assumes the chunk count is a multiple of 3");
    char* smc = (char*)smf;
    const int t = tid_(), lane = t & 63, w = t >> 6, fr = lane & 15, fg = lane >> 4;
    char* sST = smc + 24576; char* sVT = smc + 26624; char* sVS = smc + 28672; float* sG = (float*)(smc + 30720);
    const lds_cptr lds = (lds_cptr)smc;
    const int lkey = t >> 3, lc = t & 7;
    for (int cu = bid; cu < 2 * NB * 4 * 4; cu += nb) {
        const int chain = cu >> 2, cb = cu & 3;
        const ChunkInfo c0 = chunkinfo(chain * NCH);
        const int hd = c0.hd;
        auto issue = [&](ScanRegs& Rg, int n) {
            const int unit = chain * NCH + n;
            const ChunkInfo c = chunkinfo(unit);
            const bf16* wsrc = p.cW + (size_t)unit * 4096 + (16 * w + fr) * 64 + 8 * fg;
#pragma unroll
            for (int s_ = 0; s_ < 2; ++s_) {
                Rg.W[s_] = *(const i32x4_t*)(wsrc + 32 * s_);
                Rg.k[s_] = *(const i32x4_t*)(p.gq + (size_t)chunk_row(c, lkey + 32 * s_) * 768 + 256 + hd * 64 + lc * 8);
            }
#pragma unroll
            for (int r = 0; r < 4; ++r) Rg.u[r] = p.cU[(size_t)unit * 4096 + (16 * w + 4 * fg + r) * 64 + cb * 16 + fr];
            Rg.g = p.cG[(size_t)unit * 192 + (t < 192 ? t : 191)];
        };
        auto put_k = [&](const ScanRegs& Rg, int buf) {
#pragma unroll
            for (int s_ = 0; s_ < 2; ++s_) {
                const int ci = lkey + 32 * s_;
                const int fsw = ((ci >> 1) & 1) | (((ci >> 3) & 1) << 1);
                *(i32x4_t*)(smc + buf * 8192 + ci * 128 + (((((lc >> 1) ^ fsw) << 1) | (lc & 1)) << 4)) = Rg.k[s_];
            }
            if (t < 192) sG[buf * 192 + t] = Rg.g;
        };
        const int xe = (t >> 3) & 15, xc = (t & 7) ^ (xe & 7);
        const unsigned xsrc = xe * 128 + ((t & 7) << 4);
        const size_t xdst = (size_t)(cb * 16 + xe) * 64 + xc * 8;
        const unsigned c0o = ((fg) ^ (fr & 7)) << 4, c1o = ((4 + fg) ^ (fr & 7)) << 4;
        const unsigned bo0 = fr * 128 + c0o, bo1 = fr * 128 + c1o;
        const unsigned wofs = fr * 128 + ((((2 * w + (fg >> 1)) ^ (fr & 7))) << 4) + (fg & 1) * 8;
        unsigned ka[2][2];
#pragma unroll
        for (int s_ = 0; s_ < 2; ++s_)
#pragma unroll
            for (int h2 = 0; h2 < 2; ++h2) {
                const int cr = 32 * s_ + 8 * fg + (fr >> 2) + 4 * h2;
                const int fsw = ((cr >> 1) & 1) | (((cr >> 3) & 1) << 1);
                ka[s_][h2] = cr * 128 + (((((w ^ fsw) << 1) | ((fr & 3) >> 1))) << 4) + (fr & 1) * 8;
            }
        f32x4_t S = f32x4_t{0.f, 0.f, 0.f, 0.f};
        ScanRegs R0, R1, R2;
        __syncthreads();
        issue(R0, 0); issue(R1, 1);
        ((unsigned*)sST)[t] = 0u; ((unsigned*)sST)[t + 256] = 0u;
        put_k(R0, 0);
        __syncthreads();
#define SCAN_STEP(Rc, Rn, Rnn, nn, b)                                                                                                        \
        {                                                                                                                                    \
            const int n_ = (nn);                                                                                                             \
            issue(Rnn, (n_ + 2 < NCH) ? n_ + 2 : NCH - 1);                  \
            const float* g = sG + (b) * 192;                                                                                                 \
            const f32x4_t eD = *(const f32x4_t*)(g + 64 + 16 * w + 4 * fg);                                                                  \
            const float e63 = g[128];                                                                                                        \
            const bf16x8_t st0 = *(const bf16x8_t*)(sST + bo0), st1 = *(const bf16x8_t*)(sST + bo1);                                         \
            if (t < 128) *(uint4*)(scan_sp(p) + (size_t)(chain * NCH + n_) * 4096 + xdst) = *(const uint4*)(sST + xsrc);                     \
            f32x4_t v = __builtin_amdgcn_mfma_f32_16x16x32_bf16(__builtin_bit_cast(bf16x8_t, Rc.W[0]), st0, f32x4_t{0.f, 0.f, 0.f, 0.f}, 0, 0, 0); \
            v = __builtin_amdgcn_mfma_f32_16x16x32_bf16(__builtin_bit_cast(bf16x8_t, Rc.W[1]), st1, v, 0, 0, 0);                              \
            float vn[4];                                                                                                                     \
            _Pragma("unroll") for (int r = 0; r < 4; ++r) vn[r] = __uint_as_float(Rc.u[r] << 16) - v[r];                                     \
            { uint2 pk; pk.x = cvtpk(vn[0], vn[1]); pk.y = cvtpk(vn[2], vn[3]); *(uint2*)(sVT + wofs) = pk; }                                \
            { uint2 pk; pk.x = cvtpk(vn[0] * eD[0], vn[1] * eD[1]); pk.y = cvtpk(vn[2] * eD[2], vn[3] * eD[3]); *(uint2*)(sVS + wofs) = pk; }  \
            put_k(Rn, ((b) + 1) % 3);                                                                                                        \
            __syncthreads();                                                                                                                 \
            if (t >= 128) *(uint4*)(scan_vn(p) + (size_t)(chain * NCH + n_) * 4096 + xdst) = *(const uint4*)(sVT + xsrc);                    \
            const bf16x8_t vs0 = *(const bf16x8_t*)(sVS + bo0), vs1 = *(const bf16x8_t*)(sVS + bo1);                                         \
            const lds_cptr kb = lds + (b) * 8192;                                                                                            \
            const s16x4_t a00 = lds_tr16(kb + ka[0][0]), a01 = lds_tr16(kb + ka[0][1]);                                                      \
            const s16x4_t a10 = lds_tr16(kb + ka[1][0]), a11 = lds_tr16(kb + ka[1][1]);                                                      \
            f32x4_t dS = __builtin_amdgcn_mfma_f32_16x16x32_bf16(bf16x8_t{a00[0], a00[1], a00[2], a00[3], a01[0], a01[1], a01[2], a01[3]}, vs0, f32x4_t{0.f, 0.f, 0.f, 0.f}, 0, 0, 0); \
            dS = __builtin_amdgcn_mfma_f32_16x16x32_bf16(bf16x8_t{a10[0], a10[1], a10[2], a10[3], a11[0], a11[1], a11[2], a11[3]}, vs1, dS, 0, 0, 0); \
            _Pragma("unroll") for (int r = 0; r < 4; ++r) S[r] = S[r] * e63 + dS[r];                                                         \
            { uint2 pk; pk.x = cvtpk(S[0], S[1]); pk.y = cvtpk(S[2], S[3]); *(uint2*)(sST + wofs) = pk; }                                    \
            __syncthreads();                                                                                                                 \
        }
#pragma unroll 1
        for (int n = 0; n < NCH; n += 3) {
            SCAN_STEP(R0, R1, R2, n, 0)
            SCAN_STEP(R1, R2, R0, n + 1, 1)
            SCAN_STEP(R2, R0, R1, n + 2, 2)
        }
#undef SCAN_STEP
    }
}
HD void ph_gdn_outfin(const Params& p, int l, int bid, int nb, float* smf) {
    const int t = tid_(), lane = t & 63, w = t >> 6, fr = lane & 15, fg = lane >> 4;
    const float* og = p.in[I_ONORM] + l * 64;
    const int nlat = NB * 4 * NCL, nctx = (l == 0) ? NB * 4 * NCC : 0;
    float* so = smf;
    for (int u = bid; u < nlat + nctx; u += nb) {
        int b, hd, seg, nloc, ncs, T, base;
        if (u < nlat) { nloc = u % NCL; const int bh = u / NCL; hd = bh & 3; b = bh >> 2; seg = 0; ncs = NCL; T = SEQ; base = b * SEQ; }
        else { const int u2 = u - nlat; nloc = u2 % NCC; const int bh = u2 / NCC; hd = bh & 3; b = bh >> 2; seg = 1; ncs = NCC; T = CTXL; base = NLAT + b * CTXL; }
        __syncthreads();
#pragma unroll
        for (int dir = 0; dir < 2; ++dir) {
            const int nl = dir ? (ncs - 1 - nloc) : nloc;
            const int unit = ((dir * NB + b) * 4 + hd) * NCH + (seg ? nl : NCC + nl);
            const int ci = 16 * w + fr;
            const int pf = nl * 64 + ci; const int arow_ = base + (dir ? (T - 1 - pf) : pf);
            bf16x8_t qa[2], ka_[2];
#pragma unroll
            for (int s_ = 0; s_ < 2; ++s_) {
                qa[s_] = *(const bf16x8_t*)(p.gq + (size_t)arow_ * 768 + hd * 64 + 32 * s_ + 8 * fg);
                ka_[s_] = *(const bf16x8_t*)(p.cQK + (size_t)unit * 4096 + ci * 64 + 32 * s_ + 8 * fg);
            }
            const f32x4_t eG = *(const f32x4_t*)(p.cG + (size_t)unit * 192 + 16 * w + 4 * fg);
#pragma unroll
            for (int j = 0; j < 4; ++j) {
                const bf16* spr = scan_sp(p) + (size_t)unit * 4096 + (16 * j + fr) * 64 + 8 * fg;
                const bf16* vnr = scan_vn(p) + (size_t)unit * 4096 + (16 * j + fr) * 64 + 8 * fg;
                f32x4_t o1 = __builtin_amdgcn_mfma_f32_16x16x32_bf16(qa[0], *(const bf16x8_t*)(spr), f32x4_t{0.f, 0.f, 0.f, 0.f}, 0, 0, 0);
                o1 = __builtin_amdgcn_mfma_f32_16x16x32_bf16(qa[1], *(const bf16x8_t*)(spr + 32), o1, 0, 0, 0);
                f32x4_t o2 = __builtin_amdgcn_mfma_f32_16x16x32_bf16(ka_[0], *(const bf16x8_t*)(vnr), f32x4_t{0.f, 0.f, 0.f, 0.f}, 0, 0, 0);
                o2 = __builtin_amdgcn_mfma_f32_16x16x32_bf16(ka_[1], *(const bf16x8_t*)(vnr + 32), o2, 0, 0, 0);
#pragma unroll
                for (int r = 0; r < 4; ++r) {
                    const int cpos = 16 * w + 4 * fg + r;
                    const int tok = dir ? (63 - cpos) : cpos;
                    float* dst = so + tok * 65 + 16 * j + fr;
                    const float val = eG[r] * o1[r] + o2[r];
                    if (dir == 0) *dst = val; else *dst += val;
                }
            }
            __syncthreads();
        }
        {
            const int tok = t >> 2, q4 = t & 3;
            const int row = base + nloc * 64 + tok;
            float v[16]; float ss = 0.f;
#pragma unroll
            for (int c = 0; c < 16; ++c) { v[c] = so[tok * 65 + q4 * 16 + c]; ss += v[c] * v[c]; }
            ss += __shfl_xor(ss, 1); ss += __shfl_xor(ss, 2);
            const float rs = 1.0f / sqrtf(ss / 64.0f + 1e-6f);
            const uint4 z0 = *(const uint4*)(p.P + (size_t)row * PLD + C_Z + hd * 64 + q4 * 16), z1 = *(const uint4*)(p.P + (size_t)row * PLD + C_Z + hd * 64 + q4 * 16 + 8);
            const unsigned zz[8] = {z0.x, z0.y, z0.z, z0.w, z1.x, z1.y, z1.z, z1.w};
            unsigned pk[8];
#pragma unroll
            for (int c2 = 0; c2 < 8; ++c2) {
                const float za = __uint_as_float(zz[c2] << 16), zb = __uint_as_float(zz[c2] & 0xffff0000u);
                const float oa = v[2 * c2] * rs * og[q4 * 16 + 2 * c2] * siluf_(za), ob = v[2 * c2 + 1] * rs * og[q4 * 16 + 2 * c2 + 1] * siluf_(zb);
                pk[c2] = cvtpk(oa, ob);
            }
            uint4 p0, p1; p0.x = pk[0]; p0.y = pk[1]; p0.z = pk[2]; p0.w = pk[3]; p1.x = pk[4]; p1.y = pk[5]; p1.z = pk[6]; p1.w = pk[7];
            bf16* dstb = p.br + (size_t)row * D + 512 + hd * 64 + q4 * 16;
            *(uint4*)dstb = p0; *(uint4*)(dstb + 8) = p1;
        }
    }
}
#else
HD void ph_gdn_scan(const Params& p, int l, int bid, int nb, float* sm) {
    float* sQ = sm;
    float* sK = sm + 4096;
    bf16* sW = (bf16*)(sm + 8192);
    bf16* sQK = (bf16*)(sm + 10240);
    float* sS = sm + 12288;
    float* sV = sm + 13312;
    float* sU = sm + 14336;
    float* sG = sm + 15360;
    const int RQ = (l == 0) ? R : NLAT;
    for (int cu = bid; cu < 2 * NB * 4 * 4; cu += nb) {
        int chain = cu >> 2, cb = cu & 3;
        THREADS(t, 1024) { sS[t] = 0.f; }
        SYNC
        for (int n = 0; n < NCH; ++n) {
            int unit = chain * NCH + n;
            ChunkInfo c = chunkinfo(unit);
            THREADS(t, 64) { sG[t] = p.cG[(size_t)unit * 64 + t]; }
            SYNC
            THREADS(t, 4096) {
                int i = t >> 6, d = t & 63; int row = chunk_row(c, i);
                sW[t] = p.cW[(size_t)unit * 4096 + t];
                sQK[t] = p.cQK[(size_t)unit * 4096 + t];
                sQ[t] = bf2f(p.gq[(size_t)row * 768 + c.hd * 64 + d]) * expf(sG[i]);
                sK[t] = bf2f(p.gq[(size_t)row * 768 + 256 + c.hd * 64 + d]) * expf(sG[63] - sG[i]);
            }
            THREADS(t, 1024) { int i = t >> 4, e = t & 15; sU[t] = bf2f(p.cU[(size_t)unit * 4096 + i * 64 + cb * 16 + e]); }
            SYNC
            THREADS(t, 1024) {
                int i = t >> 4, e = t & 15;
                float acc = sU[t];
                for (int d = 0; d < 64; ++d) acc -= bf2f(sW[i * 64 + d]) * sS[d * 16 + e];
                sV[t] = acc;
            }
            SYNC
            THREADS(t, 1024) {
                int i = t >> 4, e = t & 15;
                float acc = 0.f;
                for (int d = 0; d < 64; ++d) acc += sQ[i * 64 + d] * sS[d * 16 + e];
                for (int j = 0; j < 64; ++j) acc += bf2f(sQK[i * 64 + j]) * sV[j * 16 + e];
                int row = chunk_row(c, i);
                if (row < RQ) p.odir[((size_t)c.dir * R + row) * 256 + c.hd * 64 + cb * 16 + e] = f2bf(acc);
            }
            SYNC
            THREADS(t, 1024) {
                int d = t >> 4, e = t & 15;
                float acc = sS[t] * expf(sG[63]);
                for (int i = 0; i < 64; ++i) acc += sK[i * 64 + d] * sV[i * 16 + e];
                sS[t] = acc;
            }
            SYNC
        }
    }
}

#endif

#ifndef CPU_EMU
HD void ph_gdn_fin(const Params& p, int l, int bid, int nb) {
    const int RQ = (l == 0) ? R : NLAT;
    const float* og = p.in[I_ONORM] + l * 64;
    const int N = RQ * 32;
    for (int idx = bid * 256 + tid_(); idx < N; idx += nb * 256) {
        const int r = idx >> 5, q = idx & 31; const int hd = q >> 3, cg = q & 7;
        const uint4 a0 = *(const uint4*)(p.odir + (size_t)r * 256 + hd * 64 + cg * 8);
        const uint4 a1 = *(const uint4*)(p.odir + ((size_t)R + r) * 256 + hd * 64 + cg * 8);
        const uint4 zz = *(const uint4*)(p.P + (size_t)r * PLD + C_Z + hd * 64 + cg * 8);
        float v[8], z[8];
        v[0] = __uint_as_float(a0.x << 16) + __uint_as_float(a1.x << 16); v[1] = __uint_as_float(a0.x & 0xffff0000u) + __uint_as_float(a1.x & 0xffff0000u);
        v[2] = __uint_as_float(a0.y << 16) + __uint_as_float(a1.y << 16); v[3] = __uint_as_float(a0.y & 0xffff0000u) + __uint_as_float(a1.y & 0xffff0000u);
        v[4] = __uint_as_float(a0.z << 16) + __uint_as_float(a1.z << 16); v[5] = __uint_as_float(a0.z & 0xffff0000u) + __uint_as_float(a1.z & 0xffff0000u);
        v[6] = __uint_as_float(a0.w << 16) + __uint_as_float(a1.w << 16); v[7] = __uint_as_float(a0.w & 0xffff0000u) + __uint_as_float(a1.w & 0xffff0000u);
        z[0] = __uint_as_float(zz.x << 16); z[1] = __uint_as_float(zz.x & 0xffff0000u); z[2] = __uint_as_float(zz.y << 16); z[3] = __uint_as_float(zz.y & 0xffff0000u);
        z[4] = __uint_as_float(zz.z << 16); z[5] = __uint_as_float(zz.z & 0xffff0000u); z[6] = __uint_as_float(zz.w << 16); z[7] = __uint_as_float(zz.w & 0xffff0000u);
        float ss = 0.f;
#pragma unroll
        for (int c = 0; c < 8; ++c) ss += v[c] * v[c];
        ss += __shfl_xor(ss, 1); ss += __shfl_xor(ss, 2); ss += __shfl_xor(ss, 4);
        const float rs = 1.0f / sqrtf(ss / 64.0f + 1e-6f);
        float o[8];
#pragma unroll
        for (int c = 0; c < 8; ++c) o[c] = v[c] * rs * og[cg * 8 + c] * siluf_(z[c]);
        uint4 pk; pk.x = cvtpk(o[0], o[1]); pk.y = cvtpk(o[2], o[3]); pk.z = cvtpk(o[4], o[5]); pk.w = cvtpk(o[6], o[7]);
        *(uint4*)(p.br + (size_t)r * D + 512 + hd * 64 + cg * 8) = pk;
    }
}
#else
HD void ph_gdn_fin(const Params& p, int l, int bid, int nb) {
    const int RQ = (l == 0) ? R : NLAT;
    const float* og = p.in[I_ONORM] + l * 64;
    const int N = RQ * 4;
    for (int u = bid; u < (N + 255) / 256; u += nb) {
        THREADS(t, 256) {
            int idx = u * 256 + t;
            if (idx < N) {
                int r = idx >> 2, hd = idx & 3;
                const bf16* o0 = p.odir + (size_t)r * 256 + hd * 64;
                const bf16* o1 = p.odir + ((size_t)R + r) * 256 + hd * 64;
                float ss = 0.f;
                for (int d = 0; d < 64; ++d) { float v = bf2f(o0[d]) + bf2f(o1[d]); ss += v * v; }
                float rs = 1.0f / sqrtf(ss / 64.0f + 1e-6f);
                for (int d = 0; d < 64; ++d) {
                    float v = (bf2f(o0[d]) + bf2f(o1[d])) * rs * og[d];
                    float z = bf2f(p.P[(size_t)r * PLD + C_Z + hd * 64 + d]);
                    p.br[(size_t)r * D + 512 + hd * 64 + d] = f2bf(v * siluf_(z));
                }
            }
        }
    }
}

#endif

#ifndef CPU_EMU
template <int NJ>
HD void merge_tile(const Params& p, int l, int mt, int nt, char* smc) {
    constexpr int NW = 32 * NJ;
    const bf16* Wg = p.wt_in + (size_t)l * WIN_NP * D + (size_t)PLD * D;
    const bf16* Wb = p.wt_br + (size_t)l * 4 * D * 256;
    AccT<NJ> accM; acc_zero(accM);
    const unsigned char* h8 = (const unsigned char*)h8_of(p);
    auto aG = [&](int r) { return (const void*)(h8 + (size_t)(mt * 128 + r) * D); };
    int cur = 0;
    __syncthreads();
    gemm_stage0<NJ>(aG, [&](int j) { return (const void*)((const unsigned char*)Wg + (size_t)(nt * NW + j) * D); }, 1, smc, 0);
#pragma unroll 1
    for (int i = 0; i < 4; ++i) {
        AccT<NJ> acc; acc_zero(acc);
        auto bG = [&](int j) { return (const void*)((const unsigned char*)Wg + (size_t)(i * 1024 + nt * NW + j) * D); };
        auto aP = [&](int r) { return (const void*)(p.br + (size_t)(mt * 128 + r) * D + i * 256); };
        auto bP = [&](int j) { return (const void*)(Wb + ((size_t)i * D + nt * NW + j) * 256); };
        gemm_chain<NJ, true>(acc, aG, bG, D, smc, cur, [&](int buf) { gemm_stage0<NJ>(aP, bP, 2, smc, buf); }, SC_H, SC_W);
        unsigned sg[4][NJ][2];
#pragma unroll
        for (int a_ = 0; a_ < 4; ++a_)
#pragma unroll
            for (int b_ = 0; b_ < NJ; ++b_) {
                float e[4];
#pragma unroll
                for (int r = 0; r < 4; ++r) e[r] = __builtin_amdgcn_rcpf(1.0f + __expf(-acc.v[a_][b_][r]));
                sg[a_][b_][0] = cvtpk(e[0], e[1]); sg[a_][b_][1] = cvtpk(e[2], e[3]);
            }
        acc_zero(acc);
        auto bGn = [&](int j) { return (const void*)((const unsigned char*)Wg + (size_t)((i + 1) * 1024 + nt * NW + j) * D); };
        gemm_chain<NJ, false>(acc, aP, bP, 256, smc, cur, [&](int buf) { if (i < 3) gemm_stage0<NJ>(aG, bGn, 1, smc, buf); }, 0, 0);
#pragma unroll
        for (int a_ = 0; a_ < 4; ++a_)
#pragma unroll
            for (int b_ = 0; b_ < NJ; ++b_) {
                accM.v[a_][b_][0] += __uint_as_float(sg[a_][b_][0] << 16) * acc.v[a_][b_][0];
                accM.v[a_][b_][1] += __uint_as_float(sg[a_][b_][0] & 0xffff0000u) * acc.v[a_][b_][1];
                accM.v[a_][b_][2] += __uint_as_float(sg[a_][b_][1] << 16) * acc.v[a_][b_][2];
                accM.v[a_][b_][3] += __uint_as_float(sg[a_][b_][1] & 0xffff0000u) * acc.v[a_][b_][3];
            }
    }
    __syncthreads();
    float* tl = (float*)smc;
    acc_to_lds<NJ>(accM, tl);
    __syncthreads();
    const int t_ = tid_(); const int row = t_ >> 1, half = t_ & 1;
    constexpr int LD = NW + 4, HW = NW / 2;
    bf16* dst = p.mg + (size_t)(mt * 128 + row) * D + nt * NW + half * HW;
#pragma unroll
    for (int q = 0; q < HW / 8; ++q) {
        const f32x4_t a = *(const f32x4_t*)(tl + row * LD + half * HW + q * 8), b = *(const f32x4_t*)(tl + row * LD + half * HW + q * 8 + 4);
        uint4 pk; pk.x = cvtpk(a[0], a[1]); pk.y = cvtpk(a[2], a[3]); pk.z = cvtpk(b[0], b[1]); pk.w = cvtpk(b[2], b[3]);
        *(uint4*)(dst + q * 8) = pk;
    }
}
HD void ph_merge(const Params& p, int l, int bid, int nb, char* smc) {
    constexpr int MTL = NLAT / 128, MTC = NCTX / 128;
    const int nfull = MTL * 8, nhalf = (l == 0) ? MTC * 16 : 0;
    for (int tile = bid; tile < nfull + nhalf; tile += nb) {
        if (tile < nfull) merge_tile<4>(p, l, tile >> 3, tile & 7, smc);
        else { const int t2 = tile - nfull; merge_tile<2>(p, l, MTL + (t2 >> 4), t2 & 15, smc); }
    }
}
#else
HD void ph_merge(const Params& p, int l, int bid, int nb, char* smc) {
    const int MT = ((l == 0) ? R : NLAT) / 128;
    const bf16* Wg = p.wt_in + (size_t)l * WIN_NP * D + (size_t)PLD * D;
    const bf16* Wb = p.wt_br + (size_t)l * 4 * D * 256;
    for (int tile = bid; tile < MT * 16; tile += nb) {
        const int mt = tile >> 4, nt = tile & 15;
        ACC_DECL(2, accM); acc_zero(accM);
        for (int i = 0; i < 4; ++i) {
            ACC_DECL(2, accG); acc_zero(accG);
            ACC_DECL(2, accP); acc_zero(accP);
            gemm_accum<2>(accG, [&](int r) { return p.h + (size_t)(mt * 128 + r) * D; },
                          [&](int j) { return Wg + (size_t)(i * 1024 + nt * 64 + j) * D; }, D, smc);
            gemm_accum<2>(accP, [&](int r) { return p.br + (size_t)(mt * 128 + r) * D + i * 256; },
                          [&](int j) { return Wb + ((size_t)i * D + nt * 64 + j) * 256; }, 256, smc);
            ACC_FOR(2, row, col) { AV(accM) += sigmoidf_(AV(accG)) * AV(accP); } ACC_END
        }
#ifndef CPU_EMU
        {
            float* tl = (float*)smc;
            acc_to_lds<2>(accM, tl);
            __syncthreads();
            const int t_ = tid_(); const int row = t_ >> 1, half = t_ & 1;
            bf16* dst = p.mg + (size_t)(mt * 128 + row) * D + nt * 64 + half * 32;
#pragma unroll
            for (int q = 0; q < 4; ++q) {
                const f32x4_t a = *(const f32x4_t*)(tl + row * 68 + half * 32 + q * 8), b = *(const f32x4_t*)(tl + row * 68 + half * 32 + q * 8 + 4);
                uint4 pk; pk.x = cvtpk(a[0], a[1]); pk.y = cvtpk(a[2], a[3]); pk.z = cvtpk(b[0], b[1]); pk.w = cvtpk(b[2], b[3]);
                *(uint4*)(dst + q * 8) = pk;
            }
        }
#else
        ACC_FOR(2, row, col) { p.mg[(size_t)(mt * 128 + row) * D + nt * 64 + col] = f2bf(AV(accM)); } ACC_END
#endif
    }
}

#endif

template <int DRY> HD void ph_outproj_t(const Params& p, int l, int bid, int nb, char* smc) {
    const int MT = ((l == 0) ? R : NLAT) / 128;
    const bf16* Wt = p.wt_out + (size_t)l * D * D;
#ifndef CPU_EMU
    constexpr int MTL_ = NLAT / 128;
    const int nfull_ = MTL_ * 8, nhalf_ = (MT - MTL_) * 16;
    for (int tile = bid + nfull_; tile < nfull_ + nhalf_; tile += nb) {
        const int t2 = tile - nfull_; const int mt = MTL_ + (t2 >> 4), nt = t2 & 15;
        AccT<2> acc; acc_zero(acc);
        gemm_accum<2>(acc, [&](int r) { return p.mg + (size_t)(mt * 128 + r) * D; }, [&](int j) { return Wt + (size_t)(nt * 64 + j) * D; }, D, smc);
        float* tl = (float*)smc;
        acc_to_lds<2>(acc, tl);
        __syncthreads();
        const int t_ = tid_(); const int row = t_ >> 1, half = t_ & 1;
        const int r = mt * 128 + row, c0 = nt * 64 + half * 32;
        const float* xi = xrow_in(p, l, r) + c0; float* xo = (DRY ? ((float*)p.Y + (size_t)r * D) : xrow_out(p, r)) + c0; const float* gm = modrow(p, l, r) + 2048 + c0;
#pragma unroll
        for (int q = 0; q < 8; ++q) {
            const f32x4_t a = *(const f32x4_t*)(tl + row * 68 + half * 32 + q * 4), xv = *(const f32x4_t*)(xi + q * 4), gv = *(const f32x4_t*)(gm + q * 4);
            f32x4_t o; o[0] = xv[0] + gv[0] * a[0]; o[1] = xv[1] + gv[1] * a[1]; o[2] = xv[2] + gv[2] * a[2]; o[3] = xv[3] + gv[3] * a[3];
            *(f32x4_t*)(xo + q * 4) = o;
        }
        __syncthreads();
    }
    const int MTF = MTL_;
#else
    const int MTF = MT;
#endif
    for (int tile = bid; tile < MTF * 8; tile += nb) {
        const int mt = tile >> 3, nt = tile & 7;
        ACC_DECL(4, acc); acc_zero(acc);
        gemm_accum<4>(acc, [&](int r) { return p.mg + (size_t)(mt * 128 + r) * D; }, [&](int j) { return Wt + (size_t)(nt * 128 + j) * D; }, D, smc);
#ifndef CPU_EMU
        {
            float* tl = (float*)smc;
            acc_to_lds<4>(acc, tl);
            __syncthreads();
            const int t_ = tid_(); const int row = t_ >> 1, half = t_ & 1;
            const int r = mt * 128 + row, c0 = nt * 128 + half * 64;
            const float* xi = xrow_in(p, l, r) + c0; float* xo = (DRY ? ((float*)p.Y + (size_t)r * D) : xrow_out(p, r)) + c0; const float* gm = modrow(p, l, r) + 2048 + c0;
#pragma unroll
            for (int q = 0; q < 16; ++q) {
                const f32x4_t a = *(const f32x4_t*)(tl + row * 132 + half * 64 + q * 4), xv = *(const f32x4_t*)(xi + q * 4), gv = *(const f32x4_t*)(gm + q * 4);
                f32x4_t o; o[0] = xv[0] + gv[0] * a[0]; o[1] = xv[1] + gv[1] * a[1]; o[2] = xv[2] + gv[2] * a[2]; o[3] = xv[3] + gv[3] * a[3];
                *(f32x4_t*)(xo + q * 4) = o;
            }
        }
#else
        ACC_FOR(4, row, col) {
            const int r = mt * 128 + row, c = nt * 128 + col;
            xrow_out(p, r)[c] = xrow_in(p, l, r)[c] + modrow(p, l, r)[2048 + c] * AV(acc);
        } ACC_END
#endif
    }
}

HD void ph_outproj(const Params& p, int l, int bid, int nb, char* smc) { ph_outproj_t<0>(p, l, bid, nb, smc); }
#ifndef CPU_EMU
template <int DRY> HD void ph_router_t(const Params& p, int l, int bid, int nb, float* smf) {
    char* smc = (char*)smf;
    const int t = tid_(), lane = t & 63, w = t >> 6, fr = lane & 15, fg = lane >> 4;
    const int RQ = (l == 0) ? R : NLAT;
    const float* gN = p.in[I_N2G] + l * D;
    constexpr int WST = 2080;
    float* lgw = (float*)(smc + 66560) + w * (16 * 17);
    int* lcnt = (int*)(smc + 70912); int* gbase = (int*)(smc + 70976);
    __syncthreads();
    for (int k = t; k < 1024; k += 256) {
        const float* wrow = p.in[I_WROUTER] + k * 16;
#pragma unroll
        for (int e = 0; e < 16; ++e) {
            const float v = wrow[e]; const bf16 hi = f2bf(v);
            *(bf16*)(smc + e * WST + k * 2) = hi; *(bf16*)(smc + 33280 + e * WST + k * 2) = f2bf(v - bf2f(hi));
        }
    }
    const int ngroups = RQ / 16;
    for (int g0 = bid * 4; g0 < ngroups; g0 += nb * 4) {
        __syncthreads();
        if (t < 16) lcnt[t] = 0;
        __syncthreads();
        const int gidx = g0 + w;
        const bool active = gidx < ngroups;
        int e1 = 0, e2 = 0, q1 = 0, q2 = 0; const int rsel = gidx * 16 + lane;
        if (active) {
            const int r = gidx * 16 + fr;
            const float* x = xrow_out(p, r);
            const float* m = modrow(p, l, r);
            float ss = 0.f;
#pragma unroll 4
            for (int s_ = 0; s_ < 32; ++s_) {
                const f32x4_t a = *(const f32x4_t*)(x + s_ * 32 + fg * 8), b = *(const f32x4_t*)(x + s_ * 32 + fg * 8 + 4);
                ss += a[0] * a[0] + a[1] * a[1] + a[2] * a[2] + a[3] * a[3] + b[0] * b[0] + b[1] * b[1] + b[2] * b[2] + b[3] * b[3];
            }
            ss += __shfl_xor(ss, 16); ss += __shfl_xor(ss, 32);
            const float rs = 1.0f / sqrtf(ss / D + 1e-6f);
            f32x4_t acc = f32x4_t{0.f, 0.f, 0.f, 0.f};
#pragma unroll 2
            for (int s_ = 0; s_ < 32; ++s_) {
                const int k0 = s_ * 32 + fg * 8;
                float hv[8];
#pragma unroll
                for (int hh = 0; hh < 2; ++hh) {
                    const f32x4_t xv = *(const f32x4_t*)(x + k0 + hh * 4), gv = *(const f32x4_t*)(gN + k0 + hh * 4);
                    const f32x4_t sc = *(const f32x4_t*)(m + 4096 + k0 + hh * 4), sh = *(const f32x4_t*)(m + 3072 + k0 + hh * 4);
#pragma unroll
                    for (int q = 0; q < 4; ++q) hv[hh * 4 + q] = xv[q] * rs * gv[q] * (1.0f + sc[q]) + sh[q];
                }
                unsigned hi[4], lo[4];
#pragma unroll
                for (int q = 0; q < 4; ++q) {
                    hi[q] = cvtpk(hv[2 * q], hv[2 * q + 1]);
                    lo[q] = cvtpk(hv[2 * q] - __uint_as_float(hi[q] << 16), hv[2 * q + 1] - __uint_as_float(hi[q] & 0xffff0000u));
                }
                const i32x4_t hiv = i32x4_t{(int)hi[0], (int)hi[1], (int)hi[2], (int)hi[3]}, lov = i32x4_t{(int)lo[0], (int)lo[1], (int)lo[2], (int)lo[3]};
                { uint2 q8; q8.x = pack_fp8x4(hv[0] * 4.f, hv[1] * 4.f, hv[2] * 4.f, hv[3] * 4.f); q8.y = pack_fp8x4(hv[4] * 4.f, hv[5] * 4.f, hv[6] * 4.f, hv[7] * 4.f);
                  *(uint2*)(h8_of(p) + (size_t)r * D + k0) = q8; }
                const bf16x8_t bh = *(const bf16x8_t*)(smc + fr * WST + s_ * 64 + fg * 16), bl = *(const bf16x8_t*)(smc + 33280 + fr * WST + s_ * 64 + fg * 16);
                acc = __builtin_amdgcn_mfma_f32_16x16x32_bf16(__builtin_bit_cast(bf16x8_t, hiv), bh, acc, 0, 0, 0);
                acc = __builtin_amdgcn_mfma_f32_16x16x32_bf16(__builtin_bit_cast(bf16x8_t, hiv), bl, acc, 0, 0, 0);
                acc = __builtin_amdgcn_mfma_f32_16x16x32_bf16(__builtin_bit_cast(bf16x8_t, lov), bh, acc, 0, 0, 0);
            }
#pragma unroll
            for (int q = 0; q < 4; ++q) lgw[(4 * fg + q) * 17 + fr] = acc[q];
            if (lane < 16) {
                float sc[16], sel[16];
#pragma unroll
                for (int e = 0; e < 16; ++e) { sc[e] = sigmoidf_(lgw[lane * 17 + e]); sel[e] = sc[e] + p.in[I_RBIAS][e]; }
                int best = 0; float bestv = -1e30f;
#pragma unroll
                for (int gph = 0; gph < 4; ++gph) {
                    float t1 = -1e30f, t2 = -1e30f;
#pragma unroll
                    for (int j = 0; j < 4; ++j) { const float v = sel[gph * 4 + j]; if (v > t1) { t2 = t1; t1 = v; } else if (v > t2) t2 = v; }
                    const float gs = t1 + t2;
                    if (gs > bestv) { bestv = gs; best = gph; }
                }
                float v1 = -1e30f, v2 = -1e30f, w1 = 0.f, w2 = 0.f; int i1 = 0, i2 = 0;
#pragma unroll
                for (int e = 0; e < 16; ++e) {
                    if ((e >> 2) == best) {
                        const float v = sel[e];
                        if (v > v1) { v2 = v1; i2 = i1; w2 = w1; v1 = v; i1 = e; w1 = sc[e]; } else if (v > v2) { v2 = v; i2 = e; w2 = sc[e]; }
                    }
                }
                e1 = i1; e2 = i2;
                const float ws_ = w1 + w2;
                p.sel_e[rsel * 2] = i1; p.sel_e[rsel * 2 + 1] = i2;
                p.sel_w[rsel * 2] = w1 / ws_; p.sel_w[rsel * 2 + 1] = w2 / ws_;
                q1 = atomicAdd(&lcnt[i1], 1); q2 = atomicAdd(&lcnt[i2], 1);
            }
        }
        __syncthreads();
        if (t < 16) { const int c = lcnt[t]; gbase[t] = (c && !DRY) ? atomicAdd(&p.cnt[l * 16 + t], c) : 0; }
        __syncthreads();
        if (active && lane < 16 && !DRY) {
            const int p1 = gbase[e1] + q1, p2 = gbase[e2] + q2;
            p.elist[(size_t)e1 * 2 * R + p1] = rsel * 2; p.apos[rsel * 2] = p1;
            p.elist[(size_t)e2 * 2 * R + p2] = rsel * 2 + 1; p.apos[rsel * 2 + 1] = p2;
        }
    }
}
HD void ph_router(const Params& p, int l, int bid, int nb, float* smf) { ph_router_t<0>(p, l, bid, nb, smf); }
#else
HD void ph_router(const Params& p, int l, int bid, int nb, float* sm) {
    const int RQ = (l == 0) ? R : NLAT;
    const float* g = p.in[I_N2G] + l * D;
    const float* wr = p.in[I_WROUTER];
    float* sh = sm + 512;
    float* sl = sm + 2048;
    for (int r = bid; r < RQ; r += nb) {
        const float* x = xrow_out(p, r);
        const float* m = modrow(p, l, r);
        THREADS(t, 256) { float s = 0.f; for (int k = t; k < D; k += 256) s += x[k] * x[k]; sm[t] = s; }
        SYNC
        THREADS(t, 1) { float s = 0.f; for (int i = 0; i < 256; ++i) s += sm[i]; sm[256] = s; }
        SYNC
        THREADS(t, 256) {
            float rs = 1.0f / sqrtf(sm[256] / D + 1e-6f);
            for (int k = t; k < D; k += 256) {
                float v = x[k] * rs * g[k];
                v = v * (1.0f + m[4096 + k]) + m[3072 + k];
                sh[k] = v;
                p.h[(size_t)r * D + k] = f2bf(v);
            }
        }
        SYNC
        THREADS(t, 256) {
            int e = t & 15, ks = t >> 4;
            float acc = 0.f;
            for (int k = ks * 64; k < ks * 64 + 64; ++k) acc += sh[k] * wr[k * 16 + e];
            sl[ks * 16 + e] = acc;
        }
        SYNC
        THREADS(t, 1) {
            float* sc = sm + 2304; float* sel = sm + 2320;
            for (int e = 0; e < 16; ++e) {
                float acc = 0.f;
                for (int ks = 0; ks < 16; ++ks) acc += sl[ks * 16 + e];
                sc[e] = sigmoidf_(acc); sel[e] = sc[e] + p.in[I_RBIAS][e];
            }
            int best = 0; float bestv = -1e30f;
            for (int gph = 0; gph < 4; ++gph) {
                float t1 = -1e30f, t2 = -1e30f;
                for (int j = 0; j < 4; ++j) { float v = sel[gph * 4 + j]; if (v > t1) { t2 = t1; t1 = v; } else if (v > t2) t2 = v; }
                float gs = t1 + t2;
                if (gs > bestv) { bestv = gs; best = gph; }
            }
            int i1 = -1, i2 = -1; float v1 = -1e30f, v2 = -1e30f;
            for (int j = 0; j < 4; ++j) {
                float v = sel[best * 4 + j];
                if (v > v1) { v2 = v1; i2 = i1; v1 = v; i1 = best * 4 + j; } else if (v > v2) { v2 = v; i2 = best * 4 + j; }
            }
            float w1 = sc[i1], w2 = sc[i2], ws = w1 + w2;
            p.sel_e[r * 2] = i1; p.sel_e[r * 2 + 1] = i2;
            p.sel_w[r * 2] = w1 / ws; p.sel_w[r * 2 + 1] = w2 / ws;
            int q1 = ATOMIC_ADD_RET(&p.cnt[l * 16 + i1], 1); p.elist[(size_t)i1 * 2 * R + q1] = r * 2; p.apos[r * 2] = q1;
            int q2 = ATOMIC_ADD_RET(&p.cnt[l * 16 + i2], 1); p.elist[(size_t)i2 * 2 * R + q2] = r * 2 + 1; p.apos[r * 2 + 1] = q2;
        }
        SYNC
    }
}

#endif

struct MoeTiles { int tstart[17]; };
HD MoeTiles moe_tiles(const Params& p, int l) {
    MoeTiles m; int acc = 0;
    for (int e = 0; e < 16; ++e) { m.tstart[e] = acc; acc += (p.cnt[l * 16 + e] + 127) >> 7; }
    m.tstart[16] = acc; return m;
}

HD void ph_ffn1(const Params& p, int l, int bid, int nb, char* smc) {
    int tstart[17];
    { int acc = 0; for (int e = 0; e < 16; ++e) { tstart[e] = acc; acc += (p.cnt[l * 16 + e] + 127) >> 7; } tstart[16] = acc; }
    const int ntiles = tstart[16];
    for (int tile = bid; tile < ntiles * 8; tile += nb) {
        const int rt = tile >> 3, nt = tile & 7;
        int e = 0, ts = 0;
#pragma unroll
        for (int q = 1; q < 16; ++q) if (rt >= tstart[q]) { e = q; ts = tstart[q]; }
        const int mt = rt - ts;
        const int cnt_e = p.cnt[l * 16 + e];
        const int* el = p.elist + (size_t)e * 2 * R;
#ifndef CPU_EMU
        const unsigned char* Wt8 = gu8_of(p) + (size_t)e * 1024 * D;
        AccT<4> acc; acc_zero(acc);
        gemm_accum8<4>(acc, [&](int i) { int q = mt * 128 + i; int a = (q < cnt_e) ? el[q] : el[0]; return (const unsigned char*)h8_of(p) + (size_t)(a >> 1) * D; },
                       [&](int j) { return Wt8 + (size_t)(nt * 128 + j) * D; }, D, smc, SC_H, SC_W);
        {
            float* tl = (float*)smc;
            acc_to_lds<4>(acc, tl);
            __syncthreads();
            const int t_ = tid_(); const int row = t_ >> 1, half = t_ & 1;
            unsigned char* dst = (unsigned char*)p.act + (size_t)(rt * 128 + row) * 512 + nt * 64 + half * 32;
#pragma unroll
            for (int q = 0; q < 2; ++q) {
                float o[16];
#pragma unroll
                for (int c4 = 0; c4 < 4; ++c4) {
                    const f32x4_t gv = *(const f32x4_t*)(tl + row * 132 + half * 64 + q * 32 + c4 * 4), uv = *(const f32x4_t*)(tl + row * 132 + half * 64 + q * 32 + 16 + c4 * 4);
#pragma unroll
                    for (int e_ = 0; e_ < 4; ++e_) o[c4 * 4 + e_] = gv[e_] / (1.0f + __expf(-gv[e_])) * uv[e_] * 16.0f;
                }
                uint4 pk; pk.x = pack_fp8x4(o[0], o[1], o[2], o[3]); pk.y = pack_fp8x4(o[4], o[5], o[6], o[7]);
                pk.z = pack_fp8x4(o[8], o[9], o[10], o[11]); pk.w = pack_fp8x4(o[12], o[13], o[14], o[15]);
                *(uint4*)(dst + q * 16) = pk;
            }
        }
#else
        const bf16* Wt = p.wt_gu + (size_t)e * 1024 * D;
        ACC_DECL(4, acc); acc_zero(acc);
        gemm_accum<4>(acc, [&](int i) { int q = mt * 128 + i; int a = (q < cnt_e) ? el[q] : el[0]; return p.h + (size_t)(a >> 1) * D; },
                      [&](int j) { return Wt + (size_t)(nt * 128 + j) * D; }, D, smc);
        ACC_FOR_PAIR(row, pcol) {
            float gv = AV_G(acc), uv = AV_U(acc);
            p.act[(size_t)(rt * 128 + row) * 512 + nt * 64 + pcol] = f2bf(siluf_(gv) * uv);
        } ACC_END
#endif
    }
}

HD void ph_ffn2(const Params& p, int l, int bid, int nb, char* smc) {
    int tstart[17];
    { int acc = 0; for (int e = 0; e < 16; ++e) { tstart[e] = acc; acc += (p.cnt[l * 16 + e] + 127) >> 7; } tstart[16] = acc; }
    const int ntiles = tstart[16];
    for (int tile = bid; tile < ntiles * 8; tile += nb) {
        const int rt = tile >> 3, nt = tile & 7;
        int e = 0;
#pragma unroll
        for (int q = 1; q < 16; ++q) if (rt >= tstart[q]) e = q;
#ifndef CPU_EMU
        const unsigned char* Wt8 = d8_of(p) + (size_t)e * D * 512;
        AccT<4> acc; acc_zero(acc);
        gemm_accum8<4>(acc, [&](int i) { return (const unsigned char*)p.act + (size_t)(rt * 128 + i) * 512; }, [&](int j) { return Wt8 + (size_t)(nt * 128 + j) * 512; }, 512, smc, SC_ACT, SC_W);
#else
        const bf16* Wt = p.wt_d + (size_t)e * D * 512;
        ACC_DECL(4, acc); acc_zero(acc);
        gemm_accum<4>(acc, [&](int i) { return p.act + (size_t)(rt * 128 + i) * 512; }, [&](int j) { return Wt + (size_t)(nt * 128 + j) * 512; }, 512, smc);
#endif
#ifndef CPU_EMU
        {
            float* tl = (float*)smc;
            acc_to_lds<4>(acc, tl);
            __syncthreads();
            const int t_ = tid_(); const int row = t_ >> 1, half = t_ & 1;
            bf16* dst = p.Y + (size_t)(rt * 128 + row) * D + nt * 128 + half * 64;
#pragma unroll
            for (int q = 0; q < 8; ++q) {
                const f32x4_t a = *(const f32x4_t*)(tl + row * 132 + half * 64 + q * 8), b = *(const f32x4_t*)(tl + row * 132 + half * 64 + q * 8 + 4);
                uint4 pk; pk.x = cvtpk(a[0], a[1]); pk.y = cvtpk(a[2], a[3]); pk.z = cvtpk(b[0], b[1]); pk.w = cvtpk(b[2], b[3]);
                *(uint4*)(dst + q * 8) = pk;
            }
        }
#else
        ACC_FOR(4, row, col) { p.Y[(size_t)(rt * 128 + row) * D + nt * 128 + col] = f2bf(AV(acc)); } ACC_END
#endif
    }
}

#ifndef CPU_EMU
template <int DRY> HD void ph_combine_t(const Params& p, int l, int bid, int nb) {
    const int RQ = (l == 0) ? R : NLAT;
    const int t = tid_(), lane = t & 63, w = t >> 6;
    int tstart[17];
    { int acc = 0;
#pragma unroll
      for (int e = 0; e < 16; ++e) { tstart[e] = acc; acc += (p.cnt[l * 16 + e] + 127) >> 7; } tstart[16] = acc; }
    for (int r = bid * 4 + w; r < RQ; r += nb * 4) {
        float* xo = xrow_out(p, r);
        const float* m = modrow(p, l, r) + 5120;
        const int e0 = p.sel_e[r * 2], e1 = p.sel_e[r * 2 + 1];
        int t0 = 0, t1 = 0;
#pragma unroll
        for (int q = 0; q < 16; ++q) { if (q == e0) t0 = tstart[q]; if (q == e1) t1 = tstart[q]; }
        const bf16* y0 = p.Y + (size_t)(t0 * 128 + p.apos[r * 2]) * D;
        const bf16* y1 = p.Y + (size_t)(t1 * 128 + p.apos[r * 2 + 1]) * D;
        const float w0 = p.sel_w[r * 2], w1 = p.sel_w[r * 2 + 1];
        f32x4_t xs[4]; float ss = 0.f;
#pragma unroll
        for (int j = 0; j < 4; ++j) {
            const int k = j * 256 + lane * 4;
            f32x4_t xv = *(const f32x4_t*)(xo + k);
            const f32x4_t gv = *(const f32x4_t*)(m + k);
            const uint2 a = *(const uint2*)(y0 + k), b = *(const uint2*)(y1 + k);
            xv[0] += gv[0] * (w0 * __uint_as_float(a.x << 16) + w1 * __uint_as_float(b.x << 16));
            xv[1] += gv[1] * (w0 * __uint_as_float(a.x & 0xffff0000u) + w1 * __uint_as_float(b.x & 0xffff0000u));
            xv[2] += gv[2] * (w0 * __uint_as_float(a.y << 16) + w1 * __uint_as_float(b.y << 16));
            xv[3] += gv[3] * (w0 * __uint_as_float(a.y & 0xffff0000u) + w1 * __uint_as_float(b.y & 0xffff0000u));
            *(f32x4_t*)((DRY ? (float*)p.gq + (size_t)r * 64 : xo) + (DRY ? (k & 63) : k)) = xv;
            xs[j] = xv; ss += xv[0] * xv[0] + xv[1] * xv[1] + xv[2] * xv[2] + xv[3] * xv[3];
        }
        if (l == 0 && !DRY) {
            ss = wave_sum(ss);
            const float rs = 1.0f / sqrtf(ss / D + 1e-6f);
            const float* g1 = p.in[I_N1G] + D; const float* m1 = modrow(p, 1, r);
#pragma unroll
            for (int j = 0; j < 4; ++j) {
                const int k = j * 256 + lane * 4;
                const f32x4_t gv = *(const f32x4_t*)(g1 + k), sc = *(const f32x4_t*)(m1 + 1024 + k), sh = *(const f32x4_t*)(m1 + k);
                float o[4];
#pragma unroll
                for (int q = 0; q < 4; ++q) o[q] = xs[j][q] * rs * gv[q] * (1.0f + sc[q]) + sh[q];
                uint2 pk; pk.x = cvtpk(o[0], o[1]); pk.y = cvtpk(o[2], o[3]);
                *(uint2*)(p.h + (size_t)r * D + k) = pk;
                *(unsigned*)(h8_of(p) + (size_t)r * D + k) = pack_fp8x4(o[0] * 4.f, o[1] * 4.f, o[2] * 4.f, o[3] * 4.f);
            }
        }
    }
}
HD void ph_combine(const Params& p, int l, int bid, int nb) { ph_combine_t<0>(p, l, bid, nb); }
#else
HD void ph_combine(const Params& p, int l, int bid, int nb) {
    const int RQ = (l == 0) ? R : NLAT;
    int tstart[17];
    { int acc = 0; for (int e = 0; e < 16; ++e) { tstart[e] = acc; acc += (p.cnt[l * 16 + e] + 127) >> 7; } tstart[16] = acc; }
    for (int r = bid; r < RQ; r += nb) {
        float* xo = xrow_out(p, r);
        const float* m = modrow(p, l, r);
        int e0 = p.sel_e[r * 2], e1 = p.sel_e[r * 2 + 1];
        int t0 = 0, t1 = 0;
#pragma unroll
        for (int q = 0; q < 16; ++q) { if (q == e0) t0 = tstart[q]; if (q == e1) t1 = tstart[q]; }
        const bf16* y0 = p.Y + (size_t)(t0 * 128 + p.apos[r * 2]) * D;
        const bf16* y1 = p.Y + (size_t)(t1 * 128 + p.apos[r * 2 + 1]) * D;
        const float w0 = p.sel_w[r * 2], w1 = p.sel_w[r * 2 + 1];
        THREADS(t, 256) {
            for (int k = t; k < D; k += 256) xo[k] += m[5120 + k] * (w0 * bf2f(y0[k]) + w1 * bf2f(y1[k]));
        }
    }
}

#endif

constexpr int NPHASE_LAYER = 14;
HD void run_phase(const Params& p, int ph, int l, int bid, int nb, float* sm) {
    switch (ph) {
        case 0: ph_norm1(p, l, bid, nb, sm); break;
        case 1: ph_inproj(p, l, bid, nb, (char*)sm); break;
        case 2: ph_prep(p, l, bid, nb); if (FOURIER_GEMM) { if (l == 0) ph_fourier_s1c(p, nb - 1 - bid, nb, (char*)sm); ph_fourier_s1(p, bid, nb, (char*)sm); } break;
        case 3: ph_na(p, l, bid, nb, (char*)sm); break;
        case 4: ph_da(p, l, bid, nb, (char*)sm); break;
        case 5: ph_gdn_chunk(p, l, bid, nb, sm); break;
        case 6: if (FOURIER_GEMM) { if (l == 0) ph_fourier_ctx(p, bid, nb, (char*)sm); ph_fourier_sA(p, bid, nb, (char*)sm); } else ph_fourier2(p, l, bid, nb); break;
        case 7: {
            ph_gdn_scan(p, l, bid, nb, sm);
            const bool split = nb == 512;
            const bool skip = split && (bid < 64 || (bid >= 256 && bid < 320));
            if (!skip) {
                const int b2 = split ? (bid < 256 ? bid - 64 : bid - 128) : bid, n2 = split ? nb - 128 : nb;
                if (FOURIER_GEMM) ph_fourier_sB(p, b2, n2, (char*)sm);
                if (l == 0) convert_static(p, b2, n2, sm, 1);
                convert_moe(p, l, b2, n2, sm);
#ifndef CPU_EMU
                ph_na(p, l, b2, n2, (char*)sm);
#endif
            }
        } break;
#ifndef CPU_EMU
        case 8: ph_gdn_outfin(p, l, bid, nb, sm); break;
#else
        case 8: ph_gdn_fin(p, l, bid, nb); break;
#endif
        case 9: ph_merge(p, l, bid, nb, (char*)sm); break;
        case 10: ph_outproj(p, l, bid, nb, (char*)sm); break;
        case 11: ph_router(p, l, bid, nb, sm); break;
        case 12: ph_ffn1(p, l, bid, nb, (char*)sm); break;
        case 13: ph_ffn2(p, l, bid, nb, (char*)sm); break;
        case 14: ph_combine(p, l, bid, nb); break;
#ifndef CPU_EMU
        case 70: ph_gdn_scan(p, l, bid, nb, sm); break;
        case 71: if (bid >= 64) { if (FOURIER_GEMM) ph_fourier_sB(p, bid - 64, nb - 64, (char*)sm); if (l == 0) convert_static(p, bid - 64, nb - 64, sm, 1); convert_moe(p, l, bid - 64, nb - 64, sm); } break;
        case 110: ph_outproj_t<1>(p, l, bid, nb, (char*)sm); break;
        case 111: ph_router_t<1>(p, l, bid, nb, sm); break;
        case 114: ph_combine_t<1>(p, l, bid, nb); break;
#endif
        default: break;
    }
}

struct WsLayout { size_t dep, fWC, fXC, ropeT, bar, fa2, fW1, fWA, fWB, mods, cosT, sinT, cs, gg, gbeta, sel_e, sel_w, cnt, elist, apos, cG, wt_in, wt_br, wt_out, wt_gu, wt_d,
                  h, P, gq, fcs, cU, cW, cQK, odir, br, mg, act, Y, total; };
inline WsLayout ws_layout() {
    WsLayout w; size_t o = 0;
    auto take = [&](size_t bytes) { size_t r = o; o += (bytes + 255) & ~(size_t)255; return r; };
    w.bar = take(3456 * 4 + 256);        w.ropeT = take(128 * 8 * 2 * 4); w.fWC = take((size_t)CTXL * 2 * CTXL * 2); w.fXC = take((size_t)NB * 256 * 2 * CTXL * 2);
    w.mods = take(2 * 3 * 6144 * 4); w.cosT = take(SEQ * 4); w.sinT = take(SEQ * 4); w.cs = take((size_t)NCTX * D * 4);
    w.gg = take((size_t)8 * R * 4); w.gbeta = take((size_t)8 * R * 4); w.sel_e = take((size_t)R * 2 * 4); w.sel_w = take((size_t)R * 2 * 4);
    w.cnt = take(32 * 4); w.elist = take((size_t)16 * 2 * R * 4); w.apos = take((size_t)2 * R * 4); w.cG = take((size_t)NUNIT * 192 * 4);
    w.wt_in = take((size_t)2 * WIN_NP * D * 2); w.wt_br = take((size_t)2 * 4 * D * 256 * 2); w.wt_out = take((size_t)2 * D * D * 2);
    w.wt_gu = take((size_t)16 * 1024 * D * 2); w.wt_d = take((size_t)16 * D * 512 * 2);
    w.h = take((size_t)R * D * 2);
    w.fa2 = take((size_t)NB * 128 * 256 * 2 * 64 * 2); w.fW1 = take(8192 * 2); w.fWA = take(65536 * 2); w.fWB = take(8192 * 2);
    {
        const size_t szP = ((size_t)R * PLD * 2 + 255) & ~(size_t)255, szQ = ((size_t)R * 768 * 2 + 255) & ~(size_t)255;
        const size_t szA = ((size_t)PADROWS * 512 * 2 + 255) & ~(size_t)255, szY = ((size_t)PADROWS * 1024 * 2 + 255) & ~(size_t)255;
        const size_t base = take((szP + szQ) > (szA + szY) ? (szP + szQ) : (szA + szY));
        w.P = base; w.gq = base + szP; w.act = base; w.Y = base + szA;
    }
    w.fcs = take((size_t)R * 512 * 2);
    w.cU = take((size_t)NUNIT * 4096 * 2); w.cW = take((size_t)NUNIT * 4096 * 2); w.cQK = take((size_t)NUNIT * 4096 * 2);
    w.odir = take((size_t)2 * R * 256 * 2); w.br = take((size_t)R * D * 2);
    w.mg = w.cU;
    w.total = o;
    return w;
}
inline void fill_params(Params& p, void* const* d_in, void* d_out, void* d_ws) {
    WsLayout w = ws_layout(); char* b = (char*)d_ws;
    for (int i = 0; i < 30; ++i) p.in[i] = (const float*)d_in[i];
    p.out = (float*)d_out;
    p.mods = (float*)(b + w.mods); p.cosT = (float*)(b + w.cosT); p.sinT = (float*)(b + w.sinT); p.cs = (float*)(b + w.cs);
    p.h = (bf16*)(b + w.h); p.P = (bf16*)(b + w.P); p.gq = (bf16*)(b + w.gq); p.gg = (float*)(b + w.gg); p.gbeta = (float*)(b + w.gbeta);
    p.fcs = (bf16*)(b + w.fcs); p.cU = (bf16*)(b + w.cU); p.cW = (bf16*)(b + w.cW); p.cQK = (bf16*)(b + w.cQK); p.cG = (float*)(b + w.cG);
    p.odir = (bf16*)(b + w.odir); p.br = (bf16*)(b + w.br); p.mg = (bf16*)(b + w.mg); p.sel_e = (int*)(b + w.sel_e);
    p.sel_w = (float*)(b + w.sel_w); p.act = (bf16*)(b + w.act); p.Y = (bf16*)(b + w.Y);
    p.wt_in = (bf16*)(b + w.wt_in); p.wt_br = (bf16*)(b + w.wt_br); p.wt_out = (bf16*)(b + w.wt_out); p.wt_gu = (bf16*)(b + w.wt_gu);
    p.fa2 = (bf16*)(b + w.fa2); p.fW1 = (bf16*)(b + w.fW1); p.fWA = (bf16*)(b + w.fWA); p.fWB = (bf16*)(b + w.fWB);
    p.bar = (unsigned*)(b + w.bar); p.dep = (int*)(b + w.bar + 3456 * 4); p.ropeT = (float*)(b + w.ropeT); p.fWC = (bf16*)(b + w.fWC); p.fXC = (bf16*)(b + w.fXC);
    p.wt_d = (bf16*)(b + w.wt_d); p.cnt = (int*)(b + w.cnt); p.elist = (int*)(b + w.elist); p.apos = (int*)(b + w.apos);
}

#if !defined(CPU_EMU) && defined(PHASE_KERNELS)
#define PK(n) __global__ void __launch_bounds__(256, 2) pk_##n(Params p) { __shared__ __attribute__((aligned(16))) float sm[SMEM_FLOATS]; run_phase(p, n, p.layer, blockIdx.x, gridDim.x, sm); }
PK(0) PK(1) PK(2) PK(3) PK(4) PK(5) PK(6) PK(7) PK(8) PK(9) PK(10) PK(11) PK(12) PK(13) PK(14)
__global__ void __launch_bounds__(256, 2) pk_init(Params p) { __shared__ __attribute__((aligned(16))) float sm[SMEM_FLOATS]; ph_init(p, blockIdx.x, gridDim.x, sm); }
#endif
#ifndef CPU_EMU

#define XB_TMO      128
#define XB_XCNT(j)  (256  + 64 * (j))
#define XB_XSUB(j)  (1280 + 64 * (j))
#define XB_XGEN(j)  (2304 + 64 * (j))
#define XB_TOP      3328
#define XB_TOPGEN   3392
#define XCD_BAR_WORDS 3456
#define XB_SPIN_CAP (1u << 22)
#define LAS __attribute__((address_space(3)))
__device__ __forceinline__ unsigned xb_ld(unsigned* p)              { return __hip_atomic_load(p, __ATOMIC_RELAXED, __HIP_MEMORY_SCOPE_AGENT); }
__device__ __forceinline__ unsigned xb_add(unsigned* p, unsigned v) { return __hip_atomic_fetch_add(p, v, __ATOMIC_RELAXED, __HIP_MEMORY_SCOPE_AGENT); }
__device__ __forceinline__ unsigned xb_xcc_id() { return (unsigned)__builtin_amdgcn_s_getreg((3 << 11) | 20) & 0xFu; }
#define XB_SPIN(cond, bar) do { unsigned _sp = 0; while (cond) { __builtin_amdgcn_s_sleep(1); \
    if ((++_sp & 255u) == 0u) { if (xb_ld(&(bar)[XB_TMO])) break; if (_sp > XB_SPIN_CAP) { atomicAdd(&(bar)[XB_TMO], 1u); break; } } } } while (0)
struct XcdBarrier { unsigned* bar; unsigned x; volatile LAS unsigned* st; };
__device__ __forceinline__ XcdBarrier xcd_barrier_post(unsigned* bar, volatile LAS unsigned* st) {
    XcdBarrier b; b.bar = bar; b.x = xb_xcc_id(); b.st = st;
    if (threadIdx.x == 0) (void)xb_add(&bar[XB_XCNT(b.x)], 1u);
    return b;
}
__device__ __forceinline__ void xcd_barrier_complete(unsigned* bar, unsigned x, unsigned& nloc, unsigned& nx) {
    const unsigned G = gridDim.x * gridDim.y * gridDim.z;
    unsigned sum, cnt, mine, sp = 0u;
    for (;;) {
        sum = 0u; cnt = 0u; mine = 0u;
#pragma unroll
        for (unsigned j = 0; j < 16; ++j) { const unsigned c = xb_ld(&bar[XB_XCNT(j)]); sum += c; cnt += (c > 0u) ? 1u : 0u; mine = (j == x) ? c : mine; }
        if (sum == G) break;
        __builtin_amdgcn_s_sleep(1);
        if ((++sp & 255u) == 0u) { if (xb_ld(&bar[XB_TMO])) break; if (sp > XB_SPIN_CAP) { atomicAdd(&bar[XB_TMO], 1u); break; } }
    }
    nloc = mine > 0u ? mine : 1u; nx = cnt > 0u ? cnt : 1u;
}
__device__ __forceinline__ void xcd_barrier(const XcdBarrier& b) {
    asm volatile("s_waitcnt vmcnt(0)" ::: "memory");
    __syncthreads();
    if (threadIdx.x == 0) {
        unsigned* bar = b.bar;
        __builtin_amdgcn_s_waitcnt(0);
        unsigned nloc = b.st[0], nx = b.st[1];
        if (nloc == 0u) { xcd_barrier_complete(bar, b.x, nloc, nx); b.st[0] = nloc; b.st[1] = nx; }
        const unsigned old = xb_add(&bar[XB_XSUB(b.x)], 1u);
        const unsigned gen = old / nloc;
        if (old + 1u == (gen + 1u) * nloc) {
            __builtin_amdgcn_fence(__ATOMIC_RELEASE, "agent");
            asm volatile("s_waitcnt vmcnt(0)" ::: "memory");
            const unsigned og = xb_add(&bar[XB_TOP], 1u);
            const unsigned tg = og / nx;
            if (og + 1u == (tg + 1u) * nx) xb_add(&bar[XB_TOPGEN], 1u);
            else XB_SPIN(xb_ld(&bar[XB_TOPGEN]) == tg, bar);
            __builtin_amdgcn_fence(__ATOMIC_ACQUIRE, "agent");
            xb_add(&bar[XB_XGEN(b.x)], 1u);
            asm volatile("s_waitcnt vmcnt(0)" ::: "memory");
        } else {
            XB_SPIN(xb_ld(&bar[XB_XGEN(b.x)]) == gen, bar);
            __builtin_amdgcn_fence(__ATOMIC_ACQUIRE, "agent");
            asm volatile("s_waitcnt vmcnt(0)" ::: "memory");
        }
    }
    __syncthreads();
}

__global__ void __launch_bounds__(256, 2) fwd_megakernel(Params p) {
    __shared__ __attribute__((aligned(16))) float sm[SMEM_FLOATS];
    cg::grid_group grid = cg::this_grid();
    const int bid = blockIdx.x, nb = gridDim.x;
    volatile LAS unsigned* xst = (volatile LAS unsigned*)(sm + SMEM_FLOATS - 4);
    if (threadIdx.x == 0) { xst[0] = 0u; xst[1] = 0u; }
    __syncthreads();
    XcdBarrier xb = xcd_barrier_post(p.bar, xst);
    ph_init(p, bid, nb, sm);
    dep_wait(p.dep, 96);
    ph_norm1(p, 0, bid, nb, sm);
    xcd_barrier(xb);
#ifdef PROBE_INIT
    ph_init(p, bid, nb, sm); xcd_barrier(xb); ph_init(p, bid, nb, sm); xcd_barrier(xb);
#endif
#define PH(n, l) run_phase(p, n, l, bid, nb, sm); xcd_barrier(xb);
#define PHN(n, l) run_phase(p, n, l, bid, nb, sm);
#ifndef PROBE_X
#define PROBE_X(n, l)
#endif
#define LAYER(l) PH(1, l) PROBE_X(1, l) PH(2, l) PROBE_X(2, l) PHN(4, l) PHN(6, l) PH(5, l) PROBE_X(4, l) PROBE_X(5, l) PROBE_X(3, l) PROBE_X(6, l) \
    PH(7, l) PROBE_X(7, l) PROBE_X(70, l) PROBE_X(71, l) PH(8, l) PROBE_X(8, l) PH(9, l) PROBE_X(9, l) PH(10, l) PH(11, l) PH(12, l) PROBE_X(12, l) \
    PH(13, l) PROBE_X(13, l) PH(14, l)
    LAYER(0)
#undef LAYER
#define LAYER(l) PH(1, l) PROBE_X(1, l) PH(2, l) PROBE_X(2, l) PHN(4, l) PHN(6, l) PH(5, l) PROBE_X(4, l) PROBE_X(5, l) PROBE_X(3, l) PROBE_X(6, l) \
    PH(7, l) PROBE_X(7, l) PROBE_X(70, l) PROBE_X(71, l) PH(8, l) PROBE_X(8, l) PH(9, l) PROBE_X(9, l) PH(10, l) PROBE_X(110, l) PH(11, l) PROBE_X(111, l) PH(12, l) PROBE_X(12, l) \
    PH(13, l) PROBE_X(13, l) PH(14, l) PROBE_X(114, l)
    LAYER(1)
}

extern "C" void kernel_launch(void* const* d_in, const int* in_sizes, int n_in, void* d_out, int out_size,
                              void* d_ws, size_t ws_size, hipStream_t stream) {
    WsLayout w = ws_layout();
    if (ws_size < w.total) { fprintf(stderr, "ws too small: need %zu have %zu\n", w.total, ws_size); return; }
    static int grid_blocks = 0;
    if (!grid_blocks) {
        int dev = 0, cus = 0, per_cu = 0;
        (void)hipGetDevice(&dev);
        (void)hipDeviceGetAttribute(&cus, hipDeviceAttributeMultiprocessorCount, dev);
        (void)hipOccupancyMaxActiveBlocksPerMultiprocessor(&per_cu, fwd_megakernel, 256, 0);
        if (per_cu < 1) per_cu = 1;
        grid_blocks = cus * per_cu;
    }
    Params p{};
    fill_params(p, d_in, d_out, d_ws);
    (void)hipMemsetAsync(p.bar, 0, XCD_BAR_WORDS * 4 + 256, stream);
    void* args[] = {&p};
    hipError_t e = hipLaunchCooperativeKernel((void*)fwd_megakernel, dim3(grid_blocks), dim3(256), args, 0, stream);
    if (e != hipSuccess) fprintf(stderr, "cooperative launch failed: %s (grid %d)\n", hipGetErrorString(e), grid_blocks);
}
#endif
```

```cpp
#ifndef CPU_EMU
#include <hip/hip_runtime.h>
#include <hip/hip_cooperative_groups.h>
#include <cstdio>
namespace cg = cooperative_groups;
#define HD __device__ __forceinline__
__device__ __forceinline__ int tid_() { int v = threadIdx.x; asm volatile("" : "+v"(v)); return v; }
#define THREADS(t, n) for (int t = tid_(); t < (n); t += 256)
#define SYNC __syncthreads();
#define COSPI(x) cospif(x)
#define SINPI(x) sinpif(x)
typedef float4 f4;
#else
#include <cmath>
#include <cstdio>
#include <cstring>
#include <cstddef>
#define HD inline
#define THREADS(t, n) for (int t = 0; t < (n); ++t)
#define SYNC
#define COSPI(x) ((float)cos(M_PI * (double)(x)))
#define SINPI(x) ((float)sin(M_PI * (double)(x)))
struct f4 { float x, y, z, w; };
#endif

#ifndef SEQ
#define SEQ 8192
#endif
#ifndef CTXL
#define CTXL 256
#endif

typedef unsigned short bf16;
#ifndef CPU_EMU
typedef __attribute__((ext_vector_type(8))) short bf16x8_t;
typedef __attribute__((ext_vector_type(4))) float f32x4_t;
typedef __attribute__((ext_vector_type(4))) int i32x4_t;
#define ATOMIC_ADD_RET(ptr, v) atomicAdd((ptr), (v))
#else
HD int atomic_add_ret_(int* p, int v) { int old;
#pragma omp atomic capture
    { old = *p; *p += v; }
    return old; }
#define ATOMIC_ADD_RET(ptr, v) atomic_add_ret_((ptr), (v))
#endif
constexpr int NB = 2, D = 1024, GW = 64, ROWS = SEQ / GW;
constexpr int NLAT = NB * SEQ, NCTX = NB * CTXL, R = NLAT + NCTX;
constexpr int DIN = 6928;
constexpr int PLD = 2816;
constexpr int C_NAQ = 0, C_NAK = 256, C_NAV = 512, C_DAQ = 768, C_DAK = 1024, C_DAV = 1280, C_GQ = 1536, C_Z = 2304,
              C_F = 2560;
constexpr int WIN_N = 6912;
constexpr int WIN_NP = WIN_N + 64;
constexpr int PADROWS = 2 * R + 16 * 128;
constexpr int NCC = CTXL / 64, NCL = SEQ / 64, NCH = NCC + NCL;
constexpr int NUNIT = 2 * NB * 4 * NCH;
constexpr bool FOURIER_GEMM = (SEQ == 8192);
constexpr int SMEM_FLOATS = 73 * 256 + 4;

struct Params {
    const float* in[30];
    float* out;
    float* mods;
    float* cosT;
    float* sinT;
    float* cs;
    bf16* h;
    bf16* P;
    bf16* gq;
    float* gg;
    float* gbeta;
    bf16* fcs;
    bf16* cU;
    bf16* cW;
    bf16* cQK;
    float* cG;
    bf16* odir;
    bf16* br;
    bf16* mg;
    int* sel_e;
    float* sel_w;
    bf16* act;
    bf16* Y;
    bf16* wt_in;
    bf16* wt_br;
    bf16* wt_out;
    bf16* wt_gu;
    bf16* wt_d;
    int* cnt;
    int* dep;
    unsigned* bar;
    bf16* fa2;
    bf16* fW1;
    float* ropeT;
    bf16* fWA;
    bf16* fWB;
    bf16* fWC;
    bf16* fXC;
    int* elist;
    int* apos;
    int phase;
    int layer;
};

enum { I_X = 0, I_C, I_CTX, I_CCTX, I_WMOD, I_BMOD, I_N1G, I_N2G, I_WIN, I_NAQG, I_NAKG, I_RPB, I_DAQG, I_DAKG, I_LQ1, I_LK1,
       I_LQ2, I_LK2, I_SUBLN, I_CONVW, I_ALOG, I_DTB, I_ONORM, I_WBR, I_WOUT, I_WROUTER, I_RBIAS, I_MG, I_MU, I_MD };

HD float bf2f(bf16 v) { union { unsigned u; float f; } x; x.u = ((unsigned)v) << 16; return x.f; }
#ifndef CPU_EMU
typedef float f32x2_t __attribute__((ext_vector_type(2))); typedef __bf16 bf16x2_t __attribute__((ext_vector_type(2)));
typedef short s16x4_t __attribute__((ext_vector_type(4)));
typedef __attribute__((address_space(3))) const char* lds_cptr;
HD unsigned cvtpk(float lo, float hi) { f32x2_t v = {lo, hi}; bf16x2_t b = __builtin_convertvector(v, bf16x2_t); return __builtin_bit_cast(unsigned, b); }
HD bf16 f2bf(float f) { return (bf16)(cvtpk(f, 0.f) & 0xffffu); }
HD s16x4_t lds_tr16(lds_cptr p) { return __builtin_bit_cast(s16x4_t, __builtin_amdgcn_ds_read_tr16_b64_v4i16((__attribute__((address_space(3))) s16x4_t*)p)); }
#else
HD bf16 f2bf(float f) { union { unsigned u; float f; } x; x.f = f; unsigned u = x.u; u += 0x7fffu + ((u >> 16) & 1u); return (bf16)(u >> 16); }
#endif
HD float sigmoidf_(float x) { return 1.0f / (1.0f + expf(-x)); }
HD float siluf_(float x) { return x / (1.0f + expf(-x)); }

struct RowInfo { int seg, b, t, T, base; };
HD RowInfo rowinfo(int r) {
    RowInfo q;
    if (r < NLAT) { q.seg = 0; q.b = r / SEQ; q.t = r % SEQ; q.T = SEQ; q.base = q.b * SEQ; }
    else { int r2 = r - NLAT; q.seg = 1; q.b = r2 / CTXL; q.t = r2 % CTXL; q.T = CTXL; q.base = NLAT + q.b * CTXL; }
    return q;
}
HD const float* xrow_in(const Params& p, int l, int r) {
    if (r < NLAT) return (l == 0 ? p.in[I_X] : p.out) + (size_t)r * D;
    return p.cs + (size_t)(r - NLAT) * D;
}
HD float* xrow_out(const Params& p, int r) {
    if (r < NLAT) return p.out + (size_t)r * D;
    return p.cs + (size_t)(r - NLAT) * D;
}
HD const float* modrow(const Params& p, int l, int r) {
    int s = (r < NLAT) ? (r / SEQ) : 2;
    return p.mods + (size_t)(l * 3 + s) * 6144;
}
#ifndef CPU_EMU
HD unsigned char* gu8_of(const Params& p) { return (unsigned char*)p.wt_gu; }
HD unsigned char* d8_of(const Params& p) { return (unsigned char*)p.wt_gu + (size_t)16 * 1024 * 1024; }
HD unsigned char* h8_of(const Params& p) { return (unsigned char*)p.wt_gu + (size_t)16 * 1024 * 1024 + (size_t)16 * 1024 * 512; }
#endif
HD float lam_init_of(int l) { return l == 0 ? 0.2f : (0.8f - 0.6f * 0.7408182206817179f); }


#ifndef CPU_EMU
template <int NJ> struct AccT { f32x4_t v[4][NJ]; };
#define ACC_DECL(NJ, a) AccT<NJ> a
template <int NJ> HD void acc_zero(AccT<NJ>& a) {
#pragma unroll
    for (int i = 0; i < 4; ++i)
#pragma unroll
        for (int j = 0; j < NJ; ++j) a.v[i][j] = f32x4_t{0.f, 0.f, 0.f, 0.f};
}
#define ACC_FOR(NJ, row, col) { const int _t = tid_(); const int _ln = _t & 63, _w = _t >> 6; \
    _Pragma("unroll") for (int _i = 0; _i < 4; ++_i) _Pragma("unroll") for (int _j = 0; _j < NJ; ++_j) _Pragma("unroll") for (int _r = 0; _r < 4; ++_r) { \
    const int row = (_w >> 1) * 64 + _i * 16 + (_ln >> 4) * 4 + _r; const int col = (_w & 1) * (16 * NJ) + _j * 16 + (_ln & 15);
#define AV(a) a.v[_i][_j][_r]
#define ACC_END }}
#define ACC_FOR_PAIR(row, pcol) { const int _t = tid_(); const int _ln = _t & 63, _w = _t >> 6; \
    _Pragma("unroll") for (int _i = 0; _i < 4; ++_i) _Pragma("unroll") for (int _jj = 0; _jj < 2; ++_jj) _Pragma("unroll") for (int _r = 0; _r < 4; ++_r) { \
    const int row = (_w >> 1) * 64 + _i * 16 + (_ln >> 4) * 4 + _r; const int pcol = (_w & 1) * 32 + _jj * 16 + (_ln & 15);
#define AV_G(a) a.v[_i][2 * _jj][_r]
#define AV_U(a) a.v[_i][2 * _jj + 1][_r]

#define WAIT_VM0() asm volatile("s_waitcnt vmcnt(0)" ::: "memory")
#define GLDS16(gp, lp) __builtin_amdgcn_global_load_lds((const unsigned*)(gp), (unsigned*)(lp), 16, 0, 0)
template <int NJ, class AF, class BF>
HD void gemm_accum(AccT<NJ>& acc, AF arow, BF brow, int K, char* smem) {
    constexpr int NBL = NJ;
    const int t = tid_(), lane = t & 63, w = t >> 6, wr = w >> 1, wc = w & 1;
    const int lr = t >> 3, lc = t & 7;
    const bf16* ap[4]; const bf16* bp[NBL];
#pragma unroll
    for (int i = 0; i < 4; ++i) ap[i] = arow(lr + 32 * i) + ((lc ^ (lr & 7)) << 3);
#pragma unroll
    for (int i = 0; i < NBL; ++i) bp[i] = brow(lr + 32 * i) + ((lc ^ (lr & 7)) << 3);
    char* sA = smem + w * 1024; char* sB = smem + 32768 + w * 1024;
    const int fr = lane & 15, fg = lane >> 4;
    const unsigned aoff0 = (wr * 64 + fr) * 128 + (((fg) ^ (fr & 7)) << 4);
    const unsigned aoff1 = (wr * 64 + fr) * 128 + (((4 + fg) ^ (fr & 7)) << 4);
    const unsigned boff0 = (wc * (16 * NJ) + fr) * 128 + (((fg) ^ (fr & 7)) << 4);
    const unsigned boff1 = (wc * (16 * NJ) + fr) * 128 + (((4 + fg) ^ (fr & 7)) << 4);
    const int KT = K >> 6;
    __syncthreads();
#pragma unroll
    for (int i = 0; i < 4; ++i) GLDS16(ap[i], sA + 4096 * i);
#pragma unroll
    for (int i = 0; i < NBL; ++i) GLDS16(bp[i], sB + 4096 * i);
    WAIT_VM0();
    __syncthreads();
#pragma unroll 1
    for (int kt = 0; kt < KT; ++kt) {
        const int cur = kt & 1;
        if (kt + 1 < KT) {
#pragma unroll
            for (int i = 0; i < 4; ++i) GLDS16(ap[i] + (kt + 1) * 64, sA + (cur ^ 1) * 16384 + 4096 * i);
#pragma unroll
            for (int i = 0; i < NBL; ++i) GLDS16(bp[i] + (kt + 1) * 64, sB + (cur ^ 1) * 16384 + 4096 * i);
        }
        const char* cA = smem + cur * 16384; const char* cB = smem + 32768 + cur * 16384;
#pragma unroll
        for (int s = 0; s < 2; ++s) {
            bf16x8_t af[4], bfr[NJ];
#pragma unroll
            for (int i = 0; i < 4; ++i) af[i] = *(const bf16x8_t*)(cA + (s ? aoff1 : aoff0) + i * 2048);
#pragma unroll
            for (int j = 0; j < NJ; ++j) bfr[j] = *(const bf16x8_t*)(cB + (s ? boff1 : boff0) + j * 2048);
#pragma unroll
            for (int i = 0; i < 4; ++i)
#pragma unroll
                for (int j = 0; j < NJ; ++j) acc.v[i][j] = __builtin_amdgcn_mfma_f32_16x16x32_bf16(af[i], bfr[j], acc.v[i][j], 0, 0, 0);
        }
        WAIT_VM0();
        __syncthreads();
    }
}
template <int NJ> HD void acc_to_lds(const AccT<NJ>& acc, float* tl) {
    const int t = tid_(), lane = t & 63, w = t >> 6;
    constexpr int LD = 32 * NJ + 4;
    float* base = tl + ((w >> 1) * 64 + (lane >> 4) * 4) * LD + (w & 1) * (16 * NJ) + (lane & 15);
#pragma unroll
    for (int i = 0; i < 4; ++i)
#pragma unroll
        for (int j = 0; j < NJ; ++j)
#pragma unroll
            for (int r = 0; r < 4; ++r) base[(i * 16 + r) * LD + j * 16] = acc.v[i][j][r];
}
typedef int i32x8_t __attribute__((ext_vector_type(8)));
typedef unsigned char u8;
template <int NJ, class AF, class BF>
HD void gemm_accum8(AccT<NJ>& acc, AF arow, BF brow, int K, char* smem, int sa, int sb) {
    constexpr int NBL = NJ;
    const int t = tid_(), lane = t & 63, w = t >> 6, wr = w >> 1, wc = w & 1;
    const int lr = t >> 3, lc = t & 7;
    const u8* ap[4]; const u8* bp[NBL];
#pragma unroll
    for (int i = 0; i < 4; ++i) ap[i] = arow(lr + 32 * i) + ((lc ^ (lr & 7)) << 4);
#pragma unroll
    for (int i = 0; i < NBL; ++i) bp[i] = brow(lr + 32 * i) + ((lc ^ (lr & 7)) << 4);
    char* sA = smem + w * 1024; char* sB = smem + 32768 + w * 1024;
    const int fr = lane & 15, fg = lane >> 4;
    const unsigned aoff0 = (wr * 64 + fr) * 128 + (((2 * fg) ^ (fr & 7)) << 4);
    const unsigned aoff1 = (wr * 64 + fr) * 128 + (((2 * fg + 1) ^ (fr & 7)) << 4);
    const unsigned boff0 = (wc * (16 * NJ) + fr) * 128 + (((2 * fg) ^ (fr & 7)) << 4);
    const unsigned boff1 = (wc * (16 * NJ) + fr) * 128 + (((2 * fg + 1) ^ (fr & 7)) << 4);
    const int KT = K >> 7;
    __syncthreads();
#pragma unroll
    for (int i = 0; i < 4; ++i) GLDS16(ap[i], sA + 4096 * i);
#pragma unroll
    for (int i = 0; i < NBL; ++i) GLDS16(bp[i], sB + 4096 * i);
    WAIT_VM0();
    __syncthreads();
#pragma unroll 1
    for (int kt = 0; kt < KT; ++kt) {
        const int cur = kt & 1;
        if (kt + 1 < KT) {
#pragma unroll
            for (int i = 0; i < 4; ++i) GLDS16(ap[i] + (kt + 1) * 128, sA + (cur ^ 1) * 16384 + 4096 * i);
#pragma unroll
            for (int i = 0; i < NBL; ++i) GLDS16(bp[i] + (kt + 1) * 128, sB + (cur ^ 1) * 16384 + 4096 * i);
        }
        const char* cA = smem + cur * 16384; const char* cB = smem + 32768 + cur * 16384;
        i32x8_t af[4], bfr[NJ];
#pragma unroll
        for (int i = 0; i < 4; ++i) {
            const i32x4_t lo = *(const i32x4_t*)(cA + aoff0 + i * 2048), hi = *(const i32x4_t*)(cA + aoff1 + i * 2048);
            af[i] = i32x8_t{lo[0], lo[1], lo[2], lo[3], hi[0], hi[1], hi[2], hi[3]};
        }
#pragma unroll
        for (int j = 0; j < NJ; ++j) {
            const i32x4_t lo = *(const i32x4_t*)(cB + boff0 + j * 2048), hi = *(const i32x4_t*)(cB + boff1 + j * 2048);
            bfr[j] = i32x8_t{lo[0], lo[1], lo[2], lo[3], hi[0], hi[1], hi[2], hi[3]};
        }
#pragma unroll
        for (int i = 0; i < 4; ++i)
#pragma unroll
            for (int j = 0; j < NJ; ++j) acc.v[i][j] = __builtin_amdgcn_mfma_scale_f32_16x16x128_f8f6f4(af[i], bfr[j], acc.v[i][j], 0, 0, 0, sa, 0, sb);
        WAIT_VM0();
        __syncthreads();
    }
}
HD unsigned pack_fp8x4(float a, float b, float c, float d) {
    a = __builtin_amdgcn_fmed3f(a, -448.f, 448.f); b = __builtin_amdgcn_fmed3f(b, -448.f, 448.f);
    c = __builtin_amdgcn_fmed3f(c, -448.f, 448.f); d = __builtin_amdgcn_fmed3f(d, -448.f, 448.f);
    int w = 0;
    w = __builtin_amdgcn_cvt_pk_fp8_f32(a, b, w, false);
    w = __builtin_amdgcn_cvt_pk_fp8_f32(c, d, w, true);
    return (unsigned)w;
}
constexpr int SC_H = 0x7d7d7d7d;
constexpr int SC_W = 0x7a7a7a7a;
constexpr int SC_ACT = 0x7b7b7b7b;
template <int NJ, class AF, class BF>
HD void gemm_stage0(AF arow, BF brow, int ebytes, char* smem, int buf) {
    const int t = tid_(), w = t >> 6, lr = t >> 3, lc = t & 7;
    char* sA = smem + w * 1024 + buf * 16384; char* sB = smem + 32768 + w * 1024 + buf * 16384;
    (void)ebytes;
#pragma unroll
    for (int i = 0; i < 4; ++i) GLDS16((const char*)arow(lr + 32 * i) + ((lc ^ (lr & 7)) << 4), sA + 4096 * i);
#pragma unroll
    for (int i = 0; i < NJ; ++i) GLDS16((const char*)brow(lr + 32 * i) + ((lc ^ (lr & 7)) << 4), sB + 4096 * i);
}
template <int NJ, bool FP8, class AF, class BF, class NF>
HD void gemm_chain(AccT<NJ>& acc, AF arow, BF brow, int K, char* smem, int& cur, NF next_stage, int sa, int sb) {
    const int t = tid_(), lane = t & 63, w = t >> 6, wr = w >> 1, wc = w & 1;
    const int lr = t >> 3, lc = t & 7;
    const char* ap[4]; const char* bp[NJ];
#pragma unroll
    for (int i = 0; i < 4; ++i) ap[i] = (const char*)arow(lr + 32 * i) + ((lc ^ (lr & 7)) << 4);
#pragma unroll
    for (int i = 0; i < NJ; ++i) bp[i] = (const char*)brow(lr + 32 * i) + ((lc ^ (lr & 7)) << 4);
    char* sA = smem + w * 1024; char* sB = smem + 32768 + w * 1024;
    const int fr = lane & 15, fg = lane >> 4;
    const unsigned rA = (wr * 64 + fr) * 128, rB = (wc * (16 * NJ) + fr) * 128;
    const int KT = K >> (FP8 ? 7 : 6);
#pragma unroll 1
    for (int kt = 0; kt < KT; ++kt) {
        WAIT_VM0();
        __syncthreads();
        if (kt + 1 < KT) {
#pragma unroll
            for (int i = 0; i < 4; ++i) GLDS16(ap[i] + (kt + 1) * 128, sA + (cur ^ 1) * 16384 + 4096 * i);
#pragma unroll
            for (int i = 0; i < NJ; ++i) GLDS16(bp[i] + (kt + 1) * 128, sB + (cur ^ 1) * 16384 + 4096 * i);
        } else next_stage(cur ^ 1);
        const char* cA = smem + cur * 16384; const char* cB = smem + 32768 + cur * 16384;
        if (FP8) {
            i32x8_t af[4], bfr[NJ];
#pragma unroll
            for (int i = 0; i < 4; ++i) {
                const i32x4_t lo = *(const i32x4_t*)(cA + rA + (((2 * fg) ^ (fr & 7)) << 4) + i * 2048), hi = *(const i32x4_t*)(cA + rA + (((2 * fg + 1) ^ (fr & 7)) << 4) + i * 2048);
                af[i] = i32x8_t{lo[0], lo[1], lo[2], lo[3], hi[0], hi[1], hi[2], hi[3]};
            }
#pragma unroll
            for (int j = 0; j < NJ; ++j) {
                const i32x4_t lo = *(const i32x4_t*)(cB + rB + (((2 * fg) ^ (fr & 7)) << 4) + j * 2048), hi = *(const i32x4_t*)(cB + rB + (((2 * fg + 1) ^ (fr & 7)) << 4) + j * 2048);
                bfr[j] = i32x8_t{lo[0], lo[1], lo[2], lo[3], hi[0], hi[1], hi[2], hi[3]};
            }
#pragma unroll
            for (int i = 0; i < 4; ++i)
#pragma unroll
                for (int j = 0; j < NJ; ++j) acc.v[i][j] = __builtin_amdgcn_mfma_scale_f32_16x16x128_f8f6f4(af[i], bfr[j], acc.v[i][j], 0, 0, 0, sa, 0, sb);
        } else {
#pragma unroll
            for (int s_ = 0; s_ < 2; ++s_) {
                bf16x8_t af[4], bfr[NJ];
#pragma unroll
                for (int i = 0; i < 4; ++i) af[i] = *(const bf16x8_t*)(cA + rA + (((4 * s_ + fg) ^ (fr & 7)) << 4) + i * 2048);
#pragma unroll
                for (int j = 0; j < NJ; ++j) bfr[j] = *(const bf16x8_t*)(cB + rB + (((4 * s_ + fg) ^ (fr & 7)) << 4) + j * 2048);
#pragma unroll
                for (int i = 0; i < 4; ++i)
#pragma unroll
                    for (int j = 0; j < NJ; ++j) acc.v[i][j] = __builtin_amdgcn_mfma_f32_16x16x32_bf16(af[i], bfr[j], acc.v[i][j], 0, 0, 0);
            }
        }
        cur ^= 1;
    }
}
#else
template <int NJ> struct AccT { float v[128][32 * NJ]; };
#define ACC_DECL(NJ, a) static thread_local AccT<NJ> a
template <int NJ> HD void acc_zero(AccT<NJ>& a) { memset(a.v, 0, sizeof(a.v)); }
#define ACC_FOR(NJ, row, col) { for (int row = 0; row < 128; ++row) for (int col = 0; col < 32 * NJ; ++col) {
#define AV(a) a.v[row][col]
#define ACC_END }}
#define ACC_FOR_PAIR(row, pcol) { for (int row = 0; row < 128; ++row) for (int pcol = 0; pcol < 64; ++pcol) {
#define AV_G(a) a.v[row][(pcol / 16) * 32 + (pcol % 16)]
#define AV_U(a) a.v[row][(pcol / 16) * 32 + 16 + (pcol % 16)]
template <int NJ, class AF, class BF>
HD void gemm_accum(AccT<NJ>& acc, AF arow, BF brow, int K, char* smem) {
    for (int i = 0; i < 128; ++i) { const bf16* a = arow(i);
        for (int j = 0; j < 32 * NJ; ++j) { const bf16* b = brow(j); float s = 0.f;
            for (int k = 0; k < K; ++k) s += bf2f(a[k]) * bf2f(b[k]);
            acc.v[i][j] += s; } }
}
#endif

template <class DF>
HD void conv_tile(const float* src, size_t lds_, bf16* dst, size_t ldd, int k0, int nsrc0, DF drow, float* sm) {
    THREADS(t, 4096) { int kk = t >> 6, nn = t & 63; sm[kk * 65 + nn] = src[(size_t)(k0 + kk) * lds_ + nsrc0 + nn]; }
    SYNC
    THREADS(t, 4096) { int nn = t >> 6, kk = t & 63; dst[(size_t)drow(nn) * ldd + k0 + kk] = f2bf(sm[kk * 65 + nn]); }
    SYNC
}
#ifndef CPU_EMU
template <class DF>
HD void conv_tile8(const float* src, size_t lds_, unsigned char* dst, size_t ldd, int k0, int nsrc0, DF drow, float scale, float* sm) {
    THREADS(t, 4096) { int kk = t >> 6, nn = t & 63; sm[kk * 65 + nn] = src[(size_t)(k0 + kk) * lds_ + nsrc0 + nn] * scale; }
    SYNC
    THREADS(t, 1024) { int nn = t >> 4, k4 = (t & 15) * 4;
        *(unsigned*)(dst + (size_t)drow(nn) * ldd + k0 + k4) = pack_fp8x4(sm[k4 * 65 + nn], sm[(k4 + 1) * 65 + nn], sm[(k4 + 2) * 65 + nn], sm[(k4 + 3) * 65 + nn]); }
    SYNC
}
HD void convert_moe(const Params& p, int l, int bid, int nb, float* sm) {
    for (int w = bid; w < 4096 + 2048; w += nb) {
        if (w < 4096) {
            int nt = w & 7, kt = (w >> 3) & 15, gu = (w >> 7) & 1, e = w >> 8;
            const float* src = p.in[gu ? I_MU : I_MG] + (size_t)(l * 16 + e) * D * 512;
            conv_tile8(src, 512, gu8_of(p) + (size_t)e * 1024 * D, D, kt * 64, nt * 64, [&](int nn) { int j = nt * 64 + nn; return (j >> 4) * 32 + (j & 15) + 16 * gu; }, 32.0f, sm);
        } else {
            int w2 = w - 4096; int nt = w2 & 15, kt = (w2 >> 4) & 7, e = w2 >> 7;
            const float* src = p.in[I_MD] + (size_t)(l * 16 + e) * 512 * D;
            conv_tile8(src, D, d8_of(p) + (size_t)e * D * 512, 512, kt * 64, nt * 64, [&](int nn) { return nt * 64 + nn; }, 32.0f, sm);
        }
    }
}
#else
HD void convert_moe(const Params& p, int l, int bid, int nb, float* sm) {
    for (int w = bid; w < 4096 + 2048; w += nb) {
        if (w < 4096) {
            int nt = w & 7, kt = (w >> 3) & 15, gu = (w >> 7) & 1, e = w >> 8;
            const float* src = p.in[gu ? I_MU : I_MG] + (size_t)(l * 16 + e) * D * 512;
            bf16* dst = p.wt_gu + (size_t)e * 1024 * D;
            conv_tile(src, 512, dst, D, kt * 64, nt * 64, [&](int nn) { int j = nt * 64 + nn; return (j >> 4) * 32 + (j & 15) + 16 * gu; }, sm);
        } else {
            int w2 = w - 4096; int nt = w2 & 15, kt = (w2 >> 4) & 7, e = w2 >> 7;
            const float* src = p.in[I_MD] + (size_t)(l * 16 + e) * 512 * D;
            bf16* dst = p.wt_d + (size_t)e * D * 512;
            conv_tile(src, D, dst, 512, kt * 64, nt * 64, [&](int nn) { return nt * 64 + nn; }, sm);
        }
    }
}
#endif
HD void convert_static(const Params& p, int bid, int nb, float* sm, int part) {
    for (int w = bid; w < 3456 + 512 + 512 + 32; w += nb) {
        {
            const bool is_win = (w < 3456), is_ab = (w >= 3456 + 512 + 512);
            const int wl = is_win ? (w / (108 * 16)) : (is_ab ? ((w - 3456 - 512 - 512) >> 4) : 1);
            const bool early = (is_win || is_ab) && wl == 0;
            if ((part == 0) != early) continue;
        }
        if (w >= 3456 + 512 + 512) {
            int w2 = w - 3456 - 512 - 512; int kt = w2 & 15, l = w2 >> 4;
            conv_tile(p.in[I_WIN] + (size_t)l * D * DIN, DIN, p.wt_in + (size_t)l * WIN_NP * D, D, kt * 64, 2560, [&](int nn) { return WIN_N + nn; }, sm);
        } else if (w < 3456) {
            int nt = w % 108, kt = (w / 108) & 15, l = w / (108 * 16);
            int n0 = nt * 64;
#ifndef CPU_EMU
            if (n0 >= PLD) {
                conv_tile8(p.in[I_WIN] + (size_t)l * D * DIN, DIN, (unsigned char*)(p.wt_in + (size_t)l * WIN_NP * D + (size_t)PLD * D), D, kt * 64, n0 + 16,
                           [&](int nn) { return n0 - PLD + nn; }, 32.0f, sm);
                continue;
            }
#endif
            conv_tile(p.in[I_WIN] + (size_t)l * D * DIN, DIN, p.wt_in + (size_t)l * WIN_NP * D, D, kt * 64, n0 < 2560 ? n0 : n0 + 16,
                      [&](int nn) { return n0 + nn; }, sm);
        } else if (w < 3456 + 512) {
            int w2 = w - 3456; int nt = w2 & 15, kt = (w2 >> 4) & 3, li = w2 >> 6;
            conv_tile(p.in[I_WBR] + (size_t)li * 256 * D, D, p.wt_br + (size_t)li * D * 256, 256, kt * 64, nt * 64, [&](int nn) { return nt * 64 + nn; }, sm);
        } else {
            int w2 = w - 3456 - 512; int nt = w2 & 15, kt = (w2 >> 4) & 15, l = w2 >> 8;
            conv_tile(p.in[I_WOUT] + (size_t)l * D * D, D, p.wt_out + (size_t)l * D * D, D, kt * 64, nt * 64, [&](int nn) { return nt * 64 + nn; }, sm);
        }
    }
}

#ifndef CPU_EMU
HD void dep_signal(int* cnt) {
    asm volatile("s_waitcnt vmcnt(0)" ::: "memory");
    __syncthreads();
    if (tid_() == 0) {
        __builtin_amdgcn_fence(__ATOMIC_RELEASE, "agent");
        asm volatile("s_waitcnt vmcnt(0)" ::: "memory");
        (void)__hip_atomic_fetch_add(cnt, 1, __ATOMIC_RELAXED, __HIP_MEMORY_SCOPE_AGENT);
    }
}
HD void dep_wait(int* cnt, int target) {
    if (tid_() == 0) {
        unsigned sp = 0;
        while (__hip_atomic_load(cnt, __ATOMIC_RELAXED, __HIP_MEMORY_SCOPE_AGENT) < target) { __builtin_amdgcn_s_sleep(4); if (++sp > (1u << 22)) break; }
        __builtin_amdgcn_fence(__ATOMIC_ACQUIRE, "agent");
        asm volatile("s_waitcnt vmcnt(0)" ::: "memory");
    }
    __syncthreads();
}
#endif
HD void init_tables(const Params& p, int bid, int nb) {
    for (int u = bid; u < (SEQ + 255) / 256; u += nb) {
        THREADS(t, 256) {
            int j = u * 256 + t;
            if (j < SEQ) { float a = 2.0f * (float)j / (float)SEQ; p.cosT[j] = COSPI(a); p.sinT[j] = SINPI(a); }
        }
    }
    if (bid == 0) {
        THREADS(t, 1024) {
            int pos = t >> 3, f = t & 7; float fr_ = 1.0f;
            for (int q = 0; q < f; ++q) fr_ *= 0.31622776601683794f;
            float ang = (float)pos * fr_;
            p.ropeT[t * 2] = cosf(ang); p.ropeT[t * 2 + 1] = sinf(ang);
        }
    }
    for (int u = bid; u < (CTXL * 2 * CTXL) / 256; u += nb) {
        THREADS(t, 256) {
            int i = u * 256 + t; int k = i / (2 * CTXL), q = i % (2 * CTXL); int cs = q / CTXL, tt = q % CTXL;
            float a = 2.0f * (float)((k * tt) % CTXL) / (float)CTXL;
            p.fWC[i] = f2bf(cs ? -SINPI(a) : COSPI(a));
        }
    }
    for (int u = bid; u < (8192 + 65536 + 8192) / 256; u += nb) {
        THREADS(t, 256) {
            int i = u * 256 + t;
            if (i < 8192) {
                int j = i >> 6, c = i & 63; int cs = j >> 6, m = j & 63;
                float a = 2.0f * (float)((m * c) & 63) / 64.0f;
                p.fW1[i] = f2bf(cs ? SINPI(a) : COSPI(a));
            } else if (i < 8192 + 65536) {
                int q = i - 8192; int n = q >> 8, k = q & 255;
                int ri = (n >> 4) & 1, k1 = (n >> 5) * 16 + (n & 15); int cs = k >> 7, t1 = k & 127;
                float a = 2.0f * (float)((k1 * t1) & 127) / 128.0f;
                float cv = COSPI(a), sv = SINPI(a);
                float v = (ri == 0) ? (cs == 0 ? cv : -sv) : (cs == 0 ? -sv : -cv);
                p.fWA[q] = f2bf(v);
            } else {
                int q = i - 8192 - 65536; int k2 = q >> 7, k = q & 127; int ri = k >> 6, t2 = k & 63;
                float a = 2.0f * (float)((k2 * t2) & 63) / 64.0f;
                p.fWB[q] = f2bf(ri ? SINPI(a) : COSPI(a));
            }
        }
    }
}

HD void ph_init(const Params& p, int bid, int nb, float* sm) {
    const int NMOD = 2 * 3 * 6144;
    if (bid == 0) { THREADS(t, 32) { p.cnt[t] = 0; } }
#ifndef CPU_EMU
    {
        const int tq = tid_(); const int col = tq & 63, ks = tq >> 6;
        for (int u = nb - 1 - bid; u < 2 * 96; u += nb) {
            const int l = u / 96, c0 = (u % 96) * 64;
            __syncthreads();
            for (int i = tq; i < 3 * D; i += 256) { const int s_ = i / D, k = i % D; const float cv = (s_ < 2) ? p.in[I_C][s_ * D + k] : p.in[I_CCTX][k]; sm[i] = siluf_(cv); }
            __syncthreads();
            const float* wp = p.in[I_WMOD] + (size_t)l * D * 6144 + (size_t)(ks * 256) * 6144 + c0 + col;
            float a0 = 0.f, a1 = 0.f, a2 = 0.f;
#pragma unroll 8
            for (int k = 0; k < 256; ++k) { const float wv = wp[(size_t)k * 6144]; a0 += sm[ks * 256 + k] * wv; a1 += sm[D + ks * 256 + k] * wv; a2 += sm[2 * D + ks * 256 + k] * wv; }
            float* red = sm + 3 * D;
            red[(ks * 3 + 0) * 64 + col] = a0; red[(ks * 3 + 1) * 64 + col] = a1; red[(ks * 3 + 2) * 64 + col] = a2;
            __syncthreads();
            if (tq < 192) {
                const int s_ = tq >> 6, cc = tq & 63;
                const float v = red[(0 * 3 + s_) * 64 + cc] + red[(1 * 3 + s_) * 64 + cc] + red[(2 * 3 + s_) * 64 + cc] + red[(3 * 3 + s_) * 64 + cc];
                p.mods[(size_t)(l * 3 + s_) * 6144 + c0 + cc] = v + p.in[I_BMOD][l * 6144 + c0 + cc];
            }
            if (l == 0) dep_signal(p.dep);
        }
    }
    convert_static(p, bid, nb, sm, 0);
#else
    convert_static(p, bid, nb, sm, 0);
    for (int u = bid; u < (NMOD + 255) / 256; u += nb) {
        THREADS(t, 256) {
            int idx = u * 256 + t;
            if (idx < NMOD) {
                int l = idx / (3 * 6144), s = (idx / 6144) % 3, col = idx % 6144;
                const float* cv = (s < 2) ? p.in[I_C] + s * D : p.in[I_CCTX];
                const float* w = p.in[I_WMOD] + (size_t)l * D * 6144 + col;
                float acc = 0.f;
                for (int k = 0; k < D; ++k) acc += siluf_(cv[k]) * w[(size_t)k * 6144];
                p.mods[idx] = acc + p.in[I_BMOD][l * 6144 + col];
            }
        }
    }
#endif
    init_tables(p, bid, nb);
    for (int u = bid; u < (NCTX * D) / 256; u += nb) {
        THREADS(t, 256) { int i = u * 256 + t; p.cs[i] = p.in[I_CTX][i]; }
    }

}

#ifndef CPU_EMU
HD float wave_sum(float v) {
#pragma unroll
    for (int o = 32; o >= 1; o >>= 1) v += __shfl_xor(v, o);
    return v;
}
HD void ph_norm1(const Params& p, int l, int bid, int nb, float* sm) {
    const int t = tid_(), lane = t & 63, w = t >> 6;
    const float* g = p.in[I_N1G] + l * D;
    for (int r = bid * 4 + w; r < R; r += nb * 4) {
        const float* x = xrow_in(p, l, r);
        const float* m = modrow(p, l, r);
        f32x4_t xv[4]; float ss = 0.f;
#pragma unroll
        for (int j = 0; j < 4; ++j) { xv[j] = *(const f32x4_t*)(x + j * 256 + lane * 4); ss += xv[j][0] * xv[j][0] + xv[j][1] * xv[j][1] + xv[j][2] * xv[j][2] + xv[j][3] * xv[j][3]; }
        ss = wave_sum(ss);
        const float rs = 1.0f / sqrtf(ss / D + 1e-6f);
#pragma unroll
        for (int j = 0; j < 4; ++j) {
            const int k = j * 256 + lane * 4;
            const f32x4_t gv = *(const f32x4_t*)(g + k), sc = *(const f32x4_t*)(m + 1024 + k), sh = *(const f32x4_t*)(m + k);
            float o[4];
#pragma unroll
            for (int q = 0; q < 4; ++q) o[q] = xv[j][q] * rs * gv[q] * (1.0f + sc[q]) + sh[q];
            uint2 pk; pk.x = cvtpk(o[0], o[1]); pk.y = cvtpk(o[2], o[3]);
            *(uint2*)(p.h + (size_t)r * D + k) = pk;
            *(unsigned*)(h8_of(p) + (size_t)r * D + k) = pack_fp8x4(o[0] * 4.f, o[1] * 4.f, o[2] * 4.f, o[3] * 4.f);
        }
    }
}
#else
HD void ph_norm1(const Params& p, int l, int bid, int nb, float* sm) {
    const float* g = p.in[I_N1G] + l * D;
    for (int r = bid; r < R; r += nb) {
        const float* x = xrow_in(p, l, r);
        const float* m = modrow(p, l, r);
        THREADS(t, 256) { float s = 0.f; for (int k = t; k < D; k += 256) s += x[k] * x[k]; sm[t] = s; }
        SYNC
        THREADS(t, 1) { float s = 0.f; for (int i = 0; i < 256; ++i) s += sm[i]; sm[256] = s; }
        SYNC
        THREADS(t, 256) {
            float rs = 1.0f / sqrtf(sm[256] / D + 1e-6f);
            for (int k = t; k < D; k += 256) {
                float v = x[k] * rs * g[k];
                p.h[(size_t)r * D + k] = f2bf(v * (1.0f + m[1024 + k]) + m[k]);
            }
        }
        SYNC
    }
}
#endif

HD void ph_inproj(const Params& p, int l, int bid, int nb, char* smc) {
    const bf16* Wt = p.wt_in + (size_t)l * WIN_NP * D;
    constexpr int NT = PLD / 128, MT = R / 128;
    for (int mt = bid; mt < MT; mt += nb) {
        ACC_DECL(2, acc); acc_zero(acc);
        gemm_accum<2>(acc, [&](int i) { return p.h + (size_t)(mt * 128 + i) * D; }, [&](int j) { return Wt + (size_t)(WIN_N + j) * D; }, D, smc);
        ACC_FOR(2, row, col) {
            const int r = mt * 128 + row;
            if (col < 8) {
                const float xx = AV(acc) + p.in[I_DTB][l * 8 + col];
                const float sp = xx > 20.f ? xx : log1pf(expf(xx));
                p.gg[(size_t)col * R + r] = -expf(p.in[I_ALOG][l * 8 + col]) * sp;
            } else if (col < 16) p.gbeta[(size_t)(col - 8) * R + r] = sigmoidf_(AV(acc));
        } ACC_END
    }
    for (int tile = bid; tile < MT * NT; tile += nb) {
        const int mt = tile / NT, nt = tile % NT;
        ACC_DECL(4, acc); acc_zero(acc);
        gemm_accum<4>(acc, [&](int i) { return p.h + (size_t)(mt * 128 + i) * D; }, [&](int j) { return Wt + (size_t)(nt * 128 + j) * D; }, D, smc);
#ifndef CPU_EMU
        {
            float* tl = (float*)smc;
            acc_to_lds<4>(acc, tl);
            __syncthreads();
            const int t_ = tid_(); const int row = t_ >> 1, half = t_ & 1;
            const int cb = nt * 128 + half * 64;
            float v[64];
#pragma unroll
            for (int q = 0; q < 16; ++q) { const f32x4_t x4 = *(const f32x4_t*)(tl + row * 132 + half * 64 + q * 4); v[q * 4] = x4[0]; v[q * 4 + 1] = x4[1]; v[q * 4 + 2] = x4[2]; v[q * 4 + 3] = x4[3]; }
            if (cb < 512) {
                const float* gn = (cb < 256 ? p.in[I_NAQG] : p.in[I_NAKG]) + l * 64;
                float ss = 0.f;
#pragma unroll
                for (int c = 0; c < 64; ++c) ss += v[c] * v[c];
                const float rs = __builtin_amdgcn_rsqf(ss * (1.0f / 64.0f) + 1e-6f) * ((cb < 256) ? 0.125f * 1.4426950408889634f : 1.0f);
#pragma unroll
                for (int c = 0; c < 64; ++c) v[c] *= rs * gn[c];
            } else if (cb >= 768 && cb < 1280) {
                const float* gn = (cb < 1024 ? p.in[I_DAQG] : p.in[I_DAKG]) + l * 32;
                const float qs = (cb < 1024) ? 0.17677669529663687f * 1.4426950408889634f : 1.0f;
#pragma unroll
                for (int gp = 0; gp < 2; ++gp) {
                    float ss = 0.f;
#pragma unroll
                    for (int c = 0; c < 32; ++c) ss += v[gp * 32 + c] * v[gp * 32 + c];
                    const float rs = __builtin_amdgcn_rsqf(ss * (1.0f / 32.0f) + 1e-6f) * qs;
#pragma unroll
                    for (int c = 0; c < 32; ++c) v[gp * 32 + c] *= rs * gn[c];
                }
                const int gr_ = mt * 128 + row;
                if (gr_ < NLAT) {
                    const int tt = gr_ % SEQ;
#pragma unroll
                    for (int a = 0; a < 2; ++a) {
                        const float pos = (float)(a == 0 ? tt / GW : tt % GW);
                        float frev = 0.15915494309189535f;
#pragma unroll
                        for (int f = 0; f < 8; ++f) {
                            const float cs = __builtin_amdgcn_cosf(pos * frev), sn = __builtin_amdgcn_sinf(pos * frev);
#pragma unroll
                            for (int gp = 0; gp < 2; ++gp) {
                                const int i1 = gp * 32 + a * 16 + f, i2 = i1 + 8;
                                const float x1 = v[i1], x2 = v[i2];
                                v[i1] = x1 * cs - x2 * sn; v[i2] = x2 * cs + x1 * sn;
                            }
                            frev *= 0.31622776601683794f;
                        }
                    }
                }
            }
            bf16* dst = p.P + (size_t)(mt * 128 + row) * PLD + cb;
#pragma unroll
            for (int q = 0; q < 8; ++q) {
                uint4 pk; pk.x = cvtpk(v[q * 8], v[q * 8 + 1]); pk.y = cvtpk(v[q * 8 + 2], v[q * 8 + 3]); pk.z = cvtpk(v[q * 8 + 4], v[q * 8 + 5]); pk.w = cvtpk(v[q * 8 + 6], v[q * 8 + 7]);
                *(uint4*)(dst + q * 8) = pk;
            }
        }
#else
        ACC_FOR(4, row, col) { p.P[(size_t)(mt * 128 + row) * PLD + nt * 128 + col] = f2bf(AV(acc)); } ACC_END
#endif
    }
}

HD void ph_prep(const Params& p, int l, int bid, int nb) {
#ifdef CPU_EMU
    {
        const float* naq = p.in[I_NAQG] + l * 64; const float* nak = p.in[I_NAKG] + l * 64;
        const float* daq = p.in[I_DAQG] + l * 32; const float* dak = p.in[I_DAKG] + l * 32;
        const int N = R * 24;
        for (int u = bid; u < (N + 255) / 256; u += nb) {
            THREADS(t, 256) {
                int idx = u * 256 + t;
                if (idx < N) {
                    int r = idx / 24, gidx = idx % 24;
                    if (gidx < 8) {
                        int isk = gidx >> 2, hd = gidx & 3;
                        bf16* ptr = p.P + (size_t)r * PLD + (isk ? C_NAK : C_NAQ) + hd * 64;
                        const float* g = isk ? nak : naq;
                        float ss = 0.f;
                        for (int d = 0; d < 64; ++d) { float v = bf2f(ptr[d]); ss += v * v; }
                        float rs = 1.0f / sqrtf(ss / 64.0f + 1e-6f);
#ifndef CPU_EMU
                        if (!isk) rs *= 0.125f * 1.4426950408889634f;
#endif
                        for (int d = 0; d < 64; ++d) ptr[d] = f2bf(bf2f(ptr[d]) * rs * g[d]);
                    } else {
                        int gi = gidx - 8; int isk = gi >> 3; int hm = gi & 7;
                        bf16* ptr = p.P + (size_t)r * PLD + (isk ? C_DAK : C_DAQ) + hm * 32;
                        const float* g = isk ? dak : daq;
                        float ss = 0.f;
                        for (int d = 0; d < 32; ++d) { float v = bf2f(ptr[d]); ss += v * v; }
                        float rs = 1.0f / sqrtf(ss / 32.0f + 1e-6f);
#ifndef CPU_EMU
                        if (!isk) rs *= 0.17677669529663687f * 1.4426950408889634f;
#endif
                        if (r < NLAT) {
                            int tt = r % SEQ; float prow = (float)(tt / GW), pcol = (float)(tt % GW);
                            for (int a = 0; a < 2; ++a) {
                                float pos = a == 0 ? prow : pcol;
                                float fr = 1.0f;
                                for (int f = 0; f < 8; ++f) {
                                    float ang = pos * fr;
                                    float cs = cosf(ang), sn = sinf(ang);
                                    int i1 = a * 16 + f, i2 = a * 16 + 8 + f;
                                    float x1 = bf2f(ptr[i1]) * rs * g[i1], x2 = bf2f(ptr[i2]) * rs * g[i2];
                                    ptr[i1] = f2bf(x1 * cs - x2 * sn);
                                    ptr[i2] = f2bf(x2 * cs + x1 * sn);
                                    fr *= 0.31622776601683794f;
                                }
                            }
                        } else {
                            for (int d = 0; d < 32; ++d) ptr[d] = f2bf(bf2f(ptr[d]) * rs * g[d]);
                        }
                    }
                }
            }
        }
    }
#endif
#ifndef CPU_EMU
    {
        const float* cw = p.in[I_CONVW] + (size_t)l * 5 * 768;
        const int N = R * 96;
        for (int idx = bid * 256 + tid_(); idx < N; idx += nb * 256) {
            const int r = idx / 96, q = idx % 96; const int ph = q >> 3, cg = q & 7; const int part = ph >> 2, hd = ph & 3;
            const RowInfo ri = rowinfo(r);
            const int ch0 = part * 256 + hd * 64 + cg * 8;
            float y[8];
#pragma unroll
            for (int c = 0; c < 8; ++c) y[c] = 0.f;
#pragma unroll
            for (int i = 0; i < 5; ++i) {
                const int tt = ri.t + i - 2;
                if (tt >= 0 && tt < ri.T) {
                    const uint4 raw = *(const uint4*)(p.P + (size_t)(ri.base + tt) * PLD + C_GQ + ch0);
                    const f32x4_t w0 = *(const f32x4_t*)(cw + i * 768 + ch0), w1 = *(const f32x4_t*)(cw + i * 768 + ch0 + 4);
                    y[0] += __uint_as_float(raw.x << 16) * w0[0]; y[1] += __uint_as_float(raw.x & 0xffff0000u) * w0[1];
                    y[2] += __uint_as_float(raw.y << 16) * w0[2]; y[3] += __uint_as_float(raw.y & 0xffff0000u) * w0[3];
                    y[4] += __uint_as_float(raw.z << 16) * w1[0]; y[5] += __uint_as_float(raw.z & 0xffff0000u) * w1[1];
                    y[6] += __uint_as_float(raw.w << 16) * w1[2]; y[7] += __uint_as_float(raw.w & 0xffff0000u) * w1[3];
                }
            }
            float ss = 0.f;
#pragma unroll
            for (int c = 0; c < 8; ++c) { y[c] = siluf_(y[c]); ss += y[c] * y[c]; }
            ss += __shfl_xor(ss, 1); ss += __shfl_xor(ss, 2); ss += __shfl_xor(ss, 4);
            float scl = 1.0f;
            if (part == 0) scl = 0.125f / sqrtf(ss + 1e-6f); else if (part == 1) scl = 1.0f / sqrtf(ss + 1e-6f);
            uint4 pk; pk.x = cvtpk(y[0] * scl, y[1] * scl); pk.y = cvtpk(y[2] * scl, y[3] * scl); pk.z = cvtpk(y[4] * scl, y[5] * scl); pk.w = cvtpk(y[6] * scl, y[7] * scl);
            *(uint4*)(p.gq + (size_t)r * 768 + ch0) = pk;
        }
    }
#else
    {
        const float* cw = p.in[I_CONVW] + (size_t)l * 5 * 768;
        const int N = R * 12;
        for (int u = bid; u < (N + 255) / 256; u += nb) {
            THREADS(t, 256) {
                int idx = u * 256 + t;
                if (idx < N) {
                    int r = idx / 12, ph = idx % 12; int part = ph >> 2, hd = ph & 3;
                    RowInfo ri = rowinfo(r);
                    int ch0 = part * 256 + hd * 64;
                    float ss = 0.f;
                    for (int pass = 0; pass < 2; ++pass) {
                        float scl = 1.0f;
                        if (pass == 1) { if (part == 0) scl = 0.125f / sqrtf(ss + 1e-6f); else if (part == 1) scl = 1.0f / sqrtf(ss + 1e-6f); }
                        if (pass == 0 && part == 2) continue;
                        for (int c = 0; c < 64; ++c) {
                            float y = 0.f;
                            for (int i = 0; i < 5; ++i) {
                                int tt = ri.t + i - 2;
                                if (tt >= 0 && tt < ri.T) y += bf2f(p.P[(size_t)(ri.base + tt) * PLD + C_GQ + ch0 + c]) * cw[i * 768 + ch0 + c];
                            }
                            y = siluf_(y);
                            if (pass == 0) ss += y * y; else p.gq[(size_t)r * 768 + ch0 + c] = f2bf(y * scl);
                        }
                    }
                }
            }
        }
    }
#endif
    {
        const int RQ = (l == 0) ? R : NLAT;
        for (int r = (FOURIER_GEMM ? RQ : 0) + bid; r < RQ; r += nb) {
            THREADS(t, 256) {
                int g = t >> 6, m = t & 63;
                const bf16* f = p.P + (size_t)r * PLD + C_F + g * 64;
                float fc = 0.f, fs = 0.f;
                for (int c = 0; c < 64; ++c) {
                    int ti = ((m * c) & 63) * (SEQ / 64);
                    float v = bf2f(f[c]);
                    fc += v * p.cosT[ti]; fs += v * p.sinT[ti];
                }
                p.fcs[(size_t)r * 512 + t] = f2bf(fc);
                p.fcs[(size_t)r * 512 + 256 + t] = f2bf(fs);
                if (FOURIER_GEMM && r >= NLAT) {
                    const int rc = r - NLAT; const int bb = rc / CTXL, tt = rc % CTXL;
                    bf16* xc = p.fXC + (((size_t)bb * 256 + t) * 2) * CTXL + tt;
                    xc[0] = f2bf(fc); xc[CTXL] = f2bf(fs);
                }
            }
        }
    }
}

#ifndef CPU_EMU
HD void ph_na(const Params& p, int l, int bid, int nb, char* smc) {
    const int t = tid_(), lane = t & 63, w = t >> 6, fr = lane & 15, fg = lane >> 4;
    const float* rpb = p.in[I_RPB] + (size_t)l * 4 * 15 * 31;
    float* sbias = (float*)(smc + 32768);
    const lds_cptr lds = (lds_cptr)smc;
    constexpr int WH = ROWS < 8 ? ROWS : 8;
    const int nlat = NB * ROWS * 4;
    const int nctx = (l == 0) ? NB * 4 * (CTXL / 64) : 0;
    const int lkey = t >> 3, lc = t & 7;
    const int ksrc = (lc ^ (lkey & 7)) << 3;
    const int vsrc = ((((lc >> 1) ^ ((lkey >> 1) & 3)) << 1) | (lc & 1)) << 3;
    for (int unit = bid; unit < nlat + nctx; unit += nb) {
        int b, hd, qrow, ntl, rs = 0, gr = 0;
        if (unit < nlat) {
            hd = unit & 3; const int br_ = unit >> 2; gr = br_ % ROWS; b = br_ / ROWS;
            qrow = b * SEQ + gr * GW + w * 16 + fr; ntl = WH;
            rs = gr - WH / 2; if (rs < 0) rs = 0; if (rs > ROWS - WH) rs = ROWS - WH;
        } else {
            const int u2 = unit - nlat; const int qt = u2 % (CTXL / 64); const int bh = u2 / (CTXL / 64); hd = bh & 3; b = bh >> 2;
            qrow = NLAT + b * CTXL + qt * 64 + w * 16 + fr; ntl = 0;
        }
        const int ntiles = ntl + NCC;
        const int qcol = w * 16 + fr;
        int cs0 = w * 16 - 8; if (cs0 < 0) cs0 = 0; if (cs0 > GW - 32) cs0 = GW - 32;
        int wsq = qcol - 8; if (wsq < 0) wsq = 0; if (wsq > GW - 16) wsq = GW - 16;
        bf16x8_t qf[2];
#pragma unroll
        for (int s_ = 0; s_ < 2; ++s_) qf[s_] = *(const bf16x8_t*)(p.P + (size_t)qrow * PLD + C_NAQ + hd * 64 + s_ * 32 + fg * 8);
        f32x4_t O[4];
#pragma unroll
        for (int d = 0; d < 4; ++d) O[d] = f32x4_t{0.f, 0.f, 0.f, 0.f};
        float ls = 0.f;
        auto keyrow = [&](int tt, int i) { return (tt < ntl) ? (b * SEQ + (rs + tt) * GW + i) : (NLAT + b * CTXL + (tt - ntl) * 64 + i); };
        char* ldst = smc + w * 1024;
        __syncthreads();
        for (int i = t; i < 15 * 31; i += 256) sbias[i] = rpb[hd * 465 + i] * 1.4426950408889634f;
#pragma unroll
        for (int i = 0; i < 2; ++i) {
            const bf16* src = p.P + (size_t)keyrow(0, lkey + 32 * i) * PLD + hd * 64;
            GLDS16(src + C_NAK + ksrc, ldst + 4096 * i); GLDS16(src + C_NAV + vsrc, ldst + 16384 + 4096 * i);
        }
        WAIT_VM0();
        __syncthreads();
        const int vkl = 4 * fg + (fr >> 2);
        const int vsw = (vkl >> 1) & 3;
        unsigned va[4];
#pragma unroll
        for (int d = 0; d < 4; ++d) va[d] = 16384 + vkl * 128 + ((((d ^ vsw) << 1) | ((fr & 3) >> 1)) << 4) + (fr & 1) * 8;
#pragma unroll 1
        for (int tt = 0; tt < ntiles; ++tt) {
            const int cur = tt & 1;
            if (tt + 1 < ntiles) {
#pragma unroll
                for (int i = 0; i < 2; ++i) {
                    const bf16* src = p.P + (size_t)keyrow(tt + 1, lkey + 32 * i) * PLD + hd * 64;
                    GLDS16(src + C_NAK + ksrc, ldst + (cur ^ 1) * 8192 + 4096 * i); GLDS16(src + C_NAV + vsrc, ldst + 16384 + (cur ^ 1) * 8192 + 4096 * i);
                }
            }
            const char* cK = smc + cur * 8192;
            const lds_cptr cV = lds + cur * 8192;
            const bool local = tt < ntl;
            const int kbase = local ? cs0 : 0;
            const int nkf = local ? 2 : 4;
            unsigned pb[2][4];
#pragma unroll
            for (int f = 0; f < 4; ++f) {
                if (f < nkf) {
                    const int key = kbase + f * 16 + fr;
                    const char* kp = cK + key * 128;
                    const bf16x8_t a0 = *(const bf16x8_t*)(kp + (((fg) ^ (fr & 7)) << 4));
                    const bf16x8_t a1 = *(const bf16x8_t*)(kp + (((4 + fg) ^ (fr & 7)) << 4));
                    f32x4_t S = __builtin_amdgcn_mfma_f32_16x16x32_bf16(a0, qf[0], f32x4_t{0.f, 0.f, 0.f, 0.f}, 0, 0, 0);
                    S = __builtin_amdgcn_mfma_f32_16x16x32_bf16(a1, qf[1], S, 0, 0, 0);
                    float e[4];
#pragma unroll
                    for (int r = 0; r < 4; ++r) {
                        float sv = S[r]; bool ok = true;
                        if (local) {
                            const int kc = kbase + f * 16 + 4 * fg + r;
                            ok = (unsigned)(kc - wsq) < 16u;
                            sv += sbias[((rs + tt) - gr + 7) * 31 + (ok ? (kc - qcol + 15) : 15)];
                        }
                        e[r] = ok ? __builtin_amdgcn_exp2f(sv) : 0.f;
                    }
                    ls += (e[0] + e[1]) + (e[2] + e[3]);
                    pb[f >> 1][(f & 1) * 2] = cvtpk(e[0], e[1]);
                    pb[f >> 1][(f & 1) * 2 + 1] = cvtpk(e[2], e[3]);
                }
            }
#pragma unroll
            for (int ks = 0; ks < 2; ++ks) {
                if (ks * 2 < nkf) {
#pragma unroll
                    for (int d = 0; d < 4; ++d) {
                        const s16x4_t lo = lds_tr16(cV + va[d] + (kbase + ks * 32) * 128);
                        const s16x4_t hi = lds_tr16(cV + va[d] + (kbase + ks * 32 + 16) * 128);
                        const bf16x8_t vf = bf16x8_t{lo[0], lo[1], lo[2], lo[3], hi[0], hi[1], hi[2], hi[3]};
                        const i32x4_t bi = i32x4_t{(int)pb[ks][0], (int)pb[ks][1], (int)pb[ks][2], (int)pb[ks][3]};
                        O[d] = __builtin_amdgcn_mfma_f32_16x16x32_bf16(vf, __builtin_bit_cast(bf16x8_t, bi), O[d], 0, 0, 0);
                    }
                }
            }
            WAIT_VM0();
            __syncthreads();
        }
        ls += __shfl_xor(ls, 16); ls += __shfl_xor(ls, 32);
        const float inv = 1.0f / ls;
        bf16* op = p.br + (size_t)qrow * D + hd * 64;
#pragma unroll
        for (int d = 0; d < 4; ++d) {
            uint2 pk; pk.x = cvtpk(O[d][0] * inv, O[d][1] * inv); pk.y = cvtpk(O[d][2] * inv, O[d][3] * inv);
            *(uint2*)(op + d * 16 + 4 * fg) = pk;
        }
    }
}
#else
HD void ph_na(const Params& p, int l, int bid, int nb, char*) {
    const float* rpb = p.in[I_RPB] + (size_t)l * 4 * 15 * 31;
    const int RQ = (l == 0) ? R : NLAT;
    const int N = RQ * 4;
    const int wh = ROWS < 8 ? ROWS : 8;
    for (int u = bid; u < (N + 255) / 256; u += nb) {
        THREADS(t, 256) {
            int idx = u * 256 + t;
            if (idx < N) {
                int hd = idx / RQ, r = idx % RQ;
                RowInfo ri = rowinfo(r);
                float q[64], o[64];
                const bf16* qp = p.P + (size_t)r * PLD + C_NAQ + hd * 64;
#pragma unroll
                for (int d = 0; d < 64; ++d) { q[d] = bf2f(qp[d]) * 0.125f; o[d] = 0.f; }
                float mx = -1e30f, lsum = 0.f;
                int nloc = 0, rs = 0, ws = 0, gr = 0, gc = 0;
                if (ri.seg == 0) {
                    gr = ri.t / GW; gc = ri.t % GW;
                    rs = gr - wh / 2; if (rs < 0) rs = 0; if (rs > ROWS - wh) rs = ROWS - wh;
                    ws = gc - 8; if (ws < 0) ws = 0; if (ws > GW - 16) ws = GW - 16;
                    nloc = wh * 16;
                }
                int ctxbase = NLAT + ri.b * CTXL;
                for (int kk = 0; kk < nloc + CTXL; ++kk) {
                    int kr; float bias = 0.f;
                    if (kk < nloc) {
                        int a = kk >> 4, c = kk & 15;
                        int krow = rs + a, kcol = ws + c;
                        kr = ri.base + krow * GW + kcol;
                        bias = rpb[(hd * 15 + (krow - gr + 7)) * 31 + (kcol - gc + 15)];
                    } else kr = ctxbase + (kk - nloc);
                    const bf16* kp = p.P + (size_t)kr * PLD + C_NAK + hd * 64;
                    float s = 0.f;
#pragma unroll
                    for (int d = 0; d < 64; ++d) s += q[d] * bf2f(kp[d]);
                    s += bias;
                    if (s > mx) { float f = expf(mx - s); lsum *= f;
#pragma unroll
                        for (int d = 0; d < 64; ++d) o[d] *= f;
                        mx = s; }
                    float e = expf(s - mx);
                    lsum += e;
                    const bf16* vp = p.P + (size_t)kr * PLD + C_NAV + hd * 64;
#pragma unroll
                    for (int d = 0; d < 64; ++d) o[d] += e * bf2f(vp[d]);
                }
                float inv = 1.0f / lsum;
                bf16* op = p.br + (size_t)r * D + hd * 64;
#pragma unroll
                for (int d = 0; d < 64; ++d) op[d] = f2bf(o[d] * inv);
            }
        }
    }
}

#endif

#ifndef CPU_EMU
HD void ph_da(const Params& p, int l, int bid, int nb, char* smc) {
    const int t = tid_(), lane = t & 63, w = t >> 6, fr = lane & 15, fg = lane >> 4;
    const float lam_init = lam_init_of(l);
    float s1 = 0.f, s2 = 0.f;
    for (int d = 0; d < 32; ++d) {
        s1 += p.in[I_LQ1][l * 32 + d] * p.in[I_LK1][l * 32 + d];
        s2 += p.in[I_LQ2][l * 32 + d] * p.in[I_LK2][l * 32 + d];
    }
    const float lam = expf(s1) - expf(s2) + lam_init;
    const float* sg = p.in[I_SUBLN] + l * 64;
    constexpr int NQT = SEQ / 128, NQC = CTXL / 128;
    const int nlat = NB * 4 * NQT;
    const int nctx = (l == 0) ? NB * 4 * NQC : 0;
    const lds_cptr lds = (lds_cptr)smc;
    for (int unit = bid; unit < nlat + nctx; unit += nb) {
        int b, hd, qrow0, kt0;
        if (unit < nlat) { const int qt = unit % NQT, bh = unit / NQT; hd = bh & 3; b = bh >> 2; qrow0 = b * SEQ + qt * 128; kt0 = 0; }
        else { const int u2 = unit - nlat; const int qt = u2 % NQC, bh = u2 / NQC; hd = bh & 3; b = bh >> 2; qrow0 = NLAT + b * CTXL + qt * 128; kt0 = NCL; }
        const int kt1 = NCL + NCC;
        bf16x8_t qf[2][2];
#pragma unroll
        for (int m = 0; m < 2; ++m)
#pragma unroll
            for (int n = 0; n < 2; ++n)
                qf[m][n] = *(const bf16x8_t*)(p.P + (size_t)(qrow0 + w * 32 + n * 16 + fr) * PLD + C_DAQ + hd * 64 + m * 32 + fg * 8);
        f32x4_t O[2][4][2];
#pragma unroll
        for (int m = 0; m < 2; ++m)
#pragma unroll
            for (int d = 0; d < 4; ++d)
#pragma unroll
                for (int n = 0; n < 2; ++n) O[m][d][n] = f32x4_t{0.f, 0.f, 0.f, 0.f};
        f32x4_t L5[2][2];
#pragma unroll
        for (int m = 0; m < 2; ++m)
#pragma unroll
            for (int n = 0; n < 2; ++n) L5[m][n] = f32x4_t{0.f, 0.f, 0.f, 0.f};
        const short one_ = (fr == 0) ? (short)0x3f80 : (short)0;
        const bf16x8_t onesf = bf16x8_t{one_, one_, one_, one_, one_, one_, one_, one_};
        const int lkey = t >> 3, lc = t & 7;
        const int ksrc = (lc ^ (lkey & 7)) << 3;
        const int vsrc = ((((lc >> 1) ^ ((lkey >> 1) & 3)) << 1) | (lc & 1)) << 3;
        auto keyrow = [&](int kt, int i) { return (kt < NCL) ? (b * SEQ + kt * 64 + i) : (NLAT + b * CTXL + (kt - NCL) * 64 + i); };
        char* ldst = smc + w * 1024;
        __syncthreads();
#pragma unroll
        for (int i = 0; i < 2; ++i) {
            const bf16* src = p.P + (size_t)keyrow(kt0, lkey + 32 * i) * PLD + hd * 64;
            GLDS16(src + C_DAK + ksrc, ldst + 4096 * i); GLDS16(src + C_DAV + vsrc, ldst + 16384 + 4096 * i);
        }
        WAIT_VM0();
        __syncthreads();
        const unsigned ka0 = fr * 128 + (((fg) ^ (fr & 7)) << 4);
        const unsigned ka1 = fr * 128 + (((4 + fg) ^ (fr & 7)) << 4);
        const int vkey = 4 * fg + (fr >> 2);
        const int vsw = (vkey >> 1) & 3;
        unsigned va[4];
#pragma unroll
        for (int d = 0; d < 4; ++d) va[d] = 16384 + vkey * 128 + ((((d ^ vsw) << 1) | ((fr & 3) >> 1)) << 4) + (fr & 1) * 8;
#pragma unroll 1
        for (int kt = kt0; kt < kt1; ++kt) {
            const int cur = (kt - kt0) & 1;
            if (kt + 1 < kt1) {
#pragma unroll
                for (int i = 0; i < 2; ++i) {
                    const bf16* src = p.P + (size_t)keyrow(kt + 1, lkey + 32 * i) * PLD + hd * 64;
                    GLDS16(src + C_DAK + ksrc, ldst + (cur ^ 1) * 8192 + 4096 * i); GLDS16(src + C_DAV + vsrc, ldst + 16384 + (cur ^ 1) * 8192 + 4096 * i);
                }
            }
            const char* cK = smc + cur * 8192;
            const lds_cptr cV = lds + cur * 8192;
#pragma unroll
            for (int m = 0; m < 2; ++m) {
                unsigned pb[2][2][4];
                {
                    f32x4_t S[4][2];
#pragma unroll
                    for (int kf = 0; kf < 4; ++kf) {
                        const bf16x8_t a = *(const bf16x8_t*)(cK + (m ? ka1 : ka0) + kf * 2048);
#pragma unroll
                        for (int n = 0; n < 2; ++n) S[kf][n] = __builtin_amdgcn_mfma_f32_16x16x32_bf16(a, qf[m][n], f32x4_t{0.f, 0.f, 0.f, 0.f}, 0, 0, 0);
                    }
#pragma unroll
                    for (int kf = 0; kf < 4; ++kf)
#pragma unroll
                        for (int n = 0; n < 2; ++n) {
                            const float e0 = __builtin_amdgcn_exp2f(S[kf][n][0]), e1 = __builtin_amdgcn_exp2f(S[kf][n][1]);
                            const float e2 = __builtin_amdgcn_exp2f(S[kf][n][2]), e3 = __builtin_amdgcn_exp2f(S[kf][n][3]);
                            pb[n][kf >> 1][(kf & 1) * 2] = cvtpk(e0, e1);
                            pb[n][kf >> 1][(kf & 1) * 2 + 1] = cvtpk(e2, e3);
                        }
                }
#pragma unroll
                for (int ks = 0; ks < 2; ++ks)
#pragma unroll
                    for (int d = 0; d < 4; ++d) {
                        const s16x4_t lo = lds_tr16(cV + va[d] + ks * 4096);
                        const s16x4_t hi = lds_tr16(cV + va[d] + ks * 4096 + 2048);
                        const bf16x8_t vf = bf16x8_t{lo[0], lo[1], lo[2], lo[3], hi[0], hi[1], hi[2], hi[3]};
#pragma unroll
                        for (int n = 0; n < 2; ++n) {
                            const i32x4_t bi = i32x4_t{(int)pb[n][ks][0], (int)pb[n][ks][1], (int)pb[n][ks][2], (int)pb[n][ks][3]};
                            O[m][d][n] = __builtin_amdgcn_mfma_f32_16x16x32_bf16(vf, __builtin_bit_cast(bf16x8_t, bi), O[m][d][n], 0, 0, 0);
                            if (d == 0) L5[m][n] = __builtin_amdgcn_mfma_f32_16x16x32_bf16(onesf, __builtin_bit_cast(bf16x8_t, bi), L5[m][n], 0, 0, 0);
                        }
                    }
                asm volatile("" ::: "memory");
            }
            WAIT_VM0();
            __syncthreads();
        }
#pragma unroll
        for (int n = 0; n < 2; ++n) {
            const float l0 = __shfl(L5[0][n][0], fr), l1 = __shfl(L5[1][n][0], fr);
            const float i0 = 1.0f / l0, i1 = lam / l1;
            float ss = 0.f;
#pragma unroll
            for (int d = 0; d < 4; ++d)
#pragma unroll
                for (int r = 0; r < 4; ++r) { const float o = O[0][d][n][r] * i0 - O[1][d][n][r] * i1; O[0][d][n][r] = o; ss += o * o; }
            ss += __shfl_xor(ss, 16); ss += __shfl_xor(ss, 32);
            const float rs = (1.0f - lam_init) / sqrtf(ss / 64.0f + 1e-6f);
            bf16* op = p.br + (size_t)(qrow0 + w * 32 + n * 16 + fr) * D + 256 + hd * 64;
#pragma unroll
            for (int d = 0; d < 4; ++d) {
                const int dv = d * 16 + 4 * fg;
                const unsigned lo = cvtpk(O[0][d][n][0] * rs * sg[dv], O[0][d][n][1] * rs * sg[dv + 1]);
                const unsigned hi = cvtpk(O[0][d][n][2] * rs * sg[dv + 2], O[0][d][n][3] * rs * sg[dv + 3]);
                uint2 pk; pk.x = lo; pk.y = hi;
                *(uint2*)(op + dv) = pk;
            }
        }
    }
}
#else
HD void ph_da(const Params& p, int l, int bid, int nb, char*) {
    const int RQ = (l == 0) ? R : NLAT;
    const int N = RQ * 4;
    const float lam_init = lam_init_of(l);
    float s1 = 0.f, s2 = 0.f;
    for (int d = 0; d < 32; ++d) {
        s1 += p.in[I_LQ1][l * 32 + d] * p.in[I_LK1][l * 32 + d];
        s2 += p.in[I_LQ2][l * 32 + d] * p.in[I_LK2][l * 32 + d];
    }
    const float lam = expf(s1) - expf(s2) + lam_init;
    const float* sg = p.in[I_SUBLN] + l * 64;
    const float scale = 0.17677669529663687f;
    for (int u = bid; u < (N + 255) / 256; u += nb) {
        THREADS(t, 256) {
            int idx = u * 256 + t;
            if (idx < N) {
                int hd = idx / RQ, r = idx % RQ;
                RowInfo ri = rowinfo(r);
                float q0[32], q1[32], o0[64], o1[64];
                const bf16* qp = p.P + (size_t)r * PLD + C_DAQ + hd * 64;
#pragma unroll
                for (int d = 0; d < 32; ++d) { q0[d] = bf2f(qp[d]) * scale; q1[d] = bf2f(qp[32 + d]) * scale; }
#pragma unroll
                for (int d = 0; d < 64; ++d) { o0[d] = 0.f; o1[d] = 0.f; }
                float m0 = -1e30f, m1 = -1e30f, l0 = 0.f, l1 = 0.f;
                int nlat = (ri.seg == 0) ? SEQ : 0;
                int latbase = ri.b * SEQ, ctxbase = NLAT + ri.b * CTXL;
                for (int kk = 0; kk < nlat + CTXL; ++kk) {
                    int kr = (kk < nlat) ? latbase + kk : ctxbase + (kk - nlat);
                    const bf16* kp = p.P + (size_t)kr * PLD + C_DAK + hd * 64;
                    const bf16* vp = p.P + (size_t)kr * PLD + C_DAV + hd * 64;
                    float sa = 0.f, sb = 0.f;
#pragma unroll
                    for (int d = 0; d < 32; ++d) { sa += q0[d] * bf2f(kp[d]); sb += q1[d] * bf2f(kp[32 + d]); }
                    if (sa > m0) { float f = expf(m0 - sa); l0 *= f;
#pragma unroll
                        for (int d = 0; d < 64; ++d) o0[d] *= f;
                        m0 = sa; }
                    if (sb > m1) { float f = expf(m1 - sb); l1 *= f;
#pragma unroll
                        for (int d = 0; d < 64; ++d) o1[d] *= f;
                        m1 = sb; }
                    float ea = expf(sa - m0), eb = expf(sb - m1);
                    l0 += ea; l1 += eb;
#pragma unroll
                    for (int d = 0; d < 64; ++d) { float v = bf2f(vp[d]); o0[d] += ea * v; o1[d] += eb * v; }
                }
                float i0 = 1.0f / l0, i1 = lam / l1;
                float ss = 0.f;
#pragma unroll
                for (int d = 0; d < 64; ++d) { o0[d] = o0[d] * i0 - o1[d] * i1; ss += o0[d] * o0[d]; }
                float rs = (1.0f - lam_init) / sqrtf(ss / 64.0f + 1e-6f);
                bf16* op = p.br + (size_t)r * D + 256 + hd * 64;
#pragma unroll
                for (int d = 0; d < 64; ++d) op[d] = f2bf(o0[d] * rs * sg[d]);
            }
        }
    }
}

#endif

struct ChunkInfo { int dir, b, hd, n, seg, T, base, nloc; };
HD ChunkInfo chunkinfo(int unit) {
    ChunkInfo c;
    c.n = unit % NCH; int ch = unit / NCH; c.hd = ch & 3; c.b = (ch >> 2) % NB; c.dir = ch / (4 * NB);
    if (c.n < NCC) { c.seg = 1; c.T = CTXL; c.base = NLAT + c.b * CTXL; c.nloc = c.n; }
    else { c.seg = 0; c.T = SEQ; c.base = c.b * SEQ; c.nloc = c.n - NCC; }
    return c;
}
HD int chunk_row(const ChunkInfo& c, int i) { int pf = c.nloc * 64 + i; return c.base + (c.dir ? (c.T - 1 - pf) : pf); }

#ifndef CPU_EMU
HD void ph_gdn_chunk(const Params& p, int l, int bid, int nb, float* smf) {
    const int t = tid_(), lane = t & 63, w = t >> 6, fr = lane & 15, fg = lane >> 4;
    const int usel = w >> 1, wh = w & 1;
    char* smc = (char*)smf + usel * 33792;
    float* sA = (float*)(smc + 16384); float* sG = (float*)(smc + 32768); float* sB = (float*)(smc + 33024); float* sE = (float*)(smc + 33280);
    const int tu = t & 127, lkey = tu >> 3, lc = tu & 7;
    const int ksrc = (lc ^ (lkey & 7)) << 3;
    char* ldst = smc + wh * 1024;
    for (int pi = bid; pi < NUNIT / 2; pi += nb) {
        const int unit = 2 * pi + usel;
        const ChunkInfo c = chunkinfo(unit);
        const int dh = c.dir * 4 + c.hd;
        __syncthreads();
#pragma unroll
        for (int i = 0; i < 4; ++i) {
            const bf16* src = p.gq + (size_t)chunk_row(c, lkey + 16 * i) * 768 + c.hd * 64;
            GLDS16(src + 256 + ksrc, ldst + 2048 * i);
            GLDS16(src + 512 + ksrc, ldst + 8192 + 2048 * i);
        }
        if (wh == 0) {
            const int row = chunk_row(c, lane);
            float x = p.gg[(size_t)dh * R + row];
#pragma unroll
            for (int off = 1; off < 64; off <<= 1) { const float y = __shfl_up(x, off); if (lane >= off) x += y; }
            const float ex = __expf(x);
            sG[lane] = x; sB[lane] = p.gbeta[(size_t)dh * R + row]; sE[lane] = 1.0f; sE[64 + lane] = ex;
            const float x63 = __shfl(x, 63);
            float* cg = p.cG + (size_t)unit * 192;
            cg[lane] = ex; cg[64 + lane] = __expf(x63 - x); cg[128 + lane] = __expf(x63);
        }
        bf16x8_t aq[2][2];
#pragma unroll
        for (int mi = 0; mi < 2; ++mi)
#pragma unroll
            for (int s_ = 0; s_ < 2; ++s_)
                aq[mi][s_] = *(const bf16x8_t*)(p.gq + (size_t)chunk_row(c, 32 * wh + 16 * mi + fr) * 768 + c.hd * 64 + 32 * s_ + 8 * fg);
        WAIT_VM0();
        __syncthreads();
        {
            const char* kt_ = smc;
            const unsigned c0 = ((fg) ^ (fr & 7)) << 4, c1 = ((4 + fg) ^ (fr & 7)) << 4;
            bf16x8_t b0[4], b1[4];
#pragma unroll
            for (int n = 0; n < 4; ++n) { b0[n] = *(const bf16x8_t*)(kt_ + (16 * n + fr) * 128 + c0); b1[n] = *(const bf16x8_t*)(kt_ + (16 * n + fr) * 128 + c1); }
#pragma unroll
            for (int mi = 0; mi < 2; ++mi) {
                const int r0 = 32 * wh + 16 * mi;
                const bf16x8_t ak0 = *(const bf16x8_t*)(kt_ + (r0 + fr) * 128 + c0), ak1 = *(const bf16x8_t*)(kt_ + (r0 + fr) * 128 + c1);
                float gi[4], bi[4];
#pragma unroll
                for (int r = 0; r < 4; ++r) { gi[r] = sG[r0 + 4 * fg + r]; bi[r] = sB[r0 + 4 * fg + r]; }
#pragma unroll
                for (int n = 0; n < 4; ++n) {
                    f32x4_t kk = __builtin_amdgcn_mfma_f32_16x16x32_bf16(ak0, b0[n], f32x4_t{0.f, 0.f, 0.f, 0.f}, 0, 0, 0);
                    kk = __builtin_amdgcn_mfma_f32_16x16x32_bf16(ak1, b1[n], kk, 0, 0, 0);
                    f32x4_t qk = __builtin_amdgcn_mfma_f32_16x16x32_bf16(aq[mi][0], b0[n], f32x4_t{0.f, 0.f, 0.f, 0.f}, 0, 0, 0);
                    qk = __builtin_amdgcn_mfma_f32_16x16x32_bf16(aq[mi][1], b1[n], qk, 0, 0, 0);
                    const int j = 16 * n + fr; const float gj = sG[j];
#pragma unroll
                    for (int r = 0; r < 4; ++r) {
                        const int i = r0 + 4 * fg + r;
                        const float dec = (j <= i) ? __expf(gi[r] - gj) : 0.f;
                        sA[i * 64 + j] = (j < i) ? kk[r] * bi[r] * dec : 0.f;
                        p.cQK[(size_t)unit * 4096 + i * 64 + j] = f2bf(qk[r] * dec);
                    }
                }
            }
        }
        __syncthreads();
        {
            float x[64];
            bf16* dst = (wh == 0 ? p.cU : p.cW) + (size_t)unit * 4096 + lane;
            const char* rt_ = smc + (wh == 0 ? 8192 : 0) + (lane & 7) * 2;
            const float* rs_ = sE + wh * 64;
            const int lch = lane >> 3;
#pragma unroll
            for (int i = 0; i < 64; ++i) {
                const float rhs = sB[i] * rs_[i] * bf2f(*(const bf16*)(rt_ + i * 128 + ((lch ^ (i & 7)) << 4)));
                float acc = rhs;
#pragma unroll
                for (int j4 = 0; j4 < i; j4 += 4) {
                    const f32x4_t a4 = *(const f32x4_t*)(sA + i * 64 + j4);
                    acc -= a4[0] * x[j4];
                    if (j4 + 1 < i) acc -= a4[1] * x[j4 + 1];
                    if (j4 + 2 < i) acc -= a4[2] * x[j4 + 2];
                    if (j4 + 3 < i) acc -= a4[3] * x[j4 + 3];
                }
                x[i] = acc;
                dst[i * 64] = f2bf(acc);
            }
        }
    }
}
#else
HD void ph_gdn_chunk(const Params& p, int l, int bid, int nb, float* sm) {
    float* sk = sm;
    float* sq = sm + 4096;
    float* sA = sm + 8192;
    float* sXu = sm + 12288;
    float* sXw = sm + 4096;
    float* sG = sm + 16384;
    float* sB = sm + 16448;
    for (int unit = bid; unit < NUNIT; unit += nb) {
        ChunkInfo c = chunkinfo(unit);
        int dh = c.dir * 4 + c.hd;
        THREADS(t, 4096) {
            int i = t >> 6, d = t & 63; int row = chunk_row(c, i);
            sq[t] = bf2f(p.gq[(size_t)row * 768 + c.hd * 64 + d]);
            sk[t] = bf2f(p.gq[(size_t)row * 768 + 256 + c.hd * 64 + d]);
        }
        THREADS(t, 1) {
            float acc = 0.f;
            for (int i = 0; i < 64; ++i) { int row = chunk_row(c, i); acc += p.gg[(size_t)dh * R + row]; sG[i] = acc; sB[i] = p.gbeta[(size_t)dh * R + row]; }
        }
        SYNC
        THREADS(t, 4096) {
            int i = t >> 6, j = t & 63;
            float kk = 0.f, qk = 0.f;
            for (int d = 0; d < 64; ++d) { kk += sk[i * 64 + d] * sk[j * 64 + d]; qk += sq[i * 64 + d] * sk[j * 64 + d]; }
            float dec = (j <= i) ? expf(sG[i] - sG[j]) : 0.f;
            sA[t] = (j < i) ? kk * sB[i] * dec : 0.f;
            p.cQK[(size_t)unit * 4096 + t] = f2bf(qk * dec);
        }
        SYNC
        THREADS(t, 4096) {
            int i = t >> 6, cc = t & 63; int row = chunk_row(c, i);
            sXu[t] = sB[i] * bf2f(p.gq[(size_t)row * 768 + 512 + c.hd * 64 + cc]);
            sXw[t] = sB[i] * expf(sG[i]) * sk[t];
        }
        SYNC
        for (int i = 1; i < 64; ++i) {
            THREADS(cc, 128) {
                float* X = (cc < 64) ? (sXu + cc) : (sXw + cc - 64);
                float acc = X[i * 64];
                for (int j = 0; j < i; ++j) acc -= sA[i * 64 + j] * X[j * 64];
                X[i * 64] = acc;
            }
            SYNC
        }
        THREADS(t, 4096) {
            p.cU[(size_t)unit * 4096 + t] = f2bf(sXu[t]);
            p.cW[(size_t)unit * 4096 + t] = f2bf(sXw[t]);
        }
        THREADS(t, 64) { p.cG[(size_t)unit * 64 + t] = sG[t]; }
        SYNC
    }
}

#endif

HD void ph_fourier2(const Params& p, int l, int bid, int nb) {
    const int RQ = (l == 0) ? R : NLAT;
    for (int r = (FOURIER_GEMM ? NLAT : 0) + bid; r < RQ; r += nb) {
        RowInfo ri = rowinfo(r);
        const float nrm = 1.0f / sqrtf((float)ri.T * 64.0f);
        const int mul = SEQ / ri.T;
        THREADS(ch, 256) {
            float acc = 0.f;
            for (int tt = 0; tt < ri.T; ++tt) {
                int ti = ((ri.t * tt) & (ri.T - 1)) * mul;
                const bf16* f = p.fcs + (size_t)(ri.base + tt) * 512;
                acc += p.cosT[ti] * bf2f(f[ch]) - p.sinT[ti] * bf2f(f[256 + ch]);
            }
            p.br[(size_t)r * D + 768 + ch] = f2bf(acc * nrm);
        }
    }
}


HD void ph_fourier_s1c(const Params& p, int bid, int nb, char* smc) {
    constexpr int MTc = CTXL / 128;
    for (int tile = bid; tile < NB * MTc * 4; tile += nb) {
        const int g = tile & 3, mtc = (tile >> 2) % MTc, b = tile / (4 * MTc);
        ACC_DECL(4, acc); acc_zero(acc);
        gemm_accum<4>(acc, [&](int i) { return p.P + (size_t)(NLAT + b * CTXL + mtc * 128 + i) * PLD + C_F + g * 64; },
                      [&](int j) { return p.fW1 + j * 64; }, 64, smc);
        ACC_FOR(4, row, col) {
            const int cs = col >> 6, m = col & 63;
            p.fXC[(((size_t)b * 256 + g * 64 + m) * 2 + cs) * CTXL + mtc * 128 + row] = f2bf(AV(acc));
        } ACC_END
    }
}
HD void ph_fourier_s1(const Params& p, int bid, int nb, char* smc) {
    for (int tile = bid; tile < NB * 64 * 4; tile += nb) {
        const int g = tile & 3, t2 = (tile >> 2) & 63, b = tile >> 8;
        ACC_DECL(4, acc); acc_zero(acc);
        gemm_accum<4>(acc, [&](int i) { return p.P + (size_t)(b * SEQ + 64 * i + t2) * PLD + C_F + g * 64; },
                      [&](int j) { return p.fW1 + j * 64; }, 64, smc);
#ifndef CPU_EMU
        {
            float* tl = (float*)smc;
            acc_to_lds<4>(acc, tl);
            __syncthreads();
            const int t_ = tid_(); const int col = t_ >> 1, half = t_ & 1;
            const int cs = col >> 6, m = col & 63;
            bf16* dst = p.fcs + ((((size_t)b * 256 + g * 64 + m) * 64 + t2) * 2 + cs) * 128 + half * 64;
#pragma unroll
            for (int q = 0; q < 8; ++q) {
                float v[8];
#pragma unroll
                for (int e = 0; e < 8; ++e) v[e] = tl[(half * 64 + q * 8 + e) * 132 + col];
                uint4 pk; pk.x = cvtpk(v[0], v[1]); pk.y = cvtpk(v[2], v[3]); pk.z = cvtpk(v[4], v[5]); pk.w = cvtpk(v[6], v[7]);
                *(uint4*)(dst + q * 8) = pk;
            }
        }
#else
        ACC_FOR(4, row, col) {
            const int cs = col >> 6, m = col & 63;
            p.fcs[((((size_t)b * 256 + g * 64 + m) * 64 + t2) * 2 + cs) * 128 + row] = f2bf(AV(acc));
        } ACC_END
#endif
    }
}
HD void ph_fourier_sA(const Params& p, int bid, int nb, char* smc) {
    for (int tile = bid; tile < NB * 128 * 2; tile += nb) {
        const int nt = tile & 1, mt = (tile >> 1) & 127, b = tile >> 8;
        ACC_DECL(4, acc); acc_zero(acc);
        gemm_accum<4>(acc, [&](int i) { return p.fcs + ((size_t)b * 16384 + mt * 128 + i) * 256; },
                      [&](int j) { return p.fWA + (size_t)(nt * 128 + j) * 256; }, 256, smc);
#ifndef CPU_EMU
        {
            float* tl = (float*)smc;
            acc_to_lds<4>(acc, tl);
            __syncthreads();
            const int t_ = tid_(); const int pcol = t_ >> 2, chl = (t_ >> 1) & 1, th = t_ & 1;
            const int k1 = nt * 64 + pcol; const int ch = mt * 2 + chl;
            const int cre = (pcol >> 4) * 32 + (pcol & 15), cim = cre + 16;
            bf16* o = p.fa2 + ((((size_t)b * 128 + k1) * 256 + ch) * 2) * 64 + th * 32;
#pragma unroll
            for (int q = 0; q < 4; ++q) {
                float vr[8], vi[8];
#pragma unroll
                for (int e = 0; e < 8; ++e) {
                    const int t2 = th * 32 + q * 8 + e;
                    const float re = tl[(chl * 64 + t2) * 132 + cre], im = tl[(chl * 64 + t2) * 132 + cim];
                    const float c = p.cosT[k1 * t2], sn = p.sinT[k1 * t2];
                    vr[e] = re * c + im * sn; vi[e] = im * c - re * sn;
                }
                uint4 pr, pi;
                pr.x = cvtpk(vr[0], vr[1]); pr.y = cvtpk(vr[2], vr[3]); pr.z = cvtpk(vr[4], vr[5]); pr.w = cvtpk(vr[6], vr[7]);
                pi.x = cvtpk(vi[0], vi[1]); pi.y = cvtpk(vi[2], vi[3]); pi.z = cvtpk(vi[4], vi[5]); pi.w = cvtpk(vi[6], vi[7]);
                *(uint4*)(o + q * 8) = pr; *(uint4*)(o + 64 + q * 8) = pi;
            }
        }
#else
        ACC_FOR_PAIR(row, pcol) {
            const int k1 = nt * 64 + pcol; const int rr = mt * 128 + row; const int ch = rr >> 6, t2 = rr & 63;
            const float re = AV_G(acc), im = AV_U(acc);
            const float c = p.cosT[k1 * t2], sn = p.sinT[k1 * t2];
            bf16* o = p.fa2 + ((((size_t)b * 128 + k1) * 256 + ch) * 2) * 64 + t2;
            o[0] = f2bf(re * c + im * sn); o[64] = f2bf(im * c - re * sn);
        } ACC_END
#endif
    }
}
HD void ph_fourier_sB(const Params& p, int bid, int nb, char* smc) {
    const float nrm = 1.0f / sqrtf((float)SEQ * 64.0f);
    for (int tile = bid; tile < NB * 128 * 2; tile += nb) {
        const int cht = tile & 1, k1 = (tile >> 1) & 127, b = tile >> 8;
        ACC_DECL(2, acc); acc_zero(acc);
        gemm_accum<2>(acc, [&](int i) { return p.fa2 + (((size_t)b * 128 + k1) * 256 + cht * 128 + i) * 128; },
                      [&](int j) { return p.fWB + j * 128; }, 128, smc);
        ACC_FOR(2, row, col) {
            p.br[(size_t)(b * SEQ + k1 + 128 * col) * D + 768 + cht * 128 + row] = f2bf(AV(acc) * nrm);
        } ACC_END
    }
}


HD void ph_fourier_ctx(const Params& p, int bid, int nb, char* smc) {
    static_assert(CTXL % 128 == 0 || !FOURIER_GEMM, "context DFT GEMM needs CTXL % 128 == 0");
    const float nrm = 1.0f / sqrtf((float)CTXL * 64.0f);
    constexpr int MTc = CTXL / 128;
    for (int tile = bid; tile < NB * MTc * 2; tile += nb) {
        const int nt = tile & 1, mt = (tile >> 1) % MTc, b = tile / (2 * MTc);
        ACC_DECL(4, acc); acc_zero(acc);
        gemm_accum<4>(acc, [&](int i) { return p.fWC + (size_t)(mt * 128 + i) * (2 * CTXL); },
                      [&](int j) { return p.fXC + ((size_t)b * 256 + nt * 128 + j) * (2 * CTXL); }, 2 * CTXL, smc);
        ACC_FOR(4, row, col) { p.br[(size_t)(NLAT + b * CTXL + mt * 128 + row) * D + 768 + nt * 128 + col] = f2bf(AV(acc) * nrm); } ACC_END
    }
}
#ifndef CPU_EMU
struct ScanRegs { i32x4_t W[2], k[2]; unsigned u[4]; float g; };
HD bf16* scan_sp(const Params& p) { return p.h; }
HD bf16* scan_vn(const Params& p) { return p.h + (size_t)NUNIT * 4096; }
HD void ph_gdn_scan(const Params& p, int l, int bid, int nb, float* smf) {
    static_assert(NCH % 3 == 0, "scan ring assumes the chunk count is a multiple of 3");
    char* smc = (char*)smf;
    const int t = tid_(), lane = t & 63, w = t >> 6, fr = lane & 15, fg = lane >> 4;
    char* sST = smc + 24576; char* sVT = smc + 26624; char* sVS = smc + 28672; float* sG = (float*)(smc + 30720);
    const lds_cptr lds = (lds_cptr)smc;
    const int lkey = t >> 3, lc = t & 7;
    for (int cu = bid; cu < 2 * NB * 4 * 4; cu += nb) {
        const int chain = cu >> 2, cb = cu & 3;
        const ChunkInfo c0 = chunkinfo(chain * NCH);
        const int hd = c0.hd;
        auto issue = [&](ScanRegs& Rg, int n) {
            const int unit = chain * NCH + n;
            const ChunkInfo c = chunkinfo(unit);
            const bf16* wsrc = p.cW + (size_t)unit * 4096 + (16 * w + fr) * 64 + 8 * fg;
#pragma unroll
            for (int s_ = 0; s_ < 2; ++s_) {
                Rg.W[s_] = *(const i32x4_t*)(wsrc + 32 * s_);
                Rg.k[s_] = *(const i32x4_t*)(p.gq + (size_t)chunk_row(c, lkey + 32 * s_) * 768 + 256 + hd * 64 + lc * 8);
            }
#pragma unroll
            for (int r = 0; r < 4; ++r) Rg.u[r] = p.cU[(size_t)unit * 4096 + (16 * w + 4 * fg + r) * 64 + cb * 16 + fr];
            Rg.g = p.cG[(size_t)unit * 192 + (t < 192 ? t : 191)];
        };
        auto put_k = [&](const ScanRegs& Rg, int buf) {
#pragma unroll
            for (int s_ = 0; s_ < 2; ++s_) {
                const int ci = lkey + 32 * s_;
                const int fsw = ((ci >> 1) & 1) | (((ci >> 3) & 1) << 1);
                *(i32x4_t*)(smc + buf * 8192 + ci * 128 + (((((lc >> 1) ^ fsw) << 1) | (lc & 1)) << 4)) = Rg.k[s_];
            }
            if (t < 192) sG[buf * 192 + t] = Rg.g;
        };
        const int xe = (t >> 3) & 15, xc = (t & 7) ^ (xe & 7);
        const unsigned xsrc = xe * 128 + ((t & 7) << 4);
        const size_t xdst = (size_t)(cb * 16 + xe) * 64 + xc * 8;
        const unsigned c0o = ((fg) ^ (fr & 7)) << 4, c1o = ((4 + fg) ^ (fr & 7)) << 4;
        const unsigned bo0 = fr * 128 + c0o, bo1 = fr * 128 + c1o;
        const unsigned wofs = fr * 128 + ((((2 * w + (fg >> 1)) ^ (fr & 7))) << 4) + (fg & 1) * 8;
        unsigned ka[2][2];
#pragma unroll
        for (int s_ = 0; s_ < 2; ++s_)
#pragma unroll
            for (int h2 = 0; h2 < 2; ++h2) {
                const int cr = 32 * s_ + 8 * fg + (fr >> 2) + 4 * h2;
                const int fsw = ((cr >> 1) & 1) | (((cr >> 3) & 1) << 1);
                ka[s_][h2] = cr * 128 + (((((w ^ fsw) << 1) | ((fr & 3) >> 1))) << 4) + (fr & 1) * 8;
            }
        f32x4_t S = f32x4_t{0.f, 0.f, 0.f, 0.f};
        ScanRegs R0, R1, R2;
        __syncthreads();
        issue(R0, 0); issue(R1, 1);
        ((unsigned*)sST)[t] = 0u; ((unsigned*)sST)[t + 256] = 0u;
        put_k(R0, 0);
        __syncthreads();
#define SCAN_STEP(Rc, Rn, Rnn, nn, b)                                                                                                        \
        {                                                                                                                                    \
            const int n_ = (nn);                                                                                                             \
            issue(Rnn, (n_ + 2 < NCH) ? n_ + 2 : NCH - 1);                  \
            const float* g = sG + (b) * 192;                                                                                                 \
            const f32x4_t eD = *(const f32x4_t*)(g + 64 + 16 * w + 4 * fg);                                                                  \
            const float e63 = g[128];                                                                                                        \
            const bf16x8_t st0 = *(const bf16x8_t*)(sST + bo0), st1 = *(const bf16x8_t*)(sST + bo1);                                         \
            if (t < 128) *(uint4*)(scan_sp(p) + (size_t)(chain * NCH + n_) * 4096 + xdst) = *(const uint4*)(sST + xsrc);                     \
            f32x4_t v = __builtin_amdgcn_mfma_f32_16x16x32_bf16(__builtin_bit_cast(bf16x8_t, Rc.W[0]), st0, f32x4_t{0.f, 0.f, 0.f, 0.f}, 0, 0, 0); \
            v = __builtin_amdgcn_mfma_f32_16x16x32_bf16(__builtin_bit_cast(bf16x8_t, Rc.W[1]), st1, v, 0, 0, 0);                              \
            float vn[4];                                                                                                                     \
            _Pragma("unroll") for (int r = 0; r < 4; ++r) vn[r] = __uint_as_float(Rc.u[r] << 16) - v[r];                                     \
            { uint2 pk; pk.x = cvtpk(vn[0], vn[1]); pk.y = cvtpk(vn[2], vn[3]); *(uint2*)(sVT + wofs) = pk; }                                \
            { uint2 pk; pk.x = cvtpk(vn[0] * eD[0], vn[1] * eD[1]); pk.y = cvtpk(vn[2] * eD[2], vn[3] * eD[3]); *(uint2*)(sVS + wofs) = pk; }  \
            put_k(Rn, ((b) + 1) % 3);                                                                                                        \
            __syncthreads();                                                                                                                 \
            if (t >= 128) *(uint4*)(scan_vn(p) + (size_t)(chain * NCH + n_) * 4096 + xdst) = *(const uint4*)(sVT + xsrc);                    \
            const bf16x8_t vs0 = *(const bf16x8_t*)(sVS + bo0), vs1 = *(const bf16x8_t*)(sVS + bo1);                                         \
            const lds_cptr kb = lds + (b) * 8192;                                                                                            \
            const s16x4_t a00 = lds_tr16(kb + ka[0][0]), a01 = lds_tr16(kb + ka[0][1]);                                                      \
            const s16x4_t a10 = lds_tr16(kb + ka[1][0]), a11 = lds_tr16(kb + ka[1][1]);                                                      \
            f32x4_t dS = __builtin_amdgcn_mfma_f32_16x16x32_bf16(bf16x8_t{a00[0], a00[1], a00[2], a00[3], a01[0], a01[1], a01[2], a01[3]}, vs0, f32x4_t{0.f, 0.f, 0.f, 0.f}, 0, 0, 0); \
            dS = __builtin_amdgcn_mfma_f32_16x16x32_bf16(bf16x8_t{a10[0], a10[1], a10[2], a10[3], a11[0], a11[1], a11[2], a11[3]}, vs1, dS, 0, 0, 0); \
            _Pragma("unroll") for (int r = 0; r < 4; ++r) S[r] = S[r] * e63 + dS[r];                                                         \
            { uint2 pk; pk.x = cvtpk(S[0], S[1]); pk.y = cvtpk(S[2], S[3]); *(uint2*)(sST + wofs) = pk; }                                    \
            __syncthreads();                                                                                                                 \
        }
#pragma unroll 1
        for (int n = 0; n < NCH; n += 3) {
            SCAN_STEP(R0, R1, R2, n, 0)
            SCAN_STEP(R1, R2, R0, n + 1, 1)
            SCAN_STEP(R2, R0, R1, n + 2, 2)
        }
#undef SCAN_STEP
    }
}
HD void ph_gdn_outfin(const Params& p, int l, int bid, int nb, float* smf) {
    const int t = tid_(), lane = t & 63, w = t >> 6, fr = lane & 15, fg = lane >> 4;
    const float* og = p.in[I_ONORM] + l * 64;
    const int nlat = NB * 4 * NCL, nctx = (l == 0) ? NB * 4 * NCC : 0;
    float* so = smf;
    for (int u = bid; u < nlat + nctx; u += nb) {
        int b, hd, seg, nloc, ncs, T, base;
        if (u < nlat) { nloc = u % NCL; const int bh = u / NCL; hd = bh & 3; b = bh >> 2; seg = 0; ncs = NCL; T = SEQ; base = b * SEQ; }
        else { const int u2 = u - nlat; nloc = u2 % NCC; const int bh = u2 / NCC; hd = bh & 3; b = bh >> 2; seg = 1; ncs = NCC; T = CTXL; base = NLAT + b * CTXL; }
        __syncthreads();
#pragma unroll
        for (int dir = 0; dir < 2; ++dir) {
            const int nl = dir ? (ncs - 1 - nloc) : nloc;
            const int unit = ((dir * NB + b) * 4 + hd) * NCH + (seg ? nl : NCC + nl);
            const int ci = 16 * w + fr;
            const int pf = nl * 64 + ci; const int arow_ = base + (dir ? (T - 1 - pf) : pf);
            bf16x8_t qa[2], ka_[2];
#pragma unroll
            for (int s_ = 0; s_ < 2; ++s_) {
                qa[s_] = *(const bf16x8_t*)(p.gq + (size_t)arow_ * 768 + hd * 64 + 32 * s_ + 8 * fg);
                ka_[s_] = *(const bf16x8_t*)(p.cQK + (size_t)unit * 4096 + ci * 64 + 32 * s_ + 8 * fg);
            }
            const f32x4_t eG = *(const f32x4_t*)(p.cG + (size_t)unit * 192 + 16 * w + 4 * fg);
#pragma unroll
            for (int j = 0; j < 4; ++j) {
                const bf16* spr = scan_sp(p) + (size_t)unit * 4096 + (16 * j + fr) * 64 + 8 * fg;
                const bf16* vnr = scan_vn(p) + (size_t)unit * 4096 + (16 * j + fr) * 64 + 8 * fg;
                f32x4_t o1 = __builtin_amdgcn_mfma_f32_16x16x32_bf16(qa[0], *(const bf16x8_t*)(spr), f32x4_t{0.f, 0.f, 0.f, 0.f}, 0, 0, 0);
                o1 = __builtin_amdgcn_mfma_f32_16x16x32_bf16(qa[1], *(const bf16x8_t*)(spr + 32), o1, 0, 0, 0);
                f32x4_t o2 = __builtin_amdgcn_mfma_f32_16x16x32_bf16(ka_[0], *(const bf16x8_t*)(vnr), f32x4_t{0.f, 0.f, 0.f, 0.f}, 0, 0, 0);
                o2 = __builtin_amdgcn_mfma_f32_16x16x32_bf16(ka_[1], *(const bf16x8_t*)(vnr + 32), o2, 0, 0, 0);
#pragma unroll
                for (int r = 0; r < 4; ++r) {
                    const int cpos = 16 * w + 4 * fg + r;
                    const int tok = dir ? (63 - cpos) : cpos;
                    float* dst = so + tok * 65 + 16 * j + fr;
                    const float val = eG[r] * o1[r] + o2[r];
                    if (dir == 0) *dst = val; else *dst += val;
                }
            }
            __syncthreads();
        }
        {
            const int tok = t >> 2, q4 = t & 3;
            const int row = base + nloc * 64 + tok;
            float v[16]; float ss = 0.f;
#pragma unroll
            for (int c = 0; c < 16; ++c) { v[c] = so[tok * 65 + q4 * 16 + c]; ss += v[c] * v[c]; }
            ss += __shfl_xor(ss, 1); ss += __shfl_xor(ss, 2);
            const float rs = 1.0f / sqrtf(ss / 64.0f + 1e-6f);
            const uint4 z0 = *(const uint4*)(p.P + (size_t)row * PLD + C_Z + hd * 64 + q4 * 16), z1 = *(const uint4*)(p.P + (size_t)row * PLD + C_Z + hd * 64 + q4 * 16 + 8);
            const unsigned zz[8] = {z0.x, z0.y, z0.z, z0.w, z1.x, z1.y, z1.z, z1.w};
            unsigned pk[8];
#pragma unroll
            for (int c2 = 0; c2 < 8; ++c2) {
                const float za = __uint_as_float(zz[c2] << 16), zb = __uint_as_float(zz[c2] & 0xffff0000u);
                const float oa = v[2 * c2] * rs * og[q4 * 16 + 2 * c2] * siluf_(za), ob = v[2 * c2 + 1] * rs * og[q4 * 16 + 2 * c2 + 1] * siluf_(zb);
                pk[c2] = cvtpk(oa, ob);
            }
            uint4 p0, p1; p0.x = pk[0]; p0.y = pk[1]; p0.z = pk[2]; p0.w = pk[3]; p1.x = pk[4]; p1.y = pk[5]; p1.z = pk[6]; p1.w = pk[7];
            bf16* dstb = p.br + (size_t)row * D + 512 + hd * 64 + q4 * 16;
            *(uint4*)dstb = p0; *(uint4*)(dstb + 8) = p1;
        }
    }
}
#else
HD void ph_gdn_scan(const Params& p, int l, int bid, int nb, float* sm) {
    float* sQ = sm;
    float* sK = sm + 4096;
    bf16* sW = (bf16*)(sm + 8192);
    bf16* sQK = (bf16*)(sm + 10240);
    float* sS = sm + 12288;
    float* sV = sm + 13312;
    float* sU = sm + 14336;
    float* sG = sm + 15360;
    const int RQ = (l == 0) ? R : NLAT;
    for (int cu = bid; cu < 2 * NB * 4 * 4; cu += nb) {
        int chain = cu >> 2, cb = cu & 3;
        THREADS(t, 1024) { sS[t] = 0.f; }
        SYNC
        for (int n = 0; n < NCH; ++n) {
            int unit = chain * NCH + n;
            ChunkInfo c = chunkinfo(unit);
            THREADS(t, 64) { sG[t] = p.cG[(size_t)unit * 64 + t]; }
            SYNC
            THREADS(t, 4096) {
                int i = t >> 6, d = t & 63; int row = chunk_row(c, i);
                sW[t] = p.cW[(size_t)unit * 4096 + t];
                sQK[t] = p.cQK[(size_t)unit * 4096 + t];
                sQ[t] = bf2f(p.gq[(size_t)row * 768 + c.hd * 64 + d]) * expf(sG[i]);
                sK[t] = bf2f(p.gq[(size_t)row * 768 + 256 + c.hd * 64 + d]) * expf(sG[63] - sG[i]);
            }
            THREADS(t, 1024) { int i = t >> 4, e = t & 15; sU[t] = bf2f(p.cU[(size_t)unit * 4096 + i * 64 + cb * 16 + e]); }
            SYNC
            THREADS(t, 1024) {
                int i = t >> 4, e = t & 15;
                float acc = sU[t];
                for (int d = 0; d < 64; ++d) acc -= bf2f(sW[i * 64 + d]) * sS[d * 16 + e];
                sV[t] = acc;
            }
            SYNC
            THREADS(t, 1024) {
                int i = t >> 4, e = t & 15;
                float acc = 0.f;
                for (int d = 0; d < 64; ++d) acc += sQ[i * 64 + d] * sS[d * 16 + e];
                for (int j = 0; j < 64; ++j) acc += bf2f(sQK[i * 64 + j]) * sV[j * 16 + e];
                int row = chunk_row(c, i);
                if (row < RQ) p.odir[((size_t)c.dir * R + row) * 256 + c.hd * 64 + cb * 16 + e] = f2bf(acc);
            }
            SYNC
            THREADS(t, 1024) {
                int d = t >> 4, e = t & 15;
                float acc = sS[t] * expf(sG[63]);
                for (int i = 0; i < 64; ++i) acc += sK[i * 64 + d] * sV[i * 16 + e];
                sS[t] = acc;
            }
            SYNC
        }
    }
}

#endif

#ifndef CPU_EMU
HD void ph_gdn_fin(const Params& p, int l, int bid, int nb) {
    const int RQ = (l == 0) ? R : NLAT;
    const float* og = p.in[I_ONORM] + l * 64;
    const int N = RQ * 32;
    for (int idx = bid * 256 + tid_(); idx < N; idx += nb * 256) {
        const int r = idx >> 5, q = idx & 31; const int hd = q >> 3, cg = q & 7;
        const uint4 a0 = *(const uint4*)(p.odir + (size_t)r * 256 + hd * 64 + cg * 8);
        const uint4 a1 = *(const uint4*)(p.odir + ((size_t)R + r) * 256 + hd * 64 + cg * 8);
        const uint4 zz = *(const uint4*)(p.P + (size_t)r * PLD + C_Z + hd * 64 + cg * 8);
        float v[8], z[8];
        v[0] = __uint_as_float(a0.x << 16) + __uint_as_float(a1.x << 16); v[1] = __uint_as_float(a0.x & 0xffff0000u) + __uint_as_float(a1.x & 0xffff0000u);
        v[2] = __uint_as_float(a0.y << 16) + __uint_as_float(a1.y << 16); v[3] = __uint_as_float(a0.y & 0xffff0000u) + __uint_as_float(a1.y & 0xffff0000u);
        v[4] = __uint_as_float(a0.z << 16) + __uint_as_float(a1.z << 16); v[5] = __uint_as_float(a0.z & 0xffff0000u) + __uint_as_float(a1.z & 0xffff0000u);
        v[6] = __uint_as_float(a0.w << 16) + __uint_as_float(a1.w << 16); v[7] = __uint_as_float(a0.w & 0xffff0000u) + __uint_as_float(a1.w & 0xffff0000u);
        z[0] = __uint_as_float(zz.x << 16); z[1] = __uint_as_float(zz.x & 0xffff0000u); z[2] = __uint_as_float(zz.y << 16); z[3] = __uint_as_float(zz.y & 0xffff0000u);
        z[4] = __uint_as_float(zz.z << 16); z[5] = __uint_as_float(zz.z & 0xffff0000u); z[6] = __uint_as_float(zz.w << 16); z[7] = __uint_as_float(zz.w & 0xffff0000u);
        float ss = 0.f;
#pragma unroll
        for (int c = 0; c < 8; ++c) ss += v[c] * v[c];
        ss += __shfl_xor(ss, 1); ss += __shfl_xor(ss, 2); ss += __shfl_xor(ss, 4);
        const float rs = 1.0f / sqrtf(ss / 64.0f + 1e-6f);
        float o[8];
#pragma unroll
        for (int c = 0; c < 8; ++c) o[c] = v[c] * rs * og[cg * 8 + c] * siluf_(z[c]);
        uint4 pk; pk.x = cvtpk(o[0], o[1]); pk.y = cvtpk(o[2], o[3]); pk.z = cvtpk(o[4], o[5]); pk.w = cvtpk(o[6], o[7]);
        *(uint4*)(p.br + (size_t)r * D + 512 + hd * 64 + cg * 8) = pk;
    }
}
#else
HD void ph_gdn_fin(const Params& p, int l, int bid, int nb) {
    const int RQ = (l == 0) ? R : NLAT;
    const float* og = p.in[I_ONORM] + l * 64;
    const int N = RQ * 4;
    for (int u = bid; u < (N + 255) / 256; u += nb) {
        THREADS(t, 256) {
            int idx = u * 256 + t;
            if (idx < N) {
                int r = idx >> 2, hd = idx & 3;
                const bf16* o0 = p.odir + (size_t)r * 256 + hd * 64;
                const bf16* o1 = p.odir + ((size_t)R + r) * 256 + hd * 64;
                float ss = 0.f;
                for (int d = 0; d < 64; ++d) { float v = bf2f(o0[d]) + bf2f(o1[d]); ss += v * v; }
                float rs = 1.0f / sqrtf(ss / 64.0f + 1e-6f);
                for (int d = 0; d < 64; ++d) {
                    float v = (bf2f(o0[d]) + bf2f(o1[d])) * rs * og[d];
                    float z = bf2f(p.P[(size_t)r * PLD + C_Z + hd * 64 + d]);
                    p.br[(size_t)r * D + 512 + hd * 64 + d] = f2bf(v * siluf_(z));
                }
            }
        }
    }
}

#endif

#ifndef CPU_EMU
template <int NJ>
HD void merge_tile(const Params& p, int l, int mt, int nt, char* smc) {
    constexpr int NW = 32 * NJ;
    const bf16* Wg = p.wt_in + (size_t)l * WIN_NP * D + (size_t)PLD * D;
    const bf16* Wb = p.wt_br + (size_t)l * 4 * D * 256;
    AccT<NJ> accM; acc_zero(accM);
    const unsigned char* h8 = (const unsigned char*)h8_of(p);
    auto aG = [&](int r) { return (const void*)(h8 + (size_t)(mt * 128 + r) * D); };
    int cur = 0;
    __syncthreads();
    gemm_stage0<NJ>(aG, [&](int j) { return (const void*)((const unsigned char*)Wg + (size_t)(nt * NW + j) * D); }, 1, smc, 0);
#pragma unroll 1
    for (int i = 0; i < 4; ++i) {
        AccT<NJ> acc; acc_zero(acc);
        auto bG = [&](int j) { return (const void*)((const unsigned char*)Wg + (size_t)(i * 1024 + nt * NW + j) * D); };
        auto aP = [&](int r) { return (const void*)(p.br + (size_t)(mt * 128 + r) * D + i * 256); };
        auto bP = [&](int j) { return (const void*)(Wb + ((size_t)i * D + nt * NW + j) * 256); };
        gemm_chain<NJ, true>(acc, aG, bG, D, smc, cur, [&](int buf) { gemm_stage0<NJ>(aP, bP, 2, smc, buf); }, SC_H, SC_W);
        unsigned sg[4][NJ][2];
#pragma unroll
        for (int a_ = 0; a_ < 4; ++a_)
#pragma unroll
            for (int b_ = 0; b_ < NJ; ++b_) {
                float e[4];
#pragma unroll
                for (int r = 0; r < 4; ++r) e[r] = __builtin_amdgcn_rcpf(1.0f + __expf(-acc.v[a_][b_][r]));
                sg[a_][b_][0] = cvtpk(e[0], e[1]); sg[a_][b_][1] = cvtpk(e[2], e[3]);
            }
        acc_zero(acc);
        auto bGn = [&](int j) { return (const void*)((const unsigned char*)Wg + (size_t)((i + 1) * 1024 + nt * NW + j) * D); };
        gemm_chain<NJ, false>(acc, aP, bP, 256, smc, cur, [&](int buf) { if (i < 3) gemm_stage0<NJ>(aG, bGn, 1, smc, buf); }, 0, 0);
#pragma unroll
        for (int a_ = 0; a_ < 4; ++a_)
#pragma unroll
            for (int b_ = 0; b_ < NJ; ++b_) {
                accM.v[a_][b_][0] += __uint_as_float(sg[a_][b_][0] << 16) * acc.v[a_][b_][0];
                accM.v[a_][b_][1] += __uint_as_float(sg[a_][b_][0] & 0xffff0000u) * acc.v[a_][b_][1];
                accM.v[a_][b_][2] += __uint_as_float(sg[a_][b_][1] << 16) * acc.v[a_][b_][2];
                accM.v[a_][b_][3] += __uint_as_float(sg[a_][b_][1] & 0xffff0000u) * acc.v[a_][b_][3];
            }
    }
    __syncthreads();
    float* tl = (float*)smc;
    acc_to_lds<NJ>(accM, tl);
    __syncthreads();
    const int t_ = tid_(); const int row = t_ >> 1, half = t_ & 1;
    constexpr int LD = NW + 4, HW = NW / 2;
    bf16* dst = p.mg + (size_t)(mt * 128 + row) * D + nt * NW + half * HW;
#pragma unroll
    for (int q = 0; q < HW / 8; ++q) {
        const f32x4_t a = *(const f32x4_t*)(tl + row * LD + half * HW + q * 8), b = *(const f32x4_t*)(tl + row * LD + half * HW + q * 8 + 4);
        uint4 pk; pk.x = cvtpk(a[0], a[1]); pk.y = cvtpk(a[2], a[3]); pk.z = cvtpk(b[0], b[1]); pk.w = cvtpk(b[2], b[3]);
        *(uint4*)(dst + q * 8) = pk;
    }
}
HD void ph_merge(const Params& p, int l, int bid, int nb, char* smc) {
    constexpr int MTL = NLAT / 128, MTC = NCTX / 128;
    const int nfull = MTL * 8, nhalf = (l == 0) ? MTC * 16 : 0;
    for (int tile = bid; tile < nfull + nhalf; tile += nb) {
        if (tile < nfull) merge_tile<4>(p, l, tile >> 3, tile & 7, smc);
        else { const int t2 = tile - nfull; merge_tile<2>(p, l, MTL + (t2 >> 4), t2 & 15, smc); }
    }
}
#else
HD void ph_merge(const Params& p, int l, int bid, int nb, char* smc) {
    const int MT = ((l == 0) ? R : NLAT) / 128;
    const bf16* Wg = p.wt_in + (size_t)l * WIN_NP * D + (size_t)PLD * D;
    const bf16* Wb = p.wt_br + (size_t)l * 4 * D * 256;
    for (int tile = bid; tile < MT * 16; tile += nb) {
        const int mt = tile >> 4, nt = tile & 15;
        ACC_DECL(2, accM); acc_zero(accM);
        for (int i = 0; i < 4; ++i) {
            ACC_DECL(2, accG); acc_zero(accG);
            ACC_DECL(2, accP); acc_zero(accP);
            gemm_accum<2>(accG, [&](int r) { return p.h + (size_t)(mt * 128 + r) * D; },
                          [&](int j) { return Wg + (size_t)(i * 1024 + nt * 64 + j) * D; }, D, smc);
            gemm_accum<2>(accP, [&](int r) { return p.br + (size_t)(mt * 128 + r) * D + i * 256; },
                          [&](int j) { return Wb + ((size_t)i * D + nt * 64 + j) * 256; }, 256, smc);
            ACC_FOR(2, row, col) { AV(accM) += sigmoidf_(AV(accG)) * AV(accP); } ACC_END
        }
#ifndef CPU_EMU
        {
            float* tl = (float*)smc;
            acc_to_lds<2>(accM, tl);
            __syncthreads();
            const int t_ = tid_(); const int row = t_ >> 1, half = t_ & 1;
            bf16* dst = p.mg + (size_t)(mt * 128 + row) * D + nt * 64 + half * 32;
#pragma unroll
            for (int q = 0; q < 4; ++q) {
                const f32x4_t a = *(const f32x4_t*)(tl + row * 68 + half * 32 + q * 8), b = *(const f32x4_t*)(tl + row * 68 + half * 32 + q * 8 + 4);
                uint4 pk; pk.x = cvtpk(a[0], a[1]); pk.y = cvtpk(a[2], a[3]); pk.z = cvtpk(b[0], b[1]); pk.w = cvtpk(b[2], b[3]);
                *(uint4*)(dst + q * 8) = pk;
            }
        }
#else
        ACC_FOR(2, row, col) { p.mg[(size_t)(mt * 128 + row) * D + nt * 64 + col] = f2bf(AV(accM)); } ACC_END
#endif
    }
}

#endif

template <int DRY> HD void ph_outproj_t(const Params& p, int l, int bid, int nb, char* smc) {
    const int MT = ((l == 0) ? R : NLAT) / 128;
    const bf16* Wt = p.wt_out + (size_t)l * D * D;
#ifndef CPU_EMU
    constexpr int MTL_ = NLAT / 128;
    const int nfull_ = MTL_ * 8, nhalf_ = (MT - MTL_) * 16;
    for (int tile = bid + nfull_; tile < nfull_ + nhalf_; tile += nb) {
        const int t2 = tile - nfull_; const int mt = MTL_ + (t2 >> 4), nt = t2 & 15;
        AccT<2> acc; acc_zero(acc);
        gemm_accum<2>(acc, [&](int r) { return p.mg + (size_t)(mt * 128 + r) * D; }, [&](int j) { return Wt + (size_t)(nt * 64 + j) * D; }, D, smc);
        float* tl = (float*)smc;
        acc_to_lds<2>(acc, tl);
        __syncthreads();
        const int t_ = tid_(); const int row = t_ >> 1, half = t_ & 1;
        const int r = mt * 128 + row, c0 = nt * 64 + half * 32;
        const float* xi = xrow_in(p, l, r) + c0; float* xo = (DRY ? ((float*)p.Y + (size_t)r * D) : xrow_out(p, r)) + c0; const float* gm = modrow(p, l, r) + 2048 + c0;
#pragma unroll
        for (int q = 0; q < 8; ++q) {
            const f32x4_t a = *(const f32x4_t*)(tl + row * 68 + half * 32 + q * 4), xv = *(const f32x4_t*)(xi + q * 4), gv = *(const f32x4_t*)(gm + q * 4);
            f32x4_t o; o[0] = xv[0] + gv[0] * a[0]; o[1] = xv[1] + gv[1] * a[1]; o[2] = xv[2] + gv[2] * a[2]; o[3] = xv[3] + gv[3] * a[3];
            *(f32x4_t*)(xo + q * 4) = o;
        }
        __syncthreads();
    }
    const int MTF = MTL_;
#else
    const int MTF = MT;
#endif
    for (int tile = bid; tile < MTF * 8; tile += nb) {
        const int mt = tile >> 3, nt = tile & 7;
        ACC_DECL(4, acc); acc_zero(acc);
        gemm_accum<4>(acc, [&](int r) { return p.mg + (size_t)(mt * 128 + r) * D; }, [&](int j) { return Wt + (size_t)(nt * 128 + j) * D; }, D, smc);
#ifndef CPU_EMU
        {
            float* tl = (float*)smc;
            acc_to_lds<4>(acc, tl);
            __syncthreads();
            const int t_ = tid_(); const int row = t_ >> 1, half = t_ & 1;
            const int r = mt * 128 + row, c0 = nt * 128 + half * 64;
            const float* xi = xrow_in(p, l, r) + c0; float* xo = (DRY ? ((float*)p.Y + (size_t)r * D) : xrow_out(p, r)) + c0; const float* gm = modrow(p, l, r) + 2048 + c0;
#pragma unroll
            for (int q = 0; q < 16; ++q) {
                const f32x4_t a = *(const f32x4_t*)(tl + row * 132 + half * 64 + q * 4), xv = *(const f32x4_t*)(xi + q * 4), gv = *(const f32x4_t*)(gm + q * 4);
                f32x4_t o; o[0] = xv[0] + gv[0] * a[0]; o[1] = xv[1] + gv[1] * a[1]; o[2] = xv[2] + gv[2] * a[2]; o[3] = xv[3] + gv[3] * a[3];
                *(f32x4_t*)(xo + q * 4) = o;
            }
        }
#else
        ACC_FOR(4, row, col) {
            const int r = mt * 128 + row, c = nt * 128 + col;
            xrow_out(p, r)[c] = xrow_in(p, l, r)[c] + modrow(p, l, r)[2048 + c] * AV(acc);
        } ACC_END
#endif
    }
}

HD void ph_outproj(const Params& p, int l, int bid, int nb, char* smc) { ph_outproj_t<0>(p, l, bid, nb, smc); }
#ifndef CPU_EMU
template <int DRY> HD void ph_router_t(const Params& p, int l, int bid, int nb, float* smf) {
    char* smc = (char*)smf;
    const int t = tid_(), lane = t & 63, w = t >> 6, fr = lane & 15, fg = lane >> 4;
    const int RQ = (l == 0) ? R : NLAT;
    const float* gN = p.in[I_N2G] + l * D;
    constexpr int WST = 2080;
    float* lgw = (float*)(smc + 66560) + w * (16 * 17);
    int* lcnt = (int*)(smc + 70912); int* gbase = (int*)(smc + 70976);
    __syncthreads();
    for (int k = t; k < 1024; k += 256) {
        const float* wrow = p.in[I_WROUTER] + k * 16;
#pragma unroll
        for (int e = 0; e < 16; ++e) {
            const float v = wrow[e]; const bf16 hi = f2bf(v);
            *(bf16*)(smc + e * WST + k * 2) = hi; *(bf16*)(smc + 33280 + e * WST + k * 2) = f2bf(v - bf2f(hi));
        }
    }
    const int ngroups = RQ / 16;
    for (int g0 = bid * 4; g0 < ngroups; g0 += nb * 4) {
        __syncthreads();
        if (t < 16) lcnt[t] = 0;
        __syncthreads();
        const int gidx = g0 + w;
        const bool active = gidx < ngroups;
        int e1 = 0, e2 = 0, q1 = 0, q2 = 0; const int rsel = gidx * 16 + lane;
        if (active) {
            const int r = gidx * 16 + fr;
            const float* x = xrow_out(p, r);
            const float* m = modrow(p, l, r);
            float ss = 0.f;
#pragma unroll 4
            for (int s_ = 0; s_ < 32; ++s_) {
                const f32x4_t a = *(const f32x4_t*)(x + s_ * 32 + fg * 8), b = *(const f32x4_t*)(x + s_ * 32 + fg * 8 + 4);
                ss += a[0] * a[0] + a[1] * a[1] + a[2] * a[2] + a[3] * a[3] + b[0] * b[0] + b[1] * b[1] + b[2] * b[2] + b[3] * b[3];
            }
            ss += __shfl_xor(ss, 16); ss += __shfl_xor(ss, 32);
            const float rs = 1.0f / sqrtf(ss / D + 1e-6f);
            f32x4_t acc = f32x4_t{0.f, 0.f, 0.f, 0.f};
#pragma unroll 2
            for (int s_ = 0; s_ < 32; ++s_) {
                const int k0 = s_ * 32 + fg * 8;
                float hv[8];
#pragma unroll
                for (int hh = 0; hh < 2; ++hh) {
                    const f32x4_t xv = *(const f32x4_t*)(x + k0 + hh * 4), gv = *(const f32x4_t*)(gN + k0 + hh * 4);
                    const f32x4_t sc = *(const f32x4_t*)(m + 4096 + k0 + hh * 4), sh = *(const f32x4_t*)(m + 3072 + k0 + hh * 4);
#pragma unroll
                    for (int q = 0; q < 4; ++q) hv[hh * 4 + q] = xv[q] * rs * gv[q] * (1.0f + sc[q]) + sh[q];
                }
                unsigned hi[4], lo[4];
#pragma unroll
                for (int q = 0; q < 4; ++q) {
                    hi[q] = cvtpk(hv[2 * q], hv[2 * q + 1]);
                    lo[q] = cvtpk(hv[2 * q] - __uint_as_float(hi[q] << 16), hv[2 * q + 1] - __uint_as_float(hi[q] & 0xffff0000u));
                }
                const i32x4_t hiv = i32x4_t{(int)hi[0], (int)hi[1], (int)hi[2], (int)hi[3]}, lov = i32x4_t{(int)lo[0], (int)lo[1], (int)lo[2], (int)lo[3]};
                { uint2 q8; q8.x = pack_fp8x4(hv[0] * 4.f, hv[1] * 4.f, hv[2] * 4.f, hv[3] * 4.f); q8.y = pack_fp8x4(hv[4] * 4.f, hv[5] * 4.f, hv[6] * 4.f, hv[7] * 4.f);
                  *(uint2*)(h8_of(p) + (size_t)r * D + k0) = q8; }
                const bf16x8_t bh = *(const bf16x8_t*)(smc + fr * WST + s_ * 64 + fg * 16), bl = *(const bf16x8_t*)(smc + 33280 + fr * WST + s_ * 64 + fg * 16);
                acc = __builtin_amdgcn_mfma_f32_16x16x32_bf16(__builtin_bit_cast(bf16x8_t, hiv), bh, acc, 0, 0, 0);
                acc = __builtin_amdgcn_mfma_f32_16x16x32_bf16(__builtin_bit_cast(bf16x8_t, hiv), bl, acc, 0, 0, 0);
                acc = __builtin_amdgcn_mfma_f32_16x16x32_bf16(__builtin_bit_cast(bf16x8_t, lov), bh, acc, 0, 0, 0);
            }
#pragma unroll
            for (int q = 0; q < 4; ++q) lgw[(4 * fg + q) * 17 + fr] = acc[q];
            if (lane < 16) {
                float sc[16], sel[16];
#pragma unroll
                for (int e = 0; e < 16; ++e) { sc[e] = sigmoidf_(lgw[lane * 17 + e]); sel[e] = sc[e] + p.in[I_RBIAS][e]; }
                int best = 0; float bestv = -1e30f;
#pragma unroll
                for (int gph = 0; gph < 4; ++gph) {
                    float t1 = -1e30f, t2 = -1e30f;
#pragma unroll
                    for (int j = 0; j < 4; ++j) { const float v = sel[gph * 4 + j]; if (v > t1) { t2 = t1; t1 = v; } else if (v > t2) t2 = v; }
                    const float gs = t1 + t2;
                    if (gs > bestv) { bestv = gs; best = gph; }
                }
                float v1 = -1e30f, v2 = -1e30f, w1 = 0.f, w2 = 0.f; int i1 = 0, i2 = 0;
#pragma unroll
                for (int e = 0; e < 16; ++e) {
                    if ((e >> 2) == best) {
                        const float v = sel[e];
                        if (v > v1) { v2 = v1; i2 = i1; w2 = w1; v1 = v; i1 = e; w1 = sc[e]; } else if (v > v2) { v2 = v; i2 = e; w2 = sc[e]; }
                    }
                }
                e1 = i1; e2 = i2;
                const float ws_ = w1 + w2;
                p.sel_e[rsel * 2] = i1; p.sel_e[rsel * 2 + 1] = i2;
                p.sel_w[rsel * 2] = w1 / ws_; p.sel_w[rsel * 2 + 1] = w2 / ws_;
                q1 = atomicAdd(&lcnt[i1], 1); q2 = atomicAdd(&lcnt[i2], 1);
            }
        }
        __syncthreads();
        if (t < 16) { const int c = lcnt[t]; gbase[t] = (c && !DRY) ? atomicAdd(&p.cnt[l * 16 + t], c) : 0; }
        __syncthreads();
        if (active && lane < 16 && !DRY) {
            const int p1 = gbase[e1] + q1, p2 = gbase[e2] + q2;
            p.elist[(size_t)e1 * 2 * R + p1] = rsel * 2; p.apos[rsel * 2] = p1;
            p.elist[(size_t)e2 * 2 * R + p2] = rsel * 2 + 1; p.apos[rsel * 2 + 1] = p2;
        }
    }
}
HD void ph_router(const Params& p, int l, int bid, int nb, float* smf) { ph_router_t<0>(p, l, bid, nb, smf); }
#else
HD void ph_router(const Params& p, int l, int bid, int nb, float* sm) {
    const int RQ = (l == 0) ? R : NLAT;
    const float* g = p.in[I_N2G] + l * D;
    const float* wr = p.in[I_WROUTER];
    float* sh = sm + 512;
    float* sl = sm + 2048;
    for (int r = bid; r < RQ; r += nb) {
        const float* x = xrow_out(p, r);
        const float* m = modrow(p, l, r);
        THREADS(t, 256) { float s = 0.f; for (int k = t; k < D; k += 256) s += x[k] * x[k]; sm[t] = s; }
        SYNC
        THREADS(t, 1) { float s = 0.f; for (int i = 0; i < 256; ++i) s += sm[i]; sm[256] = s; }
        SYNC
        THREADS(t, 256) {
            float rs = 1.0f / sqrtf(sm[256] / D + 1e-6f);
            for (int k = t; k < D; k += 256) {
                float v = x[k] * rs * g[k];
                v = v * (1.0f + m[4096 + k]) + m[3072 + k];
                sh[k] = v;
                p.h[(size_t)r * D + k] = f2bf(v);
            }
        }
        SYNC
        THREADS(t, 256) {
            int e = t & 15, ks = t >> 4;
            float acc = 0.f;
            for (int k = ks * 64; k < ks * 64 + 64; ++k) acc += sh[k] * wr[k * 16 + e];
            sl[ks * 16 + e] = acc;
        }
        SYNC
        THREADS(t, 1) {
            float* sc = sm + 2304; float* sel = sm + 2320;
            for (int e = 0; e < 16; ++e) {
                float acc = 0.f;
                for (int ks = 0; ks < 16; ++ks) acc += sl[ks * 16 + e];
                sc[e] = sigmoidf_(acc); sel[e] = sc[e] + p.in[I_RBIAS][e];
            }
            int best = 0; float bestv = -1e30f;
            for (int gph = 0; gph < 4; ++gph) {
                float t1 = -1e30f, t2 = -1e30f;
                for (int j = 0; j < 4; ++j) { float v = sel[gph * 4 + j]; if (v > t1) { t2 = t1; t1 = v; } else if (v > t2) t2 = v; }
                float gs = t1 + t2;
                if (gs > bestv) { bestv = gs; best = gph; }
            }
            int i1 = -1, i2 = -1; float v1 = -1e30f, v2 = -1e30f;
            for (int j = 0; j < 4; ++j) {
                float v = sel[best * 4 + j];
                if (v > v1) { v2 = v1; i2 = i1; v1 = v; i1 = best * 4 + j; } else if (v > v2) { v2 = v; i2 = best * 4 + j; }
            }
            float w1 = sc[i1], w2 = sc[i2], ws = w1 + w2;
            p.sel_e[r * 2] = i1; p.sel_e[r * 2 + 1] = i2;
            p.sel_w[r * 2] = w1 / ws; p.sel_w[r * 2 + 1] = w2 / ws;
            int q1 = ATOMIC_ADD_RET(&p.cnt[l * 16 + i1], 1); p.elist[(size_t)i1 * 2 * R + q1] = r * 2; p.apos[r * 2] = q1;
            int q2 = ATOMIC_ADD_RET(&p.cnt[l * 16 + i2], 1); p.elist[(size_t)i2 * 2 * R + q2] = r * 2 + 1; p.apos[r * 2 + 1] = q2;
        }
        SYNC
    }
}

#endif

struct MoeTiles { int tstart[17]; };
HD MoeTiles moe_tiles(const Params& p, int l) {
    MoeTiles m; int acc = 0;
    for (int e = 0; e < 16; ++e) { m.tstart[e] = acc; acc += (p.cnt[l * 16 + e] + 127) >> 7; }
    m.tstart[16] = acc; return m;
}

HD void ph_ffn1(const Params& p, int l, int bid, int nb, char* smc) {
    int tstart[17];
    { int acc = 0; for (int e = 0; e < 16; ++e) { tstart[e] = acc; acc += (p.cnt[l * 16 + e] + 127) >> 7; } tstart[16] = acc; }
    const int ntiles = tstart[16];
    for (int tile = bid; tile < ntiles * 8; tile += nb) {
        const int rt = tile >> 3, nt = tile & 7;
        int e = 0, ts = 0;
#pragma unroll
        for (int q = 1; q < 16; ++q) if (rt >= tstart[q]) { e = q; ts = tstart[q]; }
        const int mt = rt - ts;
        const int cnt_e = p.cnt[l * 16 + e];
        const int* el = p.elist + (size_t)e * 2 * R;
#ifndef CPU_EMU
        const unsigned char* Wt8 = gu8_of(p) + (size_t)e * 1024 * D;
        AccT<4> acc; acc_zero(acc);
        gemm_accum8<4>(acc, [&](int i) { int q = mt * 128 + i; int a = (q < cnt_e) ? el[q] : el[0]; return (const unsigned char*)h8_of(p) + (size_t)(a >> 1) * D; },
                       [&](int j) { return Wt8 + (size_t)(nt * 128 + j) * D; }, D, smc, SC_H, SC_W);
        {
            float* tl = (float*)smc;
            acc_to_lds<4>(acc, tl);
            __syncthreads();
            const int t_ = tid_(); const int row = t_ >> 1, half = t_ & 1;
            unsigned char* dst = (unsigned char*)p.act + (size_t)(rt * 128 + row) * 512 + nt * 64 + half * 32;
#pragma unroll
            for (int q = 0; q < 2; ++q) {
                float o[16];
#pragma unroll
                for (int c4 = 0; c4 < 4; ++c4) {
                    const f32x4_t gv = *(const f32x4_t*)(tl + row * 132 + half * 64 + q * 32 + c4 * 4), uv = *(const f32x4_t*)(tl + row * 132 + half * 64 + q * 32 + 16 + c4 * 4);
#pragma unroll
                    for (int e_ = 0; e_ < 4; ++e_) o[c4 * 4 + e_] = gv[e_] / (1.0f + __expf(-gv[e_])) * uv[e_] * 16.0f;
                }
                uint4 pk; pk.x = pack_fp8x4(o[0], o[1], o[2], o[3]); pk.y = pack_fp8x4(o[4], o[5], o[6], o[7]);
                pk.z = pack_fp8x4(o[8], o[9], o[10], o[11]); pk.w = pack_fp8x4(o[12], o[13], o[14], o[15]);
                *(uint4*)(dst + q * 16) = pk;
            }
        }
#else
        const bf16* Wt = p.wt_gu + (size_t)e * 1024 * D;
        ACC_DECL(4, acc); acc_zero(acc);
        gemm_accum<4>(acc, [&](int i) { int q = mt * 128 + i; int a = (q < cnt_e) ? el[q] : el[0]; return p.h + (size_t)(a >> 1) * D; },
                      [&](int j) { return Wt + (size_t)(nt * 128 + j) * D; }, D, smc);
        ACC_FOR_PAIR(row, pcol) {
            float gv = AV_G(acc), uv = AV_U(acc);
            p.act[(size_t)(rt * 128 + row) * 512 + nt * 64 + pcol] = f2bf(siluf_(gv) * uv);
        } ACC_END
#endif
    }
}

HD void ph_ffn2(const Params& p, int l, int bid, int nb, char* smc) {
    int tstart[17];
    { int acc = 0; for (int e = 0; e < 16; ++e) { tstart[e] = acc; acc += (p.cnt[l * 16 + e] + 127) >> 7; } tstart[16] = acc; }
    const int ntiles = tstart[16];
    for (int tile = bid; tile < ntiles * 8; tile += nb) {
        const int rt = tile >> 3, nt = tile & 7;
        int e = 0;
#pragma unroll
        for (int q = 1; q < 16; ++q) if (rt >= tstart[q]) e = q;
#ifndef CPU_EMU
        const unsigned char* Wt8 = d8_of(p) + (size_t)e * D * 512;
        AccT<4> acc; acc_zero(acc);
        gemm_accum8<4>(acc, [&](int i) { return (const unsigned char*)p.act + (size_t)(rt * 128 + i) * 512; }, [&](int j) { return Wt8 + (size_t)(nt * 128 + j) * 512; }, 512, smc, SC_ACT, SC_W);
#else
        const bf16* Wt = p.wt_d + (size_t)e * D * 512;
        ACC_DECL(4, acc); acc_zero(acc);
        gemm_accum<4>(acc, [&](int i) { return p.act + (size_t)(rt * 128 + i) * 512; }, [&](int j) { return Wt + (size_t)(nt * 128 + j) * 512; }, 512, smc);
#endif
#ifndef CPU_EMU
        {
            float* tl = (float*)smc;
            acc_to_lds<4>(acc, tl);
            __syncthreads();
            const int t_ = tid_(); const int row = t_ >> 1, half = t_ & 1;
            bf16* dst = p.Y + (size_t)(rt * 128 + row) * D + nt * 128 + half * 64;
#pragma unroll
            for (int q = 0; q < 8; ++q) {
                const f32x4_t a = *(const f32x4_t*)(tl + row * 132 + half * 64 + q * 8), b = *(const f32x4_t*)(tl + row * 132 + half * 64 + q * 8 + 4);
                uint4 pk; pk.x = cvtpk(a[0], a[1]); pk.y = cvtpk(a[2], a[3]); pk.z = cvtpk(b[0], b[1]); pk.w = cvtpk(b[2], b[3]);
                *(uint4*)(dst + q * 8) = pk;
            }
        }
#else
        ACC_FOR(4, row, col) { p.Y[(size_t)(rt * 128 + row) * D + nt * 128 + col] = f2bf(AV(acc)); } ACC_END
#endif
    }
}

#ifndef CPU_EMU
template <int DRY> HD void ph_combine_t(const Params& p, int l, int bid, int nb) {
    const int RQ = (l == 0) ? R : NLAT;
    const int t = tid_(), lane = t & 63, w = t >> 6;
    int tstart[17];
    { int acc = 0;
#pragma unroll
      for (int e = 0; e < 16; ++e) { tstart[e] = acc; acc += (p.cnt[l * 16 + e] + 127) >> 7; } tstart[16] = acc; }
    for (int r = bid * 4 + w; r < RQ; r += nb * 4) {
        float* xo = xrow_out(p, r);
        const float* m = modrow(p, l, r) + 5120;
        const int e0 = p.sel_e[r * 2], e1 = p.sel_e[r * 2 + 1];
        int t0 = 0, t1 = 0;
#pragma unroll
        for (int q = 0; q < 16; ++q) { if (q == e0) t0 = tstart[q]; if (q == e1) t1 = tstart[q]; }
        const bf16* y0 = p.Y + (size_t)(t0 * 128 + p.apos[r * 2]) * D;
        const bf16* y1 = p.Y + (size_t)(t1 * 128 + p.apos[r * 2 + 1]) * D;
        const float w0 = p.sel_w[r * 2], w1 = p.sel_w[r * 2 + 1];
        f32x4_t xs[4]; float ss = 0.f;
#pragma unroll
        for (int j = 0; j < 4; ++j) {
            const int k = j * 256 + lane * 4;
            f32x4_t xv = *(const f32x4_t*)(xo + k);
            const f32x4_t gv = *(const f32x4_t*)(m + k);
            const uint2 a = *(const uint2*)(y0 + k), b = *(const uint2*)(y1 + k);
            xv[0] += gv[0] * (w0 * __uint_as_float(a.x << 16) + w1 * __uint_as_float(b.x << 16));
            xv[1] += gv[1] * (w0 * __uint_as_float(a.x & 0xffff0000u) + w1 * __uint_as_float(b.x & 0xffff0000u));
            xv[2] += gv[2] * (w0 * __uint_as_float(a.y << 16) + w1 * __uint_as_float(b.y << 16));
            xv[3] += gv[3] * (w0 * __uint_as_float(a.y & 0xffff0000u) + w1 * __uint_as_float(b.y & 0xffff0000u));
            *(f32x4_t*)((DRY ? (float*)p.gq + (size_t)r * 64 : xo) + (DRY ? (k & 63) : k)) = xv;
            xs[j] = xv; ss += xv[0] * xv[0] + xv[1] * xv[1] + xv[2] * xv[2] + xv[3] * xv[3];
        }
        if (l == 0 && !DRY) {
            ss = wave_sum(ss);
            const float rs = 1.0f / sqrtf(ss / D + 1e-6f);
            const float* g1 = p.in[I_N1G] + D; const float* m1 = modrow(p, 1, r);
#pragma unroll
            for (int j = 0; j < 4; ++j) {
                const int k = j * 256 + lane * 4;
                const f32x4_t gv = *(const f32x4_t*)(g1 + k), sc = *(const f32x4_t*)(m1 + 1024 + k), sh = *(const f32x4_t*)(m1 + k);
                float o[4];
#pragma unroll
                for (int q = 0; q < 4; ++q) o[q] = xs[j][q] * rs * gv[q] * (1.0f + sc[q]) + sh[q];
                uint2 pk; pk.x = cvtpk(o[0], o[1]); pk.y = cvtpk(o[2], o[3]);
                *(uint2*)(p.h + (size_t)r * D + k) = pk;
                *(unsigned*)(h8_of(p) + (size_t)r * D + k) = pack_fp8x4(o[0] * 4.f, o[1] * 4.f, o[2] * 4.f, o[3] * 4.f);
            }
        }
    }
}
HD void ph_combine(const Params& p, int l, int bid, int nb) { ph_combine_t<0>(p, l, bid, nb); }
#else
HD void ph_combine(const Params& p, int l, int bid, int nb) {
    const int RQ = (l == 0) ? R : NLAT;
    int tstart[17];
    { int acc = 0; for (int e = 0; e < 16; ++e) { tstart[e] = acc; acc += (p.cnt[l * 16 + e] + 127) >> 7; } tstart[16] = acc; }
    for (int r = bid; r < RQ; r += nb) {
        float* xo = xrow_out(p, r);
        const float* m = modrow(p, l, r);
        int e0 = p.sel_e[r * 2], e1 = p.sel_e[r * 2 + 1];
        int t0 = 0, t1 = 0;
#pragma unroll
        for (int q = 0; q < 16; ++q) { if (q == e0) t0 = tstart[q]; if (q == e1) t1 = tstart[q]; }
        const bf16* y0 = p.Y + (size_t)(t0 * 128 + p.apos[r * 2]) * D;
        const bf16* y1 = p.Y + (size_t)(t1 * 128 + p.apos[r * 2 + 1]) * D;
        const float w0 = p.sel_w[r * 2], w1 = p.sel_w[r * 2 + 1];
        THREADS(t, 256) {
            for (int k = t; k < D; k += 256) xo[k] += m[5120 + k] * (w0 * bf2f(y0[k]) + w1 * bf2f(y1[k]));
        }
    }
}

#endif

constexpr int NPHASE_LAYER = 14;
HD void run_phase(const Params& p, int ph, int l, int bid, int nb, float* sm) {
    switch (ph) {
        case 0: ph_norm1(p, l, bid, nb, sm); break;
        case 1: ph_inproj(p, l, bid, nb, (char*)sm); break;
        case 2: ph_prep(p, l, bid, nb); if (FOURIER_GEMM) { if (l == 0) ph_fourier_s1c(p, nb - 1 - bid, nb, (char*)sm); ph_fourier_s1(p, bid, nb, (char*)sm); } break;
        case 3: ph_na(p, l, bid, nb, (char*)sm); break;
        case 4: ph_da(p, l, bid, nb, (char*)sm); break;
        case 5: ph_gdn_chunk(p, l, bid, nb, sm); break;
        case 6: if (FOURIER_GEMM) { if (l == 0) ph_fourier_ctx(p, bid, nb, (char*)sm); ph_fourier_sA(p, bid, nb, (char*)sm); } else ph_fourier2(p, l, bid, nb); break;
        case 7: {
            ph_gdn_scan(p, l, bid, nb, sm);
            const bool split = nb == 512;
            const bool skip = split && (bid < 64 || (bid >= 256 && bid < 320));
            if (!skip) {
                const int b2 = split ? (bid < 256 ? bid - 64 : bid - 128) : bid, n2 = split ? nb - 128 : nb;
                if (FOURIER_GEMM) ph_fourier_sB(p, b2, n2, (char*)sm);
                if (l == 0) convert_static(p, b2, n2, sm, 1);
                convert_moe(p, l, b2, n2, sm);
#ifndef CPU_EMU
                ph_na(p, l, b2, n2, (char*)sm);
#endif
            }
        } break;
#ifndef CPU_EMU
        case 8: ph_gdn_outfin(p, l, bid, nb, sm); break;
#else
        case 8: ph_gdn_fin(p, l, bid, nb); break;
#endif
        case 9: ph_merge(p, l, bid, nb, (char*)sm); break;
        case 10: ph_outproj(p, l, bid, nb, (char*)sm); break;
        case 11: ph_router(p, l, bid, nb, sm); break;
        case 12: ph_ffn1(p, l, bid, nb, (char*)sm); break;
        case 13: ph_ffn2(p, l, bid, nb, (char*)sm); break;
        case 14: ph_combine(p, l, bid, nb); break;
#ifndef CPU_EMU
        case 70: ph_gdn_scan(p, l, bid, nb, sm); break;
        case 71: if (bid >= 64) { if (FOURIER_GEMM) ph_fourier_sB(p, bid - 64, nb - 64, (char*)sm); if (l == 0) convert_static(p, bid - 64, nb - 64, sm, 1); convert_moe(p, l, bid - 64, nb - 64, sm); } break;
        case 110: ph_outproj_t<1>(p, l, bid, nb, (char*)sm); break;
        case 111: ph_router_t<1>(p, l, bid, nb, sm); break;
        case 114: ph_combine_t<1>(p, l, bid, nb); break;
#endif
        default: break;
    }
}

struct WsLayout { size_t dep, fWC, fXC, ropeT, bar, fa2, fW1, fWA, fWB, mods, cosT, sinT, cs, gg, gbeta, sel_e, sel_w, cnt, elist, apos, cG, wt_in, wt_br, wt_out, wt_gu, wt_d,
                  h, P, gq, fcs, cU, cW, cQK, odir, br, mg, act, Y, total; };
inline WsLayout ws_layout() {
    WsLayout w; size_t o = 0;
    auto take = [&](size_t bytes) { size_t r = o; o += (bytes + 255) & ~(size_t)255; return r; };
    w.bar = take(3456 * 4 + 256);        w.ropeT = take(128 * 8 * 2 * 4); w.fWC = take((size_t)CTXL * 2 * CTXL * 2); w.fXC = take((size_t)NB * 256 * 2 * CTXL * 2);
    w.mods = take(2 * 3 * 6144 * 4); w.cosT = take(SEQ * 4); w.sinT = take(SEQ * 4); w.cs = take((size_t)NCTX * D * 4);
    w.gg = take((size_t)8 * R * 4); w.gbeta = take((size_t)8 * R * 4); w.sel_e = take((size_t)R * 2 * 4); w.sel_w = take((size_t)R * 2 * 4);
    w.cnt = take(32 * 4); w.elist = take((size_t)16 * 2 * R * 4); w.apos = take((size_t)2 * R * 4); w.cG = take((size_t)NUNIT * 192 * 4);
    w.wt_in = take((size_t)2 * WIN_NP * D * 2); w.wt_br = take((size_t)2 * 4 * D * 256 * 2); w.wt_out = take((size_t)2 * D * D * 2);
    w.wt_gu = take((size_t)16 * 1024 * D * 2); w.wt_d = take((size_t)16 * D * 512 * 2);
    w.h = take((size_t)R * D * 2);
    w.fa2 = take((size_t)NB * 128 * 256 * 2 * 64 * 2); w.fW1 = take(8192 * 2); w.fWA = take(65536 * 2); w.fWB = take(8192 * 2);
    {
        const size_t szP = ((size_t)R * PLD * 2 + 255) & ~(size_t)255, szQ = ((size_t)R * 768 * 2 + 255) & ~(size_t)255;
        const size_t szA = ((size_t)PADROWS * 512 * 2 + 255) & ~(size_t)255, szY = ((size_t)PADROWS * 1024 * 2 + 255) & ~(size_t)255;
        const size_t base = take((szP + szQ) > (szA + szY) ? (szP + szQ) : (szA + szY));
        w.P = base; w.gq = base + szP; w.act = base; w.Y = base + szA;
    }
    w.fcs = take((size_t)R * 512 * 2);
    w.cU = take((size_t)NUNIT * 4096 * 2); w.cW = take((size_t)NUNIT * 4096 * 2); w.cQK = take((size_t)NUNIT * 4096 * 2);
    w.odir = take((size_t)2 * R * 256 * 2); w.br = take((size_t)R * D * 2);
    w.mg = w.cU;
    w.total = o;
    return w;
}
inline void fill_params(Params& p, void* const* d_in, void* d_out, void* d_ws) {
    WsLayout w = ws_layout(); char* b = (char*)d_ws;
    for (int i = 0; i < 30; ++i) p.in[i] = (const float*)d_in[i];
    p.out = (float*)d_out;
    p.mods = (float*)(b + w.mods); p.cosT = (float*)(b + w.cosT); p.sinT = (float*)(b + w.sinT); p.cs = (float*)(b + w.cs);
    p.h = (bf16*)(b + w.h); p.P = (bf16*)(b + w.P); p.gq = (bf16*)(b + w.gq); p.gg = (float*)(b + w.gg); p.gbeta = (float*)(b + w.gbeta);
    p.fcs = (bf16*)(b + w.fcs); p.cU = (bf16*)(b + w.cU); p.cW = (bf16*)(b + w.cW); p.cQK = (bf16*)(b + w.cQK); p.cG = (float*)(b + w.cG);
    p.odir = (bf16*)(b + w.odir); p.br = (bf16*)(b + w.br); p.mg = (bf16*)(b + w.mg); p.sel_e = (int*)(b + w.sel_e);
    p.sel_w = (float*)(b + w.sel_w); p.act = (bf16*)(b + w.act); p.Y = (bf16*)(b + w.Y);
    p.wt_in = (bf16*)(b + w.wt_in); p.wt_br = (bf16*)(b + w.wt_br); p.wt_out = (bf16*)(b + w.wt_out); p.wt_gu = (bf16*)(b + w.wt_gu);
    p.fa2 = (bf16*)(b + w.fa2); p.fW1 = (bf16*)(b + w.fW1); p.fWA = (bf16*)(b + w.fWA); p.fWB = (bf16*)(b + w.fWB);
    p.bar = (unsigned*)(b + w.bar); p.dep = (int*)(b + w.bar + 3456 * 4); p.ropeT = (float*)(b + w.ropeT); p.fWC = (bf16*)(b + w.fWC); p.fXC = (bf16*)(b + w.fXC);
    p.wt_d = (bf16*)(b + w.wt_d); p.cnt = (int*)(b + w.cnt); p.elist = (int*)(b + w.elist); p.apos = (int*)(b + w.apos);
}

#if !defined(CPU_EMU) && defined(PHASE_KERNELS)
#define PK(n) __global__ void __launch_bounds__(256, 2) pk_##n(Params p) { __shared__ __attribute__((aligned(16))) float sm[SMEM_FLOATS]; run_phase(p, n, p.layer, blockIdx.x, gridDim.x, sm); }
PK(0) PK(1) PK(2) PK(3) PK(4) PK(5) PK(6) PK(7) PK(8) PK(9) PK(10) PK(11) PK(12) PK(13) PK(14)
__global__ void __launch_bounds__(256, 2) pk_init(Params p) { __shared__ __attribute__((aligned(16))) float sm[SMEM_FLOATS]; ph_init(p, blockIdx.x, gridDim.x, sm); }
#endif
#ifndef CPU_EMU

#define XB_TMO      128
#define XB_XCNT(j)  (256  + 64 * (j))
#define XB_XSUB(j)  (1280 + 64 * (j))
#define XB_XGEN(j)  (2304 + 64 * (j))
#define XB_TOP      3328
#define XB_TOPGEN   3392
#define XCD_BAR_WORDS 3456
#define XB_SPIN_CAP (1u << 22)
#define LAS __attribute__((address_space(3)))
__device__ __forceinline__ unsigned xb_ld(unsigned* p)              { return __hip_atomic_load(p, __ATOMIC_RELAXED, __HIP_MEMORY_SCOPE_AGENT); }
__device__ __forceinline__ unsigned xb_add(unsigned* p, unsigned v) { return __hip_atomic_fetch_add(p, v, __ATOMIC_RELAXED, __HIP_MEMORY_SCOPE_AGENT); }
__device__ __forceinline__ unsigned xb_xcc_id() { return (unsigned)__builtin_amdgcn_s_getreg((3 << 11) | 20) & 0xFu; }
#define XB_SPIN(cond, bar) do { unsigned _sp = 0; while (cond) { __builtin_amdgcn_s_sleep(1); \
    if ((++_sp & 255u) == 0u) { if (xb_ld(&(bar)[XB_TMO])) break; if (_sp > XB_SPIN_CAP) { atomicAdd(&(bar)[XB_TMO], 1u); break; } } } } while (0)
struct XcdBarrier { unsigned* bar; unsigned x; volatile LAS unsigned* st; };
__device__ __forceinline__ XcdBarrier xcd_barrier_post(unsigned* bar, volatile LAS unsigned* st) {
    XcdBarrier b; b.bar = bar; b.x = xb_xcc_id(); b.st = st;
    if (threadIdx.x == 0) (void)xb_add(&bar[XB_XCNT(b.x)], 1u);
    return b;
}
__device__ __forceinline__ void xcd_barrier_complete(unsigned* bar, unsigned x, unsigned& nloc, unsigned& nx) {
    const unsigned G = gridDim.x * gridDim.y * gridDim.z;
    unsigned sum, cnt, mine, sp = 0u;
    for (;;) {
        sum = 0u; cnt = 0u; mine = 0u;
#pragma unroll
        for (unsigned j = 0; j < 16; ++j) { const unsigned c = xb_ld(&bar[XB_XCNT(j)]); sum += c; cnt += (c > 0u) ? 1u : 0u; mine = (j == x) ? c : mine; }
        if (sum == G) break;
        __builtin_amdgcn_s_sleep(1);
        if ((++sp & 255u) == 0u) { if (xb_ld(&bar[XB_TMO])) break; if (sp > XB_SPIN_CAP) { atomicAdd(&bar[XB_TMO], 1u); break; } }
    }
    nloc = mine > 0u ? mine : 1u; nx = cnt > 0u ? cnt : 1u;
}
__device__ __forceinline__ void xcd_barrier(const XcdBarrier& b) {
    asm volatile("s_waitcnt vmcnt(0)" ::: "memory");
    __syncthreads();
    if (threadIdx.x == 0) {
        unsigned* bar = b.bar;
        __builtin_amdgcn_s_waitcnt(0);
        unsigned nloc = b.st[0], nx = b.st[1];
        if (nloc == 0u) { xcd_barrier_complete(bar, b.x, nloc, nx); b.st[0] = nloc; b.st[1] = nx; }
        const unsigned old = xb_add(&bar[XB_XSUB(b.x)], 1u);
        const unsigned gen = old / nloc;
        if (old + 1u == (gen + 1u) * nloc) {
            __builtin_amdgcn_fence(__ATOMIC_RELEASE, "agent");
            asm volatile("s_waitcnt vmcnt(0)" ::: "memory");
            const unsigned og = xb_add(&bar[XB_TOP], 1u);
            const unsigned tg = og / nx;
            if (og + 1u == (tg + 1u) * nx) xb_add(&bar[XB_TOPGEN], 1u);
            else XB_SPIN(xb_ld(&bar[XB_TOPGEN]) == tg, bar);
            __builtin_amdgcn_fence(__ATOMIC_ACQUIRE, "agent");
            xb_add(&bar[XB_XGEN(b.x)], 1u);
            asm volatile("s_waitcnt vmcnt(0)" ::: "memory");
        } else {
            XB_SPIN(xb_ld(&bar[XB_XGEN(b.x)]) == gen, bar);
            __builtin_amdgcn_fence(__ATOMIC_ACQUIRE, "agent");
            asm volatile("s_waitcnt vmcnt(0)" ::: "memory");
        }
    }
    __syncthreads();
}

__global__ void __launch_bounds__(256, 2) fwd_megakernel(Params p) {
    __shared__ __attribute__((aligned(16))) float sm[SMEM_FLOATS];
    cg::grid_group grid = cg::this_grid();
    const int bid = blockIdx.x, nb = gridDim.x;
    volatile LAS unsigned* xst = (volatile LAS unsigned*)(sm + SMEM_FLOATS - 4);
    if (threadIdx.x == 0) { xst[0] = 0u; xst[1] = 0u; }
    __syncthreads();
    XcdBarrier xb = xcd_barrier_post(p.bar, xst);
    ph_init(p, bid, nb, sm);
    dep_wait(p.dep, 96);
    ph_norm1(p, 0, bid, nb, sm);
    xcd_barrier(xb);
#ifdef PROBE_INIT
    ph_init(p, bid, nb, sm); xcd_barrier(xb); ph_init(p, bid, nb, sm); xcd_barrier(xb);
#endif
#define PH(n, l) run_phase(p, n, l, bid, nb, sm); xcd_barrier(xb);
#define PHN(n, l) run_phase(p, n, l, bid, nb, sm);
#ifndef PROBE_X
#define PROBE_X(n, l)
#endif
#define LAYER(l) PH(1, l) PROBE_X(1, l) PH(2, l) PROBE_X(2, l) PHN(4, l) PHN(6, l) PH(5, l) PROBE_X(4, l) PROBE_X(5, l) PROBE_X(3, l) PROBE_X(6, l) \
    PH(7, l) PROBE_X(7, l) PROBE_X(70, l) PROBE_X(71, l) PH(8, l) PROBE_X(8, l) PH(9, l) PROBE_X(9, l) PH(10, l) PH(11, l) PH(12, l) PROBE_X(12, l) \
    PH(13, l) PROBE_X(13, l) PH(14, l)
    LAYER(0)
#undef LAYER
#define LAYER(l) PH(1, l) PROBE_X(1, l) PH(2, l) PROBE_X(2, l) PHN(4, l) PHN(6, l) PH(5, l) PROBE_X(4, l) PROBE_X(5, l) PROBE_X(3, l) PROBE_X(6, l) \
    PH(7, l) PROBE_X(7, l) PROBE_X(70, l) PROBE_X(71, l) PH(8, l) PROBE_X(8, l) PH(9, l) PROBE_X(9, l) PH(10, l) PROBE_X(110, l) PH(11, l) PROBE_X(111, l) PH(12, l) PROBE_X(12, l) \
    PH(13, l) PROBE_X(13, l) PH(14, l) PROBE_X(114, l)
    LAYER(1)
}

extern "C" void kernel_launch(void* const* d_in, const int* in_sizes, int n_in, void* d_out, int out_size,
                              void* d_ws, size_t ws_size, hipStream_t stream) {
    WsLayout w = ws_layout();
    if (ws_size < w.total) { fprintf(stderr, "ws too small: need %zu have %zu\n", w.total, ws_size); return; }
    static int grid_blocks = 0;
    if (!grid_blocks) {
        int dev = 0, cus = 0, per_cu = 0;
        (void)hipGetDevice(&dev);
        (void)hipDeviceGetAttribute(&cus, hipDeviceAttributeMultiprocessorCount, dev);
        (void)hipOccupancyMaxActiveBlocksPerMultiprocessor(&per_cu, fwd_megakernel, 256, 0);
        if (per_cu < 1) per_cu = 1;
        grid_blocks = cus * per_cu;
    }
    Params p{};
    fill_params(p, d_in, d_out, d_ws);
    (void)hipMemsetAsync(p.bar, 0, XCD_BAR_WORDS * 4 + 256, stream);
    void* args[] = {&p};
    hipError_t e = hipLaunchCooperativeKernel((void*)fwd_megakernel, dim3(grid_blocks), dim3(256), args, 0, stream);
    if (e != hipSuccess) fprintf(stderr, "cooperative launch failed: %s (grid %d)\n", hipGetErrorString(e), grid_blocks);
}
#endif
```

```cpp
#ifndef CPU_EMU
#include <hip/hip_runtime.h>
#include <hip/hip_cooperative_groups.h>
#include <cstdio>
namespace cg = cooperative_groups;
#define HD __device__ __forceinline__
__device__ __forceinline__ int tid_() { int v = threadIdx.x; asm volatile("" : "+v"(v)); return v; }
#define THREADS(t, n) for (int t = tid_(); t < (n); t += 256)
#define SYNC __syncthreads();
#define COSPI(x) cospif(x)
#define SINPI(x) sinpif(x)
typedef float4 f4;
#else
#include <cmath>
#include <cstdio>
#include <cstring>
#include <cstddef>
#define HD inline
#define THREADS(t, n) for (int t = 0; t < (n); ++t)
#define SYNC
#define COSPI(x) ((float)cos(M_PI * (double)(x)))
#define SINPI(x) ((float)sin(M_PI * (double)(x)))
struct f4 { float x, y, z, w; };
#endif

#ifndef SEQ
#define SEQ 8192
#endif
#ifndef CTXL
#define CTXL 256
#endif

typedef unsigned short bf16;
#ifndef CPU_EMU
typedef __attribute__((ext_vector_type(8))) short bf16x8_t;
typedef __attribute__((ext_vector_type(4))) float f32x4_t;
typedef __attribute__((ext_vector_type(4))) int i32x4_t;
#define ATOMIC_ADD_RET(ptr, v) atomicAdd((ptr), (v))
#else
HD int atomic_add_ret_(int* p, int v) { int old;
#pragma omp atomic capture
    { old = *p; *p += v; }
    return old; }
#define ATOMIC_ADD_RET(ptr, v) atomic_add_ret_((ptr), (v))
#endif
constexpr int NB = 2, D = 1024, GW = 64, ROWS = SEQ / GW;
constexpr int NLAT = NB * SEQ, NCTX = NB * CTXL, R = NLAT + NCTX;
constexpr int DIN = 6928;
constexpr int PLD = 2816;
constexpr int C_NAQ = 0, C_NAK = 256, C_NAV = 512, C_DAQ = 768, C_DAK = 1024, C_DAV = 1280, C_GQ = 1536, C_Z = 2304,
              C_F = 2560;
constexpr int WIN_N = 6912;
constexpr int WIN_NP = WIN_N + 64;
constexpr int PADROWS = 2 * R + 16 * 128;
constexpr int NCC = CTXL / 64, NCL = SEQ / 64, NCH = NCC + NCL;
constexpr int NUNIT = 2 * NB * 4 * NCH;
constexpr bool FOURIER_GEMM = (SEQ == 8192);
constexpr int SMEM_FLOATS = 73 * 256 + 4;

struct Params {
    const float* in[30];
    float* out;
    float* mods;
    float* cosT;
    float* sinT;
    float* cs;
    bf16* h;
    bf16* P;
    bf16* gq;
    float* gg;
    float* gbeta;
    bf16* fcs;
    bf16* cU;
    bf16* cW;
    bf16* cQK;
    float* cG;
    bf16* odir;
    bf16* br;
    bf16* mg;
    int* sel_e;
    float* sel_w;
    bf16* act;
    bf16* Y;
    bf16* wt_in;
    bf16* wt_br;
    bf16* wt_out;
    bf16* wt_gu;
    bf16* wt_d;
    int* cnt;
    int* dep;
    unsigned* bar;
    bf16* fa2;
    bf16* fW1;
    float* ropeT;
    bf16* fWA;
    bf16* fWB;
    bf16* fWC;
    bf16* fXC;
    int* elist;
    int* apos;
    int phase;
    int layer;
};

enum { I_X = 0, I_C, I_CTX, I_CCTX, I_WMOD, I_BMOD, I_N1G, I_N2G, I_WIN, I_NAQG, I_NAKG, I_RPB, I_DAQG, I_DAKG, I_LQ1, I_LK1,
       I_LQ2, I_LK2, I_SUBLN, I_CONVW, I_ALOG, I_DTB, I_ONORM, I_WBR, I_WOUT, I_WROUTER, I_RBIAS, I_MG, I_MU, I_MD };

HD float bf2f(bf16 v) { union { unsigned u; float f; } x; x.u = ((unsigned)v) << 16; return x.f; }
#ifndef CPU_EMU
typedef float f32x2_t __attribute__((ext_vector_type(2))); typedef __bf16 bf16x2_t __attribute__((ext_vector_type(2)));
typedef short s16x4_t __attribute__((ext_vector_type(4)));
typedef __attribute__((address_space(3))) const char* lds_cptr;
HD unsigned cvtpk(float lo, float hi) { f32x2_t v = {lo, hi}; bf16x2_t b = __builtin_convertvector(v, bf16x2_t); return __builtin_bit_cast(unsigned, b); }
HD bf16 f2bf(float f) { return (bf16)(cvtpk(f, 0.f) & 0xffffu); }
HD s16x4_t lds_tr16(lds_cptr p) { return __builtin_bit_cast(s16x4_t, __builtin_amdgcn_ds_read_tr16_b64_v4i16((__attribute__((address_space(3))) s16x4_t*)p)); }
#else
HD bf16 f2bf(float f) { union { unsigned u; float f; } x; x.f = f; unsigned u = x.u; u += 0x7fffu + ((u >> 16) & 1u); return (bf16)(u >> 16); }
#endif
HD float sigmoidf_(float x) { return 1.0f / (1.0f + expf(-x)); }
HD float siluf_(float x) { return x / (1.0f + expf(-x)); }

struct RowInfo { int seg, b, t, T, base; };
HD RowInfo rowinfo(int r) {
    RowInfo q;
    if (r < NLAT) { q.seg = 0; q.b = r / SEQ; q.t = r % SEQ; q.T = SEQ; q.base = q.b * SEQ; }
    else { int r2 = r - NLAT; q.seg = 1; q.b = r2 / CTXL; q.t = r2 % CTXL; q.T = CTXL; q.base = NLAT + q.b * CTXL; }
    return q;
}
HD const float* xrow_in(const Params& p, int l, int r) {
    if (r < NLAT) return (l == 0 ? p.in[I_X] : p.out) + (size_t)r * D;
    return p.cs + (size_t)(r - NLAT) * D;
}
HD float* xrow_out(const Params& p, int r) {
    if (r < NLAT) return p.out + (size_t)r * D;
    return p.cs + (size_t)(r - NLAT) * D;
}
HD const float* modrow(const Params& p, int l, int r) {
    int s = (r < NLAT) ? (r / SEQ) : 2;
    return p.mods + (size_t)(l * 3 + s) * 6144;
}
#ifndef CPU_EMU
HD unsigned char* gu8_of(const Params& p) { return (unsigned char*)p.wt_gu; }
HD unsigned char* d8_of(const Params& p) { return (unsigned char*)p.wt_gu + (size_t)16 * 1024 * 1024; }
HD unsigned char* h8_of(const Params& p) { return (unsigned char*)p.wt_gu + (size_t)16 * 1024 * 1024 + (size_t)16 * 1024 * 512; }
#endif
HD float lam_init_of(int l) { return l == 0 ? 0.2f : (0.8f - 0.6f * 0.7408182206817179f); }


#ifndef CPU_EMU
template <int NJ> struct AccT { f32x4_t v[4][NJ]; };
#define ACC_DECL(NJ, a) AccT<NJ> a
template <int NJ> HD void acc_zero(AccT<NJ>& a) {
#pragma unroll
    for (int i = 0; i < 4; ++i)
#pragma unroll
        for (int j = 0; j < NJ; ++j) a.v[i][j] = f32x4_t{0.f, 0.f, 0.f, 0.f};
}
#define ACC_FOR(NJ, row, col) { const int _t = tid_(); const int _ln = _t & 63, _w = _t >> 6; \
    _Pragma("unroll") for (int _i = 0; _i < 4; ++_i) _Pragma("unroll") for (int _j = 0; _j < NJ; ++_j) _Pragma("unroll") for (int _r = 0; _r < 4; ++_r) { \
    const int row = (_w >> 1) * 64 + _i * 16 + (_ln >> 4) * 4 + _r; const int col = (_w & 1) * (16 * NJ) + _j * 16 + (_ln & 15);
#define AV(a) a.v[_i][_j][_r]
#define ACC_END }}
#define ACC_FOR_PAIR(row, pcol) { const int _t = tid_(); const int _ln = _t & 63, _w = _t >> 6; \
    _Pragma("unroll") for (int _i = 0; _i < 4; ++_i) _Pragma("unroll") for (int _jj = 0; _jj < 2; ++_jj) _Pragma("unroll") for (int _r = 0; _r < 4; ++_r) { \
    const int row = (_w >> 1) * 64 + _i * 16 + (_ln >> 4) * 4 + _r; const int pcol = (_w & 1) * 32 + _jj * 16 + (_ln & 15);
#define AV_G(a) a.v[_i][2 * _jj][_r]
#define AV_U(a) a.v[_i][2 * _jj + 1][_r]

#define WAIT_VM0() asm volatile("s_waitcnt vmcnt(0)" ::: "memory")
#define GLDS16(gp, lp) __builtin_amdgcn_global_load_lds((const unsigned*)(gp), (unsigned*)(lp), 16, 0, 0)
template <int NJ, class AF, class BF>
HD void gemm_accum(AccT<NJ>& acc, AF arow, BF brow, int K, char* smem) {
    constexpr int NBL = NJ;
    const int t = tid_(), lane = t & 63, w = t >> 6, wr = w >> 1, wc = w & 1;
    const int lr = t >> 3, lc = t & 7;
    const bf16* ap[4]; const bf16* bp[NBL];
#pragma unroll
    for (int i = 0; i < 4; ++i) ap[i] = arow(lr + 32 * i) + ((lc ^ (lr & 7)) << 3);
#pragma unroll
    for (int i = 0; i < NBL; ++i) bp[i] = brow(lr + 32 * i) + ((lc ^ (lr & 7)) << 3);
    char* sA = smem + w * 1024; char* sB = smem + 32768 + w * 1024;
    const int fr = lane & 15, fg = lane >> 4;
    const unsigned aoff0 = (wr * 64 + fr) * 128 + (((fg) ^ (fr & 7)) << 4);
    const unsigned aoff1 = (wr * 64 + fr) * 128 + (((4 + fg) ^ (fr & 7)) << 4);
    const unsigned boff0 = (wc * (16 * NJ) + fr) * 128 + (((fg) ^ (fr & 7)) << 4);
    const unsigned boff1 = (wc * (16 * NJ) + fr) * 128 + (((4 + fg) ^ (fr & 7)) << 4);
    const int KT = K >> 6;
    __syncthreads();
#pragma unroll
    for (int i = 0; i < 4; ++i) GLDS16(ap[i], sA + 4096 * i);
#pragma unroll
    for (int i = 0; i < NBL; ++i) GLDS16(bp[i], sB + 4096 * i);
    WAIT_VM0();
    __syncthreads();
#pragma unroll 1
    for (int kt = 0; kt < KT; ++kt) {
        const int cur = kt & 1;
        if (kt + 1 < KT) {
#pragma unroll
            for (int i = 0; i < 4; ++i) GLDS16(ap[i] + (kt + 1) * 64, sA + (cur ^ 1) * 16384 + 4096 * i);
#pragma unroll
            for (int i = 0; i < NBL; ++i) GLDS16(bp[i] + (kt + 1) * 64, sB + (cur ^ 1) * 16384 + 4096 * i);
        }
        const char* cA = smem + cur * 16384; const char* cB = smem + 32768 + cur * 16384;
#pragma unroll
        for (int s = 0; s < 2; ++s) {
            bf16x8_t af[4], bfr[NJ];
#pragma unroll
            for (int i = 0; i < 4; ++i) af[i] = *(const bf16x8_t*)(cA + (s ? aoff1 : aoff0) + i * 2048);
#pragma unroll
            for (int j = 0; j < NJ; ++j) bfr[j] = *(const bf16x8_t*)(cB + (s ? boff1 : boff0) + j * 2048);
#pragma unroll
            for (int i = 0; i < 4; ++i)
#pragma unroll
                for (int j = 0; j < NJ; ++j) acc.v[i][j] = __builtin_amdgcn_mfma_f32_16x16x32_bf16(af[i], bfr[j], acc.v[i][j], 0, 0, 0);
        }
        WAIT_VM0();
        __syncthreads();
    }
}
template <int NJ> HD void acc_to_lds(const AccT<NJ>& acc, float* tl) {
    const int t = tid_(), lane = t & 63, w = t >> 6;
    constexpr int LD = 32 * NJ + 4;
    float* base = tl + ((w >> 1) * 64 + (lane >> 4) * 4) * LD + (w & 1) * (16 * NJ) + (lane & 15);
#pragma unroll
    for (int i = 0; i < 4; ++i)
#pragma unroll
        for (int j = 0; j < NJ; ++j)
#pragma unroll
            for (int r = 0; r < 4; ++r) base[(i * 16 + r) * LD + j * 16] = acc.v[i][j][r];
}
typedef int i32x8_t __attribute__((ext_vector_type(8)));
typedef unsigned char u8;
template <int NJ, class AF, class BF>
HD void gemm_accum8(AccT<NJ>& acc, AF arow, BF brow, int K, char* smem, int sa, int sb) {
    constexpr int NBL = NJ;
    const int t = tid_(), lane = t & 63, w = t >> 6, wr = w >> 1, wc = w & 1;
    const int lr = t >> 3, lc = t & 7;
    const u8* ap[4]; const u8* bp[NBL];
#pragma unroll
    for (int i = 0; i < 4; ++i) ap[i] = arow(lr + 32 * i) + ((lc ^ (lr & 7)) << 4);
#pragma unroll
    for (int i = 0; i < NBL; ++i) bp[i] = brow(lr + 32 * i) + ((lc ^ (lr & 7)) << 4);
    char* sA = smem + w * 1024; char* sB = smem + 32768 + w * 1024;
    const int fr = lane & 15, fg = lane >> 4;
    const unsigned aoff0 = (wr * 64 + fr) * 128 + (((2 * fg) ^ (fr & 7)) << 4);
    const unsigned aoff1 = (wr * 64 + fr) * 128 + (((2 * fg + 1) ^ (fr & 7)) << 4);
    const unsigned boff0 = (wc * (16 * NJ) + fr) * 128 + (((2 * fg) ^ (fr & 7)) << 4);
    const unsigned boff1 = (wc * (16 * NJ) + fr) * 128 + (((2 * fg + 1) ^ (fr & 7)) << 4);
    const int KT = K >> 7;
    __syncthreads();
#pragma unroll
    for (int i = 0; i < 4; ++i) GLDS16(ap[i], sA + 4096 * i);
#pragma unroll
    for (int i = 0; i < NBL; ++i) GLDS16(bp[i], sB + 4096 * i);
    WAIT_VM0();
    __syncthreads();
#pragma unroll 1
    for (int kt = 0; kt < KT; ++kt) {
        const int cur = kt & 1;
        if (kt + 1 < KT) {
#pragma unroll
            for (int i = 0; i < 4; ++i) GLDS16(ap[i] + (kt + 1) * 128, sA + (cur ^ 1) * 16384 + 4096 * i);
#pragma unroll
            for (int i = 0; i < NBL; ++i) GLDS16(bp[i] + (kt + 1) * 128, sB + (cur ^ 1) * 16384 + 4096 * i);
        }
        const char* cA = smem + cur * 16384; const char* cB = smem + 32768 + cur * 16384;
        i32x8_t af[4], bfr[NJ];
#pragma unroll
        for (int i = 0; i < 4; ++i) {
            const i32x4_t lo = *(const i32x4_t*)(cA + aoff0 + i * 2048), hi = *(const i32x4_t*)(cA + aoff1 + i * 2048);
            af[i] = i32x8_t{lo[0], lo[1], lo[2], lo[3], hi[0], hi[1], hi[2], hi[3]};
        }
#pragma unroll
        for (int j = 0; j < NJ; ++j) {
            const i32x4_t lo = *(const i32x4_t*)(cB + boff0 + j * 2048), hi = *(const i32x4_t*)(cB + boff1 + j * 2048);
            bfr[j] = i32x8_t{lo[0], lo[1], lo[2], lo[3], hi[0], hi[1], hi[2], hi[3]};
        }
#pragma unroll
        for (int i = 0; i < 4; ++i)
#pragma unroll
            for (int j = 0; j < NJ; ++j) acc.v[i][j] = __builtin_amdgcn_mfma_scale_f32_16x16x128_f8f6f4(af[i], bfr[j], acc.v[i][j], 0, 0, 0, sa, 0, sb);
        WAIT_VM0();
        __syncthreads();
    }
}
HD unsigned pack_fp8x4(float a, float b, float c, float d) {
    a = __builtin_amdgcn_fmed3f(a, -448.f, 448.f); b = __builtin_amdgcn_fmed3f(b, -448.f, 448.f);
    c = __builtin_amdgcn_fmed3f(c, -448.f, 448.f); d = __builtin_amdgcn_fmed3f(d, -448.f, 448.f);
    int w = 0;
    w = __builtin_amdgcn_cvt_pk_fp8_f32(a, b, w, false);
    w = __builtin_amdgcn_cvt_pk_fp8_f32(c, d, w, true);
    return (unsigned)w;
}
constexpr int SC_H = 0x7d7d7d7d;
constexpr int SC_W = 0x7a7a7a7a;
constexpr int SC_ACT = 0x7b7b7b7b;
template <int NJ, class AF, class BF>
HD void gemm_stage0(AF arow, BF brow, int ebytes, char* smem, int buf) {
    const int t = tid_(), w = t >> 6, lr = t >> 3, lc = t & 7;
    char* sA = smem + w * 1024 + buf * 16384; char* sB = smem + 32768 + w * 1024 + buf * 16384;
    (void)ebytes;
#pragma unroll
    for (int i = 0; i < 4; ++i) GLDS16((const char*)arow(lr + 32 * i) + ((lc ^ (lr & 7)) << 4), sA + 4096 * i);
#pragma unroll
    for (int i = 0; i < NJ; ++i) GLDS16((const char*)brow(lr + 32 * i) + ((lc ^ (lr & 7)) << 4), sB + 4096 * i);
}
template <int NJ, bool FP8, class AF, class BF, class NF>
HD void gemm_chain(AccT<NJ>& acc, AF arow, BF brow, int K, char* smem, int& cur, NF next_stage, int sa, int sb) {
    const int t = tid_(), lane = t & 63, w = t >> 6, wr = w >> 1, wc = w & 1;
    const int lr = t >> 3, lc = t & 7;
    const char* ap[4]; const char* bp[NJ];
#pragma unroll
    for (int i = 0; i < 4; ++i) ap[i] = (const char*)arow(lr + 32 * i) + ((lc ^ (lr & 7)) << 4);
#pragma unroll
    for (int i = 0; i < NJ; ++i) bp[i] = (const char*)brow(lr + 32 * i) + ((lc ^ (lr & 7)) << 4);
    char* sA = smem + w * 1024; char* sB = smem + 32768 + w * 1024;
    const int fr = lane & 15, fg = lane >> 4;
    const unsigned rA = (wr * 64 + fr) * 128, rB = (wc * (16 * NJ) + fr) * 128;
    const int KT = K >> (FP8 ? 7 : 6);
#pragma unroll 1
    for (int kt = 0; kt < KT; ++kt) {
        WAIT_VM0();
        __syncthreads();
        if (kt + 1 < KT) {
#pragma unroll
            for (int i = 0; i < 4; ++i) GLDS16(ap[i] + (kt + 1) * 128, sA + (cur ^ 1) * 16384 + 4096 * i);
#pragma unroll
            for (int i = 0; i < NJ; ++i) GLDS16(bp[i] + (kt + 1) * 128, sB + (cur ^ 1) * 16384 + 4096 * i);
        } else next_stage(cur ^ 1);
        const char* cA = smem + cur * 16384; const char* cB = smem + 32768 + cur * 16384;
        if (FP8) {
            i32x8_t af[4], bfr[NJ];
#pragma unroll
            for (int i = 0; i < 4; ++i) {
                const i32x4_t lo = *(const i32x4_t*)(cA + rA + (((2 * fg) ^ (fr & 7)) << 4) + i * 2048), hi = *(const i32x4_t*)(cA + rA + (((2 * fg + 1) ^ (fr & 7)) << 4) + i * 2048);
                af[i] = i32x8_t{lo[0], lo[1], lo[2], lo[3], hi[0], hi[1], hi[2], hi[3]};
            }
#pragma unroll
            for (int j = 0; j < NJ; ++j) {
                const i32x4_t lo = *(const i32x4_t*)(cB + rB + (((2 * fg) ^ (fr & 7)) << 4) + j * 2048), hi = *(const i32x4_t*)(cB + rB + (((2 * fg + 1) ^ (fr & 7)) << 4) + j * 2048);
                bfr[j] = i32x8_t{lo[0], lo[1], lo[2], lo[3], hi[0], hi[1], hi[2], hi[3]};
            }
#pragma unroll
            for (int i = 0; i < 4; ++i)
#pragma unroll
                for (int j = 0; j < NJ; ++j) acc.v[i][j] = __builtin_amdgcn_mfma_scale_f32_16x16x128_f8f6f4(af[i], bfr[j], acc.v[i][j], 0, 0, 0, sa, 0, sb);
        } else {
#pragma unroll
            for (int s_ = 0; s_ < 2; ++s_) {
                bf16x8_t af[4], bfr[NJ];
#pragma unroll
                for (int i = 0; i < 4; ++i) af[i] = *(const bf16x8_t*)(cA + rA + (((4 * s_ + fg) ^ (fr & 7)) << 4) + i * 2048);
#pragma unroll
                for (int j = 0; j < NJ; ++j) bfr[j] = *(const bf16x8_t*)(cB + rB + (((4 * s_ + fg) ^ (fr & 7)) << 4) + j * 2048);
#pragma unroll
                for (int i = 0; i < 4; ++i)
#pragma unroll
                    for (int j = 0; j < NJ; ++j) acc.v[i][j] = __builtin_amdgcn_mfma_f32_16x16x32_bf16(af[i], bfr[j], acc.v[i][j], 0, 0, 0);
            }
        }
        cur ^= 1;
    }
}
#else
template <int NJ> struct AccT { float v[128][32 * NJ]; };
#define ACC_DECL(NJ, a) static thread_local AccT<NJ> a
template <int NJ> HD void acc_zero(AccT<NJ>& a) { memset(a.v, 0, sizeof(a.v)); }
#define ACC_FOR(NJ, row, col) { for (int row = 0; row < 128; ++row) for (int col = 0; col < 32 * NJ; ++col) {
#define AV(a) a.v[row][col]
#define ACC_END }}
#define ACC_FOR_PAIR(row, pcol) { for (int row = 0; row < 128; ++row) for (int pcol = 0; pcol < 64; ++pcol) {
#define AV_G(a) a.v[row][(pcol / 16) * 32 + (pcol % 16)]
#define AV_U(a) a.v[row][(pcol / 16) * 32 + 16 + (pcol % 16)]
template <int NJ, class AF, class BF>
HD void gemm_accum(AccT<NJ>& acc, AF arow, BF brow, int K, char* smem) {
    for (int i = 0; i < 128; ++i) { const bf16* a = arow(i);
        for (int j = 0; j < 32 * NJ; ++j) { const bf16* b = brow(j); float s = 0.f;
            for (int k = 0; k < K; ++k) s += bf2f(a[k]) * bf2f(b[k]);
            acc.v[i][j] += s; } }
}
#endif

template <class DF>
HD void conv_tile(const float* src, size_t lds_, bf16* dst, size_t ldd, int k0, int nsrc0, DF drow, float* sm) {
    THREADS(t, 4096) { int kk = t >> 6, nn = t & 63; sm[kk * 65 + nn] = src[(size_t)(k0 + kk) * lds_ + nsrc0 + nn]; }
    SYNC
    THREADS(t, 4096) { int nn = t >> 6, kk = t & 63; dst[(size_t)drow(nn) * ldd + k0 + kk] = f2bf(sm[kk * 65 + nn]); }
    SYNC
}
#ifndef CPU_EMU
template <class DF>
HD void conv_tile8(const float* src, size_t lds_, unsigned char* dst, size_t ldd, int k0, int nsrc0, DF drow, float scale, float* sm) {
    THREADS(t, 4096) { int kk = t >> 6, nn = t & 63; sm[kk * 65 + nn] = src[(size_t)(k0 + kk) * lds_ + nsrc0 + nn] * scale; }
    SYNC
    THREADS(t, 1024) { int nn = t >> 4, k4 = (t & 15) * 4;
        *(unsigned*)(dst + (size_t)drow(nn) * ldd + k0 + k4) = pack_fp8x4(sm[k4 * 65 + nn], sm[(k4 + 1) * 65 + nn], sm[(k4 + 2) * 65 + nn], sm[(k4 + 3) * 65 + nn]); }
    SYNC
}
HD void convert_moe(const Params& p, int l, int bid, int nb, float* sm) {
    for (int w = bid; w < 4096 + 2048; w += nb) {
        if (w < 4096) {
            int nt = w & 7, kt = (w >> 3) & 15, gu = (w >> 7) & 1, e = w >> 8;
            const float* src = p.in[gu ? I_MU : I_MG] + (size_t)(l * 16 + e) * D * 512;
            conv_tile8(src, 512, gu8_of(p) + (size_t)e * 1024 * D, D, kt * 64, nt * 64, [&](int nn) { int j = nt * 64 + nn; return (j >> 4) * 32 + (j & 15) + 16 * gu; }, 32.0f, sm);
        } else {
            int w2 = w - 4096; int nt = w2 & 15, kt = (w2 >> 4) & 7, e = w2 >> 7;
            const float* src = p.in[I_MD] + (size_t)(l * 16 + e) * 512 * D;
            conv_tile8(src, D, d8_of(p) + (size_t)e * D * 512, 512, kt * 64, nt * 64, [&](int nn) { return nt * 64 + nn; }, 32.0f, sm);
        }
    }
}
#else
HD void convert_moe(const Params& p, int l, int bid, int nb, float* sm) {
    for (int w = bid; w < 4096 + 2048; w += nb) {
        if (w < 4096) {
            int nt = w & 7, kt = (w >> 3) & 15, gu = (w >> 7) & 1, e = w >> 8;
            const float* src = p.in[gu ? I_MU : I_MG] + (size_t)(l * 16 + e) * D * 512;
            bf16* dst = p.wt_gu + (size_t)e * 1024 * D;
            conv_tile(src, 512, dst, D, kt * 64, nt * 64, [&](int nn) { int j = nt * 64 + nn; return (j >> 4) * 32 + (j & 15) + 16 * gu; }, sm);
        } else {
            int w2 = w - 4096; int nt = w2 & 15, kt = (w2 >> 4) & 7, e = w2 >> 7;
            const float* src = p.in[I_MD] + (size_t)(l * 16 + e) * 512 * D;
            bf16* dst = p.wt_d + (size_t)e * D * 512;
            conv_tile(src, D, dst, 512, kt * 64, nt * 64, [&](int nn) { return nt * 64 + nn; }, sm);
        }
    }
}
#endif
HD void convert_static(const Params& p, int bid, int nb, float* sm, int part) {
    for (int w = bid; w < 3456 + 512 + 512 + 32; w += nb) {
        {
            const bool is_win = (w < 3456), is_ab = (w >= 3456 + 512 + 512);
            const int wl = is_win ? (w / (108 * 16)) : (is_ab ? ((w - 3456 - 512 - 512) >> 4) : 1);
            const bool early = (is_win || is_ab) && wl == 0;
            if ((part == 0) != early) continue;
        }
        if (w >= 3456 + 512 + 512) {
            int w2 = w - 3456 - 512 - 512; int kt = w2 & 15, l = w2 >> 4;
            conv_tile(p.in[I_WIN] + (size_t)l * D * DIN, DIN, p.wt_in + (size_t)l * WIN_NP * D, D, kt * 64, 2560, [&](int nn) { return WIN_N + nn; }, sm);
        } else if (w < 3456) {
            int nt = w % 108, kt = (w / 108) & 15, l = w / (108 * 16);
            int n0 = nt * 64;
#ifndef CPU_EMU
            if (n0 >= PLD) {
                conv_tile8(p.in[I_WIN] + (size_t)l * D * DIN, DIN, (unsigned char*)(p.wt_in + (size_t)l * WIN_NP * D + (size_t)PLD * D), D, kt * 64, n0 + 16,
                           [&](int nn) { return n0 - PLD + nn; }, 32.0f, sm);
                continue;
            }
#endif
            conv_tile(p.in[I_WIN] + (size_t)l * D * DIN, DIN, p.wt_in + (size_t)l * WIN_NP * D, D, kt * 64, n0 < 2560 ? n0 : n0 + 16,
                      [&](int nn) { return n0 + nn; }, sm);
        } else if (w < 3456 + 512) {
            int w2 = w - 3456; int nt = w2 & 15, kt = (w2 >> 4) & 3, li = w2 >> 6;
            conv_tile(p.in[I_WBR] + (size_t)li * 256 * D, D, p.wt_br + (size_t)li * D * 256, 256, kt * 64, nt * 64, [&](int nn) { return nt * 64 + nn; }, sm);
        } else {
            int w2 = w - 3456 - 512; int nt = w2 & 15, kt = (w2 >> 4) & 15, l = w2 >> 8;
            conv_tile(p.in[I_WOUT] + (size_t)l * D * D, D, p.wt_out + (size_t)l * D * D, D, kt * 64, nt * 64, [&](int nn) { return nt * 64 + nn; }, sm);
        }
    }
}

#ifndef CPU_EMU
HD void dep_signal(int* cnt) {
    asm volatile("s_waitcnt vmcnt(0)" ::: "memory");
    __syncthreads();
    if (tid_() == 0) {
        __builtin_amdgcn_fence(__ATOMIC_RELEASE, "agent");
        asm volatile("s_waitcnt vmcnt(0)" ::: "memory");
        (void)__hip_atomic_fetch_add(cnt, 1, __ATOMIC_RELAXED, __HIP_MEMORY_SCOPE_AGENT);
    }
}
HD void dep_wait(int* cnt, int target) {
    if (tid_() == 0) {
        unsigned sp = 0;
        while (__hip_atomic_load(cnt, __ATOMIC_RELAXED, __HIP_MEMORY_SCOPE_AGENT) < target) { __builtin_amdgcn_s_sleep(4); if (++sp > (1u << 22)) break; }
        __builtin_amdgcn_fence(__ATOMIC_ACQUIRE, "agent");
        asm volatile("s_waitcnt vmcnt(0)" ::: "memory");
    }
    __syncthreads();
}
#endif
HD void init_tables(const Params& p, int bid, int nb) {
    for (int u = bid; u < (SEQ + 255) / 256; u += nb) {
        THREADS(t, 256) {
            int j = u * 256 + t;
            if (j < SEQ) { float a = 2.0f * (float)j / (float)SEQ; p.cosT[j] = COSPI(a); p.sinT[j] = SINPI(a); }
        }
    }
    if (bid == 0) {
        THREADS(t, 1024) {
            int pos = t >> 3, f = t & 7; float fr_ = 1.0f;
            for (int q = 0; q < f; ++q) fr_ *= 0.31622776601683794f;
            float ang = (float)pos * fr_;
            p.ropeT[t * 2] = cosf(ang); p.ropeT[t * 2 + 1] = sinf(ang);
        }
    }
    for (int u = bid; u < (CTXL * 2 * CTXL) / 256; u += nb) {
        THREADS(t, 256) {
            int i = u * 256 + t; int k = i / (2 * CTXL), q = i % (2 * CTXL); int cs = q / CTXL, tt = q % CTXL;
            float a = 2.0f * (float)((k * tt) % CTXL) / (float)CTXL;
            p.fWC[i] = f2bf(cs ? -SINPI(a) : COSPI(a));
        }
    }
    for (int u = bid; u < (8192 + 65536 + 8192) / 256; u += nb) {
        THREADS(t, 256) {
            int i = u * 256 + t;
            if (i < 8192) {
                int j = i >> 6, c = i & 63; int cs = j >> 6, m = j & 63;
                float a = 2.0f * (float)((m * c) & 63) / 64.0f;
                p.fW1[i] = f2bf(cs ? SINPI(a) : COSPI(a));
            } else if (i < 8192 + 65536) {
                int q = i - 8192; int n = q >> 8, k = q & 255;
                int ri = (n >> 4) & 1, k1 = (n >> 5) * 16 + (n & 15); int cs = k >> 7, t1 = k & 127;
                float a = 2.0f * (float)((k1 * t1) & 127) / 128.0f;
                float cv = COSPI(a), sv = SINPI(a);
                float v = (ri == 0) ? (cs == 0 ? cv : -sv) : (cs == 0 ? -sv : -cv);
                p.fWA[q] = f2bf(v);
            } else {
                int q = i - 8192 - 65536; int k2 = q >> 7, k = q & 127; int ri = k >> 6, t2 = k & 63;
                float a = 2.0f * (float)((k2 * t2) & 63) / 64.0f;
                p.fWB[q] = f2bf(ri ? SINPI(a) : COSPI(a));
            }
        }
    }
}

HD void ph_init(const Params& p, int bid, int nb, float* sm) {
    const int NMOD = 2 * 3 * 6144;
    if (bid == 0) { THREADS(t, 32) { p.cnt[t] = 0; } }
#ifndef CPU_EMU
    {
        const int tq = tid_(); const int col = tq & 63, ks = tq >> 6;
        for (int u = nb - 1 - bid; u < 2 * 96; u += nb) {
            const int l = u / 96, c0 = (u % 96) * 64;
            __syncthreads();
            for (int i = tq; i < 3 * D; i += 256) { const int s_ = i / D, k = i % D; const float cv = (s_ < 2) ? p.in[I_C][s_ * D + k] : p.in[I_CCTX][k]; sm[i] = siluf_(cv); }
            __syncthreads();
            const float* wp = p.in[I_WMOD] + (size_t)l * D * 6144 + (size_t)(ks * 256) * 6144 + c0 + col;
            float a0 = 0.f, a1 = 0.f, a2 = 0.f;
#pragma unroll 8
            for (int k = 0; k < 256; ++k) { const float wv = wp[(size_t)k * 6144]; a0 += sm[ks * 256 + k] * wv; a1 += sm[D + ks * 256 + k] * wv; a2 += sm[2 * D + ks * 256 + k] * wv; }
            float* red = sm + 3 * D;
            red[(ks * 3 + 0) * 64 + col] = a0; red[(ks * 3 + 1) * 64 + col] = a1; red[(ks * 3 + 2) * 64 + col] = a2;
            __syncthreads();
            if (tq < 192) {
                const int s_ = tq >> 6, cc = tq & 63;
                const float v = red[(0 * 3 + s_) * 64 + cc] + red[(1 * 3 + s_) * 64 + cc] + red[(2 * 3 + s_) * 64 + cc] + red[(3 * 3 + s_) * 64 + cc];
                p.mods[(size_t)(l * 3 + s_) * 6144 + c0 + cc] = v + p.in[I_BMOD][l * 6144 + c0 + cc];
            }
            if (l == 0) dep_signal(p.dep);
        }
    }
    convert_static(p, bid, nb, sm, 0);
#else
    convert_static(p, bid, nb, sm, 0);
    for (int u = bid; u < (NMOD + 255) / 256; u += nb) {
        THREADS(t, 256) {
            int idx = u * 256 + t;
            if (idx < NMOD) {
                int l = idx / (3 * 6144), s = (idx / 6144) % 3, col = idx % 6144;
                const float* cv = (s < 2) ? p.in[I_C] + s * D : p.in[I_CCTX];
                const float* w = p.in[I_WMOD] + (size_t)l * D * 6144 + col;
                float acc = 0.f;
                for (int k = 0; k < D; ++k) acc += siluf_(cv[k]) * w[(size_t)k * 6144];
                p.mods[idx] = acc + p.in[I_BMOD][l * 6144 + col];
            }
        }
    }
#endif
    init_tables(p, bid, nb);
    for (int u = bid; u < (NCTX * D) / 256; u += nb) {
        THREADS(t, 256) { int i = u * 256 + t; p.cs[i] = p.in[I_CTX][i]; }
    }

}

#ifndef CPU_EMU
HD float wave_sum(float v) {
#pragma unroll
    for (int o = 32; o >= 1; o >>= 1) v += __shfl_xor(v, o);
    return v;
}
HD void ph_norm1(const Params& p, int l, int bid, int nb, float* sm) {
    const int t = tid_(), lane = t & 63, w = t >> 6;
    const float* g = p.in[I_N1G] + l * D;
#pragma unroll 2
    for (int r = bid * 4 + w; r < R; r += nb * 4) {
        const float* x = xrow_in(p, l, r);
        const float* m = modrow(p, l, r);
        f32x4_t xv[4]; float ss = 0.f;
#pragma unroll
        for (int j = 0; j < 4; ++j) { xv[j] = *(const f32x4_t*)(x + j * 256 + lane * 4); ss += xv[j][0] * xv[j][0] + xv[j][1] * xv[j][1] + xv[j][2] * xv[j][2] + xv[j][3] * xv[j][3]; }
        ss = wave_sum(ss);
        const float rs = 1.0f / sqrtf(ss / D + 1e-6f);
#pragma unroll
        for (int j = 0; j < 4; ++j) {
            const int k = j * 256 + lane * 4;
            const f32x4_t gv = *(const f32x4_t*)(g + k), sc = *(const f32x4_t*)(m + 1024 + k), sh = *(const f32x4_t*)(m + k);
            float o[4];
#pragma unroll
            for (int q = 0; q < 4; ++q) o[q] = xv[j][q] * rs * gv[q] * (1.0f + sc[q]) + sh[q];
            uint2 pk; pk.x = cvtpk(o[0], o[1]); pk.y = cvtpk(o[2], o[3]);
            *(uint2*)(p.h + (size_t)r * D + k) = pk;
            *(unsigned*)(h8_of(p) + (size_t)r * D + k) = pack_fp8x4(o[0] * 4.f, o[1] * 4.f, o[2] * 4.f, o[3] * 4.f);
        }
    }
}
#else
HD void ph_norm1(const Params& p, int l, int bid, int nb, float* sm) {
    const float* g = p.in[I_N1G] + l * D;
    for (int r = bid; r < R; r += nb) {
        const float* x = xrow_in(p, l, r);
        const float* m = modrow(p, l, r);
        THREADS(t, 256) { float s = 0.f; for (int k = t; k < D; k += 256) s += x[k] * x[k]; sm[t] = s; }
        SYNC
        THREADS(t, 1) { float s = 0.f; for (int i = 0; i < 256; ++i) s += sm[i]; sm[256] = s; }
        SYNC
        THREADS(t, 256) {
            float rs = 1.0f / sqrtf(sm[256] / D + 1e-6f);
            for (int k = t; k < D; k += 256) {
                float v = x[k] * rs * g[k];
                p.h[(size_t)r * D + k] = f2bf(v * (1.0f + m[1024 + k]) + m[k]);
            }
        }
        SYNC
    }
}
#endif

HD void ph_inproj(const Params& p, int l, int bid, int nb, char* smc) {
    const bf16* Wt = p.wt_in + (size_t)l * WIN_NP * D;
    constexpr int NT = PLD / 128, MT = R / 128;
    for (int mt = bid; mt < MT; mt += nb) {
        ACC_DECL(2, acc); acc_zero(acc);
        gemm_accum<2>(acc, [&](int i) { return p.h + (size_t)(mt * 128 + i) * D; }, [&](int j) { return Wt + (size_t)(WIN_N + j) * D; }, D, smc);
        ACC_FOR(2, row, col) {
            const int r = mt * 128 + row;
            if (col < 8) {
                const float xx = AV(acc) + p.in[I_DTB][l * 8 + col];
                const float sp = xx > 20.f ? xx : log1pf(expf(xx));
                p.gg[(size_t)col * R + r] = -expf(p.in[I_ALOG][l * 8 + col]) * sp;
            } else if (col < 16) p.gbeta[(size_t)(col - 8) * R + r] = sigmoidf_(AV(acc));
        } ACC_END
    }
    for (int tile = bid; tile < MT * NT; tile += nb) {
        const int mt = tile / NT, nt = tile % NT;
        ACC_DECL(4, acc); acc_zero(acc);
        gemm_accum<4>(acc, [&](int i) { return p.h + (size_t)(mt * 128 + i) * D; }, [&](int j) { return Wt + (size_t)(nt * 128 + j) * D; }, D, smc);
#ifndef CPU_EMU
        {
            float* tl = (float*)smc;
            acc_to_lds<4>(acc, tl);
            __syncthreads();
            const int t_ = tid_(); const int row = t_ >> 1, half = t_ & 1;
            const int cb = nt * 128 + half * 64;
            float v[64];
#pragma unroll
            for (int q = 0; q < 16; ++q) { const f32x4_t x4 = *(const f32x4_t*)(tl + row * 132 + half * 64 + q * 4); v[q * 4] = x4[0]; v[q * 4 + 1] = x4[1]; v[q * 4 + 2] = x4[2]; v[q * 4 + 3] = x4[3]; }
            if (cb < 512) {
                const float* gn = (cb < 256 ? p.in[I_NAQG] : p.in[I_NAKG]) + l * 64;
                float ss = 0.f;
#pragma unroll
                for (int c = 0; c < 64; ++c) ss += v[c] * v[c];
                const float rs = __builtin_amdgcn_rsqf(ss * (1.0f / 64.0f) + 1e-6f) * ((cb < 256) ? 0.125f * 1.4426950408889634f : 1.0f);
#pragma unroll
                for (int c = 0; c < 64; ++c) v[c] *= rs * gn[c];
            } else if (cb >= 768 && cb < 1280) {
                const float* gn = (cb < 1024 ? p.in[I_DAQG] : p.in[I_DAKG]) + l * 32;
                const float qs = (cb < 1024) ? 0.17677669529663687f * 1.4426950408889634f : 1.0f;
#pragma unroll
                for (int gp = 0; gp < 2; ++gp) {
                    float ss = 0.f;
#pragma unroll
                    for (int c = 0; c < 32; ++c) ss += v[gp * 32 + c] * v[gp * 32 + c];
                    const float rs = __builtin_amdgcn_rsqf(ss * (1.0f / 32.0f) + 1e-6f) * qs;
#pragma unroll
                    for (int c = 0; c < 32; ++c) v[gp * 32 + c] *= rs * gn[c];
                }
                const int gr_ = mt * 128 + row;
                if (gr_ < NLAT) {
                    const int tt = gr_ % SEQ;
#pragma unroll
                    for (int a = 0; a < 2; ++a) {
                        const float pos = (float)(a == 0 ? tt / GW : tt % GW);
                        float frev = 0.15915494309189535f;
#pragma unroll
                        for (int f = 0; f < 8; ++f) {
                            const float cs = __builtin_amdgcn_cosf(pos * frev), sn = __builtin_amdgcn_sinf(pos * frev);
#pragma unroll
                            for (int gp = 0; gp < 2; ++gp) {
                                const int i1 = gp * 32 + a * 16 + f, i2 = i1 + 8;
                                const float x1 = v[i1], x2 = v[i2];
                                v[i1] = x1 * cs - x2 * sn; v[i2] = x2 * cs + x1 * sn;
                            }
                            frev *= 0.31622776601683794f;
                        }
                    }
                }
            }
            bf16* dst = p.P + (size_t)(mt * 128 + row) * PLD + cb;
#pragma unroll
            for (int q = 0; q < 8; ++q) {
                uint4 pk; pk.x = cvtpk(v[q * 8], v[q * 8 + 1]); pk.y = cvtpk(v[q * 8 + 2], v[q * 8 + 3]); pk.z = cvtpk(v[q * 8 + 4], v[q * 8 + 5]); pk.w = cvtpk(v[q * 8 + 6], v[q * 8 + 7]);
                *(uint4*)(dst + q * 8) = pk;
            }
        }
#else
        ACC_FOR(4, row, col) { p.P[(size_t)(mt * 128 + row) * PLD + nt * 128 + col] = f2bf(AV(acc)); } ACC_END
#endif
    }
}

HD void ph_prep(const Params& p, int l, int bid, int nb) {
#ifdef CPU_EMU
    {
        const float* naq = p.in[I_NAQG] + l * 64; const float* nak = p.in[I_NAKG] + l * 64;
        const float* daq = p.in[I_DAQG] + l * 32; const float* dak = p.in[I_DAKG] + l * 32;
        const int N = R * 24;
        for (int u = bid; u < (N + 255) / 256; u += nb) {
            THREADS(t, 256) {
                int idx = u * 256 + t;
                if (idx < N) {
                    int r = idx / 24, gidx = idx % 24;
                    if (gidx < 8) {
                        int isk = gidx >> 2, hd = gidx & 3;
                        bf16* ptr = p.P + (size_t)r * PLD + (isk ? C_NAK : C_NAQ) + hd * 64;
                        const float* g = isk ? nak : naq;
                        float ss = 0.f;
                        for (int d = 0; d < 64; ++d) { float v = bf2f(ptr[d]); ss += v * v; }
                        float rs = 1.0f / sqrtf(ss / 64.0f + 1e-6f);
#ifndef CPU_EMU
                        if (!isk) rs *= 0.125f * 1.4426950408889634f;
#endif
                        for (int d = 0; d < 64; ++d) ptr[d] = f2bf(bf2f(ptr[d]) * rs * g[d]);
                    } else {
                        int gi = gidx - 8; int isk = gi >> 3; int hm = gi & 7;
                        bf16* ptr = p.P + (size_t)r * PLD + (isk ? C_DAK : C_DAQ) + hm * 32;
                        const float* g = isk ? dak : daq;
                        float ss = 0.f;
                        for (int d = 0; d < 32; ++d) { float v = bf2f(ptr[d]); ss += v * v; }
                        float rs = 1.0f / sqrtf(ss / 32.0f + 1e-6f);
#ifndef CPU_EMU
                        if (!isk) rs *= 0.17677669529663687f * 1.4426950408889634f;
#endif
                        if (r < NLAT) {
                            int tt = r % SEQ; float prow = (float)(tt / GW), pcol = (float)(tt % GW);
                            for (int a = 0; a < 2; ++a) {
                                float pos = a == 0 ? prow : pcol;
                                float fr = 1.0f;
                                for (int f = 0; f < 8; ++f) {
                                    float ang = pos * fr;
                                    float cs = cosf(ang), sn = sinf(ang);
                                    int i1 = a * 16 + f, i2 = a * 16 + 8 + f;
                                    float x1 = bf2f(ptr[i1]) * rs * g[i1], x2 = bf2f(ptr[i2]) * rs * g[i2];
                                    ptr[i1] = f2bf(x1 * cs - x2 * sn);
                                    ptr[i2] = f2bf(x2 * cs + x1 * sn);
                                    fr *= 0.31622776601683794f;
                                }
                            }
                        } else {
                            for (int d = 0; d < 32; ++d) ptr[d] = f2bf(bf2f(ptr[d]) * rs * g[d]);
                        }
                    }
                }
            }
        }
    }
#endif
#ifndef CPU_EMU
    {
        const float* cw = p.in[I_CONVW] + (size_t)l * 5 * 768;
        const int N = R * 96;
#pragma unroll 2
        for (int idx = bid * 256 + tid_(); idx < N; idx += nb * 256) {
            const int r = idx / 96, q = idx % 96; const int ph = q >> 3, cg = q & 7; const int part = ph >> 2, hd = ph & 3;
            const RowInfo ri = rowinfo(r);
            const int ch0 = part * 256 + hd * 64 + cg * 8;
            float y[8];
#pragma unroll
            for (int c = 0; c < 8; ++c) y[c] = 0.f;
#pragma unroll
            for (int i = 0; i < 5; ++i) {
                const int tt = ri.t + i - 2;
                if (tt >= 0 && tt < ri.T) {
                    const uint4 raw = *(const uint4*)(p.P + (size_t)(ri.base + tt) * PLD + C_GQ + ch0);
                    const f32x4_t w0 = *(const f32x4_t*)(cw + i * 768 + ch0), w1 = *(const f32x4_t*)(cw + i * 768 + ch0 + 4);
                    y[0] += __uint_as_float(raw.x << 16) * w0[0]; y[1] += __uint_as_float(raw.x & 0xffff0000u) * w0[1];
                    y[2] += __uint_as_float(raw.y << 16) * w0[2]; y[3] += __uint_as_float(raw.y & 0xffff0000u) * w0[3];
                    y[4] += __uint_as_float(raw.z << 16) * w1[0]; y[5] += __uint_as_float(raw.z & 0xffff0000u) * w1[1];
                    y[6] += __uint_as_float(raw.w << 16) * w1[2]; y[7] += __uint_as_float(raw.w & 0xffff0000u) * w1[3];
                }
            }
            float ss = 0.f;
#pragma unroll
            for (int c = 0; c < 8; ++c) { y[c] = siluf_(y[c]); ss += y[c] * y[c]; }
            ss += __shfl_xor(ss, 1); ss += __shfl_xor(ss, 2); ss += __shfl_xor(ss, 4);
            float scl = 1.0f;
            if (part == 0) scl = 0.125f / sqrtf(ss + 1e-6f); else if (part == 1) scl = 1.0f / sqrtf(ss + 1e-6f);
            uint4 pk; pk.x = cvtpk(y[0] * scl, y[1] * scl); pk.y = cvtpk(y[2] * scl, y[3] * scl); pk.z = cvtpk(y[4] * scl, y[5] * scl); pk.w = cvtpk(y[6] * scl, y[7] * scl);
            *(uint4*)(p.gq + (size_t)r * 768 + ch0) = pk;
        }
    }
#else
    {
        const float* cw = p.in[I_CONVW] + (size_t)l * 5 * 768;
        const int N = R * 12;
        for (int u = bid; u < (N + 255) / 256; u += nb) {
            THREADS(t, 256) {
                int idx = u * 256 + t;
                if (idx < N) {
                    int r = idx / 12, ph = idx % 12; int part = ph >> 2, hd = ph & 3;
                    RowInfo ri = rowinfo(r);
                    int ch0 = part * 256 + hd * 64;
                    float ss = 0.f;
                    for (int pass = 0; pass < 2; ++pass) {
                        float scl = 1.0f;
                        if (pass == 1) { if (part == 0) scl = 0.125f / sqrtf(ss + 1e-6f); else if (part == 1) scl = 1.0f / sqrtf(ss + 1e-6f); }
                        if (pass == 0 && part == 2) continue;
                        for (int c = 0; c < 64; ++c) {
                            float y = 0.f;
                            for (int i = 0; i < 5; ++i) {
                                int tt = ri.t + i - 2;
                                if (tt >= 0 && tt < ri.T) y += bf2f(p.P[(size_t)(ri.base + tt) * PLD + C_GQ + ch0 + c]) * cw[i * 768 + ch0 + c];
                            }
                            y = siluf_(y);
                            if (pass == 0) ss += y * y; else p.gq[(size_t)r * 768 + ch0 + c] = f2bf(y * scl);
                        }
                    }
                }
            }
        }
    }
#endif
    {
        const int RQ = (l == 0) ? R : NLAT;
        for (int r = (FOURIER_GEMM ? RQ : 0) + bid; r < RQ; r += nb) {
            THREADS(t, 256) {
                int g = t >> 6, m = t & 63;
                const bf16* f = p.P + (size_t)r * PLD + C_F + g * 64;
                float fc = 0.f, fs = 0.f;
                for (int c = 0; c < 64; ++c) {
                    int ti = ((m * c) & 63) * (SEQ / 64);
                    float v = bf2f(f[c]);
                    fc += v * p.cosT[ti]; fs += v * p.sinT[ti];
                }
                p.fcs[(size_t)r * 512 + t] = f2bf(fc);
                p.fcs[(size_t)r * 512 + 256 + t] = f2bf(fs);
                if (FOURIER_GEMM && r >= NLAT) {
                    const int rc = r - NLAT; const int bb = rc / CTXL, tt = rc % CTXL;
                    bf16* xc = p.fXC + (((size_t)bb * 256 + t) * 2) * CTXL + tt;
                    xc[0] = f2bf(fc); xc[CTXL] = f2bf(fs);
                }
            }
        }
    }
}

#ifndef CPU_EMU
HD void ph_na(const Params& p, int l, int bid, int nb, char* smc) {
    const int t = tid_(), lane = t & 63, w = t >> 6, fr = lane & 15, fg = lane >> 4;
    const float* rpb = p.in[I_RPB] + (size_t)l * 4 * 15 * 31;
    float* sbias = (float*)(smc + 32768);
    const lds_cptr lds = (lds_cptr)smc;
    constexpr int WH = ROWS < 8 ? ROWS : 8;
    const int nlat = NB * ROWS * 4;
    const int nctx = (l == 0) ? NB * 4 * (CTXL / 64) : 0;
    const int lkey = t >> 3, lc = t & 7;
    const int ksrc = (lc ^ (lkey & 7)) << 3;
    const int vsrc = ((((lc >> 1) ^ ((lkey >> 1) & 3)) << 1) | (lc & 1)) << 3;
    for (int unit = bid; unit < nlat + nctx; unit += nb) {
        int b, hd, qrow, ntl, rs = 0, gr = 0;
        if (unit < nlat) {
            hd = unit & 3; const int br_ = unit >> 2; gr = br_ % ROWS; b = br_ / ROWS;
            qrow = b * SEQ + gr * GW + w * 16 + fr; ntl = WH;
            rs = gr - WH / 2; if (rs < 0) rs = 0; if (rs > ROWS - WH) rs = ROWS - WH;
        } else {
            const int u2 = unit - nlat; const int qt = u2 % (CTXL / 64); const int bh = u2 / (CTXL / 64); hd = bh & 3; b = bh >> 2;
            qrow = NLAT + b * CTXL + qt * 64 + w * 16 + fr; ntl = 0;
        }
        const int ntiles = ntl + NCC;
        const int qcol = w * 16 + fr;
        int cs0 = w * 16 - 8; if (cs0 < 0) cs0 = 0; if (cs0 > GW - 32) cs0 = GW - 32;
        int wsq = qcol - 8; if (wsq < 0) wsq = 0; if (wsq > GW - 16) wsq = GW - 16;
        bf16x8_t qf[2];
#pragma unroll
        for (int s_ = 0; s_ < 2; ++s_) qf[s_] = *(const bf16x8_t*)(p.P + (size_t)qrow * PLD + C_NAQ + hd * 64 + s_ * 32 + fg * 8);
        f32x4_t O[4];
#pragma unroll
        for (int d = 0; d < 4; ++d) O[d] = f32x4_t{0.f, 0.f, 0.f, 0.f};
        float ls = 0.f;
        auto keyrow = [&](int tt, int i) { return (tt < ntl) ? (b * SEQ + (rs + tt) * GW + i) : (NLAT + b * CTXL + (tt - ntl) * 64 + i); };
        char* ldst = smc + w * 1024;
        __syncthreads();
        for (int i = t; i < 15 * 31; i += 256) sbias[i] = rpb[hd * 465 + i] * 1.4426950408889634f;
#pragma unroll
        for (int i = 0; i < 2; ++i) {
            const bf16* src = p.P + (size_t)keyrow(0, lkey + 32 * i) * PLD + hd * 64;
            GLDS16(src + C_NAK + ksrc, ldst + 4096 * i); GLDS16(src + C_NAV + vsrc, ldst + 16384 + 4096 * i);
        }
        WAIT_VM0();
        __syncthreads();
        const int vkl = 4 * fg + (fr >> 2);
        const int vsw = (vkl >> 1) & 3;
        unsigned va[4];
#pragma unroll
        for (int d = 0; d < 4; ++d) va[d] = 16384 + vkl * 128 + ((((d ^ vsw) << 1) | ((fr & 3) >> 1)) << 4) + (fr & 1) * 8;
#pragma unroll 1
        for (int tt = 0; tt < ntiles; ++tt) {
            const int cur = tt & 1;
            if (tt + 1 < ntiles) {
#pragma unroll
                for (int i = 0; i < 2; ++i) {
                    const bf16* src = p.P + (size_t)keyrow(tt + 1, lkey + 32 * i) * PLD + hd * 64;
                    GLDS16(src + C_NAK + ksrc, ldst + (cur ^ 1) * 8192 + 4096 * i); GLDS16(src + C_NAV + vsrc, ldst + 16384 + (cur ^ 1) * 8192 + 4096 * i);
                }
            }
            const char* cK = smc + cur * 8192;
            const lds_cptr cV = lds + cur * 8192;
            const bool local = tt < ntl;
            const int kbase = local ? cs0 : 0;
            const int nkf = local ? 2 : 4;
            unsigned pb[2][4];
#pragma unroll
            for (int f = 0; f < 4; ++f) {
                if (f < nkf) {
                    const int key = kbase + f * 16 + fr;
                    const char* kp = cK + key * 128;
                    const bf16x8_t a0 = *(const bf16x8_t*)(kp + (((fg) ^ (fr & 7)) << 4));
                    const bf16x8_t a1 = *(const bf16x8_t*)(kp + (((4 + fg) ^ (fr & 7)) << 4));
                    f32x4_t S = __builtin_amdgcn_mfma_f32_16x16x32_bf16(a0, qf[0], f32x4_t{0.f, 0.f, 0.f, 0.f}, 0, 0, 0);
                    S = __builtin_amdgcn_mfma_f32_16x16x32_bf16(a1, qf[1], S, 0, 0, 0);
                    float e[4];
#pragma unroll
                    for (int r = 0; r < 4; ++r) {
                        float sv = S[r]; bool ok = true;
                        if (local) {
                            const int kc = kbase + f * 16 + 4 * fg + r;
                            ok = (unsigned)(kc - wsq) < 16u;
                            sv += sbias[((rs + tt) - gr + 7) * 31 + (ok ? (kc - qcol + 15) : 15)];
                        }
                        e[r] = ok ? __builtin_amdgcn_exp2f(sv) : 0.f;
                    }
                    ls += (e[0] + e[1]) + (e[2] + e[3]);
                    pb[f >> 1][(f & 1) * 2] = cvtpk(e[0], e[1]);
                    pb[f >> 1][(f & 1) * 2 + 1] = cvtpk(e[2], e[3]);
                }
            }
#pragma unroll
            for (int ks = 0; ks < 2; ++ks) {
                if (ks * 2 < nkf) {
#pragma unroll
                    for (int d = 0; d < 4; ++d) {
                        const s16x4_t lo = lds_tr16(cV + va[d] + (kbase + ks * 32) * 128);
                        const s16x4_t hi = lds_tr16(cV + va[d] + (kbase + ks * 32 + 16) * 128);
                        const bf16x8_t vf = bf16x8_t{lo[0], lo[1], lo[2], lo[3], hi[0], hi[1], hi[2], hi[3]};
                        const i32x4_t bi = i32x4_t{(int)pb[ks][0], (int)pb[ks][1], (int)pb[ks][2], (int)pb[ks][3]};
                        O[d] = __builtin_amdgcn_mfma_f32_16x16x32_bf16(vf, __builtin_bit_cast(bf16x8_t, bi), O[d], 0, 0, 0);
                    }
                }
            }
            WAIT_VM0();
            __syncthreads();
        }
        ls += __shfl_xor(ls, 16); ls += __shfl_xor(ls, 32);
        const float inv = 1.0f / ls;
        bf16* op = p.br + (size_t)qrow * D + hd * 64;
#pragma unroll
        for (int d = 0; d < 4; ++d) {
            uint2 pk; pk.x = cvtpk(O[d][0] * inv, O[d][1] * inv); pk.y = cvtpk(O[d][2] * inv, O[d][3] * inv);
            *(uint2*)(op + d * 16 + 4 * fg) = pk;
        }
    }
}
#else
HD void ph_na(const Params& p, int l, int bid, int nb, char*) {
    const float* rpb = p.in[I_RPB] + (size_t)l * 4 * 15 * 31;
    const int RQ = (l == 0) ? R : NLAT;
    const int N = RQ * 4;
    const int wh = ROWS < 8 ? ROWS : 8;
    for (int u = bid; u < (N + 255) / 256; u += nb) {
        THREADS(t, 256) {
            int idx = u * 256 + t;
            if (idx < N) {
                int hd = idx / RQ, r = idx % RQ;
                RowInfo ri = rowinfo(r);
                float q[64], o[64];
                const bf16* qp = p.P + (size_t)r * PLD + C_NAQ + hd * 64;
#pragma unroll
                for (int d = 0; d < 64; ++d) { q[d] = bf2f(qp[d]) * 0.125f; o[d] = 0.f; }
                float mx = -1e30f, lsum = 0.f;
                int nloc = 0, rs = 0, ws = 0, gr = 0, gc = 0;
                if (ri.seg == 0) {
                    gr = ri.t / GW; gc = ri.t % GW;
                    rs = gr - wh / 2; if (rs < 0) rs = 0; if (rs > ROWS - wh) rs = ROWS - wh;
                    ws = gc - 8; if (ws < 0) ws = 0; if (ws > GW - 16) ws = GW - 16;
                    nloc = wh * 16;
                }
                int ctxbase = NLAT + ri.b * CTXL;
                for (int kk = 0; kk < nloc + CTXL; ++kk) {
                    int kr; float bias = 0.f;
                    if (kk < nloc) {
                        int a = kk >> 4, c = kk & 15;
                        int krow = rs + a, kcol = ws + c;
                        kr = ri.base + krow * GW + kcol;
                        bias = rpb[(hd * 15 + (krow - gr + 7)) * 31 + (kcol - gc + 15)];
                    } else kr = ctxbase + (kk - nloc);
                    const bf16* kp = p.P + (size_t)kr * PLD + C_NAK + hd * 64;
                    float s = 0.f;
#pragma unroll
                    for (int d = 0; d < 64; ++d) s += q[d] * bf2f(kp[d]);
                    s += bias;
                    if (s > mx) { float f = expf(mx - s); lsum *= f;
#pragma unroll
                        for (int d = 0; d < 64; ++d) o[d] *= f;
                        mx = s; }
                    float e = expf(s - mx);
                    lsum += e;
                    const bf16* vp = p.P + (size_t)kr * PLD + C_NAV + hd * 64;
#pragma unroll
                    for (int d = 0; d < 64; ++d) o[d] += e * bf2f(vp[d]);
                }
                float inv = 1.0f / lsum;
                bf16* op = p.br + (size_t)r * D + hd * 64;
#pragma unroll
                for (int d = 0; d < 64; ++d) op[d] = f2bf(o[d] * inv);
            }
        }
    }
}

#endif

#ifndef CPU_EMU
HD void ph_da(const Params& p, int l, int bid, int nb, char* smc) {
    const int t = tid_(), lane = t & 63, w = t >> 6, fr = lane & 15, fg = lane >> 4;
    const float lam_init = lam_init_of(l);
    float s1 = 0.f, s2 = 0.f;
    for (int d = 0; d < 32; ++d) {
        s1 += p.in[I_LQ1][l * 32 + d] * p.in[I_LK1][l * 32 + d];
        s2 += p.in[I_LQ2][l * 32 + d] * p.in[I_LK2][l * 32 + d];
    }
    const float lam = expf(s1) - expf(s2) + lam_init;
    const float* sg = p.in[I_SUBLN] + l * 64;
    constexpr int NQT = SEQ / 128, NQC = CTXL / 128;
    const int nlat = NB * 4 * NQT;
    const int nctx = (l == 0) ? NB * 4 * NQC : 0;
    const lds_cptr lds = (lds_cptr)smc;
    for (int unit = bid; unit < nlat + nctx; unit += nb) {
        int b, hd, qrow0, kt0;
        if (unit < nlat) { const int qt = unit % NQT, bh = unit / NQT; hd = bh & 3; b = bh >> 2; qrow0 = b * SEQ + qt * 128; kt0 = 0; }
        else { const int u2 = unit - nlat; const int qt = u2 % NQC, bh = u2 / NQC; hd = bh & 3; b = bh >> 2; qrow0 = NLAT + b * CTXL + qt * 128; kt0 = NCL; }
        const int kt1 = NCL + NCC;
        bf16x8_t qf[2][2];
#pragma unroll
        for (int m = 0; m < 2; ++m)
#pragma unroll
            for (int n = 0; n < 2; ++n)
                qf[m][n] = *(const bf16x8_t*)(p.P + (size_t)(qrow0 + w * 32 + n * 16 + fr) * PLD + C_DAQ + hd * 64 + m * 32 + fg * 8);
        f32x4_t O[2][4][2];
#pragma unroll
        for (int m = 0; m < 2; ++m)
#pragma unroll
            for (int d = 0; d < 4; ++d)
#pragma unroll
                for (int n = 0; n < 2; ++n) O[m][d][n] = f32x4_t{0.f, 0.f, 0.f, 0.f};
        f32x4_t L5[2][2];
#pragma unroll
        for (int m = 0; m < 2; ++m)
#pragma unroll
            for (int n = 0; n < 2; ++n) L5[m][n] = f32x4_t{0.f, 0.f, 0.f, 0.f};
        const short one_ = (fr == 0) ? (short)0x3f80 : (short)0;
        const bf16x8_t onesf = bf16x8_t{one_, one_, one_, one_, one_, one_, one_, one_};
        const int lkey = t >> 3, lc = t & 7;
        const int ksrc = (lc ^ (lkey & 7)) << 3;
        const int vsrc = ((((lc >> 1) ^ ((lkey >> 1) & 3)) << 1) | (lc & 1)) << 3;
        auto keyrow = [&](int kt, int i) { return (kt < NCL) ? (b * SEQ + kt * 64 + i) : (NLAT + b * CTXL + (kt - NCL) * 64 + i); };
        char* ldst = smc + w * 1024;
        __syncthreads();
#pragma unroll
        for (int i = 0; i < 2; ++i) {
            const bf16* src = p.P + (size_t)keyrow(kt0, lkey + 32 * i) * PLD + hd * 64;
            GLDS16(src + C_DAK + ksrc, ldst + 4096 * i); GLDS16(src + C_DAV + vsrc, ldst + 16384 + 4096 * i);
        }
        WAIT_VM0();
        __syncthreads();
        const unsigned ka0 = fr * 128 + (((fg) ^ (fr & 7)) << 4);
        const unsigned ka1 = fr * 128 + (((4 + fg) ^ (fr & 7)) << 4);
        const int vkey = 4 * fg + (fr >> 2);
        const int vsw = (vkey >> 1) & 3;
        unsigned va[4];
#pragma unroll
        for (int d = 0; d < 4; ++d) va[d] = 16384 + vkey * 128 + ((((d ^ vsw) << 1) | ((fr & 3) >> 1)) << 4) + (fr & 1) * 8;
#pragma unroll 1
        for (int kt = kt0; kt < kt1; ++kt) {
            const int cur = (kt - kt0) & 1;
            if (kt + 1 < kt1) {
#pragma unroll
                for (int i = 0; i < 2; ++i) {
                    const bf16* src = p.P + (size_t)keyrow(kt + 1, lkey + 32 * i) * PLD + hd * 64;
                    GLDS16(src + C_DAK + ksrc, ldst + (cur ^ 1) * 8192 + 4096 * i); GLDS16(src + C_DAV + vsrc, ldst + 16384 + (cur ^ 1) * 8192 + 4096 * i);
                }
            }
            const char* cK = smc + cur * 8192;
            const lds_cptr cV = lds + cur * 8192;
#pragma unroll
            for (int m = 0; m < 2; ++m) {
                unsigned pb[2][2][4];
                {
                    f32x4_t S[4][2];
#pragma unroll
                    for (int kf = 0; kf < 4; ++kf) {
                        const bf16x8_t a = *(const bf16x8_t*)(cK + (m ? ka1 : ka0) + kf * 2048);
#pragma unroll
                        for (int n = 0; n < 2; ++n) S[kf][n] = __builtin_amdgcn_mfma_f32_16x16x32_bf16(a, qf[m][n], f32x4_t{0.f, 0.f, 0.f, 0.f}, 0, 0, 0);
                    }
#pragma unroll
                    for (int kf = 0; kf < 4; ++kf)
#pragma unroll
                        for (int n = 0; n < 2; ++n) {
                            const float e0 = __builtin_amdgcn_exp2f(S[kf][n][0]), e1 = __builtin_amdgcn_exp2f(S[kf][n][1]);
                            const float e2 = __builtin_amdgcn_exp2f(S[kf][n][2]), e3 = __builtin_amdgcn_exp2f(S[kf][n][3]);
                            pb[n][kf >> 1][(kf & 1) * 2] = cvtpk(e0, e1);
                            pb[n][kf >> 1][(kf & 1) * 2 + 1] = cvtpk(e2, e3);
                        }
                }
#pragma unroll
                for (int ks = 0; ks < 2; ++ks)
#pragma unroll
                    for (int d = 0; d < 4; ++d) {
                        const s16x4_t lo = lds_tr16(cV + va[d] + ks * 4096);
                        const s16x4_t hi = lds_tr16(cV + va[d] + ks * 4096 + 2048);
                        const bf16x8_t vf = bf16x8_t{lo[0], lo[1], lo[2], lo[3], hi[0], hi[1], hi[2], hi[3]};
#pragma unroll
                        for (int n = 0; n < 2; ++n) {
                            const i32x4_t bi = i32x4_t{(int)pb[n][ks][0], (int)pb[n][ks][1], (int)pb[n][ks][2], (int)pb[n][ks][3]};
                            O[m][d][n] = __builtin_amdgcn_mfma_f32_16x16x32_bf16(vf, __builtin_bit_cast(bf16x8_t, bi), O[m][d][n], 0, 0, 0);
                            if (d == 0) L5[m][n] = __builtin_amdgcn_mfma_f32_16x16x32_bf16(onesf, __builtin_bit_cast(bf16x8_t, bi), L5[m][n], 0, 0, 0);
                        }
                    }
                asm volatile("" ::: "memory");
            }
            WAIT_VM0();
            __syncthreads();
        }
#pragma unroll
        for (int n = 0; n < 2; ++n) {
            const float l0 = __shfl(L5[0][n][0], fr), l1 = __shfl(L5[1][n][0], fr);
            const float i0 = 1.0f / l0, i1 = lam / l1;
            float ss = 0.f;
#pragma unroll
            for (int d = 0; d < 4; ++d)
#pragma unroll
                for (int r = 0; r < 4; ++r) { const float o = O[0][d][n][r] * i0 - O[1][d][n][r] * i1; O[0][d][n][r] = o; ss += o * o; }
            ss += __shfl_xor(ss, 16); ss += __shfl_xor(ss, 32);
            const float rs = (1.0f - lam_init) / sqrtf(ss / 64.0f + 1e-6f);
            bf16* op = p.br + (size_t)(qrow0 + w * 32 + n * 16 + fr) * D + 256 + hd * 64;
#pragma unroll
            for (int d = 0; d < 4; ++d) {
                const int dv = d * 16 + 4 * fg;
                const unsigned lo = cvtpk(O[0][d][n][0] * rs * sg[dv], O[0][d][n][1] * rs * sg[dv + 1]);
                const unsigned hi = cvtpk(O[0][d][n][2] * rs * sg[dv + 2], O[0][d][n][3] * rs * sg[dv + 3]);
                uint2 pk; pk.x = lo; pk.y = hi;
                *(uint2*)(op + dv) = pk;
            }
        }
    }
}
#else
HD void ph_da(const Params& p, int l, int bid, int nb, char*) {
    const int RQ = (l == 0) ? R : NLAT;
    const int N = RQ * 4;
    const float lam_init = lam_init_of(l);
    float s1 = 0.f, s2 = 0.f;
    for (int d = 0; d < 32; ++d) {
        s1 += p.in[I_LQ1][l * 32 + d] * p.in[I_LK1][l * 32 + d];
        s2 += p.in[I_LQ2][l * 32 + d] * p.in[I_LK2][l * 32 + d];
    }
    const float lam = expf(s1) - expf(s2) + lam_init;
    const float* sg = p.in[I_SUBLN] + l * 64;
    const float scale = 0.17677669529663687f;
    for (int u = bid; u < (N + 255) / 256; u += nb) {
        THREADS(t, 256) {
            int idx = u * 256 + t;
            if (idx < N) {
                int hd = idx / RQ, r = idx % RQ;
                RowInfo ri = rowinfo(r);
                float q0[32], q1[32], o0[64], o1[64];
                const bf16* qp = p.P + (size_t)r * PLD + C_DAQ + hd * 64;
#pragma unroll
                for (int d = 0; d < 32; ++d) { q0[d] = bf2f(qp[d]) * scale; q1[d] = bf2f(qp[32 + d]) * scale; }
#pragma unroll
                for (int d = 0; d < 64; ++d) { o0[d] = 0.f; o1[d] = 0.f; }
                float m0 = -1e30f, m1 = -1e30f, l0 = 0.f, l1 = 0.f;
                int nlat = (ri.seg == 0) ? SEQ : 0;
                int latbase = ri.b * SEQ, ctxbase = NLAT + ri.b * CTXL;
                for (int kk = 0; kk < nlat + CTXL; ++kk) {
                    int kr = (kk < nlat) ? latbase + kk : ctxbase + (kk - nlat);
                    const bf16* kp = p.P + (size_t)kr * PLD + C_DAK + hd * 64;
                    const bf16* vp = p.P + (size_t)kr * PLD + C_DAV + hd * 64;
                    float sa = 0.f, sb = 0.f;
#pragma unroll
                    for (int d = 0; d < 32; ++d) { sa += q0[d] * bf2f(kp[d]); sb += q1[d] * bf2f(kp[32 + d]); }
                    if (sa > m0) { float f = expf(m0 - sa); l0 *= f;
#pragma unroll
                        for (int d = 0; d < 64; ++d) o0[d] *= f;
                        m0 = sa; }
                    if (sb > m1) { float f = expf(m1 - sb); l1 *= f;
#pragma unroll
                        for (int d = 0; d < 64; ++d) o1[d] *= f;
                        m1 = sb; }
                    float ea = expf(sa - m0), eb = expf(sb - m1);
                    l0 += ea; l1 += eb;
#pragma unroll
                    for (int d = 0; d < 64; ++d) { float v = bf2f(vp[d]); o0[d] += ea * v; o1[d] += eb * v; }
                }
                float i0 = 1.0f / l0, i1 = lam / l1;
                float ss = 0.f;
#pragma unroll
                for (int d = 0; d < 64; ++d) { o0[d] = o0[d] * i0 - o1[d] * i1; ss += o0[d] * o0[d]; }
                float rs = (1.0f - lam_init) / sqrtf(ss / 64.0f + 1e-6f);
                bf16* op = p.br + (size_t)r * D + 256 + hd * 64;
#pragma unroll
                for (int d = 0; d < 64; ++d) op[d] = f2bf(o0[d] * rs * sg[d]);
            }
        }
    }
}

#endif

struct ChunkInfo { int dir, b, hd, n, seg, T, base, nloc; };
HD ChunkInfo chunkinfo(int unit) {
    ChunkInfo c;
    c.n = unit % NCH; int ch = unit / NCH; c.hd = ch & 3; c.b = (ch >> 2) % NB; c.dir = ch / (4 * NB);
    if (c.n < NCC) { c.seg = 1; c.T = CTXL; c.base = NLAT + c.b * CTXL; c.nloc = c.n; }
    else { c.seg = 0; c.T = SEQ; c.base = c.b * SEQ; c.nloc = c.n - NCC; }
    return c;
}
HD int chunk_row(const ChunkInfo& c, int i) { int pf = c.nloc * 64 + i; return c.base + (c.dir ? (c.T - 1 - pf) : pf); }

#ifndef CPU_EMU
HD void ph_gdn_chunk(const Params& p, int l, int bid, int nb, float* smf) {
    const int t = tid_(), lane = t & 63, w = t >> 6, fr = lane & 15, fg = lane >> 4;
    const int usel = w >> 1, wh = w & 1;
    char* smc = (char*)smf + usel * 33792;
    float* sA = (float*)(smc + 16384); float* sG = (float*)(smc + 32768); float* sB = (float*)(smc + 33024); float* sE = (float*)(smc + 33280);
    const int tu = t & 127, lkey = tu >> 3, lc = tu & 7;
    const int ksrc = (lc ^ (lkey & 7)) << 3;
    char* ldst = smc + wh * 1024;
    for (int pi = bid; pi < NUNIT / 2; pi += nb) {
        const int unit = 2 * pi + usel;
        const ChunkInfo c = chunkinfo(unit);
        const int dh = c.dir * 4 + c.hd;
        __syncthreads();
#pragma unroll
        for (int i = 0; i < 4; ++i) {
            const bf16* src = p.gq + (size_t)chunk_row(c, lkey + 16 * i) * 768 + c.hd * 64;
            GLDS16(src + 256 + ksrc, ldst + 2048 * i);
            GLDS16(src + 512 + ksrc, ldst + 8192 + 2048 * i);
        }
        if (wh == 0) {
            const int row = chunk_row(c, lane);
            float x = p.gg[(size_t)dh * R + row];
#pragma unroll
            for (int off = 1; off < 64; off <<= 1) { const float y = __shfl_up(x, off); if (lane >= off) x += y; }
            const float ex = __expf(x);
            sG[lane] = x; sB[lane] = p.gbeta[(size_t)dh * R + row]; sE[lane] = 1.0f; sE[64 + lane] = ex;
            const float x63 = __shfl(x, 63);
            float* cg = p.cG + (size_t)unit * 192;
            cg[lane] = ex; cg[64 + lane] = __expf(x63 - x); cg[128 + lane] = __expf(x63);
        }
        bf16x8_t aq[2][2];
#pragma unroll
        for (int mi = 0; mi < 2; ++mi)
#pragma unroll
            for (int s_ = 0; s_ < 2; ++s_)
                aq[mi][s_] = *(const bf16x8_t*)(p.gq + (size_t)chunk_row(c, 32 * wh + 16 * mi + fr) * 768 + c.hd * 64 + 32 * s_ + 8 * fg);
        WAIT_VM0();
        __syncthreads();
        {
            const char* kt_ = smc;
            const unsigned c0 = ((fg) ^ (fr & 7)) << 4, c1 = ((4 + fg) ^ (fr & 7)) << 4;
            bf16x8_t b0[4], b1[4];
#pragma unroll
            for (int n = 0; n < 4; ++n) { b0[n] = *(const bf16x8_t*)(kt_ + (16 * n + fr) * 128 + c0); b1[n] = *(const bf16x8_t*)(kt_ + (16 * n + fr) * 128 + c1); }
#pragma unroll
            for (int mi = 0; mi < 2; ++mi) {
                const int r0 = 32 * wh + 16 * mi;
                const bf16x8_t ak0 = *(const bf16x8_t*)(kt_ + (r0 + fr) * 128 + c0), ak1 = *(const bf16x8_t*)(kt_ + (r0 + fr) * 128 + c1);
                float gi[4], bi[4];
#pragma unroll
                for (int r = 0; r < 4; ++r) { gi[r] = sG[r0 + 4 * fg + r]; bi[r] = sB[r0 + 4 * fg + r]; }
#pragma unroll
                for (int n = 0; n < 4; ++n) {
                    f32x4_t kk = __builtin_amdgcn_mfma_f32_16x16x32_bf16(ak0, b0[n], f32x4_t{0.f, 0.f, 0.f, 0.f}, 0, 0, 0);
                    kk = __builtin_amdgcn_mfma_f32_16x16x32_bf16(ak1, b1[n], kk, 0, 0, 0);
                    f32x4_t qk = __builtin_amdgcn_mfma_f32_16x16x32_bf16(aq[mi][0], b0[n], f32x4_t{0.f, 0.f, 0.f, 0.f}, 0, 0, 0);
                    qk = __builtin_amdgcn_mfma_f32_16x16x32_bf16(aq[mi][1], b1[n], qk, 0, 0, 0);
                    const int j = 16 * n + fr; const float gj = sG[j];
#pragma unroll
                    for (int r = 0; r < 4; ++r) {
                        const int i = r0 + 4 * fg + r;
                        const float dec = (j <= i) ? __expf(gi[r] - gj) : 0.f;
                        sA[i * 64 + j] = (j < i) ? kk[r] * bi[r] * dec : 0.f;
                        p.cQK[(size_t)unit * 4096 + i * 64 + j] = f2bf(qk[r] * dec);
                    }
                }
            }
        }
        __syncthreads();
        {
            float x[64];
            bf16* dst = (wh == 0 ? p.cU : p.cW) + (size_t)unit * 4096 + lane;
            const char* rt_ = smc + (wh == 0 ? 8192 : 0) + (lane & 7) * 2;
            const float* rs_ = sE + wh * 64;
            const int lch = lane >> 3;
#pragma unroll
            for (int i = 0; i < 64; ++i) {
                const float rhs = sB[i] * rs_[i] * bf2f(*(const bf16*)(rt_ + i * 128 + ((lch ^ (i & 7)) << 4)));
                float acc = rhs;
#pragma unroll
                for (int j4 = 0; j4 < i; j4 += 4) {
                    const f32x4_t a4 = *(const f32x4_t*)(sA + i * 64 + j4);
                    acc -= a4[0] * x[j4];
                    if (j4 + 1 < i) acc -= a4[1] * x[j4 + 1];
                    if (j4 + 2 < i) acc -= a4[2] * x[j4 + 2];
                    if (j4 + 3 < i) acc -= a4[3] * x[j4 + 3];
                }
                x[i] = acc;
                dst[i * 64] = f2bf(acc);
            }
        }
    }
}
#else
HD void ph_gdn_chunk(const Params& p, int l, int bid, int nb, float* sm) {
    float* sk = sm;
    float* sq = sm + 4096;
    float* sA = sm + 8192;
    float* sXu = sm + 12288;
    float* sXw = sm + 4096;
    float* sG = sm + 16384;
    float* sB = sm + 16448;
    for (int unit = bid; unit < NUNIT; unit += nb) {
        ChunkInfo c = chunkinfo(unit);
        int dh = c.dir * 4 + c.hd;
        THREADS(t, 4096) {
            int i = t >> 6, d = t & 63; int row = chunk_row(c, i);
            sq[t] = bf2f(p.gq[(size_t)row * 768 + c.hd * 64 + d]);
            sk[t] = bf2f(p.gq[(size_t)row * 768 + 256 + c.hd * 64 + d]);
        }
        THREADS(t, 1) {
            float acc = 0.f;
            for (int i = 0; i < 64; ++i) { int row = chunk_row(c, i); acc += p.gg[(size_t)dh * R + row]; sG[i] = acc; sB[i] = p.gbeta[(size_t)dh * R + row]; }
        }
        SYNC
        THREADS(t, 4096) {
            int i = t >> 6, j = t & 63;
            float kk = 0.f, qk = 0.f;
            for (int d = 0; d < 64; ++d) { kk += sk[i * 64 + d] * sk[j * 64 + d]; qk += sq[i * 64 + d] * sk[j * 64 + d]; }
            float dec = (j <= i) ? expf(sG[i] - sG[j]) : 0.f;
            sA[t] = (j < i) ? kk * sB[i] * dec : 0.f;
            p.cQK[(size_t)unit * 4096 + t] = f2bf(qk * dec);
        }
        SYNC
        THREADS(t, 4096) {
            int i = t >> 6, cc = t & 63; int row = chunk_row(c, i);
            sXu[t] = sB[i] * bf2f(p.gq[(size_t)row * 768 + 512 + c.hd * 64 + cc]);
            sXw[t] = sB[i] * expf(sG[i]) * sk[t];
        }
        SYNC
        for (int i = 1; i < 64; ++i) {
            THREADS(cc, 128) {
                float* X = (cc < 64) ? (sXu + cc) : (sXw + cc - 64);
                float acc = X[i * 64];
                for (int j = 0; j < i; ++j) acc -= sA[i * 64 + j] * X[j * 64];
                X[i * 64] = acc;
            }
            SYNC
        }
        THREADS(t, 4096) {
            p.cU[(size_t)unit * 4096 + t] = f2bf(sXu[t]);
            p.cW[(size_t)unit * 4096 + t] = f2bf(sXw[t]);
        }
        THREADS(t, 64) { p.cG[(size_t)unit * 64 + t] = sG[t]; }
        SYNC
    }
}

#endif

HD void ph_fourier2(const Params& p, int l, int bid, int nb) {
    const int RQ = (l == 0) ? R : NLAT;
    for (int r = (FOURIER_GEMM ? NLAT : 0) + bid; r < RQ; r += nb) {
        RowInfo ri = rowinfo(r);
        const float nrm = 1.0f / sqrtf((float)ri.T * 64.0f);
        const int mul = SEQ / ri.T;
        THREADS(ch, 256) {
            float acc = 0.f;
            for (int tt = 0; tt < ri.T; ++tt) {
                int ti = ((ri.t * tt) & (ri.T - 1)) * mul;
                const bf16* f = p.fcs + (size_t)(ri.base + tt) * 512;
                acc += p.cosT[ti] * bf2f(f[ch]) - p.sinT[ti] * bf2f(f[256 + ch]);
            }
            p.br[(size_t)r * D + 768 + ch] = f2bf(acc * nrm);
        }
    }
}


HD void ph_fourier_s1c(const Params& p, int bid, int nb, char* smc) {
    constexpr int MTc = CTXL / 128;
    for (int tile = bid; tile < NB * MTc * 4; tile += nb) {
        const int g = tile & 3, mtc = (tile >> 2) % MTc, b = tile / (4 * MTc);
        ACC_DECL(4, acc); acc_zero(acc);
        gemm_accum<4>(acc, [&](int i) { return p.P + (size_t)(NLAT + b * CTXL + mtc * 128 + i) * PLD + C_F + g * 64; },
                      [&](int j) { return p.fW1 + j * 64; }, 64, smc);
        ACC_FOR(4, row, col) {
            const int cs = col >> 6, m = col & 63;
            p.fXC[(((size_t)b * 256 + g * 64 + m) * 2 + cs) * CTXL + mtc * 128 + row] = f2bf(AV(acc));
        } ACC_END
    }
}
HD void ph_fourier_s1(const Params& p, int bid, int nb, char* smc) {
    for (int tile = bid; tile < NB * 64 * 4; tile += nb) {
        const int g = tile & 3, t2 = (tile >> 2) & 63, b = tile >> 8;
        ACC_DECL(4, acc); acc_zero(acc);
        gemm_accum<4>(acc, [&](int i) { return p.P + (size_t)(b * SEQ + 64 * i + t2) * PLD + C_F + g * 64; },
                      [&](int j) { return p.fW1 + j * 64; }, 64, smc);
#ifndef CPU_EMU
        {
            float* tl = (float*)smc;
            acc_to_lds<4>(acc, tl);
            __syncthreads();
            const int t_ = tid_(); const int col = t_ >> 1, half = t_ & 1;
            const int cs = col >> 6, m = col & 63;
            bf16* dst = p.fcs + ((((size_t)b * 256 + g * 64 + m) * 64 + t2) * 2 + cs) * 128 + half * 64;
#pragma unroll
            for (int q = 0; q < 8; ++q) {
                float v[8];
#pragma unroll
                for (int e = 0; e < 8; ++e) v[e] = tl[(half * 64 + q * 8 + e) * 132 + col];
                uint4 pk; pk.x = cvtpk(v[0], v[1]); pk.y = cvtpk(v[2], v[3]); pk.z = cvtpk(v[4], v[5]); pk.w = cvtpk(v[6], v[7]);
                *(uint4*)(dst + q * 8) = pk;
            }
        }
#else
        ACC_FOR(4, row, col) {
            const int cs = col >> 6, m = col & 63;
            p.fcs[((((size_t)b * 256 + g * 64 + m) * 64 + t2) * 2 + cs) * 128 + row] = f2bf(AV(acc));
        } ACC_END
#endif
    }
}
HD void ph_fourier_sA(const Params& p, int bid, int nb, char* smc) {
    for (int tile = bid; tile < NB * 128 * 2; tile += nb) {
        const int nt = tile & 1, mt = (tile >> 1) & 127, b = tile >> 8;
        ACC_DECL(4, acc); acc_zero(acc);
        gemm_accum<4>(acc, [&](int i) { return p.fcs + ((size_t)b * 16384 + mt * 128 + i) * 256; },
                      [&](int j) { return p.fWA + (size_t)(nt * 128 + j) * 256; }, 256, smc);
#ifndef CPU_EMU
        {
            float* tl = (float*)smc;
            acc_to_lds<4>(acc, tl);
            __syncthreads();
            const int t_ = tid_(); const int pcol = t_ >> 2, chl = (t_ >> 1) & 1, th = t_ & 1;
            const int k1 = nt * 64 + pcol; const int ch = mt * 2 + chl;
            const int cre = (pcol >> 4) * 32 + (pcol & 15), cim = cre + 16;
            bf16* o = p.fa2 + ((((size_t)b * 128 + k1) * 256 + ch) * 2) * 64 + th * 32;
#pragma unroll
            for (int q = 0; q < 4; ++q) {
                float vr[8], vi[8];
#pragma unroll
                for (int e = 0; e < 8; ++e) {
                    const int t2 = th * 32 + q * 8 + e;
                    const float re = tl[(chl * 64 + t2) * 132 + cre], im = tl[(chl * 64 + t2) * 132 + cim];
                    const float c = p.cosT[k1 * t2], sn = p.sinT[k1 * t2];
                    vr[e] = re * c + im * sn; vi[e] = im * c - re * sn;
                }
                uint4 pr, pi;
                pr.x = cvtpk(vr[0], vr[1]); pr.y = cvtpk(vr[2], vr[3]); pr.z = cvtpk(vr[4], vr[5]); pr.w = cvtpk(vr[6], vr[7]);
                pi.x = cvtpk(vi[0], vi[1]); pi.y = cvtpk(vi[2], vi[3]); pi.z = cvtpk(vi[4], vi[5]); pi.w = cvtpk(vi[6], vi[7]);
                *(uint4*)(o + q * 8) = pr; *(uint4*)(o + 64 + q * 8) = pi;
            }
        }
#else
        ACC_FOR_PAIR(row, pcol) {
            const int k1 = nt * 64 + pcol; const int rr = mt * 128 + row; const int ch = rr >> 6, t2 = rr & 63;
            const float re = AV_G(acc), im = AV_U(acc);
            const float c = p.cosT[k1 * t2], sn = p.sinT[k1 * t2];
            bf16* o = p.fa2 + ((((size_t)b * 128 + k1) * 256 + ch) * 2) * 64 + t2;
            o[0] = f2bf(re * c + im * sn); o[64] = f2bf(im * c - re * sn);
        } ACC_END
#endif
    }
}
HD void ph_fourier_sB(const Params& p, int bid, int nb, char* smc) {
    const float nrm = 1.0f / sqrtf((float)SEQ * 64.0f);
    for (int tile = bid; tile < NB * 128 * 2; tile += nb) {
        const int cht = tile & 1, k1 = (tile >> 1) & 127, b = tile >> 8;
        ACC_DECL(2, acc); acc_zero(acc);
        gemm_accum<2>(acc, [&](int i) { return p.fa2 + (((size_t)b * 128 + k1) * 256 + cht * 128 + i) * 128; },
                      [&](int j) { return p.fWB + j * 128; }, 128, smc);
        ACC_FOR(2, row, col) {
            p.br[(size_t)(b * SEQ + k1 + 128 * col) * D + 768 + cht * 128 + row] = f2bf(AV(acc) * nrm);
        } ACC_END
    }
}


HD void ph_fourier_ctx(const Params& p, int bid, int nb, char* smc) {
    static_assert(CTXL % 128 == 0 || !FOURIER_GEMM, "context DFT GEMM needs CTXL % 128 == 0");
    const float nrm = 1.0f / sqrtf((float)CTXL * 64.0f);
    constexpr int MTc = CTXL / 128;
    for (int tile = bid; tile < NB * MTc * 2; tile += nb) {
        const int nt = tile & 1, mt = (tile >> 1) % MTc, b = tile / (2 * MTc);
        ACC_DECL(4, acc); acc_zero(acc);
        gemm_accum<4>(acc, [&](int i) { return p.fWC + (size_t)(mt * 128 + i) * (2 * CTXL); },
                      [&](int j) { return p.fXC + ((size_t)b * 256 + nt * 128 + j) * (2 * CTXL); }, 2 * CTXL, smc);
        ACC_FOR(4, row, col) { p.br[(size_t)(NLAT + b * CTXL + mt * 128 + row) * D + 768 + nt * 128 + col] = f2bf(AV(acc) * nrm); } ACC_END
    }
}
#ifndef CPU_EMU
struct ScanRegs { i32x4_t W[2], k[2]; unsigned u[4]; float g; };
HD bf16* scan_sp(const Params& p) { return p.h; }
HD bf16* scan_vn(const Params& p) { return p.h + (size_t)NUNIT * 4096; }
HD void ph_gdn_scan(const Params& p, int l, int bid, int nb, float* smf) {
    static_assert(NCH % 3 == 0, "scan ring assumes the chunk count is a multiple of 3");
    char* smc = (char*)smf;
    const int t = tid_(), lane = t & 63, w = t >> 6, fr = lane & 15, fg = lane >> 4;
    char* sST = smc + 24576; char* sVT = smc + 26624; char* sVS = smc + 28672; float* sG = (float*)(smc + 30720);
    const lds_cptr lds = (lds_cptr)smc;
    const int lkey = t >> 3, lc = t & 7;
    for (int cu = bid; cu < 2 * NB * 4 * 4; cu += nb) {
        const int chain = cu >> 2, cb = cu & 3;
        const ChunkInfo c0 = chunkinfo(chain * NCH);
        const int hd = c0.hd;
        auto issue = [&](ScanRegs& Rg, int n) {
            const int unit = chain * NCH + n;
            const ChunkInfo c = chunkinfo(unit);
            const bf16* wsrc = p.cW + (size_t)unit * 4096 + (16 * w + fr) * 64 + 8 * fg;
#pragma unroll
            for (int s_ = 0; s_ < 2; ++s_) {
                Rg.W[s_] = *(const i32x4_t*)(wsrc + 32 * s_);
                Rg.k[s_] = *(const i32x4_t*)(p.gq + (size_t)chunk_row(c, lkey + 32 * s_) * 768 + 256 + hd * 64 + lc * 8);
            }
#pragma unroll
            for (int r = 0; r < 4; ++r) Rg.u[r] = p.cU[(size_t)unit * 4096 + (16 * w + 4 * fg + r) * 64 + cb * 16 + fr];
            Rg.g = p.cG[(size_t)unit * 192 + (t < 192 ? t : 191)];
        };
        auto put_k = [&](const ScanRegs& Rg, int buf) {
#pragma unroll
            for (int s_ = 0; s_ < 2; ++s_) {
                const int ci = lkey + 32 * s_;
                const int fsw = ((ci >> 1) & 1) | (((ci >> 3) & 1) << 1);
                *(i32x4_t*)(smc + buf * 8192 + ci * 128 + (((((lc >> 1) ^ fsw) << 1) | (lc & 1)) << 4)) = Rg.k[s_];
            }
            if (t < 192) sG[buf * 192 + t] = Rg.g;
        };
        const int xe = (t >> 3) & 15, xc = (t & 7) ^ (xe & 7);
        const unsigned xsrc = xe * 128 + ((t & 7) << 4);
        const size_t xdst = (size_t)(cb * 16 + xe) * 64 + xc * 8;
        const unsigned c0o = ((fg) ^ (fr & 7)) << 4, c1o = ((4 + fg) ^ (fr & 7)) << 4;
        const unsigned bo0 = fr * 128 + c0o, bo1 = fr * 128 + c1o;
        const unsigned wofs = fr * 128 + ((((2 * w + (fg >> 1)) ^ (fr & 7))) << 4) + (fg & 1) * 8;
        unsigned ka[2][2];
#pragma unroll
        for (int s_ = 0; s_ < 2; ++s_)
#pragma unroll
            for (int h2 = 0; h2 < 2; ++h2) {
                const int cr = 32 * s_ + 8 * fg + (fr >> 2) + 4 * h2;
                const int fsw = ((cr >> 1) & 1) | (((cr >> 3) & 1) << 1);
                ka[s_][h2] = cr * 128 + (((((w ^ fsw) << 1) | ((fr & 3) >> 1))) << 4) + (fr & 1) * 8;
            }
        f32x4_t S = f32x4_t{0.f, 0.f, 0.f, 0.f};
        ScanRegs R0, R1, R2;
        __syncthreads();
        issue(R0, 0); issue(R1, 1);
        ((unsigned*)sST)[t] = 0u; ((unsigned*)sST)[t + 256] = 0u;
        put_k(R0, 0);
        __syncthreads();
#define SCAN_STEP(Rc, Rn, Rnn, nn, b)                                                                                                        \
        {                                                                                                                                    \
            const int n_ = (nn);                                                                                                             \
            issue(Rnn, (n_ + 2 < NCH) ? n_ + 2 : NCH - 1);                  \
            const float* g = sG + (b) * 192;                                                                                                 \
            const f32x4_t eD = *(const f32x4_t*)(g + 64 + 16 * w + 4 * fg);                                                                  \
            const float e63 = g[128];                                                                                                        \
            const bf16x8_t st0 = *(const bf16x8_t*)(sST + bo0), st1 = *(const bf16x8_t*)(sST + bo1);                                         \
            if (t < 128) *(uint4*)(scan_sp(p) + (size_t)(chain * NCH + n_) * 4096 + xdst) = *(const uint4*)(sST + xsrc);                     \
            f32x4_t v = __builtin_amdgcn_mfma_f32_16x16x32_bf16(__builtin_bit_cast(bf16x8_t, Rc.W[0]), st0, f32x4_t{0.f, 0.f, 0.f, 0.f}, 0, 0, 0); \
            v = __builtin_amdgcn_mfma_f32_16x16x32_bf16(__builtin_bit_cast(bf16x8_t, Rc.W[1]), st1, v, 0, 0, 0);                              \
            float vn[4];                                                                                                                     \
            _Pragma("unroll") for (int r = 0; r < 4; ++r) vn[r] = __uint_as_float(Rc.u[r] << 16) - v[r];                                     \
            { uint2 pk; pk.x = cvtpk(vn[0], vn[1]); pk.y = cvtpk(vn[2], vn[3]); *(uint2*)(sVT + wofs) = pk; }                                \
            { uint2 pk; pk.x = cvtpk(vn[0] * eD[0], vn[1] * eD[1]); pk.y = cvtpk(vn[2] * eD[2], vn[3] * eD[3]); *(uint2*)(sVS + wofs) = pk; }  \
            put_k(Rn, ((b) + 1) % 3);                                                                                                        \
            __syncthreads();                                                                                                                 \
            if (t >= 128) *(uint4*)(scan_vn(p) + (size_t)(chain * NCH + n_) * 4096 + xdst) = *(const uint4*)(sVT + xsrc);                    \
            const bf16x8_t vs0 = *(const bf16x8_t*)(sVS + bo0), vs1 = *(const bf16x8_t*)(sVS + bo1);                                         \
            const lds_cptr kb = lds + (b) * 8192;                                                                                            \
            const s16x4_t a00 = lds_tr16(kb + ka[0][0]), a01 = lds_tr16(kb + ka[0][1]);                                                      \
            const s16x4_t a10 = lds_tr16(kb + ka[1][0]), a11 = lds_tr16(kb + ka[1][1]);                                                      \
            f32x4_t dS = __builtin_amdgcn_mfma_f32_16x16x32_bf16(bf16x8_t{a00[0], a00[1], a00[2], a00[3], a01[0], a01[1], a01[2], a01[3]}, vs0, f32x4_t{0.f, 0.f, 0.f, 0.f}, 0, 0, 0); \
            dS = __builtin_amdgcn_mfma_f32_16x16x32_bf16(bf16x8_t{a10[0], a10[1], a10[2], a10[3], a11[0], a11[1], a11[2], a11[3]}, vs1, dS, 0, 0, 0); \
            _Pragma("unroll") for (int r = 0; r < 4; ++r) S[r] = S[r] * e63 + dS[r];                                                         \
            { uint2 pk; pk.x = cvtpk(S[0], S[1]); pk.y = cvtpk(S[2], S[3]); *(uint2*)(sST + wofs) = pk; }                                    \
            __syncthreads();                                                                                                                 \
        }
#pragma unroll 1
        for (int n = 0; n < NCH; n += 3) {
            SCAN_STEP(R0, R1, R2, n, 0)
            SCAN_STEP(R1, R2, R0, n + 1, 1)
            SCAN_STEP(R2, R0, R1, n + 2, 2)
        }
#undef SCAN_STEP
    }
}
HD void ph_gdn_outfin(const Params& p, int l, int bid, int nb, float* smf) {
    const int t = tid_(), lane = t & 63, w = t >> 6, fr = lane & 15, fg = lane >> 4;
    const float* og = p.in[I_ONORM] + l * 64;
    const int nlat = NB * 4 * NCL, nctx = (l == 0) ? NB * 4 * NCC : 0;
    float* so = smf;
    for (int u = bid; u < nlat + nctx; u += nb) {
        int b, hd, seg, nloc, ncs, T, base;
        if (u < nlat) { nloc = u % NCL; const int bh = u / NCL; hd = bh & 3; b = bh >> 2; seg = 0; ncs = NCL; T = SEQ; base = b * SEQ; }
        else { const int u2 = u - nlat; nloc = u2 % NCC; const int bh = u2 / NCC; hd = bh & 3; b = bh >> 2; seg = 1; ncs = NCC; T = CTXL; base = NLAT + b * CTXL; }
        __syncthreads();
#pragma unroll
        for (int dir = 0; dir < 2; ++dir) {
            const int nl = dir ? (ncs - 1 - nloc) : nloc;
            const int unit = ((dir * NB + b) * 4 + hd) * NCH + (seg ? nl : NCC + nl);
            const int ci = 16 * w + fr;
            const int pf = nl * 64 + ci; const int arow_ = base + (dir ? (T - 1 - pf) : pf);
            bf16x8_t qa[2], ka_[2];
#pragma unroll
            for (int s_ = 0; s_ < 2; ++s_) {
                qa[s_] = *(const bf16x8_t*)(p.gq + (size_t)arow_ * 768 + hd * 64 + 32 * s_ + 8 * fg);
                ka_[s_] = *(const bf16x8_t*)(p.cQK + (size_t)unit * 4096 + ci * 64 + 32 * s_ + 8 * fg);
            }
            const f32x4_t eG = *(const f32x4_t*)(p.cG + (size_t)unit * 192 + 16 * w + 4 * fg);
#pragma unroll
            for (int j = 0; j < 4; ++j) {
                const bf16* spr = scan_sp(p) + (size_t)unit * 4096 + (16 * j + fr) * 64 + 8 * fg;
                const bf16* vnr = scan_vn(p) + (size_t)unit * 4096 + (16 * j + fr) * 64 + 8 * fg;
                f32x4_t o1 = __builtin_amdgcn_mfma_f32_16x16x32_bf16(qa[0], *(const bf16x8_t*)(spr), f32x4_t{0.f, 0.f, 0.f, 0.f}, 0, 0, 0);
                o1 = __builtin_amdgcn_mfma_f32_16x16x32_bf16(qa[1], *(const bf16x8_t*)(spr + 32), o1, 0, 0, 0);
                f32x4_t o2 = __builtin_amdgcn_mfma_f32_16x16x32_bf16(ka_[0], *(const bf16x8_t*)(vnr), f32x4_t{0.f, 0.f, 0.f, 0.f}, 0, 0, 0);
                o2 = __builtin_amdgcn_mfma_f32_16x16x32_bf16(ka_[1], *(const bf16x8_t*)(vnr + 32), o2, 0, 0, 0);
#pragma unroll
                for (int r = 0; r < 4; ++r) {
                    const int cpos = 16 * w + 4 * fg + r;
                    const int tok = dir ? (63 - cpos) : cpos;
                    float* dst = so + tok * 65 + 16 * j + fr;
                    const float val = eG[r] * o1[r] + o2[r];
                    if (dir == 0) *dst = val; else *dst += val;
                }
            }
            __syncthreads();
        }
        {
            const int tok = t >> 2, q4 = t & 3;
            const int row = base + nloc * 64 + tok;
            float v[16]; float ss = 0.f;
#pragma unroll
            for (int c = 0; c < 16; ++c) { v[c] = so[tok * 65 + q4 * 16 + c]; ss += v[c] * v[c]; }
            ss += __shfl_xor(ss, 1); ss += __shfl_xor(ss, 2);
            const float rs = 1.0f / sqrtf(ss / 64.0f + 1e-6f);
            const uint4 z0 = *(const uint4*)(p.P + (size_t)row * PLD + C_Z + hd * 64 + q4 * 16), z1 = *(const uint4*)(p.P + (size_t)row * PLD + C_Z + hd * 64 + q4 * 16 + 8);
            const unsigned zz[8] = {z0.x, z0.y, z0.z, z0.w, z1.x, z1.y, z1.z, z1.w};
            unsigned pk[8];
#pragma unroll
            for (int c2 = 0; c2 < 8; ++c2) {
                const float za = __uint_as_float(zz[c2] << 16), zb = __uint_as_float(zz[c2] & 0xffff0000u);
                const float oa = v[2 * c2] * rs * og[q4 * 16 + 2 * c2] * siluf_(za), ob = v[2 * c2 + 1] * rs * og[q4 * 16 + 2 * c2 + 1] * siluf_(zb);
                pk[c2] = cvtpk(oa, ob);
            }
            uint4 p0, p1; p0.x = pk[0]; p0.y = pk[1]; p0.z = pk[2]; p0.w = pk[3]; p1.x = pk[4]; p1.y = pk[5]; p1.z = pk[6]; p1.w = pk[7];
            bf16* dstb = p.br + (size_t)row * D + 512 + hd * 64 + q4 * 16;
            *(uint4*)dstb = p0; *(uint4*)(dstb + 8) = p1;
        }
    }
}
#else
HD void ph_gdn_scan(const Params& p, int l, int bid, int nb, float* sm) {
    float* sQ = sm;
    float* sK = sm + 4096;
    bf16* sW = (bf16*)(sm + 8192);
    bf16* sQK = (bf16*)(sm + 10240);
    float* sS = sm + 12288;
    float* sV = sm + 13312;
    float* sU = sm + 14336;
    float* sG = sm + 15360;
    const int RQ = (l == 0) ? R : NLAT;
    for (int cu = bid; cu < 2 * NB * 4 * 4; cu += nb) {
        int chain = cu >> 2, cb = cu & 3;
        THREADS(t, 1024) { sS[t] = 0.f; }
        SYNC
        for (int n = 0; n < NCH; ++n) {
            int unit = chain * NCH + n;
            ChunkInfo c = chunkinfo(unit);
            THREADS(t, 64) { sG[t] = p.cG[(size_t)unit * 64 + t]; }
            SYNC
            THREADS(t, 4096) {
                int i = t >> 6, d = t & 63; int row = chunk_row(c, i);
                sW[t] = p.cW[(size_t)unit * 4096 + t];
                sQK[t] = p.cQK[(size_t)unit * 4096 + t];
                sQ[t] = bf2f(p.gq[(size_t)row * 768 + c.hd * 64 + d]) * expf(sG[i]);
                sK[t] = bf2f(p.gq[(size_t)row * 768 + 256 + c.hd * 64 + d]) * expf(sG[63] - sG[i]);
            }
            THREADS(t, 1024) { int i = t >> 4, e = t & 15; sU[t] = bf2f(p.cU[(size_t)unit * 4096 + i * 64 + cb * 16 + e]); }
            SYNC
            THREADS(t, 1024) {
                int i = t >> 4, e = t & 15;
                float acc = sU[t];
                for (int d = 0; d < 64; ++d) acc -= bf2f(sW[i * 64 + d]) * sS[d * 16 + e];
                sV[t] = acc;
            }
            SYNC
            THREADS(t, 1024) {
                int i = t >> 4, e = t & 15;
                float acc = 0.f;
                for (int d = 0; d < 64; ++d) acc += sQ[i * 64 + d] * sS[d * 16 + e];
                for (int j = 0; j < 64; ++j) acc += bf2f(sQK[i * 64 + j]) * sV[j * 16 + e];
                int row = chunk_row(c, i);
                if (row < RQ) p.odir[((size_t)c.dir * R + row) * 256 + c.hd * 64 + cb * 16 + e] = f2bf(acc);
            }
            SYNC
            THREADS(t, 1024) {
                int d = t >> 4, e = t & 15;
                float acc = sS[t] * expf(sG[63]);
                for (int i = 0; i < 64; ++i) acc += sK[i * 64 + d] * sV[i * 16 + e];
                sS[t] = acc;
            }
            SYNC
        }
    }
}

#endif

#ifndef CPU_EMU
HD void ph_gdn_fin(const Params& p, int l, int bid, int nb) {
    const int RQ = (l == 0) ? R : NLAT;
    const float* og = p.in[I_ONORM] + l * 64;
    const int N = RQ * 32;
    for (int idx = bid * 256 + tid_(); idx < N; idx += nb * 256) {
        const int r = idx >> 5, q = idx & 31; const int hd = q >> 3, cg = q & 7;
        const uint4 a0 = *(const uint4*)(p.odir + (size_t)r * 256 + hd * 64 + cg * 8);
        const uint4 a1 = *(const uint4*)(p.odir + ((size_t)R + r) * 256 + hd * 64 + cg * 8);
        const uint4 zz = *(const uint4*)(p.P + (size_t)r * PLD + C_Z + hd * 64 + cg * 8);
        float v[8], z[8];
        v[0] = __uint_as_float(a0.x << 16) + __uint_as_float(a1.x << 16); v[1] = __uint_as_float(a0.x & 0xffff0000u) + __uint_as_float(a1.x & 0xffff0000u);
        v[2] = __uint_as_float(a0.y << 16) + __uint_as_float(a1.y << 16); v[3] = __uint_as_float(a0.y & 0xffff0000u) + __uint_as_float(a1.y & 0xffff0000u);
        v[4] = __uint_as_float(a0.z << 16) + __uint_as_float(a1.z << 16); v[5] = __uint_as_float(a0.z & 0xffff0000u) + __uint_as_float(a1.z & 0xffff0000u);
        v[6] = __uint_as_float(a0.w << 16) + __uint_as_float(a1.w << 16); v[7] = __uint_as_float(a0.w & 0xffff0000u) + __uint_as_float(a1.w & 0xffff0000u);
        z[0] = __uint_as_float(zz.x << 16); z[1] = __uint_as_float(zz.x & 0xffff0000u); z[2] = __uint_as_float(zz.y << 16); z[3] = __uint_as_float(zz.y & 0xffff0000u);
        z[4] = __uint_as_float(zz.z << 16); z[5] = __uint_as_float(zz.z & 0xffff0000u); z[6] = __uint_as_float(zz.w << 16); z[7] = __uint_as_float(zz.w & 0xffff0000u);
        float ss = 0.f;
#pragma unroll
        for (int c = 0; c < 8; ++c) ss += v[c] * v[c];
        ss += __shfl_xor(ss, 1); ss += __shfl_xor(ss, 2); ss += __shfl_xor(ss, 4);
        const float rs = 1.0f / sqrtf(ss / 64.0f + 1e-6f);
        float o[8];
#pragma unroll
        for (int c = 0; c < 8; ++c) o[c] = v[c] * rs * og[cg * 8 + c] * siluf_(z[c]);
        uint4 pk; pk.x = cvtpk(o[0], o[1]); pk.y = cvtpk(o[2], o[3]); pk.z = cvtpk(o[4], o[5]); pk.w = cvtpk(o[6], o[7]);
        *(uint4*)(p.br + (size_t)r * D + 512 + hd * 64 + cg * 8) = pk;
    }
}
#else
HD void ph_gdn_fin(const Params& p, int l, int bid, int nb) {
    const int RQ = (l == 0) ? R : NLAT;
    const float* og = p.in[I_ONORM] + l * 64;
    const int N = RQ * 4;
    for (int u = bid; u < (N + 255) / 256; u += nb) {
        THREADS(t, 256) {
            int idx = u * 256 + t;
            if (idx < N) {
                int r = idx >> 2, hd = idx & 3;
                const bf16* o0 = p.odir + (size_t)r * 256 + hd * 64;
                const bf16* o1 = p.odir + ((size_t)R + r) * 256 + hd * 64;
                float ss = 0.f;
                for (int d = 0; d < 64; ++d) { float v = bf2f(o0[d]) + bf2f(o1[d]); ss += v * v; }
                float rs = 1.0f / sqrtf(ss / 64.0f + 1e-6f);
                for (int d = 0; d < 64; ++d) {
                    float v = (bf2f(o0[d]) + bf2f(o1[d])) * rs * og[d];
                    float z = bf2f(p.P[(size_t)r * PLD + C_Z + hd * 64 + d]);
                    p.br[(size_t)r * D + 512 + hd * 64 + d] = f2bf(v * siluf_(z));
                }
            }
        }
    }
}

#endif

#ifndef CPU_EMU
template <int NJ>
HD void merge_tile(const Params& p, int l, int mt, int nt, char* smc) {
    constexpr int NW = 32 * NJ;
    const bf16* Wg = p.wt_in + (size_t)l * WIN_NP * D + (size_t)PLD * D;
    const bf16* Wb = p.wt_br + (size_t)l * 4 * D * 256;
    AccT<NJ> accM; acc_zero(accM);
    const unsigned char* h8 = (const unsigned char*)h8_of(p);
    auto aG = [&](int r) { return (const void*)(h8 + (size_t)(mt * 128 + r) * D); };
    int cur = 0;
    __syncthreads();
    gemm_stage0<NJ>(aG, [&](int j) { return (const void*)((const unsigned char*)Wg + (size_t)(nt * NW + j) * D); }, 1, smc, 0);
#pragma unroll 1
    for (int i = 0; i < 4; ++i) {
        AccT<NJ> acc; acc_zero(acc);
        auto bG = [&](int j) { return (const void*)((const unsigned char*)Wg + (size_t)(i * 1024 + nt * NW + j) * D); };
        auto aP = [&](int r) { return (const void*)(p.br + (size_t)(mt * 128 + r) * D + i * 256); };
        auto bP = [&](int j) { return (const void*)(Wb + ((size_t)i * D + nt * NW + j) * 256); };
        gemm_chain<NJ, true>(acc, aG, bG, D, smc, cur, [&](int buf) { gemm_stage0<NJ>(aP, bP, 2, smc, buf); }, SC_H, SC_W);
        unsigned sg[4][NJ][2];
#pragma unroll
        for (int a_ = 0; a_ < 4; ++a_)
#pragma unroll
            for (int b_ = 0; b_ < NJ; ++b_) {
                float e[4];
#pragma unroll
                for (int r = 0; r < 4; ++r) e[r] = __builtin_amdgcn_rcpf(1.0f + __expf(-acc.v[a_][b_][r]));
                sg[a_][b_][0] = cvtpk(e[0], e[1]); sg[a_][b_][1] = cvtpk(e[2], e[3]);
            }
        acc_zero(acc);
        auto bGn = [&](int j) { return (const void*)((const unsigned char*)Wg + (size_t)((i + 1) * 1024 + nt * NW + j) * D); };
        gemm_chain<NJ, false>(acc, aP, bP, 256, smc, cur, [&](int buf) { if (i < 3) gemm_stage0<NJ>(aG, bGn, 1, smc, buf); }, 0, 0);
#pragma unroll
        for (int a_ = 0; a_ < 4; ++a_)
#pragma unroll
            for (int b_ = 0; b_ < NJ; ++b_) {
                accM.v[a_][b_][0] += __uint_as_float(sg[a_][b_][0] << 16) * acc.v[a_][b_][0];
                accM.v[a_][b_][1] += __uint_as_float(sg[a_][b_][0] & 0xffff0000u) * acc.v[a_][b_][1];
                accM.v[a_][b_][2] += __uint_as_float(sg[a_][b_][1] << 16) * acc.v[a_][b_][2];
                accM.v[a_][b_][3] += __uint_as_float(sg[a_][b_][1] & 0xffff0000u) * acc.v[a_][b_][3];
            }
    }
    __syncthreads();
    float* tl = (float*)smc;
    acc_to_lds<NJ>(accM, tl);
    __syncthreads();
    const int t_ = tid_(); const int row = t_ >> 1, half = t_ & 1;
    constexpr int LD = NW + 4, HW = NW / 2;
    bf16* dst = p.mg + (size_t)(mt * 128 + row) * D + nt * NW + half * HW;
#pragma unroll
    for (int q = 0; q < HW / 8; ++q) {
        const f32x4_t a = *(const f32x4_t*)(tl + row * LD + half * HW + q * 8), b = *(const f32x4_t*)(tl + row * LD + half * HW + q * 8 + 4);
        uint4 pk; pk.x = cvtpk(a[0], a[1]); pk.y = cvtpk(a[2], a[3]); pk.z = cvtpk(b[0], b[1]); pk.w = cvtpk(b[2], b[3]);
        *(uint4*)(dst + q * 8) = pk;
    }
}
HD void ph_merge(const Params& p, int l, int bid, int nb, char* smc) {
    constexpr int MTL = NLAT / 128, MTC = NCTX / 128;
    const int nfull = MTL * 8, nhalf = (l == 0) ? MTC * 16 : 0;
    for (int tile = bid; tile < nfull + nhalf; tile += nb) {
        if (tile < nfull) merge_tile<4>(p, l, tile >> 3, tile & 7, smc);
        else { const int t2 = tile - nfull; merge_tile<2>(p, l, MTL + (t2 >> 4), t2 & 15, smc); }
    }
}
#else
HD void ph_merge(const Params& p, int l, int bid, int nb, char* smc) {
    const int MT = ((l == 0) ? R : NLAT) / 128;
    const bf16* Wg = p.wt_in + (size_t)l * WIN_NP * D + (size_t)PLD * D;
    const bf16* Wb = p.wt_br + (size_t)l * 4 * D * 256;
    for (int tile = bid; tile < MT * 16; tile += nb) {
        const int mt = tile >> 4, nt = tile & 15;
        ACC_DECL(2, accM); acc_zero(accM);
        for (int i = 0; i < 4; ++i) {
            ACC_DECL(2, accG); acc_zero(accG);
            ACC_DECL(2, accP); acc_zero(accP);
            gemm_accum<2>(accG, [&](int r) { return p.h + (size_t)(mt * 128 + r) * D; },
                          [&](int j) { return Wg + (size_t)(i * 1024 + nt * 64 + j) * D; }, D, smc);
            gemm_accum<2>(accP, [&](int r) { return p.br + (size_t)(mt * 128 + r) * D + i * 256; },
                          [&](int j) { return Wb + ((size_t)i * D + nt * 64 + j) * 256; }, 256, smc);
            ACC_FOR(2, row, col) { AV(accM) += sigmoidf_(AV(accG)) * AV(accP); } ACC_END
        }
#ifndef CPU_EMU
        {
            float* tl = (float*)smc;
            acc_to_lds<2>(accM, tl);
            __syncthreads();
            const int t_ = tid_(); const int row = t_ >> 1, half = t_ & 1;
            bf16* dst = p.mg + (size_t)(mt * 128 + row) * D + nt * 64 + half * 32;
#pragma unroll
            for (int q = 0; q < 4; ++q) {
                const f32x4_t a = *(const f32x4_t*)(tl + row * 68 + half * 32 + q * 8), b = *(const f32x4_t*)(tl + row * 68 + half * 32 + q * 8 + 4);
                uint4 pk; pk.x = cvtpk(a[0], a[1]); pk.y = cvtpk(a[2], a[3]); pk.z = cvtpk(b[0], b[1]); pk.w = cvtpk(b[2], b[3]);
                *(uint4*)(dst + q * 8) = pk;
            }
        }
#else
        ACC_FOR(2, row, col) { p.mg[(size_t)(mt * 128 + row) * D + nt * 64 + col] = f2bf(AV(accM)); } ACC_END
#endif
    }
}

#endif

template <int DRY> HD void ph_outproj_t(const Params& p, int l, int bid, int nb, char* smc) {
    const int MT = ((l == 0) ? R : NLAT) / 128;
    const bf16* Wt = p.wt_out + (size_t)l * D * D;
#ifndef CPU_EMU
    constexpr int MTL_ = NLAT / 128;
    const int nfull_ = MTL_ * 8, nhalf_ = (MT - MTL_) * 16;
    for (int tile = bid + nfull_; tile < nfull_ + nhalf_; tile += nb) {
        const int t2 = tile - nfull_; const int mt = MTL_ + (t2 >> 4), nt = t2 & 15;
        AccT<2> acc; acc_zero(acc);
        gemm_accum<2>(acc, [&](int r) { return p.mg + (size_t)(mt * 128 + r) * D; }, [&](int j) { return Wt + (size_t)(nt * 64 + j) * D; }, D, smc);
        float* tl = (float*)smc;
        acc_to_lds<2>(acc, tl);
        __syncthreads();
        const int t_ = tid_(); const int row = t_ >> 1, half = t_ & 1;
        const int r = mt * 128 + row, c0 = nt * 64 + half * 32;
        const float* xi = xrow_in(p, l, r) + c0; float* xo = (DRY ? ((float*)p.Y + (size_t)r * D) : xrow_out(p, r)) + c0; const float* gm = modrow(p, l, r) + 2048 + c0;
#pragma unroll
        for (int q = 0; q < 8; ++q) {
            const f32x4_t a = *(const f32x4_t*)(tl + row * 68 + half * 32 + q * 4), xv = *(const f32x4_t*)(xi + q * 4), gv = *(const f32x4_t*)(gm + q * 4);
            f32x4_t o; o[0] = xv[0] + gv[0] * a[0]; o[1] = xv[1] + gv[1] * a[1]; o[2] = xv[2] + gv[2] * a[2]; o[3] = xv[3] + gv[3] * a[3];
            *(f32x4_t*)(xo + q * 4) = o;
        }
        __syncthreads();
    }
    const int MTF = MTL_;
#else
    const int MTF = MT;
#endif
    for (int tile = bid; tile < MTF * 8; tile += nb) {
        const int mt = tile >> 3, nt = tile & 7;
        ACC_DECL(4, acc); acc_zero(acc);
        gemm_accum<4>(acc, [&](int r) { return p.mg + (size_t)(mt * 128 + r) * D; }, [&](int j) { return Wt + (size_t)(nt * 128 + j) * D; }, D, smc);
#ifndef CPU_EMU
        {
            float* tl = (float*)smc;
            acc_to_lds<4>(acc, tl);
            __syncthreads();
            const int t_ = tid_(); const int row = t_ >> 1, half = t_ & 1;
            const int r = mt * 128 + row, c0 = nt * 128 + half * 64;
            const float* xi = xrow_in(p, l, r) + c0; float* xo = (DRY ? ((float*)p.Y + (size_t)r * D) : xrow_out(p, r)) + c0; const float* gm = modrow(p, l, r) + 2048 + c0;
#pragma unroll
            for (int q = 0; q < 16; ++q) {
                const f32x4_t a = *(const f32x4_t*)(tl + row * 132 + half * 64 + q * 4), xv = *(const f32x4_t*)(xi + q * 4), gv = *(const f32x4_t*)(gm + q * 4);
                f32x4_t o; o[0] = xv[0] + gv[0] * a[0]; o[1] = xv[1] + gv[1] * a[1]; o[2] = xv[2] + gv[2] * a[2]; o[3] = xv[3] + gv[3] * a[3];
                *(f32x4_t*)(xo + q * 4) = o;
            }
        }
#else
        ACC_FOR(4, row, col) {
            const int r = mt * 128 + row, c = nt * 128 + col;
            xrow_out(p, r)[c] = xrow_in(p, l, r)[c] + modrow(p, l, r)[2048 + c] * AV(acc);
        } ACC_END
#endif
    }
}

HD void ph_outproj(const Params& p, int l, int bid, int nb, char* smc) { ph_outproj_t<0>(p, l, bid, nb, smc); }
#ifndef CPU_EMU
template <int DRY> HD void ph_router_t(const Params& p, int l, int bid, int nb, float* smf) {
    char* smc = (char*)smf;
    const int t = tid_(), lane = t & 63, w = t >> 6, fr = lane & 15, fg = lane >> 4;
    const int RQ = (l == 0) ? R : NLAT;
    const float* gN = p.in[I_N2G] + l * D;
    constexpr int WST = 2080;
    float* lgw = (float*)(smc + 66560) + w * (16 * 17);
    int* lcnt = (int*)(smc + 70912); int* gbase = (int*)(smc + 70976);
    __syncthreads();
    for (int k = t; k < 1024; k += 256) {
        const float* wrow = p.in[I_WROUTER] + k * 16;
#pragma unroll
        for (int e = 0; e < 16; ++e) {
            const float v = wrow[e]; const bf16 hi = f2bf(v);
            *(bf16*)(smc + e * WST + k * 2) = hi; *(bf16*)(smc + 33280 + e * WST + k * 2) = f2bf(v - bf2f(hi));
        }
    }
    const int ngroups = RQ / 16;
    for (int g0 = bid * 4; g0 < ngroups; g0 += nb * 4) {
        __syncthreads();
        if (t < 16) lcnt[t] = 0;
        __syncthreads();
        const int gidx = g0 + w;
        const bool active = gidx < ngroups;
        int e1 = 0, e2 = 0, q1 = 0, q2 = 0; const int rsel = gidx * 16 + lane;
        if (active) {
            const int r = gidx * 16 + fr;
            const float* x = xrow_out(p, r);
            const float* m = modrow(p, l, r);
            float ss = 0.f;
#pragma unroll 4
            for (int s_ = 0; s_ < 32; ++s_) {
                const f32x4_t a = *(const f32x4_t*)(x + s_ * 32 + fg * 8), b = *(const f32x4_t*)(x + s_ * 32 + fg * 8 + 4);
                ss += a[0] * a[0] + a[1] * a[1] + a[2] * a[2] + a[3] * a[3] + b[0] * b[0] + b[1] * b[1] + b[2] * b[2] + b[3] * b[3];
            }
            ss += __shfl_xor(ss, 16); ss += __shfl_xor(ss, 32);
            const float rs = 1.0f / sqrtf(ss / D + 1e-6f);
            f32x4_t acc = f32x4_t{0.f, 0.f, 0.f, 0.f};
#pragma unroll 2
            for (int s_ = 0; s_ < 32; ++s_) {
                const int k0 = s_ * 32 + fg * 8;
                float hv[8];
#pragma unroll
                for (int hh = 0; hh < 2; ++hh) {
                    const f32x4_t xv = *(const f32x4_t*)(x + k0 + hh * 4), gv = *(const f32x4_t*)(gN + k0 + hh * 4);
                    const f32x4_t sc = *(const f32x4_t*)(m + 4096 + k0 + hh * 4), sh = *(const f32x4_t*)(m + 3072 + k0 + hh * 4);
#pragma unroll
                    for (int q = 0; q < 4; ++q) hv[hh * 4 + q] = xv[q] * rs * gv[q] * (1.0f + sc[q]) + sh[q];
                }
                unsigned hi[4], lo[4];
#pragma unroll
                for (int q = 0; q < 4; ++q) {
                    hi[q] = cvtpk(hv[2 * q], hv[2 * q + 1]);
                    lo[q] = cvtpk(hv[2 * q] - __uint_as_float(hi[q] << 16), hv[2 * q + 1] - __uint_as_float(hi[q] & 0xffff0000u));
                }
                const i32x4_t hiv = i32x4_t{(int)hi[0], (int)hi[1], (int)hi[2], (int)hi[3]}, lov = i32x4_t{(int)lo[0], (int)lo[1], (int)lo[2], (int)lo[3]};
                { uint2 q8; q8.x = pack_fp8x4(hv[0] * 4.f, hv[1] * 4.f, hv[2] * 4.f, hv[3] * 4.f); q8.y = pack_fp8x4(hv[4] * 4.f, hv[5] * 4.f, hv[6] * 4.f, hv[7] * 4.f);
                  *(uint2*)(h8_of(p) + (size_t)r * D + k0) = q8; }
                const bf16x8_t bh = *(const bf16x8_t*)(smc + fr * WST + s_ * 64 + fg * 16), bl = *(const bf16x8_t*)(smc + 33280 + fr * WST + s_ * 64 + fg * 16);
                acc = __builtin_amdgcn_mfma_f32_16x16x32_bf16(__builtin_bit_cast(bf16x8_t, hiv), bh, acc, 0, 0, 0);
                acc = __builtin_amdgcn_mfma_f32_16x16x32_bf16(__builtin_bit_cast(bf16x8_t, hiv), bl, acc, 0, 0, 0);
                acc = __builtin_amdgcn_mfma_f32_16x16x32_bf16(__builtin_bit_cast(bf16x8_t, lov), bh, acc, 0, 0, 0);
            }
#pragma unroll
            for (int q = 0; q < 4; ++q) lgw[(4 * fg + q) * 17 + fr] = acc[q];
            if (lane < 16) {
                float sc[16], sel[16];
#pragma unroll
                for (int e = 0; e < 16; ++e) { sc[e] = sigmoidf_(lgw[lane * 17 + e]); sel[e] = sc[e] + p.in[I_RBIAS][e]; }
                int best = 0; float bestv = -1e30f;
#pragma unroll
                for (int gph = 0; gph < 4; ++gph) {
                    float t1 = -1e30f, t2 = -1e30f;
#pragma unroll
                    for (int j = 0; j < 4; ++j) { const float v = sel[gph * 4 + j]; if (v > t1) { t2 = t1; t1 = v; } else if (v > t2) t2 = v; }
                    const float gs = t1 + t2;
                    if (gs > bestv) { bestv = gs; best = gph; }
                }
                float v1 = -1e30f, v2 = -1e30f, w1 = 0.f, w2 = 0.f; int i1 = 0, i2 = 0;
#pragma unroll
                for (int e = 0; e < 16; ++e) {
                    if ((e >> 2) == best) {
                        const float v = sel[e];
                        if (v > v1) { v2 = v1; i2 = i1; w2 = w1; v1 = v; i1 = e; w1 = sc[e]; } else if (v > v2) { v2 = v; i2 = e; w2 = sc[e]; }
                    }
                }
                e1 = i1; e2 = i2;
                const float ws_ = w1 + w2;
                p.sel_e[rsel * 2] = i1; p.sel_e[rsel * 2 + 1] = i2;
                p.sel_w[rsel * 2] = w1 / ws_; p.sel_w[rsel * 2 + 1] = w2 / ws_;
                q1 = atomicAdd(&lcnt[i1], 1); q2 = atomicAdd(&lcnt[i2], 1);
            }
        }
        __syncthreads();
        if (t < 16) { const int c = lcnt[t]; gbase[t] = (c && !DRY) ? atomicAdd(&p.cnt[l * 16 + t], c) : 0; }
        __syncthreads();
        if (active && lane < 16 && !DRY) {
            const int p1 = gbase[e1] + q1, p2 = gbase[e2] + q2;
            p.elist[(size_t)e1 * 2 * R + p1] = rsel * 2; p.apos[rsel * 2] = p1;
            p.elist[(size_t)e2 * 2 * R + p2] = rsel * 2 + 1; p.apos[rsel * 2 + 1] = p2;
        }
    }
}
HD void ph_router(const Params& p, int l, int bid, int nb, float* smf) { ph_router_t<0>(p, l, bid, nb, smf); }
#else
HD void ph_router(const Params& p, int l, int bid, int nb, float* sm) {
    const int RQ = (l == 0) ? R : NLAT;
    const float* g = p.in[I_N2G] + l * D;
    const float* wr = p.in[I_WROUTER];
    float* sh = sm + 512;
    float* sl = sm + 2048;
    for (int r = bid; r < RQ; r += nb) {
        const float* x = xrow_out(p, r);
        const float* m = modrow(p, l, r);
        THREADS(t, 256) { float s = 0.f; for (int k = t; k < D; k += 256) s += x[k] * x[k]; sm[t] = s; }
        SYNC
        THREADS(t, 1) { float s = 0.f; for (int i = 0; i < 256; ++i) s += sm[i]; sm[256] = s; }
        SYNC
        THREADS(t, 256) {
            float rs = 1.0f / sqrtf(sm[256] / D + 1e-6f);
            for (int k = t; k < D; k += 256) {
                float v = x[k] * rs * g[k];
                v = v * (1.0f + m[4096 + k]) + m[3072 + k];
                sh[k] = v;
                p.h[(size_t)r * D + k] = f2bf(v);
            }
        }
        SYNC
        THREADS(t, 256) {
            int e = t & 15, ks = t >> 4;
            float acc = 0.f;
            for (int k = ks * 64; k < ks * 64 + 64; ++k) acc += sh[k] * wr[k * 16 + e];
            sl[ks * 16 + e] = acc;
        }
        SYNC
        THREADS(t, 1) {
            float* sc = sm + 2304; float* sel = sm + 2320;
            for (int e = 0; e < 16; ++e) {
                float acc = 0.f;
                for (int ks = 0; ks < 16; ++ks) acc += sl[ks * 16 + e];
                sc[e] = sigmoidf_(acc); sel[e] = sc[e] + p.in[I_RBIAS][e];
            }
            int best = 0; float bestv = -1e30f;
            for (int gph = 0; gph < 4; ++gph) {
                float t1 = -1e30f, t2 = -1e30f;
                for (int j = 0; j < 4; ++j) { float v = sel[gph * 4 + j]; if (v > t1) { t2 = t1; t1 = v; } else if (v > t2) t2 = v; }
                float gs = t1 + t2;
                if (gs > bestv) { bestv = gs; best = gph; }
            }
            int i1 = -1, i2 = -1; float v1 = -1e30f, v2 = -1e30f;
            for (int j = 0; j < 4; ++j) {
                float v = sel[best * 4 + j];
                if (v > v1) { v2 = v1; i2 = i1; v1 = v; i1 = best * 4 + j; } else if (v > v2) { v2 = v; i2 = best * 4 + j; }
            }
            float w1 = sc[i1], w2 = sc[i2], ws = w1 + w2;
            p.sel_e[r * 2] = i1; p.sel_e[r * 2 + 1] = i2;
            p.sel_w[r * 2] = w1 / ws; p.sel_w[r * 2 + 1] = w2 / ws;
            int q1 = ATOMIC_ADD_RET(&p.cnt[l * 16 + i1], 1); p.elist[(size_t)i1 * 2 * R + q1] = r * 2; p.apos[r * 2] = q1;
            int q2 = ATOMIC_ADD_RET(&p.cnt[l * 16 + i2], 1); p.elist[(size_t)i2 * 2 * R + q2] = r * 2 + 1; p.apos[r * 2 + 1] = q2;
        }
        SYNC
    }
}

#endif

struct MoeTiles { int tstart[17]; };
HD MoeTiles moe_tiles(const Params& p, int l) {
    MoeTiles m; int acc = 0;
    for (int e = 0; e < 16; ++e) { m.tstart[e] = acc; acc += (p.cnt[l * 16 + e] + 127) >> 7; }
    m.tstart[16] = acc; return m;
}

HD void ph_ffn1(const Params& p, int l, int bid, int nb, char* smc) {
    int tstart[17];
    { int acc = 0; for (int e = 0; e < 16; ++e) { tstart[e] = acc; acc += (p.cnt[l * 16 + e] + 127) >> 7; } tstart[16] = acc; }
    const int ntiles = tstart[16];
    for (int tile = bid; tile < ntiles * 8; tile += nb) {
        const int rt = tile >> 3, nt = tile & 7;
        int e = 0, ts = 0;
#pragma unroll
        for (int q = 1; q < 16; ++q) if (rt >= tstart[q]) { e = q; ts = tstart[q]; }
        const int mt = rt - ts;
        const int cnt_e = p.cnt[l * 16 + e];
        const int* el = p.elist + (size_t)e * 2 * R;
#ifndef CPU_EMU
        const unsigned char* Wt8 = gu8_of(p) + (size_t)e * 1024 * D;
        AccT<4> acc; acc_zero(acc);
        gemm_accum8<4>(acc, [&](int i) { int q = mt * 128 + i; int a = (q < cnt_e) ? el[q] : el[0]; return (const unsigned char*)h8_of(p) + (size_t)(a >> 1) * D; },
                       [&](int j) { return Wt8 + (size_t)(nt * 128 + j) * D; }, D, smc, SC_H, SC_W);
        {
            float* tl = (float*)smc;
            acc_to_lds<4>(acc, tl);
            __syncthreads();
            const int t_ = tid_(); const int row = t_ >> 1, half = t_ & 1;
            unsigned char* dst = (unsigned char*)p.act + (size_t)(rt * 128 + row) * 512 + nt * 64 + half * 32;
#pragma unroll
            for (int q = 0; q < 2; ++q) {
                float o[16];
#pragma unroll
                for (int c4 = 0; c4 < 4; ++c4) {
                    const f32x4_t gv = *(const f32x4_t*)(tl + row * 132 + half * 64 + q * 32 + c4 * 4), uv = *(const f32x4_t*)(tl + row * 132 + half * 64 + q * 32 + 16 + c4 * 4);
#pragma unroll
                    for (int e_ = 0; e_ < 4; ++e_) o[c4 * 4 + e_] = gv[e_] / (1.0f + __expf(-gv[e_])) * uv[e_] * 16.0f;
                }
                uint4 pk; pk.x = pack_fp8x4(o[0], o[1], o[2], o[3]); pk.y = pack_fp8x4(o[4], o[5], o[6], o[7]);
                pk.z = pack_fp8x4(o[8], o[9], o[10], o[11]); pk.w = pack_fp8x4(o[12], o[13], o[14], o[15]);
                *(uint4*)(dst + q * 16) = pk;
            }
        }
#else
        const bf16* Wt = p.wt_gu + (size_t)e * 1024 * D;
        ACC_DECL(4, acc); acc_zero(acc);
        gemm_accum<4>(acc, [&](int i) { int q = mt * 128 + i; int a = (q < cnt_e) ? el[q] : el[0]; return p.h + (size_t)(a >> 1) * D; },
                      [&](int j) { return Wt + (size_t)(nt * 128 + j) * D; }, D, smc);
        ACC_FOR_PAIR(row, pcol) {
            float gv = AV_G(acc), uv = AV_U(acc);
            p.act[(size_t)(rt * 128 + row) * 512 + nt * 64 + pcol] = f2bf(siluf_(gv) * uv);
        } ACC_END
#endif
    }
}

HD void ph_ffn2(const Params& p, int l, int bid, int nb, char* smc) {
    int tstart[17];
    { int acc = 0; for (int e = 0; e < 16; ++e) { tstart[e] = acc; acc += (p.cnt[l * 16 + e] + 127) >> 7; } tstart[16] = acc; }
    const int ntiles = tstart[16];
    for (int tile = bid; tile < ntiles * 8; tile += nb) {
        const int rt = tile >> 3, nt = tile & 7;
        int e = 0;
#pragma unroll
        for (int q = 1; q < 16; ++q) if (rt >= tstart[q]) e = q;
#ifndef CPU_EMU
        const unsigned char* Wt8 = d8_of(p) + (size_t)e * D * 512;
        AccT<4> acc; acc_zero(acc);
        gemm_accum8<4>(acc, [&](int i) { return (const unsigned char*)p.act + (size_t)(rt * 128 + i) * 512; }, [&](int j) { return Wt8 + (size_t)(nt * 128 + j) * 512; }, 512, smc, SC_ACT, SC_W);
#else
        const bf16* Wt = p.wt_d + (size_t)e * D * 512;
        ACC_DECL(4, acc); acc_zero(acc);
        gemm_accum<4>(acc, [&](int i) { return p.act + (size_t)(rt * 128 + i) * 512; }, [&](int j) { return Wt + (size_t)(nt * 128 + j) * 512; }, 512, smc);
#endif
#ifndef CPU_EMU
        {
            float* tl = (float*)smc;
            acc_to_lds<4>(acc, tl);
            __syncthreads();
            const int t_ = tid_(); const int row = t_ >> 1, half = t_ & 1;
            bf16* dst = p.Y + (size_t)(rt * 128 + row) * D + nt * 128 + half * 64;
#pragma unroll
            for (int q = 0; q < 8; ++q) {
                const f32x4_t a = *(const f32x4_t*)(tl + row * 132 + half * 64 + q * 8), b = *(const f32x4_t*)(tl + row * 132 + half * 64 + q * 8 + 4);
                uint4 pk; pk.x = cvtpk(a[0], a[1]); pk.y = cvtpk(a[2], a[3]); pk.z = cvtpk(b[0], b[1]); pk.w = cvtpk(b[2], b[3]);
                *(uint4*)(dst + q * 8) = pk;
            }
        }
#else
        ACC_FOR(4, row, col) { p.Y[(size_t)(rt * 128 + row) * D + nt * 128 + col] = f2bf(AV(acc)); } ACC_END
#endif
    }
}

#ifndef CPU_EMU
template <int DRY> HD void ph_combine_t(const Params& p, int l, int bid, int nb) {
    const int RQ = (l == 0) ? R : NLAT;
    const int t = tid_(), lane = t & 63, w = t >> 6;
    int tstart[17];
    { int acc = 0;
#pragma unroll
      for (int e = 0; e < 16; ++e) { tstart[e] = acc; acc += (p.cnt[l * 16 + e] + 127) >> 7; } tstart[16] = acc; }
#pragma unroll 2
    for (int r = bid * 4 + w; r < RQ; r += nb * 4) {
        float* xo = xrow_out(p, r);
        const float* m = modrow(p, l, r) + 5120;
        const int e0 = p.sel_e[r * 2], e1 = p.sel_e[r * 2 + 1];
        int t0 = 0, t1 = 0;
#pragma unroll
        for (int q = 0; q < 16; ++q) { if (q == e0) t0 = tstart[q]; if (q == e1) t1 = tstart[q]; }
        const bf16* y0 = p.Y + (size_t)(t0 * 128 + p.apos[r * 2]) * D;
        const bf16* y1 = p.Y + (size_t)(t1 * 128 + p.apos[r * 2 + 1]) * D;
        const float w0 = p.sel_w[r * 2], w1 = p.sel_w[r * 2 + 1];
        f32x4_t xs[4]; float ss = 0.f;
#pragma unroll
        for (int j = 0; j < 4; ++j) {
            const int k = j * 256 + lane * 4;
            f32x4_t xv = *(const f32x4_t*)(xo + k);
            const f32x4_t gv = *(const f32x4_t*)(m + k);
            const uint2 a = *(const uint2*)(y0 + k), b = *(const uint2*)(y1 + k);
            xv[0] += gv[0] * (w0 * __uint_as_float(a.x << 16) + w1 * __uint_as_float(b.x << 16));
            xv[1] += gv[1] * (w0 * __uint_as_float(a.x & 0xffff0000u) + w1 * __uint_as_float(b.x & 0xffff0000u));
            xv[2] += gv[2] * (w0 * __uint_as_float(a.y << 16) + w1 * __uint_as_float(b.y << 16));
            xv[3] += gv[3] * (w0 * __uint_as_float(a.y & 0xffff0000u) + w1 * __uint_as_float(b.y & 0xffff0000u));
            *(f32x4_t*)((DRY ? (float*)p.gq + (size_t)r * 64 : xo) + (DRY ? (k & 63) : k)) = xv;
            xs[j] = xv; ss += xv[0] * xv[0] + xv[1] * xv[1] + xv[2] * xv[2] + xv[3] * xv[3];
        }
        if (l == 0 && !DRY) {
            ss = wave_sum(ss);
            const float rs = 1.0f / sqrtf(ss / D + 1e-6f);
            const float* g1 = p.in[I_N1G] + D; const float* m1 = modrow(p, 1, r);
#pragma unroll
            for (int j = 0; j < 4; ++j) {
                const int k = j * 256 + lane * 4;
                const f32x4_t gv = *(const f32x4_t*)(g1 + k), sc = *(const f32x4_t*)(m1 + 1024 + k), sh = *(const f32x4_t*)(m1 + k);
                float o[4];
#pragma unroll
                for (int q = 0; q < 4; ++q) o[q] = xs[j][q] * rs * gv[q] * (1.0f + sc[q]) + sh[q];
                uint2 pk; pk.x = cvtpk(o[0], o[1]); pk.y = cvtpk(o[2], o[3]);
                *(uint2*)(p.h + (size_t)r * D + k) = pk;
                *(unsigned*)(h8_of(p) + (size_t)r * D + k) = pack_fp8x4(o[0] * 4.f, o[1] * 4.f, o[2] * 4.f, o[3] * 4.f);
            }
        }
    }
}
HD void ph_combine(const Params& p, int l, int bid, int nb) { ph_combine_t<0>(p, l, bid, nb); }
#else
HD void ph_combine(const Params& p, int l, int bid, int nb) {
    const int RQ = (l == 0) ? R : NLAT;
    int tstart[17];
    { int acc = 0; for (int e = 0; e < 16; ++e) { tstart[e] = acc; acc += (p.cnt[l * 16 + e] + 127) >> 7; } tstart[16] = acc; }
    for (int r = bid; r < RQ; r += nb) {
        float* xo = xrow_out(p, r);
        const float* m = modrow(p, l, r);
        int e0 = p.sel_e[r * 2], e1 = p.sel_e[r * 2 + 1];
        int t0 = 0, t1 = 0;
#pragma unroll
        for (int q = 0; q < 16; ++q) { if (q == e0) t0 = tstart[q]; if (q == e1) t1 = tstart[q]; }
        const bf16* y0 = p.Y + (size_t)(t0 * 128 + p.apos[r * 2]) * D;
        const bf16* y1 = p.Y + (size_t)(t1 * 128 + p.apos[r * 2 + 1]) * D;
        const float w0 = p.sel_w[r * 2], w1 = p.sel_w[r * 2 + 1];
        THREADS(t, 256) {
            for (int k = t; k < D; k += 256) xo[k] += m[5120 + k] * (w0 * bf2f(y0[k]) + w1 * bf2f(y1[k]));
        }
    }
}

#endif

constexpr int NPHASE_LAYER = 14;
HD void run_phase(const Params& p, int ph, int l, int bid, int nb, float* sm) {
    switch (ph) {
        case 0: ph_norm1(p, l, bid, nb, sm); break;
        case 1: ph_inproj(p, l, bid, nb, (char*)sm); break;
        case 2: ph_prep(p, l, bid, nb); if (FOURIER_GEMM) { if (l == 0) ph_fourier_s1c(p, nb - 1 - bid, nb, (char*)sm); ph_fourier_s1(p, bid, nb, (char*)sm); } break;
        case 3: ph_na(p, l, bid, nb, (char*)sm); break;
        case 4: ph_da(p, l, bid, nb, (char*)sm); break;
        case 5: ph_gdn_chunk(p, l, bid, nb, sm); break;
        case 6: if (FOURIER_GEMM) { if (l == 0) ph_fourier_ctx(p, bid, nb, (char*)sm); ph_fourier_sA(p, bid, nb, (char*)sm); } else ph_fourier2(p, l, bid, nb); break;
        case 7: {
            ph_gdn_scan(p, l, bid, nb, sm);
            const bool split = nb == 512;
            const bool skip = split && (bid < 64 || (bid >= 256 && bid < 320));
            if (!skip) {
                const int b2 = split ? (bid < 256 ? bid - 64 : bid - 128) : bid, n2 = split ? nb - 128 : nb;
                if (FOURIER_GEMM) ph_fourier_sB(p, b2, n2, (char*)sm);
                if (l == 0) convert_static(p, b2, n2, sm, 1);
                convert_moe(p, l, b2, n2, sm);
#ifndef CPU_EMU
                ph_na(p, l, b2, n2, (char*)sm);
#endif
            }
        } break;
#ifndef CPU_EMU
        case 8: ph_gdn_outfin(p, l, bid, nb, sm); break;
#else
        case 8: ph_gdn_fin(p, l, bid, nb); break;
#endif
        case 9: ph_merge(p, l, bid, nb, (char*)sm); break;
        case 10: ph_outproj(p, l, bid, nb, (char*)sm); break;
        case 11: ph_router(p, l, bid, nb, sm); break;
        case 12: ph_ffn1(p, l, bid, nb, (char*)sm); break;
        case 13: ph_ffn2(p, l, bid, nb, (char*)sm); break;
        case 14: ph_combine(p, l, bid, nb); break;
#ifndef CPU_EMU
        case 70: ph_gdn_scan(p, l, bid, nb, sm); break;
        case 71: if (bid >= 64) { if (FOURIER_GEMM) ph_fourier_sB(p, bid - 64, nb - 64, (char*)sm); if (l == 0) convert_static(p, bid - 64, nb - 64, sm, 1); convert_moe(p, l, bid - 64, nb - 64, sm); } break;
        case 110: ph_outproj_t<1>(p, l, bid, nb, (char*)sm); break;
        case 111: ph_router_t<1>(p, l, bid, nb, sm); break;
        case 114: ph_combine_t<1>(p, l, bid, nb); break;
#endif
        default: break;
    }
}

struct WsLayout { size_t dep, fWC, fXC, ropeT, bar, fa2, fW1, fWA, fWB, mods, cosT, sinT, cs, gg, gbeta, sel_e, sel_w, cnt, elist, apos, cG, wt_in, wt_br, wt_out, wt_gu, wt_d,
                  h, P, gq, fcs, cU, cW, cQK, odir, br, mg, act, Y, total; };
inline WsLayout ws_layout() {
    WsLayout w; size_t o = 0;
    auto take = [&](size_t bytes) { size_t r = o; o += (bytes + 255) & ~(size_t)255; return r; };
    w.bar = take(3456 * 4 + 256);        w.ropeT = take(128 * 8 * 2 * 4); w.fWC = take((size_t)CTXL * 2 * CTXL * 2); w.fXC = take((size_t)NB * 256 * 2 * CTXL * 2);
    w.mods = take(2 * 3 * 6144 * 4); w.cosT = take(SEQ * 4); w.sinT = take(SEQ * 4); w.cs = take((size_t)NCTX * D * 4);
    w.gg = take((size_t)8 * R * 4); w.gbeta = take((size_t)8 * R * 4); w.sel_e = take((size_t)R * 2 * 4); w.sel_w = take((size_t)R * 2 * 4);
    w.cnt = take(32 * 4); w.elist = take((size_t)16 * 2 * R * 4); w.apos = take((size_t)2 * R * 4); w.cG = take((size_t)NUNIT * 192 * 4);
    w.wt_in = take((size_t)2 * WIN_NP * D * 2); w.wt_br = take((size_t)2 * 4 * D * 256 * 2); w.wt_out = take((size_t)2 * D * D * 2);
    w.wt_gu = take((size_t)16 * 1024 * D * 2); w.wt_d = take((size_t)16 * D * 512 * 2);
    w.h = take((size_t)R * D * 2);
    w.fa2 = take((size_t)NB * 128 * 256 * 2 * 64 * 2); w.fW1 = take(8192 * 2); w.fWA = take(65536 * 2); w.fWB = take(8192 * 2);
    {
        const size_t szP = ((size_t)R * PLD * 2 + 255) & ~(size_t)255, szQ = ((size_t)R * 768 * 2 + 255) & ~(size_t)255;
        const size_t szA = ((size_t)PADROWS * 512 * 2 + 255) & ~(size_t)255, szY = ((size_t)PADROWS * 1024 * 2 + 255) & ~(size_t)255;
        const size_t base = take((szP + szQ) > (szA + szY) ? (szP + szQ) : (szA + szY));
        w.P = base; w.gq = base + szP; w.act = base; w.Y = base + szA;
    }
    w.fcs = take((size_t)R * 512 * 2);
    w.cU = take((size_t)NUNIT * 4096 * 2); w.cW = take((size_t)NUNIT * 4096 * 2); w.cQK = take((size_t)NUNIT * 4096 * 2);
    w.odir = take((size_t)2 * R * 256 * 2); w.br = take((size_t)R * D * 2);
    w.mg = w.cU;
    w.total = o;
    return w;
}
inline void fill_params(Params& p, void* const* d_in, void* d_out, void* d_ws) {
    WsLayout w = ws_layout(); char* b = (char*)d_ws;
    for (int i = 0; i < 30; ++i) p.in[i] = (const float*)d_in[i];
    p.out = (float*)d_out;
    p.mods = (float*)(b + w.mods); p.cosT = (float*)(b + w.cosT); p.sinT = (float*)(b + w.sinT); p.cs = (float*)(b + w.cs);
    p.h = (bf16*)(b + w.h); p.P = (bf16*)(b + w.P); p.gq = (bf16*)(b + w.gq); p.gg = (float*)(b + w.gg); p.gbeta = (float*)(b + w.gbeta);
    p.fcs = (bf16*)(b + w.fcs); p.cU = (bf16*)(b + w.cU); p.cW = (bf16*)(b + w.cW); p.cQK = (bf16*)(b + w.cQK); p.cG = (float*)(b + w.cG);
    p.odir = (bf16*)(b + w.odir); p.br = (bf16*)(b + w.br); p.mg = (bf16*)(b + w.mg); p.sel_e = (int*)(b + w.sel_e);
    p.sel_w = (float*)(b + w.sel_w); p.act = (bf16*)(b + w.act); p.Y = (bf16*)(b + w.Y);
    p.wt_in = (bf16*)(b + w.wt_in); p.wt_br = (bf16*)(b + w.wt_br); p.wt_out = (bf16*)(b + w.wt_out); p.wt_gu = (bf16*)(b + w.wt_gu);
    p.fa2 = (bf16*)(b + w.fa2); p.fW1 = (bf16*)(b + w.fW1); p.fWA = (bf16*)(b + w.fWA); p.fWB = (bf16*)(b + w.fWB);
    p.bar = (unsigned*)(b + w.bar); p.dep = (int*)(b + w.bar + 3456 * 4); p.ropeT = (float*)(b + w.ropeT); p.fWC = (bf16*)(b + w.fWC); p.fXC = (bf16*)(b + w.fXC);
    p.wt_d = (bf16*)(b + w.wt_d); p.cnt = (int*)(b + w.cnt); p.elist = (int*)(b + w.elist); p.apos = (int*)(b + w.apos);
}

#if !defined(CPU_EMU) && defined(PHASE_KERNELS)
#define PK(n) __global__ void __launch_bounds__(256, 2) pk_##n(Params p) { __shared__ __attribute__((aligned(16))) float sm[SMEM_FLOATS]; run_phase(p, n, p.layer, blockIdx.x, gridDim.x, sm); }
PK(0) PK(1) PK(2) PK(3) PK(4) PK(5) PK(6) PK(7) PK(8) PK(9) PK(10) PK(11) PK(12) PK(13) PK(14)
__global__ void __launch_bounds__(256, 2) pk_init(Params p) { __shared__ __attribute__((aligned(16))) float sm[SMEM_FLOATS]; ph_init(p, blockIdx.x, gridDim.x, sm); }
#endif
#ifndef CPU_EMU

#define XB_TMO      128
#define XB_XCNT(j)  (256  + 64 * (j))
#define XB_XSUB(j)  (1280 + 64 * (j))
#define XB_XGEN(j)  (2304 + 64 * (j))
#define XB_TOP      3328
#define XB_TOPGEN   3392
#define XCD_BAR_WORDS 3456
#define XB_SPIN_CAP (1u << 22)
#define LAS __attribute__((address_space(3)))
__device__ __forceinline__ unsigned xb_ld(unsigned* p)              { return __hip_atomic_load(p, __ATOMIC_RELAXED, __HIP_MEMORY_SCOPE_AGENT); }
__device__ __forceinline__ unsigned xb_add(unsigned* p, unsigned v) { return __hip_atomic_fetch_add(p, v, __ATOMIC_RELAXED, __HIP_MEMORY_SCOPE_AGENT); }
__device__ __forceinline__ unsigned xb_xcc_id() { return (unsigned)__builtin_amdgcn_s_getreg((3 << 11) | 20) & 0xFu; }
#define XB_SPIN(cond, bar) do { unsigned _sp = 0; while (cond) { __builtin_amdgcn_s_sleep(1); \
    if ((++_sp & 255u) == 0u) { if (xb_ld(&(bar)[XB_TMO])) break; if (_sp > XB_SPIN_CAP) { atomicAdd(&(bar)[XB_TMO], 1u); break; } } } } while (0)
struct XcdBarrier { unsigned* bar; unsigned x; volatile LAS unsigned* st; };
__device__ __forceinline__ XcdBarrier xcd_barrier_post(unsigned* bar, volatile LAS unsigned* st) {
    XcdBarrier b; b.bar = bar; b.x = xb_xcc_id(); b.st = st;
    if (threadIdx.x == 0) (void)xb_add(&bar[XB_XCNT(b.x)], 1u);
    return b;
}
__device__ __forceinline__ void xcd_barrier_complete(unsigned* bar, unsigned x, unsigned& nloc, unsigned& nx) {
    const unsigned G = gridDim.x * gridDim.y * gridDim.z;
    unsigned sum, cnt, mine, sp = 0u;
    for (;;) {
        sum = 0u; cnt = 0u; mine = 0u;
#pragma unroll
        for (unsigned j = 0; j < 16; ++j) { const unsigned c = xb_ld(&bar[XB_XCNT(j)]); sum += c; cnt += (c > 0u) ? 1u : 0u; mine = (j == x) ? c : mine; }
        if (sum == G) break;
        __builtin_amdgcn_s_sleep(1);
        if ((++sp & 255u) == 0u) { if (xb_ld(&bar[XB_TMO])) break; if (sp > XB_SPIN_CAP) { atomicAdd(&bar[XB_TMO], 1u); break; } }
    }
    nloc = mine > 0u ? mine : 1u; nx = cnt > 0u ? cnt : 1u;
}
__device__ __forceinline__ void xcd_barrier(const XcdBarrier& b) {
    asm volatile("s_waitcnt vmcnt(0)" ::: "memory");
    __syncthreads();
    if (threadIdx.x == 0) {
        unsigned* bar = b.bar;
        __builtin_amdgcn_s_waitcnt(0);
        unsigned nloc = b.st[0], nx = b.st[1];
        if (nloc == 0u) { xcd_barrier_complete(bar, b.x, nloc, nx); b.st[0] = nloc; b.st[1] = nx; }
        const unsigned old = xb_add(&bar[XB_XSUB(b.x)], 1u);
        const unsigned gen = old / nloc;
        if (old + 1u == (gen + 1u) * nloc) {
            __builtin_amdgcn_fence(__ATOMIC_RELEASE, "agent");
            asm volatile("s_waitcnt vmcnt(0)" ::: "memory");
            const unsigned og = xb_add(&bar[XB_TOP], 1u);
            const unsigned tg = og / nx;
            if (og + 1u == (tg + 1u) * nx) xb_add(&bar[XB_TOPGEN], 1u);
            else XB_SPIN(xb_ld(&bar[XB_TOPGEN]) == tg, bar);
            __builtin_amdgcn_fence(__ATOMIC_ACQUIRE, "agent");
            xb_add(&bar[XB_XGEN(b.x)], 1u);
            asm volatile("s_waitcnt vmcnt(0)" ::: "memory");
        } else {
            XB_SPIN(xb_ld(&bar[XB_XGEN(b.x)]) == gen, bar);
            __builtin_amdgcn_fence(__ATOMIC_ACQUIRE, "agent");
            asm volatile("s_waitcnt vmcnt(0)" ::: "memory");
        }
    }
    __syncthreads();
}

__global__ void __launch_bounds__(256, 2) fwd_megakernel(Params p) {
    __shared__ __attribute__((aligned(16))) float sm[SMEM_FLOATS];
    cg::grid_group grid = cg::this_grid();
    const int bid = blockIdx.x, nb = gridDim.x;
    volatile LAS unsigned* xst = (volatile LAS unsigned*)(sm + SMEM_FLOATS - 4);
    if (threadIdx.x == 0) { xst[0] = 0u; xst[1] = 0u; }
    __syncthreads();
    XcdBarrier xb = xcd_barrier_post(p.bar, xst);
    ph_init(p, bid, nb, sm);
    dep_wait(p.dep, 96);
    ph_norm1(p, 0, bid, nb, sm);
    xcd_barrier(xb);
#ifdef PROBE_INIT
    ph_init(p, bid, nb, sm); xcd_barrier(xb); ph_init(p, bid, nb, sm); xcd_barrier(xb);
#endif
#define PH(n, l) run_phase(p, n, l, bid, nb, sm); xcd_barrier(xb);
#define PHN(n, l) run_phase(p, n, l, bid, nb, sm);
#ifndef PROBE_X
#define PROBE_X(n, l)
#endif
#define LAYER(l) PH(1, l) PROBE_X(1, l) PH(2, l) PROBE_X(2, l) PHN(4, l) PHN(6, l) PH(5, l) PROBE_X(4, l) PROBE_X(5, l) PROBE_X(3, l) PROBE_X(6, l) \
    PH(7, l) PROBE_X(7, l) PROBE_X(70, l) PROBE_X(71, l) PH(8, l) PROBE_X(8, l) PH(9, l) PROBE_X(9, l) PH(10, l) PH(11, l) PH(12, l) PROBE_X(12, l) \
    PH(13, l) PROBE_X(13, l) PH(14, l)
    LAYER(0)
#undef LAYER
#define LAYER(l) PH(1, l) PROBE_X(1, l) PH(2, l) PROBE_X(2, l) PHN(4, l) PHN(6, l) PH(5, l) PROBE_X(4, l) PROBE_X(5, l) PROBE_X(3, l) PROBE_X(6, l) \
    PH(7, l) PROBE_X(7, l) PROBE_X(70, l) PROBE_X(71, l) PH(8, l) PROBE_X(8, l) PH(9, l) PROBE_X(9, l) PH(10, l) PROBE_X(110, l) PH(11, l) PROBE_X(111, l) PH(12, l) PROBE_X(12, l) \
    PH(13, l) PROBE_X(13, l) PH(14, l) PROBE_X(114, l)
    LAYER(1)
}

extern "C" void kernel_launch(void* const* d_in, const int* in_sizes, int n_in, void* d_out, int out_size,
                              void* d_ws, size_t ws_size, hipStream_t stream) {
    WsLayout w = ws_layout();
    if (ws_size < w.total) { fprintf(stderr, "ws too small: need %zu have %zu\n", w.total, ws_size); return; }
    static int grid_blocks = 0;
    if (!grid_blocks) {
        int dev = 0, cus = 0, per_cu = 0;
        (void)hipGetDevice(&dev);
        (void)hipDeviceGetAttribute(&cus, hipDeviceAttributeMultiprocessorCount, dev);
        (void)hipOccupancyMaxActiveBlocksPerMultiprocessor(&per_cu, fwd_megakernel, 256, 0);
        if (per_cu < 1) per_cu = 1;
        grid_blocks = cus * per_cu;
    }
    Params p{};
    fill_params(p, d_in, d_out, d_ws);
    (void)hipMemsetAsync(p.bar, 0, XCD_BAR_WORDS * 4 + 256, stream);
    void* args[] = {&p};
    hipError_t e = hipLaunchCooperativeKernel((void*)fwd_megakernel, dim3(grid_blocks), dim3(256), args, 0, stream);
    if (e != hipSuccess) fprintf(stderr, "cooperative launch failed: %s (grid %d)\n", hipGetErrorString(e), grid_blocks);
}
#endif
```
